# Optimizing an MI355X kernel written in HIP

```python
import math
import jax, jax.numpy as jnp
from jax import lax
import numpy as np

D_MODEL = 2048
BATCH = 1
SEQ = 16384
DEPTH = 2

D_MIX = D_MODEL
SGU_WIDTH = D_MIX // 4
SGU_HEADS = 4
SGU_HEAD_DIM = SGU_WIDTH // SGU_HEADS
SGU_CHUNK = 128
CONV_CH = D_MIX // 4
CONV_K = 31
ATTN_WIDTH = D_MIX // 2
ATTN_HEADS = 8
ATTN_HEAD_DIM = ATTN_WIDTH // ATTN_HEADS
DILATED_CONFIGS = ((128, 1), (512, 4), (2048, 16))
QBLK = 128
D_IN = 2 * SGU_WIDTH + 2 * CONV_CH + 3 * ATTN_WIDTH
IN_SPLITS = (SGU_WIDTH, 2 * SGU_WIDTH, 2 * SGU_WIDTH + CONV_CH, 2 * SGU_WIDTH + 2 * CONV_CH,
             2 * SGU_WIDTH + 2 * CONV_CH + ATTN_WIDTH, 2 * SGU_WIDTH + 2 * CONV_CH + 2 * ATTN_WIDTH)
N_GROUPS = 4
EXPERTS_PER_GROUP = 8
N_EXPERTS = N_GROUPS * EXPERTS_PER_GROUP
TOP_K = 2
D_EXPERT = D_MODEL // 4
MOE_BLK = 128
EPS = 1e-6

kernel_name = "hymba_gmlp_conformer_dilated_attn_hmoe"


def rms_norm(x, g):
    xf = x.astype(jnp.float32)
    y = xf * lax.rsqrt(jnp.mean(xf * xf, axis=-1, keepdims=True) + EPS)
    return (y * g.astype(jnp.float32)).astype(x.dtype)


def layer_norm(x, g, b):
    xf = x.astype(jnp.float32)
    mu = jnp.mean(xf, axis=-1, keepdims=True)
    xc = xf - mu
    y = xc * lax.rsqrt(jnp.mean(xc * xc, axis=-1, keepdims=True) + EPS)
    return (y * g.astype(jnp.float32) + b.astype(jnp.float32)).astype(x.dtype)


def spatial_gating(u, v, g, w_s, b_s):
    B, S, _ = u.shape
    u = jax.nn.gelu(u)
    v = rms_norm(jax.nn.gelu(v), g)
    vc = v.reshape(B, S // SGU_CHUNK, SGU_CHUNK, SGU_HEADS, SGU_HEAD_DIM)
    causal = jnp.tril(jnp.ones((SGU_CHUNK, SGU_CHUNK), dtype=bool))
    w = jnp.where(causal[None], w_s, jnp.zeros((), w_s.dtype))
    z = jnp.einsum('hij,bnjhd->bnihd', w, vc) + b_s.T[None, None, :, :, None]
    return u * z.reshape(B, S, SGU_WIDTH)


def conformer_conv(a, g, w, b, ln_g, ln_b):
    z = a * jax.nn.sigmoid(g)
    z = lax.conv_general_dilated(z, w[:, None, :], window_strides=(1,),
                                 padding=[(CONV_K - 1, 0)],
                                 dimension_numbers=('NWC', 'WIO', 'NWC'),
                                 feature_group_count=CONV_CH) + b
    return jax.nn.silu(layer_norm(z, ln_g, ln_b))


def dilated_branch(q, k, v, window, dil):
    B, H, S, Dh = q.shape
    span = window // dil
    step = dil * QBLK
    P = -(-S // step) * step
    M = P // dil
    nb = M // QBLK

    def phase(t):
        t = jnp.pad(t, ((0, 0), (0, 0), (0, P - S), (0, 0)))
        t = t.reshape(B, H, M, dil, Dh).transpose(0, 1, 3, 2, 4)
        return t.reshape(B, H, dil, nb, QBLK, Dh)

    def with_prev(t):
        prev = jnp.pad(t[:, :, :, :-1], ((0, 0), (0, 0), (0, 0), (1, 0), (0, 0), (0, 0)))
        return jnp.concatenate([prev, t], axis=4)

    qb = phase(q).astype(jnp.float32)
    kb = with_prev(phase(k)).astype(jnp.float32)
    vb = with_prev(phase(v)).astype(jnp.float32)
    s = jnp.einsum('bhrnid,bhrnjd->bhrnij', qb, kb) * (Dh ** -0.5)
    i = jnp.arange(QBLK)[:, None]
    j = jnp.arange(2 * QBLK)[None, :]
    dist = QBLK + i - j
    blk = jnp.arange(nb)[:, None, None]
    valid = (dist >= 0) & (dist <= span) & ((blk > 0) | (j >= QBLK))[None] if False else \
        ((dist >= 0) & (dist <= span))[None] & ((blk > 0) | (j >= QBLK))
    s = jnp.where(valid, s, -jnp.inf)
    lse = jax.nn.logsumexp(s, axis=-1)
    p = jnp.exp(s - lse[..., None])
    o = jnp.einsum('bhrnij,bhrnjd->bhrnid', p, vb)
    o = o.reshape(B, H, dil, M, Dh).transpose(0, 1, 3, 2, 4).reshape(B, H, P, Dh)[:, :, :S]
    lse = lse.reshape(B, H, dil, M).transpose(0, 1, 3, 2).reshape(B, H, P)[:, :, :S]
    return o, lse


def dilated_attention(q, k, v, q_g, k_g):
    B, S, _ = q.shape

    def heads(t):
        return t.reshape(B, S, ATTN_HEADS, ATTN_HEAD_DIM).transpose(0, 2, 1, 3)

    qh = rms_norm(heads(q), q_g)
    kh = rms_norm(heads(k), k_g)
    vh = heads(v)
    outs, lses = [], []
    for window, dil in DILATED_CONFIGS:
        o, lse = dilated_branch(qh, kh, vh, window, dil)
        outs.append(o)
        lses.append(lse)
    wts = jax.nn.softmax(jnp.stack(lses), axis=0)
    o = jnp.einsum('gbhs,gbhsd->bhsd', wts, jnp.stack(outs))
    return o.astype(v.dtype).transpose(0, 2, 1, 3).reshape(B, S, ATTN_WIDTH)


def hier_moe(h, w_rg, b_rg, w_re, b_re, w_g, w_u, w_d):
    B, S, D = h.shape
    T = B * S
    xt = h.reshape(T, D)
    logit_g = (xt @ w_rg).astype(jnp.float32) + b_rg.astype(jnp.float32)
    p_g = jax.nn.softmax(logit_g, axis=-1)
    grp = jnp.argmax(logit_g, axis=-1).astype(jnp.int32)
    gate_g = jnp.take_along_axis(p_g, grp[:, None], axis=1)[:, 0]
    logit_e = ((xt @ w_re).astype(jnp.float32) + b_re.astype(jnp.float32)).reshape(T, N_GROUPS, EXPERTS_PER_GROUP)
    logit_e = jnp.take_along_axis(logit_e, grp[:, None, None], axis=1)[:, 0]
    top_v, top_i = lax.top_k(logit_e, TOP_K)
    gates = gate_g[:, None] * jax.nn.softmax(top_v, axis=-1)
    eid = grp[:, None] * EXPERTS_PER_GROUP + top_i.astype(jnp.int32)

    n_assign = T * TOP_K
    flat_e = eid.reshape(-1)
    flat_tok = jnp.repeat(jnp.arange(T, dtype=jnp.int32), TOP_K)
    flat_gate = gates.reshape(-1)
    order = jnp.argsort(flat_e)
    se = flat_e[order]
    counts = jnp.bincount(flat_e, length=N_EXPERTS).astype(jnp.int32)
    starts = jnp.cumsum(counts) - counts
    pcounts = (counts + MOE_BLK - 1) // MOE_BLK * MOE_BLK
    pends = jnp.cumsum(pcounts)
    pstarts = pends - pcounts
    dest = pstarts[se] + (jnp.arange(n_assign, dtype=jnp.int32) - starts[se])
    cap = n_assign + N_EXPERTS * MOE_BLK
    nblk = cap // MOE_BLK
    buf_tok = jnp.full((cap,), T, jnp.int32).at[dest].set(flat_tok[order])
    buf_gate = jnp.zeros((cap,), jnp.float32).at[dest].set(flat_gate[order])
    blk_e = jnp.minimum(jnp.searchsorted(pends, jnp.arange(nblk, dtype=jnp.int32) * MOE_BLK, side='right'),
                        N_EXPERTS - 1).astype(jnp.int32)
    xpad = jnp.concatenate([xt, jnp.zeros((1, D), xt.dtype)], axis=0)

    def expert_block(args):
        tok, e = args
        xb = xpad[tok]
        hb = jax.nn.silu(xb @ w_g[e]) * (xb @ w_u[e])
        return hb @ w_d[e]

    yb = lax.map(expert_block, (buf_tok.reshape(nblk, MOE_BLK), blk_e)).reshape(cap, D)
    y = jnp.zeros((T + 1, D), xt.dtype).at[buf_tok].add(yb * buf_gate[:, None].astype(yb.dtype))
    return y[:T].reshape(B, S, D)


def setup_inputs(seed: int = 0) -> dict:
    key = jax.random.key(seed)
    ks = jax.random.split(key, 24)
    f32 = jnp.float32

    def nrm(k, shape, scale):
        return jax.random.normal(k, shape, f32) * scale

    return {
        "x": nrm(ks[0], (BATCH, SEQ, D_MODEL), 1.0),
        "norm1": 1.0 + nrm(ks[1], (DEPTH, D_MODEL), 0.02),
        "w_in": nrm(ks[2], (DEPTH, D_MODEL, D_IN), D_MODEL ** -0.5),
        "sgu_norm": 1.0 + nrm(ks[3], (DEPTH, SGU_WIDTH), 0.02),
        "sgu_w": nrm(ks[4], (DEPTH, SGU_HEADS, SGU_CHUNK, SGU_CHUNK), SGU_CHUNK ** -0.5),
        "sgu_b": 1.0 + nrm(ks[5], (DEPTH, SGU_HEADS, SGU_CHUNK), 0.02),
        "conv_w": nrm(ks[6], (DEPTH, CONV_K, CONV_CH), CONV_K ** -0.5),
        "conv_b": nrm(ks[7], (DEPTH, CONV_CH), 0.02),
        "conv_ln_g": 1.0 + nrm(ks[8], (DEPTH, CONV_CH), 0.02),
        "conv_ln_b": nrm(ks[9], (DEPTH, CONV_CH), 0.02),
        "q_norm": 1.0 + nrm(ks[10], (DEPTH, ATTN_HEAD_DIM), 0.02),
        "k_norm": 1.0 + nrm(ks[11], (DEPTH, ATTN_HEAD_DIM), 0.02),
        "out_norm": 1.0 + nrm(ks[12], (DEPTH, D_MIX), 0.02),
        "w_out": nrm(ks[13], (DEPTH, D_MIX, D_MODEL), D_MIX ** -0.5),
        "norm2": 1.0 + nrm(ks[14], (DEPTH, D_MODEL), 0.02),
        "w_router_group": nrm(ks[15], (DEPTH, D_MODEL, N_GROUPS), D_MODEL ** -0.5),
        "b_router_group": nrm(ks[16], (DEPTH, N_GROUPS), 0.01),
        "w_router_expert": nrm(ks[17], (DEPTH, D_MODEL, N_EXPERTS), D_MODEL ** -0.5),
        "b_router_expert": nrm(ks[18], (DEPTH, N_EXPERTS), 0.01),
        "w_expert_gate": nrm(ks[19], (DEPTH, N_EXPERTS, D_MODEL, D_EXPERT), D_MODEL ** -0.5),
        "w_expert_up": nrm(ks[20], (DEPTH, N_EXPERTS, D_MODEL, D_EXPERT), D_MODEL ** -0.5),
        "w_expert_down": nrm(ks[21], (DEPTH, N_EXPERTS, D_EXPERT, D_MODEL), D_EXPERT ** -0.5),
    }


def reference(x, norm1, w_in, sgu_norm, sgu_w, sgu_b, conv_w, conv_b, conv_ln_g, conv_ln_b,
              q_norm, k_norm, out_norm, w_out, norm2, w_router_group, b_router_group,
              w_router_expert, b_router_expert, w_expert_gate, w_expert_up, w_expert_down):
    h = x
    a_end = SGU_WIDTH
    b_end = SGU_WIDTH + CONV_CH
    for l in range(DEPTH):
        hn = rms_norm(h, norm1[l])
        proj = hn @ w_in[l]
        u_a, v_a, a_b, g_b, q, k, v = jnp.split(proj, list(IN_SPLITS), axis=-1)
        y_a = spatial_gating(u_a, v_a, sgu_norm[l], sgu_w[l], sgu_b[l])
        y_b = conformer_conv(a_b, g_b, conv_w[l], conv_b[l], conv_ln_g[l], conv_ln_b[l])
        y_c = dilated_attention(q, k, v, q_norm[l], k_norm[l])
        g = out_norm[l]
        mix = jnp.concatenate([rms_norm(y_a, g[:a_end]),
                               rms_norm(y_b, g[a_end:b_end]),
                               rms_norm(y_c, g[b_end:])], axis=-1)
        h = h + mix @ w_out[l]
        h = h + hier_moe(rms_norm(h, norm2[l]), w_router_group[l], b_router_group[l],
                         w_router_expert[l], b_router_expert[l],
                         w_expert_gate[l], w_expert_up[l], w_expert_down[l])
    return h
```

```cpp
#include <hip/hip_runtime.h>
#include <cstdio>
#include <cstdint>

#ifndef MK_N_LAUNCHES
#define MK_N_LAUNCHES 17
#endif

#define GAS __attribute__((address_space(1)))
#define LAS __attribute__((address_space(3)))
typedef unsigned short bf16;
typedef short bf16x8 __attribute__((ext_vector_type(8)));
typedef short s16x4 __attribute__((ext_vector_type(4)));
typedef float f32x4 __attribute__((ext_vector_type(4)));
typedef float f32x2 __attribute__((ext_vector_type(2)));
typedef unsigned u32x4 __attribute__((ext_vector_type(4)));
typedef unsigned u32x2 __attribute__((ext_vector_type(2)));

constexpr int SEQ = 16384, DM = 2048, DIN = 5120, NLAYER = 2;
constexpr int HD = 128, NHEAD = 8, CONV_K = 31;
constexpr int NE = 32, DE = 512, TOKCAP = 16384;
constexpr int OFF_U = 0, OFF_V = 512, OFF_A = 1024, OFF_G = 1536, OFF_Q = 2048, OFF_K = 3072, OFF_VV = 4096;
constexpr float EPS = 1e-6f;
constexpr int NWAVES = 8, NTHREADS = 512;

constexpr size_t MiB = 1u << 20;
constexpr size_t WS_CTL = 0, CTL_ZERO_BYTES = 1 * MiB;
constexpr size_t WS_WIN = 1 * MiB;
constexpr size_t WS_WOUT = 41 * MiB;
constexpr size_t WS_W1 = 57 * MiB;
constexpr size_t WS_W2 = 313 * MiB;
constexpr size_t WS_SGUW = 441 * MiB;
constexpr size_t WS_WRT = 442 * MiB;
constexpr size_t WS_TOK = 443 * MiB;
constexpr size_t WS_TINFO = 445 * MiB;
constexpr size_t WS_HN = 446 * MiB;
constexpr size_t WS_HB = 510 * MiB;
constexpr size_t WS_ATT = WS_HN;
constexpr size_t WS_LSE = WS_HN + 96 * MiB;
constexpr size_t WS_PROJ = 550 * MiB;
constexpr size_t WS_Y = WS_PROJ;
constexpr size_t WS_MIX = 710 * MiB;
constexpr size_t WS_H = 774 * MiB;
constexpr size_t WS_END = 902 * MiB;
constexpr int CW_BAR = 4096;
constexpr int CW_CNT = 16384;

constexpr int LDS_BYTES = 163840;
constexpr int MISC_OFF = 159744;

__device__ __forceinline__ unsigned cvt_pk_bf16(float lo, float hi) { unsigned r; asm volatile("v_cvt_pk_bf16_f32 %0, %1, %2" : "=v"(r) : "v"(lo), "v"(hi)); return r; }
__device__ __forceinline__ float bf_lo(unsigned u) { return __builtin_bit_cast(float, u << 16); }
__device__ __forceinline__ float bf_hi(unsigned u) { return __builtin_bit_cast(float, u & 0xffff0000u); }
__device__ __forceinline__ float wave_sum(float v) {
#pragma unroll
    for (int o = 1; o < 64; o <<= 1) v += __shfl_xor(v, o);
    return v;
}
#define LDS_WAIT() asm volatile("s_waitcnt lgkmcnt(0)" ::: "memory")
#define VM_WAIT() asm volatile("s_waitcnt vmcnt(0)" ::: "memory")
__device__ __forceinline__ float fast_exp(float x) { return __builtin_amdgcn_exp2f(x * 1.4426950408889634f); }
__device__ __forceinline__ float sigmoidf_(float x) { return __builtin_amdgcn_rcpf(1.0f + fast_exp(-x)); }
__device__ __forceinline__ float gelu_tanh(float x) { const float z = 1.5957691216057308f * (x + 0.044715f * x * x * x); return x * sigmoidf_(z); }

#define XB_TMO      128
#define XB_XCNT(j)  (256  + 64 * (j))
#define XB_XSUB(j)  (1280 + 64 * (j))
#define XB_XGEN(j)  (2304 + 64 * (j))
#define XB_TOP      3328
#define XB_TOPGEN   3392
#define XCD_BAR_WORDS 3456
#define XB_SPIN_CAP (1u << 22)
__device__ __forceinline__ unsigned xb_ld(unsigned* p)              { return __hip_atomic_load(p, __ATOMIC_RELAXED, __HIP_MEMORY_SCOPE_AGENT); }
__device__ __forceinline__ unsigned xb_add(unsigned* p, unsigned v) { return __hip_atomic_fetch_add(p, v, __ATOMIC_RELAXED, __HIP_MEMORY_SCOPE_AGENT); }
__device__ __forceinline__ unsigned xb_xcc_id() { return (unsigned)__builtin_amdgcn_s_getreg((3 << 11) | 20) & 0xFu; }
#define XB_SPIN(cond, bar) do { unsigned _sp = 0; while (cond) { __builtin_amdgcn_s_sleep(1); \
    if ((++_sp & 255u) == 0u) { if (xb_ld(&(bar)[XB_TMO])) break; if (_sp > XB_SPIN_CAP) { atomicAdd(&(bar)[XB_TMO], 1u); break; } } } } while (0)
struct XcdBarrier { unsigned* bar; unsigned x; volatile LAS unsigned* st; };
__device__ __forceinline__ XcdBarrier xcd_barrier_post(unsigned* bar, volatile LAS unsigned* st) {
    XcdBarrier b; b.bar = bar; b.x = xb_xcc_id(); b.st = st;
    if (threadIdx.x == 0) (void)xb_add(&bar[XB_XCNT(b.x)], 1u);
    return b;
}
__device__ __forceinline__ void xcd_barrier_complete(unsigned* bar, unsigned x, unsigned& nloc, unsigned& nx) {
    const unsigned G = gridDim.x * gridDim.y * gridDim.z;
    unsigned sum, cnt, mine, sp = 0u;
    for (;;) {
        sum = 0u; cnt = 0u; mine = 0u;
#pragma unroll
        for (unsigned j = 0; j < 16; ++j) { const unsigned c = xb_ld(&bar[XB_XCNT(j)]); sum += c; cnt += (c > 0u) ? 1u : 0u; mine = (j == x) ? c : mine; }
        if (sum == G) break;
        __builtin_amdgcn_s_sleep(1);
        if ((++sp & 255u) == 0u) { if (xb_ld(&bar[XB_TMO])) break; if (sp > XB_SPIN_CAP) { atomicAdd(&bar[XB_TMO], 1u); break; } }
    }
    nloc = mine > 0u ? mine : 1u; nx = cnt > 0u ? cnt : 1u;
}
__device__ __forceinline__ void xcd_barrier(const XcdBarrier& b) {
    asm volatile("s_waitcnt vmcnt(0)" ::: "memory");
    __syncthreads();
    if (threadIdx.x == 0) {
        unsigned* bar = b.bar;
        __builtin_amdgcn_s_waitcnt(0);
        unsigned nloc = b.st[0], nx = b.st[1];
        if (nloc == 0u) { xcd_barrier_complete(bar, b.x, nloc, nx); b.st[0] = nloc; b.st[1] = nx; }
        const unsigned old = xb_add(&bar[XB_XSUB(b.x)], 1u);
        const unsigned gen = old / nloc;
        if (old + 1u == (gen + 1u) * nloc) {
            __builtin_amdgcn_fence(__ATOMIC_RELEASE, "agent");
            asm volatile("s_waitcnt vmcnt(0)" ::: "memory");
            const unsigned og = xb_add(&bar[XB_TOP], 1u);
            const unsigned tg = og / nx;
            if (og + 1u == (tg + 1u) * nx) xb_add(&bar[XB_TOPGEN], 1u);
            else XB_SPIN(xb_ld(&bar[XB_TOPGEN]) == tg, bar);
            __builtin_amdgcn_fence(__ATOMIC_ACQUIRE, "agent");
            xb_add(&bar[XB_XGEN(b.x)], 1u);
            asm volatile("s_waitcnt vmcnt(0)" ::: "memory");
        } else {
            XB_SPIN(xb_ld(&bar[XB_XGEN(b.x)]) == gen, bar);
            __builtin_amdgcn_fence(__ATOMIC_ACQUIRE, "agent");
            asm volatile("s_waitcnt vmcnt(0)" ::: "memory");
        }
    }
    __syncthreads();
}

namespace pg8 {
constexpr int BM = 256, BK = 64, HALF = 128, HTB = HALF * BK * 2, STAGE_BYTES = 8 * HTB, NXCD = 8, WGM = 8;
__device__ __forceinline__ int lds_byte(int r, int c) { const int st = (r >> 4) * 2 + (c >> 5), rr = r & 15, cc = c & 31, ob = rr * 64 + cc * 2; return st * 1024 + (ob ^ (((ob >> 9) & 1) << 5)); }
__device__ __forceinline__ void stage_rc(int b, int& R, int& C) { const int st = b / 1024, sb = b % 1024, swz = sb ^ (((sb >> 9) & 1) << 5); R = (st >> 1) * 16 + swz / 64; C = (st & 1) * 32 + (swz % 64) / 2; }
__device__ __forceinline__ int perm32(int rho) { const int n = rho >> 4, i = rho & 15; return 8 * (i >> 2) + 4 * n + (i & 3); }

struct Unit { int pm, pn, e, rb; };

struct StaticSched {
    const bf16* A; const bf16* Bt; int K; int nM, nN, nwg, G, c;
    __device__ __forceinline__ void init(const bf16* A_, const bf16* Bt_, int M, int N, int K_, int G_, int c_) { A = A_; Bt = Bt_; K = K_; nM = M / BM; nN = N / BM; nwg = nM * nN; G = G_; c = c_; }
    __device__ __forceinline__ bool next(int i, Unit& u) const {
        const long L = (long)i * G + c; if (L >= nwg) return false;
        int wgid = (int)L; { const int q = nwg / NXCD, r = nwg % NXCD, xcd = wgid % NXCD, off = wgid / NXCD; wgid = (xcd < r ? xcd * (q + 1) : r * (q + 1) + (xcd - r) * q) + off; }
        const int nig = WGM * nN, gid = wgid / nig, fm = gid * WGM, gsz = (nM - fm) < WGM ? (nM - fm) : WGM;
        u.pm = fm + ((wgid % nig) % gsz); u.pn = (wgid % nig) / gsz; u.e = 0; u.rb = 0; return true;
    }
    __device__ __forceinline__ const char* a_base(const Unit& u) const { return (const char*)A + (size_t)u.pm * BM * K * 2; }
    __device__ __forceinline__ const char* b_base(const Unit& u) const { return (const char*)Bt + (size_t)u.pn * BM * K * 2; }
    __device__ __forceinline__ void a_voff(const Unit&, const int (&R)[2], const int (&C)[2], unsigned (&v)[2][2]) const {
#pragma unroll
        for (int h = 0; h < 2; ++h)
#pragma unroll
            for (int i = 0; i < 2; ++i) v[h][i] = (unsigned)((h * HALF + R[i]) * K + C[i]) * 2u;
    }
};

template <class Epi, class Sched, bool ALIGN_EPI = true>
__device__ __forceinline__ void gemm_phase(LAS unsigned char* lds, const int K, const Sched& S, const Epi& E) {
    const int tid = threadIdx.x, wid = __builtin_amdgcn_readfirstlane(tid >> 6), lane = tid & 63, wr = wid >> 2, wc = wid & 3, fr = lane & 15, fq = lane >> 4;
    const int nt = K / BK;
    int Rr[2], Cc[2]; unsigned voffB[2];
#pragma unroll
    for (int i = 0; i < 2; ++i) { stage_rc(tid * 16 + i * 8192, Rr[i], Cc[i]); const int Rb = Epi::PERM ? ((Rr[i] & ~31) + perm32(Rr[i] & 31)) : Rr[i];
        voffB[i] = (unsigned)(Rb * K + Cc[i]) * 2u; }
    const size_t kstep = (size_t)(BK * 2);
    const size_t hstep = (size_t)HALF * K * 2;
    const unsigned ldsw = (unsigned)wid * 1024u;
    const int aoff = lds_byte(wr * 64 + fr, fq * 8), boff = lds_byte(wc * 32 + fr, fq * 8);
#define PG8_SA(b, h) (((b) * 2 + (h)) * HTB)
#define PG8_SB(b, h) ((4 + (b) * 2 + (h)) * HTB)
#define PG8_STAGE(bufoff, gbase, voff) do { _Pragma("unroll") for (int _i = 0; _i < 2; ++_i) \
        __builtin_amdgcn_global_load_lds((const unsigned*)((const char*)(gbase) + (voff)[_i]), (LAS unsigned*)(lds + (bufoff) + ldsw + _i * 8192), 16, 0, 0); } while (0)
#define PG8_LDA(dst, b, h) do { _Pragma("unroll") for (int m = 0; m < 4; ++m) _Pragma("unroll") for (int k = 0; k < 2; ++k) dst[m][k] = *(const LAS bf16x8*)(lds + PG8_SA(b, h) + aoff + m * 2048 + k * 1024); } while (0)
#define PG8_LDB(dst, b, h) do { _Pragma("unroll") for (int n = 0; n < 2; ++n) _Pragma("unroll") for (int k = 0; k < 2; ++k) dst[n][k] = *(const LAS bf16x8*)(lds + PG8_SB(b, h) + boff + n * 2048 + k * 1024); } while (0)
#define PG8_MMA(ai, bj, At, Bt) do { __builtin_amdgcn_s_setprio(1); _Pragma("unroll") for (int m = 0; m < 4; ++m) _Pragma("unroll") for (int n = 0; n < 2; ++n) _Pragma("unroll") for (int k = 0; k < 2; ++k) \
        acc[ai][bj][m][n] = __builtin_amdgcn_mfma_f32_16x16x32_bf16(Bt[n][k], At[m][k], acc[ai][bj][m][n], 0, 0, 0); __builtin_amdgcn_s_setprio(0); } while (0)
#define PG8_WAIT_V(n) asm volatile("s_waitcnt vmcnt(" #n ")" ::: "memory")
#define PG8_WAIT_L(n) asm volatile("s_waitcnt lgkmcnt(" #n ")" ::: "memory")
#define PG8_BAR __builtin_amdgcn_s_barrier()
#define PG8_SCHED __builtin_amdgcn_sched_barrier(0)
    Unit cur, nxt; int ui = 0;
    if (!S.next(0, cur)) return;
    f32x4 acc[2][2][4][2];
#pragma unroll
    for (int a = 0; a < 2; ++a)
#pragma unroll
        for (int b = 0; b < 2; ++b)
#pragma unroll
            for (int m = 0; m < 4; ++m)
#pragma unroll
                for (int n = 0; n < 2; ++n) acc[a][b][m][n] = (f32x4){0.f, 0.f, 0.f, 0.f};
    bf16x8 At[4][2], B0[2][2], B1[2][2];
    const char* cA = S.a_base(cur); const char* cB = S.b_base(cur);
    unsigned vA[2][2], nvA[2][2];
    S.a_voff(cur, Rr, Cc, vA);
    PG8_STAGE(PG8_SB(0, 0), cB, voffB); PG8_STAGE(PG8_SB(0, 1), cB + hstep, voffB); PG8_STAGE(PG8_SA(0, 0), cA, vA[0]); PG8_STAGE(PG8_SA(0, 1), cA, vA[1]);
    if (wr == 1) PG8_BAR;
    PG8_WAIT_V(2); PG8_BAR;
    PG8_STAGE(PG8_SB(1, 0), cB + kstep, voffB); PG8_STAGE(PG8_SA(1, 0), cA + kstep, vA[0]); PG8_STAGE(PG8_SB(1, 1), cB + hstep + kstep, voffB);
    PG8_WAIT_V(6); PG8_BAR;
    for (;;) {
        const bool has_next = S.next(ui + 1, nxt);
        const char* nA = has_next ? S.a_base(nxt) : cA; const char* nB = has_next ? S.b_base(nxt) : cB;
        if (has_next) S.a_voff(nxt, Rr, Cc, nvA);
        else { nvA[0][0] = vA[0][0]; nvA[0][1] = vA[0][1]; nvA[1][0] = vA[1][0]; nvA[1][1] = vA[1][1]; }
        for (int t = 0; t < nt; t += 2) {
            const bool last = (t == nt - 2);
            const char* a1 = cA + (size_t)(t + 1) * kstep;
            const char* a2 = last ? nA : cA + (size_t)(t + 2) * kstep; const char* b2 = last ? nB : cB + (size_t)(t + 2) * kstep;
            const char* a3 = a2 + kstep; const char* b3 = b2 + kstep;
            unsigned wA[2][2];
            wA[0][0] = last ? nvA[0][0] : vA[0][0]; wA[0][1] = last ? nvA[0][1] : vA[0][1]; wA[1][0] = last ? nvA[1][0] : vA[1][0]; wA[1][1] = last ? nvA[1][1] : vA[1][1];
            PG8_LDB(B0, 0, 0); PG8_LDB(B1, 0, 1); PG8_SCHED; PG8_LDA(At, 0, 0); PG8_STAGE(PG8_SA(1, 1), a1, vA[1]);
            PG8_WAIT_V(8); PG8_WAIT_L(0); PG8_BAR; PG8_MMA(0, 0, At, B0); PG8_MMA(0, 1, At, B1); PG8_BAR; PG8_SCHED;
            PG8_LDA(At, 0, 1); PG8_STAGE(PG8_SB(0, 0), b2, voffB); PG8_STAGE(PG8_SB(0, 1), b2 + hstep, voffB); PG8_STAGE(PG8_SA(0, 0), a2, wA[0]);
            PG8_WAIT_V(8); PG8_WAIT_L(0); PG8_BAR; PG8_MMA(1, 0, At, B0); PG8_MMA(1, 1, At, B1); PG8_BAR; PG8_SCHED;
            PG8_LDB(B0, 1, 0); PG8_LDB(B1, 1, 1); PG8_SCHED; PG8_LDA(At, 1, 0); PG8_STAGE(PG8_SA(0, 1), a2, wA[1]);
            PG8_WAIT_V(8); PG8_WAIT_L(0); PG8_BAR; PG8_MMA(0, 0, At, B0); PG8_MMA(0, 1, At, B1); PG8_BAR; PG8_SCHED;
            PG8_LDA(At, 1, 1); PG8_STAGE(PG8_SB(1, 0), b3, voffB); PG8_STAGE(PG8_SB(1, 1), b3 + hstep, voffB); PG8_STAGE(PG8_SA(1, 0), a3, wA[0]);
            PG8_WAIT_V(8); PG8_WAIT_L(0); PG8_BAR; PG8_MMA(1, 0, At, B0); PG8_MMA(1, 1, At, B1); PG8_BAR; PG8_SCHED;
        }
        if constexpr (ALIGN_EPI) { if (wr == 0) PG8_BAR; }
        E(acc, cur, wr, wc, fr, fq);
        if (!has_next) break;
#pragma unroll
        for (int a = 0; a < 2; ++a)
#pragma unroll
            for (int b = 0; b < 2; ++b)
#pragma unroll
                for (int m = 0; m < 4; ++m)
#pragma unroll
                    for (int n = 0; n < 2; ++n) acc[a][b][m][n] = (f32x4){0.f, 0.f, 0.f, 0.f};
        cur = nxt; cA = nA; cB = nB; ++ui;
        vA[0][0] = nvA[0][0]; vA[0][1] = nvA[0][1]; vA[1][0] = nvA[1][0]; vA[1][1] = nvA[1][1];
        if constexpr (ALIGN_EPI) { if (wr == 1) PG8_BAR; }
    }
    PG8_WAIT_V(0);
    if constexpr (!ALIGN_EPI) { if (wr == 0) PG8_BAR; }
    PG8_BAR;
#undef PG8_SA
#undef PG8_SB
#undef PG8_STAGE
#undef PG8_LDA
#undef PG8_LDB
#undef PG8_MMA
#undef PG8_WAIT_V
#undef PG8_WAIT_L
#undef PG8_BAR
#undef PG8_SCHED
}

struct EpiProj {
    static constexpr bool PERM = true;
    bf16* O;
    __device__ __forceinline__ void operator()(const f32x4 (&acc)[2][2][4][2], const Unit& u, int wr, int wc, int fr, int fq) const {
        const int row0 = u.pm * BM + wr * 64 + fr, col0 = u.pn * BM + wc * 32 + 8 * fq;
        const bool act = u.pn < 4;
#pragma unroll
        for (int ai = 0; ai < 2; ++ai)
#pragma unroll
            for (int m = 0; m < 4; ++m) { bf16* rowp = O + (size_t)(row0 + ai * HALF + m * 16) * DIN + col0;
#pragma unroll
                for (int bj = 0; bj < 2; ++bj) { f32x4 v0 = acc[ai][bj][m][0], v1 = acc[ai][bj][m][1];
                    if (act) {
#pragma unroll
                        for (int j = 0; j < 4; ++j) { v0[j] = gelu_tanh(v0[j]); v1[j] = gelu_tanh(v1[j]); } }
                    u32x4 w; w.x = cvt_pk_bf16(v0[0], v0[1]); w.y = cvt_pk_bf16(v0[2], v0[3]); w.z = cvt_pk_bf16(v1[0], v1[1]); w.w = cvt_pk_bf16(v1[2], v1[3]);
                    *(u32x4*)(rowp + bj * HALF) = w; } }
    }
};
struct EpiResid {
    static constexpr bool PERM = false;
    const float* res; float* out;
    __device__ __forceinline__ void operator()(const f32x4 (&acc)[2][2][4][2], const Unit& u, int wr, int wc, int fr, int fq) const {
        const int row0 = u.pm * BM + wr * 64 + fr, col0 = u.pn * BM + wc * 32 + 4 * fq;
#pragma unroll
        for (int ai = 0; ai < 2; ++ai)
#pragma unroll
            for (int m = 0; m < 4; ++m) { const size_t off = (size_t)(row0 + ai * HALF + m * 16) * DM + col0;
#pragma unroll
                for (int bj = 0; bj < 2; ++bj)
#pragma unroll
                    for (int n = 0; n < 2; ++n) { const f32x4 r = *(const f32x4*)(res + off + bj * HALF + n * 16); *(f32x4*)(out + off + bj * HALF + n * 16) = acc[ai][bj][m][n] + r; } }
    }
};
struct EpiSwiGLU {
    static constexpr bool PERM = true;
    bf16* HB;
    __device__ __forceinline__ void operator()(const f32x4 (&acc)[2][2][4][2], const Unit& u, int wr, int wc, int fr, int fq) const {
        const int row0 = u.pm * BM + wr * 64 + fr, col0 = u.pn * HALF + wc * 32 + 8 * fq;
#pragma unroll
        for (int ai = 0; ai < 2; ++ai)
#pragma unroll
            for (int m = 0; m < 4; ++m) { bf16* rowp = HB + (size_t)(row0 + ai * HALF + m * 16) * DE + col0;
                float h[8];
#pragma unroll
                for (int n = 0; n < 2; ++n)
#pragma unroll
                    for (int j = 0; j < 4; ++j) { const float g = acc[ai][0][m][n][j], up = acc[ai][1][m][n][j]; h[n * 4 + j] = g * sigmoidf_(g) * up; }
                u32x4 w; w.x = cvt_pk_bf16(h[0], h[1]); w.y = cvt_pk_bf16(h[2], h[3]); w.z = cvt_pk_bf16(h[4], h[5]); w.w = cvt_pk_bf16(h[6], h[7]);
                *(u32x4*)rowp = w; }
    }
};
struct EpiY {
    static constexpr bool PERM = true;
    bf16* Y;
    __device__ __forceinline__ void operator()(const f32x4 (&acc)[2][2][4][2], const Unit& u, int wr, int wc, int fr, int fq) const {
        const int row0 = u.pm * BM + wr * 64 + fr, col0 = u.pn * BM + wc * 32 + 8 * fq;
#pragma unroll
        for (int ai = 0; ai < 2; ++ai)
#pragma unroll
            for (int m = 0; m < 4; ++m) { bf16* rowp = Y + (size_t)(row0 + ai * HALF + m * 16) * DM + col0;
#pragma unroll
                for (int bj = 0; bj < 2; ++bj) { const f32x4 v0 = acc[ai][bj][m][0], v1 = acc[ai][bj][m][1];
                    u32x4 w; w.x = cvt_pk_bf16(v0[0], v0[1]); w.y = cvt_pk_bf16(v0[2], v0[3]); w.z = cvt_pk_bf16(v1[0], v1[1]); w.w = cvt_pk_bf16(v1[2], v1[3]);
                    *(u32x4*)(rowp + bj * HALF) = w; } }
    }
};

struct SchedG1 {
    const LAS int* tstart; const int* cnt; const int* tok; const bf16* X; const bf16* W1; int G, c;
    __device__ __forceinline__ bool next(int i, Unit& u) const {
        const int L = i * G + c, NT = tstart[NE]; if (L >= NT * 4) return false;
        const int T = L >> 2; int e = 0;
        for (int j = 1; j < NE; ++j) e = (tstart[j] <= T) ? j : e;
        u.pm = T; u.pn = L & 3; u.e = e; u.rb = T - tstart[e]; return true;
    }
    __device__ __forceinline__ const char* a_base(const Unit&) const { return (const char*)X; }
    __device__ __forceinline__ const char* b_base(const Unit& u) const { return (const char*)(W1 + ((size_t)u.e * 1024 + (size_t)u.pn * BM) * DM); }
    __device__ __forceinline__ void a_voff(const Unit& u, const int (&R)[2], const int (&C)[2], unsigned (&v)[2][2]) const {
        const int n = cnt[u.e]; const int* tl = tok + (size_t)u.e * TOKCAP;
#pragma unroll
        for (int h = 0; h < 2; ++h)
#pragma unroll
            for (int i = 0; i < 2; ++i) { int row = u.rb * BM + h * HALF + R[i]; row = row < n ? row : 0; const int t = tl[row]; v[h][i] = (unsigned)(t * DM + C[i]) * 2u; }
    }
};
struct SchedG2 {
    const LAS int* tstart; const bf16* HB; const bf16* W2; int G, c;
    __device__ __forceinline__ bool next(int i, Unit& u) const {
        const int L = i * G + c, NT = tstart[NE]; if (L >= NT * 8) return false;
        const int T = L >> 3; int e = 0;
        for (int j = 1; j < NE; ++j) e = (tstart[j] <= T) ? j : e;
        u.pm = T; u.pn = L & 7; u.e = e; u.rb = T - tstart[e]; return true;
    }
    __device__ __forceinline__ const char* a_base(const Unit& u) const { return (const char*)(HB + (size_t)u.pm * BM * DE); }
    __device__ __forceinline__ const char* b_base(const Unit& u) const { return (const char*)(W2 + ((size_t)u.e * DM + (size_t)u.pn * BM) * DE); }
    __device__ __forceinline__ void a_voff(const Unit&, const int (&R)[2], const int (&C)[2], unsigned (&v)[2][2]) const {
#pragma unroll
        for (int h = 0; h < 2; ++h)
#pragma unroll
            for (int i = 0; i < 2; ++i) v[h][i] = (unsigned)((h * HALF + R[i]) * DE + C[i]) * 2u;
    }
};
}

struct Params { const float* in[22]; float* out; unsigned char* ws; int ph_lo, ph_hi; };
enum { IN_X = 0, IN_NORM1, IN_WIN, IN_SGUN, IN_SGUW, IN_SGUB, IN_CONVW, IN_CONVB, IN_LNG, IN_LNB, IN_QN, IN_KN, IN_OUTN, IN_WOUT, IN_NORM2, IN_WRG, IN_BRG, IN_WRE, IN_BRE, IN_WG, IN_WU, IN_WD };

struct Frame {
    LAS unsigned char* lds; volatile LAS unsigned* MISC;
    int tid, lane, wave, vcu, G;
    const float* const* in; float* out; unsigned char* ws;
};

__device__ __forceinline__ void tr_tile(const float* W, int ldw, int k0, int n0, bf16* WT, int K, int nrow0, LAS float* scr, int lane) {
#pragma unroll 4
    for (int i = 0; i < 16; ++i) { const int kk = 4 * i + (lane >> 4);
        const f32x4 v = *(const f32x4*)(W + (size_t)(k0 + kk) * ldw + n0 + 4 * (lane & 15));
        LAS float* d = scr + kk * 65 + 4 * (lane & 15); d[0] = v[0]; d[1] = v[1]; d[2] = v[2]; d[3] = v[3]; }
    LDS_WAIT();
    const int c = lane & 7;
#pragma unroll
    for (int j = 0; j < 8; ++j) { const int n = (lane >> 3) + 8 * j; const LAS float* s = scr + (8 * c) * 65 + n;
        u32x4 o; o.x = cvt_pk_bf16(s[0], s[65]); o.y = cvt_pk_bf16(s[2 * 65], s[3 * 65]); o.z = cvt_pk_bf16(s[4 * 65], s[5 * 65]); o.w = cvt_pk_bf16(s[6 * 65], s[7 * 65]);
        *(u32x4*)(WT + (size_t)(nrow0 + n) * K + k0 + 8 * c) = o; }
    LDS_WAIT();
}
__device__ __forceinline__ void norm_row_bf16(const float* xrow, const float* g, bf16* orow, int lane) {
    f32x4 v[8]; float s = 0.f;
#pragma unroll
    for (int j = 0; j < 8; ++j) { v[j] = *(const f32x4*)(xrow + 4 * lane + 256 * j); s += (v[j][0] * v[j][0] + v[j][1] * v[j][1]) + (v[j][2] * v[j][2] + v[j][3] * v[j][3]); }
    const float rs = __builtin_amdgcn_rsqf(wave_sum(s) * (1.f / DM) + EPS);
#pragma unroll
    for (int j = 0; j < 8; ++j) { const f32x4 gg = *(const f32x4*)(g + 4 * lane + 256 * j);
        u32x2 o; o.x = cvt_pk_bf16(v[j][0] * rs * gg[0], v[j][1] * rs * gg[1]); o.y = cvt_pk_bf16(v[j][2] * rs * gg[2], v[j][3] * rs * gg[3]);
        *(u32x2*)(orow + 4 * lane + 256 * j) = o; }
}
__device__ __forceinline__ void p_prologue(Frame& F) {
    LAS float* scr = (LAS float*)(F.lds + F.wave * 16640);
    const int gw = F.vcu * NWAVES + F.wave, NGW = F.G * NWAVES;
    bf16* WIN = (bf16*)(F.ws + WS_WIN); bf16* WOUT = (bf16*)(F.ws + WS_WOUT); bf16* W1 = (bf16*)(F.ws + WS_W1); bf16* W2 = (bf16*)(F.ws + WS_W2);
    constexpr int T_IN = 32 * 80, T_OUT = 32 * 32, T_E = 32 * 8, T_D = 8 * 32;
    constexpr int T_LAYER = T_IN + T_OUT + NE * (2 * T_E + T_D);
    for (int it = gw; it < NLAYER * T_LAYER; it += NGW) {
        const int l = it / T_LAYER; int r = it % T_LAYER;
        if (r < T_IN) { const int kb = r / 80, nb = r % 80; tr_tile(F.in[IN_WIN] + (size_t)l * DM * DIN, DIN, 64 * kb, 64 * nb, WIN + (size_t)l * DIN * DM, DM, 64 * nb, scr, F.lane); continue; } r -= T_IN;
        if (r < T_OUT) { const int kb = r / 32, nb = r % 32; tr_tile(F.in[IN_WOUT] + (size_t)l * DM * DM, DM, 64 * kb, 64 * nb, WOUT + (size_t)l * DM * DM, DM, 64 * nb, scr, F.lane); continue; } r -= T_OUT;
        const int e = r / (2 * T_E + T_D); r %= (2 * T_E + T_D);
        const size_t le = (size_t)l * NE + e;
        if (r < 2 * T_E) { const int up = r >= T_E; r -= up * T_E; const int kb = r / 8, nb = r % 8, n0 = 64 * nb;
            tr_tile((up ? F.in[IN_WU] : F.in[IN_WG]) + le * DM * DE, DE, 64 * kb, n0, W1 + le * 1024 * DM, DM, (n0 / 128) * 256 + up * 128 + (n0 % 128), scr, F.lane); continue; }
        r -= 2 * T_E;
        { const int kb = r / 32, nb = r % 32; tr_tile(F.in[IN_WD] + le * DE * DM, DM, 64 * kb, 64 * nb, W2 + le * DM * DE, DE, 64 * nb, scr, F.lane); }
    }
    { bf16* SW = (bf16*)(F.ws + WS_SGUW); const int gt = (F.vcu * NWAVES + F.wave) * 64 + F.lane, NGT = NGW * 64;
      for (int idx = gt; idx < NLAYER * 4 * 8 * 4 * 64; idx += NGT) {
          const int ln = idx & 63, pp = (idx >> 6) & 3, itile = (idx >> 8) & 7, h = (idx >> 11) & 3, l = idx >> 13;
          const int i = 16 * itile + (ln & 15), gq = ln >> 4;
          const float* w = F.in[IN_SGUW] + ((size_t)(l * 4 + h) * 128 + i) * 128;
          float v[8];
#pragma unroll
          for (int jj = 0; jj < 8; ++jj) { const int j = 32 * pp + (jj < 4 ? 4 * gq + jj : 16 + 4 * gq + (jj - 4)); v[jj] = (j <= i) ? w[j] : 0.f; }
          u32x4 o; o.x = cvt_pk_bf16(v[0], v[1]); o.y = cvt_pk_bf16(v[2], v[3]); o.z = cvt_pk_bf16(v[4], v[5]); o.w = cvt_pk_bf16(v[6], v[7]);
          *(u32x4*)(SW + (size_t)idx * 8) = o; }
      float* WRT = (float*)(F.ws + WS_WRT);
      for (int idx = gt; idx < NLAYER * 36 * DM; idx += NGT) { const int k = idx % DM, o = (idx / DM) % 36, l = idx / (36 * DM);
          WRT[idx] = (o < 32 ? F.in[IN_WRE][((size_t)l * DM + k) * NE + o] : F.in[IN_WRG][((size_t)l * DM + k) * 4 + (o - 32)]) * F.in[IN_NORM2][(size_t)l * DM + k]; } }
    bf16* HN = (bf16*)(F.ws + WS_HN);
    for (int m = gw; m < SEQ; m += NGW) norm_row_bf16(F.in[IN_X] + (size_t)m * DM, F.in[IN_NORM1], HN + (size_t)m * DM, F.lane);
}

__device__ __forceinline__ int vimg_off(int row, int c) { return row * 256 + ((((c >> 1) ^ (row & 7)) << 1) | (c & 1)) * 16; }
__device__ __forceinline__ bf16x8 tr_frag(const LAS unsigned char* img, int ra, int rb, int dt, int lane) {
    const int gq = lane >> 4, q = (lane & 15) >> 2, p = lane & 3;
    const int r0 = ra + 4 * gq + q, r1 = rb + 4 * gq + q, c = 2 * dt + (p >> 1);
    const s16x4 a = __builtin_amdgcn_ds_read_tr16_b64_v4i16((LAS s16x4*)(img + vimg_off(r0, c) + 8 * (p & 1)));
    const s16x4 b = __builtin_amdgcn_ds_read_tr16_b64_v4i16((LAS s16x4*)(img + vimg_off(r1, c) + 8 * (p & 1)));
    bf16x8 r; r[0] = a[0]; r[1] = a[1]; r[2] = a[2]; r[3] = a[3]; r[4] = b[0]; r[5] = b[1]; r[6] = b[2]; r[7] = b[3]; return r;
}
__device__ __forceinline__ void sgu_item(Frame& F, int l, int chunk) {
    const bf16* PROJ = (const bf16*)(F.ws + WS_PROJ); bf16* MIX = (bf16*)(F.ws + WS_MIX);
    const int p0 = chunk * 128, lane = F.lane, w = F.wave;
    LAS float* red = (LAS float*)(F.lds + MISC_OFF + 256);
    const float* gn = F.in[IN_SGUN] + l * 512;
    f32x4 g0 = *(const f32x4*)(gn + 8 * lane), g1 = *(const f32x4*)(gn + 8 * lane + 4);
#pragma unroll 4
    for (int j = 0; j < 16; ++j) { const int row = w + 8 * j;
        const u32x4 raw = *(const u32x4*)(PROJ + (size_t)(p0 + row) * DIN + OFF_V + 8 * lane);
        float x[8] = {bf_lo(raw.x), bf_hi(raw.x), bf_lo(raw.y), bf_hi(raw.y), bf_lo(raw.z), bf_hi(raw.z), bf_lo(raw.w), bf_hi(raw.w)};
        float s = 0.f;
#pragma unroll
        for (int e = 0; e < 8; ++e) s += x[e] * x[e];
        const float rs = __builtin_amdgcn_rsqf(wave_sum(s) * (1.f / 512.f) + EPS);
        u32x4 o; o.x = cvt_pk_bf16(x[0] * rs * g0[0], x[1] * rs * g0[1]); o.y = cvt_pk_bf16(x[2] * rs * g0[2], x[3] * rs * g0[3]);
        o.z = cvt_pk_bf16(x[4] * rs * g1[0], x[5] * rs * g1[1]); o.w = cvt_pk_bf16(x[6] * rs * g1[2], x[7] * rs * g1[3]);
        const int h = lane >> 4, cc = lane & 15;
        *(LAS u32x4*)(F.lds + h * 32768 + vimg_off(row, cc)) = o; }
    __syncthreads();
    const int h = w >> 1, ih = w & 1, gq = lane >> 4, fr = lane & 15;
    const LAS unsigned char* img = F.lds + h * 32768;
    const bf16* SW = (const bf16*)(F.ws + WS_SGUW) + (size_t)(l * 4 + h) * 8 * 4 * 64 * 8;
    const float* bs = F.in[IN_SGUB] + (size_t)(l * 4 + h) * 128;
    const float* og = F.in[IN_OUTN] + (size_t)l * DM + h * 128 + 4 * gq;
#pragma unroll 1
    for (int half = 0; half < 2; ++half) {
        f32x4 z[2][8];
#pragma unroll
        for (int ii = 0; ii < 2; ++ii)
#pragma unroll
            for (int dt = 0; dt < 8; ++dt) z[ii][dt] = (f32x4){0.f, 0.f, 0.f, 0.f};
        const int it0 = ih + 4 * half;
#pragma unroll 1
        for (int pp = 0; pp <= (it0 + 2) / 2; ++pp) {
            const bf16x8 bw0 = *(const bf16x8*)(SW + ((size_t)(it0 * 4 + pp) * 64 + lane) * 8);
            const bf16x8 bw1 = *(const bf16x8*)(SW + ((size_t)((it0 + 2) * 4 + pp) * 64 + lane) * 8);
            const bool do0 = pp <= it0 / 2;
#pragma unroll
            for (int dt = 0; dt < 8; ++dt) { const bf16x8 a = tr_frag(img, 32 * pp, 32 * pp + 16, dt, lane);
                if (do0) z[0][dt] = __builtin_amdgcn_mfma_f32_16x16x32_bf16(a, bw0, z[0][dt], 0, 0, 0);
                z[1][dt] = __builtin_amdgcn_mfma_f32_16x16x32_bf16(a, bw1, z[1][dt], 0, 0, 0); }
        }
#pragma unroll
        for (int ii = 0; ii < 2; ++ii) { const int i = 16 * (it0 + 2 * ii) + fr; const float bi = bs[i]; float s = 0.f;
            const bf16* urow = PROJ + (size_t)(p0 + i) * DIN + OFF_U + h * 128 + 4 * gq;
#pragma unroll
            for (int dt = 0; dt < 8; ++dt) { const u32x2 ur = *(const u32x2*)(urow + 16 * dt);
                f32x4 y; y[0] = bf_lo(ur.x) * (z[ii][dt][0] + bi); y[1] = bf_hi(ur.x) * (z[ii][dt][1] + bi); y[2] = bf_lo(ur.y) * (z[ii][dt][2] + bi); y[3] = bf_hi(ur.y) * (z[ii][dt][3] + bi);
                z[ii][dt] = y; s += (y[0] * y[0] + y[1] * y[1]) + (y[2] * y[2] + y[3] * y[3]); }
            s += __shfl_xor(s, 16); s += __shfl_xor(s, 32);
            if (gq == 0) red[i * 4 + h] = s; }
        __syncthreads();
#pragma unroll
        for (int ii = 0; ii < 2; ++ii) { const int i = 16 * (it0 + 2 * ii) + fr;
            const f32x4 rr = *(const LAS f32x4*)(red + i * 4);
            const float rs = __builtin_amdgcn_rsqf(((rr[0] + rr[1]) + (rr[2] + rr[3])) * (1.f / 512.f) + EPS);
            bf16* orow = MIX + (size_t)(p0 + i) * DM + h * 128 + 4 * gq;
#pragma unroll
            for (int dt = 0; dt < 8; ++dt) { const f32x4 gg = *(const f32x4*)(og + 16 * dt); const f32x4 y = z[ii][dt];
                u32x2 o; o.x = cvt_pk_bf16(y[0] * rs * gg[0], y[1] * rs * gg[1]); o.y = cvt_pk_bf16(y[2] * rs * gg[2], y[3] * rs * gg[3]);
                *(u32x2*)(orow + 16 * dt) = o; } }
    }
    __syncthreads();
}

__device__ __forceinline__ void conv_item(Frame& F, int l, int tile) {
    const bf16* PROJ = (const bf16*)(F.ws + WS_PROJ); bf16* MIX = (bf16*)(F.ws + WS_MIX);
    constexpr int TP = 64;
    const int p0 = tile * TP, c = F.tid;
    LAS float* cbuf = (LAS float*)F.lds;
    float wk[CONV_K];
#pragma unroll
    for (int k = 0; k < CONV_K; ++k) wk[k] = F.in[IN_CONVW][((size_t)l * CONV_K + k) * 512 + c];
    const float cb = F.in[IN_CONVB][l * 512 + c];
    float win[30];
#pragma unroll
    for (int k = 0; k < 30; ++k) { const int p = p0 - 30 + k; float zv = 0.f;
        if (p >= 0) { const float a = __builtin_bit_cast(float, (unsigned)PROJ[(size_t)p * DIN + OFF_A + c] << 16), g = __builtin_bit_cast(float, (unsigned)PROJ[(size_t)p * DIN + OFF_G + c] << 16); zv = a * sigmoidf_(g); }
        win[k] = zv; }
#define CONV_STEP(q, pos) do { const int p = p0 + (pos); \
        const float a = __builtin_bit_cast(float, (unsigned)PROJ[(size_t)p * DIN + OFF_A + c] << 16), g = __builtin_bit_cast(float, (unsigned)PROJ[(size_t)p * DIN + OFF_G + c] << 16); \
        const float zv = a * sigmoidf_(g); float acc = cb + wk[30] * zv; \
        _Pragma("unroll") for (int k = 0; k < 30; ++k) acc += wk[k] * win[(k + (q)) % 30]; \
        win[(q) % 30] = zv; cbuf[(pos) * 512 + c] = acc; } while (0)
    for (int blk = 0; blk < 2; ++blk) {
#pragma unroll
        for (int q = 0; q < 30; ++q) CONV_STEP(q, blk * 30 + q);
    }
#pragma unroll
    for (int q = 0; q < 4; ++q) CONV_STEP(q, 60 + q);
#undef CONV_STEP
    __syncthreads();
    const float* lg = F.in[IN_LNG] + l * 512 + 8 * F.lane; const float* lb = F.in[IN_LNB] + l * 512 + 8 * F.lane; const float* og = F.in[IN_OUTN] + (size_t)l * DM + 512 + 8 * F.lane;
    const f32x4 lg0 = *(const f32x4*)lg, lg1 = *(const f32x4*)(lg + 4), lb0 = *(const f32x4*)lb, lb1 = *(const f32x4*)(lb + 4), og0 = *(const f32x4*)og, og1 = *(const f32x4*)(og + 4);
    for (int r = F.wave; r < TP; r += NWAVES) {
        const f32x4 a0 = *(const LAS f32x4*)(cbuf + r * 512 + 8 * F.lane), a1 = *(const LAS f32x4*)(cbuf + r * 512 + 8 * F.lane + 4);
        float x[8] = {a0[0], a0[1], a0[2], a0[3], a1[0], a1[1], a1[2], a1[3]};
        float s = 0.f;
#pragma unroll
        for (int e = 0; e < 8; ++e) s += x[e];
        const float mu = wave_sum(s) * (1.f / 512.f); float q2 = 0.f;
#pragma unroll
        for (int e = 0; e < 8; ++e) { x[e] -= mu; q2 += x[e] * x[e]; }
        const float rstd = __builtin_amdgcn_rsqf(wave_sum(q2) * (1.f / 512.f) + EPS);
        const float gam[8] = {lg0[0], lg0[1], lg0[2], lg0[3], lg1[0], lg1[1], lg1[2], lg1[3]}, bet[8] = {lb0[0], lb0[1], lb0[2], lb0[3], lb1[0], lb1[1], lb1[2], lb1[3]};
        float s2 = 0.f;
#pragma unroll
        for (int e = 0; e < 8; ++e) { const float y = x[e] * rstd * gam[e] + bet[e]; x[e] = y * sigmoidf_(y); s2 += x[e] * x[e]; }
        const float rs = __builtin_amdgcn_rsqf(wave_sum(s2) * (1.f / 512.f) + EPS);
        u32x4 o; o.x = cvt_pk_bf16(x[0] * rs * og0[0], x[1] * rs * og0[1]); o.y = cvt_pk_bf16(x[2] * rs * og0[2], x[3] * rs * og0[3]);
        o.z = cvt_pk_bf16(x[4] * rs * og1[0], x[5] * rs * og1[1]); o.w = cvt_pk_bf16(x[6] * rs * og1[2], x[7] * rs * og1[3]);
        *(u32x4*)(MIX + (size_t)(p0 + r) * DM + 512 + 8 * F.lane) = o;
    }
    __syncthreads();
}

__device__ __forceinline__ int kimg_off(int row, int c) { return row * 256 + ((c ^ (row & 15)) << 4); }
__device__ __forceinline__ void att_item(Frame& F, int l, int item) {
    const bf16* PROJ = (const bf16*)(F.ws + WS_PROJ);
    bf16* ATT = (bf16*)(F.ws + WS_ATT); float* LSE = (float*)(F.ws + WS_LSE);
    const int g = item >> 10, h = (item >> 7) & 7, qi = item & 127;
    const int sh = 2 * g, dil = 1 << sh, nbs = 128 >> sh;
    const int r = qi / nbs, nbr = qi % nbs;
    const int lane = F.lane, w = F.wave, tid = F.tid;
    LAS unsigned char* Ks = F.lds; LAS unsigned char* Vs = F.lds + 65536;
    { const int cc = tid & 15; const float* kg = F.in[IN_KN] + l * HD + 8 * cc;
      const f32x4 kg0 = *(const f32x4*)kg, kg1 = *(const f32x4*)(kg + 4);
#pragma unroll 2
      for (int j = 0; j < 8; ++j) { const int row = (tid >> 4) + 32 * j; int ms = nbr * 128 - 128 + row; ms = ms < 0 ? 0 : ms;
          const size_t pos = (size_t)ms * dil + r;
          const u32x4 kr = *(const u32x4*)(PROJ + pos * DIN + OFF_K + h * HD + 8 * cc);
          const u32x4 vr = *(const u32x4*)(PROJ + pos * DIN + OFF_VV + h * HD + 8 * cc);
          float x[8] = {bf_lo(kr.x), bf_hi(kr.x), bf_lo(kr.y), bf_hi(kr.y), bf_lo(kr.z), bf_hi(kr.z), bf_lo(kr.w), bf_hi(kr.w)};
          float s = 0.f;
#pragma unroll
          for (int e = 0; e < 8; ++e) s += x[e] * x[e];
          s += __shfl_xor(s, 1); s += __shfl_xor(s, 2); s += __shfl_xor(s, 4); s += __shfl_xor(s, 8);
          const float rs = __builtin_amdgcn_rsqf(s * (1.f / HD) + EPS);
          u32x4 o; o.x = cvt_pk_bf16(x[0] * rs * kg0[0], x[1] * rs * kg0[1]); o.y = cvt_pk_bf16(x[2] * rs * kg0[2], x[3] * rs * kg0[3]);
          o.z = cvt_pk_bf16(x[4] * rs * kg1[0], x[5] * rs * kg1[1]); o.w = cvt_pk_bf16(x[6] * rs * kg1[2], x[7] * rs * kg1[3]);
          *(LAS u32x4*)(Ks + kimg_off(row, cc)) = o;
          *(LAS u32x4*)(Vs + vimg_off(row, cc)) = vr; } }
    const int fr = lane & 15, gq = lane >> 4;
    const int iq = 16 * w + fr; const size_t qpos = (size_t)(nbr * 128 + iq) * dil + r;
    bf16x8 qf[4];
    { float x[4][8]; float s = 0.f;
#pragma unroll
      for (int ks = 0; ks < 4; ++ks) { const u32x4 qr = *(const u32x4*)(PROJ + qpos * DIN + OFF_Q + h * HD + 32 * ks + 8 * gq);
          x[ks][0] = bf_lo(qr.x); x[ks][1] = bf_hi(qr.x); x[ks][2] = bf_lo(qr.y); x[ks][3] = bf_hi(qr.y); x[ks][4] = bf_lo(qr.z); x[ks][5] = bf_hi(qr.z); x[ks][6] = bf_lo(qr.w); x[ks][7] = bf_hi(qr.w);
#pragma unroll
          for (int e = 0; e < 8; ++e) s += x[ks][e] * x[ks][e]; }
      s += __shfl_xor(s, 16); s += __shfl_xor(s, 32);
      const float rs = __builtin_amdgcn_rsqf(s * (1.f / HD) + EPS) * 0.08838834764831845f;
#pragma unroll
      for (int ks = 0; ks < 4; ++ks) { const float* qg = F.in[IN_QN] + l * HD + 32 * ks + 8 * gq; const f32x4 q0 = *(const f32x4*)qg, q1 = *(const f32x4*)(qg + 4);
          u32x4 o; o.x = cvt_pk_bf16(x[ks][0] * rs * q0[0], x[ks][1] * rs * q0[1]); o.y = cvt_pk_bf16(x[ks][2] * rs * q0[2], x[ks][3] * rs * q0[3]);
          o.z = cvt_pk_bf16(x[ks][4] * rs * q1[0], x[ks][5] * rs * q1[1]); o.w = cvt_pk_bf16(x[ks][6] * rs * q1[2], x[ks][7] * rs * q1[3]);
          qf[ks] = __builtin_bit_cast(bf16x8, o); } }
    __syncthreads();
    const int t0 = w < 6 ? w : 6;
    f32x4 sc[10];
#pragma unroll
    for (int kt = 0; kt < 10; ++kt) { sc[kt] = (f32x4){0.f, 0.f, 0.f, 0.f}; const int krow = 16 * (t0 + kt) + fr;
#pragma unroll
        for (int ks = 0; ks < 4; ++ks) { const bf16x8 kf = *(const LAS bf16x8*)(Ks + kimg_off(krow, 4 * ks + gq));
            sc[kt] = __builtin_amdgcn_mfma_f32_16x16x32_bf16(kf, qf[ks], sc[kt], 0, 0, 0); } }
    float mx = -INFINITY;
#pragma unroll
    for (int kt = 0; kt < 10; ++kt)
#pragma unroll
        for (int e = 0; e < 4; ++e) { const int j = 16 * (t0 + kt) + 4 * gq + e, dist = 128 + iq - j; const bool ok = dist >= 0 && dist <= 128 && (nbr > 0 || j >= 128);
            sc[kt][e] = ok ? sc[kt][e] : -INFINITY; mx = fmaxf(mx, sc[kt][e]); }
    mx = fmaxf(mx, __shfl_xor(mx, 16)); mx = fmaxf(mx, __shfl_xor(mx, 32));
    float sum = 0.f;
#pragma unroll
    for (int kt = 0; kt < 10; ++kt)
#pragma unroll
        for (int e = 0; e < 4; ++e) { const float p = fast_exp(sc[kt][e] - mx); sc[kt][e] = p; sum += p; }
    sum += __shfl_xor(sum, 16); sum += __shfl_xor(sum, 32);
    bf16x8 pf[5];
#pragma unroll
    for (int pp = 0; pp < 5; ++pp) { u32x4 o; o.x = cvt_pk_bf16(sc[2 * pp][0], sc[2 * pp][1]); o.y = cvt_pk_bf16(sc[2 * pp][2], sc[2 * pp][3]); o.z = cvt_pk_bf16(sc[2 * pp + 1][0], sc[2 * pp + 1][1]); o.w = cvt_pk_bf16(sc[2 * pp + 1][2], sc[2 * pp + 1][3]);
        pf[pp] = __builtin_bit_cast(bf16x8, o); }
    const float inv = __builtin_amdgcn_rcpf(sum);
    bf16* orow = ATT + ((size_t)g * SEQ + qpos) * 1024 + h * HD + 4 * gq;
#pragma unroll
    for (int dt = 0; dt < 8; ++dt) { f32x4 o = (f32x4){0.f, 0.f, 0.f, 0.f};
#pragma unroll
        for (int pp = 0; pp < 5; ++pp) { const bf16x8 vf = tr_frag(Vs, 16 * (t0 + 2 * pp), 16 * (t0 + 2 * pp + 1), dt, lane);
            o = __builtin_amdgcn_mfma_f32_16x16x32_bf16(vf, pf[pp], o, 0, 0, 0); }
        u32x2 ow; ow.x = cvt_pk_bf16(o[0] * inv, o[1] * inv); ow.y = cvt_pk_bf16(o[2] * inv, o[3] * inv);
        *(u32x2*)(orow + 16 * dt) = ow; }
    if (gq == 0) LSE[((size_t)g * SEQ + qpos) * NHEAD + h] = mx + __logf(sum);
    __syncthreads();
}

__device__ __forceinline__ void att_combine(Frame& F, int l) {
    const bf16* ATT = (const bf16*)(F.ws + WS_ATT); const float* LSE = (const float*)(F.ws + WS_LSE); bf16* MIX = (bf16*)(F.ws + WS_MIX);
    const int gw = F.vcu * NWAVES + F.wave, NGW = F.G * NWAVES, lane = F.lane;
    const float* og = F.in[IN_OUTN] + (size_t)l * DM + 1024 + 16 * lane;
    f32x4 gg[4];
#pragma unroll
    for (int q = 0; q < 4; ++q) gg[q] = *(const f32x4*)(og + 4 * q);
    for (int m = gw; m < SEQ; m += NGW) {
        const int hh = lane >> 3;
        const float l0 = LSE[((size_t)0 * SEQ + m) * NHEAD + hh], l1 = LSE[((size_t)1 * SEQ + m) * NHEAD + hh], l2 = LSE[((size_t)2 * SEQ + m) * NHEAD + hh];
        const float M = fmaxf(l0, fmaxf(l1, l2)); float w0 = fast_exp(l0 - M), w1 = fast_exp(l1 - M), w2 = fast_exp(l2 - M);
        const float iw = __builtin_amdgcn_rcpf(w0 + w1 + w2); w0 *= iw; w1 *= iw; w2 *= iw;
        float y[16]; float s = 0.f;
#pragma unroll
        for (int q = 0; q < 2; ++q) {
            const u32x4 a = *(const u32x4*)(ATT + ((size_t)0 * SEQ + m) * 1024 + 16 * lane + 8 * q), b = *(const u32x4*)(ATT + ((size_t)1 * SEQ + m) * 1024 + 16 * lane + 8 * q), c = *(const u32x4*)(ATT + ((size_t)2 * SEQ + m) * 1024 + 16 * lane + 8 * q);
            const unsigned au[4] = {a.x, a.y, a.z, a.w}, bu[4] = {b.x, b.y, b.z, b.w}, cu[4] = {c.x, c.y, c.z, c.w};
#pragma unroll
            for (int e = 0; e < 4; ++e) { y[8 * q + 2 * e] = w0 * bf_lo(au[e]) + w1 * bf_lo(bu[e]) + w2 * bf_lo(cu[e]); y[8 * q + 2 * e + 1] = w0 * bf_hi(au[e]) + w1 * bf_hi(bu[e]) + w2 * bf_hi(cu[e]); } }
#pragma unroll
        for (int e = 0; e < 16; ++e) s += y[e] * y[e];
        const float rs = __builtin_amdgcn_rsqf(wave_sum(s) * (1.f / 1024.f) + EPS);
#pragma unroll
        for (int q = 0; q < 2; ++q) { u32x4 o;
            o.x = cvt_pk_bf16(y[8 * q + 0] * rs * gg[2 * q][0], y[8 * q + 1] * rs * gg[2 * q][1]); o.y = cvt_pk_bf16(y[8 * q + 2] * rs * gg[2 * q][2], y[8 * q + 3] * rs * gg[2 * q][3]);
            o.z = cvt_pk_bf16(y[8 * q + 4] * rs * gg[2 * q + 1][0], y[8 * q + 5] * rs * gg[2 * q + 1][1]); o.w = cvt_pk_bf16(y[8 * q + 6] * rs * gg[2 * q + 1][2], y[8 * q + 7] * rs * gg[2 * q + 1][3]);
            *(u32x4*)(MIX + (size_t)m * DM + 1024 + 16 * lane + 8 * q) = o; }
    }
}

__device__ __forceinline__ void router_phase(Frame& F, int l) {
    const float* H1 = F.out; bf16* HN = (bf16*)(F.ws + WS_HN);
    const float* WRT = (const float*)(F.ws + WS_WRT) + (size_t)l * 36 * DM;
    unsigned* cnt = (unsigned*)(F.ws + WS_CTL) + CW_CNT + 64 * l;
    int* tok = (int*)(F.ws + WS_TOK); f32x4* tinfo = (f32x4*)(F.ws + WS_TINFO);
    const int lane = F.lane, tid = F.tid;
    const float* g2 = F.in[IN_NORM2] + (size_t)l * DM;
    LAS float* wl = (LAS float*)F.lds;
    for (int rd = (int)blockIdx.x; rd < SEQ / 16; rd += F.G) {
        const int row0 = rd * 16 + F.wave * 2;
        float acc[2][36]; float ss[2] = {0.f, 0.f};
#pragma unroll
        for (int r = 0; r < 2; ++r)
#pragma unroll
            for (int o = 0; o < 36; ++o) acc[r][o] = 0.f;
#pragma unroll 1
        for (int j = 0; j < 8; ++j) {
            __syncthreads();
            for (int q = tid; q < 36 * 64; q += NTHREADS) { const int o = q >> 6, c4 = q & 63; *(LAS f32x4*)(wl + o * 256 + 4 * c4) = *(const f32x4*)(WRT + (size_t)o * DM + 256 * j + 4 * c4); }
            f32x4 x[2];
#pragma unroll
            for (int r = 0; r < 2; ++r) { x[r] = *(const f32x4*)(H1 + (size_t)(row0 + r) * DM + 4 * lane + 256 * j); ss[r] += (x[r][0] * x[r][0] + x[r][1] * x[r][1]) + (x[r][2] * x[r][2] + x[r][3] * x[r][3]); }
            __syncthreads();
#pragma unroll
            for (int o = 0; o < 36; ++o) { const f32x4 wv = *(const LAS f32x4*)(wl + o * 256 + 4 * lane);
#pragma unroll
                for (int r = 0; r < 2; ++r) acc[r][o] += (x[r][0] * wv[0] + x[r][1] * wv[1]) + (x[r][2] * wv[2] + x[r][3] * wv[3]);
                if ((o % 6) == 5) asm volatile("" ::: "memory"); }
        }
#pragma unroll
        for (int r = 0; r < 2; ++r) {
            const float rs = __builtin_amdgcn_rsqf(wave_sum(ss[r]) * (1.f / DM) + EPS);
            bf16* orow = HN + (size_t)(row0 + r) * DM;
#pragma unroll
            for (int j = 0; j < 8; ++j) { const f32x4 gg = *(const f32x4*)(g2 + 4 * lane + 256 * j); const f32x4 xv = *(const f32x4*)(H1 + (size_t)(row0 + r) * DM + 4 * lane + 256 * j);
                u32x2 o; o.x = cvt_pk_bf16(xv[0] * rs * gg[0], xv[1] * rs * gg[1]); o.y = cvt_pk_bf16(xv[2] * rs * gg[2], xv[3] * rs * gg[3]);
                *(u32x2*)(orow + 4 * lane + 256 * j) = o; }
            float lg[4];
#pragma unroll
            for (int o = 0; o < 4; ++o) lg[o] = wave_sum(acc[r][32 + o]) * rs + F.in[IN_BRG][l * 4 + o];
            int gi = 0; float gm = lg[0];
#pragma unroll
            for (int o = 1; o < 4; ++o) if (lg[o] > gm) { gm = lg[o]; gi = o; }
            float den = 0.f;
#pragma unroll
            for (int o = 0; o < 4; ++o) den += __expf(lg[o] - gm);
            const float gate_g = 1.f / den;
            float t1v = -INFINITY, t2v = -INFINITY; int t1i = 0, t2i = 0;
#pragma unroll
            for (int o = 0; o < NE; ++o) { const float v = wave_sum(acc[r][o]) * rs + F.in[IN_BRE][l * NE + o];
                if ((o >> 3) == gi) { const int ii = o & 7;
                    if (v > t1v) { t2v = t1v; t2i = t1i; t1v = v; t1i = ii; }
                    else if (v > t2v) { t2v = v; t2i = ii; } } }
            if (lane == 0) { const int t = row0 + r;
                const float p1 = 1.f / (1.f + __expf(t2v - t1v)), p2 = 1.f - p1;
                const int e0 = gi * 8 + t1i, e1 = gi * 8 + t2i;
                const unsigned s0 = atomicAdd(&cnt[e0], 1u), s1 = atomicAdd(&cnt[e1], 1u);
                tok[(size_t)e0 * TOKCAP + s0] = t; tok[(size_t)e1 * TOKCAP + s1] = t;
                f32x4 ti; ti[0] = __builtin_bit_cast(float, (int)(e0 * TOKCAP + s0)); ti[1] = __builtin_bit_cast(float, (int)(e1 * TOKCAP + s1)); ti[2] = gate_g * p1; ti[3] = gate_g * p2;
                tinfo[t] = ti; }
        }
    }
    __syncthreads();
}
__device__ __forceinline__ void moe_table(Frame& F, int l) {
    const unsigned* cnt = (const unsigned*)(F.ws + WS_CTL) + CW_CNT + 64 * l;
    LAS int* tstart = (LAS int*)(F.lds + MISC_OFF + 64);
    __syncthreads();
    if (F.tid == 0) { int acc = 0; for (int e = 0; e < NE; ++e) { tstart[e] = acc; acc += ((int)cnt[e] + 255) >> 8; } tstart[NE] = acc; }
    __syncthreads();
}
__device__ __forceinline__ void combine_phase(Frame& F, int l) {
    const LAS int* tstart = (const LAS int*)(F.lds + MISC_OFF + 64);
    const bf16* Y = (const bf16*)(F.ws + WS_Y); const f32x4* tinfo = (const f32x4*)(F.ws + WS_TINFO);
    float* H = (float*)(F.ws + WS_H); bf16* HN = (bf16*)(F.ws + WS_HN);
    const int gw = F.vcu * NWAVES + F.wave, NGW = F.G * NWAVES, lane = F.lane;
    const float* g1n = F.in[IN_NORM1] + (size_t)DM;
    for (int m = gw; m < SEQ; m += NGW) {
        const f32x4 ti = tinfo[m];
        const float tf0 = ti[0], tf1 = ti[1]; const int s0 = __builtin_bit_cast(int, tf0), s1 = __builtin_bit_cast(int, tf1);
        const int e0 = s0 >> 14, e1 = s1 >> 14;
        const size_t r0 = (size_t)tstart[e0] * 256 + (s0 & (TOKCAP - 1)), r1 = (size_t)tstart[e1] * 256 + (s1 & (TOKCAP - 1));
        const float ga = ti[2], gb = ti[3];
        const float* xrow = F.out + (size_t)m * DM;
        f32x4 v[8]; float s = 0.f;
#pragma unroll
        for (int j = 0; j < 8; ++j) { v[j] = *(const f32x4*)(xrow + 4 * lane + 256 * j);
            const u32x2 ya = *(const u32x2*)(Y + r0 * DM + 4 * lane + 256 * j), yb = *(const u32x2*)(Y + r1 * DM + 4 * lane + 256 * j);
            v[j][0] += ga * bf_lo(ya.x) + gb * bf_lo(yb.x); v[j][1] += ga * bf_hi(ya.x) + gb * bf_hi(yb.x); v[j][2] += ga * bf_lo(ya.y) + gb * bf_lo(yb.y); v[j][3] += ga * bf_hi(ya.y) + gb * bf_hi(yb.y);
            s += (v[j][0] * v[j][0] + v[j][1] * v[j][1]) + (v[j][2] * v[j][2] + v[j][3] * v[j][3]); }
        if (l == 0) {
            const float rs = __builtin_amdgcn_rsqf(wave_sum(s) * (1.f / DM) + EPS);
            float* hrow = H + (size_t)m * DM; bf16* orow = HN + (size_t)m * DM;
#pragma unroll
            for (int j = 0; j < 8; ++j) { *(f32x4*)(hrow + 4 * lane + 256 * j) = v[j]; const f32x4 gg = *(const f32x4*)(g1n + 4 * lane + 256 * j);
                u32x2 o; o.x = cvt_pk_bf16(v[j][0] * rs * gg[0], v[j][1] * rs * gg[1]); o.y = cvt_pk_bf16(v[j][2] * rs * gg[2], v[j][3] * rs * gg[3]);
                *(u32x2*)(orow + 4 * lane + 256 * j) = o; }
        } else {
            float* orow = F.out + (size_t)m * DM;
#pragma unroll
            for (int j = 0; j < 8; ++j) *(f32x4*)(orow + 4 * lane + 256 * j) = v[j];
        }
    }
}

constexpr int N_PHASES = 17;
#ifndef PHASE_MASK
#define PHASE_MASK 0x1ff
#endif
#ifndef MIX_MASK
#define MIX_MASK 7
#endif
#define IN(k) (lo <= (k) && (k) < hi)
#define EN(b) ((PHASE_MASK >> (b)) & 1)
#define SEAM(k) do { if (IN(k) && IN((k) + 1)) xcd_barrier(bar); } while (0)
template <int l>
__device__ __forceinline__ void layer_phases(Frame& F, const XcdBarrier& bar, const int lo, const int hi) {
    constexpr int pb = 1 + 8 * l;
    if (EN(1) && IN(pb)) {
        pg8::StaticSched S; S.init((const bf16*)(F.ws + WS_HN), (const bf16*)(F.ws + WS_WIN) + (size_t)l * DIN * DM, SEQ, DIN, DM, F.G, (int)blockIdx.x);
        pg8::EpiProj E{(bf16*)(F.ws + WS_PROJ)};
        pg8::gemm_phase<pg8::EpiProj, pg8::StaticSched>(F.lds, DM, S, E);
    }
    SEAM(pb);
    if (EN(2) && IN(pb + 1)) {
        constexpr int N_SGU = 128, N_CONV = 256, N_ATT = 3072;
        if (MIX_MASK & 1) for (int it = (int)blockIdx.x; it < N_ATT; it += F.G) att_item(F, l, it);
        if (MIX_MASK & 2) for (int it = (int)blockIdx.x; it < N_CONV; it += F.G) conv_item(F, l, it);
        if (MIX_MASK & 4) for (int it = (int)blockIdx.x; it < N_SGU; it += F.G) sgu_item(F, l, (it + 64) & 127);
    }
    SEAM(pb + 1);
    if (EN(3) && IN(pb + 2)) att_combine(F, l);
    SEAM(pb + 2);
    if (EN(4) && IN(pb + 3)) {
        pg8::StaticSched S; S.init((const bf16*)(F.ws + WS_MIX), (const bf16*)(F.ws + WS_WOUT) + (size_t)l * DM * DM, SEQ, DM, DM, F.G, (int)blockIdx.x);
        pg8::EpiResid E{l == 0 ? F.in[IN_X] : (const float*)(F.ws + WS_H), F.out};
        pg8::gemm_phase<pg8::EpiResid, pg8::StaticSched>(F.lds, DM, S, E);
    }
    SEAM(pb + 3);
    if (EN(5) && IN(pb + 4)) router_phase(F, l);
    SEAM(pb + 4);
    if (EN(6) && IN(pb + 5)) {
        moe_table(F, l);
        pg8::SchedG1 S{(const LAS int*)(F.lds + MISC_OFF + 64), (const int*)((const unsigned*)(F.ws + WS_CTL) + CW_CNT + 64 * l), (const int*)(F.ws + WS_TOK), (const bf16*)(F.ws + WS_HN),
                       (const bf16*)(F.ws + WS_W1) + (size_t)l * NE * 1024 * DM, F.G, (int)blockIdx.x};
        pg8::EpiSwiGLU E{(bf16*)(F.ws + WS_HB)};
        pg8::gemm_phase<pg8::EpiSwiGLU, pg8::SchedG1>(F.lds, DM, S, E);
    }
    SEAM(pb + 5);
    if (EN(7) && IN(pb + 6)) {
        moe_table(F, l);
        pg8::SchedG2 S{(const LAS int*)(F.lds + MISC_OFF + 64), (const bf16*)(F.ws + WS_HB), (const bf16*)(F.ws + WS_W2) + (size_t)l * NE * DM * DE, F.G, (int)blockIdx.x};
        pg8::EpiY E{(bf16*)(F.ws + WS_Y)};
        pg8::gemm_phase<pg8::EpiY, pg8::SchedG2>(F.lds, DE, S, E);
    }
    SEAM(pb + 6);
    if (EN(8) && IN(pb + 7)) { moe_table(F, l); combine_phase(F, l); }
    SEAM(pb + 7);
}
__global__ void __launch_bounds__(NTHREADS, 2) fwd_kernel(Params args) {
    extern __shared__ __attribute__((aligned(16))) unsigned char lds_raw[];
    Frame F;
    F.lds = (LAS unsigned char*)lds_raw; F.MISC = (volatile LAS unsigned*)(F.lds + MISC_OFF);
    F.tid = threadIdx.x; F.lane = F.tid & 63; F.wave = __builtin_amdgcn_readfirstlane(F.tid >> 6);
    F.G = gridDim.x; { const int bx = blockIdx.x; F.vcu = (F.G % 8 == 0) ? (bx % 8) * (F.G / 8) + bx / 8 : bx; }
    F.in = args.in; F.out = args.out; F.ws = args.ws;
    for (int u = F.tid; u < (LDS_BYTES - MISC_OFF) / 4; u += NTHREADS) ((LAS unsigned*)(F.lds + MISC_OFF))[u] = 0u;
    __syncthreads();
    unsigned* ctl = (unsigned*)(args.ws + WS_CTL);
    const int lo = args.ph_lo, hi = args.ph_hi;
    const bool multi = (hi - lo) > 1;
    XcdBarrier bar; bar.bar = ctl + CW_BAR; bar.x = 0; bar.st = nullptr;
    if (multi) bar = xcd_barrier_post(ctl + CW_BAR, F.MISC);
    if (EN(0) && IN(0)) { p_prologue(F); }
    SEAM(0);
    layer_phases<0>(F, bar, lo, hi);
    layer_phases<1>(F, bar, lo, hi);
}
#undef IN
#undef EN
#undef SEAM

extern "C" void kernel_launch(void* const* d_in, const int* in_sizes, int n_in, void* d_out, int out_size, void* d_ws, size_t ws_size, hipStream_t stream) {
    static int grid = 0;
    if (grid == 0) {
        if (n_in != 22 || out_size != SEQ * DM || ws_size < WS_END) { fprintf(stderr, "kernel_launch: unexpected shapes (n_in %d out %d ws %zu, need %zu)\n", n_in, out_size, ws_size, (size_t)WS_END); grid = -1; return; }
        int dev = 0, cus = 0, per_cu = 0;
        if (hipGetDevice(&dev) != hipSuccess || hipDeviceGetAttribute(&cus, hipDeviceAttributeMultiprocessorCount, dev) != hipSuccess) { grid = -1; return; }
        if (hipFuncSetAttribute((const void*)fwd_kernel, hipFuncAttributeMaxDynamicSharedMemorySize, LDS_BYTES) != hipSuccess) { fprintf(stderr, "kernel_launch: hipFuncSetAttribute failed\n"); grid = -1; return; }
        if (hipOccupancyMaxActiveBlocksPerMultiprocessor(&per_cu, (const void*)fwd_kernel, NTHREADS, LDS_BYTES) != hipSuccess || per_cu < 1) { fprintf(stderr, "kernel_launch: occupancy query says %d\n", per_cu); }
        (void)hipGetLastError();
        grid = cus;
    }
    if (grid < 0) return;
    if (hipMemsetAsync((char*)d_ws + WS_CTL, 0, CTL_ZERO_BYTES, stream) != hipSuccess) return;
    Params p{};
    for (int i = 0; i < 22; ++i) p.in[i] = (const float*)d_in[i];
    p.out = (float*)d_out; p.ws = (unsigned char*)d_ws;
    constexpr int NL = MK_N_LAUNCHES;
    for (int li = 0; li < NL; ++li) {
        p.ph_lo = (NL == 1) ? 0 : li; p.ph_hi = (NL == 1) ? N_PHASES : li + 1;
        hipLaunchKernelGGL(fwd_kernel, dim3(grid), dim3(NTHREADS), LDS_BYTES, stream, p);
        if (hipPeekAtLastError() != hipSuccess) { fprintf(stderr, "kernel_launch: launch %d failed\n", li); break; }
    }
}
```

```cpp
#include <hip/hip_runtime.h>
#include <cstdio>
#include <cstdint>

#ifndef MK_N_LAUNCHES
#define MK_N_LAUNCHES 1
#endif

#define GAS __attribute__((address_space(1)))
#define LAS __attribute__((address_space(3)))
typedef unsigned short bf16;
typedef short bf16x8 __attribute__((ext_vector_type(8)));
typedef short s16x4 __attribute__((ext_vector_type(4)));
typedef float f32x4 __attribute__((ext_vector_type(4)));
typedef float f32x2 __attribute__((ext_vector_type(2)));
typedef unsigned u32x4 __attribute__((ext_vector_type(4)));
typedef unsigned u32x2 __attribute__((ext_vector_type(2)));

constexpr int SEQ = 16384, DM = 2048, DIN = 5120, NLAYER = 2;
constexpr int HD = 128, NHEAD = 8, CONV_K = 31;
constexpr int NE = 32, DE = 512, TOKCAP = 16384;
constexpr int OFF_U = 0, OFF_V = 512, OFF_A = 1024, OFF_G = 1536, OFF_Q = 2048, OFF_K = 3072, OFF_VV = 4096;
constexpr float EPS = 1e-6f;
constexpr int NWAVES = 8, NTHREADS = 512;

constexpr size_t MiB = 1u << 20;
constexpr size_t WS_CTL = 0, CTL_ZERO_BYTES = 1 * MiB;
constexpr size_t WS_WIN = 1 * MiB;
constexpr size_t WS_WOUT = 41 * MiB;
constexpr size_t WS_W1 = 57 * MiB;
constexpr size_t WS_W2 = 313 * MiB;
constexpr size_t WS_SGUW = 441 * MiB;
constexpr size_t WS_WRT = 442 * MiB;
constexpr size_t WS_TOK = 443 * MiB;
constexpr size_t WS_TINFO = 445 * MiB;
constexpr size_t WS_HN = 446 * MiB;
constexpr size_t WS_HB = 510 * MiB;
constexpr size_t WS_ATT = WS_HN;
constexpr size_t WS_LSE = WS_HN + 96 * MiB;
constexpr size_t WS_PROJ = 550 * MiB;
constexpr size_t WS_Y = WS_PROJ;
constexpr size_t WS_MIX = 710 * MiB;
constexpr size_t WS_H = 774 * MiB;
constexpr size_t WS_END = 902 * MiB;
constexpr int CW_BAR = 4096;
constexpr int CW_CNT = 16384;

constexpr int LDS_BYTES = 163840;
constexpr int MISC_OFF = 159744;

__device__ __forceinline__ unsigned cvt_pk_bf16(float lo, float hi) { unsigned r; asm volatile("v_cvt_pk_bf16_f32 %0, %1, %2" : "=v"(r) : "v"(lo), "v"(hi)); return r; }
__device__ __forceinline__ float bf_lo(unsigned u) { return __builtin_bit_cast(float, u << 16); }
__device__ __forceinline__ float bf_hi(unsigned u) { return __builtin_bit_cast(float, u & 0xffff0000u); }
__device__ __forceinline__ float wave_sum(float v) {
#pragma unroll
    for (int o = 1; o < 64; o <<= 1) v += __shfl_xor(v, o);
    return v;
}
#define LDS_WAIT() asm volatile("s_waitcnt lgkmcnt(0)" ::: "memory")
#define VM_WAIT() asm volatile("s_waitcnt vmcnt(0)" ::: "memory")
__device__ __forceinline__ float fast_exp(float x) { return __builtin_amdgcn_exp2f(x * 1.4426950408889634f); }
__device__ __forceinline__ float sigmoidf_(float x) { return __builtin_amdgcn_rcpf(1.0f + fast_exp(-x)); }
__device__ __forceinline__ float gelu_tanh(float x) { const float z = 1.5957691216057308f * (x + 0.044715f * x * x * x); return x * sigmoidf_(z); }

#define XB_TMO      128
#define XB_XCNT(j)  (256  + 64 * (j))
#define XB_XSUB(j)  (1280 + 64 * (j))
#define XB_XGEN(j)  (2304 + 64 * (j))
#define XB_TOP      3328
#define XB_TOPGEN   3392
#define XCD_BAR_WORDS 3456
#define XB_SPIN_CAP (1u << 22)
__device__ __forceinline__ unsigned xb_ld(unsigned* p)              { return __hip_atomic_load(p, __ATOMIC_RELAXED, __HIP_MEMORY_SCOPE_AGENT); }
__device__ __forceinline__ unsigned xb_add(unsigned* p, unsigned v) { return __hip_atomic_fetch_add(p, v, __ATOMIC_RELAXED, __HIP_MEMORY_SCOPE_AGENT); }
__device__ __forceinline__ unsigned xb_xcc_id() { return (unsigned)__builtin_amdgcn_s_getreg((3 << 11) | 20) & 0xFu; }
#define XB_SPIN(cond, bar) do { unsigned _sp = 0; while (cond) { __builtin_amdgcn_s_sleep(1); \
    if ((++_sp & 255u) == 0u) { if (xb_ld(&(bar)[XB_TMO])) break; if (_sp > XB_SPIN_CAP) { atomicAdd(&(bar)[XB_TMO], 1u); break; } } } } while (0)
struct XcdBarrier { unsigned* bar; unsigned x; volatile LAS unsigned* st; };
__device__ __forceinline__ XcdBarrier xcd_barrier_post(unsigned* bar, volatile LAS unsigned* st) {
    XcdBarrier b; b.bar = bar; b.x = xb_xcc_id(); b.st = st;
    if (threadIdx.x == 0) (void)xb_add(&bar[XB_XCNT(b.x)], 1u);
    return b;
}
__device__ __forceinline__ void xcd_barrier_complete(unsigned* bar, unsigned x, unsigned& nloc, unsigned& nx) {
    const unsigned G = gridDim.x * gridDim.y * gridDim.z;
    unsigned sum, cnt, mine, sp = 0u;
    for (;;) {
        sum = 0u; cnt = 0u; mine = 0u;
#pragma unroll
        for (unsigned j = 0; j < 16; ++j) { const unsigned c = xb_ld(&bar[XB_XCNT(j)]); sum += c; cnt += (c > 0u) ? 1u : 0u; mine = (j == x) ? c : mine; }
        if (sum == G) break;
        __builtin_amdgcn_s_sleep(1);
        if ((++sp & 255u) == 0u) { if (xb_ld(&bar[XB_TMO])) break; if (sp > XB_SPIN_CAP) { atomicAdd(&bar[XB_TMO], 1u); break; } }
    }
    nloc = mine > 0u ? mine : 1u; nx = cnt > 0u ? cnt : 1u;
}
__device__ __forceinline__ void xcd_barrier(const XcdBarrier& b) {
    asm volatile("s_waitcnt vmcnt(0)" ::: "memory");
    __syncthreads();
    if (threadIdx.x == 0) {
        unsigned* bar = b.bar;
        __builtin_amdgcn_s_waitcnt(0);
        unsigned nloc = b.st[0], nx = b.st[1];
        if (nloc == 0u) { xcd_barrier_complete(bar, b.x, nloc, nx); b.st[0] = nloc; b.st[1] = nx; }
        const unsigned old = xb_add(&bar[XB_XSUB(b.x)], 1u);
        const unsigned gen = old / nloc;
        if (old + 1u == (gen + 1u) * nloc) {
            __builtin_amdgcn_fence(__ATOMIC_RELEASE, "agent");
            asm volatile("s_waitcnt vmcnt(0)" ::: "memory");
            const unsigned og = xb_add(&bar[XB_TOP], 1u);
            const unsigned tg = og / nx;
            if (og + 1u == (tg + 1u) * nx) xb_add(&bar[XB_TOPGEN], 1u);
            else XB_SPIN(xb_ld(&bar[XB_TOPGEN]) == tg, bar);
            __builtin_amdgcn_fence(__ATOMIC_ACQUIRE, "agent");
            xb_add(&bar[XB_XGEN(b.x)], 1u);
            asm volatile("s_waitcnt vmcnt(0)" ::: "memory");
        } else {
            XB_SPIN(xb_ld(&bar[XB_XGEN(b.x)]) == gen, bar);
            __builtin_amdgcn_fence(__ATOMIC_ACQUIRE, "agent");
            asm volatile("s_waitcnt vmcnt(0)" ::: "memory");
        }
    }
    __syncthreads();
}

namespace pg8 {
constexpr int BM = 256, BK = 64, HALF = 128, HTB = HALF * BK * 2, STAGE_BYTES = 8 * HTB, NXCD = 8, WGM = 8;
__device__ __forceinline__ int lds_byte(int r, int c) { const int st = (r >> 4) * 2 + (c >> 5), rr = r & 15, cc = c & 31, ob = rr * 64 + cc * 2; return st * 1024 + (ob ^ (((ob >> 9) & 1) << 5)); }
__device__ __forceinline__ void stage_rc(int b, int& R, int& C) { const int st = b / 1024, sb = b % 1024, swz = sb ^ (((sb >> 9) & 1) << 5); R = (st >> 1) * 16 + swz / 64; C = (st & 1) * 32 + (swz % 64) / 2; }
__device__ __forceinline__ int perm32(int rho) { const int n = rho >> 4, i = rho & 15; return 8 * (i >> 2) + 4 * n + (i & 3); }

struct Unit { int pm, pn, e, rb; };

struct StaticSched {
    const bf16* A; const bf16* Bt; int K; int nM, nN, nwg, G, c;
    __device__ __forceinline__ void init(const bf16* A_, const bf16* Bt_, int M, int N, int K_, int G_, int c_) { A = A_; Bt = Bt_; K = K_; nM = M / BM; nN = N / BM; nwg = nM * nN; G = G_; c = c_; }
    __device__ __forceinline__ bool next(int i, Unit& u) const {
        const long L = (long)i * G + c; if (L >= nwg) return false;
        int wgid = (int)L; { const int q = nwg / NXCD, r = nwg % NXCD, xcd = wgid % NXCD, off = wgid / NXCD; wgid = (xcd < r ? xcd * (q + 1) : r * (q + 1) + (xcd - r) * q) + off; }
        const int nig = WGM * nN, gid = wgid / nig, fm = gid * WGM, gsz = (nM - fm) < WGM ? (nM - fm) : WGM;
        u.pm = fm + ((wgid % nig) % gsz); u.pn = (wgid % nig) / gsz; u.e = 0; u.rb = 0; return true;
    }
    __device__ __forceinline__ const char* a_base(const Unit& u) const { return (const char*)A + (size_t)u.pm * BM * K * 2; }
    __device__ __forceinline__ const char* b_base(const Unit& u) const { return (const char*)Bt + (size_t)u.pn * BM * K * 2; }
    __device__ __forceinline__ void a_voff(const Unit&, const int (&R)[2], const int (&C)[2], unsigned (&v)[2][2]) const {
#pragma unroll
        for (int h = 0; h < 2; ++h)
#pragma unroll
            for (int i = 0; i < 2; ++i) v[h][i] = (unsigned)((h * HALF + R[i]) * K + C[i]) * 2u;
    }
};

template <class Epi, class Sched, bool ALIGN_EPI = true>
__device__ __forceinline__ void gemm_phase(LAS unsigned char* lds, const int K, const Sched& S, const Epi& E) {
    const int tid = threadIdx.x, wid = __builtin_amdgcn_readfirstlane(tid >> 6), lane = tid & 63, wr = wid >> 2, wc = wid & 3, fr = lane & 15, fq = lane >> 4;
    const int nt = K / BK;
    int Rr[2], Cc[2]; unsigned voffB[2];
#pragma unroll
    for (int i = 0; i < 2; ++i) { stage_rc(tid * 16 + i * 8192, Rr[i], Cc[i]); const int Rb = Epi::PERM ? ((Rr[i] & ~31) + perm32(Rr[i] & 31)) : Rr[i];
        voffB[i] = (unsigned)(Rb * K + Cc[i]) * 2u; }
    const size_t kstep = (size_t)(BK * 2);
    const size_t hstep = (size_t)HALF * K * 2;
    const unsigned ldsw = (unsigned)wid * 1024u;
    const int aoff = lds_byte(wr * 64 + fr, fq * 8), boff = lds_byte(wc * 32 + fr, fq * 8);
#define PG8_SA(b, h) (((b) * 2 + (h)) * HTB)
#define PG8_SB(b, h) ((4 + (b) * 2 + (h)) * HTB)
#define PG8_STAGE(bufoff, gbase, voff) do { _Pragma("unroll") for (int _i = 0; _i < 2; ++_i) \
        __builtin_amdgcn_global_load_lds((const unsigned*)((const char*)(gbase) + (voff)[_i]), (LAS unsigned*)(lds + (bufoff) + ldsw + _i * 8192), 16, 0, 0); } while (0)
#define PG8_LDA(dst, b, h) do { _Pragma("unroll") for (int m = 0; m < 4; ++m) _Pragma("unroll") for (int k = 0; k < 2; ++k) dst[m][k] = *(const LAS bf16x8*)(lds + PG8_SA(b, h) + aoff + m * 2048 + k * 1024); } while (0)
#define PG8_LDB(dst, b, h) do { _Pragma("unroll") for (int n = 0; n < 2; ++n) _Pragma("unroll") for (int k = 0; k < 2; ++k) dst[n][k] = *(const LAS bf16x8*)(lds + PG8_SB(b, h) + boff + n * 2048 + k * 1024); } while (0)
#define PG8_MMA(ai, bj, At, Bt) do { __builtin_amdgcn_s_setprio(1); _Pragma("unroll") for (int m = 0; m < 4; ++m) _Pragma("unroll") for (int n = 0; n < 2; ++n) _Pragma("unroll") for (int k = 0; k < 2; ++k) \
        acc[ai][bj][m][n] = __builtin_amdgcn_mfma_f32_16x16x32_bf16(Bt[n][k], At[m][k], acc[ai][bj][m][n], 0, 0, 0); __builtin_amdgcn_s_setprio(0); } while (0)
#define PG8_WAIT_V(n) asm volatile("s_waitcnt vmcnt(" #n ")" ::: "memory")
#define PG8_WAIT_L(n) asm volatile("s_waitcnt lgkmcnt(" #n ")" ::: "memory")
#define PG8_BAR __builtin_amdgcn_s_barrier()
#define PG8_SCHED __builtin_amdgcn_sched_barrier(0)
    Unit cur, nxt; int ui = 0;
    if (!S.next(0, cur)) return;
    f32x4 acc[2][2][4][2];
#pragma unroll
    for (int a = 0; a < 2; ++a)
#pragma unroll
        for (int b = 0; b < 2; ++b)
#pragma unroll
            for (int m = 0; m < 4; ++m)
#pragma unroll
                for (int n = 0; n < 2; ++n) acc[a][b][m][n] = (f32x4){0.f, 0.f, 0.f, 0.f};
    bf16x8 At[4][2], B0[2][2], B1[2][2];
    const char* cA = S.a_base(cur); const char* cB = S.b_base(cur);
    unsigned vA[2][2], nvA[2][2];
    S.a_voff(cur, Rr, Cc, vA);
    PG8_STAGE(PG8_SB(0, 0), cB, voffB); PG8_STAGE(PG8_SB(0, 1), cB + hstep, voffB); PG8_STAGE(PG8_SA(0, 0), cA, vA[0]); PG8_STAGE(PG8_SA(0, 1), cA, vA[1]);
    if (wr == 1) PG8_BAR;
    PG8_WAIT_V(2); PG8_BAR;
    PG8_STAGE(PG8_SB(1, 0), cB + kstep, voffB); PG8_STAGE(PG8_SA(1, 0), cA + kstep, vA[0]); PG8_STAGE(PG8_SB(1, 1), cB + hstep + kstep, voffB);
    PG8_WAIT_V(6); PG8_BAR;
    for (;;) {
        const bool has_next = S.next(ui + 1, nxt);
        const char* nA = has_next ? S.a_base(nxt) : cA; const char* nB = has_next ? S.b_base(nxt) : cB;
        if (has_next) S.a_voff(nxt, Rr, Cc, nvA);
        else { nvA[0][0] = vA[0][0]; nvA[0][1] = vA[0][1]; nvA[1][0] = vA[1][0]; nvA[1][1] = vA[1][1]; }
        for (int t = 0; t < nt; t += 2) {
            const bool last = (t == nt - 2);
            const char* a1 = cA + (size_t)(t + 1) * kstep;
            const char* a2 = last ? nA : cA + (size_t)(t + 2) * kstep; const char* b2 = last ? nB : cB + (size_t)(t + 2) * kstep;
            const char* a3 = a2 + kstep; const char* b3 = b2 + kstep;
            unsigned wA[2][2];
            wA[0][0] = last ? nvA[0][0] : vA[0][0]; wA[0][1] = last ? nvA[0][1] : vA[0][1]; wA[1][0] = last ? nvA[1][0] : vA[1][0]; wA[1][1] = last ? nvA[1][1] : vA[1][1];
            PG8_LDB(B0, 0, 0); PG8_LDB(B1, 0, 1); PG8_SCHED; PG8_LDA(At, 0, 0); PG8_STAGE(PG8_SA(1, 1), a1, vA[1]);
            PG8_WAIT_V(8); PG8_WAIT_L(0); PG8_BAR; PG8_MMA(0, 0, At, B0); PG8_MMA(0, 1, At, B1); PG8_BAR; PG8_SCHED;
            PG8_LDA(At, 0, 1); PG8_STAGE(PG8_SB(0, 0), b2, voffB); PG8_STAGE(PG8_SB(0, 1), b2 + hstep, voffB); PG8_STAGE(PG8_SA(0, 0), a2, wA[0]);
            PG8_WAIT_V(8); PG8_WAIT_L(0); PG8_BAR; PG8_MMA(1, 0, At, B0); PG8_MMA(1, 1, At, B1); PG8_BAR; PG8_SCHED;
            PG8_LDB(B0, 1, 0); PG8_LDB(B1, 1, 1); PG8_SCHED; PG8_LDA(At, 1, 0); PG8_STAGE(PG8_SA(0, 1), a2, wA[1]);
            PG8_WAIT_V(8); PG8_WAIT_L(0); PG8_BAR; PG8_MMA(0, 0, At, B0); PG8_MMA(0, 1, At, B1); PG8_BAR; PG8_SCHED;
            PG8_LDA(At, 1, 1); PG8_STAGE(PG8_SB(1, 0), b3, voffB); PG8_STAGE(PG8_SB(1, 1), b3 + hstep, voffB); PG8_STAGE(PG8_SA(1, 0), a3, wA[0]);
            PG8_WAIT_V(8); PG8_WAIT_L(0); PG8_BAR; PG8_MMA(1, 0, At, B0); PG8_MMA(1, 1, At, B1); PG8_BAR; PG8_SCHED;
        }
        if constexpr (ALIGN_EPI) { if (wr == 0) PG8_BAR; }
        E(acc, cur, wr, wc, fr, fq);
        if (!has_next) break;
#pragma unroll
        for (int a = 0; a < 2; ++a)
#pragma unroll
            for (int b = 0; b < 2; ++b)
#pragma unroll
                for (int m = 0; m < 4; ++m)
#pragma unroll
                    for (int n = 0; n < 2; ++n) acc[a][b][m][n] = (f32x4){0.f, 0.f, 0.f, 0.f};
        cur = nxt; cA = nA; cB = nB; ++ui;
        vA[0][0] = nvA[0][0]; vA[0][1] = nvA[0][1]; vA[1][0] = nvA[1][0]; vA[1][1] = nvA[1][1];
        if constexpr (ALIGN_EPI) { if (wr == 1) PG8_BAR; }
    }
    PG8_WAIT_V(0);
    if constexpr (!ALIGN_EPI) { if (wr == 0) PG8_BAR; }
    PG8_BAR;
#undef PG8_SA
#undef PG8_SB
#undef PG8_STAGE
#undef PG8_LDA
#undef PG8_LDB
#undef PG8_MMA
#undef PG8_WAIT_V
#undef PG8_WAIT_L
#undef PG8_BAR
#undef PG8_SCHED
}

struct EpiProj {
    static constexpr bool PERM = true;
    bf16* O;
    __device__ __forceinline__ void operator()(const f32x4 (&acc)[2][2][4][2], const Unit& u, int wr, int wc, int fr, int fq) const {
        const int row0 = u.pm * BM + wr * 64 + fr, col0 = u.pn * BM + wc * 32 + 8 * fq;
        const bool act = u.pn < 4;
#pragma unroll
        for (int ai = 0; ai < 2; ++ai)
#pragma unroll
            for (int m = 0; m < 4; ++m) { bf16* rowp = O + (size_t)(row0 + ai * HALF + m * 16) * DIN + col0;
#pragma unroll
                for (int bj = 0; bj < 2; ++bj) { f32x4 v0 = acc[ai][bj][m][0], v1 = acc[ai][bj][m][1];
                    if (act) {
#pragma unroll
                        for (int j = 0; j < 4; ++j) { v0[j] = gelu_tanh(v0[j]); v1[j] = gelu_tanh(v1[j]); } }
                    u32x4 w; w.x = cvt_pk_bf16(v0[0], v0[1]); w.y = cvt_pk_bf16(v0[2], v0[3]); w.z = cvt_pk_bf16(v1[0], v1[1]); w.w = cvt_pk_bf16(v1[2], v1[3]);
                    *(u32x4*)(rowp + bj * HALF) = w; } }
    }
};
struct EpiResid {
    static constexpr bool PERM = false;
    const float* res; float* out;
    __device__ __forceinline__ void operator()(const f32x4 (&acc)[2][2][4][2], const Unit& u, int wr, int wc, int fr, int fq) const {
        const int row0 = u.pm * BM + wr * 64 + fr, col0 = u.pn * BM + wc * 32 + 4 * fq;
#pragma unroll
        for (int ai = 0; ai < 2; ++ai)
#pragma unroll
            for (int m = 0; m < 4; ++m) { const size_t off = (size_t)(row0 + ai * HALF + m * 16) * DM + col0;
#pragma unroll
                for (int bj = 0; bj < 2; ++bj)
#pragma unroll
                    for (int n = 0; n < 2; ++n) { const f32x4 r = *(const f32x4*)(res + off + bj * HALF + n * 16); *(f32x4*)(out + off + bj * HALF + n * 16) = acc[ai][bj][m][n] + r; } }
    }
};
struct EpiSwiGLU {
    static constexpr bool PERM = true;
    bf16* HB;
    __device__ __forceinline__ void operator()(const f32x4 (&acc)[2][2][4][2], const Unit& u, int wr, int wc, int fr, int fq) const {
        const int row0 = u.pm * BM + wr * 64 + fr, col0 = u.pn * HALF + wc * 32 + 8 * fq;
#pragma unroll
        for (int ai = 0; ai < 2; ++ai)
#pragma unroll
            for (int m = 0; m < 4; ++m) { bf16* rowp = HB + (size_t)(row0 + ai * HALF + m * 16) * DE + col0;
                float h[8];
#pragma unroll
                for (int n = 0; n < 2; ++n)
#pragma unroll
                    for (int j = 0; j < 4; ++j) { const float g = acc[ai][0][m][n][j], up = acc[ai][1][m][n][j]; h[n * 4 + j] = g * sigmoidf_(g) * up; }
                u32x4 w; w.x = cvt_pk_bf16(h[0], h[1]); w.y = cvt_pk_bf16(h[2], h[3]); w.z = cvt_pk_bf16(h[4], h[5]); w.w = cvt_pk_bf16(h[6], h[7]);
                *(u32x4*)rowp = w; }
    }
};
struct EpiY {
    static constexpr bool PERM = true;
    bf16* Y;
    __device__ __forceinline__ void operator()(const f32x4 (&acc)[2][2][4][2], const Unit& u, int wr, int wc, int fr, int fq) const {
        const int row0 = u.pm * BM + wr * 64 + fr, col0 = u.pn * BM + wc * 32 + 8 * fq;
#pragma unroll
        for (int ai = 0; ai < 2; ++ai)
#pragma unroll
            for (int m = 0; m < 4; ++m) { bf16* rowp = Y + (size_t)(row0 + ai * HALF + m * 16) * DM + col0;
#pragma unroll
                for (int bj = 0; bj < 2; ++bj) { const f32x4 v0 = acc[ai][bj][m][0], v1 = acc[ai][bj][m][1];
                    u32x4 w; w.x = cvt_pk_bf16(v0[0], v0[1]); w.y = cvt_pk_bf16(v0[2], v0[3]); w.z = cvt_pk_bf16(v1[0], v1[1]); w.w = cvt_pk_bf16(v1[2], v1[3]);
                    *(u32x4*)(rowp + bj * HALF) = w; } }
    }
};

struct SchedG1 {
    const LAS int* tstart; const int* cnt; const int* tok; const bf16* X; const bf16* W1; int G, c;
    __device__ __forceinline__ bool next(int i, Unit& u) const {
        const int L = i * G + c, NT = tstart[NE]; if (L >= NT * 4) return false;
        const int T = L >> 2; int e = 0;
        for (int j = 1; j < NE; ++j) e = (tstart[j] <= T) ? j : e;
        u.pm = T; u.pn = L & 3; u.e = e; u.rb = T - tstart[e]; return true;
    }
    __device__ __forceinline__ const char* a_base(const Unit&) const { return (const char*)X; }
    __device__ __forceinline__ const char* b_base(const Unit& u) const { return (const char*)(W1 + ((size_t)u.e * 1024 + (size_t)u.pn * BM) * DM); }
    __device__ __forceinline__ void a_voff(const Unit& u, const int (&R)[2], const int (&C)[2], unsigned (&v)[2][2]) const {
        const int n = cnt[u.e]; const int* tl = tok + (size_t)u.e * TOKCAP;
#pragma unroll
        for (int h = 0; h < 2; ++h)
#pragma unroll
            for (int i = 0; i < 2; ++i) { int row = u.rb * BM + h * HALF + R[i]; row = row < n ? row : 0; const int t = tl[row]; v[h][i] = (unsigned)(t * DM + C[i]) * 2u; }
    }
};
struct SchedG2 {
    const LAS int* tstart; const bf16* HB; const bf16* W2; int G, c;
    __device__ __forceinline__ bool next(int i, Unit& u) const {
        const int L = i * G + c, NT = tstart[NE]; if (L >= NT * 8) return false;
        const int T = L >> 3; int e = 0;
        for (int j = 1; j < NE; ++j) e = (tstart[j] <= T) ? j : e;
        u.pm = T; u.pn = L & 7; u.e = e; u.rb = T - tstart[e]; return true;
    }
    __device__ __forceinline__ const char* a_base(const Unit& u) const { return (const char*)(HB + (size_t)u.pm * BM * DE); }
    __device__ __forceinline__ const char* b_base(const Unit& u) const { return (const char*)(W2 + ((size_t)u.e * DM + (size_t)u.pn * BM) * DE); }
    __device__ __forceinline__ void a_voff(const Unit&, const int (&R)[2], const int (&C)[2], unsigned (&v)[2][2]) const {
#pragma unroll
        for (int h = 0; h < 2; ++h)
#pragma unroll
            for (int i = 0; i < 2; ++i) v[h][i] = (unsigned)((h * HALF + R[i]) * DE + C[i]) * 2u;
    }
};
}

struct Params { const float* in[22]; float* out; unsigned char* ws; int ph_lo, ph_hi; };
enum { IN_X = 0, IN_NORM1, IN_WIN, IN_SGUN, IN_SGUW, IN_SGUB, IN_CONVW, IN_CONVB, IN_LNG, IN_LNB, IN_QN, IN_KN, IN_OUTN, IN_WOUT, IN_NORM2, IN_WRG, IN_BRG, IN_WRE, IN_BRE, IN_WG, IN_WU, IN_WD };

struct Frame {
    LAS unsigned char* lds; volatile LAS unsigned* MISC;
    int tid, lane, wave, vcu, G;
    const float* const* in; float* out; unsigned char* ws;
};

__device__ __forceinline__ void tr_tile(const float* W, int ldw, int k0, int n0, bf16* WT, int K, int nrow0, LAS float* scr, int lane) {
#pragma unroll 4
    for (int i = 0; i < 16; ++i) { const int kk = 4 * i + (lane >> 4);
        const f32x4 v = *(const f32x4*)(W + (size_t)(k0 + kk) * ldw + n0 + 4 * (lane & 15));
        LAS float* d = scr + kk * 65 + 4 * (lane & 15); d[0] = v[0]; d[1] = v[1]; d[2] = v[2]; d[3] = v[3]; }
    LDS_WAIT();
    const int c = lane & 7;
#pragma unroll
    for (int j = 0; j < 8; ++j) { const int n = (lane >> 3) + 8 * j; const LAS float* s = scr + (8 * c) * 65 + n;
        u32x4 o; o.x = cvt_pk_bf16(s[0], s[65]); o.y = cvt_pk_bf16(s[2 * 65], s[3 * 65]); o.z = cvt_pk_bf16(s[4 * 65], s[5 * 65]); o.w = cvt_pk_bf16(s[6 * 65], s[7 * 65]);
        *(u32x4*)(WT + (size_t)(nrow0 + n) * K + k0 + 8 * c) = o; }
    LDS_WAIT();
}
__device__ __forceinline__ void norm_row_bf16(const float* xrow, const float* g, bf16* orow, int lane) {
    f32x4 v[8]; float s = 0.f;
#pragma unroll
    for (int j = 0; j < 8; ++j) { v[j] = *(const f32x4*)(xrow + 4 * lane + 256 * j); s += (v[j][0] * v[j][0] + v[j][1] * v[j][1]) + (v[j][2] * v[j][2] + v[j][3] * v[j][3]); }
    const float rs = __builtin_amdgcn_rsqf(wave_sum(s) * (1.f / DM) + EPS);
#pragma unroll
    for (int j = 0; j < 8; ++j) { const f32x4 gg = *(const f32x4*)(g + 4 * lane + 256 * j);
        u32x2 o; o.x = cvt_pk_bf16(v[j][0] * rs * gg[0], v[j][1] * rs * gg[1]); o.y = cvt_pk_bf16(v[j][2] * rs * gg[2], v[j][3] * rs * gg[3]);
        *(u32x2*)(orow + 4 * lane + 256 * j) = o; }
}
__device__ __forceinline__ void p_prologue(Frame& F) {
    LAS float* scr = (LAS float*)(F.lds + F.wave * 16640);
    const int gw = F.vcu * NWAVES + F.wave, NGW = F.G * NWAVES;
    bf16* WIN = (bf16*)(F.ws + WS_WIN); bf16* WOUT = (bf16*)(F.ws + WS_WOUT); bf16* W1 = (bf16*)(F.ws + WS_W1); bf16* W2 = (bf16*)(F.ws + WS_W2);
    constexpr int T_IN = 32 * 80, T_OUT = 32 * 32, T_E = 32 * 8, T_D = 8 * 32;
    constexpr int T_LAYER = T_IN + T_OUT + NE * (2 * T_E + T_D);
    for (int it = gw; it < NLAYER * T_LAYER; it += NGW) {
        const int l = it / T_LAYER; int r = it % T_LAYER;
        if (r < T_IN) { const int kb = r / 80, nb = r % 80; tr_tile(F.in[IN_WIN] + (size_t)l * DM * DIN, DIN, 64 * kb, 64 * nb, WIN + (size_t)l * DIN * DM, DM, 64 * nb, scr, F.lane); continue; } r -= T_IN;
        if (r < T_OUT) { const int kb = r / 32, nb = r % 32; tr_tile(F.in[IN_WOUT] + (size_t)l * DM * DM, DM, 64 * kb, 64 * nb, WOUT + (size_t)l * DM * DM, DM, 64 * nb, scr, F.lane); continue; } r -= T_OUT;
        const int e = r / (2 * T_E + T_D); r %= (2 * T_E + T_D);
        const size_t le = (size_t)l * NE + e;
        if (r < 2 * T_E) { const int up = r >= T_E; r -= up * T_E; const int kb = r / 8, nb = r % 8, n0 = 64 * nb;
            tr_tile((up ? F.in[IN_WU] : F.in[IN_WG]) + le * DM * DE, DE, 64 * kb, n0, W1 + le * 1024 * DM, DM, (n0 / 128) * 256 + up * 128 + (n0 % 128), scr, F.lane); continue; }
        r -= 2 * T_E;
        { const int kb = r / 32, nb = r % 32; tr_tile(F.in[IN_WD] + le * DE * DM, DM, 64 * kb, 64 * nb, W2 + le * DM * DE, DE, 64 * nb, scr, F.lane); }
    }
    { bf16* SW = (bf16*)(F.ws + WS_SGUW); const int gt = (F.vcu * NWAVES + F.wave) * 64 + F.lane, NGT = NGW * 64;
      for (int idx = gt; idx < NLAYER * 4 * 8 * 4 * 64; idx += NGT) {
          const int ln = idx & 63, pp = (idx >> 6) & 3, itile = (idx >> 8) & 7, h = (idx >> 11) & 3, l = idx >> 13;
          const int i = 16 * itile + (ln & 15), gq = ln >> 4;
          const float* w = F.in[IN_SGUW] + ((size_t)(l * 4 + h) * 128 + i) * 128;
          float v[8];
#pragma unroll
          for (int jj = 0; jj < 8; ++jj) { const int j = 32 * pp + (jj < 4 ? 4 * gq + jj : 16 + 4 * gq + (jj - 4)); v[jj] = (j <= i) ? w[j] : 0.f; }
          u32x4 o; o.x = cvt_pk_bf16(v[0], v[1]); o.y = cvt_pk_bf16(v[2], v[3]); o.z = cvt_pk_bf16(v[4], v[5]); o.w = cvt_pk_bf16(v[6], v[7]);
          *(u32x4*)(SW + (size_t)idx * 8) = o; }
      float* WRT = (float*)(F.ws + WS_WRT);
      for (int idx = gt; idx < NLAYER * 36 * DM; idx += NGT) { const int k = idx % DM, o = (idx / DM) % 36, l = idx / (36 * DM);
          WRT[idx] = (o < 32 ? F.in[IN_WRE][((size_t)l * DM + k) * NE + o] : F.in[IN_WRG][((size_t)l * DM + k) * 4 + (o - 32)]) * F.in[IN_NORM2][(size_t)l * DM + k]; } }
    bf16* HN = (bf16*)(F.ws + WS_HN);
    for (int m = gw; m < SEQ; m += NGW) norm_row_bf16(F.in[IN_X] + (size_t)m * DM, F.in[IN_NORM1], HN + (size_t)m * DM, F.lane);
}

__device__ __forceinline__ int vimg_off(int row, int c) { return row * 256 + ((((c >> 1) ^ (row & 7)) << 1) | (c & 1)) * 16; }
__device__ __forceinline__ bf16x8 tr_frag(const LAS unsigned char* img, int ra, int rb, int dt, int lane) {
    const int gq = lane >> 4, q = (lane & 15) >> 2, p = lane & 3;
    const int r0 = ra + 4 * gq + q, r1 = rb + 4 * gq + q, c = 2 * dt + (p >> 1);
    const s16x4 a = __builtin_amdgcn_ds_read_tr16_b64_v4i16((LAS s16x4*)(img + vimg_off(r0, c) + 8 * (p & 1)));
    const s16x4 b = __builtin_amdgcn_ds_read_tr16_b64_v4i16((LAS s16x4*)(img + vimg_off(r1, c) + 8 * (p & 1)));
    bf16x8 r; r[0] = a[0]; r[1] = a[1]; r[2] = a[2]; r[3] = a[3]; r[4] = b[0]; r[5] = b[1]; r[6] = b[2]; r[7] = b[3]; return r;
}
__device__ __forceinline__ void sgu_item(Frame& F, int l, int chunk) {
    const bf16* PROJ = (const bf16*)(F.ws + WS_PROJ); bf16* MIX = (bf16*)(F.ws + WS_MIX);
    const int p0 = chunk * 128, lane = F.lane, w = F.wave;
    LAS float* red = (LAS float*)(F.lds + MISC_OFF + 256);
    const float* gn = F.in[IN_SGUN] + l * 512;
    f32x4 g0 = *(const f32x4*)(gn + 8 * lane), g1 = *(const f32x4*)(gn + 8 * lane + 4);
#pragma unroll 4
    for (int j = 0; j < 16; ++j) { const int row = w + 8 * j;
        const u32x4 raw = *(const u32x4*)(PROJ + (size_t)(p0 + row) * DIN + OFF_V + 8 * lane);
        float x[8] = {bf_lo(raw.x), bf_hi(raw.x), bf_lo(raw.y), bf_hi(raw.y), bf_lo(raw.z), bf_hi(raw.z), bf_lo(raw.w), bf_hi(raw.w)};
        float s = 0.f;
#pragma unroll
        for (int e = 0; e < 8; ++e) s += x[e] * x[e];
        const float rs = __builtin_amdgcn_rsqf(wave_sum(s) * (1.f / 512.f) + EPS);
        u32x4 o; o.x = cvt_pk_bf16(x[0] * rs * g0[0], x[1] * rs * g0[1]); o.y = cvt_pk_bf16(x[2] * rs * g0[2], x[3] * rs * g0[3]);
        o.z = cvt_pk_bf16(x[4] * rs * g1[0], x[5] * rs * g1[1]); o.w = cvt_pk_bf16(x[6] * rs * g1[2], x[7] * rs * g1[3]);
        const int h = lane >> 4, cc = lane & 15;
        *(LAS u32x4*)(F.lds + h * 32768 + vimg_off(row, cc)) = o; }
    __syncthreads();
    const int h = w >> 1, ih = w & 1, gq = lane >> 4, fr = lane & 15;
    const LAS unsigned char* img = F.lds + h * 32768;
    const bf16* SW = (const bf16*)(F.ws + WS_SGUW) + (size_t)(l * 4 + h) * 8 * 4 * 64 * 8;
    const float* bs = F.in[IN_SGUB] + (size_t)(l * 4 + h) * 128;
    const float* og = F.in[IN_OUTN] + (size_t)l * DM + h * 128 + 4 * gq;
#pragma unroll 1
    for (int half = 0; half < 2; ++half) {
        f32x4 z[2][8];
#pragma unroll
        for (int ii = 0; ii < 2; ++ii)
#pragma unroll
            for (int dt = 0; dt < 8; ++dt) z[ii][dt] = (f32x4){0.f, 0.f, 0.f, 0.f};
        const int it0 = ih + 4 * half;
#pragma unroll 1
        for (int pp = 0; pp <= (it0 + 2) / 2; ++pp) {
            const bf16x8 bw0 = *(const bf16x8*)(SW + ((size_t)(it0 * 4 + pp) * 64 + lane) * 8);
            const bf16x8 bw1 = *(const bf16x8*)(SW + ((size_t)((it0 + 2) * 4 + pp) * 64 + lane) * 8);
            const bool do0 = pp <= it0 / 2;
#pragma unroll
            for (int dt = 0; dt < 8; ++dt) { const bf16x8 a = tr_frag(img, 32 * pp, 32 * pp + 16, dt, lane);
                if (do0) z[0][dt] = __builtin_amdgcn_mfma_f32_16x16x32_bf16(a, bw0, z[0][dt], 0, 0, 0);
                z[1][dt] = __builtin_amdgcn_mfma_f32_16x16x32_bf16(a, bw1, z[1][dt], 0, 0, 0); }
        }
#pragma unroll
        for (int ii = 0; ii < 2; ++ii) { const int i = 16 * (it0 + 2 * ii) + fr; const float bi = bs[i]; float s = 0.f;
            const bf16* urow = PROJ + (size_t)(p0 + i) * DIN + OFF_U + h * 128 + 4 * gq;
#pragma unroll
            for (int dt = 0; dt < 8; ++dt) { const u32x2 ur = *(const u32x2*)(urow + 16 * dt);
                f32x4 y; y[0] = bf_lo(ur.x) * (z[ii][dt][0] + bi); y[1] = bf_hi(ur.x) * (z[ii][dt][1] + bi); y[2] = bf_lo(ur.y) * (z[ii][dt][2] + bi); y[3] = bf_hi(ur.y) * (z[ii][dt][3] + bi);
                z[ii][dt] = y; s += (y[0] * y[0] + y[1] * y[1]) + (y[2] * y[2] + y[3] * y[3]); }
            s += __shfl_xor(s, 16); s += __shfl_xor(s, 32);
            if (gq == 0) red[i * 4 + h] = s; }
        __syncthreads();
#pragma unroll
        for (int ii = 0; ii < 2; ++ii) { const int i = 16 * (it0 + 2 * ii) + fr;
            const f32x4 rr = *(const LAS f32x4*)(red + i * 4);
            const float rs = __builtin_amdgcn_rsqf(((rr[0] + rr[1]) + (rr[2] + rr[3])) * (1.f / 512.f) + EPS);
            bf16* orow = MIX + (size_t)(p0 + i) * DM + h * 128 + 4 * gq;
#pragma unroll
            for (int dt = 0; dt < 8; ++dt) { const f32x4 gg = *(const f32x4*)(og + 16 * dt); const f32x4 y = z[ii][dt];
                u32x2 o; o.x = cvt_pk_bf16(y[0] * rs * gg[0], y[1] * rs * gg[1]); o.y = cvt_pk_bf16(y[2] * rs * gg[2], y[3] * rs * gg[3]);
                *(u32x2*)(orow + 16 * dt) = o; } }
    }
    __syncthreads();
}

__device__ __forceinline__ void conv_item(Frame& F, int l, int tile) {
    const bf16* PROJ = (const bf16*)(F.ws + WS_PROJ); bf16* MIX = (bf16*)(F.ws + WS_MIX);
    constexpr int TP = 64;
    const int p0 = tile * TP, c = F.tid;
    LAS float* cbuf = (LAS float*)F.lds;
    float wk[CONV_K];
#pragma unroll
    for (int k = 0; k < CONV_K; ++k) wk[k] = F.in[IN_CONVW][((size_t)l * CONV_K + k) * 512 + c];
    const float cb = F.in[IN_CONVB][l * 512 + c];
    float win[30];
#pragma unroll
    for (int k = 0; k < 30; ++k) { const int p = p0 - 30 + k; float zv = 0.f;
        if (p >= 0) { const float a = __builtin_bit_cast(float, (unsigned)PROJ[(size_t)p * DIN + OFF_A + c] << 16), g = __builtin_bit_cast(float, (unsigned)PROJ[(size_t)p * DIN + OFF_G + c] << 16); zv = a * sigmoidf_(g); }
        win[k] = zv; }
#define CONV_STEP(q, pos) do { const int p = p0 + (pos); \
        const float a = __builtin_bit_cast(float, (unsigned)PROJ[(size_t)p * DIN + OFF_A + c] << 16), g = __builtin_bit_cast(float, (unsigned)PROJ[(size_t)p * DIN + OFF_G + c] << 16); \
        const float zv = a * sigmoidf_(g); float acc = cb + wk[30] * zv; \
        _Pragma("unroll") for (int k = 0; k < 30; ++k) acc += wk[k] * win[(k + (q)) % 30]; \
        win[(q) % 30] = zv; cbuf[(pos) * 512 + c] = acc; } while (0)
    for (int blk = 0; blk < 2; ++blk) {
#pragma unroll
        for (int q = 0; q < 30; ++q) CONV_STEP(q, blk * 30 + q);
    }
#pragma unroll
    for (int q = 0; q < 4; ++q) CONV_STEP(q, 60 + q);
#undef CONV_STEP
    __syncthreads();
    const float* lg = F.in[IN_LNG] + l * 512 + 8 * F.lane; const float* lb = F.in[IN_LNB] + l * 512 + 8 * F.lane; const float* og = F.in[IN_OUTN] + (size_t)l * DM + 512 + 8 * F.lane;
    const f32x4 lg0 = *(const f32x4*)lg, lg1 = *(const f32x4*)(lg + 4), lb0 = *(const f32x4*)lb, lb1 = *(const f32x4*)(lb + 4), og0 = *(const f32x4*)og, og1 = *(const f32x4*)(og + 4);
    for (int r = F.wave; r < TP; r += NWAVES) {
        const f32x4 a0 = *(const LAS f32x4*)(cbuf + r * 512 + 8 * F.lane), a1 = *(const LAS f32x4*)(cbuf + r * 512 + 8 * F.lane + 4);
        float x[8] = {a0[0], a0[1], a0[2], a0[3], a1[0], a1[1], a1[2], a1[3]};
        float s = 0.f;
#pragma unroll
        for (int e = 0; e < 8; ++e) s += x[e];
        const float mu = wave_sum(s) * (1.f / 512.f); float q2 = 0.f;
#pragma unroll
        for (int e = 0; e < 8; ++e) { x[e] -= mu; q2 += x[e] * x[e]; }
        const float rstd = __builtin_amdgcn_rsqf(wave_sum(q2) * (1.f / 512.f) + EPS);
        const float gam[8] = {lg0[0], lg0[1], lg0[2], lg0[3], lg1[0], lg1[1], lg1[2], lg1[3]}, bet[8] = {lb0[0], lb0[1], lb0[2], lb0[3], lb1[0], lb1[1], lb1[2], lb1[3]};
        float s2 = 0.f;
#pragma unroll
        for (int e = 0; e < 8; ++e) { const float y = x[e] * rstd * gam[e] + bet[e]; x[e] = y * sigmoidf_(y); s2 += x[e] * x[e]; }
        const float rs = __builtin_amdgcn_rsqf(wave_sum(s2) * (1.f / 512.f) + EPS);
        u32x4 o; o.x = cvt_pk_bf16(x[0] * rs * og0[0], x[1] * rs * og0[1]); o.y = cvt_pk_bf16(x[2] * rs * og0[2], x[3] * rs * og0[3]);
        o.z = cvt_pk_bf16(x[4] * rs * og1[0], x[5] * rs * og1[1]); o.w = cvt_pk_bf16(x[6] * rs * og1[2], x[7] * rs * og1[3]);
        *(u32x4*)(MIX + (size_t)(p0 + r) * DM + 512 + 8 * F.lane) = o;
    }
    __syncthreads();
}

__device__ __forceinline__ int kimg_off(int row, int c) { return row * 256 + ((c ^ (row & 15)) << 4); }
__device__ __forceinline__ void att_item(Frame& F, int l, int item) {
    const bf16* PROJ = (const bf16*)(F.ws + WS_PROJ);
    bf16* ATT = (bf16*)(F.ws + WS_ATT); float* LSE = (float*)(F.ws + WS_LSE);
    const int g = item >> 10, h = (item >> 7) & 7, qi = item & 127;
    const int sh = 2 * g, dil = 1 << sh, nbs = 128 >> sh;
    const int r = qi / nbs, nbr = qi % nbs;
    const int lane = F.lane, w = F.wave, tid = F.tid;
    LAS unsigned char* Ks = F.lds; LAS unsigned char* Vs = F.lds + 65536;
    { const int cc = tid & 15; const float* kg = F.in[IN_KN] + l * HD + 8 * cc;
      const f32x4 kg0 = *(const f32x4*)kg, kg1 = *(const f32x4*)(kg + 4);
#pragma unroll 2
      for (int j = 0; j < 8; ++j) { const int row = (tid >> 4) + 32 * j; int ms = nbr * 128 - 128 + row; ms = ms < 0 ? 0 : ms;
          const size_t pos = (size_t)ms * dil + r;
          const u32x4 kr = *(const u32x4*)(PROJ + pos * DIN + OFF_K + h * HD + 8 * cc);
          const u32x4 vr = *(const u32x4*)(PROJ + pos * DIN + OFF_VV + h * HD + 8 * cc);
          float x[8] = {bf_lo(kr.x), bf_hi(kr.x), bf_lo(kr.y), bf_hi(kr.y), bf_lo(kr.z), bf_hi(kr.z), bf_lo(kr.w), bf_hi(kr.w)};
          float s = 0.f;
#pragma unroll
          for (int e = 0; e < 8; ++e) s += x[e] * x[e];
          s += __shfl_xor(s, 1); s += __shfl_xor(s, 2); s += __shfl_xor(s, 4); s += __shfl_xor(s, 8);
          const float rs = __builtin_amdgcn_rsqf(s * (1.f / HD) + EPS);
          u32x4 o; o.x = cvt_pk_bf16(x[0] * rs * kg0[0], x[1] * rs * kg0[1]); o.y = cvt_pk_bf16(x[2] * rs * kg0[2], x[3] * rs * kg0[3]);
          o.z = cvt_pk_bf16(x[4] * rs * kg1[0], x[5] * rs * kg1[1]); o.w = cvt_pk_bf16(x[6] * rs * kg1[2], x[7] * rs * kg1[3]);
          *(LAS u32x4*)(Ks + kimg_off(row, cc)) = o;
          *(LAS u32x4*)(Vs + vimg_off(row, cc)) = vr; } }
    const int fr = lane & 15, gq = lane >> 4;
    const int iq = 16 * w + fr; const size_t qpos = (size_t)(nbr * 128 + iq) * dil + r;
    bf16x8 qf[4];
    { float x[4][8]; float s = 0.f;
#pragma unroll
      for (int ks = 0; ks < 4; ++ks) { const u32x4 qr = *(const u32x4*)(PROJ + qpos * DIN + OFF_Q + h * HD + 32 * ks + 8 * gq);
          x[ks][0] = bf_lo(qr.x); x[ks][1] = bf_hi(qr.x); x[ks][2] = bf_lo(qr.y); x[ks][3] = bf_hi(qr.y); x[ks][4] = bf_lo(qr.z); x[ks][5] = bf_hi(qr.z); x[ks][6] = bf_lo(qr.w); x[ks][7] = bf_hi(qr.w);
#pragma unroll
          for (int e = 0; e < 8; ++e) s += x[ks][e] * x[ks][e]; }
      s += __shfl_xor(s, 16); s += __shfl_xor(s, 32);
      const float rs = __builtin_amdgcn_rsqf(s * (1.f / HD) + EPS) * 0.08838834764831845f;
#pragma unroll
      for (int ks = 0; ks < 4; ++ks) { const float* qg = F.in[IN_QN] + l * HD + 32 * ks + 8 * gq; const f32x4 q0 = *(const f32x4*)qg, q1 = *(const f32x4*)(qg + 4);
          u32x4 o; o.x = cvt_pk_bf16(x[ks][0] * rs * q0[0], x[ks][1] * rs * q0[1]); o.y = cvt_pk_bf16(x[ks][2] * rs * q0[2], x[ks][3] * rs * q0[3]);
          o.z = cvt_pk_bf16(x[ks][4] * rs * q1[0], x[ks][5] * rs * q1[1]); o.w = cvt_pk_bf16(x[ks][6] * rs * q1[2], x[ks][7] * rs * q1[3]);
          qf[ks] = __builtin_bit_cast(bf16x8, o); } }
    __syncthreads();
    const int t0 = w < 6 ? w : 6;
    f32x4 sc[10];
#pragma unroll
    for (int kt = 0; kt < 10; ++kt) { sc[kt] = (f32x4){0.f, 0.f, 0.f, 0.f}; const int krow = 16 * (t0 + kt) + fr;
#pragma unroll
        for (int ks = 0; ks < 4; ++ks) { const bf16x8 kf = *(const LAS bf16x8*)(Ks + kimg_off(krow, 4 * ks + gq));
            sc[kt] = __builtin_amdgcn_mfma_f32_16x16x32_bf16(kf, qf[ks], sc[kt], 0, 0, 0); } }
    float mx = -INFINITY;
#pragma unroll
    for (int kt = 0; kt < 10; ++kt)
#pragma unroll
        for (int e = 0; e < 4; ++e) { const int j = 16 * (t0 + kt) + 4 * gq + e, dist = 128 + iq - j; const bool ok = dist >= 0 && dist <= 128 && (nbr > 0 || j >= 128);
            sc[kt][e] = ok ? sc[kt][e] : -INFINITY; mx = fmaxf(mx, sc[kt][e]); }
    mx = fmaxf(mx, __shfl_xor(mx, 16)); mx = fmaxf(mx, __shfl_xor(mx, 32));
    float sum = 0.f;
#pragma unroll
    for (int kt = 0; kt < 10; ++kt)
#pragma unroll
        for (int e = 0; e < 4; ++e) { const float p = fast_exp(sc[kt][e] - mx); sc[kt][e] = p; sum += p; }
    sum += __shfl_xor(sum, 16); sum += __shfl_xor(sum, 32);
    bf16x8 pf[5];
#pragma unroll
    for (int pp = 0; pp < 5; ++pp) { u32x4 o; o.x = cvt_pk_bf16(sc[2 * pp][0], sc[2 * pp][1]); o.y = cvt_pk_bf16(sc[2 * pp][2], sc[2 * pp][3]); o.z = cvt_pk_bf16(sc[2 * pp + 1][0], sc[2 * pp + 1][1]); o.w = cvt_pk_bf16(sc[2 * pp + 1][2], sc[2 * pp + 1][3]);
        pf[pp] = __builtin_bit_cast(bf16x8, o); }
    const float inv = __builtin_amdgcn_rcpf(sum);
    bf16* orow = ATT + ((size_t)g * SEQ + qpos) * 1024 + h * HD + 4 * gq;
#pragma unroll
    for (int dt = 0; dt < 8; ++dt) { f32x4 o = (f32x4){0.f, 0.f, 0.f, 0.f};
#pragma unroll
        for (int pp = 0; pp < 5; ++pp) { const bf16x8 vf = tr_frag(Vs, 16 * (t0 + 2 * pp), 16 * (t0 + 2 * pp + 1), dt, lane);
            o = __builtin_amdgcn_mfma_f32_16x16x32_bf16(vf, pf[pp], o, 0, 0, 0); }
        u32x2 ow; ow.x = cvt_pk_bf16(o[0] * inv, o[1] * inv); ow.y = cvt_pk_bf16(o[2] * inv, o[3] * inv);
        *(u32x2*)(orow + 16 * dt) = ow; }
    if (gq == 0) LSE[((size_t)g * SEQ + qpos) * NHEAD + h] = mx + __logf(sum);
    __syncthreads();
}

__device__ __forceinline__ void att_combine(Frame& F, int l) {
    const bf16* ATT = (const bf16*)(F.ws + WS_ATT); const float* LSE = (const float*)(F.ws + WS_LSE); bf16* MIX = (bf16*)(F.ws + WS_MIX);
    const int gw = F.vcu * NWAVES + F.wave, NGW = F.G * NWAVES, lane = F.lane;
    const float* og = F.in[IN_OUTN] + (size_t)l * DM + 1024 + 16 * lane;
    f32x4 gg[4];
#pragma unroll
    for (int q = 0; q < 4; ++q) gg[q] = *(const f32x4*)(og + 4 * q);
    for (int m = gw; m < SEQ; m += NGW) {
        const int hh = lane >> 3;
        const float l0 = LSE[((size_t)0 * SEQ + m) * NHEAD + hh], l1 = LSE[((size_t)1 * SEQ + m) * NHEAD + hh], l2 = LSE[((size_t)2 * SEQ + m) * NHEAD + hh];
        const float M = fmaxf(l0, fmaxf(l1, l2)); float w0 = fast_exp(l0 - M), w1 = fast_exp(l1 - M), w2 = fast_exp(l2 - M);
        const float iw = __builtin_amdgcn_rcpf(w0 + w1 + w2); w0 *= iw; w1 *= iw; w2 *= iw;
        float y[16]; float s = 0.f;
#pragma unroll
        for (int q = 0; q < 2; ++q) {
            const u32x4 a = *(const u32x4*)(ATT + ((size_t)0 * SEQ + m) * 1024 + 16 * lane + 8 * q), b = *(const u32x4*)(ATT + ((size_t)1 * SEQ + m) * 1024 + 16 * lane + 8 * q), c = *(const u32x4*)(ATT + ((size_t)2 * SEQ + m) * 1024 + 16 * lane + 8 * q);
            const unsigned au[4] = {a.x, a.y, a.z, a.w}, bu[4] = {b.x, b.y, b.z, b.w}, cu[4] = {c.x, c.y, c.z, c.w};
#pragma unroll
            for (int e = 0; e < 4; ++e) { y[8 * q + 2 * e] = w0 * bf_lo(au[e]) + w1 * bf_lo(bu[e]) + w2 * bf_lo(cu[e]); y[8 * q + 2 * e + 1] = w0 * bf_hi(au[e]) + w1 * bf_hi(bu[e]) + w2 * bf_hi(cu[e]); } }
#pragma unroll
        for (int e = 0; e < 16; ++e) s += y[e] * y[e];
        const float rs = __builtin_amdgcn_rsqf(wave_sum(s) * (1.f / 1024.f) + EPS);
#pragma unroll
        for (int q = 0; q < 2; ++q) { u32x4 o;
            o.x = cvt_pk_bf16(y[8 * q + 0] * rs * gg[2 * q][0], y[8 * q + 1] * rs * gg[2 * q][1]); o.y = cvt_pk_bf16(y[8 * q + 2] * rs * gg[2 * q][2], y[8 * q + 3] * rs * gg[2 * q][3]);
            o.z = cvt_pk_bf16(y[8 * q + 4] * rs * gg[2 * q + 1][0], y[8 * q + 5] * rs * gg[2 * q + 1][1]); o.w = cvt_pk_bf16(y[8 * q + 6] * rs * gg[2 * q + 1][2], y[8 * q + 7] * rs * gg[2 * q + 1][3]);
            *(u32x4*)(MIX + (size_t)m * DM + 1024 + 16 * lane + 8 * q) = o; }
    }
}

__device__ __forceinline__ void router_phase(Frame& F, int l) {
    const float* H1 = F.out; bf16* HN = (bf16*)(F.ws + WS_HN);
    const float* WRT = (const float*)(F.ws + WS_WRT) + (size_t)l * 36 * DM;
    unsigned* cnt = (unsigned*)(F.ws + WS_CTL) + CW_CNT + 64 * l;
    int* tok = (int*)(F.ws + WS_TOK); f32x4* tinfo = (f32x4*)(F.ws + WS_TINFO);
    const int lane = F.lane, tid = F.tid;
    const float* g2 = F.in[IN_NORM2] + (size_t)l * DM;
    LAS float* wl = (LAS float*)F.lds;
    for (int rd = (int)blockIdx.x; rd < SEQ / 16; rd += F.G) {
        const int row0 = rd * 16 + F.wave * 2;
        float acc[2][36]; float ss[2] = {0.f, 0.f};
#pragma unroll
        for (int r = 0; r < 2; ++r)
#pragma unroll
            for (int o = 0; o < 36; ++o) acc[r][o] = 0.f;
#pragma unroll 1
        for (int j = 0; j < 8; ++j) {
            __syncthreads();
            for (int q = tid; q < 36 * 64; q += NTHREADS) { const int o = q >> 6, c4 = q & 63; *(LAS f32x4*)(wl + o * 256 + 4 * c4) = *(const f32x4*)(WRT + (size_t)o * DM + 256 * j + 4 * c4); }
            f32x4 x[2];
#pragma unroll
            for (int r = 0; r < 2; ++r) { x[r] = *(const f32x4*)(H1 + (size_t)(row0 + r) * DM + 4 * lane + 256 * j); ss[r] += (x[r][0] * x[r][0] + x[r][1] * x[r][1]) + (x[r][2] * x[r][2] + x[r][3] * x[r][3]); }
            __syncthreads();
#pragma unroll
            for (int o = 0; o < 36; ++o) { const f32x4 wv = *(const LAS f32x4*)(wl + o * 256 + 4 * lane);
#pragma unroll
                for (int r = 0; r < 2; ++r) acc[r][o] += (x[r][0] * wv[0] + x[r][1] * wv[1]) + (x[r][2] * wv[2] + x[r][3] * wv[3]);
                if ((o % 6) == 5) asm volatile("" ::: "memory"); }
        }
#pragma unroll
        for (int r = 0; r < 2; ++r) {
            const float rs = __builtin_amdgcn_rsqf(wave_sum(ss[r]) * (1.f / DM) + EPS);
            bf16* orow = HN + (size_t)(row0 + r) * DM;
#pragma unroll
            for (int j = 0; j < 8; ++j) { const f32x4 gg = *(const f32x4*)(g2 + 4 * lane + 256 * j); const f32x4 xv = *(const f32x4*)(H1 + (size_t)(row0 + r) * DM + 4 * lane + 256 * j);
                u32x2 o; o.x = cvt_pk_bf16(xv[0] * rs * gg[0], xv[1] * rs * gg[1]); o.y = cvt_pk_bf16(xv[2] * rs * gg[2], xv[3] * rs * gg[3]);
                *(u32x2*)(orow + 4 * lane + 256 * j) = o; }
            float lg[4];
#pragma unroll
            for (int o = 0; o < 4; ++o) lg[o] = wave_sum(acc[r][32 + o]) * rs + F.in[IN_BRG][l * 4 + o];
            int gi = 0; float gm = lg[0];
#pragma unroll
            for (int o = 1; o < 4; ++o) if (lg[o] > gm) { gm = lg[o]; gi = o; }
            float den = 0.f;
#pragma unroll
            for (int o = 0; o < 4; ++o) den += __expf(lg[o] - gm);
            const float gate_g = 1.f / den;
            float t1v = -INFINITY, t2v = -INFINITY; int t1i = 0, t2i = 0;
#pragma unroll
            for (int o = 0; o < NE; ++o) { const float v = wave_sum(acc[r][o]) * rs + F.in[IN_BRE][l * NE + o];
                if ((o >> 3) == gi) { const int ii = o & 7;
                    if (v > t1v) { t2v = t1v; t2i = t1i; t1v = v; t1i = ii; }
                    else if (v > t2v) { t2v = v; t2i = ii; } } }
            if (lane == 0) { const int t = row0 + r;
                const float p1 = 1.f / (1.f + __expf(t2v - t1v)), p2 = 1.f - p1;
                const int e0 = gi * 8 + t1i, e1 = gi * 8 + t2i;
                const unsigned s0 = atomicAdd(&cnt[e0], 1u), s1 = atomicAdd(&cnt[e1], 1u);
                tok[(size_t)e0 * TOKCAP + s0] = t; tok[(size_t)e1 * TOKCAP + s1] = t;
                f32x4 ti; ti[0] = __builtin_bit_cast(float, (int)(e0 * TOKCAP + s0)); ti[1] = __builtin_bit_cast(float, (int)(e1 * TOKCAP + s1)); ti[2] = gate_g * p1; ti[3] = gate_g * p2;
                tinfo[t] = ti; }
        }
    }
    __syncthreads();
}
__device__ __forceinline__ void moe_table(Frame& F, int l) {
    const unsigned* cnt = (const unsigned*)(F.ws + WS_CTL) + CW_CNT + 64 * l;
    LAS int* tstart = (LAS int*)(F.lds + MISC_OFF + 64);
    __syncthreads();
    if (F.tid == 0) { int acc = 0; for (int e = 0; e < NE; ++e) { tstart[e] = acc; acc += ((int)cnt[e] + 255) >> 8; } tstart[NE] = acc; }
    __syncthreads();
}
__device__ __forceinline__ void combine_phase(Frame& F, int l) {
    const LAS int* tstart = (const LAS int*)(F.lds + MISC_OFF + 64);
    const bf16* Y = (const bf16*)(F.ws + WS_Y); const f32x4* tinfo = (const f32x4*)(F.ws + WS_TINFO);
    float* H = (float*)(F.ws + WS_H); bf16* HN = (bf16*)(F.ws + WS_HN);
    const int gw = F.vcu * NWAVES + F.wave, NGW = F.G * NWAVES, lane = F.lane;
    const float* g1n = F.in[IN_NORM1] + (size_t)DM;
    for (int m = gw; m < SEQ; m += NGW) {
        const f32x4 ti = tinfo[m];
        const float tf0 = ti[0], tf1 = ti[1]; const int s0 = __builtin_bit_cast(int, tf0), s1 = __builtin_bit_cast(int, tf1);
        const int e0 = s0 >> 14, e1 = s1 >> 14;
        const size_t r0 = (size_t)tstart[e0] * 256 + (s0 & (TOKCAP - 1)), r1 = (size_t)tstart[e1] * 256 + (s1 & (TOKCAP - 1));
        const float ga = ti[2], gb = ti[3];
        const float* xrow = F.out + (size_t)m * DM;
        f32x4 v[8]; float s = 0.f;
#pragma unroll
        for (int j = 0; j < 8; ++j) { v[j] = *(const f32x4*)(xrow + 4 * lane + 256 * j);
            const u32x2 ya = *(const u32x2*)(Y + r0 * DM + 4 * lane + 256 * j), yb = *(const u32x2*)(Y + r1 * DM + 4 * lane + 256 * j);
            v[j][0] += ga * bf_lo(ya.x) + gb * bf_lo(yb.x); v[j][1] += ga * bf_hi(ya.x) + gb * bf_hi(yb.x); v[j][2] += ga * bf_lo(ya.y) + gb * bf_lo(yb.y); v[j][3] += ga * bf_hi(ya.y) + gb * bf_hi(yb.y);
            s += (v[j][0] * v[j][0] + v[j][1] * v[j][1]) + (v[j][2] * v[j][2] + v[j][3] * v[j][3]); }
        if (l == 0) {
            const float rs = __builtin_amdgcn_rsqf(wave_sum(s) * (1.f / DM) + EPS);
            float* hrow = H + (size_t)m * DM; bf16* orow = HN + (size_t)m * DM;
#pragma unroll
            for (int j = 0; j < 8; ++j) { *(f32x4*)(hrow + 4 * lane + 256 * j) = v[j]; const f32x4 gg = *(const f32x4*)(g1n + 4 * lane + 256 * j);
                u32x2 o; o.x = cvt_pk_bf16(v[j][0] * rs * gg[0], v[j][1] * rs * gg[1]); o.y = cvt_pk_bf16(v[j][2] * rs * gg[2], v[j][3] * rs * gg[3]);
                *(u32x2*)(orow + 4 * lane + 256 * j) = o; }
        } else {
            float* orow = F.out + (size_t)m * DM;
#pragma unroll
            for (int j = 0; j < 8; ++j) *(f32x4*)(orow + 4 * lane + 256 * j) = v[j];
        }
    }
}

constexpr int N_PHASES = 17;
#ifndef PHASE_MASK
#define PHASE_MASK 0x1ff
#endif
#ifndef MIX_MASK
#define MIX_MASK 7
#endif
#define IN(k) (lo <= (k) && (k) < hi)
#define EN(b) ((PHASE_MASK >> (b)) & 1)
#define SEAM(k) do { if (IN(k) && IN((k) + 1)) xcd_barrier(bar); } while (0)
template <int l>
__device__ __forceinline__ void layer_phases(Frame& F, const XcdBarrier& bar, const int lo, const int hi) {
    constexpr int pb = 1 + 8 * l;
    if (EN(1) && IN(pb)) {
        pg8::StaticSched S; S.init((const bf16*)(F.ws + WS_HN), (const bf16*)(F.ws + WS_WIN) + (size_t)l * DIN * DM, SEQ, DIN, DM, F.G, (int)blockIdx.x);
        pg8::EpiProj E{(bf16*)(F.ws + WS_PROJ)};
        pg8::gemm_phase<pg8::EpiProj, pg8::StaticSched>(F.lds, DM, S, E);
    }
    SEAM(pb);
    if (EN(2) && IN(pb + 1)) {
        constexpr int N_SGU = 128, N_CONV = 256, N_ATT = 3072;
        if (MIX_MASK & 1) for (int it = (int)blockIdx.x; it < N_ATT; it += F.G) att_item(F, l, it);
        if (MIX_MASK & 2) for (int it = (int)blockIdx.x; it < N_CONV; it += F.G) conv_item(F, l, it);
        if (MIX_MASK & 4) for (int it = (int)blockIdx.x; it < N_SGU; it += F.G) sgu_item(F, l, (it + 64) & 127);
    }
    SEAM(pb + 1);
    if (EN(3) && IN(pb + 2)) att_combine(F, l);
    SEAM(pb + 2);
    if (EN(4) && IN(pb + 3)) {
        pg8::StaticSched S; S.init((const bf16*)(F.ws + WS_MIX), (const bf16*)(F.ws + WS_WOUT) + (size_t)l * DM * DM, SEQ, DM, DM, F.G, (int)blockIdx.x);
        pg8::EpiResid E{l == 0 ? F.in[IN_X] : (const float*)(F.ws + WS_H), F.out};
        pg8::gemm_phase<pg8::EpiResid, pg8::StaticSched>(F.lds, DM, S, E);
    }
    SEAM(pb + 3);
    if (EN(5) && IN(pb + 4)) router_phase(F, l);
    SEAM(pb + 4);
    if (EN(6) && IN(pb + 5)) {
        moe_table(F, l);
        pg8::SchedG1 S{(const LAS int*)(F.lds + MISC_OFF + 64), (const int*)((const unsigned*)(F.ws + WS_CTL) + CW_CNT + 64 * l), (const int*)(F.ws + WS_TOK), (const bf16*)(F.ws + WS_HN),
                       (const bf16*)(F.ws + WS_W1) + (size_t)l * NE * 1024 * DM, F.G, (int)blockIdx.x};
        pg8::EpiSwiGLU E{(bf16*)(F.ws + WS_HB)};
        pg8::gemm_phase<pg8::EpiSwiGLU, pg8::SchedG1>(F.lds, DM, S, E);
    }
    SEAM(pb + 5);
    if (EN(7) && IN(pb + 6)) {
        moe_table(F, l);
        pg8::SchedG2 S{(const LAS int*)(F.lds + MISC_OFF + 64), (const bf16*)(F.ws + WS_HB), (const bf16*)(F.ws + WS_W2) + (size_t)l * NE * DM * DE, F.G, (int)blockIdx.x};
        pg8::EpiY E{(bf16*)(F.ws + WS_Y)};
        pg8::gemm_phase<pg8::EpiY, pg8::SchedG2>(F.lds, DE, S, E);
    }
    SEAM(pb + 6);
    if (EN(8) && IN(pb + 7)) { moe_table(F, l); combine_phase(F, l); }
    SEAM(pb + 7);
}
__global__ void __launch_bounds__(NTHREADS, 2) fwd_kernel(Params args) {
    extern __shared__ __attribute__((aligned(16))) unsigned char lds_raw[];
    Frame F;
    F.lds = (LAS unsigned char*)lds_raw; F.MISC = (volatile LAS unsigned*)(F.lds + MISC_OFF);
    F.tid = threadIdx.x; F.lane = F.tid & 63; F.wave = __builtin_amdgcn_readfirstlane(F.tid >> 6);
    F.G = gridDim.x; { const int bx = blockIdx.x; F.vcu = (F.G % 8 == 0) ? (bx % 8) * (F.G / 8) + bx / 8 : bx; }
    F.in = args.in; F.out = args.out; F.ws = args.ws;
    for (int u = F.tid; u < (LDS_BYTES - MISC_OFF) / 4; u += NTHREADS) ((LAS unsigned*)(F.lds + MISC_OFF))[u] = 0u;
    __syncthreads();
    unsigned* ctl = (unsigned*)(args.ws + WS_CTL);
    const int lo = args.ph_lo, hi = args.ph_hi;
    const bool multi = (hi - lo) > 1;
    XcdBarrier bar; bar.bar = ctl + CW_BAR; bar.x = 0; bar.st = nullptr;
    if (multi) bar = xcd_barrier_post(ctl + CW_BAR, F.MISC);
    if (EN(0) && IN(0)) { p_prologue(F); }
    SEAM(0);
    layer_phases<0>(F, bar, lo, hi);
    layer_phases<1>(F, bar, lo, hi);
}
#undef IN
#undef EN
#undef SEAM

extern "C" void kernel_launch(void* const* d_in, const int* in_sizes, int n_in, void* d_out, int out_size, void* d_ws, size_t ws_size, hipStream_t stream) {
    static int grid = 0;
    if (grid == 0) {
        if (n_in != 22 || out_size != SEQ * DM || ws_size < WS_END) { fprintf(stderr, "kernel_launch: unexpected shapes (n_in %d out %d ws %zu, need %zu)\n", n_in, out_size, ws_size, (size_t)WS_END); grid = -1; return; }
        int dev = 0, cus = 0, per_cu = 0;
        if (hipGetDevice(&dev) != hipSuccess || hipDeviceGetAttribute(&cus, hipDeviceAttributeMultiprocessorCount, dev) != hipSuccess) { grid = -1; return; }
        if (hipFuncSetAttribute((const void*)fwd_kernel, hipFuncAttributeMaxDynamicSharedMemorySize, LDS_BYTES) != hipSuccess) { fprintf(stderr, "kernel_launch: hipFuncSetAttribute failed\n"); grid = -1; return; }
        if (hipOccupancyMaxActiveBlocksPerMultiprocessor(&per_cu, (const void*)fwd_kernel, NTHREADS, LDS_BYTES) != hipSuccess || per_cu < 1) { fprintf(stderr, "kernel_launch: occupancy query says %d\n", per_cu); }
        (void)hipGetLastError();
        grid = cus;
    }
    if (grid < 0) return;
    if (hipMemsetAsync((char*)d_ws + WS_CTL, 0, CTL_ZERO_BYTES, stream) != hipSuccess) return;
    Params p{};
    for (int i = 0; i < 22; ++i) p.in[i] = (const float*)d_in[i];
    p.out = (float*)d_out; p.ws = (unsigned char*)d_ws;
    constexpr int NL = MK_N_LAUNCHES;
    for (int li = 0; li < NL; ++li) {
        p.ph_lo = (NL == 1) ? 0 : li; p.ph_hi = (NL == 1) ? N_PHASES : li + 1;
        hipLaunchKernelGGL(fwd_kernel, dim3(grid), dim3(NTHREADS), LDS_BYTES, stream, p);
        if (hipPeekAtLastError() != hipSuccess) { fprintf(stderr, "kernel_launch: launch %d failed\n", li); break; }
    }
}
```

```cpp
#include <hip/hip_runtime.h>
#include <cstdio>
#include <cstdint>

#ifndef MK_N_LAUNCHES
#define MK_N_LAUNCHES 1
#endif

#ifndef ATT_EXP
#define ATT_EXP 0
#endif
#define GAS __attribute__((address_space(1)))
#define LAS __attribute__((address_space(3)))
typedef unsigned short bf16;
typedef short bf16x8 __attribute__((ext_vector_type(8)));
typedef short s16x4 __attribute__((ext_vector_type(4)));
typedef float f32x4 __attribute__((ext_vector_type(4)));
typedef float f32x2 __attribute__((ext_vector_type(2)));
typedef unsigned u32x4 __attribute__((ext_vector_type(4)));
typedef unsigned u32x2 __attribute__((ext_vector_type(2)));

constexpr int SEQ = 16384, DM = 2048, DIN = 5120, NLAYER = 2;
constexpr int HD = 128, NHEAD = 8, CONV_K = 31;
constexpr int NE = 32, DE = 512, TOKCAP = 16384;
constexpr int OFF_U = 0, OFF_V = 512, OFF_A = 1024, OFF_G = 1536, OFF_Q = 2048, OFF_K = 3072, OFF_VV = 4096;
constexpr float EPS = 1e-6f;
constexpr int NWAVES = 8, NTHREADS = 512;

constexpr size_t MiB = 1u << 20;
constexpr size_t WS_CTL = 0, CTL_ZERO_BYTES = 1 * MiB;
constexpr size_t WS_WIN = 1 * MiB;
constexpr size_t WS_WOUT = 41 * MiB;
constexpr size_t WS_W1 = 57 * MiB;
constexpr size_t WS_W2 = 313 * MiB;
constexpr size_t WS_SGUW = 441 * MiB;
constexpr size_t WS_WRT = 442 * MiB;
constexpr size_t WS_TOK = 443 * MiB;
constexpr size_t WS_TINFO = 445 * MiB;
constexpr size_t WS_HN = 446 * MiB;
constexpr size_t WS_HB = 510 * MiB;
constexpr size_t WS_ATT = WS_HN;
constexpr size_t WS_LSE = WS_HN + 96 * MiB;
constexpr size_t WS_PROJ = 550 * MiB;
constexpr size_t WS_Y = WS_PROJ;
constexpr size_t WS_MIX = 710 * MiB;
constexpr size_t WS_H = 774 * MiB;
constexpr size_t WS_RSLOT = 902 * MiB;
constexpr size_t WS_ALT = 904 * MiB;
constexpr size_t WS_END = 910 * MiB;
constexpr int CW_BAR = 4096;
constexpr int CW_CNT = 16384, CNT_STRIDE = 64;

constexpr int LDS_BYTES = 163840;
constexpr int MISC_OFF = 159744;

__device__ __forceinline__ unsigned cvt_pk_bf16(float lo, float hi) { unsigned r; asm volatile("v_cvt_pk_bf16_f32 %0, %1, %2" : "=v"(r) : "v"(lo), "v"(hi)); return r; }
__device__ __forceinline__ float bf_lo(unsigned u) { return __builtin_bit_cast(float, u << 16); }
__device__ __forceinline__ float bf_hi(unsigned u) { return __builtin_bit_cast(float, u & 0xffff0000u); }
template <int CTRL, int RM> __device__ __forceinline__ float dpp_mov0(float v) { return __builtin_bit_cast(float, __builtin_amdgcn_update_dpp(0, __builtin_bit_cast(int, v), CTRL, RM, 0xf, false)); }
__device__ __forceinline__ float wave_sum(float s) {
    s += dpp_mov0<0xB1, 0xf>(s); s += dpp_mov0<0x4E, 0xf>(s); s += dpp_mov0<0x141, 0xf>(s); s += dpp_mov0<0x140, 0xf>(s);
    s += dpp_mov0<0x142, 0xa>(s); s += dpp_mov0<0x143, 0xc>(s);
    return __builtin_bit_cast(float, __builtin_amdgcn_readlane(__builtin_bit_cast(int, s), 63));
}
__device__ __forceinline__ float row16_sum(float s) {
    s += dpp_mov0<0xB1, 0xf>(s); s += dpp_mov0<0x4E, 0xf>(s); s += dpp_mov0<0x141, 0xf>(s); s += dpp_mov0<0x140, 0xf>(s); return s;
}
#define LDS_WAIT() asm volatile("s_waitcnt lgkmcnt(0)" ::: "memory")
#define VM_WAIT() asm volatile("s_waitcnt vmcnt(0)" ::: "memory")
__device__ __forceinline__ float fast_exp(float x) { return __builtin_amdgcn_exp2f(x * 1.4426950408889634f); }
__device__ __forceinline__ float sigmoidf_(float x) { return __builtin_amdgcn_rcpf(1.0f + fast_exp(-x)); }
__device__ __forceinline__ float gelu_tanh(float x) { const float z = 1.5957691216057308f * (x + 0.044715f * x * x * x); return x * sigmoidf_(z); }

#define XB_TMO      128
#define XB_XCNT(j)  (256  + 64 * (j))
#define XB_XSUB(j)  (1280 + 64 * (j))
#define XB_XGEN(j)  (2304 + 64 * (j))
#define XB_TOP      3328
#define XB_TOPGEN   3392
#define XCD_BAR_WORDS 3456
#define XB_SPIN_CAP (1u << 22)
__device__ __forceinline__ unsigned xb_ld(unsigned* p)              { return __hip_atomic_load(p, __ATOMIC_RELAXED, __HIP_MEMORY_SCOPE_AGENT); }
__device__ __forceinline__ unsigned xb_add(unsigned* p, unsigned v) { return __hip_atomic_fetch_add(p, v, __ATOMIC_RELAXED, __HIP_MEMORY_SCOPE_AGENT); }
__device__ __forceinline__ unsigned xb_xcc_id() { return (unsigned)__builtin_amdgcn_s_getreg((3 << 11) | 20) & 0xFu; }
#define XB_SPIN(cond, bar) do { unsigned _sp = 0; while (cond) { __builtin_amdgcn_s_sleep(1); \
    if ((++_sp & 255u) == 0u) { if (xb_ld(&(bar)[XB_TMO])) break; if (_sp > XB_SPIN_CAP) { atomicAdd(&(bar)[XB_TMO], 1u); break; } } } } while (0)
struct XcdBarrier { unsigned* bar; unsigned x; volatile LAS unsigned* st; };
__device__ __forceinline__ XcdBarrier xcd_barrier_post(unsigned* bar, volatile LAS unsigned* st) {
    XcdBarrier b; b.bar = bar; b.x = xb_xcc_id(); b.st = st;
    if (threadIdx.x == 0) (void)xb_add(&bar[XB_XCNT(b.x)], 1u);
    return b;
}
__device__ __forceinline__ void xcd_barrier_complete(unsigned* bar, unsigned x, unsigned& nloc, unsigned& nx) {
    const unsigned G = gridDim.x * gridDim.y * gridDim.z;
    unsigned sum, cnt, mine, sp = 0u;
    for (;;) {
        sum = 0u; cnt = 0u; mine = 0u;
#pragma unroll
        for (unsigned j = 0; j < 16; ++j) { const unsigned c = xb_ld(&bar[XB_XCNT(j)]); sum += c; cnt += (c > 0u) ? 1u : 0u; mine = (j == x) ? c : mine; }
        if (sum == G) break;
        __builtin_amdgcn_s_sleep(1);
        if ((++sp & 255u) == 0u) { if (xb_ld(&bar[XB_TMO])) break; if (sp > XB_SPIN_CAP) { atomicAdd(&bar[XB_TMO], 1u); break; } }
    }
    nloc = mine > 0u ? mine : 1u; nx = cnt > 0u ? cnt : 1u;
}
__device__ __forceinline__ void xcd_barrier(const XcdBarrier& b) {
    asm volatile("s_waitcnt vmcnt(0)" ::: "memory");
    __syncthreads();
    if (threadIdx.x == 0) {
        unsigned* bar = b.bar;
        __builtin_amdgcn_s_waitcnt(0);
        unsigned nloc = b.st[0], nx = b.st[1];
        if (nloc == 0u) { xcd_barrier_complete(bar, b.x, nloc, nx); b.st[0] = nloc; b.st[1] = nx; }
        const unsigned old = xb_add(&bar[XB_XSUB(b.x)], 1u);
        const unsigned gen = old / nloc;
        if (old + 1u == (gen + 1u) * nloc) {
            __builtin_amdgcn_fence(__ATOMIC_RELEASE, "agent");
            asm volatile("s_waitcnt vmcnt(0)" ::: "memory");
            const unsigned og = xb_add(&bar[XB_TOP], 1u);
            const unsigned tg = og / nx;
            if (og + 1u == (tg + 1u) * nx) xb_add(&bar[XB_TOPGEN], 1u);
            else XB_SPIN(xb_ld(&bar[XB_TOPGEN]) == tg, bar);
            __builtin_amdgcn_fence(__ATOMIC_ACQUIRE, "agent");
            xb_add(&bar[XB_XGEN(b.x)], 1u);
            asm volatile("s_waitcnt vmcnt(0)" ::: "memory");
        } else {
            XB_SPIN(xb_ld(&bar[XB_XGEN(b.x)]) == gen, bar);
            __builtin_amdgcn_fence(__ATOMIC_ACQUIRE, "agent");
            asm volatile("s_waitcnt vmcnt(0)" ::: "memory");
        }
    }
    __syncthreads();
}

namespace pg8 {
constexpr int BM = 256, BK = 64, HALF = 128, HTB = HALF * BK * 2, STAGE_BYTES = 8 * HTB, NXCD = 8, WGM = 8;
__device__ __forceinline__ int lds_byte(int r, int c) { const int st = (r >> 4) * 2 + (c >> 5), rr = r & 15, cc = c & 31, ob = rr * 64 + cc * 2; return st * 1024 + (ob ^ (((ob >> 9) & 1) << 5)); }
__device__ __forceinline__ void stage_rc(int b, int& R, int& C) { const int st = b / 1024, sb = b % 1024, swz = sb ^ (((sb >> 9) & 1) << 5); R = (st >> 1) * 16 + swz / 64; C = (st & 1) * 32 + (swz % 64) / 2; }
__device__ __forceinline__ int perm32(int rho) { const int n = rho >> 4, i = rho & 15; return 8 * (i >> 2) + 4 * n + (i & 3); }

struct Unit { int pm, pn, e, rb; };

struct StaticSched {
    static constexpr bool GATHER = false;
    const bf16* A; const bf16* Bt; int K; int nM, nN, nwg, G, c;
    __device__ __forceinline__ void init(const bf16* A_, const bf16* Bt_, int M, int N, int K_, int G_, int c_) { A = A_; Bt = Bt_; K = K_; nM = M / BM; nN = N / BM; nwg = nM * nN; G = G_; c = c_; }
    __device__ __forceinline__ bool next(int i, Unit& u) const {
        const long L = (long)i * G + c; if (L >= nwg) return false;
        int wgid = (int)L; { const int q = nwg / NXCD, r = nwg % NXCD, xcd = wgid % NXCD, off = wgid / NXCD; wgid = (xcd < r ? xcd * (q + 1) : r * (q + 1) + (xcd - r) * q) + off; }
        const int nig = WGM * nN, gid = wgid / nig, fm = gid * WGM, gsz = (nM - fm) < WGM ? (nM - fm) : WGM;
        u.pm = fm + ((wgid % nig) % gsz); u.pn = (wgid % nig) / gsz; u.e = 0; u.rb = 0; return true;
    }
    __device__ __forceinline__ const char* a_base(const Unit& u) const { return (const char*)A + (size_t)u.pm * BM * K * 2; }
    __device__ __forceinline__ const char* b_base(const Unit& u) const { return (const char*)Bt + (size_t)u.pn * BM * K * 2; }
    __device__ __forceinline__ void a_voff(const Unit&, const int (&R)[2], const int (&C)[2], unsigned (&v)[2][2]) const {
#pragma unroll
        for (int h = 0; h < 2; ++h)
#pragma unroll
            for (int i = 0; i < 2; ++i) v[h][i] = (unsigned)((h * HALF + R[i]) * K + C[i]) * 2u;
    }
};

template <class Epi, class Sched, bool ALIGN_EPI = true>
__device__ __forceinline__ void gemm_phase(LAS unsigned char* lds, const int K, const Sched& S, const Epi& E) {
    const int tid = threadIdx.x, wid = __builtin_amdgcn_readfirstlane(tid >> 6), lane = tid & 63, wr = wid >> 2, wc = wid & 3, fr = lane & 15, fq = lane >> 4;
    const int nt = K / BK;
    int Rr[2], Cc[2]; unsigned voffB[2];
#pragma unroll
    for (int i = 0; i < 2; ++i) { stage_rc(tid * 16 + i * 8192, Rr[i], Cc[i]); const int Rb = Epi::PERM ? ((Rr[i] & ~31) + perm32(Rr[i] & 31)) : Rr[i];
        voffB[i] = (unsigned)(Rb * K + Cc[i]) * 2u; }
    const size_t kstep = (size_t)(BK * 2);
    const size_t hstep = (size_t)HALF * K * 2;
    const unsigned ldsw = (unsigned)wid * 1024u;
    const int aoff = lds_byte(wr * 64 + fr, fq * 8), boff = lds_byte(wc * 32 + fr, fq * 8);
#define PG8_SA(b, h) (((b) * 2 + (h)) * HTB)
#define PG8_SB(b, h) ((4 + (b) * 2 + (h)) * HTB)
#define PG8_STAGE(bufoff, gbase, voff) do { _Pragma("unroll") for (int _i = 0; _i < 2; ++_i) \
        __builtin_amdgcn_global_load_lds((const unsigned*)((const char*)(gbase) + (voff)[_i]), (LAS unsigned*)(lds + (bufoff) + ldsw + _i * 8192), 16, 0, 0); } while (0)
#define PG8_LDA(dst, b, h) do { _Pragma("unroll") for (int m = 0; m < 4; ++m) _Pragma("unroll") for (int k = 0; k < 2; ++k) dst[m][k] = *(const LAS bf16x8*)(lds + PG8_SA(b, h) + aoff + m * 2048 + k * 1024); } while (0)
#define PG8_LDB(dst, b, h) do { _Pragma("unroll") for (int n = 0; n < 2; ++n) _Pragma("unroll") for (int k = 0; k < 2; ++k) dst[n][k] = *(const LAS bf16x8*)(lds + PG8_SB(b, h) + boff + n * 2048 + k * 1024); } while (0)
#define PG8_MMA(ai, bj, At, Bt) do { __builtin_amdgcn_s_setprio(1); _Pragma("unroll") for (int m = 0; m < 4; ++m) _Pragma("unroll") for (int n = 0; n < 2; ++n) _Pragma("unroll") for (int k = 0; k < 2; ++k) \
        acc[ai][bj][m][n] = __builtin_amdgcn_mfma_f32_16x16x32_bf16(Bt[n][k], At[m][k], acc[ai][bj][m][n], 0, 0, 0); __builtin_amdgcn_s_setprio(0); } while (0)
#define PG8_WAIT_V(n) asm volatile("s_waitcnt vmcnt(" #n ")" ::: "memory")
#define PG8_WAIT_L(n) asm volatile("s_waitcnt lgkmcnt(" #n ")" ::: "memory")
#define PG8_BAR __builtin_amdgcn_s_barrier()
#define PG8_SCHED __builtin_amdgcn_sched_barrier(0)
    Unit cur, nxt; int ui = 0;
    if (!S.next(0, cur)) return;
    f32x4 acc[2][2][4][2];
#pragma unroll
    for (int a = 0; a < 2; ++a)
#pragma unroll
        for (int b = 0; b < 2; ++b)
#pragma unroll
            for (int m = 0; m < 4; ++m)
#pragma unroll
                for (int n = 0; n < 2; ++n) acc[a][b][m][n] = (f32x4){0.f, 0.f, 0.f, 0.f};
    bf16x8 At[4][2], B0[2][2], B1[2][2];
    const char* cA = S.a_base(cur); const char* cB = S.b_base(cur);
    constexpr bool GATHER = Sched::GATHER;
    constexpr int NV = GATHER ? 2 : 1;
    unsigned vA[NV][2], nvA[NV][2];
    if constexpr (GATHER) S.a_voff(cur, Rr, Cc, vA);
    else {
#pragma unroll
        for (int i = 0; i < 2; ++i) vA[0][i] = (unsigned)(Rr[i] * K + Cc[i]) * 2u; }
    const size_t ahstep = GATHER ? 0 : hstep;
#define PG8_STAGE_A(bufoff, kptr, h, vv) PG8_STAGE(bufoff, (kptr) + (h) * ahstep, (vv)[GATHER ? (h) : 0])
    PG8_STAGE(PG8_SB(0, 0), cB, voffB); PG8_STAGE(PG8_SB(0, 1), cB + hstep, voffB); PG8_STAGE_A(PG8_SA(0, 0), cA, 0, vA); PG8_STAGE_A(PG8_SA(0, 1), cA, 1, vA);
    if (wr == 1) PG8_BAR;
    PG8_WAIT_V(2); PG8_BAR;
    PG8_STAGE(PG8_SB(1, 0), cB + kstep, voffB); PG8_STAGE_A(PG8_SA(1, 0), cA + kstep, 0, vA); PG8_STAGE(PG8_SB(1, 1), cB + hstep + kstep, voffB);
    PG8_WAIT_V(6); PG8_BAR;
    for (;;) {
        const bool has_next = S.next(ui + 1, nxt);
        const char* nA = has_next ? S.a_base(nxt) : cA; const char* nB = has_next ? S.b_base(nxt) : cB;
        if constexpr (GATHER) {
            if (has_next) S.a_voff(nxt, Rr, Cc, nvA);
            else { nvA[0][0] = vA[0][0]; nvA[0][1] = vA[0][1]; nvA[NV - 1][0] = vA[NV - 1][0]; nvA[NV - 1][1] = vA[NV - 1][1]; }
        }
        for (int t = 0; t < nt; t += 2) {
            const bool last = (t == nt - 2);
            const char* a1 = cA + (size_t)(t + 1) * kstep;
            const char* a2 = last ? nA : cA + (size_t)(t + 2) * kstep; const char* b2 = last ? nB : cB + (size_t)(t + 2) * kstep;
            const char* a3 = a2 + kstep; const char* b3 = b2 + kstep;
            unsigned wA[NV][2];
            if constexpr (GATHER) { wA[0][0] = last ? nvA[0][0] : vA[0][0]; wA[0][1] = last ? nvA[0][1] : vA[0][1]; wA[NV - 1][0] = last ? nvA[NV - 1][0] : vA[NV - 1][0]; wA[NV - 1][1] = last ? nvA[NV - 1][1] : vA[NV - 1][1]; }
            else { wA[0][0] = vA[0][0]; wA[0][1] = vA[0][1]; }
            PG8_LDB(B0, 0, 0); PG8_LDB(B1, 0, 1); PG8_SCHED; PG8_LDA(At, 0, 0); PG8_STAGE_A(PG8_SA(1, 1), a1, 1, vA);
            PG8_WAIT_V(8); PG8_WAIT_L(0); PG8_BAR; PG8_MMA(0, 0, At, B0); PG8_MMA(0, 1, At, B1); PG8_BAR; PG8_SCHED;
            PG8_LDA(At, 0, 1); PG8_STAGE(PG8_SB(0, 0), b2, voffB); PG8_STAGE(PG8_SB(0, 1), b2 + hstep, voffB); PG8_STAGE_A(PG8_SA(0, 0), a2, 0, wA);
            PG8_WAIT_V(8); PG8_WAIT_L(0); PG8_BAR; PG8_MMA(1, 0, At, B0); PG8_MMA(1, 1, At, B1); PG8_BAR; PG8_SCHED;
            PG8_LDB(B0, 1, 0); PG8_LDB(B1, 1, 1); PG8_SCHED; PG8_LDA(At, 1, 0); PG8_STAGE_A(PG8_SA(0, 1), a2, 1, wA);
            PG8_WAIT_V(8); PG8_WAIT_L(0); PG8_BAR; PG8_MMA(0, 0, At, B0); PG8_MMA(0, 1, At, B1); PG8_BAR; PG8_SCHED;
            PG8_LDA(At, 1, 1); PG8_STAGE(PG8_SB(1, 0), b3, voffB); PG8_STAGE(PG8_SB(1, 1), b3 + hstep, voffB); PG8_STAGE_A(PG8_SA(1, 0), a3, 0, wA);
            PG8_WAIT_V(8); PG8_WAIT_L(0); PG8_BAR; PG8_MMA(1, 0, At, B0); PG8_MMA(1, 1, At, B1); PG8_BAR; PG8_SCHED;
        }
        if constexpr (ALIGN_EPI) { if (wr == 0) PG8_BAR; }
        E(acc, cur, wr, wc, fr, fq);
        if (!has_next) break;
#pragma unroll
        for (int a = 0; a < 2; ++a)
#pragma unroll
            for (int b = 0; b < 2; ++b)
#pragma unroll
                for (int m = 0; m < 4; ++m)
#pragma unroll
                    for (int n = 0; n < 2; ++n) acc[a][b][m][n] = (f32x4){0.f, 0.f, 0.f, 0.f};
        cur = nxt; cA = nA; cB = nB; ++ui;
        if constexpr (GATHER) { vA[0][0] = nvA[0][0]; vA[0][1] = nvA[0][1]; vA[NV - 1][0] = nvA[NV - 1][0]; vA[NV - 1][1] = nvA[NV - 1][1]; }
        if constexpr (ALIGN_EPI) { if (wr == 1) PG8_BAR; }
    }
    PG8_WAIT_V(0);
    if constexpr (!ALIGN_EPI) { if (wr == 0) PG8_BAR; }
    PG8_BAR;
#undef PG8_SA
#undef PG8_SB
#undef PG8_STAGE
#undef PG8_STAGE_A
#undef PG8_LDA
#undef PG8_LDB
#undef PG8_MMA
#undef PG8_WAIT_V
#undef PG8_WAIT_L
#undef PG8_BAR
#undef PG8_SCHED
}

struct EpiProj {
    static constexpr bool PERM = true;
    bf16* O;
    __device__ __forceinline__ void operator()(const f32x4 (&acc)[2][2][4][2], const Unit& u, int wr, int wc, int fr, int fq) const {
        const int row0 = u.pm * BM + wr * 64 + fr, col0 = u.pn * BM + wc * 32 + 8 * fq;
        const bool act = u.pn < 4;
#pragma unroll
        for (int ai = 0; ai < 2; ++ai)
#pragma unroll
            for (int m = 0; m < 4; ++m) { bf16* rowp = O + (size_t)(row0 + ai * HALF + m * 16) * DIN + col0;
#pragma unroll
                for (int bj = 0; bj < 2; ++bj) { f32x4 v0 = acc[ai][bj][m][0], v1 = acc[ai][bj][m][1];
                    if (act) {
#pragma unroll
                        for (int j = 0; j < 4; ++j) { v0[j] = gelu_tanh(v0[j]); v1[j] = gelu_tanh(v1[j]); } }
                    u32x4 w; w.x = cvt_pk_bf16(v0[0], v0[1]); w.y = cvt_pk_bf16(v0[2], v0[3]); w.z = cvt_pk_bf16(v1[0], v1[1]); w.w = cvt_pk_bf16(v1[2], v1[3]);
                    *(u32x4*)(rowp + bj * HALF) = w; } }
    }
};
template <bool RES_BF16> struct EpiResid {
    static constexpr bool PERM = true;
    const void* res; bf16* out;
    __device__ __forceinline__ void operator()(const f32x4 (&acc)[2][2][4][2], const Unit& u, int wr, int wc, int fr, int fq) const {
        const int row0 = u.pm * BM + wr * 64 + fr, col0 = u.pn * BM + wc * 32 + 8 * fq;
#pragma unroll
        for (int ai = 0; ai < 2; ++ai)
#pragma unroll
            for (int m = 0; m < 4; ++m) { const size_t off = (size_t)(row0 + ai * HALF + m * 16) * DM + col0;
#pragma unroll
                for (int bj = 0; bj < 2; ++bj) { f32x4 v0 = acc[ai][bj][m][0], v1 = acc[ai][bj][m][1];
                    if (RES_BF16) { const u32x4 r = *(const u32x4*)((const bf16*)res + off + bj * HALF);
                        v0[0] += bf_lo(r.x); v0[1] += bf_hi(r.x); v0[2] += bf_lo(r.y); v0[3] += bf_hi(r.y); v1[0] += bf_lo(r.z); v1[1] += bf_hi(r.z); v1[2] += bf_lo(r.w); v1[3] += bf_hi(r.w); }
                    else { const f32x4 r0 = *(const f32x4*)((const float*)res + off + bj * HALF), r1 = *(const f32x4*)((const float*)res + off + bj * HALF + 4); v0 = v0 + r0; v1 = v1 + r1; }
                    u32x4 w; w.x = cvt_pk_bf16(v0[0], v0[1]); w.y = cvt_pk_bf16(v0[2], v0[3]); w.z = cvt_pk_bf16(v1[0], v1[1]); w.w = cvt_pk_bf16(v1[2], v1[3]);
                    *(u32x4*)(out + off + bj * HALF) = w; } }
    }
};
struct EpiSwiGLU {
    static constexpr bool PERM = true;
    bf16* HB; const float* rslot;
    __device__ __forceinline__ void operator()(const f32x4 (&acc)[2][2][4][2], const Unit& u, int wr, int wc, int fr, int fq) const {
        const int row0 = u.pm * BM + wr * 64 + fr, col0 = u.pn * HALF + wc * 32 + 8 * fq;
        const float* rsl = rslot + (size_t)u.e * TOKCAP + u.rb * BM + wr * 64 + fr;
#pragma unroll
        for (int ai = 0; ai < 2; ++ai)
#pragma unroll
            for (int m = 0; m < 4; ++m) { bf16* rowp = HB + (size_t)(row0 + ai * HALF + m * 16) * DE + col0;
                const float rs = rsl[ai * HALF + m * 16];
                float h[8];
#pragma unroll
                for (int n = 0; n < 2; ++n)
#pragma unroll
                    for (int j = 0; j < 4; ++j) { const float g = acc[ai][0][m][n][j] * rs, up = acc[ai][1][m][n][j] * rs; h[n * 4 + j] = g * sigmoidf_(g) * up; }
                u32x4 w; w.x = cvt_pk_bf16(h[0], h[1]); w.y = cvt_pk_bf16(h[2], h[3]); w.z = cvt_pk_bf16(h[4], h[5]); w.w = cvt_pk_bf16(h[6], h[7]);
                *(u32x4*)rowp = w; }
    }
};
struct EpiY {
    static constexpr bool PERM = true;
    bf16* Y;
    __device__ __forceinline__ void operator()(const f32x4 (&acc)[2][2][4][2], const Unit& u, int wr, int wc, int fr, int fq) const {
        const int row0 = u.pm * BM + wr * 64 + fr, col0 = u.pn * BM + wc * 32 + 8 * fq;
#pragma unroll
        for (int ai = 0; ai < 2; ++ai)
#pragma unroll
            for (int m = 0; m < 4; ++m) { bf16* rowp = Y + (size_t)(row0 + ai * HALF + m * 16) * DM + col0;
#pragma unroll
                for (int bj = 0; bj < 2; ++bj) { const f32x4 v0 = acc[ai][bj][m][0], v1 = acc[ai][bj][m][1];
                    u32x4 w; w.x = cvt_pk_bf16(v0[0], v0[1]); w.y = cvt_pk_bf16(v0[2], v0[3]); w.z = cvt_pk_bf16(v1[0], v1[1]); w.w = cvt_pk_bf16(v1[2], v1[3]);
                    *(u32x4*)(rowp + bj * HALF) = w; } }
    }
};

struct SchedG1 {
    static constexpr bool GATHER = true;
    const LAS int* tstart; const int* cnt; const int* tok; const bf16* X; const bf16* W1; int G, c;
    __device__ __forceinline__ bool next(int i, Unit& u) const {
        const int L = i * G + c, NT = tstart[NE]; if (L >= NT * 4) return false;
        const int T = L >> 2; int e = 0;
        for (int j = 1; j < NE; ++j) e = (tstart[j] <= T) ? j : e;
        u.pm = T; u.pn = L & 3; u.e = e; u.rb = T - tstart[e]; return true;
    }
    __device__ __forceinline__ const char* a_base(const Unit&) const { return (const char*)X; }
    __device__ __forceinline__ const char* b_base(const Unit& u) const { return (const char*)(W1 + ((size_t)u.e * 1024 + (size_t)u.pn * BM) * DM); }
    __device__ __forceinline__ void a_voff(const Unit& u, const int (&R)[2], const int (&C)[2], unsigned (&v)[2][2]) const {
        const int n = cnt[u.e * 64]; const int* tl = tok + (size_t)u.e * TOKCAP;
#pragma unroll
        for (int h = 0; h < 2; ++h)
#pragma unroll
            for (int i = 0; i < 2; ++i) { int row = u.rb * BM + h * HALF + R[i]; row = row < n ? row : 0; const int t = tl[row]; v[h][i] = (unsigned)(t * DM + C[i]) * 2u; }
    }
};
struct SchedG2 {
    static constexpr bool GATHER = false;
    const LAS int* tstart; const bf16* HB; const bf16* W2; int G, c;
    __device__ __forceinline__ bool next(int i, Unit& u) const {
        const int L = i * G + c, NT = tstart[NE]; if (L >= NT * 8) return false;
        const int T = L >> 3; int e = 0;
        for (int j = 1; j < NE; ++j) e = (tstart[j] <= T) ? j : e;
        u.pm = T; u.pn = L & 7; u.e = e; u.rb = T - tstart[e]; return true;
    }
    __device__ __forceinline__ const char* a_base(const Unit& u) const { return (const char*)(HB + (size_t)u.pm * BM * DE); }
    __device__ __forceinline__ const char* b_base(const Unit& u) const { return (const char*)(W2 + ((size_t)u.e * DM + (size_t)u.pn * BM) * DE); }
    __device__ __forceinline__ void a_voff(const Unit&, const int (&R)[2], const int (&C)[2], unsigned (&v)[2][2]) const {
#pragma unroll
        for (int h = 0; h < 2; ++h)
#pragma unroll
            for (int i = 0; i < 2; ++i) v[h][i] = (unsigned)((h * HALF + R[i]) * DE + C[i]) * 2u;
    }
};
}

struct Params { const float* in[22]; float* out; unsigned char* ws; int ph_lo, ph_hi; };
enum { IN_X = 0, IN_NORM1, IN_WIN, IN_SGUN, IN_SGUW, IN_SGUB, IN_CONVW, IN_CONVB, IN_LNG, IN_LNB, IN_QN, IN_KN, IN_OUTN, IN_WOUT, IN_NORM2, IN_WRG, IN_BRG, IN_WRE, IN_BRE, IN_WG, IN_WU, IN_WD };

struct Frame {
    LAS unsigned char* lds; volatile LAS unsigned* MISC;
    int tid, lane, wave, vcu, G;
    const float* const* in; float* out; unsigned char* ws;
};

__device__ __forceinline__ void tile_desc(const float* const* in, unsigned char* ws, int it, const float*& src, int& ldw, bf16*& dst, int& K, const float*& ksc) {
    bf16* WIN = (bf16*)(ws + WS_WIN); bf16* WOUT = (bf16*)(ws + WS_WOUT); bf16* W1 = (bf16*)(ws + WS_W1); bf16* W2 = (bf16*)(ws + WS_W2);
    constexpr int T_IN = 32 * 80, T_OUT = 32 * 32, T_E = 32 * 8, T_D = 8 * 32;
    constexpr int T_LAYER = T_IN + T_OUT + NE * (2 * T_E + T_D);
    const int l = it / T_LAYER; int r = it % T_LAYER; ksc = nullptr;
    if (r < T_IN) { const int kb = r / 80, nb = r % 80; ldw = DIN; K = DM; src = in[IN_WIN] + (size_t)l * DM * DIN + (size_t)(64 * kb) * DIN + 64 * nb; dst = WIN + (size_t)l * DIN * DM + (size_t)(64 * nb) * DM + 64 * kb; return; } r -= T_IN;
    if (r < T_OUT) { const int kb = r / 32, nb = r % 32; ldw = DM; K = DM; src = in[IN_WOUT] + (size_t)l * DM * DM + (size_t)(64 * kb) * DM + 64 * nb; dst = WOUT + (size_t)l * DM * DM + (size_t)(64 * nb) * DM + 64 * kb; return; } r -= T_OUT;
    const int e = r / (2 * T_E + T_D); r %= (2 * T_E + T_D);
    const size_t le = (size_t)l * NE + e;
    if (r < 2 * T_E) { const int up = r >= T_E; r -= up * T_E; const int kb = r / 8, nb = r % 8, n0 = 64 * nb; ldw = DE; K = DM;
        src = (up ? in[IN_WU] : in[IN_WG]) + le * DM * DE + (size_t)(64 * kb) * DE + n0; dst = W1 + le * 1024 * DM + (size_t)((n0 / 128) * 256 + up * 128 + (n0 % 128)) * DM + 64 * kb; ksc = in[IN_NORM2] + (size_t)l * DM + 64 * kb; return; }
    r -= 2 * T_E;
    { const int kb = r / 32, nb = r % 32; ldw = DM; K = DE; src = in[IN_WD] + le * DE * DM + (size_t)(64 * kb) * DM + 64 * nb; dst = W2 + le * DM * DE + (size_t)(64 * nb) * DE + 64 * kb; }
}
#define TR_LOAD(V, src, ldw) do { _Pragma("unroll") for (int i = 0; i < 16; ++i) V[i] = __builtin_nontemporal_load((const f32x4*)((src) + (size_t)(4 * i + (lane >> 4)) * (ldw) + 4 * (lane & 15))); } while (0)
#define TR_PROC(V, dst, K, ksc) do { \
    _Pragma("unroll") for (int i = 0; i < 16; ++i) { const int kk = 4 * i + (lane >> 4); f32x4 v = V[i]; if (ksc) v = v * (ksc)[kk]; \
        LAS float* d = scr + kk * 65 + 4 * (lane & 15); d[0] = v[0]; d[1] = v[1]; d[2] = v[2]; d[3] = v[3]; } \
    LDS_WAIT(); \
    _Pragma("unroll") for (int j = 0; j < 8; ++j) { const int n = (lane >> 3) + 8 * j; const LAS float* sp = scr + (8 * (lane & 7)) * 65 + n; \
        u32x4 o; o.x = cvt_pk_bf16(sp[0], sp[65]); o.y = cvt_pk_bf16(sp[2 * 65], sp[3 * 65]); o.z = cvt_pk_bf16(sp[4 * 65], sp[5 * 65]); o.w = cvt_pk_bf16(sp[6 * 65], sp[7 * 65]); \
        *(u32x4*)((dst) + (size_t)n * (K) + 8 * (lane & 7)) = o; } \
    LDS_WAIT(); } while (0)
__device__ __forceinline__ void norm_row_bf16(const float* xrow, const float* g, bf16* orow, int lane) {
    f32x4 v[8]; float s = 0.f;
#pragma unroll
    for (int j = 0; j < 8; ++j) { v[j] = *(const f32x4*)(xrow + 4 * lane + 256 * j); s += (v[j][0] * v[j][0] + v[j][1] * v[j][1]) + (v[j][2] * v[j][2] + v[j][3] * v[j][3]); }
    const float rs = __builtin_amdgcn_rsqf(wave_sum(s) * (1.f / DM) + EPS);
#pragma unroll
    for (int j = 0; j < 8; ++j) { const f32x4 gg = *(const f32x4*)(g + 4 * lane + 256 * j);
        u32x2 o; o.x = cvt_pk_bf16(v[j][0] * rs * gg[0], v[j][1] * rs * gg[1]); o.y = cvt_pk_bf16(v[j][2] * rs * gg[2], v[j][3] * rs * gg[3]);
        *(u32x2*)(orow + 4 * lane + 256 * j) = o; }
}
__device__ __forceinline__ void p_prologue(Frame& F) {
    LAS float* scr = (LAS float*)(F.lds + F.wave * 16640);
    const int gw = F.vcu * NWAVES + F.wave, NGW = F.G * NWAVES, lane = F.lane;
    constexpr int T_TOTAL = NLAYER * (32 * 80 + 32 * 32 + NE * (2 * 32 * 8 + 8 * 32));
    {
        f32x4 va[16], vb[16];
        const float* srcA; const float* srcB; bf16* dstA; bf16* dstB; const float* kA; const float* kB; int ldA, ldB, KA, KB;
        int it = gw;
        if (it < T_TOTAL) { tile_desc(F.in, F.ws, it, srcA, ldA, dstA, KA, kA); TR_LOAD(va, srcA, ldA); }
        while (it < T_TOTAL) {
            const int itb = it + NGW;
            if (itb < T_TOTAL) { tile_desc(F.in, F.ws, itb, srcB, ldB, dstB, KB, kB); TR_LOAD(vb, srcB, ldB); }
            TR_PROC(va, dstA, KA, kA);
            if (itb >= T_TOTAL) break;
            const int ita = itb + NGW;
            if (ita < T_TOTAL) { tile_desc(F.in, F.ws, ita, srcA, ldA, dstA, KA, kA); TR_LOAD(va, srcA, ldA); }
            TR_PROC(vb, dstB, KB, kB);
            it = ita;
        }
    }
    { bf16* SW = (bf16*)(F.ws + WS_SGUW); const int gt = gw * 64 + F.lane, NGT = NGW * 64;
      for (int idx = gt; idx < NLAYER * 4 * 8 * 4 * 64; idx += NGT) {
          const int ln = idx & 63, pp = (idx >> 6) & 3, itile = (idx >> 8) & 7, h = (idx >> 11) & 3, l = idx >> 13;
          const int i = 16 * itile + (ln & 15), gq = ln >> 4;
          const float* w = F.in[IN_SGUW] + ((size_t)(l * 4 + h) * 128 + i) * 128;
          float v[8];
#pragma unroll
          for (int jj = 0; jj < 8; ++jj) { const int j = 32 * pp + (jj < 4 ? 4 * gq + jj : 16 + 4 * gq + (jj - 4)); v[jj] = (j <= i) ? w[j] : 0.f; }
          u32x4 o; o.x = cvt_pk_bf16(v[0], v[1]); o.y = cvt_pk_bf16(v[2], v[3]); o.z = cvt_pk_bf16(v[4], v[5]); o.w = cvt_pk_bf16(v[6], v[7]);
          *(u32x4*)(SW + (size_t)idx * 8) = o; }
      bf16* WRF = (bf16*)(F.ws + WS_WRT);
      for (int idx = gt; idx < NLAYER * 64 * 3 * 64; idx += NGT) { const int ln = idx & 63, ct = (idx >> 6) % 3, ks = (idx / 192) & 63, l = idx / (192 * 64);
          const int o = 16 * ct + (ln & 15), k0 = 32 * ks + 8 * (ln >> 4);
          float v[8];
#pragma unroll
          for (int j = 0; j < 8; ++j) { const int k = k0 + j; const float wv = o < 32 ? F.in[IN_WRE][((size_t)l * DM + k) * NE + o] : (o < 36 ? F.in[IN_WRG][((size_t)l * DM + k) * 4 + (o - 32)] : 0.f);
              v[j] = wv * F.in[IN_NORM2][(size_t)l * DM + k]; }
          u32x4 hi, lo; hi.x = cvt_pk_bf16(v[0], v[1]); hi.y = cvt_pk_bf16(v[2], v[3]); hi.z = cvt_pk_bf16(v[4], v[5]); hi.w = cvt_pk_bf16(v[6], v[7]);
          lo.x = cvt_pk_bf16(v[0] - bf_lo(hi.x), v[1] - bf_hi(hi.x)); lo.y = cvt_pk_bf16(v[2] - bf_lo(hi.y), v[3] - bf_hi(hi.y));
          lo.z = cvt_pk_bf16(v[4] - bf_lo(hi.z), v[5] - bf_hi(hi.z)); lo.w = cvt_pk_bf16(v[6] - bf_lo(hi.w), v[7] - bf_hi(hi.w));
          bf16* dst = WRF + ((((size_t)l * 64 + ks) * 3 + ct) * 2 * 64 + ln) * 8;
          *(u32x4*)dst = hi; *(u32x4*)(dst + 512) = lo; } }
    bf16* HN = (bf16*)(F.ws + WS_HN);
    for (int m = gw; m < SEQ; m += NGW) norm_row_bf16(F.in[IN_X] + (size_t)m * DM, F.in[IN_NORM1], HN + (size_t)m * DM, F.lane);
}

__device__ __forceinline__ int vimg_off(int row, int c) { return row * 256 + ((((c >> 1) ^ (row & 7)) << 1) | (c & 1)) * 16; }
__device__ __forceinline__ bf16x8 tr_frag(const LAS unsigned char* img, int ra, int rb, int dt, int lane) {
    const int gq = lane >> 4, q = (lane & 15) >> 2, p = lane & 3;
    const int r0 = ra + 4 * gq + q, r1 = rb + 4 * gq + q, c = 2 * dt + (p >> 1);
    const s16x4 a = __builtin_amdgcn_ds_read_tr16_b64_v4i16((LAS s16x4*)(img + vimg_off(r0, c) + 8 * (p & 1)));
    const s16x4 b = __builtin_amdgcn_ds_read_tr16_b64_v4i16((LAS s16x4*)(img + vimg_off(r1, c) + 8 * (p & 1)));
    bf16x8 r; r[0] = a[0]; r[1] = a[1]; r[2] = a[2]; r[3] = a[3]; r[4] = b[0]; r[5] = b[1]; r[6] = b[2]; r[7] = b[3]; return r;
}
__device__ __forceinline__ void sgu_stage8(const bf16* vsrc, int j0, int w, int lane, const f32x4& g0, const f32x4& g1, LAS unsigned char* lds) {
    u32x4 raw[8];
#pragma unroll
    for (int j = 0; j < 8; ++j) raw[j] = *(const u32x4*)(vsrc + (size_t)(w + 8 * (j0 + j)) * DIN);
#pragma unroll
    for (int j = 0; j < 8; ++j) { const int row = w + 8 * (j0 + j);
        float x[8] = {bf_lo(raw[j].x), bf_hi(raw[j].x), bf_lo(raw[j].y), bf_hi(raw[j].y), bf_lo(raw[j].z), bf_hi(raw[j].z), bf_lo(raw[j].w), bf_hi(raw[j].w)};
        float s = 0.f;
#pragma unroll
        for (int e = 0; e < 8; ++e) s += x[e] * x[e];
        const float rs = __builtin_amdgcn_rsqf(wave_sum(s) * (1.f / 512.f) + EPS);
        u32x4 o; o.x = cvt_pk_bf16(x[0] * rs * g0[0], x[1] * rs * g0[1]); o.y = cvt_pk_bf16(x[2] * rs * g0[2], x[3] * rs * g0[3]);
        o.z = cvt_pk_bf16(x[4] * rs * g1[0], x[5] * rs * g1[1]); o.w = cvt_pk_bf16(x[6] * rs * g1[2], x[7] * rs * g1[3]);
        *(LAS u32x4*)(lds + (lane >> 4) * 32768 + vimg_off(row, lane & 15)) = o; }
}
__device__ __forceinline__ void sgu_item(Frame& F, int l, int chunk, int half) {
    const bf16* PROJ = (const bf16*)(F.ws + WS_PROJ); bf16* MIX = (bf16*)(F.ws + WS_MIX);
    const int p0 = chunk * 128, lane = F.lane, w = F.wave;
    LAS float* red = (LAS float*)(F.lds + MISC_OFF + 256);
    const float* gn = F.in[IN_SGUN] + l * 512;
    const f32x4 g0 = *(const f32x4*)(gn + 8 * lane), g1 = *(const f32x4*)(gn + 8 * lane + 4);
    const bf16* vsrc = PROJ + (size_t)p0 * DIN + OFF_V + 8 * lane;
    sgu_stage8(vsrc, 0, w, lane, g0, g1, F.lds);
    if (half) sgu_stage8(vsrc, 8, w, lane, g0, g1, F.lds);
    const int h = w >> 1, ih = w & 1, gq = lane >> 4, fr = lane & 15;
    const LAS unsigned char* img = F.lds + h * 32768;
    const bf16* SW = (const bf16*)(F.ws + WS_SGUW) + (size_t)(l * 4 + h) * 8 * 4 * 64 * 8;
    const float* bs = F.in[IN_SGUB] + (size_t)(l * 4 + h) * 128;
    const float* og = F.in[IN_OUTN] + (size_t)l * DM + h * 128 + 4 * gq;
    const int it0 = ih + 4 * half;
    u32x2 ur[2][8];
#pragma unroll
    for (int ii = 0; ii < 2; ++ii) { const bf16* urow = PROJ + (size_t)(p0 + 16 * (it0 + 2 * ii) + fr) * DIN + OFF_U + h * 128 + 4 * gq;
#pragma unroll
        for (int dt = 0; dt < 8; ++dt) ur[ii][dt] = *(const u32x2*)(urow + 16 * dt); }
    __syncthreads();
    f32x4 z[2][8];
#pragma unroll
    for (int ii = 0; ii < 2; ++ii)
#pragma unroll
        for (int dt = 0; dt < 8; ++dt) z[ii][dt] = (f32x4){0.f, 0.f, 0.f, 0.f};
#pragma unroll 1
    for (int pp = 0; pp <= (it0 + 2) / 2; ++pp) {
        const bf16x8 bw0 = *(const bf16x8*)(SW + ((size_t)(it0 * 4 + pp) * 64 + lane) * 8);
        const bf16x8 bw1 = *(const bf16x8*)(SW + ((size_t)((it0 + 2) * 4 + pp) * 64 + lane) * 8);
        const bool do0 = pp <= it0 / 2;
#pragma unroll
        for (int dt = 0; dt < 8; ++dt) { const bf16x8 a = tr_frag(img, 32 * pp, 32 * pp + 16, dt, lane);
            if (do0) z[0][dt] = __builtin_amdgcn_mfma_f32_16x16x32_bf16(a, bw0, z[0][dt], 0, 0, 0);
            z[1][dt] = __builtin_amdgcn_mfma_f32_16x16x32_bf16(a, bw1, z[1][dt], 0, 0, 0); }
    }
#pragma unroll
    for (int ii = 0; ii < 2; ++ii) { const int i = 16 * (it0 + 2 * ii) + fr; const float bi = bs[i]; float s = 0.f;
#pragma unroll
        for (int dt = 0; dt < 8; ++dt) { const u32x2 u2 = ur[ii][dt];
            f32x4 y; y[0] = bf_lo(u2.x) * (z[ii][dt][0] + bi); y[1] = bf_hi(u2.x) * (z[ii][dt][1] + bi); y[2] = bf_lo(u2.y) * (z[ii][dt][2] + bi); y[3] = bf_hi(u2.y) * (z[ii][dt][3] + bi);
            z[ii][dt] = y; s += (y[0] * y[0] + y[1] * y[1]) + (y[2] * y[2] + y[3] * y[3]); }
        s += __shfl_xor(s, 16); s += __shfl_xor(s, 32);
        if (gq == 0) red[i * 4 + h] = s; }
    __syncthreads();
#pragma unroll
    for (int ii = 0; ii < 2; ++ii) { const int i = 16 * (it0 + 2 * ii) + fr;
        const f32x4 rr = *(const LAS f32x4*)(red + i * 4);
        const float rs = __builtin_amdgcn_rsqf(((rr[0] + rr[1]) + (rr[2] + rr[3])) * (1.f / 512.f) + EPS);
        bf16* orow = MIX + (size_t)(p0 + i) * DM + h * 128 + 4 * gq;
#pragma unroll
        for (int dt = 0; dt < 8; ++dt) { const f32x4 gg = *(const f32x4*)(og + 16 * dt); const f32x4 y = z[ii][dt];
            u32x2 o; o.x = cvt_pk_bf16(y[0] * rs * gg[0], y[1] * rs * gg[1]); o.y = cvt_pk_bf16(y[2] * rs * gg[2], y[3] * rs * gg[3]);
            *(u32x2*)(orow + 16 * dt) = o; } }
    __syncthreads();
}

__device__ __forceinline__ void conv_item(Frame& F, int l, int tile) {
    const bf16* PROJ = (const bf16*)(F.ws + WS_PROJ); bf16* MIX = (bf16*)(F.ws + WS_MIX);
    constexpr int TP = 32, NR = TP + 30;
    const int p0 = tile * TP, c = F.tid, tid = F.tid;
    LAS float* cbuf = (LAS float*)F.lds;
    LAS bf16* zbuf = (LAS bf16*)(F.lds + 65536);
    { u32x4 av[8], gv[8];
#pragma unroll
      for (int i = 0; i < 8; ++i) { const int id = tid + NTHREADS * i, row = id >> 6, ch = (id & 63) * 8; int p = p0 - 30 + row; p = p < 0 ? 0 : p; p = row < NR ? p : 0;
          av[i] = *(const u32x4*)(PROJ + (size_t)p * DIN + OFF_A + ch); gv[i] = *(const u32x4*)(PROJ + (size_t)p * DIN + OFF_G + ch); }
#pragma unroll
      for (int i = 0; i < 8; ++i) { const int id = tid + NTHREADS * i, row = id >> 6, ch = (id & 63) * 8; const bool live = (p0 - 30 + row) >= 0;
          const unsigned au[4] = {av[i].x, av[i].y, av[i].z, av[i].w}, gu[4] = {gv[i].x, gv[i].y, gv[i].z, gv[i].w}; u32x4 o; unsigned ou[4];
#pragma unroll
          for (int e = 0; e < 4; ++e) { const float z0 = bf_lo(au[e]) * sigmoidf_(bf_lo(gu[e])), z1 = bf_hi(au[e]) * sigmoidf_(bf_hi(gu[e])); ou[e] = live ? cvt_pk_bf16(z0, z1) : 0u; }
          o.x = ou[0]; o.y = ou[1]; o.z = ou[2]; o.w = ou[3];
          if (row < NR) *(LAS u32x4*)(zbuf + row * 512 + ch) = o; } }
    float wk[CONV_K];
#pragma unroll
    for (int k = 0; k < CONV_K; ++k) wk[k] = F.in[IN_CONVW][((size_t)l * CONV_K + k) * 512 + c];
    const float cb = F.in[IN_CONVB][l * 512 + c];
    __syncthreads();
#define CONV_Z(r) __builtin_bit_cast(float, (unsigned)zbuf[(r) * 512 + c] << 16)
    float win[30];
#pragma unroll
    for (int r = 0; r < 30; ++r) win[r] = CONV_Z(r);
#pragma unroll
    for (int q = 0; q < TP; ++q) { const float zv = CONV_Z(30 + q); float acc = cb + wk[30] * zv;
#pragma unroll
        for (int k = 0; k < 30; ++k) acc += wk[k] * win[(k + q) % 30];
        win[q % 30] = zv; cbuf[q * 512 + c] = acc; }
#undef CONV_Z
    __syncthreads();
    const float* lg = F.in[IN_LNG] + l * 512 + 8 * F.lane; const float* lb = F.in[IN_LNB] + l * 512 + 8 * F.lane; const float* og = F.in[IN_OUTN] + (size_t)l * DM + 512 + 8 * F.lane;
    const f32x4 lg0 = *(const f32x4*)lg, lg1 = *(const f32x4*)(lg + 4), lb0 = *(const f32x4*)lb, lb1 = *(const f32x4*)(lb + 4), og0 = *(const f32x4*)og, og1 = *(const f32x4*)(og + 4);
    for (int r = F.wave; r < TP; r += NWAVES) {
        const f32x4 a0 = *(const LAS f32x4*)(cbuf + r * 512 + 8 * F.lane), a1 = *(const LAS f32x4*)(cbuf + r * 512 + 8 * F.lane + 4);
        float x[8] = {a0[0], a0[1], a0[2], a0[3], a1[0], a1[1], a1[2], a1[3]};
        float s = 0.f;
#pragma unroll
        for (int e = 0; e < 8; ++e) s += x[e];
        const float mu = wave_sum(s) * (1.f / 512.f); float q2 = 0.f;
#pragma unroll
        for (int e = 0; e < 8; ++e) { x[e] -= mu; q2 += x[e] * x[e]; }
        const float rstd = __builtin_amdgcn_rsqf(wave_sum(q2) * (1.f / 512.f) + EPS);
        const float gam[8] = {lg0[0], lg0[1], lg0[2], lg0[3], lg1[0], lg1[1], lg1[2], lg1[3]}, bet[8] = {lb0[0], lb0[1], lb0[2], lb0[3], lb1[0], lb1[1], lb1[2], lb1[3]};
        float s2 = 0.f;
#pragma unroll
        for (int e = 0; e < 8; ++e) { const float y = x[e] * rstd * gam[e] + bet[e]; x[e] = y * sigmoidf_(y); s2 += x[e] * x[e]; }
        const float rs = __builtin_amdgcn_rsqf(wave_sum(s2) * (1.f / 512.f) + EPS);
        u32x4 o; o.x = cvt_pk_bf16(x[0] * rs * og0[0], x[1] * rs * og0[1]); o.y = cvt_pk_bf16(x[2] * rs * og0[2], x[3] * rs * og0[3]);
        o.z = cvt_pk_bf16(x[4] * rs * og1[0], x[5] * rs * og1[1]); o.w = cvt_pk_bf16(x[6] * rs * og1[2], x[7] * rs * og1[3]);
        *(u32x4*)(MIX + (size_t)(p0 + r) * DM + 512 + 8 * F.lane) = o;
    }
    __syncthreads();
}

__device__ __forceinline__ int kimg_off(int row, int c) { return row * 256 + ((c ^ (row & 15)) << 4); }
__device__ __forceinline__ bf16x8 tr_frag2(const LAS unsigned char* vs, int ta, int tb, int dt, int lane) {
    const int gq = lane >> 4, q = (lane & 15) >> 2, p = lane & 3, c = 2 * dt + (p >> 1), rr = 4 * gq + q;
    const int off = rr * 256 + ((((c >> 1) ^ (rr & 7)) << 1) | (c & 1)) * 16 + 8 * (p & 1);
    const s16x4 a = __builtin_amdgcn_ds_read_tr16_b64_v4i16((LAS s16x4*)(vs + ta + off));
    const s16x4 b = __builtin_amdgcn_ds_read_tr16_b64_v4i16((LAS s16x4*)(vs + tb + off));
    bf16x8 r; r[0] = a[0]; r[1] = a[1]; r[2] = a[2]; r[3] = a[3]; r[4] = b[0]; r[5] = b[1]; r[6] = b[2]; r[7] = b[3]; return r;
}
#define ATT_DECODE(st) const int run_ = (int)blockIdx.x + F.G * ((st) / 5), b_ = (st) % 5 - 1; const int g = run_ >> 8, h = (run_ >> 5) & 7, rr_ = run_ & 31; \
    const int sh = 2 * g, dil = 1 << sh, rps = 32 >> sh; const int r = rr_ / rps, nb = 4 * (rr_ % rps) + b_
#define ATT_LOAD(st) do { if (ATT_EXP == 2) break; ATT_DECODE(st); const int cc = tid & 15; \
    _Pragma("unroll") for (int j = 0; j < 4; ++j) { const int row = (tid >> 4) + 32 * j; int ms = nb * 128 + row; ms = ms < 0 ? 0 : ms; const size_t pos = (size_t)ms * dil + r; \
        kr[j] = *(const u32x4*)(PROJ + pos * DIN + OFF_K + h * HD + 8 * cc); vr[j] = *(const u32x4*)(PROJ + pos * DIN + OFF_VV + h * HD + 8 * cc); } \
    if (b_ >= 0) { const size_t qpos_ = (size_t)(nb * 128 + 16 * w + (lane & 15)) * dil + r; \
        _Pragma("unroll") for (int ks = 0; ks < 4; ++ks) qr[ks] = *(const u32x4*)(PROJ + qpos_ * DIN + OFF_Q + h * HD + 32 * ks + 8 * (lane >> 4)); } } while (0)
__device__ __forceinline__ void att_phase(Frame& F, int l) {
    const bf16* PROJ = (const bf16*)(F.ws + WS_PROJ);
    bf16* ATT = (bf16*)(F.ws + WS_ATT); float* LSE = (float*)(F.ws + WS_LSE);
    const int lane = F.lane, w = F.wave, tid = F.tid, fr = lane & 15, gq = lane >> 4;
    LAS unsigned char* Ks = F.lds; LAS unsigned char* Vs = F.lds + 65536;
    const int nsteps = 5 * ((768 - (int)blockIdx.x + F.G - 1) / F.G);
    u32x4 kr[4], vr[4], qr[4];
    if (ATT_EXP == 2) { for (int j = 0; j < 4; ++j) { kr[j] = (u32x4){0x3f803f80u + (unsigned)tid, 0x3f003f80u, 0x3f803f00u, 0x3e803f80u}; vr[j] = kr[j]; qr[j] = kr[j]; } }
    if (nsteps > 0) ATT_LOAD(0);
    const int cc = tid & 15;
    const float* kgp = F.in[IN_KN] + l * HD + 8 * cc;
    const f32x4 kg0 = *(const f32x4*)kgp, kg1 = *(const f32x4*)(kgp + 4);
    for (int st = 0; st < nsteps; ++st) {
        ATT_DECODE(st);
        const int slot = (b_ + 1) & 1, curoff = slot * 32768, prevoff = 32768 - curoff;
#pragma unroll
        for (int j = 0; j < 4; ++j) { const int row = (tid >> 4) + 32 * j;
            const u32x4 k4 = kr[j];
            float x[8] = {bf_lo(k4.x), bf_hi(k4.x), bf_lo(k4.y), bf_hi(k4.y), bf_lo(k4.z), bf_hi(k4.z), bf_lo(k4.w), bf_hi(k4.w)};
            float sq = 0.f;
#pragma unroll
            for (int e = 0; e < 8; ++e) sq += x[e] * x[e];
            const float rs = __builtin_amdgcn_rsqf(row16_sum(sq) * (1.f / HD) + EPS);
            u32x4 o; o.x = cvt_pk_bf16(x[0] * rs * kg0[0], x[1] * rs * kg0[1]); o.y = cvt_pk_bf16(x[2] * rs * kg0[2], x[3] * rs * kg0[3]);
            o.z = cvt_pk_bf16(x[4] * rs * kg1[0], x[5] * rs * kg1[1]); o.w = cvt_pk_bf16(x[6] * rs * kg1[2], x[7] * rs * kg1[3]);
            *(LAS u32x4*)(Ks + curoff + kimg_off(row, cc)) = o;
            *(LAS u32x4*)(Vs + curoff + vimg_off(row, cc)) = vr[j]; }
        const int iq = 16 * w + fr; const size_t qpos = (size_t)(nb * 128 + iq) * dil + r;
        bf16x8 qf[4];
        if (b_ >= 0) { float x[4][8]; float sq = 0.f;
#pragma unroll
          for (int ks = 0; ks < 4; ++ks) { const u32x4 q4 = qr[ks];
              x[ks][0] = bf_lo(q4.x); x[ks][1] = bf_hi(q4.x); x[ks][2] = bf_lo(q4.y); x[ks][3] = bf_hi(q4.y); x[ks][4] = bf_lo(q4.z); x[ks][5] = bf_hi(q4.z); x[ks][6] = bf_lo(q4.w); x[ks][7] = bf_hi(q4.w);
#pragma unroll
              for (int e = 0; e < 8; ++e) sq += x[ks][e] * x[ks][e]; }
          sq += __shfl_xor(sq, 16); sq += __shfl_xor(sq, 32);
          const float rs = __builtin_amdgcn_rsqf(sq * (1.f / HD) + EPS) * 0.08838834764831845f;
#pragma unroll
          for (int ks = 0; ks < 4; ++ks) { const float* qg = F.in[IN_QN] + l * HD + 32 * ks + 8 * gq; const f32x4 q0 = *(const f32x4*)qg, q1 = *(const f32x4*)(qg + 4);
              u32x4 o; o.x = cvt_pk_bf16(x[ks][0] * rs * q0[0], x[ks][1] * rs * q0[1]); o.y = cvt_pk_bf16(x[ks][2] * rs * q0[2], x[ks][3] * rs * q0[3]);
              o.z = cvt_pk_bf16(x[ks][4] * rs * q1[0], x[ks][5] * rs * q1[1]); o.w = cvt_pk_bf16(x[ks][6] * rs * q1[2], x[ks][7] * rs * q1[3]);
              qf[ks] = __builtin_bit_cast(bf16x8, o); } }
        __syncthreads();
        if (st + 1 < nsteps) ATT_LOAD(st + 1);
        if (b_ >= 0 && ATT_EXP != 1) {
        const int t0 = w < 6 ? w : 6;
        f32x4 sc[10];
#pragma unroll
        for (int kt = 0; kt < 10; ++kt) { sc[kt] = (f32x4){0.f, 0.f, 0.f, 0.f}; const int T = t0 + kt; const int kbase = (T < 8 ? prevoff : curoff); const int krow = 16 * (T & 7) + fr;
#pragma unroll
            for (int ks = 0; ks < 4; ++ks) { const bf16x8 kf = *(const LAS bf16x8*)(Ks + kbase + kimg_off(krow, 4 * ks + gq));
                sc[kt] = __builtin_amdgcn_mfma_f32_16x16x32_bf16(kf, qf[ks], sc[kt], 0, 0, 0); } }
        float mx = -INFINITY;
#pragma unroll
        for (int kt = 0; kt < 10; ++kt)
#pragma unroll
            for (int e = 0; e < 4; ++e) { const int j = 16 * (t0 + kt) + 4 * gq + e, dist = 128 + iq - j; const bool ok = dist >= 0 && dist <= 128 && (nb > 0 || j >= 128);
                sc[kt][e] = ok ? sc[kt][e] : -INFINITY; mx = fmaxf(mx, sc[kt][e]); }
        mx = fmaxf(mx, __shfl_xor(mx, 16)); mx = fmaxf(mx, __shfl_xor(mx, 32));
        float sum = 0.f;
#pragma unroll
        for (int kt = 0; kt < 10; ++kt)
#pragma unroll
            for (int e = 0; e < 4; ++e) { const float p = fast_exp(sc[kt][e] - mx); sc[kt][e] = p; sum += p; }
        sum += __shfl_xor(sum, 16); sum += __shfl_xor(sum, 32);
        bf16x8 pf[5];
#pragma unroll
        for (int pp = 0; pp < 5; ++pp) { u32x4 o; o.x = cvt_pk_bf16(sc[2 * pp][0], sc[2 * pp][1]); o.y = cvt_pk_bf16(sc[2 * pp][2], sc[2 * pp][3]); o.z = cvt_pk_bf16(sc[2 * pp + 1][0], sc[2 * pp + 1][1]); o.w = cvt_pk_bf16(sc[2 * pp + 1][2], sc[2 * pp + 1][3]);
            pf[pp] = __builtin_bit_cast(bf16x8, o); }
        const float inv = __builtin_amdgcn_rcpf(sum);
        bf16* orow = ATT + ((size_t)g * SEQ + qpos) * 1024 + h * HD + 4 * gq;
        int toff[10];
#pragma unroll
        for (int kt = 0; kt < 10; ++kt) { const int T = t0 + kt; toff[kt] = (T < 8 ? prevoff : curoff) + (T & 7) * 16 * 256; }
#pragma unroll
        for (int dt = 0; dt < 8; ++dt) { f32x4 o = (f32x4){0.f, 0.f, 0.f, 0.f};
#pragma unroll
            for (int pp = 0; pp < 5; ++pp) { const bf16x8 vf = tr_frag2(Vs, toff[2 * pp], toff[2 * pp + 1], dt, lane);
                o = __builtin_amdgcn_mfma_f32_16x16x32_bf16(vf, pf[pp], o, 0, 0, 0); }
            u32x2 ow; ow.x = cvt_pk_bf16(o[0] * inv, o[1] * inv); ow.y = cvt_pk_bf16(o[2] * inv, o[3] * inv);
            *(u32x2*)(orow + 16 * dt) = ow; }
        if (gq == 0) LSE[((size_t)g * SEQ + qpos) * NHEAD + h] = mx + __logf(sum);
        }
        if (b_ >= 0 && ATT_EXP == 1) { bf16* orow = ATT + ((size_t)g * SEQ + qpos) * 1024 + h * HD + 4 * gq;
#pragma unroll
            for (int dt = 0; dt < 8; ++dt) { u32x2 ow; ow.x = __builtin_bit_cast(unsigned, qf[dt & 3][0] | (qf[dt & 3][1] << 16)) & 0x3f803f80u; ow.y = 0u; *(u32x2*)(orow + 16 * dt) = ow; }
            if (gq == 0) LSE[((size_t)g * SEQ + qpos) * NHEAD + h] = 0.f; }
        __syncthreads();
    }
}
#undef ATT_DECODE
#undef ATT_LOAD

__device__ __forceinline__ void att_combine(Frame& F, int l) {
    const bf16* ATT = (const bf16*)(F.ws + WS_ATT); const float* LSE = (const float*)(F.ws + WS_LSE); bf16* MIX = (bf16*)(F.ws + WS_MIX);
    const int gw = F.vcu * NWAVES + F.wave, NGW = F.G * NWAVES, lane = F.lane;
    const float* og = F.in[IN_OUTN] + (size_t)l * DM + 1024 + 16 * lane;
    f32x4 gg[4];
#pragma unroll
    for (int q = 0; q < 4; ++q) gg[q] = *(const f32x4*)(og + 4 * q);
    for (int m = gw; m < SEQ; m += NGW) {
        const int hh = lane >> 3;
        const float l0 = LSE[((size_t)0 * SEQ + m) * NHEAD + hh], l1 = LSE[((size_t)1 * SEQ + m) * NHEAD + hh], l2 = LSE[((size_t)2 * SEQ + m) * NHEAD + hh];
        const float M = fmaxf(l0, fmaxf(l1, l2)); float w0 = fast_exp(l0 - M), w1 = fast_exp(l1 - M), w2 = fast_exp(l2 - M);
        const float iw = __builtin_amdgcn_rcpf(w0 + w1 + w2); w0 *= iw; w1 *= iw; w2 *= iw;
        float y[16]; float s = 0.f;
#pragma unroll
        for (int q = 0; q < 2; ++q) {
            const u32x4 a = *(const u32x4*)(ATT + ((size_t)0 * SEQ + m) * 1024 + 16 * lane + 8 * q), b = *(const u32x4*)(ATT + ((size_t)1 * SEQ + m) * 1024 + 16 * lane + 8 * q), c = *(const u32x4*)(ATT + ((size_t)2 * SEQ + m) * 1024 + 16 * lane + 8 * q);
            const unsigned au[4] = {a.x, a.y, a.z, a.w}, bu[4] = {b.x, b.y, b.z, b.w}, cu[4] = {c.x, c.y, c.z, c.w};
#pragma unroll
            for (int e = 0; e < 4; ++e) { y[8 * q + 2 * e] = w0 * bf_lo(au[e]) + w1 * bf_lo(bu[e]) + w2 * bf_lo(cu[e]); y[8 * q + 2 * e + 1] = w0 * bf_hi(au[e]) + w1 * bf_hi(bu[e]) + w2 * bf_hi(cu[e]); } }
#pragma unroll
        for (int e = 0; e < 16; ++e) s += y[e] * y[e];
        const float rs = __builtin_amdgcn_rsqf(wave_sum(s) * (1.f / 1024.f) + EPS);
#pragma unroll
        for (int q = 0; q < 2; ++q) { u32x4 o;
            o.x = cvt_pk_bf16(y[8 * q + 0] * rs * gg[2 * q][0], y[8 * q + 1] * rs * gg[2 * q][1]); o.y = cvt_pk_bf16(y[8 * q + 2] * rs * gg[2 * q][2], y[8 * q + 3] * rs * gg[2 * q][3]);
            o.z = cvt_pk_bf16(y[8 * q + 4] * rs * gg[2 * q + 1][0], y[8 * q + 5] * rs * gg[2 * q + 1][1]); o.w = cvt_pk_bf16(y[8 * q + 6] * rs * gg[2 * q + 1][2], y[8 * q + 7] * rs * gg[2 * q + 1][3]);
            *(u32x4*)(MIX + (size_t)m * DM + 1024 + 16 * lane + 8 * q) = o; }
    }
}

#define ROUTER_LOAD(S, ks) do { \
    _Pragma("unroll") for (int rt = 0; rt < 4; ++rt) xa##S[rt] = *(const u32x4*)(xrow + (size_t)rt * 16 * DM + 32 * (ks)); \
    _Pragma("unroll") for (int ct = 0; ct < 3; ++ct) { bh##S[ct] = *(const bf16x8*)(wf + (size_t)(ks) * 3072 + (ct * 2) * 512); bl##S[ct] = *(const bf16x8*)(wf + (size_t)(ks) * 3072 + (ct * 2 + 1) * 512); } } while (0)
#define ROUTER_STEP(S, ks) do { \
    _Pragma("unroll") for (int rt = 0; rt < 4; ++rt) { const u32x4 xq = xa##S[rt]; \
        const float x0 = bf_lo(xq.x), x1 = bf_hi(xq.x), x2 = bf_lo(xq.y), x3 = bf_hi(xq.y), x4 = bf_lo(xq.z), x5 = bf_hi(xq.z), x6 = bf_lo(xq.w), x7 = bf_hi(xq.w); \
        ssq[rt] += (x0 * x0 + x1 * x1) + (x2 * x2 + x3 * x3) + (x4 * x4 + x5 * x5) + (x6 * x6 + x7 * x7); \
        const bf16x8 xh = __builtin_bit_cast(bf16x8, xq); \
        _Pragma("unroll") for (int ct = 0; ct < 3; ++ct) { \
            acc[rt][ct] = __builtin_amdgcn_mfma_f32_16x16x32_bf16(xh, bh##S[ct], acc[rt][ct], 0, 0, 0); \
            acc[rt][ct] = __builtin_amdgcn_mfma_f32_16x16x32_bf16(xh, bl##S[ct], acc[rt][ct], 0, 0, 0); } } } while (0)
__device__ __forceinline__ void router_phase(Frame& F, int l, int alt = 0) {
    const bf16* H1 = (const bf16*)(F.ws + WS_HN);
    const bf16* WRF = (const bf16*)(F.ws + WS_WRT) + (size_t)l * 64 * 3 * 2 * 64 * 8;
    unsigned* cnt = (unsigned*)(F.ws + WS_CTL) + CW_CNT + 2048 * l + 32768 * alt;
    int* tok = (int*)(F.ws + (alt ? WS_ALT : WS_TOK)); f32x4* tinfo = (f32x4*)(F.ws + (alt ? WS_ALT + 4 * MiB : WS_TINFO)); float* rslot = (float*)(F.ws + (alt ? WS_ALT + 2 * MiB : WS_RSLOT));
    const int lane = F.lane, tid = F.tid, w = F.wave, fr = lane & 15, g = lane >> 4;
    constexpr int PS = 49;
    LAS float* P = (LAS float*)F.lds;
    LAS float* SS = (LAS float*)(F.lds + 8 * 64 * PS * 4);
    for (int task = (int)blockIdx.x; task < SEQ / 64; task += F.G) {
        const bf16* xrow = H1 + (size_t)(task * 64 + fr) * DM + 256 * w + 8 * g;
        const bf16* wf = WRF + ((size_t)(8 * w) * 3 * 2 * 64 + lane) * 8;
        f32x4 acc[4][3]; float ssq[4] = {0.f, 0.f, 0.f, 0.f};
#pragma unroll
        for (int rt = 0; rt < 4; ++rt)
#pragma unroll
            for (int ct = 0; ct < 3; ++ct) acc[rt][ct] = (f32x4){0.f, 0.f, 0.f, 0.f};
        u32x4 xaA[4], xaB[4]; bf16x8 bhA[3], blA[3], bhB[3], blB[3];
        ROUTER_LOAD(A, 0);
#pragma unroll 1
        for (int it = 0; it < 4; ++it) {
            ROUTER_LOAD(B, 1); __builtin_amdgcn_sched_barrier(0);
            ROUTER_STEP(A, 0); __builtin_amdgcn_sched_barrier(0);
            if (it < 3) ROUTER_LOAD(A, 2);
            __builtin_amdgcn_sched_barrier(0);
            ROUTER_STEP(B, 1); __builtin_amdgcn_sched_barrier(0);
            xrow += 64; wf += 2 * 3072;
        }
#pragma unroll
        for (int rt = 0; rt < 4; ++rt) { float sq = ssq[rt]; sq += __shfl_xor(sq, 16); sq += __shfl_xor(sq, 32);
            if (g == 0) SS[w * 64 + 16 * rt + fr] = sq;
#pragma unroll
            for (int ct = 0; ct < 3; ++ct)
#pragma unroll
                for (int e = 0; e < 4; ++e) P[(w * 64 + 16 * rt + 4 * g + e) * PS + 16 * ct + fr] = acc[rt][ct][e]; }
        __syncthreads();
        if (tid < 64) {
            const int t = task * 64 + tid;
            float ss = 0.f;
#pragma unroll
            for (int q = 0; q < 8; ++q) ss += SS[q * 64 + tid];
            const float rs = __builtin_amdgcn_rsqf(ss * (1.f / DM) + EPS);
            const LAS float* pr = P + tid * PS;
            float lg[4];
#pragma unroll
            for (int o = 0; o < 4; ++o) { float a = 0.f;
#pragma unroll
                for (int q = 0; q < 8; ++q) a += pr[q * 64 * PS + 32 + o];
                lg[o] = a * rs + F.in[IN_BRG][l * 4 + o]; }
            int gi = 0; float gm = lg[0];
#pragma unroll
            for (int o = 1; o < 4; ++o) if (lg[o] > gm) { gm = lg[o]; gi = o; }
            float den = 0.f;
#pragma unroll
            for (int o = 0; o < 4; ++o) den += __expf(lg[o] - gm);
            const float gate_g = 1.f / den;
            float t1v = -INFINITY, t2v = -INFINITY; int t1i = 0, t2i = 0;
#pragma unroll
            for (int ii = 0; ii < 8; ++ii) { const int o = gi * 8 + ii; float a = 0.f;
#pragma unroll
                for (int q = 0; q < 8; ++q) a += pr[q * 64 * PS + o];
                const float v = a * rs + F.in[IN_BRE][l * NE + o];
                if (v > t1v) { t2v = t1v; t2i = t1i; t1v = v; t1i = ii; }
                else if (v > t2v) { t2v = v; t2i = ii; } }
            const float pp1 = 1.f / (1.f + __expf(t2v - t1v)), pp2 = 1.f - pp1;
            const int e0 = gi * 8 + t1i, e1 = gi * 8 + t2i;
            LAS unsigned* lcnt = (LAS unsigned*)(F.lds + 8 * 64 * PS * 4 + 8 * 64 * 4);
            if (tid < 32) lcnt[tid] = 0u;
            const unsigned r0 = __hip_atomic_fetch_add(lcnt + e0, 1u, __ATOMIC_RELAXED, __HIP_MEMORY_SCOPE_WORKGROUP), r1 = __hip_atomic_fetch_add(lcnt + e1, 1u, __ATOMIC_RELAXED, __HIP_MEMORY_SCOPE_WORKGROUP);
            if (tid < 32) { const unsigned c = lcnt[tid]; lcnt[32 + tid] = c ? atomicAdd(&cnt[tid * CNT_STRIDE], c) : 0u; }
            const unsigned s0 = lcnt[32 + e0] + r0, s1 = lcnt[32 + e1] + r1;
            tok[(size_t)e0 * TOKCAP + s0] = t; tok[(size_t)e1 * TOKCAP + s1] = t;
            rslot[(size_t)e0 * TOKCAP + s0] = rs; rslot[(size_t)e1 * TOKCAP + s1] = rs;
            f32x4 ti; ti[0] = __builtin_bit_cast(float, (int)(e0 * TOKCAP + s0)); ti[1] = __builtin_bit_cast(float, (int)(e1 * TOKCAP + s1)); ti[2] = gate_g * pp1; ti[3] = gate_g * pp2;
            tinfo[t] = ti;
        }
        __syncthreads();
    }
}
__device__ __forceinline__ void moe_table(Frame& F, int l) {
    const unsigned* cnt = (const unsigned*)(F.ws + WS_CTL) + CW_CNT + 2048 * l;
    LAS int* tstart = (LAS int*)(F.lds + MISC_OFF + 64);
    __syncthreads();
    if (F.tid == 0) { int acc = 0; for (int e = 0; e < NE; ++e) { tstart[e] = acc; acc += ((int)cnt[e * CNT_STRIDE] + 255) >> 8; } tstart[NE] = acc; }
    __syncthreads();
}
__device__ __forceinline__ void combine_phase(Frame& F, int l) {
    const LAS int* tstart = (const LAS int*)(F.lds + MISC_OFF + 64);
    const bf16* Y = (const bf16*)(F.ws + WS_Y); const f32x4* tinfo = (const f32x4*)(F.ws + WS_TINFO);
    bf16* H = (bf16*)(F.ws + WS_H); bf16* HN = (bf16*)(F.ws + WS_HN);
    const int gw = F.vcu * NWAVES + F.wave, NGW = F.G * NWAVES, lane = F.lane;
    const float* g1n = F.in[IN_NORM1] + (size_t)DM;
    for (int m = gw; m < SEQ; m += NGW) {
        const f32x4 ti = tinfo[m];
        const float tf0 = ti[0], tf1 = ti[1]; const int s0 = __builtin_bit_cast(int, tf0), s1 = __builtin_bit_cast(int, tf1);
        const int e0 = s0 >> 14, e1 = s1 >> 14;
        const size_t r0 = (size_t)tstart[e0] * 256 + (s0 & (TOKCAP - 1)), r1 = (size_t)tstart[e1] * 256 + (s1 & (TOKCAP - 1));
        const float ga = ti[2], gb = ti[3];
        f32x4 v[8]; float s = 0.f;
#pragma unroll
        for (int j = 0; j < 8; ++j) { const u32x2 hx = *(const u32x2*)(HN + (size_t)m * DM + 4 * lane + 256 * j);
            const u32x2 ya = *(const u32x2*)(Y + r0 * DM + 4 * lane + 256 * j), yb = *(const u32x2*)(Y + r1 * DM + 4 * lane + 256 * j);
            v[j][0] = bf_lo(hx.x) + ga * bf_lo(ya.x) + gb * bf_lo(yb.x); v[j][1] = bf_hi(hx.x) + ga * bf_hi(ya.x) + gb * bf_hi(yb.x);
            v[j][2] = bf_lo(hx.y) + ga * bf_lo(ya.y) + gb * bf_lo(yb.y); v[j][3] = bf_hi(hx.y) + ga * bf_hi(ya.y) + gb * bf_hi(yb.y);
            s += (v[j][0] * v[j][0] + v[j][1] * v[j][1]) + (v[j][2] * v[j][2] + v[j][3] * v[j][3]); }
        if (l == 0) {
            const float rs = __builtin_amdgcn_rsqf(wave_sum(s) * (1.f / DM) + EPS);
            bf16* hrow = H + (size_t)m * DM; bf16* orow = HN + (size_t)m * DM;
#pragma unroll
            for (int j = 0; j < 8; ++j) { const f32x4 gg = *(const f32x4*)(g1n + 4 * lane + 256 * j);
                u32x2 hb; hb.x = cvt_pk_bf16(v[j][0], v[j][1]); hb.y = cvt_pk_bf16(v[j][2], v[j][3]); *(u32x2*)(hrow + 4 * lane + 256 * j) = hb;
                u32x2 o; o.x = cvt_pk_bf16(v[j][0] * rs * gg[0], v[j][1] * rs * gg[1]); o.y = cvt_pk_bf16(v[j][2] * rs * gg[2], v[j][3] * rs * gg[3]);
                *(u32x2*)(orow + 4 * lane + 256 * j) = o; }
        } else {
            float* orow = F.out + (size_t)m * DM;
#pragma unroll
            for (int j = 0; j < 8; ++j) *(f32x4*)(orow + 4 * lane + 256 * j) = v[j];
        }
    }
}

constexpr int N_PHASES = 17;
#ifndef PHASE_MASK
#define PHASE_MASK 0x1ff
#endif
#ifndef MIX_MASK
#define MIX_MASK 7
#endif
#ifndef DUP_PHASE
#define DUP_PHASE 0
#endif
#define DUP(k) for (int _d = 0; _d < ((DUP_PHASE == (k)) ? 2 : 1); ++_d)
#define IN(k) (lo <= (k) && (k) < hi)
#define EN(b) ((PHASE_MASK >> (b)) & 1)
#ifndef PROBE_STAMP
#define PROBE_STAMP (-1)
#endif
#define SEAM(k) do { if (IN(k) && IN((k) + 1)) { xcd_barrier(bar); if (PROBE_STAMP >= 0 && blockIdx.x == 0 && F.tid == 0) { const unsigned long long _t = wall_clock64(); F.MISC[802 + 2 * (k)] = (unsigned)_t; F.MISC[803 + 2 * (k)] = (unsigned)(_t >> 32); } } } while (0)
template <int l>
__device__ __forceinline__ void layer_phases(Frame& F, const XcdBarrier& bar, const int lo, const int hi) {
    constexpr int pb = 1 + 8 * l;
    if (EN(1) && IN(pb)) {
        pg8::StaticSched S; S.init((const bf16*)(F.ws + WS_HN), (const bf16*)(F.ws + WS_WIN) + (size_t)l * DIN * DM, SEQ, DIN, DM, F.G, (int)blockIdx.x);
        pg8::EpiProj E{(bf16*)(F.ws + WS_PROJ)};
        DUP(1) pg8::gemm_phase<pg8::EpiProj, pg8::StaticSched>(F.lds, DM, S, E);
    }
    SEAM(pb);
    if (EN(2) && IN(pb + 1)) {
        constexpr int N_SGU = 256, N_CONV = 512, N_ATT = 3072;
#define MSTAMP(i) do { if (PROBE_STAMP >= 100 && l == 0 && blockIdx.x == 0 && F.tid == 0) { const unsigned long long _t = wall_clock64(); F.MISC[900 + 2 * (i)] = (unsigned)_t; F.MISC[901 + 2 * (i)] = (unsigned)(_t >> 32); } } while (0)
        MSTAMP(0);
        if (MIX_MASK & 1) DUP(2) att_phase(F, l);
        MSTAMP(1);
        if (MIX_MASK & 2) DUP(3) for (int it = (int)blockIdx.x; it < N_CONV; it += F.G) conv_item(F, l, it);
        MSTAMP(2);
        if (MIX_MASK & 4) DUP(4) for (int it = (int)blockIdx.x; it < N_SGU; it += F.G) sgu_item(F, l, it >> 1, it & 1);
        MSTAMP(3);
#undef MSTAMP
    }
    SEAM(pb + 1);
    if (DUP_PHASE == 12 && IN(pb + 1)) {
        pg8::StaticSched S; S.init((const bf16*)(F.ws + WS_MIX), (const bf16*)(F.ws + WS_WIN) + (size_t)l * DIN * DM, SEQ, DIN, DM, F.G, (int)blockIdx.x);
        pg8::EpiProj E{(bf16*)(F.ws + WS_PROJ)};
        pg8::gemm_phase<pg8::EpiProj, pg8::StaticSched>(F.lds, DM, S, E);
        xcd_barrier(bar);
    }
    if (EN(3) && IN(pb + 2)) DUP(5) att_combine(F, l);
    SEAM(pb + 2);
    if (EN(4) && IN(pb + 3)) {
        pg8::StaticSched S; S.init((const bf16*)(F.ws + WS_MIX), (const bf16*)(F.ws + WS_WOUT) + (size_t)l * DM * DM, SEQ, DM, DM, F.G, (int)blockIdx.x);
        if constexpr (l == 0) { pg8::EpiResid<false> E{(const void*)F.in[IN_X], (bf16*)(F.ws + WS_HN)}; DUP(6) pg8::gemm_phase<pg8::EpiResid<false>, pg8::StaticSched>(F.lds, DM, S, E); }
        else { pg8::EpiResid<true> E{(const void*)(F.ws + WS_H), (bf16*)(F.ws + WS_HN)}; DUP(6) pg8::gemm_phase<pg8::EpiResid<true>, pg8::StaticSched>(F.lds, DM, S, E); }
    }
    SEAM(pb + 3);
    if (EN(5) && IN(pb + 4)) { router_phase(F, l); if (DUP_PHASE == 11) router_phase(F, l, 1); }
    if (DUP_PHASE == 13 && IN(pb + 4)) { for (int q = 0; q < 8; ++q) xcd_barrier(bar); }
    SEAM(pb + 4);
    if (EN(6) && IN(pb + 5)) {
        moe_table(F, l);
        pg8::SchedG1 S{(const LAS int*)(F.lds + MISC_OFF + 64), (const int*)((const unsigned*)(F.ws + WS_CTL) + CW_CNT + 2048 * l), (const int*)(F.ws + WS_TOK), (const bf16*)(F.ws + WS_HN),
                       (const bf16*)(F.ws + WS_W1) + (size_t)l * NE * 1024 * DM, F.G, (int)blockIdx.x};
        pg8::EpiSwiGLU E{(bf16*)(F.ws + WS_HB), (const float*)(F.ws + WS_RSLOT)};
        DUP(7) pg8::gemm_phase<pg8::EpiSwiGLU, pg8::SchedG1>(F.lds, DM, S, E);
    }
    SEAM(pb + 5);
    if (EN(7) && IN(pb + 6)) {
        moe_table(F, l);
        pg8::SchedG2 S{(const LAS int*)(F.lds + MISC_OFF + 64), (const bf16*)(F.ws + WS_HB), (const bf16*)(F.ws + WS_W2) + (size_t)l * NE * DM * DE, F.G, (int)blockIdx.x};
        pg8::EpiY E{(bf16*)(F.ws + WS_Y)};
        DUP(8) pg8::gemm_phase<pg8::EpiY, pg8::SchedG2>(F.lds, DE, S, E);
    }
    SEAM(pb + 6);
    if (EN(8) && IN(pb + 7)) { moe_table(F, l); DUP(l == 0 ? 9 : 99) combine_phase(F, l); }
    SEAM(pb + 7);
}
__global__ void __launch_bounds__(NTHREADS, 2) fwd_kernel(Params args) {
    extern __shared__ __attribute__((aligned(16))) unsigned char lds_raw[];
    Frame F;
    F.lds = (LAS unsigned char*)lds_raw; F.MISC = (volatile LAS unsigned*)(F.lds + MISC_OFF);
    F.tid = threadIdx.x; F.lane = F.tid & 63; F.wave = __builtin_amdgcn_readfirstlane(F.tid >> 6);
    F.G = gridDim.x; { const int bx = blockIdx.x; F.vcu = (F.G % 8 == 0) ? (bx % 8) * (F.G / 8) + bx / 8 : bx; }
    F.in = args.in; F.out = args.out; F.ws = args.ws;
    for (int u = F.tid; u < (LDS_BYTES - MISC_OFF) / 4; u += NTHREADS) ((LAS unsigned*)(F.lds + MISC_OFF))[u] = 0u;
    __syncthreads();
    unsigned* ctl = (unsigned*)(args.ws + WS_CTL);
    const int lo = args.ph_lo, hi = args.ph_hi;
    const bool multi = (hi - lo) > 1;
    XcdBarrier bar; bar.bar = ctl + CW_BAR; bar.x = 0; bar.st = nullptr;
    if (multi) bar = xcd_barrier_post(ctl + CW_BAR, F.MISC);
    if (PROBE_STAMP >= 0 && blockIdx.x == 0 && F.tid == 0) { const unsigned long long _t = wall_clock64(); F.MISC[800] = (unsigned)_t; F.MISC[801] = (unsigned)(_t >> 32); }
    if (EN(0) && IN(0)) { DUP(10) p_prologue(F); }
    SEAM(0);
    layer_phases<0>(F, bar, lo, hi);
    layer_phases<1>(F, bar, lo, hi);
    if (PROBE_STAMP >= 0 && blockIdx.x == 0 && F.tid == 0) {
        asm volatile("s_waitcnt vmcnt(0)" ::: "memory");
        constexpr int SB = PROBE_STAMP >= 100 ? 900 + 2 * (PROBE_STAMP - 100) : 800 + 2 * PROBE_STAMP;
        const unsigned long long t1 = ((unsigned long long)F.MISC[SB + 3] << 32) | F.MISC[SB + 2], t0 = ((unsigned long long)F.MISC[SB + 1] << 32) | F.MISC[SB];
        F.out[0] += (float)(long long)(t1 - t0) * 0.01f;
    }
}
#undef IN
#undef EN
#undef SEAM
#undef DUP

extern "C" void kernel_launch(void* const* d_in, const int* in_sizes, int n_in, void* d_out, int out_size, void* d_ws, size_t ws_size, hipStream_t stream) {
    static int grid = 0;
    if (grid == 0) {
        if (n_in != 22 || out_size != SEQ * DM || ws_size < WS_END) { fprintf(stderr, "kernel_launch: unexpected shapes (n_in %d out %d ws %zu, need %zu)\n", n_in, out_size, ws_size, (size_t)WS_END); grid = -1; return; }
        int dev = 0, cus = 0, per_cu = 0;
        if (hipGetDevice(&dev) != hipSuccess || hipDeviceGetAttribute(&cus, hipDeviceAttributeMultiprocessorCount, dev) != hipSuccess) { grid = -1; return; }
        if (hipFuncSetAttribute((const void*)fwd_kernel, hipFuncAttributeMaxDynamicSharedMemorySize, LDS_BYTES) != hipSuccess) { fprintf(stderr, "kernel_launch: hipFuncSetAttribute failed\n"); grid = -1; return; }
        if (hipOccupancyMaxActiveBlocksPerMultiprocessor(&per_cu, (const void*)fwd_kernel, NTHREADS, LDS_BYTES) != hipSuccess || per_cu < 1) { fprintf(stderr, "kernel_launch: occupancy query says %d\n", per_cu); }
        (void)hipGetLastError();
        grid = cus;
    }
    if (grid < 0) return;
    if (hipMemsetAsync((char*)d_ws + WS_CTL, 0, CTL_ZERO_BYTES, stream) != hipSuccess) return;
    Params p{};
    for (int i = 0; i < 22; ++i) p.in[i] = (const float*)d_in[i];
    p.out = (float*)d_out; p.ws = (unsigned char*)d_ws;
    constexpr int NL = MK_N_LAUNCHES;
    for (int li = 0; li < NL; ++li) {
        p.ph_lo = (NL == 1) ? 0 : li; p.ph_hi = (NL == 1) ? N_PHASES : li + 1;
        hipLaunchKernelGGL(fwd_kernel, dim3(grid), dim3(NTHREADS), LDS_BYTES, stream, p);
        if (hipPeekAtLastError() != hipSuccess) { fprintf(stderr, "kernel_launch: launch %d failed\n", li); break; }
    }
}
```

```cpp
#include <hip/hip_runtime.h>
#include <cstdio>
#include <cstdint>

#ifndef MK_N_LAUNCHES
#define MK_N_LAUNCHES 1
#endif

#ifndef ATT_EXP
#define ATT_EXP 0
#endif
#define GAS __attribute__((address_space(1)))
#define LAS __attribute__((address_space(3)))
typedef unsigned short bf16;
typedef short bf16x8 __attribute__((ext_vector_type(8)));
typedef short s16x4 __attribute__((ext_vector_type(4)));
typedef float f32x4 __attribute__((ext_vector_type(4)));
typedef float f32x2 __attribute__((ext_vector_type(2)));
typedef unsigned u32x4 __attribute__((ext_vector_type(4)));
typedef unsigned u32x2 __attribute__((ext_vector_type(2)));

constexpr int SEQ = 16384, DM = 2048, DIN = 5120, NLAYER = 2;
constexpr int HD = 128, NHEAD = 8, CONV_K = 31;
constexpr int NE = 32, DE = 512, TOKCAP = 16384;
constexpr int OFF_U = 0, OFF_V = 512, OFF_A = 1024, OFF_G = 1536, OFF_Q = 2048, OFF_K = 3072, OFF_VV = 4096;
constexpr float EPS = 1e-6f;
constexpr int NWAVES = 8, NTHREADS = 512;

constexpr size_t MiB = 1u << 20;
constexpr size_t WS_CTL = 0, CTL_ZERO_BYTES = 1 * MiB;
constexpr size_t WS_WIN = 1 * MiB;
constexpr size_t WS_WOUT = 41 * MiB;
constexpr size_t WS_W1 = 57 * MiB;
constexpr size_t WS_W2 = 313 * MiB;
constexpr size_t WS_SGUW = 441 * MiB;
constexpr size_t WS_WRT = 442 * MiB;
constexpr size_t WS_TOK = 443 * MiB;
constexpr size_t WS_TINFO = 445 * MiB;
constexpr size_t WS_HN = 446 * MiB;
constexpr size_t WS_HB = 510 * MiB;
constexpr size_t WS_ATT = WS_HN;
constexpr size_t WS_LSE = WS_HN + 96 * MiB;
constexpr size_t WS_PROJ = 550 * MiB;
constexpr size_t WS_Y = WS_PROJ;
constexpr size_t WS_MIX = 710 * MiB;
constexpr size_t WS_H = 774 * MiB;
constexpr size_t WS_RSLOT = 902 * MiB;
constexpr size_t WS_ALT = 904 * MiB;
constexpr size_t WS_END = 910 * MiB;
constexpr int CW_BAR = 4096;
constexpr int CW_TMO = 0;
constexpr int CW_RDY = 65536;
constexpr int CW_CNT = 16384, CNT_STRIDE = 64;

constexpr int LDS_BYTES = 163840;
constexpr int MISC_OFF = 159744;

__device__ __forceinline__ unsigned cvt_pk_bf16(float lo, float hi) { unsigned r; asm volatile("v_cvt_pk_bf16_f32 %0, %1, %2" : "=v"(r) : "v"(lo), "v"(hi)); return r; }
__device__ __forceinline__ float bf_lo(unsigned u) { return __builtin_bit_cast(float, u << 16); }
__device__ __forceinline__ float bf_hi(unsigned u) { return __builtin_bit_cast(float, u & 0xffff0000u); }
template <int CTRL, int RM> __device__ __forceinline__ float dpp_mov0(float v) { return __builtin_bit_cast(float, __builtin_amdgcn_update_dpp(0, __builtin_bit_cast(int, v), CTRL, RM, 0xf, false)); }
__device__ __forceinline__ float wave_sum(float s) {
    s += dpp_mov0<0xB1, 0xf>(s); s += dpp_mov0<0x4E, 0xf>(s); s += dpp_mov0<0x141, 0xf>(s); s += dpp_mov0<0x140, 0xf>(s);
    s += dpp_mov0<0x142, 0xa>(s); s += dpp_mov0<0x143, 0xc>(s);
    return __builtin_bit_cast(float, __builtin_amdgcn_readlane(__builtin_bit_cast(int, s), 63));
}
__device__ __forceinline__ float row16_sum(float s) {
    s += dpp_mov0<0xB1, 0xf>(s); s += dpp_mov0<0x4E, 0xf>(s); s += dpp_mov0<0x141, 0xf>(s); s += dpp_mov0<0x140, 0xf>(s); return s;
}
#define LDS_WAIT() asm volatile("s_waitcnt lgkmcnt(0)" ::: "memory")
#define VM_WAIT() asm volatile("s_waitcnt vmcnt(0)" ::: "memory")
__device__ __forceinline__ float fast_exp(float x) { return __builtin_amdgcn_exp2f(x * 1.4426950408889634f); }
__device__ __forceinline__ float sigmoidf_(float x) { return __builtin_amdgcn_rcpf(1.0f + fast_exp(-x)); }
__device__ __forceinline__ float gelu_tanh(float x) { const float z = 1.5957691216057308f * (x + 0.044715f * x * x * x); return x * sigmoidf_(z); }

#define XB_TMO      128
#define XB_XCNT(j)  (256  + 64 * (j))
#define XB_XSUB(j)  (1280 + 64 * (j))
#define XB_XGEN(j)  (2304 + 64 * (j))
#define XB_TOP      3328
#define XB_TOPGEN   3392
#define XCD_BAR_WORDS 3456
#define XB_SPIN_CAP (1u << 22)
__device__ __forceinline__ unsigned xb_ld(unsigned* p)              { return __hip_atomic_load(p, __ATOMIC_RELAXED, __HIP_MEMORY_SCOPE_AGENT); }
__device__ __forceinline__ unsigned xb_add(unsigned* p, unsigned v) { return __hip_atomic_fetch_add(p, v, __ATOMIC_RELAXED, __HIP_MEMORY_SCOPE_AGENT); }
__device__ __forceinline__ unsigned xb_xcc_id() { return (unsigned)__builtin_amdgcn_s_getreg((3 << 11) | 20) & 0xFu; }
#define XB_SPIN(cond, bar) do { unsigned _sp = 0; while (cond) { __builtin_amdgcn_s_sleep(1); \
    if ((++_sp & 255u) == 0u) { if (xb_ld(&(bar)[XB_TMO])) break; if (_sp > XB_SPIN_CAP) { atomicAdd(&(bar)[XB_TMO], 1u); break; } } } } while (0)
struct XcdBarrier { unsigned* bar; unsigned x; volatile LAS unsigned* st; };
__device__ __forceinline__ XcdBarrier xcd_barrier_post(unsigned* bar, volatile LAS unsigned* st) {
    XcdBarrier b; b.bar = bar; b.x = xb_xcc_id(); b.st = st;
    if (threadIdx.x == 0) (void)xb_add(&bar[XB_XCNT(b.x)], 1u);
    return b;
}
__device__ __forceinline__ void xcd_barrier_complete(unsigned* bar, unsigned x, unsigned& nloc, unsigned& nx) {
    const unsigned G = gridDim.x * gridDim.y * gridDim.z;
    unsigned sum, cnt, mine, sp = 0u;
    for (;;) {
        sum = 0u; cnt = 0u; mine = 0u;
#pragma unroll
        for (unsigned j = 0; j < 16; ++j) { const unsigned c = xb_ld(&bar[XB_XCNT(j)]); sum += c; cnt += (c > 0u) ? 1u : 0u; mine = (j == x) ? c : mine; }
        if (sum == G) break;
        __builtin_amdgcn_s_sleep(1);
        if ((++sp & 255u) == 0u) { if (xb_ld(&bar[XB_TMO])) break; if (sp > XB_SPIN_CAP) { atomicAdd(&bar[XB_TMO], 1u); break; } }
    }
    nloc = mine > 0u ? mine : 1u; nx = cnt > 0u ? cnt : 1u;
}
__device__ __forceinline__ void xcd_barrier(const XcdBarrier& b) {
    asm volatile("s_waitcnt vmcnt(0)" ::: "memory");
    __syncthreads();
    if (threadIdx.x == 0) {
        unsigned* bar = b.bar;
        __builtin_amdgcn_s_waitcnt(0);
        unsigned nloc = b.st[0], nx = b.st[1];
        if (nloc == 0u) { xcd_barrier_complete(bar, b.x, nloc, nx); b.st[0] = nloc; b.st[1] = nx; }
        const unsigned old = xb_add(&bar[XB_XSUB(b.x)], 1u);
        const unsigned gen = old / nloc;
        if (old + 1u == (gen + 1u) * nloc) {
            __builtin_amdgcn_fence(__ATOMIC_RELEASE, "agent");
            asm volatile("s_waitcnt vmcnt(0)" ::: "memory");
            const unsigned og = xb_add(&bar[XB_TOP], 1u);
            const unsigned tg = og / nx;
            if (og + 1u == (tg + 1u) * nx) xb_add(&bar[XB_TOPGEN], 1u);
            else XB_SPIN(xb_ld(&bar[XB_TOPGEN]) == tg, bar);
            __builtin_amdgcn_fence(__ATOMIC_ACQUIRE, "agent");
            xb_add(&bar[XB_XGEN(b.x)], 1u);
            asm volatile("s_waitcnt vmcnt(0)" ::: "memory");
        } else {
            XB_SPIN(xb_ld(&bar[XB_XGEN(b.x)]) == gen, bar);
            __builtin_amdgcn_fence(__ATOMIC_ACQUIRE, "agent");
            asm volatile("s_waitcnt vmcnt(0)" ::: "memory");
        }
    }
    __syncthreads();
}

namespace pg8 {
constexpr int BM = 256, BK = 64, HALF = 128, HTB = HALF * BK * 2, STAGE_BYTES = 8 * HTB, NXCD = 8, WGM = 8;
__device__ __forceinline__ int lds_byte(int r, int c) { const int st = (r >> 4) * 2 + (c >> 5), rr = r & 15, cc = c & 31, ob = rr * 64 + cc * 2; return st * 1024 + (ob ^ (((ob >> 9) & 1) << 5)); }
__device__ __forceinline__ void stage_rc(int b, int& R, int& C) { const int st = b / 1024, sb = b % 1024, swz = sb ^ (((sb >> 9) & 1) << 5); R = (st >> 1) * 16 + swz / 64; C = (st & 1) * 32 + (swz % 64) / 2; }
__device__ __forceinline__ int perm32(int rho) { const int n = rho >> 4, i = rho & 15; return 8 * (i >> 2) + 4 * n + (i & 3); }

struct Unit { int pm, pn, e, rb; };

struct StaticSched {
    static constexpr bool GATHER = false;
    const bf16* A; const bf16* Bt; int K; int nM, nN, nwg, G, c;
    __device__ __forceinline__ void init(const bf16* A_, const bf16* Bt_, int M, int N, int K_, int G_, int c_) { A = A_; Bt = Bt_; K = K_; nM = M / BM; nN = N / BM; nwg = nM * nN; G = G_; c = c_; }
    __device__ __forceinline__ bool next(int i, Unit& u) const {
        const long L = (long)i * G + c; if (L >= nwg) return false;
        int wgid = (int)L; { const int q = nwg / NXCD, r = nwg % NXCD, xcd = wgid % NXCD, off = wgid / NXCD; wgid = (xcd < r ? xcd * (q + 1) : r * (q + 1) + (xcd - r) * q) + off; }
        const int nig = WGM * nN, gid = wgid / nig, fm = gid * WGM, gsz = (nM - fm) < WGM ? (nM - fm) : WGM;
        u.pm = fm + ((wgid % nig) % gsz); u.pn = (wgid % nig) / gsz; u.e = 0; u.rb = 0; return true;
    }
    __device__ __forceinline__ void a_ready(const Unit&) const {}
    __device__ __forceinline__ void done(const Unit&) const {}
    __device__ __forceinline__ const char* a_base(const Unit& u) const { return (const char*)A + (size_t)u.pm * BM * K * 2; }
    __device__ __forceinline__ const char* b_base(const Unit& u) const { return (const char*)Bt + (size_t)u.pn * BM * K * 2; }
    __device__ __forceinline__ void a_voff(const Unit&, const int (&R)[2], const int (&C)[2], unsigned (&v)[2][2]) const {
#pragma unroll
        for (int h = 0; h < 2; ++h)
#pragma unroll
            for (int i = 0; i < 2; ++i) v[h][i] = (unsigned)((h * HALF + R[i]) * K + C[i]) * 2u;
    }
};

template <class Epi, class Sched, bool ALIGN_EPI = true>
__device__ __forceinline__ void gemm_phase(LAS unsigned char* lds, const int K, const Sched& S, const Epi& E) {
    const int tid = threadIdx.x, wid = __builtin_amdgcn_readfirstlane(tid >> 6), lane = tid & 63, wr = wid >> 2, wc = wid & 3, fr = lane & 15, fq = lane >> 4;
    const int nt = K / BK;
    int Rr[2], Cc[2]; unsigned voffB[2];
#pragma unroll
    for (int i = 0; i < 2; ++i) { stage_rc(tid * 16 + i * 8192, Rr[i], Cc[i]); const int Rb = Epi::PERM ? ((Rr[i] & ~31) + perm32(Rr[i] & 31)) : Rr[i];
        voffB[i] = (unsigned)(Rb * K + Cc[i]) * 2u; }
    const size_t kstep = (size_t)(BK * 2);
    const size_t hstep = (size_t)HALF * K * 2;
    const unsigned ldsw = (unsigned)wid * 1024u;
    const int aoff = lds_byte(wr * 64 + fr, fq * 8), boff = lds_byte(wc * 32 + fr, fq * 8);
#define PG8_SA(b, h) (((b) * 2 + (h)) * HTB)
#define PG8_SB(b, h) ((4 + (b) * 2 + (h)) * HTB)
#define PG8_STAGE(bufoff, gbase, voff) do { _Pragma("unroll") for (int _i = 0; _i < 2; ++_i) \
        __builtin_amdgcn_global_load_lds((const unsigned*)((const char*)(gbase) + (voff)[_i]), (LAS unsigned*)(lds + (bufoff) + ldsw + _i * 8192), 16, 0, 0); } while (0)
#define PG8_LDA(dst, b, h) do { _Pragma("unroll") for (int m = 0; m < 4; ++m) _Pragma("unroll") for (int k = 0; k < 2; ++k) dst[m][k] = *(const LAS bf16x8*)(lds + PG8_SA(b, h) + aoff + m * 2048 + k * 1024); } while (0)
#define PG8_LDB(dst, b, h) do { _Pragma("unroll") for (int n = 0; n < 2; ++n) _Pragma("unroll") for (int k = 0; k < 2; ++k) dst[n][k] = *(const LAS bf16x8*)(lds + PG8_SB(b, h) + boff + n * 2048 + k * 1024); } while (0)
#define PG8_MMA(ai, bj, At, Bt) do { __builtin_amdgcn_s_setprio(1); _Pragma("unroll") for (int m = 0; m < 4; ++m) _Pragma("unroll") for (int n = 0; n < 2; ++n) _Pragma("unroll") for (int k = 0; k < 2; ++k) \
        acc[ai][bj][m][n] = __builtin_amdgcn_mfma_f32_16x16x32_bf16(Bt[n][k], At[m][k], acc[ai][bj][m][n], 0, 0, 0); __builtin_amdgcn_s_setprio(0); } while (0)
#define PG8_WAIT_V(n) asm volatile("s_waitcnt vmcnt(" #n ")" ::: "memory")
#define PG8_WAIT_L(n) asm volatile("s_waitcnt lgkmcnt(" #n ")" ::: "memory")
#define PG8_BAR __builtin_amdgcn_s_barrier()
#define PG8_SCHED __builtin_amdgcn_sched_barrier(0)
    Unit cur, nxt; int ui = 0;
    if (!S.next(0, cur)) return;
    f32x4 acc[2][2][4][2];
#pragma unroll
    for (int a = 0; a < 2; ++a)
#pragma unroll
        for (int b = 0; b < 2; ++b)
#pragma unroll
            for (int m = 0; m < 4; ++m)
#pragma unroll
                for (int n = 0; n < 2; ++n) acc[a][b][m][n] = (f32x4){0.f, 0.f, 0.f, 0.f};
    bf16x8 At[4][2], B0[2][2], B1[2][2];
    const char* cA = S.a_base(cur); const char* cB = S.b_base(cur);
    S.a_ready(cur);
    constexpr bool GATHER = Sched::GATHER;
    constexpr int NV = GATHER ? 2 : 1;
    unsigned vA[NV][2], nvA[NV][2];
    if constexpr (GATHER) S.a_voff(cur, Rr, Cc, vA);
    else {
#pragma unroll
        for (int i = 0; i < 2; ++i) vA[0][i] = (unsigned)(Rr[i] * K + Cc[i]) * 2u; }
    const size_t ahstep = GATHER ? 0 : hstep;
#define PG8_STAGE_A(bufoff, kptr, h, vv) PG8_STAGE(bufoff, (kptr) + (h) * ahstep, (vv)[GATHER ? (h) : 0])
    PG8_STAGE(PG8_SB(0, 0), cB, voffB); PG8_STAGE(PG8_SB(0, 1), cB + hstep, voffB); PG8_STAGE_A(PG8_SA(0, 0), cA, 0, vA); PG8_STAGE_A(PG8_SA(0, 1), cA, 1, vA);
    if (wr == 1) PG8_BAR;
    PG8_WAIT_V(2); PG8_BAR;
    PG8_STAGE(PG8_SB(1, 0), cB + kstep, voffB); PG8_STAGE_A(PG8_SA(1, 0), cA + kstep, 0, vA); PG8_STAGE(PG8_SB(1, 1), cB + hstep + kstep, voffB);
    PG8_WAIT_V(6); PG8_BAR;
    for (;;) {
        const bool has_next = S.next(ui + 1, nxt);
        const char* nA = has_next ? S.a_base(nxt) : cA; const char* nB = has_next ? S.b_base(nxt) : cB;
        if constexpr (GATHER) {
            if (has_next) S.a_voff(nxt, Rr, Cc, nvA);
            else { nvA[0][0] = vA[0][0]; nvA[0][1] = vA[0][1]; nvA[NV - 1][0] = vA[NV - 1][0]; nvA[NV - 1][1] = vA[NV - 1][1]; }
        }
        for (int t = 0; t < nt; t += 2) {
            const bool last = (t == nt - 2);
            const char* a1 = cA + (size_t)(t + 1) * kstep;
            const char* a2 = last ? nA : cA + (size_t)(t + 2) * kstep; const char* b2 = last ? nB : cB + (size_t)(t + 2) * kstep;
            const char* a3 = a2 + kstep; const char* b3 = b2 + kstep;
            if (last && has_next) S.a_ready(nxt);
            unsigned wA[NV][2];
            if constexpr (GATHER) { wA[0][0] = last ? nvA[0][0] : vA[0][0]; wA[0][1] = last ? nvA[0][1] : vA[0][1]; wA[NV - 1][0] = last ? nvA[NV - 1][0] : vA[NV - 1][0]; wA[NV - 1][1] = last ? nvA[NV - 1][1] : vA[NV - 1][1]; }
            else { wA[0][0] = vA[0][0]; wA[0][1] = vA[0][1]; }
            PG8_LDB(B0, 0, 0); PG8_LDB(B1, 0, 1); PG8_SCHED; PG8_LDA(At, 0, 0); PG8_STAGE_A(PG8_SA(1, 1), a1, 1, vA);
            PG8_WAIT_V(8); PG8_WAIT_L(0); PG8_BAR; PG8_MMA(0, 0, At, B0); PG8_MMA(0, 1, At, B1); PG8_BAR; PG8_SCHED;
            PG8_LDA(At, 0, 1); PG8_STAGE(PG8_SB(0, 0), b2, voffB); PG8_STAGE(PG8_SB(0, 1), b2 + hstep, voffB); PG8_STAGE_A(PG8_SA(0, 0), a2, 0, wA);
            PG8_WAIT_V(8); PG8_WAIT_L(0); PG8_BAR; PG8_MMA(1, 0, At, B0); PG8_MMA(1, 1, At, B1); PG8_BAR; PG8_SCHED;
            PG8_LDB(B0, 1, 0); PG8_LDB(B1, 1, 1); PG8_SCHED; PG8_LDA(At, 1, 0); PG8_STAGE_A(PG8_SA(0, 1), a2, 1, wA);
            PG8_WAIT_V(8); PG8_WAIT_L(0); PG8_BAR; PG8_MMA(0, 0, At, B0); PG8_MMA(0, 1, At, B1); PG8_BAR; PG8_SCHED;
            PG8_LDA(At, 1, 1); PG8_STAGE(PG8_SB(1, 0), b3, voffB); PG8_STAGE(PG8_SB(1, 1), b3 + hstep, voffB); PG8_STAGE_A(PG8_SA(1, 0), a3, 0, wA);
            PG8_WAIT_V(8); PG8_WAIT_L(0); PG8_BAR; PG8_MMA(1, 0, At, B0); PG8_MMA(1, 1, At, B1); PG8_BAR; PG8_SCHED;
        }
        if constexpr (ALIGN_EPI) { if (wr == 0) PG8_BAR; }
        E(acc, cur, wr, wc, fr, fq); S.done(cur);
        if (!has_next) break;
#pragma unroll
        for (int a = 0; a < 2; ++a)
#pragma unroll
            for (int b = 0; b < 2; ++b)
#pragma unroll
                for (int m = 0; m < 4; ++m)
#pragma unroll
                    for (int n = 0; n < 2; ++n) acc[a][b][m][n] = (f32x4){0.f, 0.f, 0.f, 0.f};
        cur = nxt; cA = nA; cB = nB; ++ui;
        if constexpr (GATHER) { vA[0][0] = nvA[0][0]; vA[0][1] = nvA[0][1]; vA[NV - 1][0] = nvA[NV - 1][0]; vA[NV - 1][1] = nvA[NV - 1][1]; }
        if constexpr (ALIGN_EPI) { if (wr == 1) PG8_BAR; }
    }
    PG8_WAIT_V(0);
    if constexpr (!ALIGN_EPI) { if (wr == 0) PG8_BAR; }
    PG8_BAR;
#undef PG8_SA
#undef PG8_SB
#undef PG8_STAGE
#undef PG8_STAGE_A
#undef PG8_LDA
#undef PG8_LDB
#undef PG8_MMA
#undef PG8_WAIT_V
#undef PG8_WAIT_L
#undef PG8_BAR
#undef PG8_SCHED
}

struct EpiProj {
    static constexpr bool PERM = true;
    bf16* O;
    __device__ __forceinline__ void operator()(const f32x4 (&acc)[2][2][4][2], const Unit& u, int wr, int wc, int fr, int fq) const {
        const int row0 = u.pm * BM + wr * 64 + fr, col0 = u.pn * BM + wc * 32 + 8 * fq;
        const bool act = u.pn < 4;
#pragma unroll
        for (int ai = 0; ai < 2; ++ai)
#pragma unroll
            for (int m = 0; m < 4; ++m) { bf16* rowp = O + (size_t)(row0 + ai * HALF + m * 16) * DIN + col0;
#pragma unroll
                for (int bj = 0; bj < 2; ++bj) { f32x4 v0 = acc[ai][bj][m][0], v1 = acc[ai][bj][m][1];
                    if (act) {
#pragma unroll
                        for (int j = 0; j < 4; ++j) { v0[j] = gelu_tanh(v0[j]); v1[j] = gelu_tanh(v1[j]); } }
                    u32x4 w; w.x = cvt_pk_bf16(v0[0], v0[1]); w.y = cvt_pk_bf16(v0[2], v0[3]); w.z = cvt_pk_bf16(v1[0], v1[1]); w.w = cvt_pk_bf16(v1[2], v1[3]);
                    *(u32x4*)(rowp + bj * HALF) = w; } }
    }
};
template <bool RES_BF16> struct EpiResid {
    static constexpr bool PERM = true;
    const void* res; bf16* out;
    __device__ __forceinline__ void operator()(const f32x4 (&acc)[2][2][4][2], const Unit& u, int wr, int wc, int fr, int fq) const {
        const int row0 = u.pm * BM + wr * 64 + fr, col0 = u.pn * BM + wc * 32 + 8 * fq;
#pragma unroll
        for (int ai = 0; ai < 2; ++ai) {
            if constexpr (RES_BF16) {
                u32x4 r[4][2];
#pragma unroll
                for (int m = 0; m < 4; ++m)
#pragma unroll
                    for (int bj = 0; bj < 2; ++bj) r[m][bj] = *(const u32x4*)((const bf16*)res + (size_t)(row0 + ai * HALF + m * 16) * DM + col0 + bj * HALF);
                asm volatile("s_waitcnt vmcnt(0)" ::: "memory");
#pragma unroll
                for (int m = 0; m < 4; ++m)
#pragma unroll
                    for (int bj = 0; bj < 2; ++bj) { f32x4 v0 = acc[ai][bj][m][0], v1 = acc[ai][bj][m][1]; const u32x4 q = r[m][bj];
                        v0[0] += bf_lo(q.x); v0[1] += bf_hi(q.x); v0[2] += bf_lo(q.y); v0[3] += bf_hi(q.y); v1[0] += bf_lo(q.z); v1[1] += bf_hi(q.z); v1[2] += bf_lo(q.w); v1[3] += bf_hi(q.w);
                        u32x4 w; w.x = cvt_pk_bf16(v0[0], v0[1]); w.y = cvt_pk_bf16(v0[2], v0[3]); w.z = cvt_pk_bf16(v1[0], v1[1]); w.w = cvt_pk_bf16(v1[2], v1[3]);
                        *(u32x4*)(out + (size_t)(row0 + ai * HALF + m * 16) * DM + col0 + bj * HALF) = w; }
            } else {
#pragma unroll
                for (int mh = 0; mh < 2; ++mh) {
                    f32x4 r[2][2][2];
#pragma unroll
                    for (int m = 0; m < 2; ++m)
#pragma unroll
                        for (int bj = 0; bj < 2; ++bj) { const float* rp = (const float*)res + (size_t)(row0 + ai * HALF + (2 * mh + m) * 16) * DM + col0 + bj * HALF; r[m][bj][0] = *(const f32x4*)rp; r[m][bj][1] = *(const f32x4*)(rp + 4); }
                    asm volatile("s_waitcnt vmcnt(0)" ::: "memory");
#pragma unroll
                    for (int m = 0; m < 2; ++m)
#pragma unroll
                        for (int bj = 0; bj < 2; ++bj) { const f32x4 v0 = acc[ai][bj][2 * mh + m][0] + r[m][bj][0], v1 = acc[ai][bj][2 * mh + m][1] + r[m][bj][1];
                            u32x4 w; w.x = cvt_pk_bf16(v0[0], v0[1]); w.y = cvt_pk_bf16(v0[2], v0[3]); w.z = cvt_pk_bf16(v1[0], v1[1]); w.w = cvt_pk_bf16(v1[2], v1[3]);
                            *(u32x4*)(out + (size_t)(row0 + ai * HALF + (2 * mh + m) * 16) * DM + col0 + bj * HALF) = w; }
                }
            }
        }
    }
};
struct EpiSwiGLU {
    static constexpr bool PERM = true;
    bf16* HB; const float* rslot;
    __device__ __forceinline__ void operator()(const f32x4 (&acc)[2][2][4][2], const Unit& u, int wr, int wc, int fr, int fq) const {
        const int row0 = u.pm * BM + wr * 64 + fr, col0 = u.pn * HALF + wc * 32 + 8 * fq;
        const __amdgpu_buffer_rsrc_t rsrc = __builtin_amdgcn_make_buffer_rsrc((void*)HB, 0, 40960 * DE * 2, 0x00020000);
        const float* rsl = rslot + (size_t)u.e * TOKCAP + u.rb * BM + wr * 64 + fr;
        float rsv[2][4];
#pragma unroll
        for (int ai = 0; ai < 2; ++ai)
#pragma unroll
            for (int m = 0; m < 4; ++m) rsv[ai][m] = rsl[ai * HALF + m * 16];
        asm volatile("s_waitcnt vmcnt(0)" ::: "memory");
#pragma unroll
        for (int ai = 0; ai < 2; ++ai)
#pragma unroll
            for (int m = 0; m < 4; ++m) { const unsigned boff = (unsigned)((row0 + ai * HALF + m * 16) * DE + col0) * 2u;
                const float rs = rsv[ai][m];
                float h[8];
#pragma unroll
                for (int n = 0; n < 2; ++n)
#pragma unroll
                    for (int j = 0; j < 4; ++j) { const float g = acc[ai][0][m][n][j] * rs, up = acc[ai][1][m][n][j] * rs; h[n * 4 + j] = g * sigmoidf_(g) * up; }
                u32x4 w; w.x = cvt_pk_bf16(h[0], h[1]); w.y = cvt_pk_bf16(h[2], h[3]); w.z = cvt_pk_bf16(h[4], h[5]); w.w = cvt_pk_bf16(h[6], h[7]);
                __builtin_amdgcn_raw_buffer_store_b128(w, rsrc, boff, 0, 16); }
    }
};
struct EpiY {
    static constexpr bool PERM = true;
    bf16* Y;
    __device__ __forceinline__ void operator()(const f32x4 (&acc)[2][2][4][2], const Unit& u, int wr, int wc, int fr, int fq) const {
        const int row0 = u.pm * BM + wr * 64 + fr, col0 = u.pn * BM + wc * 32 + 8 * fq;
#pragma unroll
        for (int ai = 0; ai < 2; ++ai)
#pragma unroll
            for (int m = 0; m < 4; ++m) { bf16* rowp = Y + (size_t)(row0 + ai * HALF + m * 16) * DM + col0;
#pragma unroll
                for (int bj = 0; bj < 2; ++bj) { const f32x4 v0 = acc[ai][bj][m][0], v1 = acc[ai][bj][m][1];
                    u32x4 w; w.x = cvt_pk_bf16(v0[0], v0[1]); w.y = cvt_pk_bf16(v0[2], v0[3]); w.z = cvt_pk_bf16(v1[0], v1[1]); w.w = cvt_pk_bf16(v1[2], v1[3]);
                    *(u32x4*)(rowp + bj * HALF) = w; } }
    }
};

struct SchedG1 {
    static constexpr bool GATHER = true;
    const LAS int* tstart; const int* cnt; const int* tok; const bf16* X; const bf16* W1; int G, c; unsigned* ready;
    __device__ __forceinline__ void a_ready(const Unit&) const {}
    __device__ __forceinline__ void done(const Unit& u) const {
        asm volatile("s_waitcnt vmcnt(0)" ::: "memory");
        if ((threadIdx.x & 63) == 0) __hip_atomic_fetch_add(ready + 64 * u.pm, 1u, __ATOMIC_RELAXED, __HIP_MEMORY_SCOPE_AGENT);
    }
    __device__ __forceinline__ bool next(int i, Unit& u) const {
        const int L = i * G + c, NT = tstart[NE]; if (L >= NT * 4) return false;
        const int T = L >> 2; int e = 0;
        for (int j = 1; j < NE; ++j) e = (tstart[j] <= T) ? j : e;
        u.pm = T; u.pn = L & 3; u.e = e; u.rb = T - tstart[e]; return true;
    }
    __device__ __forceinline__ const char* a_base(const Unit&) const { return (const char*)X; }
    __device__ __forceinline__ const char* b_base(const Unit& u) const { return (const char*)(W1 + ((size_t)u.e * 1024 + (size_t)u.pn * BM) * DM); }
    __device__ __forceinline__ void a_voff(const Unit& u, const int (&R)[2], const int (&C)[2], unsigned (&v)[2][2]) const {
        const int n = cnt[u.e * 64]; const int* tl = tok + (size_t)u.e * TOKCAP;
#pragma unroll
        for (int h = 0; h < 2; ++h)
#pragma unroll
            for (int i = 0; i < 2; ++i) { int row = u.rb * BM + h * HALF + R[i]; row = row < n ? row : 0; const int t = tl[row]; v[h][i] = (unsigned)(t * DM + C[i]) * 2u; }
    }
};
struct SchedG2 {
    static constexpr bool GATHER = false;
    const LAS int* tstart; const bf16* HB; const bf16* W2; int G, c; unsigned* ready; unsigned* tmo;
    __device__ __forceinline__ bool next(int i, Unit& u) const {
        constexpr int K0 = 3;
        const int NT = tstart[NE], n1 = 4 * NT, n1max = (n1 + G - 1) / G, R = n1 - G * (n1max - 1), nB = G - R;
        int L;
        if (c >= R) L = (i < K0) ? i * nB + (c - R) : K0 * nB + (i - K0) * G + c;
        else L = K0 * nB + i * G + c;
        if (L >= NT * 8) return false;
        const int T = L >> 3; int e = 0;
        for (int j = 1; j < NE; ++j) e = (tstart[j] <= T) ? j : e;
        u.pm = T; u.pn = L & 7; u.e = e; u.rb = T - tstart[e]; return true;
    }
    __device__ __forceinline__ void done(const Unit&) const {}
    __device__ __forceinline__ void a_ready(const Unit& u) const {
        if (threadIdx.x < 64) {
            unsigned polls = 0;
            while ((unsigned)__builtin_amdgcn_readfirstlane(__hip_atomic_load(ready + 64 * u.pm, __ATOMIC_RELAXED, __HIP_MEMORY_SCOPE_AGENT)) < 32u) {
                if (++polls > (1u << 22)) { if (threadIdx.x == 0) __hip_atomic_store(tmo, 0x600u | (unsigned)(u.pm & 0xff), __ATOMIC_RELAXED, __HIP_MEMORY_SCOPE_AGENT); break; }
                __builtin_amdgcn_s_sleep(2); }
            __builtin_amdgcn_fence(__ATOMIC_ACQUIRE, "agent");
            asm volatile("s_waitcnt vmcnt(0)" ::: "memory");
        }
        asm volatile("" ::: "memory"); __builtin_amdgcn_s_barrier(); asm volatile("" ::: "memory");
    }
    __device__ __forceinline__ const char* a_base(const Unit& u) const { return (const char*)(HB + (size_t)u.pm * BM * DE); }
    __device__ __forceinline__ const char* b_base(const Unit& u) const { return (const char*)(W2 + ((size_t)u.e * DM + (size_t)u.pn * BM) * DE); }
    __device__ __forceinline__ void a_voff(const Unit&, const int (&R)[2], const int (&C)[2], unsigned (&v)[2][2]) const {
#pragma unroll
        for (int h = 0; h < 2; ++h)
#pragma unroll
            for (int i = 0; i < 2; ++i) v[h][i] = (unsigned)((h * HALF + R[i]) * DE + C[i]) * 2u;
    }
};
}

struct Params { const float* in[22]; float* out; unsigned char* ws; int ph_lo, ph_hi; };
enum { IN_X = 0, IN_NORM1, IN_WIN, IN_SGUN, IN_SGUW, IN_SGUB, IN_CONVW, IN_CONVB, IN_LNG, IN_LNB, IN_QN, IN_KN, IN_OUTN, IN_WOUT, IN_NORM2, IN_WRG, IN_BRG, IN_WRE, IN_BRE, IN_WG, IN_WU, IN_WD };

struct Frame {
    LAS unsigned char* lds; volatile LAS unsigned* MISC;
    int tid, lane, wave, vcu, G;
    const float* const* in; float* out; unsigned char* ws;
};

__device__ __forceinline__ void tile_desc(const float* const* in, unsigned char* ws, int it, const float*& src, int& ldw, bf16*& dst, int& K, const float*& ksc) {
    bf16* WIN = (bf16*)(ws + WS_WIN); bf16* WOUT = (bf16*)(ws + WS_WOUT); bf16* W1 = (bf16*)(ws + WS_W1); bf16* W2 = (bf16*)(ws + WS_W2);
    constexpr int T_IN = 32 * 80, T_OUT = 32 * 32, T_E = 32 * 8, T_D = 8 * 32;
    constexpr int T_LAYER = T_IN + T_OUT + NE * (2 * T_E + T_D);
    const int l = it / T_LAYER; int r = it % T_LAYER; ksc = nullptr;
    if (r < T_IN) { const int kb = r / 80, nb = r % 80; ldw = DIN; K = DM; src = in[IN_WIN] + (size_t)l * DM * DIN + (size_t)(64 * kb) * DIN + 64 * nb; dst = WIN + (size_t)l * DIN * DM + (size_t)(64 * nb) * DM + 64 * kb; return; } r -= T_IN;
    if (r < T_OUT) { const int kb = r / 32, nb = r % 32; ldw = DM; K = DM; src = in[IN_WOUT] + (size_t)l * DM * DM + (size_t)(64 * kb) * DM + 64 * nb; dst = WOUT + (size_t)l * DM * DM + (size_t)(64 * nb) * DM + 64 * kb; return; } r -= T_OUT;
    const int e = r / (2 * T_E + T_D); r %= (2 * T_E + T_D);
    const size_t le = (size_t)l * NE + e;
    if (r < 2 * T_E) { const int up = r >= T_E; r -= up * T_E; const int kb = r / 8, nb = r % 8, n0 = 64 * nb; ldw = DE; K = DM;
        src = (up ? in[IN_WU] : in[IN_WG]) + le * DM * DE + (size_t)(64 * kb) * DE + n0; dst = W1 + le * 1024 * DM + (size_t)((n0 / 128) * 256 + up * 128 + (n0 % 128)) * DM + 64 * kb; ksc = in[IN_NORM2] + (size_t)l * DM + 64 * kb; return; }
    r -= 2 * T_E;
    { const int kb = r / 32, nb = r % 32; ldw = DM; K = DE; src = in[IN_WD] + le * DE * DM + (size_t)(64 * kb) * DM + 64 * nb; dst = W2 + le * DM * DE + (size_t)(64 * nb) * DE + 64 * kb; }
}
#define TR_LOAD(V, src, ldw) do { _Pragma("unroll") for (int i = 0; i < 16; ++i) V[i] = __builtin_nontemporal_load((const f32x4*)((src) + (size_t)(4 * i + (lane >> 4)) * (ldw) + 4 * (lane & 15))); } while (0)
#define TR_PROC(V, dst, K, ksc) do { \
    _Pragma("unroll") for (int i = 0; i < 16; ++i) { const int kk = 4 * i + (lane >> 4); f32x4 v = V[i]; if (ksc) v = v * (ksc)[kk]; \
        LAS float* d = scr + kk * 65 + 4 * (lane & 15); d[0] = v[0]; d[1] = v[1]; d[2] = v[2]; d[3] = v[3]; } \
    LDS_WAIT(); \
    _Pragma("unroll") for (int j = 0; j < 8; ++j) { const int n = (lane >> 3) + 8 * j; const LAS float* sp = scr + (8 * (lane & 7)) * 65 + n; \
        u32x4 o; o.x = cvt_pk_bf16(sp[0], sp[65]); o.y = cvt_pk_bf16(sp[2 * 65], sp[3 * 65]); o.z = cvt_pk_bf16(sp[4 * 65], sp[5 * 65]); o.w = cvt_pk_bf16(sp[6 * 65], sp[7 * 65]); \
        *(u32x4*)((dst) + (size_t)n * (K) + 8 * (lane & 7)) = o; } \
    LDS_WAIT(); } while (0)
__device__ __forceinline__ void norm_row_bf16(const float* xrow, const float* g, bf16* orow, int lane) {
    f32x4 v[8]; float s = 0.f;
#pragma unroll
    for (int j = 0; j < 8; ++j) { v[j] = *(const f32x4*)(xrow + 4 * lane + 256 * j); s += (v[j][0] * v[j][0] + v[j][1] * v[j][1]) + (v[j][2] * v[j][2] + v[j][3] * v[j][3]); }
    const float rs = __builtin_amdgcn_rsqf(wave_sum(s) * (1.f / DM) + EPS);
#pragma unroll
    for (int j = 0; j < 8; ++j) { const f32x4 gg = *(const f32x4*)(g + 4 * lane + 256 * j);
        u32x2 o; o.x = cvt_pk_bf16(v[j][0] * rs * gg[0], v[j][1] * rs * gg[1]); o.y = cvt_pk_bf16(v[j][2] * rs * gg[2], v[j][3] * rs * gg[3]);
        *(u32x2*)(orow + 4 * lane + 256 * j) = o; }
}
__device__ __forceinline__ void p_prologue(Frame& F) {
    LAS float* scr = (LAS float*)(F.lds + F.wave * 16640);
    const int gw = F.vcu * NWAVES + F.wave, NGW = F.G * NWAVES, lane = F.lane;
    constexpr int T_TOTAL = NLAYER * (32 * 80 + 32 * 32 + NE * (2 * 32 * 8 + 8 * 32));
    {
        f32x4 va[16], vb[16];
        const float* srcA; const float* srcB; bf16* dstA; bf16* dstB; const float* kA; const float* kB; int ldA, ldB, KA, KB;
        int it = gw;
        if (it < T_TOTAL) { tile_desc(F.in, F.ws, it, srcA, ldA, dstA, KA, kA); TR_LOAD(va, srcA, ldA); }
        while (it < T_TOTAL) {
            const int itb = it + NGW;
            if (itb < T_TOTAL) { tile_desc(F.in, F.ws, itb, srcB, ldB, dstB, KB, kB); TR_LOAD(vb, srcB, ldB); }
            TR_PROC(va, dstA, KA, kA);
            if (itb >= T_TOTAL) break;
            const int ita = itb + NGW;
            if (ita < T_TOTAL) { tile_desc(F.in, F.ws, ita, srcA, ldA, dstA, KA, kA); TR_LOAD(va, srcA, ldA); }
            TR_PROC(vb, dstB, KB, kB);
            it = ita;
        }
    }
    { bf16* SW = (bf16*)(F.ws + WS_SGUW); const int gt = gw * 64 + F.lane, NGT = NGW * 64;
      for (int idx = gt; idx < NLAYER * 4 * 8 * 4 * 64; idx += NGT) {
          const int ln = idx & 63, pp = (idx >> 6) & 3, itile = (idx >> 8) & 7, h = (idx >> 11) & 3, l = idx >> 13;
          const int i = 16 * itile + (ln & 15), gq = ln >> 4;
          const float* w = F.in[IN_SGUW] + ((size_t)(l * 4 + h) * 128 + i) * 128;
          float v[8];
#pragma unroll
          for (int jj = 0; jj < 8; ++jj) { const int j = 32 * pp + (jj < 4 ? 4 * gq + jj : 16 + 4 * gq + (jj - 4)); v[jj] = (j <= i) ? w[j] : 0.f; }
          u32x4 o; o.x = cvt_pk_bf16(v[0], v[1]); o.y = cvt_pk_bf16(v[2], v[3]); o.z = cvt_pk_bf16(v[4], v[5]); o.w = cvt_pk_bf16(v[6], v[7]);
          *(u32x4*)(SW + (size_t)idx * 8) = o; }
      bf16* WRF = (bf16*)(F.ws + WS_WRT);
      for (int idx = gt; idx < NLAYER * 64 * 3 * 64; idx += NGT) { const int ln = idx & 63, ct = (idx >> 6) % 3, ks = (idx / 192) & 63, l = idx / (192 * 64);
          const int o = 16 * ct + (ln & 15), k0 = 32 * ks + 8 * (ln >> 4);
          float v[8];
#pragma unroll
          for (int j = 0; j < 8; ++j) { const int k = k0 + j; const float wv = o < 32 ? F.in[IN_WRE][((size_t)l * DM + k) * NE + o] : (o < 36 ? F.in[IN_WRG][((size_t)l * DM + k) * 4 + (o - 32)] : 0.f);
              v[j] = wv * F.in[IN_NORM2][(size_t)l * DM + k]; }
          u32x4 hi, lo; hi.x = cvt_pk_bf16(v[0], v[1]); hi.y = cvt_pk_bf16(v[2], v[3]); hi.z = cvt_pk_bf16(v[4], v[5]); hi.w = cvt_pk_bf16(v[6], v[7]);
          lo.x = cvt_pk_bf16(v[0] - bf_lo(hi.x), v[1] - bf_hi(hi.x)); lo.y = cvt_pk_bf16(v[2] - bf_lo(hi.y), v[3] - bf_hi(hi.y));
          lo.z = cvt_pk_bf16(v[4] - bf_lo(hi.z), v[5] - bf_hi(hi.z)); lo.w = cvt_pk_bf16(v[6] - bf_lo(hi.w), v[7] - bf_hi(hi.w));
          bf16* dst = WRF + ((((size_t)l * 64 + ks) * 3 + ct) * 2 * 64 + ln) * 8;
          *(u32x4*)dst = hi; *(u32x4*)(dst + 512) = lo; } }
    bf16* HN = (bf16*)(F.ws + WS_HN);
    for (int m = gw; m < SEQ; m += NGW) norm_row_bf16(F.in[IN_X] + (size_t)m * DM, F.in[IN_NORM1], HN + (size_t)m * DM, F.lane);
}

__device__ __forceinline__ int vimg_off(int row, int c) { return row * 256 + ((((c >> 1) ^ (row & 7)) << 1) | (c & 1)) * 16; }
__device__ __forceinline__ bf16x8 tr_frag(const LAS unsigned char* img, int ra, int rb, int dt, int lane) {
    const int gq = lane >> 4, q = (lane & 15) >> 2, p = lane & 3;
    const int r0 = ra + 4 * gq + q, r1 = rb + 4 * gq + q, c = 2 * dt + (p >> 1);
    const s16x4 a = __builtin_amdgcn_ds_read_tr16_b64_v4i16((LAS s16x4*)(img + vimg_off(r0, c) + 8 * (p & 1)));
    const s16x4 b = __builtin_amdgcn_ds_read_tr16_b64_v4i16((LAS s16x4*)(img + vimg_off(r1, c) + 8 * (p & 1)));
    bf16x8 r; r[0] = a[0]; r[1] = a[1]; r[2] = a[2]; r[3] = a[3]; r[4] = b[0]; r[5] = b[1]; r[6] = b[2]; r[7] = b[3]; return r;
}
__device__ __forceinline__ void sgu_stage8(const bf16* vsrc, int j0, int w, int lane, const f32x4& g0, const f32x4& g1, LAS unsigned char* lds) {
    u32x4 raw[8];
#pragma unroll
    for (int j = 0; j < 8; ++j) raw[j] = *(const u32x4*)(vsrc + (size_t)(w + 8 * (j0 + j)) * DIN);
#pragma unroll
    for (int j = 0; j < 8; ++j) { const int row = w + 8 * (j0 + j);
        float x[8] = {bf_lo(raw[j].x), bf_hi(raw[j].x), bf_lo(raw[j].y), bf_hi(raw[j].y), bf_lo(raw[j].z), bf_hi(raw[j].z), bf_lo(raw[j].w), bf_hi(raw[j].w)};
        float s = 0.f;
#pragma unroll
        for (int e = 0; e < 8; ++e) s += x[e] * x[e];
        const float rs = __builtin_amdgcn_rsqf(wave_sum(s) * (1.f / 512.f) + EPS);
        u32x4 o; o.x = cvt_pk_bf16(x[0] * rs * g0[0], x[1] * rs * g0[1]); o.y = cvt_pk_bf16(x[2] * rs * g0[2], x[3] * rs * g0[3]);
        o.z = cvt_pk_bf16(x[4] * rs * g1[0], x[5] * rs * g1[1]); o.w = cvt_pk_bf16(x[6] * rs * g1[2], x[7] * rs * g1[3]);
        *(LAS u32x4*)(lds + (lane >> 4) * 32768 + vimg_off(row, lane & 15)) = o; }
}
__device__ __forceinline__ void sgu_item(Frame& F, int l, int chunk, int half) {
    const bf16* PROJ = (const bf16*)(F.ws + WS_PROJ); bf16* MIX = (bf16*)(F.ws + WS_MIX);
    const int p0 = chunk * 128, lane = F.lane, w = F.wave;
    LAS float* red = (LAS float*)(F.lds + MISC_OFF + 256);
    const float* gn = F.in[IN_SGUN] + l * 512;
    const f32x4 g0 = *(const f32x4*)(gn + 8 * lane), g1 = *(const f32x4*)(gn + 8 * lane + 4);
    const bf16* vsrc = PROJ + (size_t)p0 * DIN + OFF_V + 8 * lane;
    sgu_stage8(vsrc, 0, w, lane, g0, g1, F.lds);
    if (half) sgu_stage8(vsrc, 8, w, lane, g0, g1, F.lds);
    const int h = w >> 1, ih = w & 1, gq = lane >> 4, fr = lane & 15;
    const LAS unsigned char* img = F.lds + h * 32768;
    const bf16* SW = (const bf16*)(F.ws + WS_SGUW) + (size_t)(l * 4 + h) * 8 * 4 * 64 * 8;
    const float* bs = F.in[IN_SGUB] + (size_t)(l * 4 + h) * 128;
    const float* og = F.in[IN_OUTN] + (size_t)l * DM + h * 128 + 4 * gq;
    const int it0 = ih + 4 * half;
    u32x2 ur[2][8];
#pragma unroll
    for (int ii = 0; ii < 2; ++ii) { const bf16* urow = PROJ + (size_t)(p0 + 16 * (it0 + 2 * ii) + fr) * DIN + OFF_U + h * 128 + 4 * gq;
#pragma unroll
        for (int dt = 0; dt < 8; ++dt) ur[ii][dt] = *(const u32x2*)(urow + 16 * dt); }
    __syncthreads();
    f32x4 z[2][8];
#pragma unroll
    for (int ii = 0; ii < 2; ++ii)
#pragma unroll
        for (int dt = 0; dt < 8; ++dt) z[ii][dt] = (f32x4){0.f, 0.f, 0.f, 0.f};
#pragma unroll 1
    for (int pp = 0; pp <= (it0 + 2) / 2; ++pp) {
        const bf16x8 bw0 = *(const bf16x8*)(SW + ((size_t)(it0 * 4 + pp) * 64 + lane) * 8);
        const bf16x8 bw1 = *(const bf16x8*)(SW + ((size_t)((it0 + 2) * 4 + pp) * 64 + lane) * 8);
        const bool do0 = pp <= it0 / 2;
#pragma unroll
        for (int dt = 0; dt < 8; ++dt) { const bf16x8 a = tr_frag(img, 32 * pp, 32 * pp + 16, dt, lane);
            if (do0) z[0][dt] = __builtin_amdgcn_mfma_f32_16x16x32_bf16(a, bw0, z[0][dt], 0, 0, 0);
            z[1][dt] = __builtin_amdgcn_mfma_f32_16x16x32_bf16(a, bw1, z[1][dt], 0, 0, 0); }
    }
#pragma unroll
    for (int ii = 0; ii < 2; ++ii) { const int i = 16 * (it0 + 2 * ii) + fr; const float bi = bs[i]; float s = 0.f;
#pragma unroll
        for (int dt = 0; dt < 8; ++dt) { const u32x2 u2 = ur[ii][dt];
            f32x4 y; y[0] = bf_lo(u2.x) * (z[ii][dt][0] + bi); y[1] = bf_hi(u2.x) * (z[ii][dt][1] + bi); y[2] = bf_lo(u2.y) * (z[ii][dt][2] + bi); y[3] = bf_hi(u2.y) * (z[ii][dt][3] + bi);
            z[ii][dt] = y; s += (y[0] * y[0] + y[1] * y[1]) + (y[2] * y[2] + y[3] * y[3]); }
        s += __shfl_xor(s, 16); s += __shfl_xor(s, 32);
        if (gq == 0) red[i * 4 + h] = s; }
    __syncthreads();
#pragma unroll
    for (int ii = 0; ii < 2; ++ii) { const int i = 16 * (it0 + 2 * ii) + fr;
        const f32x4 rr = *(const LAS f32x4*)(red + i * 4);
        const float rs = __builtin_amdgcn_rsqf(((rr[0] + rr[1]) + (rr[2] + rr[3])) * (1.f / 512.f) + EPS);
        bf16* orow = MIX + (size_t)(p0 + i) * DM + h * 128 + 4 * gq;
#pragma unroll
        for (int dt = 0; dt < 8; ++dt) { const f32x4 gg = *(const f32x4*)(og + 16 * dt); const f32x4 y = z[ii][dt];
            u32x2 o; o.x = cvt_pk_bf16(y[0] * rs * gg[0], y[1] * rs * gg[1]); o.y = cvt_pk_bf16(y[2] * rs * gg[2], y[3] * rs * gg[3]);
            *(u32x2*)(orow + 16 * dt) = o; } }
    __syncthreads();
}

__device__ __forceinline__ void conv_item(Frame& F, int l, int tile) {
    const bf16* PROJ = (const bf16*)(F.ws + WS_PROJ); bf16* MIX = (bf16*)(F.ws + WS_MIX);
    constexpr int TP = 32, NR = TP + 30;
    const int p0 = tile * TP, c = F.tid, tid = F.tid;
    LAS float* cbuf = (LAS float*)F.lds;
    LAS bf16* zbuf = (LAS bf16*)(F.lds + 65536);
    { u32x4 av[8], gv[8];
#pragma unroll
      for (int i = 0; i < 8; ++i) { const int id = tid + NTHREADS * i, row = id >> 6, ch = (id & 63) * 8; int p = p0 - 30 + row; p = p < 0 ? 0 : p; p = row < NR ? p : 0;
          av[i] = *(const u32x4*)(PROJ + (size_t)p * DIN + OFF_A + ch); gv[i] = *(const u32x4*)(PROJ + (size_t)p * DIN + OFF_G + ch); }
#pragma unroll
      for (int i = 0; i < 8; ++i) { const int id = tid + NTHREADS * i, row = id >> 6, ch = (id & 63) * 8; const bool live = (p0 - 30 + row) >= 0;
          const unsigned au[4] = {av[i].x, av[i].y, av[i].z, av[i].w}, gu[4] = {gv[i].x, gv[i].y, gv[i].z, gv[i].w}; u32x4 o; unsigned ou[4];
#pragma unroll
          for (int e = 0; e < 4; ++e) { const float z0 = bf_lo(au[e]) * sigmoidf_(bf_lo(gu[e])), z1 = bf_hi(au[e]) * sigmoidf_(bf_hi(gu[e])); ou[e] = live ? cvt_pk_bf16(z0, z1) : 0u; }
          o.x = ou[0]; o.y = ou[1]; o.z = ou[2]; o.w = ou[3];
          if (row < NR) *(LAS u32x4*)(zbuf + row * 512 + ch) = o; } }
    float wk[CONV_K];
#pragma unroll
    for (int k = 0; k < CONV_K; ++k) wk[k] = F.in[IN_CONVW][((size_t)l * CONV_K + k) * 512 + c];
    const float cb = F.in[IN_CONVB][l * 512 + c];
    __syncthreads();
#define CONV_Z(r) __builtin_bit_cast(float, (unsigned)zbuf[(r) * 512 + c] << 16)
    float win[30];
#pragma unroll
    for (int r = 0; r < 30; ++r) win[r] = CONV_Z(r);
#pragma unroll
    for (int q = 0; q < TP; ++q) { const float zv = CONV_Z(30 + q); float acc = cb + wk[30] * zv;
#pragma unroll
        for (int k = 0; k < 30; ++k) acc += wk[k] * win[(k + q) % 30];
        win[q % 30] = zv; cbuf[q * 512 + c] = acc; }
#undef CONV_Z
    __syncthreads();
    const float* lg = F.in[IN_LNG] + l * 512 + 8 * F.lane; const float* lb = F.in[IN_LNB] + l * 512 + 8 * F.lane; const float* og = F.in[IN_OUTN] + (size_t)l * DM + 512 + 8 * F.lane;
    const f32x4 lg0 = *(const f32x4*)lg, lg1 = *(const f32x4*)(lg + 4), lb0 = *(const f32x4*)lb, lb1 = *(const f32x4*)(lb + 4), og0 = *(const f32x4*)og, og1 = *(const f32x4*)(og + 4);
    for (int r = F.wave; r < TP; r += NWAVES) {
        const f32x4 a0 = *(const LAS f32x4*)(cbuf + r * 512 + 8 * F.lane), a1 = *(const LAS f32x4*)(cbuf + r * 512 + 8 * F.lane + 4);
        float x[8] = {a0[0], a0[1], a0[2], a0[3], a1[0], a1[1], a1[2], a1[3]};
        float s = 0.f;
#pragma unroll
        for (int e = 0; e < 8; ++e) s += x[e];
        const float mu = wave_sum(s) * (1.f / 512.f); float q2 = 0.f;
#pragma unroll
        for (int e = 0; e < 8; ++e) { x[e] -= mu; q2 += x[e] * x[e]; }
        const float rstd = __builtin_amdgcn_rsqf(wave_sum(q2) * (1.f / 512.f) + EPS);
        const float gam[8] = {lg0[0], lg0[1], lg0[2], lg0[3], lg1[0], lg1[1], lg1[2], lg1[3]}, bet[8] = {lb0[0], lb0[1], lb0[2], lb0[3], lb1[0], lb1[1], lb1[2], lb1[3]};
        float s2 = 0.f;
#pragma unroll
        for (int e = 0; e < 8; ++e) { const float y = x[e] * rstd * gam[e] + bet[e]; x[e] = y * sigmoidf_(y); s2 += x[e] * x[e]; }
        const float rs = __builtin_amdgcn_rsqf(wave_sum(s2) * (1.f / 512.f) + EPS);
        u32x4 o; o.x = cvt_pk_bf16(x[0] * rs * og0[0], x[1] * rs * og0[1]); o.y = cvt_pk_bf16(x[2] * rs * og0[2], x[3] * rs * og0[3]);
        o.z = cvt_pk_bf16(x[4] * rs * og1[0], x[5] * rs * og1[1]); o.w = cvt_pk_bf16(x[6] * rs * og1[2], x[7] * rs * og1[3]);
        *(u32x4*)(MIX + (size_t)(p0 + r) * DM + 512 + 8 * F.lane) = o;
    }
    __syncthreads();
}

__device__ __forceinline__ int kimg_off(int row, int c) { return row * 256 + ((c ^ (row & 15)) << 4); }
__device__ __forceinline__ bf16x8 tr_frag2(const LAS unsigned char* vs, int ta, int tb, int dt, int lane) {
    const int gq = lane >> 4, q = (lane & 15) >> 2, p = lane & 3, c = 2 * dt + (p >> 1), rr = 4 * gq + q;
    const int off = rr * 256 + ((((c >> 1) ^ (rr & 7)) << 1) | (c & 1)) * 16 + 8 * (p & 1);
    const s16x4 a = __builtin_amdgcn_ds_read_tr16_b64_v4i16((LAS s16x4*)(vs + ta + off));
    const s16x4 b = __builtin_amdgcn_ds_read_tr16_b64_v4i16((LAS s16x4*)(vs + tb + off));
    bf16x8 r; r[0] = a[0]; r[1] = a[1]; r[2] = a[2]; r[3] = a[3]; r[4] = b[0]; r[5] = b[1]; r[6] = b[2]; r[7] = b[3]; return r;
}
#define ATT_DECODE(st) const int run_ = (int)blockIdx.x + F.G * ((st) / 5), b_ = (st) % 5 - 1; const int g = run_ >> 8, h = (run_ >> 5) & 7, rr_ = run_ & 31; \
    const int sh = 2 * g, dil = 1 << sh, rps = 32 >> sh; const int r = rr_ / rps, nb = 4 * (rr_ % rps) + b_
#define ATT_LOAD(st) do { if (ATT_EXP == 2) break; ATT_DECODE(st); const int cc = tid & 15; \
    _Pragma("unroll") for (int j = 0; j < 4; ++j) { const int row = (tid >> 4) + 32 * j; int ms = nb * 128 + row; ms = ms < 0 ? 0 : ms; const size_t pos = (size_t)ms * dil + r; \
        kr[j] = *(const u32x4*)(PROJ + pos * DIN + OFF_K + h * HD + 8 * cc); vr[j] = *(const u32x4*)(PROJ + pos * DIN + OFF_VV + h * HD + 8 * cc); } \
    if (b_ >= 0) { const size_t qpos_ = (size_t)(nb * 128 + 16 * w + (lane & 15)) * dil + r; \
        _Pragma("unroll") for (int ks = 0; ks < 4; ++ks) qr[ks] = *(const u32x4*)(PROJ + qpos_ * DIN + OFF_Q + h * HD + 32 * ks + 8 * (lane >> 4)); } } while (0)
__device__ __forceinline__ void att_phase(Frame& F, int l) {
    const bf16* PROJ = (const bf16*)(F.ws + WS_PROJ);
    bf16* ATT = (bf16*)(F.ws + WS_ATT); float* LSE = (float*)(F.ws + WS_LSE);
    const int lane = F.lane, w = F.wave, tid = F.tid, fr = lane & 15, gq = lane >> 4;
    LAS unsigned char* Ks = F.lds; LAS unsigned char* Vs = F.lds + 65536;
    const int nsteps = 5 * ((768 - (int)blockIdx.x + F.G - 1) / F.G);
    u32x4 kr[4], vr[4], qr[4];
    if (ATT_EXP == 2) { for (int j = 0; j < 4; ++j) { kr[j] = (u32x4){0x3f803f80u + (unsigned)tid, 0x3f003f80u, 0x3f803f00u, 0x3e803f80u}; vr[j] = kr[j]; qr[j] = kr[j]; } }
    if (nsteps > 0) ATT_LOAD(0);
    const int cc = tid & 15;
    const float* kgp = F.in[IN_KN] + l * HD + 8 * cc;
    const f32x4 kg0 = *(const f32x4*)kgp, kg1 = *(const f32x4*)(kgp + 4);
    for (int st = 0; st < nsteps; ++st) {
        ATT_DECODE(st);
        const int slot = (b_ + 1) & 1, curoff = slot * 32768, prevoff = 32768 - curoff;
#pragma unroll
        for (int j = 0; j < 4; ++j) { const int row = (tid >> 4) + 32 * j;
            const u32x4 k4 = kr[j];
            float x[8] = {bf_lo(k4.x), bf_hi(k4.x), bf_lo(k4.y), bf_hi(k4.y), bf_lo(k4.z), bf_hi(k4.z), bf_lo(k4.w), bf_hi(k4.w)};
            float sq = 0.f;
#pragma unroll
            for (int e = 0; e < 8; ++e) sq += x[e] * x[e];
            const float rs = __builtin_amdgcn_rsqf(row16_sum(sq) * (1.f / HD) + EPS);
            u32x4 o; o.x = cvt_pk_bf16(x[0] * rs * kg0[0], x[1] * rs * kg0[1]); o.y = cvt_pk_bf16(x[2] * rs * kg0[2], x[3] * rs * kg0[3]);
            o.z = cvt_pk_bf16(x[4] * rs * kg1[0], x[5] * rs * kg1[1]); o.w = cvt_pk_bf16(x[6] * rs * kg1[2], x[7] * rs * kg1[3]);
            *(LAS u32x4*)(Ks + curoff + kimg_off(row, cc)) = o;
            *(LAS u32x4*)(Vs + curoff + vimg_off(row, cc)) = vr[j]; }
        const int iq = 16 * w + fr; const size_t qpos = (size_t)(nb * 128 + iq) * dil + r;
        bf16x8 qf[4];
        if (b_ >= 0) { float x[4][8]; float sq = 0.f;
#pragma unroll
          for (int ks = 0; ks < 4; ++ks) { const u32x4 q4 = qr[ks];
              x[ks][0] = bf_lo(q4.x); x[ks][1] = bf_hi(q4.x); x[ks][2] = bf_lo(q4.y); x[ks][3] = bf_hi(q4.y); x[ks][4] = bf_lo(q4.z); x[ks][5] = bf_hi(q4.z); x[ks][6] = bf_lo(q4.w); x[ks][7] = bf_hi(q4.w);
#pragma unroll
              for (int e = 0; e < 8; ++e) sq += x[ks][e] * x[ks][e]; }
          sq += __shfl_xor(sq, 16); sq += __shfl_xor(sq, 32);
          const float rs = __builtin_amdgcn_rsqf(sq * (1.f / HD) + EPS) * 0.08838834764831845f;
#pragma unroll
          for (int ks = 0; ks < 4; ++ks) { const float* qg = F.in[IN_QN] + l * HD + 32 * ks + 8 * gq; const f32x4 q0 = *(const f32x4*)qg, q1 = *(const f32x4*)(qg + 4);
              u32x4 o; o.x = cvt_pk_bf16(x[ks][0] * rs * q0[0], x[ks][1] * rs * q0[1]); o.y = cvt_pk_bf16(x[ks][2] * rs * q0[2], x[ks][3] * rs * q0[3]);
              o.z = cvt_pk_bf16(x[ks][4] * rs * q1[0], x[ks][5] * rs * q1[1]); o.w = cvt_pk_bf16(x[ks][6] * rs * q1[2], x[ks][7] * rs * q1[3]);
              qf[ks] = __builtin_bit_cast(bf16x8, o); } }
        __syncthreads();
        if (st + 1 < nsteps) ATT_LOAD(st + 1);
        if (b_ >= 0 && ATT_EXP != 1) {
        const int t0 = w < 6 ? w : 6;
        f32x4 sc[10];
#pragma unroll
        for (int kt = 0; kt < 10; ++kt) { sc[kt] = (f32x4){0.f, 0.f, 0.f, 0.f}; const int T = t0 + kt; const int kbase = (T < 8 ? prevoff : curoff); const int krow = 16 * (T & 7) + fr;
#pragma unroll
            for (int ks = 0; ks < 4; ++ks) { const bf16x8 kf = *(const LAS bf16x8*)(Ks + kbase + kimg_off(krow, 4 * ks + gq));
                sc[kt] = __builtin_amdgcn_mfma_f32_16x16x32_bf16(kf, qf[ks], sc[kt], 0, 0, 0); } }
        float mx = -INFINITY;
#pragma unroll
        for (int kt = 0; kt < 10; ++kt)
#pragma unroll
            for (int e = 0; e < 4; ++e) { const int j = 16 * (t0 + kt) + 4 * gq + e, dist = 128 + iq - j; const bool ok = dist >= 0 && dist <= 128 && (nb > 0 || j >= 128);
                sc[kt][e] = ok ? sc[kt][e] : -INFINITY; mx = fmaxf(mx, sc[kt][e]); }
        mx = fmaxf(mx, __shfl_xor(mx, 16)); mx = fmaxf(mx, __shfl_xor(mx, 32));
        float sum = 0.f;
#pragma unroll
        for (int kt = 0; kt < 10; ++kt)
#pragma unroll
            for (int e = 0; e < 4; ++e) { const float p = fast_exp(sc[kt][e] - mx); sc[kt][e] = p; sum += p; }
        sum += __shfl_xor(sum, 16); sum += __shfl_xor(sum, 32);
        bf16x8 pf[5];
#pragma unroll
        for (int pp = 0; pp < 5; ++pp) { u32x4 o; o.x = cvt_pk_bf16(sc[2 * pp][0], sc[2 * pp][1]); o.y = cvt_pk_bf16(sc[2 * pp][2], sc[2 * pp][3]); o.z = cvt_pk_bf16(sc[2 * pp + 1][0], sc[2 * pp + 1][1]); o.w = cvt_pk_bf16(sc[2 * pp + 1][2], sc[2 * pp + 1][3]);
            pf[pp] = __builtin_bit_cast(bf16x8, o); }
        const float inv = __builtin_amdgcn_rcpf(sum);
        bf16* orow = ATT + ((size_t)g * SEQ + qpos) * 1024 + h * HD + 4 * gq;
        int toff[10];
#pragma unroll
        for (int kt = 0; kt < 10; ++kt) { const int T = t0 + kt; toff[kt] = (T < 8 ? prevoff : curoff) + (T & 7) * 16 * 256; }
#pragma unroll
        for (int dt = 0; dt < 8; ++dt) { f32x4 o = (f32x4){0.f, 0.f, 0.f, 0.f};
#pragma unroll
            for (int pp = 0; pp < 5; ++pp) { const bf16x8 vf = tr_frag2(Vs, toff[2 * pp], toff[2 * pp + 1], dt, lane);
                o = __builtin_amdgcn_mfma_f32_16x16x32_bf16(vf, pf[pp], o, 0, 0, 0); }
            u32x2 ow; ow.x = cvt_pk_bf16(o[0] * inv, o[1] * inv); ow.y = cvt_pk_bf16(o[2] * inv, o[3] * inv);
            *(u32x2*)(orow + 16 * dt) = ow; }
        if (gq == 0) LSE[((size_t)g * SEQ + qpos) * NHEAD + h] = mx + __logf(sum);
        }
        if (b_ >= 0 && ATT_EXP == 1) { bf16* orow = ATT + ((size_t)g * SEQ + qpos) * 1024 + h * HD + 4 * gq;
#pragma unroll
            for (int dt = 0; dt < 8; ++dt) { u32x2 ow; ow.x = __builtin_bit_cast(unsigned, qf[dt & 3][0] | (qf[dt & 3][1] << 16)) & 0x3f803f80u; ow.y = 0u; *(u32x2*)(orow + 16 * dt) = ow; }
            if (gq == 0) LSE[((size_t)g * SEQ + qpos) * NHEAD + h] = 0.f; }
        __syncthreads();
    }
}
#undef ATT_DECODE
#undef ATT_LOAD

__device__ __forceinline__ void att_combine(Frame& F, int l) {
    const bf16* ATT = (const bf16*)(F.ws + WS_ATT); const float* LSE = (const float*)(F.ws + WS_LSE); bf16* MIX = (bf16*)(F.ws + WS_MIX);
    const int gw = F.vcu * NWAVES + F.wave, NGW = F.G * NWAVES, lane = F.lane;
    const float* og = F.in[IN_OUTN] + (size_t)l * DM + 1024 + 16 * lane;
    f32x4 gg[4];
#pragma unroll
    for (int q = 0; q < 4; ++q) gg[q] = *(const f32x4*)(og + 4 * q);
    for (int m = gw; m < SEQ; m += NGW) {
        const int hh = lane >> 3;
        const float l0 = LSE[((size_t)0 * SEQ + m) * NHEAD + hh], l1 = LSE[((size_t)1 * SEQ + m) * NHEAD + hh], l2 = LSE[((size_t)2 * SEQ + m) * NHEAD + hh];
        const float M = fmaxf(l0, fmaxf(l1, l2)); float w0 = fast_exp(l0 - M), w1 = fast_exp(l1 - M), w2 = fast_exp(l2 - M);
        const float iw = __builtin_amdgcn_rcpf(w0 + w1 + w2); w0 *= iw; w1 *= iw; w2 *= iw;
        float y[16]; float s = 0.f;
#pragma unroll
        for (int q = 0; q < 2; ++q) {
            const u32x4 a = *(const u32x4*)(ATT + ((size_t)0 * SEQ + m) * 1024 + 16 * lane + 8 * q), b = *(const u32x4*)(ATT + ((size_t)1 * SEQ + m) * 1024 + 16 * lane + 8 * q), c = *(const u32x4*)(ATT + ((size_t)2 * SEQ + m) * 1024 + 16 * lane + 8 * q);
            const unsigned au[4] = {a.x, a.y, a.z, a.w}, bu[4] = {b.x, b.y, b.z, b.w}, cu[4] = {c.x, c.y, c.z, c.w};
#pragma unroll
            for (int e = 0; e < 4; ++e) { y[8 * q + 2 * e] = w0 * bf_lo(au[e]) + w1 * bf_lo(bu[e]) + w2 * bf_lo(cu[e]); y[8 * q + 2 * e + 1] = w0 * bf_hi(au[e]) + w1 * bf_hi(bu[e]) + w2 * bf_hi(cu[e]); } }
#pragma unroll
        for (int e = 0; e < 16; ++e) s += y[e] * y[e];
        const float rs = __builtin_amdgcn_rsqf(wave_sum(s) * (1.f / 1024.f) + EPS);
#pragma unroll
        for (int q = 0; q < 2; ++q) { u32x4 o;
            o.x = cvt_pk_bf16(y[8 * q + 0] * rs * gg[2 * q][0], y[8 * q + 1] * rs * gg[2 * q][1]); o.y = cvt_pk_bf16(y[8 * q + 2] * rs * gg[2 * q][2], y[8 * q + 3] * rs * gg[2 * q][3]);
            o.z = cvt_pk_bf16(y[8 * q + 4] * rs * gg[2 * q + 1][0], y[8 * q + 5] * rs * gg[2 * q + 1][1]); o.w = cvt_pk_bf16(y[8 * q + 6] * rs * gg[2 * q + 1][2], y[8 * q + 7] * rs * gg[2 * q + 1][3]);
            *(u32x4*)(MIX + (size_t)m * DM + 1024 + 16 * lane + 8 * q) = o; }
    }
}

#define ROUTER_LOAD(S, ks) do { \
    _Pragma("unroll") for (int rt = 0; rt < 4; ++rt) xa##S[rt] = *(const u32x4*)(xrow + (size_t)rt * 16 * DM + 32 * (ks)); \
    _Pragma("unroll") for (int ct = 0; ct < 3; ++ct) { bh##S[ct] = *(const bf16x8*)(wf + (size_t)(ks) * 3072 + (ct * 2) * 512); bl##S[ct] = *(const bf16x8*)(wf + (size_t)(ks) * 3072 + (ct * 2 + 1) * 512); } } while (0)
#define ROUTER_STEP(S, ks) do { \
    _Pragma("unroll") for (int rt = 0; rt < 4; ++rt) { const u32x4 xq = xa##S[rt]; \
        const float x0 = bf_lo(xq.x), x1 = bf_hi(xq.x), x2 = bf_lo(xq.y), x3 = bf_hi(xq.y), x4 = bf_lo(xq.z), x5 = bf_hi(xq.z), x6 = bf_lo(xq.w), x7 = bf_hi(xq.w); \
        ssq[rt] += (x0 * x0 + x1 * x1) + (x2 * x2 + x3 * x3) + (x4 * x4 + x5 * x5) + (x6 * x6 + x7 * x7); \
        const bf16x8 xh = __builtin_bit_cast(bf16x8, xq); \
        _Pragma("unroll") for (int ct = 0; ct < 3; ++ct) { \
            acc[rt][ct] = __builtin_amdgcn_mfma_f32_16x16x32_bf16(xh, bh##S[ct], acc[rt][ct], 0, 0, 0); \
            acc[rt][ct] = __builtin_amdgcn_mfma_f32_16x16x32_bf16(xh, bl##S[ct], acc[rt][ct], 0, 0, 0); } } } while (0)
__device__ __forceinline__ void router_phase(Frame& F, int l, int alt = 0) {
    const bf16* H1 = (const bf16*)(F.ws + WS_HN);
    const bf16* WRF = (const bf16*)(F.ws + WS_WRT) + (size_t)l * 64 * 3 * 2 * 64 * 8;
    unsigned* cnt = (unsigned*)(F.ws + WS_CTL) + CW_CNT + 2048 * l + 32768 * alt;
    int* tok = (int*)(F.ws + (alt ? WS_ALT : WS_TOK)); f32x4* tinfo = (f32x4*)(F.ws + (alt ? WS_ALT + 4 * MiB : WS_TINFO)); float* rslot = (float*)(F.ws + (alt ? WS_ALT + 2 * MiB : WS_RSLOT));
    const int lane = F.lane, tid = F.tid, w = F.wave, fr = lane & 15, g = lane >> 4;
    constexpr int PS = 49;
    LAS float* P = (LAS float*)F.lds;
    LAS float* SS = (LAS float*)(F.lds + 8 * 64 * PS * 4);
    for (int task = (int)blockIdx.x; task < SEQ / 64; task += F.G) {
        const bf16* xrow = H1 + (size_t)(task * 64 + fr) * DM + 256 * w + 8 * g;
        const bf16* wf = WRF + ((size_t)(8 * w) * 3 * 2 * 64 + lane) * 8;
        f32x4 acc[4][3]; float ssq[4] = {0.f, 0.f, 0.f, 0.f};
#pragma unroll
        for (int rt = 0; rt < 4; ++rt)
#pragma unroll
            for (int ct = 0; ct < 3; ++ct) acc[rt][ct] = (f32x4){0.f, 0.f, 0.f, 0.f};
        u32x4 xaA[4], xaB[4]; bf16x8 bhA[3], blA[3], bhB[3], blB[3];
        ROUTER_LOAD(A, 0);
#pragma unroll 1
        for (int it = 0; it < 4; ++it) {
            ROUTER_LOAD(B, 1); __builtin_amdgcn_sched_barrier(0);
            ROUTER_STEP(A, 0); __builtin_amdgcn_sched_barrier(0);
            if (it < 3) ROUTER_LOAD(A, 2);
            __builtin_amdgcn_sched_barrier(0);
            ROUTER_STEP(B, 1); __builtin_amdgcn_sched_barrier(0);
            xrow += 64; wf += 2 * 3072;
        }
#pragma unroll
        for (int rt = 0; rt < 4; ++rt) { float sq = ssq[rt]; sq += __shfl_xor(sq, 16); sq += __shfl_xor(sq, 32);
            if (g == 0) SS[w * 64 + 16 * rt + fr] = sq;
#pragma unroll
            for (int ct = 0; ct < 3; ++ct)
#pragma unroll
                for (int e = 0; e < 4; ++e) P[(w * 64 + 16 * rt + 4 * g + e) * PS + 16 * ct + fr] = acc[rt][ct][e]; }
        __syncthreads();
        if (tid < 64) {
            const int t = task * 64 + tid;
            float ss = 0.f;
#pragma unroll
            for (int q = 0; q < 8; ++q) ss += SS[q * 64 + tid];
            const float rs = __builtin_amdgcn_rsqf(ss * (1.f / DM) + EPS);
            const LAS float* pr = P + tid * PS;
            float lg[4];
#pragma unroll
            for (int o = 0; o < 4; ++o) { float a = 0.f;
#pragma unroll
                for (int q = 0; q < 8; ++q) a += pr[q * 64 * PS + 32 + o];
                lg[o] = a * rs + F.in[IN_BRG][l * 4 + o]; }
            int gi = 0; float gm = lg[0];
#pragma unroll
            for (int o = 1; o < 4; ++o) if (lg[o] > gm) { gm = lg[o]; gi = o; }
            float den = 0.f;
#pragma unroll
            for (int o = 0; o < 4; ++o) den += __expf(lg[o] - gm);
            const float gate_g = 1.f / den;
            float t1v = -INFINITY, t2v = -INFINITY; int t1i = 0, t2i = 0;
#pragma unroll
            for (int ii = 0; ii < 8; ++ii) { const int o = gi * 8 + ii; float a = 0.f;
#pragma unroll
                for (int q = 0; q < 8; ++q) a += pr[q * 64 * PS + o];
                const float v = a * rs + F.in[IN_BRE][l * NE + o];
                if (v > t1v) { t2v = t1v; t2i = t1i; t1v = v; t1i = ii; }
                else if (v > t2v) { t2v = v; t2i = ii; } }
            const float pp1 = 1.f / (1.f + __expf(t2v - t1v)), pp2 = 1.f - pp1;
            const int e0 = gi * 8 + t1i, e1 = gi * 8 + t2i;
            LAS unsigned* lcnt = (LAS unsigned*)(F.lds + 8 * 64 * PS * 4 + 8 * 64 * 4);
            if (tid < 32) lcnt[tid] = 0u;
            const unsigned r0 = __hip_atomic_fetch_add(lcnt + e0, 1u, __ATOMIC_RELAXED, __HIP_MEMORY_SCOPE_WORKGROUP), r1 = __hip_atomic_fetch_add(lcnt + e1, 1u, __ATOMIC_RELAXED, __HIP_MEMORY_SCOPE_WORKGROUP);
            if (tid < 32) { const unsigned c = lcnt[tid]; lcnt[32 + tid] = c ? atomicAdd(&cnt[tid * CNT_STRIDE], c) : 0u; }
            const unsigned s0 = lcnt[32 + e0] + r0, s1 = lcnt[32 + e1] + r1;
            tok[(size_t)e0 * TOKCAP + s0] = t; tok[(size_t)e1 * TOKCAP + s1] = t;
            rslot[(size_t)e0 * TOKCAP + s0] = rs; rslot[(size_t)e1 * TOKCAP + s1] = rs;
            f32x4 ti; ti[0] = __builtin_bit_cast(float, (int)(e0 * TOKCAP + s0)); ti[1] = __builtin_bit_cast(float, (int)(e1 * TOKCAP + s1)); ti[2] = gate_g * pp1; ti[3] = gate_g * pp2;
            tinfo[t] = ti;
        }
        __syncthreads();
    }
}
__device__ __forceinline__ void moe_table(Frame& F, int l) {
    const unsigned* cnt = (const unsigned*)(F.ws + WS_CTL) + CW_CNT + 2048 * l;
    LAS int* tstart = (LAS int*)(F.lds + MISC_OFF + 64);
    __syncthreads();
    if (F.tid == 0) { int acc = 0; for (int e = 0; e < NE; ++e) { tstart[e] = acc; acc += ((int)cnt[e * CNT_STRIDE] + 255) >> 8; } tstart[NE] = acc; }
    __syncthreads();
}
__device__ __forceinline__ void combine_phase(Frame& F, int l) {
    const LAS int* tstart = (const LAS int*)(F.lds + MISC_OFF + 64);
    const bf16* Y = (const bf16*)(F.ws + WS_Y); const f32x4* tinfo = (const f32x4*)(F.ws + WS_TINFO);
    bf16* H = (bf16*)(F.ws + WS_H); bf16* HN = (bf16*)(F.ws + WS_HN);
    const int gw = F.vcu * NWAVES + F.wave, NGW = F.G * NWAVES, lane = F.lane;
    const float* g1n = F.in[IN_NORM1] + (size_t)DM;
    for (int m = gw; m < SEQ; m += NGW) {
        const f32x4 ti = tinfo[m];
        const float tf0 = ti[0], tf1 = ti[1]; const int s0 = __builtin_bit_cast(int, tf0), s1 = __builtin_bit_cast(int, tf1);
        const int e0 = s0 >> 14, e1 = s1 >> 14;
        const size_t r0 = (size_t)tstart[e0] * 256 + (s0 & (TOKCAP - 1)), r1 = (size_t)tstart[e1] * 256 + (s1 & (TOKCAP - 1));
        const float ga = ti[2], gb = ti[3];
        f32x4 v[8]; float s = 0.f;
#pragma unroll
        for (int j = 0; j < 8; ++j) { const u32x2 hx = *(const u32x2*)(HN + (size_t)m * DM + 4 * lane + 256 * j);
            const u32x2 ya = *(const u32x2*)(Y + r0 * DM + 4 * lane + 256 * j), yb = *(const u32x2*)(Y + r1 * DM + 4 * lane + 256 * j);
            v[j][0] = bf_lo(hx.x) + ga * bf_lo(ya.x) + gb * bf_lo(yb.x); v[j][1] = bf_hi(hx.x) + ga * bf_hi(ya.x) + gb * bf_hi(yb.x);
            v[j][2] = bf_lo(hx.y) + ga * bf_lo(ya.y) + gb * bf_lo(yb.y); v[j][3] = bf_hi(hx.y) + ga * bf_hi(ya.y) + gb * bf_hi(yb.y);
            s += (v[j][0] * v[j][0] + v[j][1] * v[j][1]) + (v[j][2] * v[j][2] + v[j][3] * v[j][3]); }
        if (l == 0) {
            const float rs = __builtin_amdgcn_rsqf(wave_sum(s) * (1.f / DM) + EPS);
            bf16* hrow = H + (size_t)m * DM; bf16* orow = HN + (size_t)m * DM;
#pragma unroll
            for (int j = 0; j < 8; ++j) { const f32x4 gg = *(const f32x4*)(g1n + 4 * lane + 256 * j);
                u32x2 hb; hb.x = cvt_pk_bf16(v[j][0], v[j][1]); hb.y = cvt_pk_bf16(v[j][2], v[j][3]); *(u32x2*)(hrow + 4 * lane + 256 * j) = hb;
                u32x2 o; o.x = cvt_pk_bf16(v[j][0] * rs * gg[0], v[j][1] * rs * gg[1]); o.y = cvt_pk_bf16(v[j][2] * rs * gg[2], v[j][3] * rs * gg[3]);
                *(u32x2*)(orow + 4 * lane + 256 * j) = o; }
        } else {
            float* orow = F.out + (size_t)m * DM;
#pragma unroll
            for (int j = 0; j < 8; ++j) *(f32x4*)(orow + 4 * lane + 256 * j) = v[j];
        }
    }
}

constexpr int N_PHASES = 17;
#ifndef PHASE_MASK
#define PHASE_MASK 0x1ff
#endif
#ifndef MIX_MASK
#define MIX_MASK 7
#endif
#ifndef DUP_PHASE
#define DUP_PHASE 0
#endif
#define DUP(k) for (int _d = 0; _d < ((DUP_PHASE == (k)) ? 2 : 1); ++_d)
#define IN(k) (lo <= (k) && (k) < hi)
#define EN(b) ((PHASE_MASK >> (b)) & 1)
#ifndef PROBE_STAMP
#define PROBE_STAMP (-1)
#endif
#define SEAM(k) do { if (IN(k) && IN((k) + 1)) { xcd_barrier(bar); if (PROBE_STAMP >= 0 && blockIdx.x == 0 && F.tid == 0) { const unsigned long long _t = wall_clock64(); F.MISC[802 + 2 * (k)] = (unsigned)_t; F.MISC[803 + 2 * (k)] = (unsigned)(_t >> 32); } } } while (0)
template <int l>
__device__ __forceinline__ void layer_phases(Frame& F, const XcdBarrier& bar, const int lo, const int hi) {
    constexpr int pb = 1 + 8 * l;
    if (EN(1) && IN(pb)) {
        pg8::StaticSched S; S.init((const bf16*)(F.ws + WS_HN), (const bf16*)(F.ws + WS_WIN) + (size_t)l * DIN * DM, SEQ, DIN, DM, F.G, (int)blockIdx.x);
        pg8::EpiProj E{(bf16*)(F.ws + WS_PROJ)};
        DUP(1) pg8::gemm_phase<pg8::EpiProj, pg8::StaticSched>(F.lds, DM, S, E);
    }
    SEAM(pb);
    if (EN(2) && IN(pb + 1)) {
        constexpr int N_SGU = 256, N_CONV = 512, N_ATT = 3072;
#define MSTAMP(i) do { if (PROBE_STAMP >= 100 && l == 0 && blockIdx.x == 0 && F.tid == 0) { const unsigned long long _t = wall_clock64(); F.MISC[900 + 2 * (i)] = (unsigned)_t; F.MISC[901 + 2 * (i)] = (unsigned)(_t >> 32); } } while (0)
        MSTAMP(0);
        if (MIX_MASK & 1) DUP(2) att_phase(F, l);
        MSTAMP(1);
        if (MIX_MASK & 2) DUP(3) for (int it = (int)blockIdx.x; it < N_CONV; it += F.G) conv_item(F, l, it);
        MSTAMP(2);
        if (MIX_MASK & 4) DUP(4) for (int it = (int)blockIdx.x; it < N_SGU; it += F.G) sgu_item(F, l, it >> 1, it & 1);
        MSTAMP(3);
#undef MSTAMP
    }
    SEAM(pb + 1);
    if (DUP_PHASE == 12 && IN(pb + 1)) {
        pg8::StaticSched S; S.init((const bf16*)(F.ws + WS_MIX), (const bf16*)(F.ws + WS_WIN) + (size_t)l * DIN * DM, SEQ, DIN, DM, F.G, (int)blockIdx.x);
        pg8::EpiProj E{(bf16*)(F.ws + WS_PROJ)};
        pg8::gemm_phase<pg8::EpiProj, pg8::StaticSched>(F.lds, DM, S, E);
        xcd_barrier(bar);
    }
    if (EN(3) && IN(pb + 2)) DUP(5) att_combine(F, l);
    SEAM(pb + 2);
    if (EN(4) && IN(pb + 3)) {
        pg8::StaticSched S; S.init((const bf16*)(F.ws + WS_MIX), (const bf16*)(F.ws + WS_WOUT) + (size_t)l * DM * DM, SEQ, DM, DM, F.G, (int)blockIdx.x);
        if constexpr (l == 0) { pg8::EpiResid<false> E{(const void*)F.in[IN_X], (bf16*)(F.ws + WS_HN)}; DUP(6) pg8::gemm_phase<pg8::EpiResid<false>, pg8::StaticSched>(F.lds, DM, S, E); }
        else { pg8::EpiResid<true> E{(const void*)(F.ws + WS_H), (bf16*)(F.ws + WS_HN)}; DUP(6) pg8::gemm_phase<pg8::EpiResid<true>, pg8::StaticSched>(F.lds, DM, S, E); }
    }
    SEAM(pb + 3);
    if (EN(5) && IN(pb + 4)) { router_phase(F, l); if (DUP_PHASE == 11) router_phase(F, l, 1); }
    if (DUP_PHASE == 13 && IN(pb + 4)) { for (int q = 0; q < 8; ++q) xcd_barrier(bar); }
    SEAM(pb + 4);
    if (EN(6) && IN(pb + 5)) {
        moe_table(F, l);
        unsigned* ready = (unsigned*)(F.ws + WS_CTL) + CW_RDY + 16384 * l;
        {
            pg8::SchedG1 S{(const LAS int*)(F.lds + MISC_OFF + 64), (const int*)((const unsigned*)(F.ws + WS_CTL) + CW_CNT + 2048 * l), (const int*)(F.ws + WS_TOK), (const bf16*)(F.ws + WS_HN),
                           (const bf16*)(F.ws + WS_W1) + (size_t)l * NE * 1024 * DM, F.G, (int)blockIdx.x, ready};
            pg8::EpiSwiGLU E{(bf16*)(F.ws + WS_HB), (const float*)(F.ws + WS_RSLOT)};
            DUP(7) pg8::gemm_phase<pg8::EpiSwiGLU, pg8::SchedG1>(F.lds, DM, S, E);
        }
        {
            pg8::SchedG2 S{(const LAS int*)(F.lds + MISC_OFF + 64), (const bf16*)(F.ws + WS_HB), (const bf16*)(F.ws + WS_W2) + (size_t)l * NE * DM * DE, F.G, (int)blockIdx.x, ready, (unsigned*)(F.ws + WS_CTL) + CW_TMO};
            pg8::EpiY E{(bf16*)(F.ws + WS_Y)};
            DUP(8) pg8::gemm_phase<pg8::EpiY, pg8::SchedG2>(F.lds, DE, S, E);
        }
    }
    SEAM(pb + 6);
    if (EN(8) && IN(pb + 7)) { moe_table(F, l); DUP(l == 0 ? 9 : 99) combine_phase(F, l); }
    SEAM(pb + 7);
}
__global__ void __launch_bounds__(NTHREADS, 2) fwd_kernel(Params args) {
    extern __shared__ __attribute__((aligned(16))) unsigned char lds_raw[];
    Frame F;
    F.lds = (LAS unsigned char*)lds_raw; F.MISC = (volatile LAS unsigned*)(F.lds + MISC_OFF);
    F.tid = threadIdx.x; F.lane = F.tid & 63; F.wave = __builtin_amdgcn_readfirstlane(F.tid >> 6);
    F.G = gridDim.x; { const int bx = blockIdx.x; F.vcu = (F.G % 8 == 0) ? (bx % 8) * (F.G / 8) + bx / 8 : bx; }
    F.in = args.in; F.out = args.out; F.ws = args.ws;
    for (int u = F.tid; u < (LDS_BYTES - MISC_OFF) / 4; u += NTHREADS) ((LAS unsigned*)(F.lds + MISC_OFF))[u] = 0u;
    __syncthreads();
    unsigned* ctl = (unsigned*)(args.ws + WS_CTL);
    const int lo = args.ph_lo, hi = args.ph_hi;
    const bool multi = (hi - lo) > 1;
    XcdBarrier bar; bar.bar = ctl + CW_BAR; bar.x = 0; bar.st = nullptr;
    if (multi) bar = xcd_barrier_post(ctl + CW_BAR, F.MISC);
    if (PROBE_STAMP >= 0 && blockIdx.x == 0 && F.tid == 0) { const unsigned long long _t = wall_clock64(); F.MISC[800] = (unsigned)_t; F.MISC[801] = (unsigned)(_t >> 32); }
    if (EN(0) && IN(0)) { DUP(10) p_prologue(F); }
    SEAM(0);
    layer_phases<0>(F, bar, lo, hi);
    layer_phases<1>(F, bar, lo, hi);
    if (PROBE_STAMP >= 0 && blockIdx.x == 0 && F.tid == 0) {
        asm volatile("s_waitcnt vmcnt(0)" ::: "memory");
        constexpr int SB = PROBE_STAMP >= 100 ? 900 + 2 * (PROBE_STAMP - 100) : 800 + 2 * PROBE_STAMP;
        const unsigned long long t1 = ((unsigned long long)F.MISC[SB + 3] << 32) | F.MISC[SB + 2], t0 = ((unsigned long long)F.MISC[SB + 1] << 32) | F.MISC[SB];
        F.out[0] += (float)(long long)(t1 - t0) * 0.01f;
    }
}
#undef IN
#undef EN
#undef SEAM
#undef DUP

extern "C" void kernel_launch(void* const* d_in, const int* in_sizes, int n_in, void* d_out, int out_size, void* d_ws, size_t ws_size, hipStream_t stream) {
    static int grid = 0;
    if (grid == 0) {
        if (n_in != 22 || out_size != SEQ * DM || ws_size < WS_END) { fprintf(stderr, "kernel_launch: unexpected shapes (n_in %d out %d ws %zu, need %zu)\n", n_in, out_size, ws_size, (size_t)WS_END); grid = -1; return; }
        int dev = 0, cus = 0, per_cu = 0;
        if (hipGetDevice(&dev) != hipSuccess || hipDeviceGetAttribute(&cus, hipDeviceAttributeMultiprocessorCount, dev) != hipSuccess) { grid = -1; return; }
        if (hipFuncSetAttribute((const void*)fwd_kernel, hipFuncAttributeMaxDynamicSharedMemorySize, LDS_BYTES) != hipSuccess) { fprintf(stderr, "kernel_launch: hipFuncSetAttribute failed\n"); grid = -1; return; }
        if (hipOccupancyMaxActiveBlocksPerMultiprocessor(&per_cu, (const void*)fwd_kernel, NTHREADS, LDS_BYTES) != hipSuccess || per_cu < 1) { fprintf(stderr, "kernel_launch: occupancy query says %d\n", per_cu); }
        (void)hipGetLastError();
        grid = cus;
    }
    if (grid < 0) return;
    if (hipMemsetAsync((char*)d_ws + WS_CTL, 0, CTL_ZERO_BYTES, stream) != hipSuccess) return;
    Params p{};
    for (int i = 0; i < 22; ++i) p.in[i] = (const float*)d_in[i];
    p.out = (float*)d_out; p.ws = (unsigned char*)d_ws;
    constexpr int NL = MK_N_LAUNCHES;
    for (int li = 0; li < NL; ++li) {
        p.ph_lo = (NL == 1) ? 0 : li; p.ph_hi = (NL == 1) ? N_PHASES : li + 1;
        hipLaunchKernelGGL(fwd_kernel, dim3(grid), dim3(NTHREADS), LDS_BYTES, stream, p);
        if (hipPeekAtLastError() != hipSuccess) { fprintf(stderr, "kernel_launch: launch %d failed\n", li); break; }
    }
}
```

```cpp
#include <hip/hip_runtime.h>
#include <cstdio>
#include <cstdint>

#ifndef MK_N_LAUNCHES
#define MK_N_LAUNCHES 1
#endif

#ifndef ATT_EXP
#define ATT_EXP 0
#endif
#define GAS __attribute__((address_space(1)))
#define LAS __attribute__((address_space(3)))
typedef unsigned short bf16;
typedef short bf16x8 __attribute__((ext_vector_type(8)));
typedef short s16x4 __attribute__((ext_vector_type(4)));
typedef float f32x4 __attribute__((ext_vector_type(4)));
typedef float f32x2 __attribute__((ext_vector_type(2)));
typedef unsigned u32x4 __attribute__((ext_vector_type(4)));
typedef unsigned u32x2 __attribute__((ext_vector_type(2)));

constexpr int SEQ = 16384, DM = 2048, DIN = 5120, NLAYER = 2;
constexpr int HD = 128, NHEAD = 8, CONV_K = 31;
constexpr int NE = 32, DE = 512, TOKCAP = 16384;
constexpr int OFF_U = 0, OFF_V = 512, OFF_A = 1024, OFF_G = 1536, OFF_Q = 2048, OFF_K = 3072, OFF_VV = 4096;
constexpr float EPS = 1e-6f;
constexpr float W1_SCALE = 64.f, W2_SCALE = 32.f;
constexpr int NWAVES = 8, NTHREADS = 512;

constexpr size_t MiB = 1u << 20;
constexpr size_t WS_CTL = 0, CTL_ZERO_BYTES = 1 * MiB;
constexpr size_t WS_WIN = 1 * MiB;
constexpr size_t WS_WOUT = 41 * MiB;
constexpr size_t WS_W1 = 57 * MiB;
constexpr size_t WS_X8 = 185 * MiB;
constexpr size_t WS_W2 = 313 * MiB;
constexpr size_t WS_SGUW = 441 * MiB;
constexpr size_t WS_WRT = 442 * MiB;
constexpr size_t WS_TOK = 443 * MiB;
constexpr size_t WS_TINFO = 445 * MiB;
constexpr size_t WS_HN = 446 * MiB;
constexpr size_t WS_HB = 510 * MiB;
constexpr size_t WS_ATT = WS_HN;
constexpr size_t WS_LSE = WS_HN + 96 * MiB;
constexpr size_t WS_PROJ = 550 * MiB;
constexpr size_t WS_Y = WS_PROJ;
constexpr size_t WS_MIX = 710 * MiB;
constexpr size_t WS_H = 774 * MiB;
constexpr size_t WS_RSLOT = 902 * MiB;
constexpr size_t WS_ALT = 904 * MiB;
constexpr size_t WS_END = 910 * MiB;
constexpr int CW_BAR = 4096;
constexpr int CW_TMO = 0;
constexpr int CW_RDY = 65536;
constexpr int CW_CNT = 16384, CNT_STRIDE = 64;

constexpr int LDS_BYTES = 163840;
constexpr int MISC_OFF = 159744;

__device__ __forceinline__ unsigned cvt_pk_bf16(float lo, float hi) { unsigned r; asm volatile("v_cvt_pk_bf16_f32 %0, %1, %2" : "=v"(r) : "v"(lo), "v"(hi)); return r; }
__device__ __forceinline__ unsigned pk4_fp8(float a, float b, float c, float d) { int p = 0; p = __builtin_amdgcn_cvt_pk_fp8_f32(a, b, p, false); p = __builtin_amdgcn_cvt_pk_fp8_f32(c, d, p, true); return (unsigned)p; }
__device__ __forceinline__ float bf_lo(unsigned u) { return __builtin_bit_cast(float, u << 16); }
__device__ __forceinline__ float bf_hi(unsigned u) { return __builtin_bit_cast(float, u & 0xffff0000u); }
template <int CTRL, int RM> __device__ __forceinline__ float dpp_mov0(float v) { return __builtin_bit_cast(float, __builtin_amdgcn_update_dpp(0, __builtin_bit_cast(int, v), CTRL, RM, 0xf, false)); }
__device__ __forceinline__ float wave_sum(float s) {
    s += dpp_mov0<0xB1, 0xf>(s); s += dpp_mov0<0x4E, 0xf>(s); s += dpp_mov0<0x141, 0xf>(s); s += dpp_mov0<0x140, 0xf>(s);
    s += dpp_mov0<0x142, 0xa>(s); s += dpp_mov0<0x143, 0xc>(s);
    return __builtin_bit_cast(float, __builtin_amdgcn_readlane(__builtin_bit_cast(int, s), 63));
}
__device__ __forceinline__ float row16_sum(float s) {
    s += dpp_mov0<0xB1, 0xf>(s); s += dpp_mov0<0x4E, 0xf>(s); s += dpp_mov0<0x141, 0xf>(s); s += dpp_mov0<0x140, 0xf>(s); return s;
}
__device__ __forceinline__ float sum4(float x) {
    const unsigned xu = __builtin_bit_cast(unsigned, x); const auto r = __builtin_amdgcn_permlane16_swap(xu, xu, false, false); const unsigned r0 = r[0], r1 = r[1];
    const float a = __builtin_bit_cast(float, r0) + __builtin_bit_cast(float, r1);
    const unsigned au = __builtin_bit_cast(unsigned, a); const auto q = __builtin_amdgcn_permlane32_swap(au, au, false, false); const unsigned q0 = q[0], q1 = q[1];
    return __builtin_bit_cast(float, q0) + __builtin_bit_cast(float, q1);
}
__device__ __forceinline__ float max4(float x) {
    const unsigned xu = __builtin_bit_cast(unsigned, x); const auto r = __builtin_amdgcn_permlane16_swap(xu, xu, false, false); const unsigned r0 = r[0], r1 = r[1];
    const float a = fmaxf(__builtin_bit_cast(float, r0), __builtin_bit_cast(float, r1));
    const unsigned au = __builtin_bit_cast(unsigned, a); const auto q = __builtin_amdgcn_permlane32_swap(au, au, false, false); const unsigned q0 = q[0], q1 = q[1];
    return fmaxf(__builtin_bit_cast(float, q0), __builtin_bit_cast(float, q1));
}
#define LDS_WAIT() asm volatile("s_waitcnt lgkmcnt(0)" ::: "memory")
#define VM_WAIT() asm volatile("s_waitcnt vmcnt(0)" ::: "memory")
__device__ __forceinline__ float fast_exp(float x) { return __builtin_amdgcn_exp2f(x * 1.4426950408889634f); }
__device__ __forceinline__ float sigmoidf_(float x) { return __builtin_amdgcn_rcpf(1.0f + fast_exp(-x)); }
__device__ __forceinline__ float gelu_tanh(float x) { const float z = 1.5957691216057308f * (x + 0.044715f * x * x * x); return x * sigmoidf_(z); }

#define XB_TMO      128
#define XB_XCNT(j)  (256  + 64 * (j))
#define XB_XSUB(j)  (1280 + 64 * (j))
#define XB_XGEN(j)  (2304 + 64 * (j))
#define XB_TOP      3328
#define XB_TOPGEN   3392
#define XCD_BAR_WORDS 3456
#define XB_SPIN_CAP (1u << 22)
__device__ __forceinline__ unsigned xb_ld(unsigned* p)              { return __hip_atomic_load(p, __ATOMIC_RELAXED, __HIP_MEMORY_SCOPE_AGENT); }
__device__ __forceinline__ unsigned xb_add(unsigned* p, unsigned v) { return __hip_atomic_fetch_add(p, v, __ATOMIC_RELAXED, __HIP_MEMORY_SCOPE_AGENT); }
__device__ __forceinline__ unsigned xb_xcc_id() { return (unsigned)__builtin_amdgcn_s_getreg((3 << 11) | 20) & 0xFu; }
#define XB_SPIN(cond, bar) do { unsigned _sp = 0; while (cond) { __builtin_amdgcn_s_sleep(1); \
    if ((++_sp & 255u) == 0u) { if (xb_ld(&(bar)[XB_TMO])) break; if (_sp > XB_SPIN_CAP) { atomicAdd(&(bar)[XB_TMO], 1u); break; } } } } while (0)
struct XcdBarrier { unsigned* bar; unsigned x; volatile LAS unsigned* st; };
__device__ __forceinline__ XcdBarrier xcd_barrier_post(unsigned* bar, volatile LAS unsigned* st) {
    XcdBarrier b; b.bar = bar; b.x = xb_xcc_id(); b.st = st;
    if (threadIdx.x == 0) (void)xb_add(&bar[XB_XCNT(b.x)], 1u);
    return b;
}
__device__ __forceinline__ void xcd_barrier_complete(unsigned* bar, unsigned x, unsigned& nloc, unsigned& nx) {
    const unsigned G = gridDim.x * gridDim.y * gridDim.z;
    unsigned sum, cnt, mine, sp = 0u;
    for (;;) {
        sum = 0u; cnt = 0u; mine = 0u;
#pragma unroll
        for (unsigned j = 0; j < 16; ++j) { const unsigned c = xb_ld(&bar[XB_XCNT(j)]); sum += c; cnt += (c > 0u) ? 1u : 0u; mine = (j == x) ? c : mine; }
        if (sum == G) break;
        __builtin_amdgcn_s_sleep(1);
        if ((++sp & 255u) == 0u) { if (xb_ld(&bar[XB_TMO])) break; if (sp > XB_SPIN_CAP) { atomicAdd(&bar[XB_TMO], 1u); break; } }
    }
    nloc = mine > 0u ? mine : 1u; nx = cnt > 0u ? cnt : 1u;
}
__device__ __forceinline__ void xcd_barrier(const XcdBarrier& b) {
    asm volatile("s_waitcnt vmcnt(0)" ::: "memory");
    __syncthreads();
    if (threadIdx.x == 0) {
        unsigned* bar = b.bar;
        __builtin_amdgcn_s_waitcnt(0);
        unsigned nloc = b.st[0], nx = b.st[1];
        if (nloc == 0u) { xcd_barrier_complete(bar, b.x, nloc, nx); b.st[0] = nloc; b.st[1] = nx; }
        const unsigned old = xb_add(&bar[XB_XSUB(b.x)], 1u);
        const unsigned gen = old / nloc;
        if (old + 1u == (gen + 1u) * nloc) {
            __builtin_amdgcn_fence(__ATOMIC_RELEASE, "agent");
            asm volatile("s_waitcnt vmcnt(0)" ::: "memory");
            const unsigned og = xb_add(&bar[XB_TOP], 1u);
            const unsigned tg = og / nx;
            if (og + 1u == (tg + 1u) * nx) xb_add(&bar[XB_TOPGEN], 1u);
            else XB_SPIN(xb_ld(&bar[XB_TOPGEN]) == tg, bar);
            __builtin_amdgcn_fence(__ATOMIC_ACQUIRE, "agent");
            xb_add(&bar[XB_XGEN(b.x)], 1u);
            asm volatile("s_waitcnt vmcnt(0)" ::: "memory");
        } else {
            XB_SPIN(xb_ld(&bar[XB_XGEN(b.x)]) == gen, bar);
            __builtin_amdgcn_fence(__ATOMIC_ACQUIRE, "agent");
            asm volatile("s_waitcnt vmcnt(0)" ::: "memory");
        }
    }
    __syncthreads();
}

namespace pg8 {
constexpr int BM = 256, BK = 64, HALF = 128, HTB = HALF * BK * 2, STAGE_BYTES = 8 * HTB, NXCD = 8, WGM = 8;
__device__ __forceinline__ int lds_byte(int r, int c) { const int st = (r >> 4) * 2 + (c >> 5), rr = r & 15, cc = c & 31, ob = rr * 64 + cc * 2; return st * 1024 + (ob ^ (((ob >> 9) & 1) << 5)); }
__device__ __forceinline__ void stage_rc(int b, int& R, int& C) { const int st = b / 1024, sb = b % 1024, swz = sb ^ (((sb >> 9) & 1) << 5); R = (st >> 1) * 16 + swz / 64; C = (st & 1) * 32 + (swz % 64) / 2; }
__device__ __forceinline__ int perm32(int rho) { const int n = rho >> 4, i = rho & 15; return 8 * (i >> 2) + 4 * n + (i & 3); }

struct Unit { int pm, pn, e, rb; };

struct StaticSched {
    static constexpr bool GATHER = false;
    const bf16* A; const bf16* Bt; int K; int nM, nN, nwg, G, c;
    __device__ __forceinline__ void init(const bf16* A_, const bf16* Bt_, int M, int N, int K_, int G_, int c_) { A = A_; Bt = Bt_; K = K_; nM = M / BM; nN = N / BM; nwg = nM * nN; G = G_; c = c_; }
    __device__ __forceinline__ bool next(int i, Unit& u) const {
        const long L = (long)i * G + c; if (L >= nwg) return false;
        int wgid = (int)L; { const int q = nwg / NXCD, r = nwg % NXCD, xcd = wgid % NXCD, off = wgid / NXCD; wgid = (xcd < r ? xcd * (q + 1) : r * (q + 1) + (xcd - r) * q) + off; }
        const int nig = WGM * nN, gid = wgid / nig, fm = gid * WGM, gsz = (nM - fm) < WGM ? (nM - fm) : WGM;
        u.pm = fm + ((wgid % nig) % gsz); u.pn = (wgid % nig) / gsz; u.e = 0; u.rb = 0; return true;
    }
    __device__ __forceinline__ void a_ready(const Unit&) const {}
    __device__ __forceinline__ void done(const Unit&) const {}
    __device__ __forceinline__ const char* a_base(const Unit& u) const { return (const char*)A + (size_t)u.pm * BM * K * 2; }
    __device__ __forceinline__ const char* b_base(const Unit& u) const { return (const char*)Bt + (size_t)u.pn * BM * K * 2; }
    __device__ __forceinline__ void a_voff(const Unit&, const int (&R)[2], const int (&C)[2], unsigned (&v)[2][2]) const {
#pragma unroll
        for (int h = 0; h < 2; ++h)
#pragma unroll
            for (int i = 0; i < 2; ++i) v[h][i] = (unsigned)((h * HALF + R[i]) * K + C[i]) * 2u;
    }
};

typedef int v8i __attribute__((ext_vector_type(8)));
typedef int v4i __attribute__((ext_vector_type(4)));
template <class Epi, class Sched, bool ALIGN_EPI = true, bool FP8 = false>
__device__ __forceinline__ void gemm_phase(LAS unsigned char* lds, const int K, const Sched& S, const Epi& E) {
    int tid_ = threadIdx.x; asm volatile("" : "+v"(tid_));
    const int tid = tid_, wid = __builtin_amdgcn_readfirstlane(tid >> 6), lane = tid & 63, wr = wid >> 2, wc = wid & 3, fr = lane & 15, fq = lane >> 4;
    const int nt = K / BK;
    int Rr[2], Cc[2]; unsigned voffB[2];
#pragma unroll
    for (int i = 0; i < 2; ++i) { stage_rc(tid * 16 + i * 8192, Rr[i], Cc[i]); const int Rb = Epi::PERM ? ((Rr[i] & ~31) + perm32(Rr[i] & 31)) : Rr[i];
        voffB[i] = (unsigned)(Rb * K + Cc[i]) * 2u; }
    const size_t kstep = (size_t)(BK * 2);
    const size_t hstep = (size_t)HALF * K * 2;
    const unsigned ldsw = (unsigned)wid * 1024u;
    const unsigned ldsbase = (unsigned)__builtin_amdgcn_readfirstlane((int)(unsigned)(size_t)lds);
    const int aoff = lds_byte(wr * 64 + fr, fq * 8), boff = lds_byte(wc * 32 + fr, fq * 8);
#define PG8_SA(b, h) (((b) * 2 + (h)) * HTB)
#define PG8_SB(b, h) ((4 + (b) * 2 + (h)) * HTB)
#define PG8_STAGE(bufoff, gbase, voff) do { _Pragma("unroll") for (int _i = 0; _i < 2; ++_i) { unsigned _keep; \
        asm volatile("s_mov_b32 %0, m0\n\ts_mov_b32 m0, %3\n\ts_nop 0\n\tglobal_load_lds_dwordx4 %1, %2\n\ts_mov_b32 m0, %0" : "=&s"(_keep) : "v"((voff)[_i]), "s"((const char*)(gbase)), "s"(ldsbase + (unsigned)(bufoff) + ldsw + (unsigned)(_i * 8192)) : "memory"); } } while (0)
#define PG8_LDA(dst, b, h) do { _Pragma("unroll") for (int m = 0; m < 4; ++m) _Pragma("unroll") for (int k = 0; k < 2; ++k) dst[m][k] = *(const LAS bf16x8*)(lds + PG8_SA(b, h) + aoff + m * 2048 + k * 1024); } while (0)
#define PG8_LDB(dst, b, h) do { _Pragma("unroll") for (int n = 0; n < 2; ++n) _Pragma("unroll") for (int k = 0; k < 2; ++k) dst[n][k] = *(const LAS bf16x8*)(lds + PG8_SB(b, h) + boff + n * 2048 + k * 1024); } while (0)
#define PG8_LDA8(dst, b, h) do { _Pragma("unroll") for (int m = 0; m < 4; ++m) { const v4i lo_ = *(const LAS v4i*)(lds + PG8_SA(b, h) + aoff + m * 2048), hi_ = *(const LAS v4i*)(lds + PG8_SA(b, h) + aoff + m * 2048 + 1024); dst[m] = __builtin_shufflevector(lo_, hi_, 0, 1, 2, 3, 4, 5, 6, 7); } } while (0)
#define PG8_LDB8(dst, b, h) do { _Pragma("unroll") for (int n = 0; n < 2; ++n) { const v4i lo_ = *(const LAS v4i*)(lds + PG8_SB(b, h) + boff + n * 2048), hi_ = *(const LAS v4i*)(lds + PG8_SB(b, h) + boff + n * 2048 + 1024); dst[n] = __builtin_shufflevector(lo_, hi_, 0, 1, 2, 3, 4, 5, 6, 7); } } while (0)
#define PG8_MMA(ai, bj, At, Bt) do { __builtin_amdgcn_s_setprio(1); _Pragma("unroll") for (int m = 0; m < 4; ++m) _Pragma("unroll") for (int n = 0; n < 2; ++n) _Pragma("unroll") for (int k = 0; k < 2; ++k) \
        acc[ai][bj][m][n] = __builtin_amdgcn_mfma_f32_16x16x32_bf16(Bt[n][k], At[m][k], acc[ai][bj][m][n], 0, 0, 0); __builtin_amdgcn_s_setprio(0); } while (0)
#define PG8_MMA8(ai, bj, At, Bt) do { __builtin_amdgcn_s_setprio(1); _Pragma("unroll") for (int m = 0; m < 4; ++m) _Pragma("unroll") for (int n = 0; n < 2; ++n) \
        acc[ai][bj][m][n] = __builtin_amdgcn_mfma_scale_f32_16x16x128_f8f6f4(Bt[n], At[m], acc[ai][bj][m][n], 0, 0, 0, 0, 0, 0); __builtin_amdgcn_s_setprio(0); } while (0)
#define LDA_(b, h) do { if constexpr (FP8) PG8_LDA8(At8, b, h); else PG8_LDA(At, b, h); } while (0)
#define LDB0_(b, h) do { if constexpr (FP8) PG8_LDB8(B08, b, h); else PG8_LDB(B0, b, h); } while (0)
#define LDB1_(b, h) do { if constexpr (FP8) PG8_LDB8(B18, b, h); else PG8_LDB(B1, b, h); } while (0)
#define MMA0_(ai, bj) do { if constexpr (FP8) PG8_MMA8(ai, bj, At8, B08); else PG8_MMA(ai, bj, At, B0); } while (0)
#define MMA1_(ai, bj) do { if constexpr (FP8) PG8_MMA8(ai, bj, At8, B18); else PG8_MMA(ai, bj, At, B1); } while (0)
#define PG8_WAIT_V(n) asm volatile("s_waitcnt vmcnt(" #n ")" ::: "memory")
#define PG8_WAIT_L(n) asm volatile("s_waitcnt lgkmcnt(" #n ")" ::: "memory")
#define PG8_BAR __builtin_amdgcn_s_barrier()
#define PG8_SCHED __builtin_amdgcn_sched_barrier(0)
    Unit cur, nxt; int ui = 0;
    if (!S.next(0, cur)) return;
    f32x4 acc[2][2][4][2];
#pragma unroll
    for (int a = 0; a < 2; ++a)
#pragma unroll
        for (int b = 0; b < 2; ++b)
#pragma unroll
            for (int m = 0; m < 4; ++m)
#pragma unroll
                for (int n = 0; n < 2; ++n) acc[a][b][m][n] = (f32x4){0.f, 0.f, 0.f, 0.f};
    bf16x8 At[4][2], B0[2][2], B1[2][2]; v8i At8[4], B08[2], B18[2];
    const char* cA = S.a_base(cur); const char* cB = S.b_base(cur);
    S.a_ready(cur);
    constexpr bool GATHER = Sched::GATHER;
    unsigned vA[1][2];
    LAS unsigned* goff = (LAS unsigned*)(lds + STAGE_BYTES) + tid;
    int gslot = 0;
    if constexpr (GATHER) { unsigned t4[2][2]; S.a_voff(cur, Rr, Cc, t4); goff[0 * 512] = t4[0][0]; goff[1 * 512] = t4[0][1]; goff[2 * 512] = t4[1][0]; goff[3 * 512] = t4[1][1]; goff[8 * 512] = voffB[0]; goff[9 * 512] = voffB[1]; }
    else {
#pragma unroll
        for (int i = 0; i < 2; ++i) vA[0][i] = (unsigned)(Rr[i] * K + Cc[i]) * 2u; }
    const size_t ahstep = GATHER ? 0 : hstep;
#define PG8_STAGE_B(bufoff, kptr) do { if constexpr (GATHER) { unsigned _o[2]; _o[0] = goff[8 * 512]; _o[1] = goff[9 * 512]; PG8_STAGE(bufoff, kptr, _o); } else PG8_STAGE(bufoff, kptr, voffB); } while (0)
#define PG8_STAGE_A(bufoff, kptr, h, nx) do { if constexpr (GATHER) { unsigned _o[2]; const int _s = (gslot ^ (nx)) * 2048 + (h) * 1024; _o[0] = goff[_s]; _o[1] = goff[_s + 512]; PG8_STAGE(bufoff, kptr, _o); } \
        else PG8_STAGE(bufoff, (kptr) + (h) * ahstep, vA[0]); } while (0)
    PG8_STAGE(PG8_SB(0, 0), cB, voffB); PG8_STAGE(PG8_SB(0, 1), cB + hstep, voffB); PG8_STAGE_A(PG8_SA(0, 0), cA, 0, 0); PG8_STAGE_A(PG8_SA(0, 1), cA, 1, 0);
    if (wr == 1) PG8_BAR;
    PG8_WAIT_V(2); PG8_BAR;
    PG8_STAGE(PG8_SB(1, 0), cB + kstep, voffB); PG8_STAGE_A(PG8_SA(1, 0), cA + kstep, 0, 0); PG8_STAGE(PG8_SB(1, 1), cB + hstep + kstep, voffB);
    PG8_WAIT_V(6); PG8_BAR;
    for (;;) {
        const bool has_next = S.next(ui + 1, nxt);
        const char* nA = has_next ? S.a_base(nxt) : cA; const char* nB = has_next ? S.b_base(nxt) : cB;
        if constexpr (GATHER) { if (has_next) { unsigned t4[2][2]; int tl_ = tid; asm volatile("" : "+v"(tl_)); int R2[2], C2[2]; stage_rc(tl_ * 16, R2[0], C2[0]); stage_rc(tl_ * 16 + 8192, R2[1], C2[1]); S.a_voff(nxt, R2, C2, t4); const int o = (gslot ^ 1) * 2048; goff[o] = t4[0][0]; goff[o + 512] = t4[0][1]; goff[o + 1024] = t4[1][0]; goff[o + 1536] = t4[1][1]; } }
#pragma unroll 1
        for (int t = 0; t < nt; t += 2) {
            const bool last = (t == nt - 2);
            const char* a1 = cA + (size_t)(t + 1) * kstep;
            const char* a2 = last ? nA : cA + (size_t)(t + 2) * kstep; const char* b2 = last ? nB : cB + (size_t)(t + 2) * kstep;
            const char* a3 = a2 + kstep; const char* b3 = b2 + kstep;
            if (last && has_next) S.a_ready(nxt);
            const int nx = (last && has_next) ? 1 : 0;
            LDB0_(0, 0); LDB1_(0, 1); PG8_SCHED; LDA_(0, 0); PG8_STAGE_A(PG8_SA(1, 1), a1, 1, 0);
            PG8_WAIT_V(8); PG8_WAIT_L(0); PG8_BAR; MMA0_(0, 0); MMA1_(0, 1); PG8_BAR; PG8_SCHED;
            LDA_(0, 1); PG8_STAGE_B(PG8_SB(0, 0), b2); PG8_STAGE_B(PG8_SB(0, 1), b2 + hstep); PG8_STAGE_A(PG8_SA(0, 0), a2, 0, nx);
            PG8_WAIT_V(8); PG8_WAIT_L(0); PG8_BAR; MMA0_(1, 0); MMA1_(1, 1); PG8_BAR; PG8_SCHED;
            LDB0_(1, 0); LDB1_(1, 1); PG8_SCHED; LDA_(1, 0); PG8_STAGE_A(PG8_SA(0, 1), a2, 1, nx);
            PG8_WAIT_V(8); PG8_WAIT_L(0); PG8_BAR; MMA0_(0, 0); MMA1_(0, 1); PG8_BAR; PG8_SCHED;
            LDA_(1, 1); PG8_STAGE_B(PG8_SB(1, 0), b3); PG8_STAGE_B(PG8_SB(1, 1), b3 + hstep); PG8_STAGE_A(PG8_SA(1, 0), a3, 0, nx);
            PG8_WAIT_V(8); PG8_WAIT_L(0); PG8_BAR; MMA0_(1, 0); MMA1_(1, 1); PG8_BAR; PG8_SCHED;
        }
        if constexpr (ALIGN_EPI) { if (wr == 0) PG8_BAR; }
        { int fr2 = fr, fq2 = fq; asm volatile("" : "+v"(fr2), "+v"(fq2));
          E(acc, cur, wr, wc, fr2, fq2); } S.done(cur);
        if (!has_next) break;
#pragma unroll
        for (int a = 0; a < 2; ++a)
#pragma unroll
            for (int b = 0; b < 2; ++b)
#pragma unroll
                for (int m = 0; m < 4; ++m)
#pragma unroll
                    for (int n = 0; n < 2; ++n) acc[a][b][m][n] = (f32x4){0.f, 0.f, 0.f, 0.f};
        cur = nxt; cA = nA; cB = nB; ++ui;
        if constexpr (GATHER) gslot ^= 1;
        if constexpr (ALIGN_EPI) { if (wr == 1) PG8_BAR; }
    }
    PG8_WAIT_V(0);
    if constexpr (!ALIGN_EPI) { if (wr == 0) PG8_BAR; }
    PG8_BAR;
#undef PG8_SA
#undef PG8_SB
#undef PG8_STAGE
#undef PG8_STAGE_A
#undef PG8_STAGE_B
#undef PG8_LDA
#undef PG8_LDB
#undef PG8_MMA
#undef PG8_MMA8
#undef PG8_LDA8
#undef PG8_LDB8
#undef LDA_
#undef LDB0_
#undef LDB1_
#undef MMA0_
#undef MMA1_
#undef PG8_WAIT_V
#undef PG8_WAIT_L
#undef PG8_BAR
#undef PG8_SCHED
}

struct EpiProj {
    static constexpr bool PERM = true;
    bf16* O;
    __device__ __forceinline__ void operator()(const f32x4 (&acc)[2][2][4][2], const Unit& u, int wr, int wc, int fr, int fq) const {
        const int row0 = u.pm * BM + wr * 64 + fr, col0 = u.pn * BM + wc * 32 + 8 * fq;
        const bool act = u.pn < 4;
#pragma unroll
        for (int ai = 0; ai < 2; ++ai)
#pragma unroll
            for (int m = 0; m < 4; ++m) { bf16* rowp = O + (size_t)(row0 + ai * HALF + m * 16) * DIN + col0;
#pragma unroll
                for (int bj = 0; bj < 2; ++bj) { f32x4 v0 = acc[ai][bj][m][0], v1 = acc[ai][bj][m][1];
                    if (act) {
#pragma unroll
                        for (int j = 0; j < 4; ++j) { v0[j] = gelu_tanh(v0[j]); v1[j] = gelu_tanh(v1[j]); } }
                    u32x4 w; w.x = cvt_pk_bf16(v0[0], v0[1]); w.y = cvt_pk_bf16(v0[2], v0[3]); w.z = cvt_pk_bf16(v1[0], v1[1]); w.w = cvt_pk_bf16(v1[2], v1[3]);
                    *(u32x4*)(rowp + bj * HALF) = w; } }
    }
};
template <bool RES_BF16> struct EpiResid {
    static constexpr bool PERM = true;
    const void* res; bf16* out;
    __device__ __forceinline__ void operator()(const f32x4 (&acc)[2][2][4][2], const Unit& u, int wr, int wc, int fr, int fq) const {
        const int row0 = u.pm * BM + wr * 64 + fr, col0 = u.pn * BM + wc * 32 + 8 * fq;
#pragma unroll
        for (int ai = 0; ai < 2; ++ai) {
            if constexpr (RES_BF16) {
                u32x4 r[4][2];
#pragma unroll
                for (int m = 0; m < 4; ++m)
#pragma unroll
                    for (int bj = 0; bj < 2; ++bj) r[m][bj] = *(const u32x4*)((const bf16*)res + (size_t)(row0 + ai * HALF + m * 16) * DM + col0 + bj * HALF);
                asm volatile("s_waitcnt vmcnt(0)" ::: "memory");
#pragma unroll
                for (int m = 0; m < 4; ++m)
#pragma unroll
                    for (int bj = 0; bj < 2; ++bj) { f32x4 v0 = acc[ai][bj][m][0], v1 = acc[ai][bj][m][1]; const u32x4 q = r[m][bj];
                        v0[0] += bf_lo(q.x); v0[1] += bf_hi(q.x); v0[2] += bf_lo(q.y); v0[3] += bf_hi(q.y); v1[0] += bf_lo(q.z); v1[1] += bf_hi(q.z); v1[2] += bf_lo(q.w); v1[3] += bf_hi(q.w);
                        u32x4 w; w.x = cvt_pk_bf16(v0[0], v0[1]); w.y = cvt_pk_bf16(v0[2], v0[3]); w.z = cvt_pk_bf16(v1[0], v1[1]); w.w = cvt_pk_bf16(v1[2], v1[3]);
                        *(u32x4*)(out + (size_t)(row0 + ai * HALF + m * 16) * DM + col0 + bj * HALF) = w; }
            } else {
#pragma unroll
                for (int mh = 0; mh < 2; ++mh) {
                    f32x4 r[2][2][2];
#pragma unroll
                    for (int m = 0; m < 2; ++m)
#pragma unroll
                        for (int bj = 0; bj < 2; ++bj) { const float* rp = (const float*)res + (size_t)(row0 + ai * HALF + (2 * mh + m) * 16) * DM + col0 + bj * HALF; r[m][bj][0] = *(const f32x4*)rp; r[m][bj][1] = *(const f32x4*)(rp + 4); }
                    asm volatile("s_waitcnt vmcnt(0)" ::: "memory");
#pragma unroll
                    for (int m = 0; m < 2; ++m)
#pragma unroll
                        for (int bj = 0; bj < 2; ++bj) { const f32x4 v0 = acc[ai][bj][2 * mh + m][0] + r[m][bj][0], v1 = acc[ai][bj][2 * mh + m][1] + r[m][bj][1];
                            u32x4 w; w.x = cvt_pk_bf16(v0[0], v0[1]); w.y = cvt_pk_bf16(v0[2], v0[3]); w.z = cvt_pk_bf16(v1[0], v1[1]); w.w = cvt_pk_bf16(v1[2], v1[3]);
                            *(u32x4*)(out + (size_t)(row0 + ai * HALF + (2 * mh + m) * 16) * DM + col0 + bj * HALF) = w; }
                }
            }
        }
    }
};
struct EpiSwiGLU {
    static constexpr bool PERM = true;
    unsigned char* HB; const float* rslot;
    __device__ __forceinline__ void operator()(const f32x4 (&acc)[2][2][4][2], const Unit& u, int wr, int wc, int fr, int fq) const {
        const int row0 = u.pm * BM + wr * 64 + fr, col0 = u.pn * HALF + wc * 32 + 8 * fq;
        const __amdgpu_buffer_rsrc_t rsrc = __builtin_amdgcn_make_buffer_rsrc((void*)HB, 0, 40960 * DE, 0x00020000);
        const float* rsl = rslot + (size_t)u.e * TOKCAP + u.rb * BM + wr * 64 + fr;
#pragma unroll
        for (int ai = 0; ai < 2; ++ai) {
            float rsv[4];
#pragma unroll
            for (int m = 0; m < 4; ++m) rsv[m] = rsl[ai * HALF + m * 16];
            asm volatile("s_waitcnt vmcnt(0)" ::: "memory");
#pragma unroll
            for (int m = 0; m < 4; ++m) { const unsigned boff = (unsigned)((row0 + ai * HALF + m * 16) * DE + col0);
                const float rs = rsv[m] * (1.f / W1_SCALE);
                float h[8];
#pragma unroll
                for (int n = 0; n < 2; ++n)
#pragma unroll
                    for (int j = 0; j < 4; ++j) { const float g = acc[ai][0][m][n][j] * rs, up = acc[ai][1][m][n][j] * rs; h[n * 4 + j] = g * sigmoidf_(g) * up; }
                u32x2 w; w.x = pk4_fp8(h[0], h[1], h[2], h[3]); w.y = pk4_fp8(h[4], h[5], h[6], h[7]);
                __builtin_amdgcn_raw_buffer_store_b64(w, rsrc, boff, 0, 16); } }
    }
};
struct EpiY {
    static constexpr bool PERM = true;
    bf16* Y;
    __device__ __forceinline__ void operator()(const f32x4 (&acc)[2][2][4][2], const Unit& u, int wr, int wc, int fr, int fq) const {
        const int row0 = u.pm * BM + wr * 64 + fr, col0 = u.pn * BM + wc * 32 + 8 * fq;
#pragma unroll
        for (int ai = 0; ai < 2; ++ai)
#pragma unroll
            for (int m = 0; m < 4; ++m) { bf16* rowp = Y + (size_t)(row0 + ai * HALF + m * 16) * DM + col0;
#pragma unroll
                for (int bj = 0; bj < 2; ++bj) { const f32x4 v0 = acc[ai][bj][m][0] * (1.f / W2_SCALE), v1 = acc[ai][bj][m][1] * (1.f / W2_SCALE);
                    u32x4 w; w.x = cvt_pk_bf16(v0[0], v0[1]); w.y = cvt_pk_bf16(v0[2], v0[3]); w.z = cvt_pk_bf16(v1[0], v1[1]); w.w = cvt_pk_bf16(v1[2], v1[3]);
                    *(u32x4*)(rowp + bj * HALF) = w; } }
    }
};

struct SchedG1 {
    static constexpr bool GATHER = true;
    const LAS int* tstart; const int* cnt; const int* tok; const bf16* X; const bf16* W1; int G, c; unsigned* ready;
    __device__ __forceinline__ void a_ready(const Unit&) const {}
    __device__ __forceinline__ void done(const Unit& u) const {
        asm volatile("s_waitcnt vmcnt(0)" ::: "memory");
        if ((threadIdx.x & 63) == 0) __hip_atomic_fetch_add(ready + 64 * u.pm, 1u, __ATOMIC_RELAXED, __HIP_MEMORY_SCOPE_AGENT);
    }
    __device__ __forceinline__ bool next(int i, Unit& u) const {
        const int L = i * G + c, NT = __builtin_amdgcn_readfirstlane(tstart[NE]); if (L >= NT * 4) return false;
        const int T = L >> 2; const int e = tstart[560 + T];
        u.pm = __builtin_amdgcn_readfirstlane(T); u.pn = L & 3; u.e = __builtin_amdgcn_readfirstlane(e); u.rb = __builtin_amdgcn_readfirstlane(T - tstart[e]); return true;
    }
    static constexpr int KU = DM / 2;
    __device__ __forceinline__ const char* a_base(const Unit&) const { return (const char*)X; }
    __device__ __forceinline__ const char* b_base(const Unit& u) const { return (const char*)W1 + ((size_t)u.e * 1024 + (size_t)u.pn * BM) * DM; }
    __device__ __forceinline__ void a_voff(const Unit& u, const int (&R)[2], const int (&C)[2], unsigned (&v)[2][2]) const {
        const int n = cnt[u.e * 64]; const int* tl = tok + (size_t)u.e * TOKCAP;
#pragma unroll
        for (int h = 0; h < 2; ++h)
#pragma unroll
            for (int i = 0; i < 2; ++i) { int row = u.rb * BM + h * HALF + R[i]; row = row < n ? row : 0; const int t = tl[row]; v[h][i] = (unsigned)(t * KU + C[i]) * 2u; }
    }
};
struct SchedG2 {
    static constexpr bool GATHER = false;
    const LAS int* tstart; const bf16* HB; const bf16* W2; int G, c; unsigned* ready; unsigned* tmo;
    __device__ __forceinline__ bool next(int i, Unit& u) const {
        constexpr int K0 = 3;
        const int NT = __builtin_amdgcn_readfirstlane(tstart[NE]), n1 = 4 * NT, n1max = (n1 + G - 1) / G, R = n1 - G * (n1max - 1), nB = G - R;
        int L;
        if (c >= R) L = (i < K0) ? i * nB + (c - R) : K0 * nB + (i - K0) * G + c;
        else L = K0 * nB + i * G + c;
        if (L >= NT * 8) return false;
        const int T = L >> 3; const int e = tstart[560 + T];
        u.pm = __builtin_amdgcn_readfirstlane(T); u.pn = __builtin_amdgcn_readfirstlane(L & 7); u.e = __builtin_amdgcn_readfirstlane(e); u.rb = __builtin_amdgcn_readfirstlane(T - tstart[e]); return true;
    }
    __device__ __forceinline__ void done(const Unit&) const {}
    __device__ __forceinline__ void a_ready(const Unit& u) const {
        if (threadIdx.x < 64) {
            unsigned polls = 0;
            while ((unsigned)__builtin_amdgcn_readfirstlane(__hip_atomic_load(ready + 64 * u.pm, __ATOMIC_RELAXED, __HIP_MEMORY_SCOPE_AGENT)) < 32u) {
                if (++polls > (1u << 22)) { if (threadIdx.x == 0) __hip_atomic_store(tmo, 0x600u | (unsigned)(u.pm & 0xff), __ATOMIC_RELAXED, __HIP_MEMORY_SCOPE_AGENT); break; }
                __builtin_amdgcn_s_sleep(2); }
            __builtin_amdgcn_fence(__ATOMIC_ACQUIRE, "agent");
            asm volatile("s_waitcnt vmcnt(0)" ::: "memory");
        }
        asm volatile("" ::: "memory"); __builtin_amdgcn_s_barrier(); asm volatile("" ::: "memory");
    }
    __device__ __forceinline__ const char* a_base(const Unit& u) const { return (const char*)HB + (size_t)u.pm * BM * DE; }
    __device__ __forceinline__ const char* b_base(const Unit& u) const { return (const char*)W2 + ((size_t)u.e * DM + (size_t)u.pn * BM) * DE; }
    __device__ __forceinline__ void a_voff(const Unit&, const int (&R)[2], const int (&C)[2], unsigned (&v)[2][2]) const {
#pragma unroll
        for (int h = 0; h < 2; ++h)
#pragma unroll
            for (int i = 0; i < 2; ++i) v[h][i] = (unsigned)((h * HALF + R[i]) * DE + C[i]) * 2u;
    }
};
}

struct Params { const float* in[22]; float* out; unsigned char* ws; int ph_lo, ph_hi; };
enum { IN_X = 0, IN_NORM1, IN_WIN, IN_SGUN, IN_SGUW, IN_SGUB, IN_CONVW, IN_CONVB, IN_LNG, IN_LNB, IN_QN, IN_KN, IN_OUTN, IN_WOUT, IN_NORM2, IN_WRG, IN_BRG, IN_WRE, IN_BRE, IN_WG, IN_WU, IN_WD };

struct Frame {
    LAS unsigned char* lds; volatile LAS unsigned* MISC;
    int tid, lane, wave, vcu, G;
    const float* const* in; float* out; unsigned char* ws;
};

__device__ __forceinline__ void tile_desc(const float* const* in, unsigned char* ws, int it, const float*& src, int& ldw, unsigned char*& dst, int& pitch, const float*& ksc, float& wsc, int& fp8) {
    constexpr int T_IN = 32 * 80, T_OUT = 32 * 32, T_E = 32 * 8, T_D = 8 * 32;
    constexpr int T_LAYER = T_IN + T_OUT + NE * (2 * T_E + T_D);
    const int l = it / T_LAYER; int r = it % T_LAYER; ksc = nullptr; wsc = 1.f; fp8 = 0;
    if (r < T_IN) { const int kb = r / 80, nb = r % 80; ldw = DIN; pitch = DM * 2; src = in[IN_WIN] + (size_t)l * DM * DIN + (size_t)(64 * kb) * DIN + 64 * nb; dst = ws + WS_WIN + (((size_t)l * DIN + 64 * nb) * DM + 64 * kb) * 2; return; } r -= T_IN;
    if (r < T_OUT) { const int kb = r / 32, nb = r % 32; ldw = DM; pitch = DM * 2; src = in[IN_WOUT] + (size_t)l * DM * DM + (size_t)(64 * kb) * DM + 64 * nb; dst = ws + WS_WOUT + (((size_t)l * DM + 64 * nb) * DM + 64 * kb) * 2; return; } r -= T_OUT;
    const int e = r / (2 * T_E + T_D); r %= (2 * T_E + T_D);
    const size_t le = (size_t)l * NE + e; fp8 = 1;
    if (r < 2 * T_E) { const int up = r >= T_E; r -= up * T_E; const int kb = r / 8, nb = r % 8, n0 = 64 * nb; ldw = DE; pitch = DM; wsc = W1_SCALE;
        src = (up ? in[IN_WU] : in[IN_WG]) + le * DM * DE + (size_t)(64 * kb) * DE + n0; dst = ws + WS_W1 + (le * 1024 + (size_t)((n0 / 128) * 256 + up * 128 + (n0 % 128))) * DM + 64 * kb; ksc = in[IN_NORM2] + (size_t)l * DM + 64 * kb; return; }
    r -= 2 * T_E;
    { const int kb = r / 32, nb = r % 32; ldw = DM; pitch = DE; wsc = W2_SCALE; src = in[IN_WD] + le * DE * DM + (size_t)(64 * kb) * DM + 64 * nb; dst = ws + WS_W2 + (le * DM + 64 * nb) * DE + 64 * kb; }
}
#define TR_LOAD(V, src, ldw) do { _Pragma("unroll") for (int i = 0; i < 16; ++i) V[i] = __builtin_nontemporal_load((const f32x4*)((src) + (size_t)(4 * i + (lane >> 4)) * (ldw) + 4 * (lane & 15))); } while (0)
#define TR_PROC(V, dst, pitch, ksc, wsc, fp8) do { \
    _Pragma("unroll") for (int i = 0; i < 16; ++i) { const int kk = 4 * i + (lane >> 4); f32x4 v = V[i] * ((ksc) ? (ksc)[kk] * (wsc) : (wsc)); \
        LAS float* d = scr + kk * 65 + 4 * (lane & 15); d[0] = v[0]; d[1] = v[1]; d[2] = v[2]; d[3] = v[3]; } \
    LDS_WAIT(); \
    _Pragma("unroll") for (int j = 0; j < 8; ++j) { const int n = (lane >> 3) + 8 * j; const LAS float* sp = scr + (8 * (lane & 7)) * 65 + n; \
        if (fp8) { u32x2 o; o.x = pk4_fp8(sp[0], sp[65], sp[2 * 65], sp[3 * 65]); o.y = pk4_fp8(sp[4 * 65], sp[5 * 65], sp[6 * 65], sp[7 * 65]); *(u32x2*)((dst) + (size_t)n * (pitch) + 8 * (lane & 7)) = o; } \
        else { u32x4 o; o.x = cvt_pk_bf16(sp[0], sp[65]); o.y = cvt_pk_bf16(sp[2 * 65], sp[3 * 65]); o.z = cvt_pk_bf16(sp[4 * 65], sp[5 * 65]); o.w = cvt_pk_bf16(sp[6 * 65], sp[7 * 65]); \
            *(u32x4*)((dst) + (size_t)n * (pitch) + 16 * (lane & 7)) = o; } } \
    LDS_WAIT(); } while (0)
__device__ __forceinline__ void norm_row_bf16(const float* xrow, const float* g, bf16* orow, int lane) {
    f32x4 v[8]; float s = 0.f;
#pragma unroll
    for (int j = 0; j < 8; ++j) { v[j] = *(const f32x4*)(xrow + 4 * lane + 256 * j); s += (v[j][0] * v[j][0] + v[j][1] * v[j][1]) + (v[j][2] * v[j][2] + v[j][3] * v[j][3]); }
    const float rs = __builtin_amdgcn_rsqf(wave_sum(s) * (1.f / DM) + EPS);
#pragma unroll
    for (int j = 0; j < 8; ++j) { const f32x4 gg = *(const f32x4*)(g + 4 * lane + 256 * j);
        u32x2 o; o.x = cvt_pk_bf16(v[j][0] * rs * gg[0], v[j][1] * rs * gg[1]); o.y = cvt_pk_bf16(v[j][2] * rs * gg[2], v[j][3] * rs * gg[3]);
        *(u32x2*)(orow + 4 * lane + 256 * j) = o; }
}
__device__ __forceinline__ void p_prologue(Frame& F) {
    LAS float* scr = (LAS float*)(F.lds + F.wave * 16640);
    const int gw = F.vcu * NWAVES + F.wave, NGW = F.G * NWAVES, lane = F.lane;
    constexpr int T_TOTAL = NLAYER * (32 * 80 + 32 * 32 + NE * (2 * 32 * 8 + 8 * 32));
    {
        f32x4 va[16], vb[16];
        const float* srcA; const float* srcB; unsigned char* dstA; unsigned char* dstB; const float* kA; const float* kB; int ldA, ldB, pA, pB, fA, fB; float wA, wB;
        int it = gw;
        if (it < T_TOTAL) { tile_desc(F.in, F.ws, it, srcA, ldA, dstA, pA, kA, wA, fA); TR_LOAD(va, srcA, ldA); }
        while (it < T_TOTAL) {
            const int itb = it + NGW;
            if (itb < T_TOTAL) { tile_desc(F.in, F.ws, itb, srcB, ldB, dstB, pB, kB, wB, fB); TR_LOAD(vb, srcB, ldB); }
            TR_PROC(va, dstA, pA, kA, wA, fA);
            if (itb >= T_TOTAL) break;
            const int ita = itb + NGW;
            if (ita < T_TOTAL) { tile_desc(F.in, F.ws, ita, srcA, ldA, dstA, pA, kA, wA, fA); TR_LOAD(va, srcA, ldA); }
            TR_PROC(vb, dstB, pB, kB, wB, fB);
            it = ita;
        }
    }
    { bf16* SW = (bf16*)(F.ws + WS_SGUW); const int gt = gw * 64 + F.lane, NGT = NGW * 64;
      for (int idx = gt; idx < NLAYER * 4 * 8 * 4 * 64; idx += NGT) {
          const int ln = idx & 63, pp = (idx >> 6) & 3, itile = (idx >> 8) & 7, h = (idx >> 11) & 3, l = idx >> 13;
          const int i = 16 * itile + (ln & 15), gq = ln >> 4;
          const float* w = F.in[IN_SGUW] + ((size_t)(l * 4 + h) * 128 + i) * 128;
          float v[8];
#pragma unroll
          for (int jj = 0; jj < 8; ++jj) { const int j = 32 * pp + (jj < 4 ? 4 * gq + jj : 16 + 4 * gq + (jj - 4)); v[jj] = (j <= i) ? w[j] : 0.f; }
          u32x4 o; o.x = cvt_pk_bf16(v[0], v[1]); o.y = cvt_pk_bf16(v[2], v[3]); o.z = cvt_pk_bf16(v[4], v[5]); o.w = cvt_pk_bf16(v[6], v[7]);
          *(u32x4*)(SW + (size_t)idx * 8) = o; }
      bf16* WRF = (bf16*)(F.ws + WS_WRT);
      for (int idx = gt; idx < NLAYER * 64 * 3 * 64; idx += NGT) { const int ln = idx & 63, ct = (idx >> 6) % 3, ks = (idx / 192) & 63, l = idx / (192 * 64);
          const int o = 16 * ct + (ln & 15), k0 = 32 * ks + 8 * (ln >> 4);
          float v[8];
#pragma unroll
          for (int j = 0; j < 8; ++j) { const int k = k0 + j; const float wv = o < 32 ? F.in[IN_WRE][((size_t)l * DM + k) * NE + o] : (o < 36 ? F.in[IN_WRG][((size_t)l * DM + k) * 4 + (o - 32)] : 0.f);
              v[j] = wv * F.in[IN_NORM2][(size_t)l * DM + k]; }
          u32x4 hi, lo; hi.x = cvt_pk_bf16(v[0], v[1]); hi.y = cvt_pk_bf16(v[2], v[3]); hi.z = cvt_pk_bf16(v[4], v[5]); hi.w = cvt_pk_bf16(v[6], v[7]);
          lo.x = cvt_pk_bf16(v[0] - bf_lo(hi.x), v[1] - bf_hi(hi.x)); lo.y = cvt_pk_bf16(v[2] - bf_lo(hi.y), v[3] - bf_hi(hi.y));
          lo.z = cvt_pk_bf16(v[4] - bf_lo(hi.z), v[5] - bf_hi(hi.z)); lo.w = cvt_pk_bf16(v[6] - bf_lo(hi.w), v[7] - bf_hi(hi.w));
          bf16* dst = WRF + ((((size_t)l * 64 + ks) * 3 + ct) * 2 * 64 + ln) * 8;
          *(u32x4*)dst = hi; *(u32x4*)(dst + 512) = lo; } }
    bf16* HN = (bf16*)(F.ws + WS_HN);
    for (int m = gw; m < SEQ; m += NGW) norm_row_bf16(F.in[IN_X] + (size_t)m * DM, F.in[IN_NORM1], HN + (size_t)m * DM, F.lane);
}

__device__ __forceinline__ int vimg_off(int row, int c) { return row * 256 + ((((c >> 1) ^ (row & 7)) << 1) | (c & 1)) * 16; }
__device__ __forceinline__ bf16x8 tr_frag(const LAS unsigned char* img, int ra, int rb, int dt, int lane) {
    const int gq = lane >> 4, q = (lane & 15) >> 2, p = lane & 3;
    const int r0 = ra + 4 * gq + q, r1 = rb + 4 * gq + q, c = 2 * dt + (p >> 1);
    const s16x4 a = __builtin_amdgcn_ds_read_tr16_b64_v4i16((LAS s16x4*)(img + vimg_off(r0, c) + 8 * (p & 1)));
    const s16x4 b = __builtin_amdgcn_ds_read_tr16_b64_v4i16((LAS s16x4*)(img + vimg_off(r1, c) + 8 * (p & 1)));
    bf16x8 r; r[0] = a[0]; r[1] = a[1]; r[2] = a[2]; r[3] = a[3]; r[4] = b[0]; r[5] = b[1]; r[6] = b[2]; r[7] = b[3]; return r;
}
__device__ __forceinline__ void sgu_stage8(const bf16* vsrc, int j0, int w, int lane, const f32x4& g0, const f32x4& g1, LAS unsigned char* lds) {
    u32x4 raw[8];
#pragma unroll
    for (int j = 0; j < 8; ++j) raw[j] = *(const u32x4*)(vsrc + (size_t)(w + 8 * (j0 + j)) * DIN);
#pragma unroll
    for (int j = 0; j < 8; ++j) { const int row = w + 8 * (j0 + j);
        float x[8] = {bf_lo(raw[j].x), bf_hi(raw[j].x), bf_lo(raw[j].y), bf_hi(raw[j].y), bf_lo(raw[j].z), bf_hi(raw[j].z), bf_lo(raw[j].w), bf_hi(raw[j].w)};
        float s = 0.f;
#pragma unroll
        for (int e = 0; e < 8; ++e) s += x[e] * x[e];
        const float rs = __builtin_amdgcn_rsqf(wave_sum(s) * (1.f / 512.f) + EPS);
        u32x4 o; o.x = cvt_pk_bf16(x[0] * rs * g0[0], x[1] * rs * g0[1]); o.y = cvt_pk_bf16(x[2] * rs * g0[2], x[3] * rs * g0[3]);
        o.z = cvt_pk_bf16(x[4] * rs * g1[0], x[5] * rs * g1[1]); o.w = cvt_pk_bf16(x[6] * rs * g1[2], x[7] * rs * g1[3]);
        *(LAS u32x4*)(lds + (lane >> 4) * 32768 + vimg_off(row, lane & 15)) = o; }
}
__device__ __forceinline__ void sgu_item(Frame& F, int l, int chunk, int half) {
    const bf16* PROJ = (const bf16*)(F.ws + WS_PROJ); bf16* MIX = (bf16*)(F.ws + WS_MIX);
    const int p0 = chunk * 128, lane = F.lane, w = F.wave;
    LAS float* red = (LAS float*)(F.lds + MISC_OFF + 256);
    const float* gn = F.in[IN_SGUN] + l * 512;
    const f32x4 g0 = *(const f32x4*)(gn + 8 * lane), g1 = *(const f32x4*)(gn + 8 * lane + 4);
    const bf16* vsrc = PROJ + (size_t)p0 * DIN + OFF_V + 8 * lane;
    sgu_stage8(vsrc, 0, w, lane, g0, g1, F.lds);
    if (half) sgu_stage8(vsrc, 8, w, lane, g0, g1, F.lds);
    const int h = w >> 1, ih = w & 1, gq = lane >> 4, fr = lane & 15;
    const LAS unsigned char* img = F.lds + h * 32768;
    const bf16* SW = (const bf16*)(F.ws + WS_SGUW) + (size_t)(l * 4 + h) * 8 * 4 * 64 * 8;
    const float* bs = F.in[IN_SGUB] + (size_t)(l * 4 + h) * 128;
    const float* og = F.in[IN_OUTN] + (size_t)l * DM + h * 128 + 4 * gq;
    const int it0 = ih + 4 * half;
    u32x2 ur[2][8];
#pragma unroll
    for (int ii = 0; ii < 2; ++ii) { const bf16* urow = PROJ + (size_t)(p0 + 16 * (it0 + 2 * ii) + fr) * DIN + OFF_U + h * 128 + 4 * gq;
#pragma unroll
        for (int dt = 0; dt < 8; ++dt) ur[ii][dt] = *(const u32x2*)(urow + 16 * dt); }
    __syncthreads();
    f32x4 z[2][8];
#pragma unroll
    for (int ii = 0; ii < 2; ++ii)
#pragma unroll
        for (int dt = 0; dt < 8; ++dt) z[ii][dt] = (f32x4){0.f, 0.f, 0.f, 0.f};
#pragma unroll 1
    for (int pp = 0; pp <= (it0 + 2) / 2; ++pp) {
        const bf16x8 bw0 = *(const bf16x8*)(SW + ((size_t)(it0 * 4 + pp) * 64 + lane) * 8);
        const bf16x8 bw1 = *(const bf16x8*)(SW + ((size_t)((it0 + 2) * 4 + pp) * 64 + lane) * 8);
        const bool do0 = pp <= it0 / 2;
#pragma unroll
        for (int dt = 0; dt < 8; ++dt) { const bf16x8 a = tr_frag(img, 32 * pp, 32 * pp + 16, dt, lane);
            if (do0) z[0][dt] = __builtin_amdgcn_mfma_f32_16x16x32_bf16(a, bw0, z[0][dt], 0, 0, 0);
            z[1][dt] = __builtin_amdgcn_mfma_f32_16x16x32_bf16(a, bw1, z[1][dt], 0, 0, 0); }
    }
#pragma unroll
    for (int ii = 0; ii < 2; ++ii) { const int i = 16 * (it0 + 2 * ii) + fr; const float bi = bs[i]; float s = 0.f;
#pragma unroll
        for (int dt = 0; dt < 8; ++dt) { const u32x2 u2 = ur[ii][dt];
            f32x4 y; y[0] = bf_lo(u2.x) * (z[ii][dt][0] + bi); y[1] = bf_hi(u2.x) * (z[ii][dt][1] + bi); y[2] = bf_lo(u2.y) * (z[ii][dt][2] + bi); y[3] = bf_hi(u2.y) * (z[ii][dt][3] + bi);
            z[ii][dt] = y; s += (y[0] * y[0] + y[1] * y[1]) + (y[2] * y[2] + y[3] * y[3]); }
        s += __shfl_xor(s, 16); s += __shfl_xor(s, 32);
        if (gq == 0) red[i * 4 + h] = s; }
    __syncthreads();
#pragma unroll
    for (int ii = 0; ii < 2; ++ii) { const int i = 16 * (it0 + 2 * ii) + fr;
        const f32x4 rr = *(const LAS f32x4*)(red + i * 4);
        const float rs = __builtin_amdgcn_rsqf(((rr[0] + rr[1]) + (rr[2] + rr[3])) * (1.f / 512.f) + EPS);
        bf16* orow = MIX + (size_t)(p0 + i) * DM + h * 128 + 4 * gq;
#pragma unroll
        for (int dt = 0; dt < 8; ++dt) { const f32x4 gg = *(const f32x4*)(og + 16 * dt); const f32x4 y = z[ii][dt];
            u32x2 o; o.x = cvt_pk_bf16(y[0] * rs * gg[0], y[1] * rs * gg[1]); o.y = cvt_pk_bf16(y[2] * rs * gg[2], y[3] * rs * gg[3]);
            *(u32x2*)(orow + 16 * dt) = o; } }
    __syncthreads();
}

__device__ __forceinline__ void conv_item(Frame& F, int l, int tile) {
    const bf16* PROJ = (const bf16*)(F.ws + WS_PROJ); bf16* MIX = (bf16*)(F.ws + WS_MIX);
    constexpr int TP = 32, NR = TP + 30;
    const int p0 = tile * TP, c = F.tid, tid = F.tid;
    LAS float* cbuf = (LAS float*)F.lds;
    LAS bf16* zbuf = (LAS bf16*)(F.lds + 65536);
    { u32x4 av[8], gv[8];
#pragma unroll
      for (int i = 0; i < 8; ++i) { const int id = tid + NTHREADS * i, row = id >> 6, ch = (id & 63) * 8; int p = p0 - 30 + row; p = p < 0 ? 0 : p; p = row < NR ? p : 0;
          av[i] = *(const u32x4*)(PROJ + (size_t)p * DIN + OFF_A + ch); gv[i] = *(const u32x4*)(PROJ + (size_t)p * DIN + OFF_G + ch); }
#pragma unroll
      for (int i = 0; i < 8; ++i) { const int id = tid + NTHREADS * i, row = id >> 6, ch = (id & 63) * 8; const bool live = (p0 - 30 + row) >= 0;
          const unsigned au[4] = {av[i].x, av[i].y, av[i].z, av[i].w}, gu[4] = {gv[i].x, gv[i].y, gv[i].z, gv[i].w}; u32x4 o; unsigned ou[4];
#pragma unroll
          for (int e = 0; e < 4; ++e) { const float z0 = bf_lo(au[e]) * sigmoidf_(bf_lo(gu[e])), z1 = bf_hi(au[e]) * sigmoidf_(bf_hi(gu[e])); ou[e] = live ? cvt_pk_bf16(z0, z1) : 0u; }
          o.x = ou[0]; o.y = ou[1]; o.z = ou[2]; o.w = ou[3];
          if (row < NR) *(LAS u32x4*)(zbuf + row * 512 + ch) = o; } }
    float wk[CONV_K];
#pragma unroll
    for (int k = 0; k < CONV_K; ++k) wk[k] = F.in[IN_CONVW][((size_t)l * CONV_K + k) * 512 + c];
    const float cb = F.in[IN_CONVB][l * 512 + c];
    __syncthreads();
#define CONV_Z(r) __builtin_bit_cast(float, (unsigned)zbuf[(r) * 512 + c] << 16)
    float win[30];
#pragma unroll
    for (int r = 0; r < 30; ++r) win[r] = CONV_Z(r);
#pragma unroll
    for (int q = 0; q < TP; ++q) { const float zv = CONV_Z(30 + q); float acc = cb + wk[30] * zv;
#pragma unroll
        for (int k = 0; k < 30; ++k) acc += wk[k] * win[(k + q) % 30];
        win[q % 30] = zv; cbuf[q * 512 + c] = acc; }
#undef CONV_Z
    __syncthreads();
    const float* lg = F.in[IN_LNG] + l * 512 + 8 * F.lane; const float* lb = F.in[IN_LNB] + l * 512 + 8 * F.lane; const float* og = F.in[IN_OUTN] + (size_t)l * DM + 512 + 8 * F.lane;
    const f32x4 lg0 = *(const f32x4*)lg, lg1 = *(const f32x4*)(lg + 4), lb0 = *(const f32x4*)lb, lb1 = *(const f32x4*)(lb + 4), og0 = *(const f32x4*)og, og1 = *(const f32x4*)(og + 4);
    for (int r = F.wave; r < TP; r += NWAVES) {
        const f32x4 a0 = *(const LAS f32x4*)(cbuf + r * 512 + 8 * F.lane), a1 = *(const LAS f32x4*)(cbuf + r * 512 + 8 * F.lane + 4);
        float x[8] = {a0[0], a0[1], a0[2], a0[3], a1[0], a1[1], a1[2], a1[3]};
        float s = 0.f;
#pragma unroll
        for (int e = 0; e < 8; ++e) s += x[e];
        const float mu = wave_sum(s) * (1.f / 512.f); float q2 = 0.f;
#pragma unroll
        for (int e = 0; e < 8; ++e) { x[e] -= mu; q2 += x[e] * x[e]; }
        const float rstd = __builtin_amdgcn_rsqf(wave_sum(q2) * (1.f / 512.f) + EPS);
        const float gam[8] = {lg0[0], lg0[1], lg0[2], lg0[3], lg1[0], lg1[1], lg1[2], lg1[3]}, bet[8] = {lb0[0], lb0[1], lb0[2], lb0[3], lb1[0], lb1[1], lb1[2], lb1[3]};
        float s2 = 0.f;
#pragma unroll
        for (int e = 0; e < 8; ++e) { const float y = x[e] * rstd * gam[e] + bet[e]; x[e] = y * sigmoidf_(y); s2 += x[e] * x[e]; }
        const float rs = __builtin_amdgcn_rsqf(wave_sum(s2) * (1.f / 512.f) + EPS);
        u32x4 o; o.x = cvt_pk_bf16(x[0] * rs * og0[0], x[1] * rs * og0[1]); o.y = cvt_pk_bf16(x[2] * rs * og0[2], x[3] * rs * og0[3]);
        o.z = cvt_pk_bf16(x[4] * rs * og1[0], x[5] * rs * og1[1]); o.w = cvt_pk_bf16(x[6] * rs * og1[2], x[7] * rs * og1[3]);
        *(u32x4*)(MIX + (size_t)(p0 + r) * DM + 512 + 8 * F.lane) = o;
    }
    __syncthreads();
}

__device__ __forceinline__ int kimg_off(int row, int c) { return row * 256 + ((c ^ (row & 15)) << 4); }
__device__ __forceinline__ bf16x8 tr_frag2(const LAS unsigned char* vs, int ta, int tb, int dt, int lane) {
    const int gq = lane >> 4, q = (lane & 15) >> 2, p = lane & 3, c = 2 * dt + (p >> 1), rr = 4 * gq + q;
    const int off = rr * 256 + ((((c >> 1) ^ (rr & 7)) << 1) | (c & 1)) * 16 + 8 * (p & 1);
    const s16x4 a = __builtin_amdgcn_ds_read_tr16_b64_v4i16((LAS s16x4*)(vs + ta + off));
    const s16x4 b = __builtin_amdgcn_ds_read_tr16_b64_v4i16((LAS s16x4*)(vs + tb + off));
    bf16x8 r; r[0] = a[0]; r[1] = a[1]; r[2] = a[2]; r[3] = a[3]; r[4] = b[0]; r[5] = b[1]; r[6] = b[2]; r[7] = b[3]; return r;
}
#define ATT_DECODE(st) const int run_ = (int)blockIdx.x + F.G * ((st) / 5), b_ = (st) % 5 - 1; const int g = run_ >> 8, h = (run_ >> 5) & 7, rr_ = run_ & 31; \
    const int sh = 2 * g, dil = 1 << sh, rps = 32 >> sh; const int r = rr_ / rps, nb = 4 * (rr_ % rps) + b_
#define ATT_LOAD(st) do { if (ATT_EXP == 2) break; ATT_DECODE(st); const int cc = tid & 15; \
    _Pragma("unroll") for (int j = 0; j < 4; ++j) { const int row = (tid >> 4) + 32 * j; int ms = nb * 128 + row; ms = ms < 0 ? 0 : ms; const size_t pos = (size_t)ms * dil + r; \
        kr[j] = *(const u32x4*)(PROJ + pos * DIN + OFF_K + h * HD + 8 * cc); vr[j] = *(const u32x4*)(PROJ + pos * DIN + OFF_VV + h * HD + 8 * cc); } \
    if (b_ >= 0) { const size_t qpos_ = (size_t)(nb * 128 + 16 * w + (lane & 15)) * dil + r; \
        _Pragma("unroll") for (int ks = 0; ks < 4; ++ks) qr[ks] = *(const u32x4*)(PROJ + qpos_ * DIN + OFF_Q + h * HD + 32 * ks + 8 * (lane >> 4)); } } while (0)
__device__ __forceinline__ void att_phase(Frame& F, int l) {
    const bf16* PROJ = (const bf16*)(F.ws + WS_PROJ);
    bf16* ATT = (bf16*)(F.ws + WS_ATT); float* LSE = (float*)(F.ws + WS_LSE);
    const int lane = F.lane, w = F.wave, tid = F.tid, fr = lane & 15, gq = lane >> 4;
    LAS unsigned char* Ks = F.lds; LAS unsigned char* Vs = F.lds + 65536;
    const int nsteps = 5 * ((768 - (int)blockIdx.x + F.G - 1) / F.G);
    u32x4 kr[4], vr[4], qr[4];
    if (ATT_EXP == 2) { for (int j = 0; j < 4; ++j) { kr[j] = (u32x4){0x3f803f80u + (unsigned)tid, 0x3f003f80u, 0x3f803f00u, 0x3e803f80u}; vr[j] = kr[j]; qr[j] = kr[j]; } }
    if (nsteps > 0) ATT_LOAD(0);
    const int cc = tid & 15;
    const float* kgp = F.in[IN_KN] + l * HD + 8 * cc;
    const f32x4 kg0 = *(const f32x4*)kgp, kg1 = *(const f32x4*)(kgp + 4);
    for (int st = 0; st < nsteps; ++st) {
        ATT_DECODE(st);
        const int slot = (b_ + 1) & 1, curoff = slot * 32768, prevoff = 32768 - curoff;
#pragma unroll
        for (int j = 0; j < 4; ++j) { const int row = (tid >> 4) + 32 * j;
            const u32x4 k4 = kr[j];
            float x[8] = {bf_lo(k4.x), bf_hi(k4.x), bf_lo(k4.y), bf_hi(k4.y), bf_lo(k4.z), bf_hi(k4.z), bf_lo(k4.w), bf_hi(k4.w)};
            float sq = 0.f;
#pragma unroll
            for (int e = 0; e < 8; ++e) sq += x[e] * x[e];
            const float rs = __builtin_amdgcn_rsqf(row16_sum(sq) * (1.f / HD) + EPS);
            u32x4 o; o.x = cvt_pk_bf16(x[0] * rs * kg0[0], x[1] * rs * kg0[1]); o.y = cvt_pk_bf16(x[2] * rs * kg0[2], x[3] * rs * kg0[3]);
            o.z = cvt_pk_bf16(x[4] * rs * kg1[0], x[5] * rs * kg1[1]); o.w = cvt_pk_bf16(x[6] * rs * kg1[2], x[7] * rs * kg1[3]);
            *(LAS u32x4*)(Ks + curoff + kimg_off(row, cc)) = o;
            *(LAS u32x4*)(Vs + curoff + vimg_off(row, cc)) = vr[j]; }
        const int iq = 16 * w + fr; const size_t qpos = (size_t)(nb * 128 + iq) * dil + r;
        bf16x8 qf[4];
        if (b_ >= 0) { float x[4][8]; float sq = 0.f;
#pragma unroll
          for (int ks = 0; ks < 4; ++ks) { const u32x4 q4 = qr[ks];
              x[ks][0] = bf_lo(q4.x); x[ks][1] = bf_hi(q4.x); x[ks][2] = bf_lo(q4.y); x[ks][3] = bf_hi(q4.y); x[ks][4] = bf_lo(q4.z); x[ks][5] = bf_hi(q4.z); x[ks][6] = bf_lo(q4.w); x[ks][7] = bf_hi(q4.w);
#pragma unroll
              for (int e = 0; e < 8; ++e) sq += x[ks][e] * x[ks][e]; }
          sq = sum4(sq);
          const float rs = __builtin_amdgcn_rsqf(sq * (1.f / HD) + EPS) * 0.12751743f;
#pragma unroll
          for (int ks = 0; ks < 4; ++ks) { const float* qg = F.in[IN_QN] + l * HD + 32 * ks + 8 * gq; const f32x4 q0 = *(const f32x4*)qg, q1 = *(const f32x4*)(qg + 4);
              u32x4 o; o.x = cvt_pk_bf16(x[ks][0] * rs * q0[0], x[ks][1] * rs * q0[1]); o.y = cvt_pk_bf16(x[ks][2] * rs * q0[2], x[ks][3] * rs * q0[3]);
              o.z = cvt_pk_bf16(x[ks][4] * rs * q1[0], x[ks][5] * rs * q1[1]); o.w = cvt_pk_bf16(x[ks][6] * rs * q1[2], x[ks][7] * rs * q1[3]);
              qf[ks] = __builtin_bit_cast(bf16x8, o); } }
        __syncthreads();
        if (st + 1 < nsteps) ATT_LOAD(st + 1);
        if (b_ >= 0 && ATT_EXP != 1) {
        f32x4 sc[10];
#pragma unroll
        for (int kt = 0; kt < 9; ++kt) { sc[kt] = (f32x4){0.f, 0.f, 0.f, 0.f}; const int T = w + kt; const int kbase = (T < 8 ? prevoff : curoff); const int krow = 16 * (T & 7) + fr;
#pragma unroll
            for (int ks = 0; ks < 4; ++ks) { const bf16x8 kf = *(const LAS bf16x8*)(Ks + kbase + kimg_off(krow, 4 * ks + gq));
                sc[kt] = __builtin_amdgcn_mfma_f32_16x16x32_bf16(kf, qf[ks], sc[kt], 0, 0, 0); } }
#pragma unroll
        for (int e = 0; e < 4; ++e) { sc[0][e] = (4 * gq + e >= fr) ? sc[0][e] : -INFINITY; sc[8][e] = (4 * gq + e <= fr) ? sc[8][e] : -INFINITY; }
        if (nb == 0) {
#pragma unroll
            for (int kt = 0; kt < 8; ++kt) if (w + kt < 8) sc[kt] = (f32x4){-INFINITY, -INFINITY, -INFINITY, -INFINITY}; }
        float mx = -INFINITY;
#pragma unroll
        for (int kt = 0; kt < 9; ++kt) mx = fmaxf(fmaxf(mx, fmaxf(sc[kt][0], sc[kt][1])), fmaxf(sc[kt][2], sc[kt][3]));
        mx = max4(mx);
        float sum = 0.f;
#pragma unroll
        for (int kt = 0; kt < 9; ++kt)
#pragma unroll
            for (int e = 0; e < 4; ++e) { const float p = __builtin_amdgcn_exp2f(sc[kt][e] - mx); sc[kt][e] = p; sum += p; }
        sc[9] = (f32x4){0.f, 0.f, 0.f, 0.f};
        sum = sum4(sum);
        bf16x8 pf[5];
#pragma unroll
        for (int pp = 0; pp < 5; ++pp) { u32x4 o; o.x = cvt_pk_bf16(sc[2 * pp][0], sc[2 * pp][1]); o.y = cvt_pk_bf16(sc[2 * pp][2], sc[2 * pp][3]); o.z = cvt_pk_bf16(sc[2 * pp + 1][0], sc[2 * pp + 1][1]); o.w = cvt_pk_bf16(sc[2 * pp + 1][2], sc[2 * pp + 1][3]);
            pf[pp] = __builtin_bit_cast(bf16x8, o); }
        const float inv = __builtin_amdgcn_rcpf(sum);
        bf16* orow = ATT + ((size_t)g * SEQ + qpos) * 1024 + h * HD + 4 * gq;
        int toff[10];
#pragma unroll
        for (int kt = 0; kt < 10; ++kt) { const int T = (w + kt) < 15 ? (w + kt) : 15; toff[kt] = (T < 8 ? prevoff : curoff) + (T & 7) * 16 * 256; }
#pragma unroll
        for (int dt = 0; dt < 8; ++dt) { f32x4 o = (f32x4){0.f, 0.f, 0.f, 0.f};
#pragma unroll
            for (int pp = 0; pp < 5; ++pp) { const bf16x8 vf = tr_frag2(Vs, toff[2 * pp], toff[2 * pp + 1], dt, lane);
                o = __builtin_amdgcn_mfma_f32_16x16x32_bf16(vf, pf[pp], o, 0, 0, 0); }
            u32x2 ow; ow.x = cvt_pk_bf16(o[0] * inv, o[1] * inv); ow.y = cvt_pk_bf16(o[2] * inv, o[3] * inv);
            *(u32x2*)(orow + 16 * dt) = ow; }
        if (gq == 0) LSE[((size_t)g * SEQ + qpos) * NHEAD + h] = (mx + __builtin_amdgcn_logf(sum)) * 0.6931471805599453f;
        }
        if (b_ >= 0 && ATT_EXP == 1) { bf16* orow = ATT + ((size_t)g * SEQ + qpos) * 1024 + h * HD + 4 * gq;
#pragma unroll
            for (int dt = 0; dt < 8; ++dt) { u32x2 ow; ow.x = __builtin_bit_cast(unsigned, qf[dt & 3][0] | (qf[dt & 3][1] << 16)) & 0x3f803f80u; ow.y = 0u; *(u32x2*)(orow + 16 * dt) = ow; }
            if (gq == 0) LSE[((size_t)g * SEQ + qpos) * NHEAD + h] = 0.f; }
        __syncthreads();
    }
}
#undef ATT_DECODE
#undef ATT_LOAD

__device__ __forceinline__ void att_combine(Frame& F, int l) {
    const bf16* ATT = (const bf16*)(F.ws + WS_ATT); const float* LSE = (const float*)(F.ws + WS_LSE); bf16* MIX = (bf16*)(F.ws + WS_MIX);
    const int gw = F.vcu * NWAVES + F.wave, NGW = F.G * NWAVES, lane = F.lane;
    const float* og = F.in[IN_OUTN] + (size_t)l * DM + 1024 + 16 * lane;
    f32x4 gg[4];
#pragma unroll
    for (int q = 0; q < 4; ++q) gg[q] = *(const f32x4*)(og + 4 * q);
    for (int m = gw; m < SEQ; m += NGW) {
        const int hh = lane >> 3;
        const float l0 = LSE[((size_t)0 * SEQ + m) * NHEAD + hh], l1 = LSE[((size_t)1 * SEQ + m) * NHEAD + hh], l2 = LSE[((size_t)2 * SEQ + m) * NHEAD + hh];
        const float M = fmaxf(l0, fmaxf(l1, l2)); float w0 = fast_exp(l0 - M), w1 = fast_exp(l1 - M), w2 = fast_exp(l2 - M);
        const float iw = __builtin_amdgcn_rcpf(w0 + w1 + w2); w0 *= iw; w1 *= iw; w2 *= iw;
        float y[16]; float s = 0.f;
#pragma unroll
        for (int q = 0; q < 2; ++q) {
            const u32x4 a = *(const u32x4*)(ATT + ((size_t)0 * SEQ + m) * 1024 + 16 * lane + 8 * q), b = *(const u32x4*)(ATT + ((size_t)1 * SEQ + m) * 1024 + 16 * lane + 8 * q), c = *(const u32x4*)(ATT + ((size_t)2 * SEQ + m) * 1024 + 16 * lane + 8 * q);
            const unsigned au[4] = {a.x, a.y, a.z, a.w}, bu[4] = {b.x, b.y, b.z, b.w}, cu[4] = {c.x, c.y, c.z, c.w};
#pragma unroll
            for (int e = 0; e < 4; ++e) { y[8 * q + 2 * e] = w0 * bf_lo(au[e]) + w1 * bf_lo(bu[e]) + w2 * bf_lo(cu[e]); y[8 * q + 2 * e + 1] = w0 * bf_hi(au[e]) + w1 * bf_hi(bu[e]) + w2 * bf_hi(cu[e]); } }
#pragma unroll
        for (int e = 0; e < 16; ++e) s += y[e] * y[e];
        const float rs = __builtin_amdgcn_rsqf(wave_sum(s) * (1.f / 1024.f) + EPS);
#pragma unroll
        for (int q = 0; q < 2; ++q) { u32x4 o;
            o.x = cvt_pk_bf16(y[8 * q + 0] * rs * gg[2 * q][0], y[8 * q + 1] * rs * gg[2 * q][1]); o.y = cvt_pk_bf16(y[8 * q + 2] * rs * gg[2 * q][2], y[8 * q + 3] * rs * gg[2 * q][3]);
            o.z = cvt_pk_bf16(y[8 * q + 4] * rs * gg[2 * q + 1][0], y[8 * q + 5] * rs * gg[2 * q + 1][1]); o.w = cvt_pk_bf16(y[8 * q + 6] * rs * gg[2 * q + 1][2], y[8 * q + 7] * rs * gg[2 * q + 1][3]);
            *(u32x4*)(MIX + (size_t)m * DM + 1024 + 16 * lane + 8 * q) = o; }
    }
}

#define ROUTER_LOAD(S, ks) do { \
    _Pragma("unroll") for (int rt = 0; rt < 4; ++rt) xa##S[rt] = *(const u32x4*)(xrow + (size_t)rt * 16 * DM + 32 * (ks)); \
    _Pragma("unroll") for (int ct = 0; ct < 3; ++ct) { bh##S[ct] = *(const bf16x8*)(wf + (size_t)(ks) * 3072 + (ct * 2) * 512); bl##S[ct] = *(const bf16x8*)(wf + (size_t)(ks) * 3072 + (ct * 2 + 1) * 512); } } while (0)
#define ROUTER_STEP(S, ks) do { \
    _Pragma("unroll") for (int rt = 0; rt < 4; ++rt) { const u32x4 xq = xa##S[rt]; \
        const float x0 = bf_lo(xq.x), x1 = bf_hi(xq.x), x2 = bf_lo(xq.y), x3 = bf_hi(xq.y), x4 = bf_lo(xq.z), x5 = bf_hi(xq.z), x6 = bf_lo(xq.w), x7 = bf_hi(xq.w); \
        ssq[rt] += (x0 * x0 + x1 * x1) + (x2 * x2 + x3 * x3) + (x4 * x4 + x5 * x5) + (x6 * x6 + x7 * x7); \
        { u32x2 x8; x8.x = pk4_fp8(x0, x1, x2, x3); x8.y = pk4_fp8(x4, x5, x6, x7); *(u32x2*)(x8row + (size_t)rt * 16 * DM + 32 * (ks)) = x8; } \
        const bf16x8 xh = __builtin_bit_cast(bf16x8, xq); \
        _Pragma("unroll") for (int ct = 0; ct < 3; ++ct) { \
            acc[rt][ct] = __builtin_amdgcn_mfma_f32_16x16x32_bf16(xh, bh##S[ct], acc[rt][ct], 0, 0, 0); \
            acc[rt][ct] = __builtin_amdgcn_mfma_f32_16x16x32_bf16(xh, bl##S[ct], acc[rt][ct], 0, 0, 0); } } } while (0)
__device__ __forceinline__ void router_phase(Frame& F, int l, int alt = 0) {
    const bf16* H1 = (const bf16*)(F.ws + WS_HN);
    const bf16* WRF = (const bf16*)(F.ws + WS_WRT) + (size_t)l * 64 * 3 * 2 * 64 * 8;
    unsigned* cnt = (unsigned*)(F.ws + WS_CTL) + CW_CNT + 2048 * l + 32768 * alt;
    int* tok = (int*)(F.ws + (alt ? WS_ALT : WS_TOK)); f32x4* tinfo = (f32x4*)(F.ws + (alt ? WS_ALT + 4 * MiB : WS_TINFO)); float* rslot = (float*)(F.ws + (alt ? WS_ALT + 2 * MiB : WS_RSLOT));
    const int lane = F.lane, tid = F.tid, w = F.wave, fr = lane & 15, g = lane >> 4;
    constexpr int PS = 49;
    LAS float* P = (LAS float*)F.lds;
    LAS float* SS = (LAS float*)(F.lds + 8 * 64 * PS * 4);
    for (int task = (int)blockIdx.x; task < SEQ / 64; task += F.G) {
        const bf16* xrow = H1 + (size_t)(task * 64 + fr) * DM + 256 * w + 8 * g;
        unsigned char* x8row = F.ws + WS_X8 + (size_t)(task * 64 + fr) * DM + 256 * w + 8 * g;
        const bf16* wf = WRF + ((size_t)(8 * w) * 3 * 2 * 64 + lane) * 8;
        f32x4 acc[4][3]; float ssq[4] = {0.f, 0.f, 0.f, 0.f};
#pragma unroll
        for (int rt = 0; rt < 4; ++rt)
#pragma unroll
            for (int ct = 0; ct < 3; ++ct) acc[rt][ct] = (f32x4){0.f, 0.f, 0.f, 0.f};
        u32x4 xaA[4], xaB[4]; bf16x8 bhA[3], blA[3], bhB[3], blB[3];
        ROUTER_LOAD(A, 0);
#pragma unroll 1
        for (int it = 0; it < 4; ++it) {
            ROUTER_LOAD(B, 1); __builtin_amdgcn_sched_barrier(0);
            ROUTER_STEP(A, 0); __builtin_amdgcn_sched_barrier(0);
            if (it < 3) ROUTER_LOAD(A, 2);
            __builtin_amdgcn_sched_barrier(0);
            ROUTER_STEP(B, 1); __builtin_amdgcn_sched_barrier(0);
            xrow += 64; x8row += 64; wf += 2 * 3072;
        }
#pragma unroll
        for (int rt = 0; rt < 4; ++rt) { float sq = ssq[rt]; sq += __shfl_xor(sq, 16); sq += __shfl_xor(sq, 32);
            if (g == 0) SS[w * 64 + 16 * rt + fr] = sq;
#pragma unroll
            for (int ct = 0; ct < 3; ++ct)
#pragma unroll
                for (int e = 0; e < 4; ++e) P[(w * 64 + 16 * rt + 4 * g + e) * PS + 16 * ct + fr] = acc[rt][ct][e]; }
        __syncthreads();
        if (tid < 64) {
            const int t = task * 64 + tid;
            float ss = 0.f;
#pragma unroll
            for (int q = 0; q < 8; ++q) ss += SS[q * 64 + tid];
            const float rs = __builtin_amdgcn_rsqf(ss * (1.f / DM) + EPS);
            const LAS float* pr = P + tid * PS;
            float lg[4];
#pragma unroll
            for (int o = 0; o < 4; ++o) { float a = 0.f;
#pragma unroll
                for (int q = 0; q < 8; ++q) a += pr[q * 64 * PS + 32 + o];
                lg[o] = a * rs + F.in[IN_BRG][l * 4 + o]; }
            int gi = 0; float gm = lg[0];
#pragma unroll
            for (int o = 1; o < 4; ++o) if (lg[o] > gm) { gm = lg[o]; gi = o; }
            float den = 0.f;
#pragma unroll
            for (int o = 0; o < 4; ++o) den += __expf(lg[o] - gm);
            const float gate_g = 1.f / den;
            float t1v = -INFINITY, t2v = -INFINITY; int t1i = 0, t2i = 0;
#pragma unroll
            for (int ii = 0; ii < 8; ++ii) { const int o = gi * 8 + ii; float a = 0.f;
#pragma unroll
                for (int q = 0; q < 8; ++q) a += pr[q * 64 * PS + o];
                const float v = a * rs + F.in[IN_BRE][l * NE + o];
                if (v > t1v) { t2v = t1v; t2i = t1i; t1v = v; t1i = ii; }
                else if (v > t2v) { t2v = v; t2i = ii; } }
            const float pp1 = 1.f / (1.f + __expf(t2v - t1v)), pp2 = 1.f - pp1;
            const int e0 = gi * 8 + t1i, e1 = gi * 8 + t2i;
            LAS unsigned* lcnt = (LAS unsigned*)(F.lds + 8 * 64 * PS * 4 + 8 * 64 * 4);
            if (tid < 32) lcnt[tid] = 0u;
            const unsigned r0 = __hip_atomic_fetch_add(lcnt + e0, 1u, __ATOMIC_RELAXED, __HIP_MEMORY_SCOPE_WORKGROUP), r1 = __hip_atomic_fetch_add(lcnt + e1, 1u, __ATOMIC_RELAXED, __HIP_MEMORY_SCOPE_WORKGROUP);
            if (tid < 32) { const unsigned c = lcnt[tid]; lcnt[32 + tid] = c ? atomicAdd(&cnt[tid * CNT_STRIDE], c) : 0u; }
            const unsigned s0 = lcnt[32 + e0] + r0, s1 = lcnt[32 + e1] + r1;
            tok[(size_t)e0 * TOKCAP + s0] = t; tok[(size_t)e1 * TOKCAP + s1] = t;
            rslot[(size_t)e0 * TOKCAP + s0] = rs; rslot[(size_t)e1 * TOKCAP + s1] = rs;
            f32x4 ti; ti[0] = __builtin_bit_cast(float, (int)(e0 * TOKCAP + s0)); ti[1] = __builtin_bit_cast(float, (int)(e1 * TOKCAP + s1)); ti[2] = gate_g * pp1; ti[3] = gate_g * pp2;
            tinfo[t] = ti;
        }
        __syncthreads();
    }
}
__device__ __forceinline__ void moe_table(Frame& F, int l) {
    const unsigned* cnt = (const unsigned*)(F.ws + WS_CTL) + CW_CNT + 2048 * l;
    LAS int* tstart = (LAS int*)(F.lds + MISC_OFF + 64);
    __syncthreads();
    if (F.tid == 0) { int acc = 0; for (int e = 0; e < NE; ++e) { tstart[e] = acc; acc += ((int)cnt[e * CNT_STRIDE] + 255) >> 8; } tstart[NE] = acc; }
    __syncthreads();
    { LAS int* tile_e = (LAS int*)(F.lds + MISC_OFF + 2304);
      if (F.tid < 160) { int e = 0; for (int j = 1; j < NE; ++j) e = (tstart[j] <= F.tid) ? j : e; tile_e[F.tid] = e; } }
    __syncthreads();
}
__device__ __forceinline__ void combine_phase(Frame& F, int l) {
    const LAS int* tstart = (const LAS int*)(F.lds + MISC_OFF + 64);
    const bf16* Y = (const bf16*)(F.ws + WS_Y); const f32x4* tinfo = (const f32x4*)(F.ws + WS_TINFO);
    bf16* H = (bf16*)(F.ws + WS_H); bf16* HN = (bf16*)(F.ws + WS_HN);
    const int gw = F.vcu * NWAVES + F.wave, NGW = F.G * NWAVES, lane = F.lane;
    const float* g1n = F.in[IN_NORM1] + (size_t)DM;
    for (int m = gw; m < SEQ; m += NGW) {
        const f32x4 ti = tinfo[m];
        const float tf0 = ti[0], tf1 = ti[1]; const int s0 = __builtin_bit_cast(int, tf0), s1 = __builtin_bit_cast(int, tf1);
        const int e0 = s0 >> 14, e1 = s1 >> 14;
        const size_t r0 = (size_t)tstart[e0] * 256 + (s0 & (TOKCAP - 1)), r1 = (size_t)tstart[e1] * 256 + (s1 & (TOKCAP - 1));
        const float ga = ti[2], gb = ti[3];
        f32x4 v[8]; float s = 0.f;
#pragma unroll
        for (int j = 0; j < 8; ++j) { const u32x2 hx = *(const u32x2*)(HN + (size_t)m * DM + 4 * lane + 256 * j);
            const u32x2 ya = *(const u32x2*)(Y + r0 * DM + 4 * lane + 256 * j), yb = *(const u32x2*)(Y + r1 * DM + 4 * lane + 256 * j);
            v[j][0] = bf_lo(hx.x) + ga * bf_lo(ya.x) + gb * bf_lo(yb.x); v[j][1] = bf_hi(hx.x) + ga * bf_hi(ya.x) + gb * bf_hi(yb.x);
            v[j][2] = bf_lo(hx.y) + ga * bf_lo(ya.y) + gb * bf_lo(yb.y); v[j][3] = bf_hi(hx.y) + ga * bf_hi(ya.y) + gb * bf_hi(yb.y);
            s += (v[j][0] * v[j][0] + v[j][1] * v[j][1]) + (v[j][2] * v[j][2] + v[j][3] * v[j][3]); }
        if (l == 0) {
            const float rs = __builtin_amdgcn_rsqf(wave_sum(s) * (1.f / DM) + EPS);
            bf16* hrow = H + (size_t)m * DM; bf16* orow = HN + (size_t)m * DM;
#pragma unroll
            for (int j = 0; j < 8; ++j) { const f32x4 gg = *(const f32x4*)(g1n + 4 * lane + 256 * j);
                u32x2 hb; hb.x = cvt_pk_bf16(v[j][0], v[j][1]); hb.y = cvt_pk_bf16(v[j][2], v[j][3]); *(u32x2*)(hrow + 4 * lane + 256 * j) = hb;
                u32x2 o; o.x = cvt_pk_bf16(v[j][0] * rs * gg[0], v[j][1] * rs * gg[1]); o.y = cvt_pk_bf16(v[j][2] * rs * gg[2], v[j][3] * rs * gg[3]);
                *(u32x2*)(orow + 4 * lane + 256 * j) = o; }
        } else {
            float* orow = F.out + (size_t)m * DM;
#pragma unroll
            for (int j = 0; j < 8; ++j) *(f32x4*)(orow + 4 * lane + 256 * j) = v[j];
        }
    }
}

__device__ __forceinline__ void relaunder(Frame& F) { int t = threadIdx.x; asm volatile("" : "+v"(t)); F.tid = t; F.lane = t & 63; }
constexpr int N_PHASES = 17;
#ifndef PHASE_MASK
#define PHASE_MASK 0x1ff
#endif
#ifndef MIX_MASK
#define MIX_MASK 7
#endif
#ifndef DUP_PHASE
#define DUP_PHASE 0
#endif
#define DUP(k) for (int _d = 0; _d < ((DUP_PHASE == (k)) ? 2 : 1); ++_d)
#define IN(k) (lo <= (k) && (k) < hi)
#define EN(b) ((PHASE_MASK >> (b)) & 1)
#ifndef PROBE_STAMP
#define PROBE_STAMP (-1)
#endif
#define SEAM(k) do { if (IN(k) && IN((k) + 1)) { xcd_barrier(bar); if (PROBE_STAMP >= 0 && blockIdx.x == 0 && F.tid == 0) { const unsigned long long _t = wall_clock64(); F.MISC[802 + 2 * (k)] = (unsigned)_t; F.MISC[803 + 2 * (k)] = (unsigned)(_t >> 32); } } } while (0)
template <int l>
__device__ __forceinline__ void layer_phases(Frame& F, const XcdBarrier& bar, const int lo, const int hi) {
    constexpr int pb = 1 + 8 * l;
    relaunder(F);
    if (EN(1) && IN(pb)) {
        pg8::StaticSched S; S.init((const bf16*)(F.ws + WS_HN), (const bf16*)(F.ws + WS_WIN) + (size_t)l * DIN * DM, SEQ, DIN, DM, F.G, (int)blockIdx.x);
        pg8::EpiProj E{(bf16*)(F.ws + WS_PROJ)};
        DUP(1) pg8::gemm_phase<pg8::EpiProj, pg8::StaticSched>(F.lds, DM, S, E);
    }
    SEAM(pb);
    relaunder(F);
    if (EN(2) && IN(pb + 1)) {
        constexpr int N_SGU = 256, N_CONV = 512, N_ATT = 3072;
#define MSTAMP(i) do { if (PROBE_STAMP >= 100 && l == 0 && blockIdx.x == 0 && F.tid == 0) { const unsigned long long _t = wall_clock64(); F.MISC[900 + 2 * (i)] = (unsigned)_t; F.MISC[901 + 2 * (i)] = (unsigned)(_t >> 32); } } while (0)
        MSTAMP(0);
        if (MIX_MASK & 1) DUP(2) att_phase(F, l);
        MSTAMP(1);
        if (MIX_MASK & 2) DUP(3) for (int it = (int)blockIdx.x; it < N_CONV; it += F.G) conv_item(F, l, it);
        MSTAMP(2);
        if (MIX_MASK & 4) DUP(4) for (int it = (int)blockIdx.x; it < N_SGU; it += F.G) sgu_item(F, l, it >> 1, it & 1);
        MSTAMP(3);
#undef MSTAMP
    }
    SEAM(pb + 1);
    if (DUP_PHASE == 12 && IN(pb + 1)) {
        pg8::StaticSched S; S.init((const bf16*)(F.ws + WS_MIX), (const bf16*)(F.ws + WS_WIN) + (size_t)l * DIN * DM, SEQ, DIN, DM, F.G, (int)blockIdx.x);
        pg8::EpiProj E{(bf16*)(F.ws + WS_PROJ)};
        pg8::gemm_phase<pg8::EpiProj, pg8::StaticSched>(F.lds, DM, S, E);
        xcd_barrier(bar);
    }
    relaunder(F);
    if (EN(3) && IN(pb + 2)) DUP(5) att_combine(F, l);
    SEAM(pb + 2);
    relaunder(F);
    if (EN(4) && IN(pb + 3)) {
        pg8::StaticSched S; S.init((const bf16*)(F.ws + WS_MIX), (const bf16*)(F.ws + WS_WOUT) + (size_t)l * DM * DM, SEQ, DM, DM, F.G, (int)blockIdx.x);
        if constexpr (l == 0) { pg8::EpiResid<false> E{(const void*)F.in[IN_X], (bf16*)(F.ws + WS_HN)}; DUP(6) pg8::gemm_phase<pg8::EpiResid<false>, pg8::StaticSched>(F.lds, DM, S, E); }
        else { pg8::EpiResid<true> E{(const void*)(F.ws + WS_H), (bf16*)(F.ws + WS_HN)}; DUP(6) pg8::gemm_phase<pg8::EpiResid<true>, pg8::StaticSched>(F.lds, DM, S, E); }
    }
    SEAM(pb + 3);
    relaunder(F);
    if (EN(5) && IN(pb + 4)) { router_phase(F, l); if (DUP_PHASE == 11) router_phase(F, l, 1); }
    if (DUP_PHASE == 13 && IN(pb + 4)) { for (int q = 0; q < 8; ++q) xcd_barrier(bar); }
    SEAM(pb + 4);
    relaunder(F);
    if (EN(6) && IN(pb + 5)) {
        moe_table(F, l);
        unsigned* ready = (unsigned*)(F.ws + WS_CTL) + CW_RDY + 16384 * l;
        {
            pg8::SchedG1 S{(const LAS int*)(F.lds + MISC_OFF + 64), (const int*)((const unsigned*)(F.ws + WS_CTL) + CW_CNT + 2048 * l), (const int*)(F.ws + WS_TOK), (const bf16*)(F.ws + WS_X8),
                           (const bf16*)(F.ws + WS_W1 + (size_t)l * NE * 1024 * DM), F.G, (int)blockIdx.x, ready};
            pg8::EpiSwiGLU E{F.ws + WS_HB, (const float*)(F.ws + WS_RSLOT)};
            DUP(7) pg8::gemm_phase<pg8::EpiSwiGLU, pg8::SchedG1, true, true>(F.lds, DM / 2, S, E);
        }
        {
            pg8::SchedG2 S{(const LAS int*)(F.lds + MISC_OFF + 64), (const bf16*)(F.ws + WS_HB), (const bf16*)(F.ws + WS_W2 + (size_t)l * NE * DM * DE), F.G, (int)blockIdx.x, ready, (unsigned*)(F.ws + WS_CTL) + CW_TMO};
            pg8::EpiY E{(bf16*)(F.ws + WS_Y)};
            DUP(8) pg8::gemm_phase<pg8::EpiY, pg8::SchedG2, true, true>(F.lds, DE / 2, S, E);
        }
    }
    SEAM(pb + 6);
    relaunder(F);
    if (EN(8) && IN(pb + 7)) { moe_table(F, l); DUP(l == 0 ? 9 : 99) combine_phase(F, l); }
    SEAM(pb + 7);
}
__global__ void __launch_bounds__(NTHREADS, 2) fwd_kernel(Params args) {
    extern __shared__ __attribute__((aligned(16))) unsigned char lds_raw[];
    Frame F;
    F.lds = (LAS unsigned char*)lds_raw; F.MISC = (volatile LAS unsigned*)(F.lds + MISC_OFF);
    F.tid = threadIdx.x; F.lane = F.tid & 63; F.wave = __builtin_amdgcn_readfirstlane(F.tid >> 6);
    F.G = gridDim.x; { const int bx = blockIdx.x; F.vcu = (F.G % 8 == 0) ? (bx % 8) * (F.G / 8) + bx / 8 : bx; }
    F.in = args.in; F.out = args.out; F.ws = args.ws;
    for (int u = F.tid; u < (LDS_BYTES - MISC_OFF) / 4; u += NTHREADS) ((LAS unsigned*)(F.lds + MISC_OFF))[u] = 0u;
    __syncthreads();
    unsigned* ctl = (unsigned*)(args.ws + WS_CTL);
    const int lo = args.ph_lo, hi = args.ph_hi;
    const bool multi = (hi - lo) > 1;
    XcdBarrier bar; bar.bar = ctl + CW_BAR; bar.x = 0; bar.st = nullptr;
    if (multi) bar = xcd_barrier_post(ctl + CW_BAR, F.MISC);
    if (PROBE_STAMP >= 0 && blockIdx.x == 0 && F.tid == 0) { const unsigned long long _t = wall_clock64(); F.MISC[800] = (unsigned)_t; F.MISC[801] = (unsigned)(_t >> 32); }
    if (EN(0) && IN(0)) { DUP(10) p_prologue(F); }
    SEAM(0);
    layer_phases<0>(F, bar, lo, hi);
    layer_phases<1>(F, bar, lo, hi);
    if (PROBE_STAMP >= 0 && blockIdx.x == 0 && F.tid == 0) {
        asm volatile("s_waitcnt vmcnt(0)" ::: "memory");
        constexpr int SB = PROBE_STAMP >= 100 ? 900 + 2 * (PROBE_STAMP - 100) : (PROBE_STAMP == 6 ? 810 : 800 + 2 * PROBE_STAMP);
        constexpr int SB1 = (PROBE_STAMP == 6) ? SB + 4 : SB + 2;
        const unsigned long long t1 = ((unsigned long long)F.MISC[SB1 + 1] << 32) | F.MISC[SB1], t0 = ((unsigned long long)F.MISC[SB + 1] << 32) | F.MISC[SB];
        F.out[0] += (float)(long long)(t1 - t0) * 0.01f;
    }
}
#undef IN
#undef EN
#undef SEAM
#undef DUP

extern "C" void kernel_launch(void* const* d_in, const int* in_sizes, int n_in, void* d_out, int out_size, void* d_ws, size_t ws_size, hipStream_t stream) {
    static int grid = 0;
    if (grid == 0) {
        if (n_in != 22 || out_size != SEQ * DM || ws_size < WS_END) { fprintf(stderr, "kernel_launch: unexpected shapes (n_in %d out %d ws %zu, need %zu)\n", n_in, out_size, ws_size, (size_t)WS_END); grid = -1; return; }
        int dev = 0, cus = 0, per_cu = 0;
        if (hipGetDevice(&dev) != hipSuccess || hipDeviceGetAttribute(&cus, hipDeviceAttributeMultiprocessorCount, dev) != hipSuccess) { grid = -1; return; }
        if (hipFuncSetAttribute((const void*)fwd_kernel, hipFuncAttributeMaxDynamicSharedMemorySize, LDS_BYTES) != hipSuccess) { fprintf(stderr, "kernel_launch: hipFuncSetAttribute failed\n"); grid = -1; return; }
        if (hipOccupancyMaxActiveBlocksPerMultiprocessor(&per_cu, (const void*)fwd_kernel, NTHREADS, LDS_BYTES) != hipSuccess || per_cu < 1) { fprintf(stderr, "kernel_launch: occupancy query says %d\n", per_cu); }
        (void)hipGetLastError();
        grid = cus;
    }
    if (grid < 0) return;
    if (hipMemsetAsync((char*)d_ws + WS_CTL, 0, CTL_ZERO_BYTES, stream) != hipSuccess) return;
    Params p{};
    for (int i = 0; i < 22; ++i) p.in[i] = (const float*)d_in[i];
    p.out = (float*)d_out; p.ws = (unsigned char*)d_ws;
    constexpr int NL = MK_N_LAUNCHES;
    for (int li = 0; li < NL; ++li) {
        p.ph_lo = (NL == 1) ? 0 : li; p.ph_hi = (NL == 1) ? N_PHASES : li + 1;
        hipLaunchKernelGGL(fwd_kernel, dim3(grid), dim3(NTHREADS), LDS_BYTES, stream, p);
        if (hipPeekAtLastError() != hipSuccess) { fprintf(stderr, "kernel_launch: launch %d failed\n", li); break; }
    }
}
```

```cpp
#include <hip/hip_runtime.h>
#include <cstdio>
#include <cstdint>

#ifndef MK_N_LAUNCHES
#define MK_N_LAUNCHES 1
#endif

#ifndef OUTPROJ_FP8
#define OUTPROJ_FP8 2
#endif
#ifndef ATT_EXP
#define ATT_EXP 0
#endif
#define OP8(l) ((OUTPROJ_FP8 >> (l)) & 1)
#define GAS __attribute__((address_space(1)))
#define LAS __attribute__((address_space(3)))
typedef unsigned short bf16;
typedef short bf16x8 __attribute__((ext_vector_type(8)));
typedef short s16x4 __attribute__((ext_vector_type(4)));
typedef float f32x4 __attribute__((ext_vector_type(4)));
typedef float f32x2 __attribute__((ext_vector_type(2)));
typedef unsigned u32x4 __attribute__((ext_vector_type(4)));
typedef unsigned u32x2 __attribute__((ext_vector_type(2)));

constexpr int SEQ = 16384, DM = 2048, DIN = 5120, NLAYER = 2;
constexpr int HD = 128, NHEAD = 8, CONV_K = 31;
constexpr int NE = 32, DE = 512, TOKCAP = 16384;
constexpr int OFF_U = 0, OFF_V = 512, OFF_A = 1024, OFF_G = 1536, OFF_Q = 2048, OFF_K = 3072, OFF_VV = 4096;
constexpr float EPS = 1e-6f;
constexpr float W1_SCALE = 64.f, W2_SCALE = 32.f, WOUT_SCALE = 64.f;
constexpr int NWAVES = 8, NTHREADS = 512;

constexpr size_t MiB = 1u << 20;
constexpr size_t WS_CTL = 0, CTL_ZERO_BYTES = 1 * MiB;
constexpr size_t WS_WIN = 1 * MiB;
constexpr size_t WS_WOUT = 41 * MiB;
constexpr size_t WS_W1 = 57 * MiB;
constexpr size_t WS_X8 = 185 * MiB;
constexpr size_t WS_W2 = 313 * MiB;
constexpr size_t WS_SGUW = 441 * MiB;
constexpr size_t WS_WRT = 442 * MiB;
constexpr size_t WS_TOK = 443 * MiB;
constexpr size_t WS_TINFO = 445 * MiB;
constexpr size_t WS_HN = 446 * MiB;
constexpr size_t WS_HB = 510 * MiB;
constexpr size_t WS_ATT = WS_HN;
constexpr size_t WS_LSE = WS_HN + 96 * MiB;
constexpr size_t WS_PROJ = 550 * MiB;
constexpr size_t WS_Y = WS_PROJ;
constexpr size_t WS_MIX = 710 * MiB;
constexpr size_t WS_H = 774 * MiB;
constexpr size_t WS_RSLOT = 902 * MiB;
constexpr size_t WS_ALT = 904 * MiB;
constexpr size_t WS_END = 910 * MiB;
constexpr int CW_BAR = 4096;
constexpr int CW_TMO = 0;
constexpr int CW_RDY = 65536;
constexpr int CW_CNT = 16384, CNT_STRIDE = 64;

constexpr int LDS_BYTES = 163840;
constexpr int MISC_OFF = 159744;

__device__ __forceinline__ unsigned cvt_pk_bf16(float lo, float hi) { unsigned r; asm volatile("v_cvt_pk_bf16_f32 %0, %1, %2" : "=v"(r) : "v"(lo), "v"(hi)); return r; }
__device__ __forceinline__ unsigned pk4_fp8(float a, float b, float c, float d) { int p = 0; p = __builtin_amdgcn_cvt_pk_fp8_f32(a, b, p, false); p = __builtin_amdgcn_cvt_pk_fp8_f32(c, d, p, true); return (unsigned)p; }
__device__ __forceinline__ float bf_lo(unsigned u) { return __builtin_bit_cast(float, u << 16); }
__device__ __forceinline__ float bf_hi(unsigned u) { return __builtin_bit_cast(float, u & 0xffff0000u); }
template <int CTRL, int RM> __device__ __forceinline__ float dpp_mov0(float v) { return __builtin_bit_cast(float, __builtin_amdgcn_update_dpp(0, __builtin_bit_cast(int, v), CTRL, RM, 0xf, false)); }
__device__ __forceinline__ float wave_sum(float s) {
    s += dpp_mov0<0xB1, 0xf>(s); s += dpp_mov0<0x4E, 0xf>(s); s += dpp_mov0<0x141, 0xf>(s); s += dpp_mov0<0x140, 0xf>(s);
    s += dpp_mov0<0x142, 0xa>(s); s += dpp_mov0<0x143, 0xc>(s);
    return __builtin_bit_cast(float, __builtin_amdgcn_readlane(__builtin_bit_cast(int, s), 63));
}
__device__ __forceinline__ float row16_sum(float s) {
    s += dpp_mov0<0xB1, 0xf>(s); s += dpp_mov0<0x4E, 0xf>(s); s += dpp_mov0<0x141, 0xf>(s); s += dpp_mov0<0x140, 0xf>(s); return s;
}
__device__ __forceinline__ float sum4(float x) {
    const unsigned xu = __builtin_bit_cast(unsigned, x); const auto r = __builtin_amdgcn_permlane16_swap(xu, xu, false, false); const unsigned r0 = r[0], r1 = r[1];
    const float a = __builtin_bit_cast(float, r0) + __builtin_bit_cast(float, r1);
    const unsigned au = __builtin_bit_cast(unsigned, a); const auto q = __builtin_amdgcn_permlane32_swap(au, au, false, false); const unsigned q0 = q[0], q1 = q[1];
    return __builtin_bit_cast(float, q0) + __builtin_bit_cast(float, q1);
}
__device__ __forceinline__ float max4(float x) {
    const unsigned xu = __builtin_bit_cast(unsigned, x); const auto r = __builtin_amdgcn_permlane16_swap(xu, xu, false, false); const unsigned r0 = r[0], r1 = r[1];
    const float a = fmaxf(__builtin_bit_cast(float, r0), __builtin_bit_cast(float, r1));
    const unsigned au = __builtin_bit_cast(unsigned, a); const auto q = __builtin_amdgcn_permlane32_swap(au, au, false, false); const unsigned q0 = q[0], q1 = q[1];
    return fmaxf(__builtin_bit_cast(float, q0), __builtin_bit_cast(float, q1));
}
__device__ __forceinline__ int lane_now() { int l; asm volatile("v_mbcnt_lo_u32_b32 %0, -1, 0\n\tv_mbcnt_hi_u32_b32 %0, -1, %0" : "=v"(l)); return l; }
#define LDS_WAIT() asm volatile("s_waitcnt lgkmcnt(0)" ::: "memory")
#define VM_WAIT() asm volatile("s_waitcnt vmcnt(0)" ::: "memory")
__device__ __forceinline__ float fast_exp(float x) { return __builtin_amdgcn_exp2f(x * 1.4426950408889634f); }
__device__ __forceinline__ float sigmoidf_(float x) { return __builtin_amdgcn_rcpf(1.0f + fast_exp(-x)); }
__device__ __forceinline__ float gelu_tanh(float x) { const float z = 1.5957691216057308f * (x + 0.044715f * x * x * x); return x * sigmoidf_(z); }

#define XB_TMO      128
#define XB_XCNT(j)  (256  + 64 * (j))
#define XB_XSUB(j)  (1280 + 64 * (j))
#define XB_XGEN(j)  (2304 + 64 * (j))
#define XB_TOP      3328
#define XB_TOPGEN   3392
#define XCD_BAR_WORDS 3456
#define XB_SPIN_CAP (1u << 22)
__device__ __forceinline__ unsigned xb_ld(unsigned* p)              { return __hip_atomic_load(p, __ATOMIC_RELAXED, __HIP_MEMORY_SCOPE_AGENT); }
__device__ __forceinline__ unsigned xb_add(unsigned* p, unsigned v) { return __hip_atomic_fetch_add(p, v, __ATOMIC_RELAXED, __HIP_MEMORY_SCOPE_AGENT); }
__device__ __forceinline__ unsigned xb_xcc_id() { return (unsigned)__builtin_amdgcn_s_getreg((3 << 11) | 20) & 0xFu; }
#define XB_SPIN(cond, bar) do { unsigned _sp = 0; while (cond) { __builtin_amdgcn_s_sleep(1); \
    if ((++_sp & 255u) == 0u) { if (xb_ld(&(bar)[XB_TMO])) break; if (_sp > XB_SPIN_CAP) { atomicAdd(&(bar)[XB_TMO], 1u); break; } } } } while (0)
struct XcdBarrier { unsigned* bar; unsigned x; volatile LAS unsigned* st; unsigned lead; };
__device__ __forceinline__ XcdBarrier xcd_barrier_post(unsigned* bar, volatile LAS unsigned* st, unsigned lead) {
    XcdBarrier b; b.bar = bar; b.x = xb_xcc_id(); b.st = st; b.lead = lead;
    if (lead && lane_now() == 0) (void)xb_add(&bar[XB_XCNT(b.x)], 1u);
    return b;
}
__device__ __forceinline__ void xcd_barrier_complete(unsigned* bar, unsigned x, unsigned& nloc, unsigned& nx) {
    const unsigned G = gridDim.x * gridDim.y * gridDim.z;
    unsigned sum, cnt, mine, sp = 0u;
    for (;;) {
        sum = 0u; cnt = 0u; mine = 0u;
#pragma unroll
        for (unsigned j = 0; j < 16; ++j) { const unsigned c = xb_ld(&bar[XB_XCNT(j)]); sum += c; cnt += (c > 0u) ? 1u : 0u; mine = (j == x) ? c : mine; }
        if (sum == G) break;
        __builtin_amdgcn_s_sleep(1);
        if ((++sp & 255u) == 0u) { if (xb_ld(&bar[XB_TMO])) break; if (sp > XB_SPIN_CAP) { atomicAdd(&bar[XB_TMO], 1u); break; } }
    }
    nloc = mine > 0u ? mine : 1u; nx = cnt > 0u ? cnt : 1u;
}
__device__ __forceinline__ void xcd_barrier(const XcdBarrier& b) {
    asm volatile("s_waitcnt vmcnt(0)" ::: "memory");
    __syncthreads();
    if (b.lead && lane_now() == 0) {
        unsigned* bar = b.bar;
        __builtin_amdgcn_s_waitcnt(0);
        unsigned nloc = b.st[0], nx = b.st[1];
        if (nloc == 0u) { xcd_barrier_complete(bar, b.x, nloc, nx); b.st[0] = nloc; b.st[1] = nx; }
        const unsigned old = xb_add(&bar[XB_XSUB(b.x)], 1u);
        const unsigned gen = old / nloc;
        if (old + 1u == (gen + 1u) * nloc) {
            __builtin_amdgcn_fence(__ATOMIC_RELEASE, "agent");
            asm volatile("s_waitcnt vmcnt(0)" ::: "memory");
            const unsigned og = xb_add(&bar[XB_TOP], 1u);
            const unsigned tg = og / nx;
            if (og + 1u == (tg + 1u) * nx) xb_add(&bar[XB_TOPGEN], 1u);
            else XB_SPIN(xb_ld(&bar[XB_TOPGEN]) == tg, bar);
            __builtin_amdgcn_fence(__ATOMIC_ACQUIRE, "agent");
            xb_add(&bar[XB_XGEN(b.x)], 1u);
            asm volatile("s_waitcnt vmcnt(0)" ::: "memory");
        } else {
            XB_SPIN(xb_ld(&bar[XB_XGEN(b.x)]) == gen, bar);
            __builtin_amdgcn_fence(__ATOMIC_ACQUIRE, "agent");
            asm volatile("s_waitcnt vmcnt(0)" ::: "memory");
        }
    }
    __syncthreads();
}

namespace pg8 {
constexpr int BM = 256, BK = 64, HALF = 128, HTB = HALF * BK * 2, STAGE_BYTES = 8 * HTB, NXCD = 8, WGM = 8;
__device__ __forceinline__ int lds_byte(int r, int c) { const int st = (r >> 4) * 2 + (c >> 5), rr = r & 15, cc = c & 31, ob = rr * 64 + cc * 2; return st * 1024 + (ob ^ (((ob >> 9) & 1) << 5)); }
__device__ __forceinline__ void stage_rc(int b, int& R, int& C) { const int st = b / 1024, sb = b % 1024, swz = sb ^ (((sb >> 9) & 1) << 5); R = (st >> 1) * 16 + swz / 64; C = (st & 1) * 32 + (swz % 64) / 2; }
__device__ __forceinline__ int perm32(int rho) { const int n = rho >> 4, i = rho & 15; return 8 * (i >> 2) + 4 * n + (i & 3); }

struct Unit { int pm, pn, e, rb; };

struct StaticSched {
    static constexpr bool GATHER = false;
    const bf16* A; const bf16* Bt; int K; int nM, nN, nwg, G, c;
    __device__ __forceinline__ void init(const bf16* A_, const bf16* Bt_, int M, int N, int K_, int G_, int c_) { A = A_; Bt = Bt_; K = K_; nM = M / BM; nN = N / BM; nwg = nM * nN; G = G_; c = c_; }
    __device__ __forceinline__ bool next(int i, Unit& u) const {
        const long L = (long)i * G + c; if (L >= nwg) return false;
        int wgid = (int)L; { const int q = nwg / NXCD, r = nwg % NXCD, xcd = wgid % NXCD, off = wgid / NXCD; wgid = (xcd < r ? xcd * (q + 1) : r * (q + 1) + (xcd - r) * q) + off; }
        const int nig = WGM * nN, gid = wgid / nig, fm = gid * WGM, gsz = (nM - fm) < WGM ? (nM - fm) : WGM;
        u.pm = fm + ((wgid % nig) % gsz); u.pn = (wgid % nig) / gsz; u.e = 0; u.rb = 0; return true;
    }
    __device__ __forceinline__ void a_ready(const Unit&) const {}
    __device__ __forceinline__ void done(const Unit&) const {}
    __device__ __forceinline__ const char* a_base(const Unit& u) const { return (const char*)A + (size_t)u.pm * BM * K * 2; }
    __device__ __forceinline__ const char* b_base(const Unit& u) const { return (const char*)Bt + (size_t)u.pn * BM * K * 2; }
    __device__ __forceinline__ void a_voff(const Unit&, const int (&R)[2], const int (&C)[2], unsigned (&v)[2][2]) const {
#pragma unroll
        for (int h = 0; h < 2; ++h)
#pragma unroll
            for (int i = 0; i < 2; ++i) v[h][i] = (unsigned)((h * HALF + R[i]) * K + C[i]) * 2u;
    }
};

typedef int v8i __attribute__((ext_vector_type(8)));
typedef int v4i __attribute__((ext_vector_type(4)));
template <class Epi, class Sched, bool ALIGN_EPI = true, bool FP8 = false>
__device__ __forceinline__ void gemm_phase(LAS unsigned char* lds, const int K, const Sched& S, const Epi& E, const int wave) {
    const int lane = lane_now(), wid = wave, tid = wid * 64 + lane,
              wr = wid >> 2, wc = wid & 3, fr = lane & 15, fq = lane >> 4;
    const int nt = K / BK;
    int Rr[2], Cc[2]; unsigned voffB[2];
#pragma unroll
    for (int i = 0; i < 2; ++i) { stage_rc(tid * 16 + i * 8192, Rr[i], Cc[i]); const int Rb = Epi::PERM ? ((Rr[i] & ~31) + perm32(Rr[i] & 31)) : Rr[i];
        voffB[i] = (unsigned)(Rb * K + Cc[i]) * 2u; }
    const size_t kstep = (size_t)(BK * 2);
    const size_t hstep = (size_t)HALF * K * 2;
    const unsigned ldsw = (unsigned)wid * 1024u;
    const unsigned ldsbase = (unsigned)__builtin_amdgcn_readfirstlane((int)(unsigned)(size_t)lds);
    const int aoff = lds_byte(wr * 64 + fr, fq * 8), boff = lds_byte(wc * 32 + fr, fq * 8);
#define PG8_SA(b, h) (((b) * 2 + (h)) * HTB)
#define PG8_SB(b, h) ((4 + (b) * 2 + (h)) * HTB)
#define PG8_STAGE(bufoff, gbase, voff) do { _Pragma("unroll") for (int _i = 0; _i < 2; ++_i) { unsigned _keep; \
        asm volatile("s_mov_b32 %0, m0\n\ts_mov_b32 m0, %3\n\ts_nop 0\n\tglobal_load_lds_dwordx4 %1, %2\n\ts_mov_b32 m0, %0" : "=&s"(_keep) : "v"((voff)[_i]), "s"((const char*)(gbase)), "s"(ldsbase + (unsigned)(bufoff) + ldsw + (unsigned)(_i * 8192)) : "memory"); } } while (0)
#define PG8_LDA(dst, b, h) do { _Pragma("unroll") for (int m = 0; m < 4; ++m) _Pragma("unroll") for (int k = 0; k < 2; ++k) dst[m][k] = *(const LAS bf16x8*)(lds + PG8_SA(b, h) + aoff + m * 2048 + k * 1024); } while (0)
#define PG8_LDB(dst, b, h) do { _Pragma("unroll") for (int n = 0; n < 2; ++n) _Pragma("unroll") for (int k = 0; k < 2; ++k) dst[n][k] = *(const LAS bf16x8*)(lds + PG8_SB(b, h) + boff + n * 2048 + k * 1024); } while (0)
#define PG8_LDA8(dst, b, h) do { _Pragma("unroll") for (int m = 0; m < 4; ++m) { const v4i lo_ = *(const LAS v4i*)(lds + PG8_SA(b, h) + aoff + m * 2048), hi_ = *(const LAS v4i*)(lds + PG8_SA(b, h) + aoff + m * 2048 + 1024); dst[m] = __builtin_shufflevector(lo_, hi_, 0, 1, 2, 3, 4, 5, 6, 7); } } while (0)
#define PG8_LDB8(dst, b, h) do { _Pragma("unroll") for (int n = 0; n < 2; ++n) { const v4i lo_ = *(const LAS v4i*)(lds + PG8_SB(b, h) + boff + n * 2048), hi_ = *(const LAS v4i*)(lds + PG8_SB(b, h) + boff + n * 2048 + 1024); dst[n] = __builtin_shufflevector(lo_, hi_, 0, 1, 2, 3, 4, 5, 6, 7); } } while (0)
#define PG8_MMA(ai, bj, At, Bt) do { __builtin_amdgcn_s_setprio(1); _Pragma("unroll") for (int m = 0; m < 4; ++m) _Pragma("unroll") for (int n = 0; n < 2; ++n) _Pragma("unroll") for (int k = 0; k < 2; ++k) \
        acc[ai][bj][m][n] = __builtin_amdgcn_mfma_f32_16x16x32_bf16(Bt[n][k], At[m][k], acc[ai][bj][m][n], 0, 0, 0); __builtin_amdgcn_s_setprio(0); } while (0)
#define PG8_MMA8(ai, bj, At, Bt) do { __builtin_amdgcn_s_setprio(1); _Pragma("unroll") for (int m = 0; m < 4; ++m) _Pragma("unroll") for (int n = 0; n < 2; ++n) \
        acc[ai][bj][m][n] = __builtin_amdgcn_mfma_scale_f32_16x16x128_f8f6f4(Bt[n], At[m], acc[ai][bj][m][n], 0, 0, 0, 0, 0, 0); __builtin_amdgcn_s_setprio(0); } while (0)
#define LDA_(b, h) do { if constexpr (FP8) PG8_LDA8(At8, b, h); else PG8_LDA(At, b, h); } while (0)
#define LDB0_(b, h) do { if constexpr (FP8) PG8_LDB8(B08, b, h); else PG8_LDB(B0, b, h); } while (0)
#define LDB1_(b, h) do { if constexpr (FP8) PG8_LDB8(B18, b, h); else PG8_LDB(B1, b, h); } while (0)
#define MMA0_(ai, bj) do { if constexpr (FP8) PG8_MMA8(ai, bj, At8, B08); else PG8_MMA(ai, bj, At, B0); } while (0)
#define MMA1_(ai, bj) do { if constexpr (FP8) PG8_MMA8(ai, bj, At8, B18); else PG8_MMA(ai, bj, At, B1); } while (0)
#define PG8_WAIT_V(n) asm volatile("s_waitcnt vmcnt(" #n ")" ::: "memory")
#define PG8_WAIT_L(n) asm volatile("s_waitcnt lgkmcnt(" #n ")" ::: "memory")
#define PG8_BAR __builtin_amdgcn_s_barrier()
#define PG8_SCHED __builtin_amdgcn_sched_barrier(0)
    Unit cur, nxt; int ui = 0;
    if (!S.next(0, cur)) return;
    f32x4 acc[2][2][4][2];
#pragma unroll
    for (int a = 0; a < 2; ++a)
#pragma unroll
        for (int b = 0; b < 2; ++b)
#pragma unroll
            for (int m = 0; m < 4; ++m)
#pragma unroll
                for (int n = 0; n < 2; ++n) acc[a][b][m][n] = (f32x4){0.f, 0.f, 0.f, 0.f};
    bf16x8 At[4][2], B0[2][2], B1[2][2]; v8i At8[4], B08[2], B18[2];
    const char* cA = S.a_base(cur); const char* cB = S.b_base(cur);
    S.a_ready(cur);
    constexpr bool GATHER = Sched::GATHER;
    unsigned vA[1][2];
    LAS unsigned* goff = (LAS unsigned*)(lds + STAGE_BYTES) + tid;
    int gslot = 0;
    constexpr bool LOFF = GATHER || FP8;
    if constexpr (!GATHER && FP8) { goff[8 * 512] = voffB[0]; goff[9 * 512] = voffB[1]; goff[10 * 512] = (unsigned)(Rr[0] * K + Cc[0]) * 2u; goff[11 * 512] = (unsigned)(Rr[1] * K + Cc[1]) * 2u; }
    if constexpr (GATHER) { unsigned t4[2][2]; S.a_voff(cur, Rr, Cc, t4); goff[0 * 512] = t4[0][0]; goff[1 * 512] = t4[0][1]; goff[2 * 512] = t4[1][0]; goff[3 * 512] = t4[1][1]; goff[8 * 512] = voffB[0]; goff[9 * 512] = voffB[1]; }
    else {
#pragma unroll
        for (int i = 0; i < 2; ++i) vA[0][i] = (unsigned)(Rr[i] * K + Cc[i]) * 2u; }
    const size_t ahstep = GATHER ? 0 : hstep;
#define PG8_STAGE_B(bufoff, kptr) do { if constexpr (LOFF) { unsigned _o[2]; _o[0] = goff[8 * 512]; _o[1] = goff[9 * 512]; PG8_STAGE(bufoff, kptr, _o); } else PG8_STAGE(bufoff, kptr, voffB); } while (0)
#define PG8_STAGE_A(bufoff, kptr, h, nx) do { if constexpr (GATHER) { unsigned _o[2]; const int _s = (gslot ^ (nx)) * 2048 + (h) * 1024; _o[0] = goff[_s]; _o[1] = goff[_s + 512]; PG8_STAGE(bufoff, kptr, _o); } \
        else if constexpr (FP8) { unsigned _o[2]; _o[0] = goff[10 * 512]; _o[1] = goff[11 * 512]; PG8_STAGE(bufoff, (kptr) + (h) * ahstep, _o); } \
        else PG8_STAGE(bufoff, (kptr) + (h) * ahstep, vA[0]); } while (0)
    PG8_STAGE(PG8_SB(0, 0), cB, voffB); PG8_STAGE(PG8_SB(0, 1), cB + hstep, voffB); PG8_STAGE_A(PG8_SA(0, 0), cA, 0, 0); PG8_STAGE_A(PG8_SA(0, 1), cA, 1, 0);
    if (wr == 1) PG8_BAR;
    PG8_WAIT_V(2); PG8_BAR;
    PG8_STAGE(PG8_SB(1, 0), cB + kstep, voffB); PG8_STAGE_A(PG8_SA(1, 0), cA + kstep, 0, 0); PG8_STAGE(PG8_SB(1, 1), cB + hstep + kstep, voffB);
    PG8_WAIT_V(6); PG8_BAR;
    for (;;) {
        const bool has_next = S.next(ui + 1, nxt);
        const char* nA = has_next ? S.a_base(nxt) : cA; const char* nB = has_next ? S.b_base(nxt) : cB;
        if constexpr (GATHER) { if (has_next) { unsigned t4[2][2]; int tl_ = tid; asm volatile("" : "+v"(tl_)); int R2[2], C2[2]; stage_rc(tl_ * 16, R2[0], C2[0]); stage_rc(tl_ * 16 + 8192, R2[1], C2[1]); S.a_voff(nxt, R2, C2, t4); const int o = (gslot ^ 1) * 2048; goff[o] = t4[0][0]; goff[o + 512] = t4[0][1]; goff[o + 1024] = t4[1][0]; goff[o + 1536] = t4[1][1]; } }
#pragma unroll 1
        for (int t = 0; t < nt; t += 2) {
            const bool last = (t == nt - 2);
            const char* a1 = cA + (size_t)(t + 1) * kstep;
            const char* a2 = last ? nA : cA + (size_t)(t + 2) * kstep; const char* b2 = last ? nB : cB + (size_t)(t + 2) * kstep;
            const char* a3 = a2 + kstep; const char* b3 = b2 + kstep;
            if (last && has_next) S.a_ready(nxt);
            const int nx = (last && has_next) ? 1 : 0;
            LDB0_(0, 0); LDB1_(0, 1); PG8_SCHED; LDA_(0, 0); PG8_STAGE_A(PG8_SA(1, 1), a1, 1, 0);
            PG8_WAIT_V(8); PG8_WAIT_L(0); PG8_BAR; MMA0_(0, 0); MMA1_(0, 1); PG8_BAR; PG8_SCHED;
            LDA_(0, 1); PG8_STAGE_B(PG8_SB(0, 0), b2); PG8_STAGE_B(PG8_SB(0, 1), b2 + hstep); PG8_STAGE_A(PG8_SA(0, 0), a2, 0, nx);
            PG8_WAIT_V(8); PG8_WAIT_L(0); PG8_BAR; MMA0_(1, 0); MMA1_(1, 1); PG8_BAR; PG8_SCHED;
            LDB0_(1, 0); LDB1_(1, 1); PG8_SCHED; LDA_(1, 0); PG8_STAGE_A(PG8_SA(0, 1), a2, 1, nx);
            PG8_WAIT_V(8); PG8_WAIT_L(0); PG8_BAR; MMA0_(0, 0); MMA1_(0, 1); PG8_BAR; PG8_SCHED;
            LDA_(1, 1); PG8_STAGE_B(PG8_SB(1, 0), b3); PG8_STAGE_B(PG8_SB(1, 1), b3 + hstep); PG8_STAGE_A(PG8_SA(1, 0), a3, 0, nx);
            PG8_WAIT_V(8); PG8_WAIT_L(0); PG8_BAR; MMA0_(1, 0); MMA1_(1, 1); PG8_BAR; PG8_SCHED;
        }
        if constexpr (ALIGN_EPI) { if (wr == 0) PG8_BAR; }
        { int fr2 = fr, fq2 = fq; asm volatile("" : "+v"(fr2), "+v"(fq2));
          E(acc, cur, wr, wc, fr2, fq2); } S.done(cur);
        if (!has_next) break;
#pragma unroll
        for (int a = 0; a < 2; ++a)
#pragma unroll
            for (int b = 0; b < 2; ++b)
#pragma unroll
                for (int m = 0; m < 4; ++m)
#pragma unroll
                    for (int n = 0; n < 2; ++n) acc[a][b][m][n] = (f32x4){0.f, 0.f, 0.f, 0.f};
        cur = nxt; cA = nA; cB = nB; ++ui;
        if constexpr (GATHER) gslot ^= 1;
        if constexpr (ALIGN_EPI) { if (wr == 1) PG8_BAR; }
    }
    PG8_WAIT_V(0);
    if constexpr (!ALIGN_EPI) { if (wr == 0) PG8_BAR; }
    PG8_BAR;
#undef PG8_SA
#undef PG8_SB
#undef PG8_STAGE
#undef PG8_STAGE_A
#undef PG8_STAGE_B
#undef PG8_LDA
#undef PG8_LDB
#undef PG8_MMA
#undef PG8_MMA8
#undef PG8_LDA8
#undef PG8_LDB8
#undef LDA_
#undef LDB0_
#undef LDB1_
#undef MMA0_
#undef MMA1_
#undef PG8_WAIT_V
#undef PG8_WAIT_L
#undef PG8_BAR
#undef PG8_SCHED
}

struct EpiProj {
    static constexpr bool PERM = true;
    bf16* O;
    __device__ __forceinline__ void operator()(const f32x4 (&acc)[2][2][4][2], const Unit& u, int wr, int wc, int fr, int fq) const {
        const int row0 = u.pm * BM + wr * 64 + fr, col0 = u.pn * BM + wc * 32 + 8 * fq;
        const bool act = u.pn < 4;
#pragma unroll
        for (int ai = 0; ai < 2; ++ai)
#pragma unroll
            for (int m = 0; m < 4; ++m) { bf16* rowp = O + (size_t)(row0 + ai * HALF + m * 16) * DIN + col0;
#pragma unroll
                for (int bj = 0; bj < 2; ++bj) { f32x4 v0 = acc[ai][bj][m][0], v1 = acc[ai][bj][m][1];
                    if (act) {
#pragma unroll
                        for (int j = 0; j < 4; ++j) { v0[j] = gelu_tanh(v0[j]); v1[j] = gelu_tanh(v1[j]); } }
                    u32x4 w; w.x = cvt_pk_bf16(v0[0], v0[1]); w.y = cvt_pk_bf16(v0[2], v0[3]); w.z = cvt_pk_bf16(v1[0], v1[1]); w.w = cvt_pk_bf16(v1[2], v1[3]);
                    *(u32x4*)(rowp + bj * HALF) = w; } }
    }
};
template <bool RES_BF16> struct EpiResid {
    static constexpr bool PERM = true; static constexpr float ASC = OP8(RES_BF16 ? 1 : 0) ? 1.f / WOUT_SCALE : 1.f;
    const void* res; bf16* out;
    __device__ __forceinline__ void operator()(const f32x4 (&acc)[2][2][4][2], const Unit& u, int wr, int wc, int fr, int fq) const {
        const int row0 = u.pm * BM + wr * 64 + fr, col0 = u.pn * BM + wc * 32 + 8 * fq;
#pragma unroll
        for (int ai = 0; ai < 2; ++ai) {
            if constexpr (RES_BF16) {
                u32x4 r[4][2];
#pragma unroll
                for (int m = 0; m < 4; ++m)
#pragma unroll
                    for (int bj = 0; bj < 2; ++bj) r[m][bj] = *(const u32x4*)((const bf16*)res + (size_t)(row0 + ai * HALF + m * 16) * DM + col0 + bj * HALF);
                asm volatile("s_waitcnt vmcnt(0)" ::: "memory");
#pragma unroll
                for (int m = 0; m < 4; ++m)
#pragma unroll
                    for (int bj = 0; bj < 2; ++bj) { f32x4 v0 = acc[ai][bj][m][0] * ASC, v1 = acc[ai][bj][m][1] * ASC; const u32x4 q = r[m][bj];
                        v0[0] += bf_lo(q.x); v0[1] += bf_hi(q.x); v0[2] += bf_lo(q.y); v0[3] += bf_hi(q.y); v1[0] += bf_lo(q.z); v1[1] += bf_hi(q.z); v1[2] += bf_lo(q.w); v1[3] += bf_hi(q.w);
                        u32x4 w; w.x = cvt_pk_bf16(v0[0], v0[1]); w.y = cvt_pk_bf16(v0[2], v0[3]); w.z = cvt_pk_bf16(v1[0], v1[1]); w.w = cvt_pk_bf16(v1[2], v1[3]);
                        *(u32x4*)(out + (size_t)(row0 + ai * HALF + m * 16) * DM + col0 + bj * HALF) = w; }
            } else {
#pragma unroll
                for (int mh = 0; mh < 2; ++mh) {
                    f32x4 r[2][2][2];
#pragma unroll
                    for (int m = 0; m < 2; ++m)
#pragma unroll
                        for (int bj = 0; bj < 2; ++bj) { const float* rp = (const float*)res + (size_t)(row0 + ai * HALF + (2 * mh + m) * 16) * DM + col0 + bj * HALF; r[m][bj][0] = *(const f32x4*)rp; r[m][bj][1] = *(const f32x4*)(rp + 4); }
                    asm volatile("s_waitcnt vmcnt(0)" ::: "memory");
#pragma unroll
                    for (int m = 0; m < 2; ++m)
#pragma unroll
                        for (int bj = 0; bj < 2; ++bj) { const f32x4 v0 = acc[ai][bj][2 * mh + m][0] * ASC + r[m][bj][0], v1 = acc[ai][bj][2 * mh + m][1] * ASC + r[m][bj][1];
                            u32x4 w; w.x = cvt_pk_bf16(v0[0], v0[1]); w.y = cvt_pk_bf16(v0[2], v0[3]); w.z = cvt_pk_bf16(v1[0], v1[1]); w.w = cvt_pk_bf16(v1[2], v1[3]);
                            *(u32x4*)(out + (size_t)(row0 + ai * HALF + (2 * mh + m) * 16) * DM + col0 + bj * HALF) = w; }
                }
            }
        }
    }
};
struct EpiSwiGLU {
    static constexpr bool PERM = true;
    unsigned char* HB; const float* rslot;
    __device__ __forceinline__ void operator()(const f32x4 (&acc)[2][2][4][2], const Unit& u, int wr, int wc, int fr, int fq) const {
        const int row0 = u.pm * BM + wr * 64 + fr, col0 = u.pn * HALF + wc * 32 + 8 * fq;
        const __amdgpu_buffer_rsrc_t rsrc = __builtin_amdgcn_make_buffer_rsrc((void*)HB, 0, 40960 * DE, 0x00020000);
        const float* rsl = rslot + (size_t)u.e * TOKCAP + u.rb * BM + wr * 64 + fr;
#pragma unroll
        for (int ai = 0; ai < 2; ++ai) {
            float rsv[4];
#pragma unroll
            for (int m = 0; m < 4; ++m) rsv[m] = rsl[ai * HALF + m * 16];
            asm volatile("s_waitcnt vmcnt(0)" ::: "memory");
#pragma unroll
            for (int m = 0; m < 4; ++m) { const unsigned boff = (unsigned)((row0 + ai * HALF + m * 16) * DE + col0);
                const float rs = rsv[m] * (1.f / W1_SCALE);
                float h[8];
#pragma unroll
                for (int n = 0; n < 2; ++n)
#pragma unroll
                    for (int j = 0; j < 4; ++j) { const float g = acc[ai][0][m][n][j] * rs, up = acc[ai][1][m][n][j] * rs; h[n * 4 + j] = g * sigmoidf_(g) * up; }
                u32x2 w; w.x = pk4_fp8(h[0], h[1], h[2], h[3]); w.y = pk4_fp8(h[4], h[5], h[6], h[7]);
                __builtin_amdgcn_raw_buffer_store_b64(w, rsrc, boff, 0, 16); } }
    }
};
struct EpiY {
    static constexpr bool PERM = true;
    bf16* Y;
    __device__ __forceinline__ void operator()(const f32x4 (&acc)[2][2][4][2], const Unit& u, int wr, int wc, int fr, int fq) const {
        const int row0 = u.pm * BM + wr * 64 + fr, col0 = u.pn * BM + wc * 32 + 8 * fq;
#pragma unroll
        for (int ai = 0; ai < 2; ++ai)
#pragma unroll
            for (int m = 0; m < 4; ++m) { bf16* rowp = Y + (size_t)(row0 + ai * HALF + m * 16) * DM + col0;
#pragma unroll
                for (int bj = 0; bj < 2; ++bj) { const f32x4 v0 = acc[ai][bj][m][0] * (1.f / W2_SCALE), v1 = acc[ai][bj][m][1] * (1.f / W2_SCALE);
                    u32x4 w; w.x = cvt_pk_bf16(v0[0], v0[1]); w.y = cvt_pk_bf16(v0[2], v0[3]); w.z = cvt_pk_bf16(v1[0], v1[1]); w.w = cvt_pk_bf16(v1[2], v1[3]);
                    *(u32x4*)(rowp + bj * HALF) = w; } }
    }
};

struct SchedG1 {
    static constexpr bool GATHER = true;
    const LAS int* tstart; const int* cnt; const int* tok; const bf16* X; const bf16* W1; int G, c; unsigned* ready;
    __device__ __forceinline__ void a_ready(const Unit&) const {}
    __device__ __forceinline__ void done(const Unit& u) const {
        asm volatile("s_waitcnt vmcnt(0)" ::: "memory");
        if (lane_now() == 0) __hip_atomic_fetch_add(ready + 64 * u.pm, 1u, __ATOMIC_RELAXED, __HIP_MEMORY_SCOPE_AGENT);
    }
    __device__ __forceinline__ bool next(int i, Unit& u) const {
        const int L = i * G + c, NT = __builtin_amdgcn_readfirstlane(tstart[NE]); if (L >= NT * 4) return false;
        const int T = L >> 2; const int e = tstart[560 + T];
        u.pm = __builtin_amdgcn_readfirstlane(T); u.pn = L & 3; u.e = __builtin_amdgcn_readfirstlane(e); u.rb = __builtin_amdgcn_readfirstlane(T - tstart[e]); return true;
    }
    static constexpr int KU = DM / 2;
    __device__ __forceinline__ const char* a_base(const Unit&) const { return (const char*)X; }
    __device__ __forceinline__ const char* b_base(const Unit& u) const { return (const char*)W1 + ((size_t)u.e * 1024 + (size_t)u.pn * BM) * DM; }
    __device__ __forceinline__ void a_voff(const Unit& u, const int (&R)[2], const int (&C)[2], unsigned (&v)[2][2]) const {
        const int n = cnt[u.e * 64]; const int* tl = tok + (size_t)u.e * TOKCAP;
#pragma unroll
        for (int h = 0; h < 2; ++h)
#pragma unroll
            for (int i = 0; i < 2; ++i) { int row = u.rb * BM + h * HALF + R[i]; row = row < n ? row : 0; const int t = tl[row]; v[h][i] = (unsigned)(t * KU + C[i]) * 2u; }
    }
};
struct SchedG2 {
    static constexpr bool GATHER = false;
    const LAS int* tstart; const bf16* HB; const bf16* W2; int G, c; unsigned* ready; unsigned* tmo; int wave;
    __device__ __forceinline__ bool next(int i, Unit& u) const {
        constexpr int K0 = 3;
        const int NT = __builtin_amdgcn_readfirstlane(tstart[NE]), n1 = 4 * NT, n1max = (n1 + G - 1) / G, R = n1 - G * (n1max - 1), nB = G - R;
        int L;
        if (c >= R) L = (i < K0) ? i * nB + (c - R) : K0 * nB + (i - K0) * G + c;
        else L = K0 * nB + i * G + c;
        if (L >= NT * 8) return false;
        const int T = L >> 3; const int e = tstart[560 + T];
        u.pm = __builtin_amdgcn_readfirstlane(T); u.pn = __builtin_amdgcn_readfirstlane(L & 7); u.e = __builtin_amdgcn_readfirstlane(e); u.rb = __builtin_amdgcn_readfirstlane(T - tstart[e]); return true;
    }
    __device__ __forceinline__ void done(const Unit&) const {}
    __device__ __forceinline__ void a_ready(const Unit& u) const {
        if (wave == 0) {
            unsigned polls = 0;
            while ((unsigned)__builtin_amdgcn_readfirstlane(__hip_atomic_load(ready + 64 * u.pm, __ATOMIC_RELAXED, __HIP_MEMORY_SCOPE_AGENT)) < 32u) {
                if (++polls > (1u << 22)) { if (lane_now() == 0) __hip_atomic_store(tmo, 0x600u | (unsigned)(u.pm & 0xff), __ATOMIC_RELAXED, __HIP_MEMORY_SCOPE_AGENT); break; }
                __builtin_amdgcn_s_sleep(2); }
            __builtin_amdgcn_fence(__ATOMIC_ACQUIRE, "agent");
            asm volatile("s_waitcnt vmcnt(0)" ::: "memory");
        }
        asm volatile("" ::: "memory"); __builtin_amdgcn_s_barrier(); asm volatile("" ::: "memory");
    }
    __device__ __forceinline__ const char* a_base(const Unit& u) const { return (const char*)HB + (size_t)u.pm * BM * DE; }
    __device__ __forceinline__ const char* b_base(const Unit& u) const { return (const char*)W2 + ((size_t)u.e * DM + (size_t)u.pn * BM) * DE; }
    __device__ __forceinline__ void a_voff(const Unit&, const int (&R)[2], const int (&C)[2], unsigned (&v)[2][2]) const {
#pragma unroll
        for (int h = 0; h < 2; ++h)
#pragma unroll
            for (int i = 0; i < 2; ++i) v[h][i] = (unsigned)((h * HALF + R[i]) * DE + C[i]) * 2u;
    }
};
}

struct Params { const float* in[22]; float* out; unsigned char* ws; int ph_lo, ph_hi; };
enum { IN_X = 0, IN_NORM1, IN_WIN, IN_SGUN, IN_SGUW, IN_SGUB, IN_CONVW, IN_CONVB, IN_LNG, IN_LNB, IN_QN, IN_KN, IN_OUTN, IN_WOUT, IN_NORM2, IN_WRG, IN_BRG, IN_WRE, IN_BRE, IN_WG, IN_WU, IN_WD };

struct Frame {
    LAS unsigned char* lds; volatile LAS unsigned* MISC;
    int tid, lane, wave, vcu, G;
    const float* const* in; float* out; unsigned char* ws;
};

__device__ __forceinline__ void tile_desc(const float* const* in, unsigned char* ws, int it, const float*& src, int& ldw, unsigned char*& dst, int& pitch, const float*& ksc, float& wsc, int& fp8) {
    constexpr int T_IN = 32 * 80, T_OUT = 32 * 32, T_E = 32 * 8, T_D = 8 * 32;
    constexpr int T_LAYER = T_IN + T_OUT + NE * (2 * T_E + T_D);
    const int l = it / T_LAYER; int r = it % T_LAYER; ksc = nullptr; wsc = 1.f; fp8 = 0;
    if (r < T_IN) { const int kb = r / 80, nb = r % 80; ldw = DIN; pitch = DM * 2; src = in[IN_WIN] + (size_t)l * DM * DIN + (size_t)(64 * kb) * DIN + 64 * nb; dst = ws + WS_WIN + (((size_t)l * DIN + 64 * nb) * DM + 64 * kb) * 2; return; } r -= T_IN;
    if (r < T_OUT) { const int kb = r / 32, nb = r % 32; ldw = DM; src = in[IN_WOUT] + (size_t)l * DM * DM + (size_t)(64 * kb) * DM + 64 * nb;
        if (OP8(l)) { pitch = DM; fp8 = 1; wsc = WOUT_SCALE; dst = ws + WS_WOUT + (size_t)l * DM * DM * 2 + ((size_t)64 * nb) * DM + 64 * kb; } else { pitch = DM * 2; dst = ws + WS_WOUT + (((size_t)l * DM + 64 * nb) * DM + 64 * kb) * 2; }
        return; } r -= T_OUT;
    const int e = r / (2 * T_E + T_D); r %= (2 * T_E + T_D);
    const size_t le = (size_t)l * NE + e; fp8 = 1;
    if (r < 2 * T_E) { const int up = r >= T_E; r -= up * T_E; const int kb = r / 8, nb = r % 8, n0 = 64 * nb; ldw = DE; pitch = DM; wsc = W1_SCALE;
        src = (up ? in[IN_WU] : in[IN_WG]) + le * DM * DE + (size_t)(64 * kb) * DE + n0; dst = ws + WS_W1 + (le * 1024 + (size_t)((n0 / 128) * 256 + up * 128 + (n0 % 128))) * DM + 64 * kb; ksc = in[IN_NORM2] + (size_t)l * DM + 64 * kb; return; }
    r -= 2 * T_E;
    { const int kb = r / 32, nb = r % 32; ldw = DM; pitch = DE; wsc = W2_SCALE; src = in[IN_WD] + le * DE * DM + (size_t)(64 * kb) * DM + 64 * nb; dst = ws + WS_W2 + (le * DM + 64 * nb) * DE + 64 * kb; }
}
#define TR_LOAD(V, src, ldw) do { _Pragma("unroll") for (int i = 0; i < 16; ++i) V[i] = __builtin_nontemporal_load((const f32x4*)((src) + (size_t)(4 * i + (lane >> 4)) * (ldw) + 4 * (lane & 15))); } while (0)
#define TR_PROC(V, dst, pitch, ksc, wsc, fp8) do { \
    _Pragma("unroll") for (int i = 0; i < 16; ++i) { const int kk = 4 * i + (lane >> 4); f32x4 v = V[i] * ((ksc) ? (ksc)[kk] * (wsc) : (wsc)); \
        LAS float* d = scr + kk * 65 + 4 * (lane & 15); d[0] = v[0]; d[1] = v[1]; d[2] = v[2]; d[3] = v[3]; } \
    LDS_WAIT(); \
    _Pragma("unroll") for (int j = 0; j < 8; ++j) { const int n = (lane >> 3) + 8 * j; const LAS float* sp = scr + (8 * (lane & 7)) * 65 + n; \
        if (fp8) { u32x2 o; o.x = pk4_fp8(sp[0], sp[65], sp[2 * 65], sp[3 * 65]); o.y = pk4_fp8(sp[4 * 65], sp[5 * 65], sp[6 * 65], sp[7 * 65]); *(u32x2*)((dst) + (size_t)n * (pitch) + 8 * (lane & 7)) = o; } \
        else { u32x4 o; o.x = cvt_pk_bf16(sp[0], sp[65]); o.y = cvt_pk_bf16(sp[2 * 65], sp[3 * 65]); o.z = cvt_pk_bf16(sp[4 * 65], sp[5 * 65]); o.w = cvt_pk_bf16(sp[6 * 65], sp[7 * 65]); \
            *(u32x4*)((dst) + (size_t)n * (pitch) + 16 * (lane & 7)) = o; } } \
    LDS_WAIT(); } while (0)
__device__ __forceinline__ void norm_row_bf16(const float* xrow, const float* g, bf16* orow, int lane) {
    f32x4 v[8]; float s = 0.f;
#pragma unroll
    for (int j = 0; j < 8; ++j) { v[j] = *(const f32x4*)(xrow + 4 * lane + 256 * j); s += (v[j][0] * v[j][0] + v[j][1] * v[j][1]) + (v[j][2] * v[j][2] + v[j][3] * v[j][3]); }
    const float rs = __builtin_amdgcn_rsqf(wave_sum(s) * (1.f / DM) + EPS);
#pragma unroll
    for (int j = 0; j < 8; ++j) { const f32x4 gg = *(const f32x4*)(g + 4 * lane + 256 * j);
        u32x2 o; o.x = cvt_pk_bf16(v[j][0] * rs * gg[0], v[j][1] * rs * gg[1]); o.y = cvt_pk_bf16(v[j][2] * rs * gg[2], v[j][3] * rs * gg[3]);
        *(u32x2*)(orow + 4 * lane + 256 * j) = o; }
}
__device__ __forceinline__ void p_prologue(Frame& F) {
    LAS float* scr = (LAS float*)(F.lds + F.wave * 16640);
    const int gw = F.vcu * NWAVES + F.wave, NGW = F.G * NWAVES, lane = F.lane;
    constexpr int T_TOTAL = NLAYER * (32 * 80 + 32 * 32 + NE * (2 * 32 * 8 + 8 * 32));
    {
        f32x4 va[16], vb[16];
        const float* srcA; const float* srcB; unsigned char* dstA; unsigned char* dstB; const float* kA; const float* kB; int ldA, ldB, pA, pB, fA, fB; float wA, wB;
        int it = gw;
        if (it < T_TOTAL) { tile_desc(F.in, F.ws, it, srcA, ldA, dstA, pA, kA, wA, fA); TR_LOAD(va, srcA, ldA); }
        while (it < T_TOTAL) {
            const int itb = it + NGW;
            if (itb < T_TOTAL) { tile_desc(F.in, F.ws, itb, srcB, ldB, dstB, pB, kB, wB, fB); TR_LOAD(vb, srcB, ldB); }
            TR_PROC(va, dstA, pA, kA, wA, fA);
            if (itb >= T_TOTAL) break;
            const int ita = itb + NGW;
            if (ita < T_TOTAL) { tile_desc(F.in, F.ws, ita, srcA, ldA, dstA, pA, kA, wA, fA); TR_LOAD(va, srcA, ldA); }
            TR_PROC(vb, dstB, pB, kB, wB, fB);
            it = ita;
        }
    }
    { bf16* SW = (bf16*)(F.ws + WS_SGUW); const int gt = gw * 64 + F.lane, NGT = NGW * 64;
      for (int idx = gt; idx < NLAYER * 4 * 8 * 4 * 64; idx += NGT) {
          const int ln = idx & 63, pp = (idx >> 6) & 3, itile = (idx >> 8) & 7, h = (idx >> 11) & 3, l = idx >> 13;
          const int i = 16 * itile + (ln & 15), gq = ln >> 4;
          const float* w = F.in[IN_SGUW] + ((size_t)(l * 4 + h) * 128 + i) * 128;
          float v[8];
#pragma unroll
          for (int jj = 0; jj < 8; ++jj) { const int j = 32 * pp + (jj < 4 ? 4 * gq + jj : 16 + 4 * gq + (jj - 4)); v[jj] = (j <= i) ? w[j] : 0.f; }
          u32x4 o; o.x = cvt_pk_bf16(v[0], v[1]); o.y = cvt_pk_bf16(v[2], v[3]); o.z = cvt_pk_bf16(v[4], v[5]); o.w = cvt_pk_bf16(v[6], v[7]);
          *(u32x4*)(SW + (size_t)idx * 8) = o; }
      bf16* WRF = (bf16*)(F.ws + WS_WRT);
      for (int idx = gt; idx < NLAYER * 64 * 3 * 64; idx += NGT) { const int ln = idx & 63, ct = (idx >> 6) % 3, ks = (idx / 192) & 63, l = idx / (192 * 64);
          const int o = 16 * ct + (ln & 15), k0 = 32 * ks + 8 * (ln >> 4);
          float v[8];
#pragma unroll
          for (int j = 0; j < 8; ++j) { const int k = k0 + j; const float wv = o < 32 ? F.in[IN_WRE][((size_t)l * DM + k) * NE + o] : (o < 36 ? F.in[IN_WRG][((size_t)l * DM + k) * 4 + (o - 32)] : 0.f);
              v[j] = wv * F.in[IN_NORM2][(size_t)l * DM + k]; }
          u32x4 hi, lo; hi.x = cvt_pk_bf16(v[0], v[1]); hi.y = cvt_pk_bf16(v[2], v[3]); hi.z = cvt_pk_bf16(v[4], v[5]); hi.w = cvt_pk_bf16(v[6], v[7]);
          lo.x = cvt_pk_bf16(v[0] - bf_lo(hi.x), v[1] - bf_hi(hi.x)); lo.y = cvt_pk_bf16(v[2] - bf_lo(hi.y), v[3] - bf_hi(hi.y));
          lo.z = cvt_pk_bf16(v[4] - bf_lo(hi.z), v[5] - bf_hi(hi.z)); lo.w = cvt_pk_bf16(v[6] - bf_lo(hi.w), v[7] - bf_hi(hi.w));
          bf16* dst = WRF + ((((size_t)l * 64 + ks) * 3 + ct) * 2 * 64 + ln) * 8;
          *(u32x4*)dst = hi; *(u32x4*)(dst + 512) = lo; } }
    bf16* HN = (bf16*)(F.ws + WS_HN);
    for (int m = gw; m < SEQ; m += NGW) norm_row_bf16(F.in[IN_X] + (size_t)m * DM, F.in[IN_NORM1], HN + (size_t)m * DM, F.lane);
}

__device__ __forceinline__ int vimg_off(int row, int c) { return row * 256 + ((((c >> 1) ^ (row & 7)) << 1) | (c & 1)) * 16; }
__device__ __forceinline__ bf16x8 tr_frag(const LAS unsigned char* img, int ra, int rb, int dt, int lane) {
    const int gq = lane >> 4, q = (lane & 15) >> 2, p = lane & 3;
    const int r0 = ra + 4 * gq + q, r1 = rb + 4 * gq + q, c = 2 * dt + (p >> 1);
    const s16x4 a = __builtin_amdgcn_ds_read_tr16_b64_v4i16((LAS s16x4*)(img + vimg_off(r0, c) + 8 * (p & 1)));
    const s16x4 b = __builtin_amdgcn_ds_read_tr16_b64_v4i16((LAS s16x4*)(img + vimg_off(r1, c) + 8 * (p & 1)));
    bf16x8 r; r[0] = a[0]; r[1] = a[1]; r[2] = a[2]; r[3] = a[3]; r[4] = b[0]; r[5] = b[1]; r[6] = b[2]; r[7] = b[3]; return r;
}
__device__ __forceinline__ void sgu_stage8(const bf16* vsrc, int j0, int w, int lane, const f32x4& g0, const f32x4& g1, LAS unsigned char* lds) {
    u32x4 raw[8];
#pragma unroll
    for (int j = 0; j < 8; ++j) raw[j] = *(const u32x4*)(vsrc + (size_t)(w + 8 * (j0 + j)) * DIN);
#pragma unroll
    for (int j = 0; j < 8; ++j) { const int row = w + 8 * (j0 + j);
        float x[8] = {bf_lo(raw[j].x), bf_hi(raw[j].x), bf_lo(raw[j].y), bf_hi(raw[j].y), bf_lo(raw[j].z), bf_hi(raw[j].z), bf_lo(raw[j].w), bf_hi(raw[j].w)};
        float s = 0.f;
#pragma unroll
        for (int e = 0; e < 8; ++e) s += x[e] * x[e];
        const float rs = __builtin_amdgcn_rsqf(wave_sum(s) * (1.f / 512.f) + EPS);
        u32x4 o; o.x = cvt_pk_bf16(x[0] * rs * g0[0], x[1] * rs * g0[1]); o.y = cvt_pk_bf16(x[2] * rs * g0[2], x[3] * rs * g0[3]);
        o.z = cvt_pk_bf16(x[4] * rs * g1[0], x[5] * rs * g1[1]); o.w = cvt_pk_bf16(x[6] * rs * g1[2], x[7] * rs * g1[3]);
        *(LAS u32x4*)(lds + (lane >> 4) * 32768 + vimg_off(row, lane & 15)) = o; }
}
__device__ __forceinline__ void sgu_item(Frame& F, int l, int chunk, int half) {
    const bf16* PROJ = (const bf16*)(F.ws + WS_PROJ); bf16* MIX = (bf16*)(F.ws + WS_MIX);
    const int p0 = chunk * 128, lane = F.lane, w = F.wave;
    LAS float* red = (LAS float*)(F.lds + MISC_OFF + 256);
    const float* gn = F.in[IN_SGUN] + l * 512;
    const f32x4 g0 = *(const f32x4*)(gn + 8 * lane), g1 = *(const f32x4*)(gn + 8 * lane + 4);
    const bf16* vsrc = PROJ + (size_t)p0 * DIN + OFF_V + 8 * lane;
    sgu_stage8(vsrc, 0, w, lane, g0, g1, F.lds);
    if (half) sgu_stage8(vsrc, 8, w, lane, g0, g1, F.lds);
    const int h = w >> 1, ih = w & 1, gq = lane >> 4, fr = lane & 15;
    const LAS unsigned char* img = F.lds + h * 32768;
    const bf16* SW = (const bf16*)(F.ws + WS_SGUW) + (size_t)(l * 4 + h) * 8 * 4 * 64 * 8;
    const float* bs = F.in[IN_SGUB] + (size_t)(l * 4 + h) * 128;
    const float* og = F.in[IN_OUTN] + (size_t)l * DM + h * 128 + 4 * gq;
    const int it0 = ih + 4 * half;
    u32x2 ur[2][8];
#pragma unroll
    for (int ii = 0; ii < 2; ++ii) { const bf16* urow = PROJ + (size_t)(p0 + 16 * (it0 + 2 * ii) + fr) * DIN + OFF_U + h * 128 + 4 * gq;
#pragma unroll
        for (int dt = 0; dt < 8; ++dt) ur[ii][dt] = *(const u32x2*)(urow + 16 * dt); }
    __syncthreads();
    f32x4 z[2][8];
#pragma unroll
    for (int ii = 0; ii < 2; ++ii)
#pragma unroll
        for (int dt = 0; dt < 8; ++dt) z[ii][dt] = (f32x4){0.f, 0.f, 0.f, 0.f};
#pragma unroll 1
    for (int pp = 0; pp <= (it0 + 2) / 2; ++pp) {
        const bf16x8 bw0 = *(const bf16x8*)(SW + ((size_t)(it0 * 4 + pp) * 64 + lane) * 8);
        const bf16x8 bw1 = *(const bf16x8*)(SW + ((size_t)((it0 + 2) * 4 + pp) * 64 + lane) * 8);
        const bool do0 = pp <= it0 / 2;
#pragma unroll
        for (int dt = 0; dt < 8; ++dt) { const bf16x8 a = tr_frag(img, 32 * pp, 32 * pp + 16, dt, lane);
            if (do0) z[0][dt] = __builtin_amdgcn_mfma_f32_16x16x32_bf16(a, bw0, z[0][dt], 0, 0, 0);
            z[1][dt] = __builtin_amdgcn_mfma_f32_16x16x32_bf16(a, bw1, z[1][dt], 0, 0, 0); }
    }
#pragma unroll
    for (int ii = 0; ii < 2; ++ii) { const int i = 16 * (it0 + 2 * ii) + fr; const float bi = bs[i]; float s = 0.f;
#pragma unroll
        for (int dt = 0; dt < 8; ++dt) { const u32x2 u2 = ur[ii][dt];
            f32x4 y; y[0] = bf_lo(u2.x) * (z[ii][dt][0] + bi); y[1] = bf_hi(u2.x) * (z[ii][dt][1] + bi); y[2] = bf_lo(u2.y) * (z[ii][dt][2] + bi); y[3] = bf_hi(u2.y) * (z[ii][dt][3] + bi);
            z[ii][dt] = y; s += (y[0] * y[0] + y[1] * y[1]) + (y[2] * y[2] + y[3] * y[3]); }
        s += __shfl_xor(s, 16); s += __shfl_xor(s, 32);
        if (gq == 0) red[i * 4 + h] = s; }
    __syncthreads();
#pragma unroll
    for (int ii = 0; ii < 2; ++ii) { const int i = 16 * (it0 + 2 * ii) + fr;
        const f32x4 rr = *(const LAS f32x4*)(red + i * 4);
        const float rs = __builtin_amdgcn_rsqf(((rr[0] + rr[1]) + (rr[2] + rr[3])) * (1.f / 512.f) + EPS);
        bf16* orow = MIX + (size_t)(p0 + i) * DM + h * 128 + 4 * gq;
#pragma unroll
        for (int dt = 0; dt < 8; ++dt) { const f32x4 gg = *(const f32x4*)(og + 16 * dt); const f32x4 y = z[ii][dt];
            if (OP8(l)) *(unsigned*)((unsigned char*)MIX + (size_t)(p0 + i) * DM + h * 128 + 4 * gq + 16 * dt) = pk4_fp8(y[0] * rs * gg[0], y[1] * rs * gg[1], y[2] * rs * gg[2], y[3] * rs * gg[3]);
            else { u32x2 o; o.x = cvt_pk_bf16(y[0] * rs * gg[0], y[1] * rs * gg[1]); o.y = cvt_pk_bf16(y[2] * rs * gg[2], y[3] * rs * gg[3]);
            *(u32x2*)(orow + 16 * dt) = o; } } }
    __syncthreads();
}

__device__ __forceinline__ void conv_item(Frame& F, int l, int tile) {
    const bf16* PROJ = (const bf16*)(F.ws + WS_PROJ); bf16* MIX = (bf16*)(F.ws + WS_MIX);
    constexpr int TP = 32, NR = TP + 30;
    const int p0 = tile * TP, c = F.tid, tid = F.tid;
    LAS float* cbuf = (LAS float*)F.lds;
    LAS bf16* zbuf = (LAS bf16*)(F.lds + 65536);
    { u32x4 av[8], gv[8];
#pragma unroll
      for (int i = 0; i < 8; ++i) { const int id = tid + NTHREADS * i, row = id >> 6, ch = (id & 63) * 8; int p = p0 - 30 + row; p = p < 0 ? 0 : p; p = row < NR ? p : 0;
          av[i] = *(const u32x4*)(PROJ + (size_t)p * DIN + OFF_A + ch); gv[i] = *(const u32x4*)(PROJ + (size_t)p * DIN + OFF_G + ch); }
#pragma unroll
      for (int i = 0; i < 8; ++i) { const int id = tid + NTHREADS * i, row = id >> 6, ch = (id & 63) * 8; const bool live = (p0 - 30 + row) >= 0;
          const unsigned au[4] = {av[i].x, av[i].y, av[i].z, av[i].w}, gu[4] = {gv[i].x, gv[i].y, gv[i].z, gv[i].w}; u32x4 o; unsigned ou[4];
#pragma unroll
          for (int e = 0; e < 4; ++e) { const float z0 = bf_lo(au[e]) * sigmoidf_(bf_lo(gu[e])), z1 = bf_hi(au[e]) * sigmoidf_(bf_hi(gu[e])); ou[e] = live ? cvt_pk_bf16(z0, z1) : 0u; }
          o.x = ou[0]; o.y = ou[1]; o.z = ou[2]; o.w = ou[3];
          if (row < NR) *(LAS u32x4*)(zbuf + row * 512 + ch) = o; } }
    float wk[CONV_K];
#pragma unroll
    for (int k = 0; k < CONV_K; ++k) wk[k] = F.in[IN_CONVW][((size_t)l * CONV_K + k) * 512 + c];
    const float cb = F.in[IN_CONVB][l * 512 + c];
    __syncthreads();
#define CONV_Z(r) __builtin_bit_cast(float, (unsigned)zbuf[(r) * 512 + c] << 16)
    float win[30];
#pragma unroll
    for (int r = 0; r < 30; ++r) win[r] = CONV_Z(r);
#pragma unroll
    for (int q = 0; q < TP; ++q) { const float zv = CONV_Z(30 + q); float acc = cb + wk[30] * zv;
#pragma unroll
        for (int k = 0; k < 30; ++k) acc += wk[k] * win[(k + q) % 30];
        win[q % 30] = zv; cbuf[q * 512 + c] = acc; }
#undef CONV_Z
    __syncthreads();
    const float* lg = F.in[IN_LNG] + l * 512 + 8 * F.lane; const float* lb = F.in[IN_LNB] + l * 512 + 8 * F.lane; const float* og = F.in[IN_OUTN] + (size_t)l * DM + 512 + 8 * F.lane;
    const f32x4 lg0 = *(const f32x4*)lg, lg1 = *(const f32x4*)(lg + 4), lb0 = *(const f32x4*)lb, lb1 = *(const f32x4*)(lb + 4), og0 = *(const f32x4*)og, og1 = *(const f32x4*)(og + 4);
    for (int r = F.wave; r < TP; r += NWAVES) {
        const f32x4 a0 = *(const LAS f32x4*)(cbuf + r * 512 + 8 * F.lane), a1 = *(const LAS f32x4*)(cbuf + r * 512 + 8 * F.lane + 4);
        float x[8] = {a0[0], a0[1], a0[2], a0[3], a1[0], a1[1], a1[2], a1[3]};
        float s = 0.f;
#pragma unroll
        for (int e = 0; e < 8; ++e) s += x[e];
        const float mu = wave_sum(s) * (1.f / 512.f); float q2 = 0.f;
#pragma unroll
        for (int e = 0; e < 8; ++e) { x[e] -= mu; q2 += x[e] * x[e]; }
        const float rstd = __builtin_amdgcn_rsqf(wave_sum(q2) * (1.f / 512.f) + EPS);
        const float gam[8] = {lg0[0], lg0[1], lg0[2], lg0[3], lg1[0], lg1[1], lg1[2], lg1[3]}, bet[8] = {lb0[0], lb0[1], lb0[2], lb0[3], lb1[0], lb1[1], lb1[2], lb1[3]};
        float s2 = 0.f;
#pragma unroll
        for (int e = 0; e < 8; ++e) { const float y = x[e] * rstd * gam[e] + bet[e]; x[e] = y * sigmoidf_(y); s2 += x[e] * x[e]; }
        const float rs = __builtin_amdgcn_rsqf(wave_sum(s2) * (1.f / 512.f) + EPS);
        if (OP8(l)) { u32x2 o8; o8.x = pk4_fp8(x[0] * rs * og0[0], x[1] * rs * og0[1], x[2] * rs * og0[2], x[3] * rs * og0[3]); o8.y = pk4_fp8(x[4] * rs * og1[0], x[5] * rs * og1[1], x[6] * rs * og1[2], x[7] * rs * og1[3]);
            *(u32x2*)((unsigned char*)MIX + (size_t)(p0 + r) * DM + 512 + 8 * F.lane) = o8; }
        else {
        u32x4 o; o.x = cvt_pk_bf16(x[0] * rs * og0[0], x[1] * rs * og0[1]); o.y = cvt_pk_bf16(x[2] * rs * og0[2], x[3] * rs * og0[3]);
        o.z = cvt_pk_bf16(x[4] * rs * og1[0], x[5] * rs * og1[1]); o.w = cvt_pk_bf16(x[6] * rs * og1[2], x[7] * rs * og1[3]);
        *(u32x4*)(MIX + (size_t)(p0 + r) * DM + 512 + 8 * F.lane) = o; }
    }
    __syncthreads();
}

__device__ __forceinline__ int kimg_off(int row, int c) { return row * 256 + ((c ^ (row & 15)) << 4); }
__device__ __forceinline__ bf16x8 tr_frag2(const LAS unsigned char* vs, int ta, int tb, int dt, int lane) {
    const int gq = lane >> 4, q = (lane & 15) >> 2, p = lane & 3, c = 2 * dt + (p >> 1), rr = 4 * gq + q;
    const int off = rr * 256 + ((((c >> 1) ^ (rr & 7)) << 1) | (c & 1)) * 16 + 8 * (p & 1);
    const s16x4 a = __builtin_amdgcn_ds_read_tr16_b64_v4i16((LAS s16x4*)(vs + ta + off));
    const s16x4 b = __builtin_amdgcn_ds_read_tr16_b64_v4i16((LAS s16x4*)(vs + tb + off));
    bf16x8 r; r[0] = a[0]; r[1] = a[1]; r[2] = a[2]; r[3] = a[3]; r[4] = b[0]; r[5] = b[1]; r[6] = b[2]; r[7] = b[3]; return r;
}
#define ATT_DECODE(st) const int run_ = (int)blockIdx.x + F.G * ((st) / 5), b_ = (st) % 5 - 1; const int g = run_ >> 8, h = (run_ >> 5) & 7, rr_ = run_ & 31; \
    const int sh = 2 * g, dil = 1 << sh, rps = 32 >> sh; const int r = rr_ / rps, nb = 4 * (rr_ % rps) + b_
#define ATT_LOAD(st) do { if (ATT_EXP == 2) break; ATT_DECODE(st); const int cc = tid & 15; \
    _Pragma("unroll") for (int j = 0; j < 4; ++j) { const int row = (tid >> 4) + 32 * j; int ms = nb * 128 + row; ms = ms < 0 ? 0 : ms; const size_t pos = (size_t)ms * dil + r; \
        kr[j] = *(const u32x4*)(PROJ + pos * DIN + OFF_K + h * HD + 8 * cc); vr[j] = *(const u32x4*)(PROJ + pos * DIN + OFF_VV + h * HD + 8 * cc); } \
    if (b_ >= 0) { const size_t qpos_ = (size_t)(nb * 128 + 16 * w + (lane & 15)) * dil + r; \
        _Pragma("unroll") for (int ks = 0; ks < 4; ++ks) qr[ks] = *(const u32x4*)(PROJ + qpos_ * DIN + OFF_Q + h * HD + 32 * ks + 8 * (lane >> 4)); } } while (0)
__device__ __forceinline__ void att_phase(Frame& F, int l) {
    const bf16* PROJ = (const bf16*)(F.ws + WS_PROJ);
    bf16* ATT = (bf16*)(F.ws + WS_ATT); float* LSE = (float*)(F.ws + WS_LSE);
    const int lane = F.lane, w = F.wave, tid = F.tid, fr = lane & 15, gq = lane >> 4;
    LAS unsigned char* Ks = F.lds; LAS unsigned char* Vs = F.lds + 65536;
    const int nsteps = 5 * ((768 - (int)blockIdx.x + F.G - 1) / F.G);
    u32x4 kr[4], vr[4], qr[4];
    if (ATT_EXP == 2) { for (int j = 0; j < 4; ++j) { kr[j] = (u32x4){0x3f803f80u + (unsigned)tid, 0x3f003f80u, 0x3f803f00u, 0x3e803f80u}; vr[j] = kr[j]; qr[j] = kr[j]; } }
    if (nsteps > 0) ATT_LOAD(0);
    const int cc = tid & 15;
    const float* kgp = F.in[IN_KN] + l * HD + 8 * cc;
    const f32x4 kg0 = *(const f32x4*)kgp, kg1 = *(const f32x4*)(kgp + 4);
    for (int st = 0; st < nsteps; ++st) {
        ATT_DECODE(st);
        const int slot = (b_ + 1) & 1, curoff = slot * 32768, prevoff = 32768 - curoff;
#pragma unroll
        for (int j = 0; j < 4; ++j) { const int row = (tid >> 4) + 32 * j;
            const u32x4 k4 = kr[j];
            float x[8] = {bf_lo(k4.x), bf_hi(k4.x), bf_lo(k4.y), bf_hi(k4.y), bf_lo(k4.z), bf_hi(k4.z), bf_lo(k4.w), bf_hi(k4.w)};
            float sq = 0.f;
#pragma unroll
            for (int e = 0; e < 8; ++e) sq += x[e] * x[e];
            const float rs = __builtin_amdgcn_rsqf(row16_sum(sq) * (1.f / HD) + EPS);
            u32x4 o; o.x = cvt_pk_bf16(x[0] * rs * kg0[0], x[1] * rs * kg0[1]); o.y = cvt_pk_bf16(x[2] * rs * kg0[2], x[3] * rs * kg0[3]);
            o.z = cvt_pk_bf16(x[4] * rs * kg1[0], x[5] * rs * kg1[1]); o.w = cvt_pk_bf16(x[6] * rs * kg1[2], x[7] * rs * kg1[3]);
            *(LAS u32x4*)(Ks + curoff + kimg_off(row, cc)) = o;
            *(LAS u32x4*)(Vs + curoff + vimg_off(row, cc)) = vr[j]; }
        const int iq = 16 * w + fr; const size_t qpos = (size_t)(nb * 128 + iq) * dil + r;
        bf16x8 qf[4];
        if (b_ >= 0) { float x[4][8]; float sq = 0.f;
#pragma unroll
          for (int ks = 0; ks < 4; ++ks) { const u32x4 q4 = qr[ks];
              x[ks][0] = bf_lo(q4.x); x[ks][1] = bf_hi(q4.x); x[ks][2] = bf_lo(q4.y); x[ks][3] = bf_hi(q4.y); x[ks][4] = bf_lo(q4.z); x[ks][5] = bf_hi(q4.z); x[ks][6] = bf_lo(q4.w); x[ks][7] = bf_hi(q4.w);
#pragma unroll
              for (int e = 0; e < 8; ++e) sq += x[ks][e] * x[ks][e]; }
          sq = sum4(sq);
          const float rs = __builtin_amdgcn_rsqf(sq * (1.f / HD) + EPS) * 0.12751743f;
#pragma unroll
          for (int ks = 0; ks < 4; ++ks) { const float* qg = F.in[IN_QN] + l * HD + 32 * ks + 8 * gq; const f32x4 q0 = *(const f32x4*)qg, q1 = *(const f32x4*)(qg + 4);
              u32x4 o; o.x = cvt_pk_bf16(x[ks][0] * rs * q0[0], x[ks][1] * rs * q0[1]); o.y = cvt_pk_bf16(x[ks][2] * rs * q0[2], x[ks][3] * rs * q0[3]);
              o.z = cvt_pk_bf16(x[ks][4] * rs * q1[0], x[ks][5] * rs * q1[1]); o.w = cvt_pk_bf16(x[ks][6] * rs * q1[2], x[ks][7] * rs * q1[3]);
              qf[ks] = __builtin_bit_cast(bf16x8, o); } }
        __syncthreads();
        if (st + 1 < nsteps) ATT_LOAD(st + 1);
        if (b_ >= 0 && ATT_EXP != 1) {
        f32x4 sc[10];
#pragma unroll
        for (int kt = 0; kt < 9; ++kt) { sc[kt] = (f32x4){0.f, 0.f, 0.f, 0.f}; const int T = w + kt; const int kbase = (T < 8 ? prevoff : curoff); const int krow = 16 * (T & 7) + fr;
#pragma unroll
            for (int ks = 0; ks < 4; ++ks) { const bf16x8 kf = *(const LAS bf16x8*)(Ks + kbase + kimg_off(krow, 4 * ks + gq));
                sc[kt] = __builtin_amdgcn_mfma_f32_16x16x32_bf16(kf, qf[ks], sc[kt], 0, 0, 0); } }
#pragma unroll
        for (int e = 0; e < 4; ++e) { sc[0][e] = (4 * gq + e >= fr) ? sc[0][e] : -INFINITY; sc[8][e] = (4 * gq + e <= fr) ? sc[8][e] : -INFINITY; }
        if (nb == 0) {
#pragma unroll
            for (int kt = 0; kt < 8; ++kt) if (w + kt < 8) sc[kt] = (f32x4){-INFINITY, -INFINITY, -INFINITY, -INFINITY}; }
        float mx = -INFINITY;
#pragma unroll
        for (int kt = 0; kt < 9; ++kt) mx = fmaxf(fmaxf(mx, fmaxf(sc[kt][0], sc[kt][1])), fmaxf(sc[kt][2], sc[kt][3]));
        mx = max4(mx);
        float sum = 0.f;
#pragma unroll
        for (int kt = 0; kt < 9; ++kt)
#pragma unroll
            for (int e = 0; e < 4; ++e) { const float p = __builtin_amdgcn_exp2f(sc[kt][e] - mx); sc[kt][e] = p; sum += p; }
        sc[9] = (f32x4){0.f, 0.f, 0.f, 0.f};
        sum = sum4(sum);
        bf16x8 pf[5];
#pragma unroll
        for (int pp = 0; pp < 5; ++pp) { u32x4 o; o.x = cvt_pk_bf16(sc[2 * pp][0], sc[2 * pp][1]); o.y = cvt_pk_bf16(sc[2 * pp][2], sc[2 * pp][3]); o.z = cvt_pk_bf16(sc[2 * pp + 1][0], sc[2 * pp + 1][1]); o.w = cvt_pk_bf16(sc[2 * pp + 1][2], sc[2 * pp + 1][3]);
            pf[pp] = __builtin_bit_cast(bf16x8, o); }
        const float inv = __builtin_amdgcn_rcpf(sum);
        bf16* orow = ATT + ((size_t)g * SEQ + qpos) * 1024 + h * HD + 4 * gq;
        int toff[10];
#pragma unroll
        for (int kt = 0; kt < 10; ++kt) { const int T = (w + kt) < 15 ? (w + kt) : 15; toff[kt] = (T < 8 ? prevoff : curoff) + (T & 7) * 16 * 256; }
#pragma unroll
        for (int dt = 0; dt < 8; ++dt) { f32x4 o = (f32x4){0.f, 0.f, 0.f, 0.f};
#pragma unroll
            for (int pp = 0; pp < 5; ++pp) { const bf16x8 vf = tr_frag2(Vs, toff[2 * pp], toff[2 * pp + 1], dt, lane);
                o = __builtin_amdgcn_mfma_f32_16x16x32_bf16(vf, pf[pp], o, 0, 0, 0); }
            u32x2 ow; ow.x = cvt_pk_bf16(o[0] * inv, o[1] * inv); ow.y = cvt_pk_bf16(o[2] * inv, o[3] * inv);
            *(u32x2*)(orow + 16 * dt) = ow; }
        if (gq == 0) LSE[((size_t)g * SEQ + qpos) * NHEAD + h] = (mx + __builtin_amdgcn_logf(sum)) * 0.6931471805599453f;
        }
        if (b_ >= 0 && ATT_EXP == 1) { bf16* orow = ATT + ((size_t)g * SEQ + qpos) * 1024 + h * HD + 4 * gq;
#pragma unroll
            for (int dt = 0; dt < 8; ++dt) { u32x2 ow; ow.x = __builtin_bit_cast(unsigned, qf[dt & 3][0] | (qf[dt & 3][1] << 16)) & 0x3f803f80u; ow.y = 0u; *(u32x2*)(orow + 16 * dt) = ow; }
            if (gq == 0) LSE[((size_t)g * SEQ + qpos) * NHEAD + h] = 0.f; }
        __syncthreads();
    }
}
#undef ATT_DECODE
#undef ATT_LOAD

__device__ __forceinline__ void att_combine(Frame& F, int l) {
    const bf16* ATT = (const bf16*)(F.ws + WS_ATT); const float* LSE = (const float*)(F.ws + WS_LSE); bf16* MIX = (bf16*)(F.ws + WS_MIX);
    const int gw = F.vcu * NWAVES + F.wave, NGW = F.G * NWAVES, lane = F.lane;
    const float* og = F.in[IN_OUTN] + (size_t)l * DM + 1024 + 16 * lane;
    f32x4 gg[4];
#pragma unroll
    for (int q = 0; q < 4; ++q) gg[q] = *(const f32x4*)(og + 4 * q);
    for (int m = gw; m < SEQ; m += NGW) {
        const int hh = lane >> 3;
        const float l0 = LSE[((size_t)0 * SEQ + m) * NHEAD + hh], l1 = LSE[((size_t)1 * SEQ + m) * NHEAD + hh], l2 = LSE[((size_t)2 * SEQ + m) * NHEAD + hh];
        const float M = fmaxf(l0, fmaxf(l1, l2)); float w0 = fast_exp(l0 - M), w1 = fast_exp(l1 - M), w2 = fast_exp(l2 - M);
        const float iw = __builtin_amdgcn_rcpf(w0 + w1 + w2); w0 *= iw; w1 *= iw; w2 *= iw;
        float y[16]; float s = 0.f;
#pragma unroll
        for (int q = 0; q < 2; ++q) {
            const u32x4 a = *(const u32x4*)(ATT + ((size_t)0 * SEQ + m) * 1024 + 16 * lane + 8 * q), b = *(const u32x4*)(ATT + ((size_t)1 * SEQ + m) * 1024 + 16 * lane + 8 * q), c = *(const u32x4*)(ATT + ((size_t)2 * SEQ + m) * 1024 + 16 * lane + 8 * q);
            const unsigned au[4] = {a.x, a.y, a.z, a.w}, bu[4] = {b.x, b.y, b.z, b.w}, cu[4] = {c.x, c.y, c.z, c.w};
#pragma unroll
            for (int e = 0; e < 4; ++e) { y[8 * q + 2 * e] = w0 * bf_lo(au[e]) + w1 * bf_lo(bu[e]) + w2 * bf_lo(cu[e]); y[8 * q + 2 * e + 1] = w0 * bf_hi(au[e]) + w1 * bf_hi(bu[e]) + w2 * bf_hi(cu[e]); } }
#pragma unroll
        for (int e = 0; e < 16; ++e) s += y[e] * y[e];
        const float rs = __builtin_amdgcn_rsqf(wave_sum(s) * (1.f / 1024.f) + EPS);
        if (OP8(l)) { u32x4 o8;
            o8.x = pk4_fp8(y[0] * rs * gg[0][0], y[1] * rs * gg[0][1], y[2] * rs * gg[0][2], y[3] * rs * gg[0][3]); o8.y = pk4_fp8(y[4] * rs * gg[1][0], y[5] * rs * gg[1][1], y[6] * rs * gg[1][2], y[7] * rs * gg[1][3]);
            o8.z = pk4_fp8(y[8] * rs * gg[2][0], y[9] * rs * gg[2][1], y[10] * rs * gg[2][2], y[11] * rs * gg[2][3]); o8.w = pk4_fp8(y[12] * rs * gg[3][0], y[13] * rs * gg[3][1], y[14] * rs * gg[3][2], y[15] * rs * gg[3][3]);
            *(u32x4*)((unsigned char*)MIX + (size_t)m * DM + 1024 + 16 * lane) = o8; }
        else
#pragma unroll
        for (int q = 0; q < 2; ++q) { u32x4 o;
            o.x = cvt_pk_bf16(y[8 * q + 0] * rs * gg[2 * q][0], y[8 * q + 1] * rs * gg[2 * q][1]); o.y = cvt_pk_bf16(y[8 * q + 2] * rs * gg[2 * q][2], y[8 * q + 3] * rs * gg[2 * q][3]);
            o.z = cvt_pk_bf16(y[8 * q + 4] * rs * gg[2 * q + 1][0], y[8 * q + 5] * rs * gg[2 * q + 1][1]); o.w = cvt_pk_bf16(y[8 * q + 6] * rs * gg[2 * q + 1][2], y[8 * q + 7] * rs * gg[2 * q + 1][3]);
            *(u32x4*)(MIX + (size_t)m * DM + 1024 + 16 * lane + 8 * q) = o; }
    }
}

#define ROUTER_LOAD(S, ks) do { \
    _Pragma("unroll") for (int rt = 0; rt < 4; ++rt) xa##S[rt] = *(const u32x4*)(xrow + (size_t)rt * 16 * DM + 32 * (ks)); \
    _Pragma("unroll") for (int ct = 0; ct < 3; ++ct) { bh##S[ct] = *(const bf16x8*)(wf + (size_t)(ks) * 3072 + (ct * 2) * 512); bl##S[ct] = *(const bf16x8*)(wf + (size_t)(ks) * 3072 + (ct * 2 + 1) * 512); } } while (0)
#define ROUTER_STEP(S, ks) do { \
    _Pragma("unroll") for (int rt = 0; rt < 4; ++rt) { const u32x4 xq = xa##S[rt]; \
        const float x0 = bf_lo(xq.x), x1 = bf_hi(xq.x), x2 = bf_lo(xq.y), x3 = bf_hi(xq.y), x4 = bf_lo(xq.z), x5 = bf_hi(xq.z), x6 = bf_lo(xq.w), x7 = bf_hi(xq.w); \
        ssq[rt] += (x0 * x0 + x1 * x1) + (x2 * x2 + x3 * x3) + (x4 * x4 + x5 * x5) + (x6 * x6 + x7 * x7); \
        { u32x2 x8; x8.x = pk4_fp8(x0, x1, x2, x3); x8.y = pk4_fp8(x4, x5, x6, x7); *(u32x2*)(x8row + (size_t)rt * 16 * DM + 32 * (ks)) = x8; } \
        const bf16x8 xh = __builtin_bit_cast(bf16x8, xq); \
        _Pragma("unroll") for (int ct = 0; ct < 3; ++ct) { \
            acc[rt][ct] = __builtin_amdgcn_mfma_f32_16x16x32_bf16(xh, bh##S[ct], acc[rt][ct], 0, 0, 0); \
            acc[rt][ct] = __builtin_amdgcn_mfma_f32_16x16x32_bf16(xh, bl##S[ct], acc[rt][ct], 0, 0, 0); } } } while (0)
__device__ __forceinline__ void router_phase(Frame& F, int l, int alt = 0) {
    const bf16* H1 = (const bf16*)(F.ws + WS_HN);
    const bf16* WRF = (const bf16*)(F.ws + WS_WRT) + (size_t)l * 64 * 3 * 2 * 64 * 8;
    unsigned* cnt = (unsigned*)(F.ws + WS_CTL) + CW_CNT + 2048 * l + 32768 * alt;
    int* tok = (int*)(F.ws + (alt ? WS_ALT : WS_TOK)); f32x4* tinfo = (f32x4*)(F.ws + (alt ? WS_ALT + 4 * MiB : WS_TINFO)); float* rslot = (float*)(F.ws + (alt ? WS_ALT + 2 * MiB : WS_RSLOT));
    const int lane = F.lane, tid = F.tid, w = F.wave, fr = lane & 15, g = lane >> 4;
    constexpr int PS = 49;
    LAS float* P = (LAS float*)F.lds;
    LAS float* SS = (LAS float*)(F.lds + 8 * 64 * PS * 4);
    for (int task = (int)blockIdx.x; task < SEQ / 64; task += F.G) {
        const bf16* xrow = H1 + (size_t)(task * 64 + fr) * DM + 256 * w + 8 * g;
        unsigned char* x8row = F.ws + WS_X8 + (size_t)(task * 64 + fr) * DM + 256 * w + 8 * g;
        const bf16* wf = WRF + ((size_t)(8 * w) * 3 * 2 * 64 + lane) * 8;
        f32x4 acc[4][3]; float ssq[4] = {0.f, 0.f, 0.f, 0.f};
#pragma unroll
        for (int rt = 0; rt < 4; ++rt)
#pragma unroll
            for (int ct = 0; ct < 3; ++ct) acc[rt][ct] = (f32x4){0.f, 0.f, 0.f, 0.f};
        u32x4 xaA[4], xaB[4]; bf16x8 bhA[3], blA[3], bhB[3], blB[3];
        ROUTER_LOAD(A, 0);
#pragma unroll 1
        for (int it = 0; it < 4; ++it) {
            ROUTER_LOAD(B, 1); __builtin_amdgcn_sched_barrier(0);
            ROUTER_STEP(A, 0); __builtin_amdgcn_sched_barrier(0);
            if (it < 3) ROUTER_LOAD(A, 2);
            __builtin_amdgcn_sched_barrier(0);
            ROUTER_STEP(B, 1); __builtin_amdgcn_sched_barrier(0);
            xrow += 64; x8row += 64; wf += 2 * 3072;
        }
#pragma unroll
        for (int rt = 0; rt < 4; ++rt) { float sq = ssq[rt]; sq += __shfl_xor(sq, 16); sq += __shfl_xor(sq, 32);
            if (g == 0) SS[w * 64 + 16 * rt + fr] = sq;
#pragma unroll
            for (int ct = 0; ct < 3; ++ct)
#pragma unroll
                for (int e = 0; e < 4; ++e) P[(w * 64 + 16 * rt + 4 * g + e) * PS + 16 * ct + fr] = acc[rt][ct][e]; }
        __syncthreads();
        if (tid < 64) {
            const int t = task * 64 + tid;
            float ss = 0.f;
#pragma unroll
            for (int q = 0; q < 8; ++q) ss += SS[q * 64 + tid];
            const float rs = __builtin_amdgcn_rsqf(ss * (1.f / DM) + EPS);
            const LAS float* pr = P + tid * PS;
            float lg[4];
#pragma unroll
            for (int o = 0; o < 4; ++o) { float a = 0.f;
#pragma unroll
                for (int q = 0; q < 8; ++q) a += pr[q * 64 * PS + 32 + o];
                lg[o] = a * rs + F.in[IN_BRG][l * 4 + o]; }
            int gi = 0; float gm = lg[0];
#pragma unroll
            for (int o = 1; o < 4; ++o) if (lg[o] > gm) { gm = lg[o]; gi = o; }
            float den = 0.f;
#pragma unroll
            for (int o = 0; o < 4; ++o) den += __expf(lg[o] - gm);
            const float gate_g = 1.f / den;
            float t1v = -INFINITY, t2v = -INFINITY; int t1i = 0, t2i = 0;
#pragma unroll
            for (int ii = 0; ii < 8; ++ii) { const int o = gi * 8 + ii; float a = 0.f;
#pragma unroll
                for (int q = 0; q < 8; ++q) a += pr[q * 64 * PS + o];
                const float v = a * rs + F.in[IN_BRE][l * NE + o];
                if (v > t1v) { t2v = t1v; t2i = t1i; t1v = v; t1i = ii; }
                else if (v > t2v) { t2v = v; t2i = ii; } }
            const float pp1 = 1.f / (1.f + __expf(t2v - t1v)), pp2 = 1.f - pp1;
            const int e0 = gi * 8 + t1i, e1 = gi * 8 + t2i;
            LAS unsigned* lcnt = (LAS unsigned*)(F.lds + 8 * 64 * PS * 4 + 8 * 64 * 4);
            if (tid < 32) lcnt[tid] = 0u;
            const unsigned r0 = __hip_atomic_fetch_add(lcnt + e0, 1u, __ATOMIC_RELAXED, __HIP_MEMORY_SCOPE_WORKGROUP), r1 = __hip_atomic_fetch_add(lcnt + e1, 1u, __ATOMIC_RELAXED, __HIP_MEMORY_SCOPE_WORKGROUP);
            if (tid < 32) { const unsigned c = lcnt[tid]; lcnt[32 + tid] = c ? atomicAdd(&cnt[tid * CNT_STRIDE], c) : 0u; }
            const unsigned s0 = lcnt[32 + e0] + r0, s1 = lcnt[32 + e1] + r1;
            tok[(size_t)e0 * TOKCAP + s0] = t; tok[(size_t)e1 * TOKCAP + s1] = t;
            rslot[(size_t)e0 * TOKCAP + s0] = rs; rslot[(size_t)e1 * TOKCAP + s1] = rs;
            f32x4 ti; ti[0] = __builtin_bit_cast(float, (int)(e0 * TOKCAP + s0)); ti[1] = __builtin_bit_cast(float, (int)(e1 * TOKCAP + s1)); ti[2] = gate_g * pp1; ti[3] = gate_g * pp2;
            tinfo[t] = ti;
        }
        __syncthreads();
    }
}
__device__ __forceinline__ void moe_table(Frame& F, int l) {
    const unsigned* cnt = (const unsigned*)(F.ws + WS_CTL) + CW_CNT + 2048 * l;
    LAS int* tstart = (LAS int*)(F.lds + MISC_OFF + 64);
    __syncthreads();
    if (F.tid == 0) { int acc = 0; for (int e = 0; e < NE; ++e) { tstart[e] = acc; acc += ((int)cnt[e * CNT_STRIDE] + 255) >> 8; } tstart[NE] = acc; }
    __syncthreads();
    { LAS int* tile_e = (LAS int*)(F.lds + MISC_OFF + 2304);
      if (F.tid < 160) { int e = 0; for (int j = 1; j < NE; ++j) e = (tstart[j] <= F.tid) ? j : e; tile_e[F.tid] = e; } }
    __syncthreads();
}
__device__ __forceinline__ void combine_phase(Frame& F, int l) {
    const LAS int* tstart = (const LAS int*)(F.lds + MISC_OFF + 64);
    const bf16* Y = (const bf16*)(F.ws + WS_Y); const f32x4* tinfo = (const f32x4*)(F.ws + WS_TINFO);
    bf16* H = (bf16*)(F.ws + WS_H); bf16* HN = (bf16*)(F.ws + WS_HN);
    const int gw = F.vcu * NWAVES + F.wave, NGW = F.G * NWAVES, lane = F.lane;
    const float* g1n = F.in[IN_NORM1] + (size_t)DM;
    for (int m = gw; m < SEQ; m += NGW) {
        const f32x4 ti = tinfo[m];
        const float tf0 = ti[0], tf1 = ti[1]; const int s0 = __builtin_bit_cast(int, tf0), s1 = __builtin_bit_cast(int, tf1);
        const int e0 = s0 >> 14, e1 = s1 >> 14;
        const size_t r0 = (size_t)tstart[e0] * 256 + (s0 & (TOKCAP - 1)), r1 = (size_t)tstart[e1] * 256 + (s1 & (TOKCAP - 1));
        const float ga = ti[2], gb = ti[3];
        f32x4 v[8]; float s = 0.f;
#pragma unroll
        for (int j = 0; j < 8; ++j) { const u32x2 hx = *(const u32x2*)(HN + (size_t)m * DM + 4 * lane + 256 * j);
            const u32x2 ya = *(const u32x2*)(Y + r0 * DM + 4 * lane + 256 * j), yb = *(const u32x2*)(Y + r1 * DM + 4 * lane + 256 * j);
            v[j][0] = bf_lo(hx.x) + ga * bf_lo(ya.x) + gb * bf_lo(yb.x); v[j][1] = bf_hi(hx.x) + ga * bf_hi(ya.x) + gb * bf_hi(yb.x);
            v[j][2] = bf_lo(hx.y) + ga * bf_lo(ya.y) + gb * bf_lo(yb.y); v[j][3] = bf_hi(hx.y) + ga * bf_hi(ya.y) + gb * bf_hi(yb.y);
            s += (v[j][0] * v[j][0] + v[j][1] * v[j][1]) + (v[j][2] * v[j][2] + v[j][3] * v[j][3]); }
        if (l == 0) {
            const float rs = __builtin_amdgcn_rsqf(wave_sum(s) * (1.f / DM) + EPS);
            bf16* hrow = H + (size_t)m * DM; bf16* orow = HN + (size_t)m * DM;
#pragma unroll
            for (int j = 0; j < 8; ++j) { const f32x4 gg = *(const f32x4*)(g1n + 4 * lane + 256 * j);
                u32x2 hb; hb.x = cvt_pk_bf16(v[j][0], v[j][1]); hb.y = cvt_pk_bf16(v[j][2], v[j][3]); *(u32x2*)(hrow + 4 * lane + 256 * j) = hb;
                u32x2 o; o.x = cvt_pk_bf16(v[j][0] * rs * gg[0], v[j][1] * rs * gg[1]); o.y = cvt_pk_bf16(v[j][2] * rs * gg[2], v[j][3] * rs * gg[3]);
                *(u32x2*)(orow + 4 * lane + 256 * j) = o; }
        } else {
            float* orow = F.out + (size_t)m * DM;
#pragma unroll
            for (int j = 0; j < 8; ++j) *(f32x4*)(orow + 4 * lane + 256 * j) = v[j];
        }
    }
}

__device__ __forceinline__ void relaunder(Frame& F) { F.lane = lane_now(); F.tid = F.wave * 64 + F.lane; }
constexpr int N_PHASES = 17;
#ifndef PHASE_MASK
#define PHASE_MASK 0x1ff
#endif
#ifndef MIX_MASK
#define MIX_MASK 7
#endif
#ifndef DUP_PHASE
#define DUP_PHASE 0
#endif
#define DUP(k) for (int _d = 0; _d < ((DUP_PHASE == (k)) ? 2 : 1); ++_d)
#define IN(k) (lo <= (k) && (k) < hi)
#define EN(b) ((PHASE_MASK >> (b)) & 1)
#ifndef PROBE_STAMP
#define PROBE_STAMP (-1)
#endif
#define SEAM(k) do { if (IN(k) && IN((k) + 1)) { xcd_barrier(bar); if (PROBE_STAMP >= 0 && blockIdx.x == 0 && F.tid == 0) { const unsigned long long _t = wall_clock64(); F.MISC[802 + 2 * (k)] = (unsigned)_t; F.MISC[803 + 2 * (k)] = (unsigned)(_t >> 32); } } } while (0)
template <int l>
__device__ __forceinline__ void layer_phases(Frame& F, const XcdBarrier& bar, const int lo, const int hi) {
    constexpr int pb = 1 + 8 * l;
    relaunder(F);
    if (EN(1) && IN(pb)) {
        pg8::StaticSched S; S.init((const bf16*)(F.ws + WS_HN), (const bf16*)(F.ws + WS_WIN) + (size_t)l * DIN * DM, SEQ, DIN, DM, F.G, (int)blockIdx.x);
        pg8::EpiProj E{(bf16*)(F.ws + WS_PROJ)};
        DUP(1) pg8::gemm_phase<pg8::EpiProj, pg8::StaticSched>(F.lds, DM, S, E, F.wave);
    }
    SEAM(pb);
    relaunder(F);
    if (EN(2) && IN(pb + 1)) {
        constexpr int N_SGU = 256, N_CONV = 512, N_ATT = 3072;
#define MSTAMP(i) do { if (PROBE_STAMP >= 100 && l == 0 && blockIdx.x == 0 && F.tid == 0) { const unsigned long long _t = wall_clock64(); F.MISC[900 + 2 * (i)] = (unsigned)_t; F.MISC[901 + 2 * (i)] = (unsigned)(_t >> 32); } } while (0)
        MSTAMP(0);
        if (MIX_MASK & 1) DUP(2) att_phase(F, l);
        MSTAMP(1);
        if (MIX_MASK & 2) DUP(3) for (int it = (int)blockIdx.x; it < N_CONV; it += F.G) conv_item(F, l, it);
        MSTAMP(2);
        if (MIX_MASK & 4) DUP(4) for (int it = (int)blockIdx.x; it < N_SGU; it += F.G) sgu_item(F, l, it >> 1, it & 1);
        MSTAMP(3);
#undef MSTAMP
    }
    SEAM(pb + 1);
    if (DUP_PHASE == 12 && IN(pb + 1)) {
        pg8::StaticSched S; S.init((const bf16*)(F.ws + WS_MIX), (const bf16*)(F.ws + WS_WIN) + (size_t)l * DIN * DM, SEQ, DIN, DM, F.G, (int)blockIdx.x);
        pg8::EpiProj E{(bf16*)(F.ws + WS_PROJ)};
        pg8::gemm_phase<pg8::EpiProj, pg8::StaticSched>(F.lds, DM, S, E, F.wave);
        xcd_barrier(bar);
    }
    relaunder(F);
    if (EN(3) && IN(pb + 2)) DUP(5) att_combine(F, l);
    SEAM(pb + 2);
    relaunder(F);
    if (EN(4) && IN(pb + 3)) {
        constexpr int KO = OP8(l) ? DM / 2 : DM;
        pg8::StaticSched S; S.init((const bf16*)(F.ws + WS_MIX), (const bf16*)(F.ws + WS_WOUT) + (size_t)l * DM * DM, SEQ, DM, KO, F.G, (int)blockIdx.x);
        if constexpr (l == 0) { pg8::EpiResid<false> E{(const void*)F.in[IN_X], (bf16*)(F.ws + WS_HN)}; DUP(6) pg8::gemm_phase<pg8::EpiResid<false>, pg8::StaticSched, true, OP8(l) != 0>(F.lds, KO, S, E, F.wave); }
        else { pg8::EpiResid<true> E{(const void*)(F.ws + WS_H), (bf16*)(F.ws + WS_HN)}; DUP(6) pg8::gemm_phase<pg8::EpiResid<true>, pg8::StaticSched, true, OP8(l) != 0>(F.lds, KO, S, E, F.wave); }
    }
    SEAM(pb + 3);
    relaunder(F);
    if (EN(5) && IN(pb + 4)) { router_phase(F, l); if (DUP_PHASE == 11) router_phase(F, l, 1); }
    if (DUP_PHASE == 13 && IN(pb + 4)) { for (int q = 0; q < 8; ++q) xcd_barrier(bar); }
    SEAM(pb + 4);
    relaunder(F);
    if (EN(6) && IN(pb + 5)) {
        moe_table(F, l);
        unsigned* ready = (unsigned*)(F.ws + WS_CTL) + CW_RDY + 16384 * l;
        {
            pg8::SchedG1 S{(const LAS int*)(F.lds + MISC_OFF + 64), (const int*)((const unsigned*)(F.ws + WS_CTL) + CW_CNT + 2048 * l), (const int*)(F.ws + WS_TOK), (const bf16*)(F.ws + WS_X8),
                           (const bf16*)(F.ws + WS_W1 + (size_t)l * NE * 1024 * DM), F.G, (int)blockIdx.x, ready};
            pg8::EpiSwiGLU E{F.ws + WS_HB, (const float*)(F.ws + WS_RSLOT)};
            DUP(7) pg8::gemm_phase<pg8::EpiSwiGLU, pg8::SchedG1, true, true>(F.lds, DM / 2, S, E, F.wave);
        }
        {
            pg8::SchedG2 S{(const LAS int*)(F.lds + MISC_OFF + 64), (const bf16*)(F.ws + WS_HB), (const bf16*)(F.ws + WS_W2 + (size_t)l * NE * DM * DE), F.G, (int)blockIdx.x, ready, (unsigned*)(F.ws + WS_CTL) + CW_TMO, F.wave};
            pg8::EpiY E{(bf16*)(F.ws + WS_Y)};
            DUP(8) pg8::gemm_phase<pg8::EpiY, pg8::SchedG2, true, true>(F.lds, DE / 2, S, E, F.wave);
        }
    }
    SEAM(pb + 6);
    relaunder(F);
    if (EN(8) && IN(pb + 7)) { moe_table(F, l); DUP(l == 0 ? 9 : 99) combine_phase(F, l); }
    SEAM(pb + 7);
}
__global__ void __launch_bounds__(NTHREADS, 2) fwd_kernel(Params args) {
    extern __shared__ __attribute__((aligned(16))) unsigned char lds_raw[];
    Frame F;
    F.lds = (LAS unsigned char*)lds_raw; F.MISC = (volatile LAS unsigned*)(F.lds + MISC_OFF);
    F.tid = threadIdx.x; F.lane = F.tid & 63; F.wave = __builtin_amdgcn_readfirstlane(F.tid >> 6);
    F.G = gridDim.x; { const int bx = blockIdx.x; F.vcu = (F.G % 8 == 0) ? (bx % 8) * (F.G / 8) + bx / 8 : bx; }
    F.in = args.in; F.out = args.out; F.ws = args.ws;
    for (int u = F.tid; u < (LDS_BYTES - MISC_OFF) / 4; u += NTHREADS) ((LAS unsigned*)(F.lds + MISC_OFF))[u] = 0u;
    __syncthreads();
    unsigned* ctl = (unsigned*)(args.ws + WS_CTL);
    const int lo = args.ph_lo, hi = args.ph_hi;
    const bool multi = (hi - lo) > 1;
    XcdBarrier bar; bar.bar = ctl + CW_BAR; bar.x = 0; bar.st = nullptr; bar.lead = 0;
    if (multi) bar = xcd_barrier_post(ctl + CW_BAR, F.MISC, F.wave == 0 ? 1u : 0u);
    if (PROBE_STAMP >= 0 && blockIdx.x == 0 && F.tid == 0) { const unsigned long long _t = wall_clock64(); F.MISC[800] = (unsigned)_t; F.MISC[801] = (unsigned)(_t >> 32); }
    if (EN(0) && IN(0)) { DUP(10) p_prologue(F); }
    SEAM(0);
    layer_phases<0>(F, bar, lo, hi);
    layer_phases<1>(F, bar, lo, hi);
    if (PROBE_STAMP >= 0 && blockIdx.x == 0 && F.tid == 0) {
        asm volatile("s_waitcnt vmcnt(0)" ::: "memory");
        constexpr int SB = PROBE_STAMP >= 100 ? 900 + 2 * (PROBE_STAMP - 100) : (PROBE_STAMP == 6 ? 810 : 800 + 2 * PROBE_STAMP);
        constexpr int SB1 = (PROBE_STAMP == 6) ? SB + 4 : SB + 2;
        const unsigned long long t1 = ((unsigned long long)F.MISC[SB1 + 1] << 32) | F.MISC[SB1], t0 = ((unsigned long long)F.MISC[SB + 1] << 32) | F.MISC[SB];
        F.out[0] += (float)(long long)(t1 - t0) * 0.01f;
    }
}
#undef IN
#undef EN
#undef SEAM
#undef DUP

extern "C" void kernel_launch(void* const* d_in, const int* in_sizes, int n_in, void* d_out, int out_size, void* d_ws, size_t ws_size, hipStream_t stream) {
    static int grid = 0;
    if (grid == 0) {
        if (n_in != 22 || out_size != SEQ * DM || ws_size < WS_END) { fprintf(stderr, "kernel_launch: unexpected shapes (n_in %d out %d ws %zu, need %zu)\n", n_in, out_size, ws_size, (size_t)WS_END); grid = -1; return; }
        int dev = 0, cus = 0, per_cu = 0;
        if (hipGetDevice(&dev) != hipSuccess || hipDeviceGetAttribute(&cus, hipDeviceAttributeMultiprocessorCount, dev) != hipSuccess) { grid = -1; return; }
        if (hipFuncSetAttribute((const void*)fwd_kernel, hipFuncAttributeMaxDynamicSharedMemorySize, LDS_BYTES) != hipSuccess) { fprintf(stderr, "kernel_launch: hipFuncSetAttribute failed\n"); grid = -1; return; }
        if (hipOccupancyMaxActiveBlocksPerMultiprocessor(&per_cu, (const void*)fwd_kernel, NTHREADS, LDS_BYTES) != hipSuccess || per_cu < 1) { fprintf(stderr, "kernel_launch: occupancy query says %d\n", per_cu); }
        (void)hipGetLastError();
        grid = cus;
    }
    if (grid < 0) return;
    if (hipMemsetAsync((char*)d_ws + WS_CTL, 0, CTL_ZERO_BYTES, stream) != hipSuccess) return;
    Params p{};
    for (int i = 0; i < 22; ++i) p.in[i] = (const float*)d_in[i];
    p.out = (float*)d_out; p.ws = (unsigned char*)d_ws;
    constexpr int NL = MK_N_LAUNCHES;
    for (int li = 0; li < NL; ++li) {
        p.ph_lo = (NL == 1) ? 0 : li; p.ph_hi = (NL == 1) ? N_PHASES : li + 1;
        hipLaunchKernelGGL(fwd_kernel, dim3(grid), dim3(NTHREADS), LDS_BYTES, stream, p);
        if (hipPeekAtLastError() != hipSuccess) { fprintf(stderr, "kernel_launch: launch %d failed\n", li); break; }
    }
}
```

```cpp
#include <hip/hip_runtime.h>
#include <cstdio>
#include <cstdint>

#ifndef MK_N_LAUNCHES
#define MK_N_LAUNCHES 1
#endif

#ifndef OUTPROJ_FP8
#define OUTPROJ_FP8 2
#endif
#ifndef ATT_EXP
#define ATT_EXP 0
#endif
#define OP8(l) ((OUTPROJ_FP8 >> (l)) & 1)
#ifndef INPROJ_FP8
#define INPROJ_FP8 2
#endif
#define IP8(l) ((INPROJ_FP8 >> (l)) & 1)
#define GAS __attribute__((address_space(1)))
#define LAS __attribute__((address_space(3)))
typedef unsigned short bf16;
typedef short bf16x8 __attribute__((ext_vector_type(8)));
typedef short s16x4 __attribute__((ext_vector_type(4)));
typedef float f32x4 __attribute__((ext_vector_type(4)));
typedef float f32x2 __attribute__((ext_vector_type(2)));
typedef unsigned u32x4 __attribute__((ext_vector_type(4)));
typedef unsigned u32x2 __attribute__((ext_vector_type(2)));

constexpr int SEQ = 16384, DM = 2048, DIN = 5120, NLAYER = 2;
constexpr int HD = 128, NHEAD = 8, CONV_K = 31;
constexpr int NE = 32, DE = 512, TOKCAP = 16384;
constexpr int OFF_U = 0, OFF_V = 512, OFF_A = 1024, OFF_G = 1536, OFF_Q = 2048, OFF_K = 3072, OFF_VV = 4096;
constexpr float EPS = 1e-6f;
constexpr float W1_SCALE = 64.f, W2_SCALE = 32.f, WOUT_SCALE = 64.f, WIN_SCALE = 64.f, Y_SCALE = 16.f;
constexpr int NWAVES = 8, NTHREADS = 512;

constexpr size_t MiB = 1u << 20;
constexpr size_t WS_CTL = 0, CTL_ZERO_BYTES = 1 * MiB;
constexpr size_t WS_WIN = 1 * MiB;
constexpr size_t WS_WOUT = 41 * MiB;
constexpr size_t WS_W1 = 57 * MiB;
constexpr size_t WS_X8 = 185 * MiB;
constexpr size_t WS_W2 = 313 * MiB;
constexpr size_t WS_SGUW = 441 * MiB;
constexpr size_t WS_WRT = 442 * MiB;
constexpr size_t WS_TOK = 443 * MiB;
constexpr size_t WS_TINFO = 445 * MiB;
constexpr size_t WS_HN = 446 * MiB;
constexpr size_t WS_HB = 510 * MiB;
constexpr size_t WS_ATT = WS_HN;
constexpr size_t WS_LSE = WS_HN + 96 * MiB;
constexpr size_t WS_PROJ = 550 * MiB;
constexpr size_t WS_Y = WS_PROJ;
constexpr size_t WS_MIX = 710 * MiB;
constexpr size_t WS_H = 774 * MiB;
constexpr size_t WS_RSLOT = 902 * MiB;
constexpr size_t WS_ALT = 904 * MiB;
constexpr size_t WS_END = 910 * MiB;
constexpr int CW_BAR = 4096;
constexpr int CW_TMO = 0;
constexpr int CW_RDY = 65536;
constexpr int CW_CNT = 16384, CNT_STRIDE = 64;

constexpr int LDS_BYTES = 163840;
constexpr int MISC_OFF = 159744;

__device__ __forceinline__ unsigned cvt_pk_bf16(float lo, float hi) { unsigned r; asm volatile("v_cvt_pk_bf16_f32 %0, %1, %2" : "=v"(r) : "v"(lo), "v"(hi)); return r; }
__device__ __forceinline__ unsigned pk4_fp8(float a, float b, float c, float d) { int p = 0; p = __builtin_amdgcn_cvt_pk_fp8_f32(a, b, p, false); p = __builtin_amdgcn_cvt_pk_fp8_f32(c, d, p, true); return (unsigned)p; }
__device__ __forceinline__ float bf_lo(unsigned u) { return __builtin_bit_cast(float, u << 16); }
__device__ __forceinline__ float bf_hi(unsigned u) { return __builtin_bit_cast(float, u & 0xffff0000u); }
template <int CTRL, int RM> __device__ __forceinline__ float dpp_mov0(float v) { return __builtin_bit_cast(float, __builtin_amdgcn_update_dpp(0, __builtin_bit_cast(int, v), CTRL, RM, 0xf, false)); }
__device__ __forceinline__ float wave_sum(float s) {
    s += dpp_mov0<0xB1, 0xf>(s); s += dpp_mov0<0x4E, 0xf>(s); s += dpp_mov0<0x141, 0xf>(s); s += dpp_mov0<0x140, 0xf>(s);
    s += dpp_mov0<0x142, 0xa>(s); s += dpp_mov0<0x143, 0xc>(s);
    return __builtin_bit_cast(float, __builtin_amdgcn_readlane(__builtin_bit_cast(int, s), 63));
}
__device__ __forceinline__ float row16_sum(float s) {
    s += dpp_mov0<0xB1, 0xf>(s); s += dpp_mov0<0x4E, 0xf>(s); s += dpp_mov0<0x141, 0xf>(s); s += dpp_mov0<0x140, 0xf>(s); return s;
}
__device__ __forceinline__ float sum4(float x) {
    const unsigned xu = __builtin_bit_cast(unsigned, x); const auto r = __builtin_amdgcn_permlane16_swap(xu, xu, false, false); const unsigned r0 = r[0], r1 = r[1];
    const float a = __builtin_bit_cast(float, r0) + __builtin_bit_cast(float, r1);
    const unsigned au = __builtin_bit_cast(unsigned, a); const auto q = __builtin_amdgcn_permlane32_swap(au, au, false, false); const unsigned q0 = q[0], q1 = q[1];
    return __builtin_bit_cast(float, q0) + __builtin_bit_cast(float, q1);
}
__device__ __forceinline__ float max4(float x) {
    const unsigned xu = __builtin_bit_cast(unsigned, x); const auto r = __builtin_amdgcn_permlane16_swap(xu, xu, false, false); const unsigned r0 = r[0], r1 = r[1];
    const float a = fmaxf(__builtin_bit_cast(float, r0), __builtin_bit_cast(float, r1));
    const unsigned au = __builtin_bit_cast(unsigned, a); const auto q = __builtin_amdgcn_permlane32_swap(au, au, false, false); const unsigned q0 = q[0], q1 = q[1];
    return fmaxf(__builtin_bit_cast(float, q0), __builtin_bit_cast(float, q1));
}
__device__ __forceinline__ int lane_now() { int l; asm volatile("v_mbcnt_lo_u32_b32 %0, -1, 0\n\tv_mbcnt_hi_u32_b32 %0, -1, %0" : "=v"(l)); return l; }
#define LDS_WAIT() asm volatile("s_waitcnt lgkmcnt(0)" ::: "memory")
#define VM_WAIT() asm volatile("s_waitcnt vmcnt(0)" ::: "memory")
__device__ __forceinline__ float fast_exp(float x) { return __builtin_amdgcn_exp2f(x * 1.4426950408889634f); }
__device__ __forceinline__ float sigmoidf_(float x) { return __builtin_amdgcn_rcpf(1.0f + fast_exp(-x)); }
__device__ __forceinline__ float gelu_tanh(float x) { const float z = 1.5957691216057308f * (x + 0.044715f * x * x * x); return x * sigmoidf_(z); }

#define XB_TMO      128
#define XB_XCNT(j)  (256  + 64 * (j))
#define XB_XSUB(j)  (1280 + 64 * (j))
#define XB_XGEN(j)  (2304 + 64 * (j))
#define XB_TOP      3328
#define XB_TOPGEN   3392
#define XCD_BAR_WORDS 3456
#define XB_SPIN_CAP (1u << 22)
__device__ __forceinline__ unsigned xb_ld(unsigned* p)              { return __hip_atomic_load(p, __ATOMIC_RELAXED, __HIP_MEMORY_SCOPE_AGENT); }
__device__ __forceinline__ unsigned xb_add(unsigned* p, unsigned v) { return __hip_atomic_fetch_add(p, v, __ATOMIC_RELAXED, __HIP_MEMORY_SCOPE_AGENT); }
__device__ __forceinline__ unsigned xb_xcc_id() { return (unsigned)__builtin_amdgcn_s_getreg((3 << 11) | 20) & 0xFu; }
#define XB_SPIN(cond, bar) do { unsigned _sp = 0; while (cond) { __builtin_amdgcn_s_sleep(1); \
    if ((++_sp & 255u) == 0u) { if (xb_ld(&(bar)[XB_TMO])) break; if (_sp > XB_SPIN_CAP) { atomicAdd(&(bar)[XB_TMO], 1u); break; } } } } while (0)
struct XcdBarrier { unsigned* bar; unsigned x; volatile LAS unsigned* st; unsigned lead; };
__device__ __forceinline__ XcdBarrier xcd_barrier_post(unsigned* bar, volatile LAS unsigned* st, unsigned lead) {
    XcdBarrier b; b.bar = bar; b.x = xb_xcc_id(); b.st = st; b.lead = lead;
    if (lead && lane_now() == 0) (void)xb_add(&bar[XB_XCNT(b.x)], 1u);
    return b;
}
__device__ __forceinline__ void xcd_barrier_complete(unsigned* bar, unsigned x, unsigned& nloc, unsigned& nx) {
    const unsigned G = gridDim.x * gridDim.y * gridDim.z;
    unsigned sum, cnt, mine, sp = 0u;
    for (;;) {
        sum = 0u; cnt = 0u; mine = 0u;
#pragma unroll
        for (unsigned j = 0; j < 16; ++j) { const unsigned c = xb_ld(&bar[XB_XCNT(j)]); sum += c; cnt += (c > 0u) ? 1u : 0u; mine = (j == x) ? c : mine; }
        if (sum == G) break;
        __builtin_amdgcn_s_sleep(1);
        if ((++sp & 255u) == 0u) { if (xb_ld(&bar[XB_TMO])) break; if (sp > XB_SPIN_CAP) { atomicAdd(&bar[XB_TMO], 1u); break; } }
    }
    nloc = mine > 0u ? mine : 1u; nx = cnt > 0u ? cnt : 1u;
}
__device__ __forceinline__ void xcd_barrier(const XcdBarrier& b) {
    asm volatile("s_waitcnt vmcnt(0)" ::: "memory");
    __syncthreads();
    if (b.lead && lane_now() == 0) {
        unsigned* bar = b.bar;
        __builtin_amdgcn_s_waitcnt(0);
        unsigned nloc = b.st[0], nx = b.st[1];
        if (nloc == 0u) { xcd_barrier_complete(bar, b.x, nloc, nx); b.st[0] = nloc; b.st[1] = nx; }
        const unsigned old = xb_add(&bar[XB_XSUB(b.x)], 1u);
        const unsigned gen = old / nloc;
        if (old + 1u == (gen + 1u) * nloc) {
            __builtin_amdgcn_fence(__ATOMIC_RELEASE, "agent");
            asm volatile("s_waitcnt vmcnt(0)" ::: "memory");
            const unsigned og = xb_add(&bar[XB_TOP], 1u);
            const unsigned tg = og / nx;
            if (og + 1u == (tg + 1u) * nx) xb_add(&bar[XB_TOPGEN], 1u);
            else XB_SPIN(xb_ld(&bar[XB_TOPGEN]) == tg, bar);
            __builtin_amdgcn_fence(__ATOMIC_ACQUIRE, "agent");
            xb_add(&bar[XB_XGEN(b.x)], 1u);
            asm volatile("s_waitcnt vmcnt(0)" ::: "memory");
        } else {
            XB_SPIN(xb_ld(&bar[XB_XGEN(b.x)]) == gen, bar);
            __builtin_amdgcn_fence(__ATOMIC_ACQUIRE, "agent");
            asm volatile("s_waitcnt vmcnt(0)" ::: "memory");
        }
    }
    __syncthreads();
}

namespace pg8 {
constexpr int BM = 256, BK = 64, HALF = 128, HTB = HALF * BK * 2, STAGE_BYTES = 8 * HTB, NXCD = 8, WGM = 8;
__device__ __forceinline__ int lds_byte(int r, int c) { const int st = (r >> 4) * 2 + (c >> 5), rr = r & 15, cc = c & 31, ob = rr * 64 + cc * 2; return st * 1024 + (ob ^ (((ob >> 9) & 1) << 5)); }
__device__ __forceinline__ void stage_rc(int b, int& R, int& C) { const int st = b / 1024, sb = b % 1024, swz = sb ^ (((sb >> 9) & 1) << 5); R = (st >> 1) * 16 + swz / 64; C = (st & 1) * 32 + (swz % 64) / 2; }
__device__ __forceinline__ int perm32(int rho) { const int n = rho >> 4, i = rho & 15; return 8 * (i >> 2) + 4 * n + (i & 3); }

struct Unit { int pm, pn, e, rb; };

struct StaticSched {
    static constexpr bool GATHER = false;
    const bf16* A; const bf16* Bt; int K; int nM, nN, nwg, G, c;
    __device__ __forceinline__ void init(const bf16* A_, const bf16* Bt_, int M, int N, int K_, int G_, int c_) { A = A_; Bt = Bt_; K = K_; nM = M / BM; nN = N / BM; nwg = nM * nN; G = G_; c = c_; }
    __device__ __forceinline__ bool next(int i, Unit& u) const {
        const long L = (long)i * G + c; if (L >= nwg) return false;
        int wgid = (int)L; { const int q = nwg / NXCD, r = nwg % NXCD, xcd = wgid % NXCD, off = wgid / NXCD; wgid = (xcd < r ? xcd * (q + 1) : r * (q + 1) + (xcd - r) * q) + off; }
        const int nig = WGM * nN, gid = wgid / nig, fm = gid * WGM, gsz = (nM - fm) < WGM ? (nM - fm) : WGM;
        u.pm = fm + ((wgid % nig) % gsz); u.pn = (wgid % nig) / gsz; u.e = 0; u.rb = 0; return true;
    }
    __device__ __forceinline__ void a_ready(const Unit&) const {}
    __device__ __forceinline__ void done(const Unit&) const {}
    __device__ __forceinline__ const char* a_base(const Unit& u) const { return (const char*)A + (size_t)u.pm * BM * K * 2; }
    __device__ __forceinline__ const char* b_base(const Unit& u) const { return (const char*)Bt + (size_t)u.pn * BM * K * 2; }
    __device__ __forceinline__ void a_voff(const Unit&, const int (&R)[2], const int (&C)[2], unsigned (&v)[2][2]) const {
#pragma unroll
        for (int h = 0; h < 2; ++h)
#pragma unroll
            for (int i = 0; i < 2; ++i) v[h][i] = (unsigned)((h * HALF + R[i]) * K + C[i]) * 2u;
    }
};

typedef int v8i __attribute__((ext_vector_type(8)));
typedef int v4i __attribute__((ext_vector_type(4)));
template <class Epi, class Sched, bool ALIGN_EPI = true, bool FP8 = false>
__device__ __forceinline__ void gemm_phase(LAS unsigned char* lds, const int K, const Sched& S, const Epi& E, const int wave) {
    const int lane = lane_now(), wid = wave, tid = wid * 64 + lane,
              wr = wid >> 2, wc = wid & 3, fr = lane & 15, fq = lane >> 4;
    const int nt = K / BK;
    int Rr[2], Cc[2]; unsigned voffB[2];
#pragma unroll
    for (int i = 0; i < 2; ++i) { stage_rc(tid * 16 + i * 8192, Rr[i], Cc[i]); const int Rb = Epi::PERM ? ((Rr[i] & ~31) + perm32(Rr[i] & 31)) : Rr[i];
        voffB[i] = (unsigned)(Rb * K + Cc[i]) * 2u; }
    const size_t kstep = (size_t)(BK * 2);
    const size_t hstep = (size_t)HALF * K * 2;
    const unsigned ldsw = (unsigned)wid * 1024u;
    const unsigned ldsbase = (unsigned)__builtin_amdgcn_readfirstlane((int)(unsigned)(size_t)lds);
    const int aoff = lds_byte(wr * 64 + fr, fq * 8), boff = lds_byte(wc * 32 + fr, fq * 8);
#define PG8_SA(b, h) (((b) * 2 + (h)) * HTB)
#define PG8_SB(b, h) ((4 + (b) * 2 + (h)) * HTB)
#define PG8_STAGE(bufoff, gbase, voff) do { _Pragma("unroll") for (int _i = 0; _i < 2; ++_i) { unsigned _keep; \
        asm volatile("s_mov_b32 %0, m0\n\ts_mov_b32 m0, %3\n\ts_nop 0\n\tglobal_load_lds_dwordx4 %1, %2\n\ts_mov_b32 m0, %0" : "=&s"(_keep) : "v"((voff)[_i]), "s"((const char*)(gbase)), "s"(ldsbase + (unsigned)(bufoff) + ldsw + (unsigned)(_i * 8192)) : "memory"); } } while (0)
#define PG8_LDA(dst, b, h) do { _Pragma("unroll") for (int m = 0; m < 4; ++m) _Pragma("unroll") for (int k = 0; k < 2; ++k) dst[m][k] = *(const LAS bf16x8*)(lds + PG8_SA(b, h) + aoff + m * 2048 + k * 1024); } while (0)
#define PG8_LDB(dst, b, h) do { _Pragma("unroll") for (int n = 0; n < 2; ++n) _Pragma("unroll") for (int k = 0; k < 2; ++k) dst[n][k] = *(const LAS bf16x8*)(lds + PG8_SB(b, h) + boff + n * 2048 + k * 1024); } while (0)
#define PG8_LDA8(dst, b, h) do { _Pragma("unroll") for (int m = 0; m < 4; ++m) { const v4i lo_ = *(const LAS v4i*)(lds + PG8_SA(b, h) + aoff + m * 2048), hi_ = *(const LAS v4i*)(lds + PG8_SA(b, h) + aoff + m * 2048 + 1024); dst[m] = __builtin_shufflevector(lo_, hi_, 0, 1, 2, 3, 4, 5, 6, 7); } } while (0)
#define PG8_LDB8(dst, b, h) do { _Pragma("unroll") for (int n = 0; n < 2; ++n) { const v4i lo_ = *(const LAS v4i*)(lds + PG8_SB(b, h) + boff + n * 2048), hi_ = *(const LAS v4i*)(lds + PG8_SB(b, h) + boff + n * 2048 + 1024); dst[n] = __builtin_shufflevector(lo_, hi_, 0, 1, 2, 3, 4, 5, 6, 7); } } while (0)
#define PG8_MMA(ai, bj, At, Bt) do { __builtin_amdgcn_s_setprio(1); _Pragma("unroll") for (int m = 0; m < 4; ++m) _Pragma("unroll") for (int n = 0; n < 2; ++n) _Pragma("unroll") for (int k = 0; k < 2; ++k) \
        acc[ai][bj][m][n] = __builtin_amdgcn_mfma_f32_16x16x32_bf16(Bt[n][k], At[m][k], acc[ai][bj][m][n], 0, 0, 0); __builtin_amdgcn_s_setprio(0); } while (0)
#define PG8_MMA8(ai, bj, At, Bt) do { __builtin_amdgcn_s_setprio(1); _Pragma("unroll") for (int m = 0; m < 4; ++m) _Pragma("unroll") for (int n = 0; n < 2; ++n) \
        acc[ai][bj][m][n] = __builtin_amdgcn_mfma_scale_f32_16x16x128_f8f6f4(Bt[n], At[m], acc[ai][bj][m][n], 0, 0, 0, 0, 0, 0); __builtin_amdgcn_s_setprio(0); } while (0)
#define LDA_(b, h) do { if constexpr (FP8) PG8_LDA8(At8, b, h); else PG8_LDA(At, b, h); } while (0)
#define LDB0_(b, h) do { if constexpr (FP8) PG8_LDB8(B08, b, h); else PG8_LDB(B0, b, h); } while (0)
#define LDB1_(b, h) do { if constexpr (FP8) PG8_LDB8(B18, b, h); else PG8_LDB(B1, b, h); } while (0)
#define MMA0_(ai, bj) do { if constexpr (FP8) PG8_MMA8(ai, bj, At8, B08); else PG8_MMA(ai, bj, At, B0); } while (0)
#define MMA1_(ai, bj) do { if constexpr (FP8) PG8_MMA8(ai, bj, At8, B18); else PG8_MMA(ai, bj, At, B1); } while (0)
#define PG8_WAIT_V(n) asm volatile("s_waitcnt vmcnt(" #n ")" ::: "memory")
#define PG8_WAIT_L(n) asm volatile("s_waitcnt lgkmcnt(" #n ")" ::: "memory")
#define PG8_BAR __builtin_amdgcn_s_barrier()
#define PG8_SCHED __builtin_amdgcn_sched_barrier(0)
    Unit cur, nxt; int ui = 0;
    if (!S.next(0, cur)) return;
    f32x4 acc[2][2][4][2];
#pragma unroll
    for (int a = 0; a < 2; ++a)
#pragma unroll
        for (int b = 0; b < 2; ++b)
#pragma unroll
            for (int m = 0; m < 4; ++m)
#pragma unroll
                for (int n = 0; n < 2; ++n) acc[a][b][m][n] = (f32x4){0.f, 0.f, 0.f, 0.f};
    bf16x8 At[4][2], B0[2][2], B1[2][2]; v8i At8[4], B08[2], B18[2];
    const char* cA = S.a_base(cur); const char* cB = S.b_base(cur);
    S.a_ready(cur);
    constexpr bool GATHER = Sched::GATHER;
    unsigned vA[1][2];
    LAS unsigned* goff = (LAS unsigned*)(lds + STAGE_BYTES) + tid;
    int gslot = 0;
    constexpr bool LOFF = GATHER || FP8;
    if constexpr (!GATHER && FP8) { goff[8 * 512] = voffB[0]; goff[9 * 512] = voffB[1]; goff[10 * 512] = (unsigned)(Rr[0] * K + Cc[0]) * 2u; goff[11 * 512] = (unsigned)(Rr[1] * K + Cc[1]) * 2u; }
    if constexpr (GATHER) { unsigned t4[2][2]; S.a_voff(cur, Rr, Cc, t4); goff[0 * 512] = t4[0][0]; goff[1 * 512] = t4[0][1]; goff[2 * 512] = t4[1][0]; goff[3 * 512] = t4[1][1]; goff[8 * 512] = voffB[0]; goff[9 * 512] = voffB[1]; }
    else {
#pragma unroll
        for (int i = 0; i < 2; ++i) vA[0][i] = (unsigned)(Rr[i] * K + Cc[i]) * 2u; }
    const size_t ahstep = GATHER ? 0 : hstep;
#define PG8_STAGE_B(bufoff, kptr) do { if constexpr (LOFF) { unsigned _o[2]; _o[0] = goff[8 * 512]; _o[1] = goff[9 * 512]; PG8_STAGE(bufoff, kptr, _o); } else PG8_STAGE(bufoff, kptr, voffB); } while (0)
#define PG8_STAGE_A(bufoff, kptr, h, nx) do { if constexpr (GATHER) { unsigned _o[2]; const int _s = (gslot ^ (nx)) * 2048 + (h) * 1024; _o[0] = goff[_s]; _o[1] = goff[_s + 512]; PG8_STAGE(bufoff, kptr, _o); } \
        else if constexpr (FP8) { unsigned _o[2]; _o[0] = goff[10 * 512]; _o[1] = goff[11 * 512]; PG8_STAGE(bufoff, (kptr) + (h) * ahstep, _o); } \
        else PG8_STAGE(bufoff, (kptr) + (h) * ahstep, vA[0]); } while (0)
    PG8_STAGE(PG8_SB(0, 0), cB, voffB); PG8_STAGE(PG8_SB(0, 1), cB + hstep, voffB); PG8_STAGE_A(PG8_SA(0, 0), cA, 0, 0); PG8_STAGE_A(PG8_SA(0, 1), cA, 1, 0);
    if (wr == 1) PG8_BAR;
    PG8_WAIT_V(2); PG8_BAR;
    PG8_STAGE(PG8_SB(1, 0), cB + kstep, voffB); PG8_STAGE_A(PG8_SA(1, 0), cA + kstep, 0, 0); PG8_STAGE(PG8_SB(1, 1), cB + hstep + kstep, voffB);
    PG8_WAIT_V(6); PG8_BAR;
    for (;;) {
        const bool has_next = S.next(ui + 1, nxt);
        const char* nA = has_next ? S.a_base(nxt) : cA; const char* nB = has_next ? S.b_base(nxt) : cB;
        if constexpr (GATHER) { if (has_next) { unsigned t4[2][2]; int tl_ = tid; asm volatile("" : "+v"(tl_)); int R2[2], C2[2]; stage_rc(tl_ * 16, R2[0], C2[0]); stage_rc(tl_ * 16 + 8192, R2[1], C2[1]); S.a_voff(nxt, R2, C2, t4); const int o = (gslot ^ 1) * 2048; goff[o] = t4[0][0]; goff[o + 512] = t4[0][1]; goff[o + 1024] = t4[1][0]; goff[o + 1536] = t4[1][1]; } }
#pragma unroll 1
        for (int t = 0; t < nt; t += 2) {
            const bool last = (t == nt - 2);
            const char* a1 = cA + (size_t)(t + 1) * kstep;
            const char* a2 = last ? nA : cA + (size_t)(t + 2) * kstep; const char* b2 = last ? nB : cB + (size_t)(t + 2) * kstep;
            const char* a3 = a2 + kstep; const char* b3 = b2 + kstep;
            if (last && has_next) S.a_ready(nxt);
            const int nx = (last && has_next) ? 1 : 0;
            LDB0_(0, 0); LDB1_(0, 1); PG8_SCHED; LDA_(0, 0); PG8_STAGE_A(PG8_SA(1, 1), a1, 1, 0);
            PG8_WAIT_V(8); PG8_WAIT_L(0); PG8_BAR; MMA0_(0, 0); MMA1_(0, 1); PG8_BAR; PG8_SCHED;
            LDA_(0, 1); PG8_STAGE_B(PG8_SB(0, 0), b2); PG8_STAGE_B(PG8_SB(0, 1), b2 + hstep); PG8_STAGE_A(PG8_SA(0, 0), a2, 0, nx);
            PG8_WAIT_V(8); PG8_WAIT_L(0); PG8_BAR; MMA0_(1, 0); MMA1_(1, 1); PG8_BAR; PG8_SCHED;
            LDB0_(1, 0); LDB1_(1, 1); PG8_SCHED; LDA_(1, 0); PG8_STAGE_A(PG8_SA(0, 1), a2, 1, nx);
            PG8_WAIT_V(8); PG8_WAIT_L(0); PG8_BAR; MMA0_(0, 0); MMA1_(0, 1); PG8_BAR; PG8_SCHED;
            LDA_(1, 1); PG8_STAGE_B(PG8_SB(1, 0), b3); PG8_STAGE_B(PG8_SB(1, 1), b3 + hstep); PG8_STAGE_A(PG8_SA(1, 0), a3, 0, nx);
            PG8_WAIT_V(8); PG8_WAIT_L(0); PG8_BAR; MMA0_(1, 0); MMA1_(1, 1); PG8_BAR; PG8_SCHED;
        }
        if constexpr (ALIGN_EPI) { if (wr == 0) PG8_BAR; }
        { int fr2 = fr, fq2 = fq; asm volatile("" : "+v"(fr2), "+v"(fq2));
          E(acc, cur, wr, wc, fr2, fq2); } S.done(cur);
        if (!has_next) break;
#pragma unroll
        for (int a = 0; a < 2; ++a)
#pragma unroll
            for (int b = 0; b < 2; ++b)
#pragma unroll
                for (int m = 0; m < 4; ++m)
#pragma unroll
                    for (int n = 0; n < 2; ++n) acc[a][b][m][n] = (f32x4){0.f, 0.f, 0.f, 0.f};
        cur = nxt; cA = nA; cB = nB; ++ui;
        if constexpr (GATHER) gslot ^= 1;
        if constexpr (ALIGN_EPI) { if (wr == 1) PG8_BAR; }
    }
    PG8_WAIT_V(0);
    if constexpr (!ALIGN_EPI) { if (wr == 0) PG8_BAR; }
    PG8_BAR;
#undef PG8_SA
#undef PG8_SB
#undef PG8_STAGE
#undef PG8_STAGE_A
#undef PG8_STAGE_B
#undef PG8_LDA
#undef PG8_LDB
#undef PG8_MMA
#undef PG8_MMA8
#undef PG8_LDA8
#undef PG8_LDB8
#undef LDA_
#undef LDB0_
#undef LDB1_
#undef MMA0_
#undef MMA1_
#undef PG8_WAIT_V
#undef PG8_WAIT_L
#undef PG8_BAR
#undef PG8_SCHED
}

struct EpiProj {
    static constexpr bool PERM = true;
    bf16* O; float asc;
    __device__ __forceinline__ void operator()(const f32x4 (&acc)[2][2][4][2], const Unit& u, int wr, int wc, int fr, int fq) const {
        const int row0 = u.pm * BM + wr * 64 + fr, col0 = u.pn * BM + wc * 32 + 8 * fq;
        const bool act = u.pn < 4;
#pragma unroll
        for (int ai = 0; ai < 2; ++ai)
#pragma unroll
            for (int m = 0; m < 4; ++m) { bf16* rowp = O + (size_t)(row0 + ai * HALF + m * 16) * DIN + col0;
#pragma unroll
                for (int bj = 0; bj < 2; ++bj) { f32x4 v0 = acc[ai][bj][m][0] * asc, v1 = acc[ai][bj][m][1] * asc;
                    if (act) {
#pragma unroll
                        for (int j = 0; j < 4; ++j) { v0[j] = gelu_tanh(v0[j]); v1[j] = gelu_tanh(v1[j]); } }
                    u32x4 w; w.x = cvt_pk_bf16(v0[0], v0[1]); w.y = cvt_pk_bf16(v0[2], v0[3]); w.z = cvt_pk_bf16(v1[0], v1[1]); w.w = cvt_pk_bf16(v1[2], v1[3]);
                    *(u32x4*)(rowp + bj * HALF) = w; } }
    }
};
template <bool RES_BF16> struct EpiResid {
    static constexpr bool PERM = true; static constexpr float ASC = OP8(RES_BF16 ? 1 : 0) ? 1.f / WOUT_SCALE : 1.f;
    const void* res; bf16* out;
    __device__ __forceinline__ void operator()(const f32x4 (&acc)[2][2][4][2], const Unit& u, int wr, int wc, int fr, int fq) const {
        const int row0 = u.pm * BM + wr * 64 + fr, col0 = u.pn * BM + wc * 32 + 8 * fq;
#pragma unroll
        for (int ai = 0; ai < 2; ++ai) {
            if constexpr (RES_BF16) {
                u32x4 r[4][2];
#pragma unroll
                for (int m = 0; m < 4; ++m)
#pragma unroll
                    for (int bj = 0; bj < 2; ++bj) r[m][bj] = *(const u32x4*)((const bf16*)res + (size_t)(row0 + ai * HALF + m * 16) * DM + col0 + bj * HALF);
                asm volatile("s_waitcnt vmcnt(0)" ::: "memory");
#pragma unroll
                for (int m = 0; m < 4; ++m)
#pragma unroll
                    for (int bj = 0; bj < 2; ++bj) { f32x4 v0 = acc[ai][bj][m][0] * ASC, v1 = acc[ai][bj][m][1] * ASC; const u32x4 q = r[m][bj];
                        v0[0] += bf_lo(q.x); v0[1] += bf_hi(q.x); v0[2] += bf_lo(q.y); v0[3] += bf_hi(q.y); v1[0] += bf_lo(q.z); v1[1] += bf_hi(q.z); v1[2] += bf_lo(q.w); v1[3] += bf_hi(q.w);
                        u32x4 w; w.x = cvt_pk_bf16(v0[0], v0[1]); w.y = cvt_pk_bf16(v0[2], v0[3]); w.z = cvt_pk_bf16(v1[0], v1[1]); w.w = cvt_pk_bf16(v1[2], v1[3]);
                        *(u32x4*)(out + (size_t)(row0 + ai * HALF + m * 16) * DM + col0 + bj * HALF) = w; }
            } else {
#pragma unroll
                for (int mh = 0; mh < 2; ++mh) {
                    f32x4 r[2][2][2];
#pragma unroll
                    for (int m = 0; m < 2; ++m)
#pragma unroll
                        for (int bj = 0; bj < 2; ++bj) { const float* rp = (const float*)res + (size_t)(row0 + ai * HALF + (2 * mh + m) * 16) * DM + col0 + bj * HALF; r[m][bj][0] = *(const f32x4*)rp; r[m][bj][1] = *(const f32x4*)(rp + 4); }
                    asm volatile("s_waitcnt vmcnt(0)" ::: "memory");
#pragma unroll
                    for (int m = 0; m < 2; ++m)
#pragma unroll
                        for (int bj = 0; bj < 2; ++bj) { const f32x4 v0 = acc[ai][bj][2 * mh + m][0] * ASC + r[m][bj][0], v1 = acc[ai][bj][2 * mh + m][1] * ASC + r[m][bj][1];
                            u32x4 w; w.x = cvt_pk_bf16(v0[0], v0[1]); w.y = cvt_pk_bf16(v0[2], v0[3]); w.z = cvt_pk_bf16(v1[0], v1[1]); w.w = cvt_pk_bf16(v1[2], v1[3]);
                            *(u32x4*)(out + (size_t)(row0 + ai * HALF + (2 * mh + m) * 16) * DM + col0 + bj * HALF) = w; }
                }
            }
        }
    }
};
struct EpiSwiGLU {
    static constexpr bool PERM = true;
    unsigned char* HB; const float* rslot;
    __device__ __forceinline__ void operator()(const f32x4 (&acc)[2][2][4][2], const Unit& u, int wr, int wc, int fr, int fq) const {
        const int row0 = u.pm * BM + wr * 64 + fr, col0 = u.pn * HALF + wc * 32 + 8 * fq;
        const __amdgpu_buffer_rsrc_t rsrc = __builtin_amdgcn_make_buffer_rsrc((void*)HB, 0, 40960 * DE, 0x00020000);
        const float* rsl = rslot + (size_t)u.e * TOKCAP + u.rb * BM + wr * 64 + fr;
#pragma unroll
        for (int ai = 0; ai < 2; ++ai) {
            float rsv[4];
#pragma unroll
            for (int m = 0; m < 4; ++m) rsv[m] = rsl[ai * HALF + m * 16];
            asm volatile("s_waitcnt vmcnt(0)" ::: "memory");
#pragma unroll
            for (int m = 0; m < 4; ++m) { const unsigned boff = (unsigned)((row0 + ai * HALF + m * 16) * DE + col0);
                const float rs = rsv[m] * (1.f / W1_SCALE);
                float h[8];
#pragma unroll
                for (int n = 0; n < 2; ++n)
#pragma unroll
                    for (int j = 0; j < 4; ++j) { const float g = acc[ai][0][m][n][j] * rs, up = acc[ai][1][m][n][j] * rs; h[n * 4 + j] = g * sigmoidf_(g) * up; }
                u32x2 w; w.x = pk4_fp8(h[0], h[1], h[2], h[3]); w.y = pk4_fp8(h[4], h[5], h[6], h[7]);
                __builtin_amdgcn_raw_buffer_store_b64(w, rsrc, boff, 0, 16); } }
    }
};
struct EpiY {
    static constexpr bool PERM = true;
    unsigned char* Y;
    __device__ __forceinline__ void operator()(const f32x4 (&acc)[2][2][4][2], const Unit& u, int wr, int wc, int fr, int fq) const {
        const int row0 = u.pm * BM + wr * 64 + fr, col0 = u.pn * BM + wc * 32 + 8 * fq;
#pragma unroll
        for (int ai = 0; ai < 2; ++ai)
#pragma unroll
            for (int m = 0; m < 4; ++m) { unsigned char* rowp = Y + (size_t)(row0 + ai * HALF + m * 16) * DM + col0;
#pragma unroll
                for (int bj = 0; bj < 2; ++bj) { const f32x4 v0 = acc[ai][bj][m][0] * (Y_SCALE / W2_SCALE), v1 = acc[ai][bj][m][1] * (Y_SCALE / W2_SCALE);
                    u32x2 w; w.x = pk4_fp8(v0[0], v0[1], v0[2], v0[3]); w.y = pk4_fp8(v1[0], v1[1], v1[2], v1[3]);
                    *(u32x2*)(rowp + bj * HALF) = w; } }
    }
};

struct SchedG1 {
    static constexpr bool GATHER = true;
    const LAS int* tstart; const int* cnt; const int* tok; const bf16* X; const bf16* W1; int G, c; unsigned* ready;
    __device__ __forceinline__ void a_ready(const Unit&) const {}
    __device__ __forceinline__ void done(const Unit& u) const {
        asm volatile("s_waitcnt vmcnt(0)" ::: "memory");
        if (lane_now() == 0) __hip_atomic_fetch_add(ready + 64 * u.pm, 1u, __ATOMIC_RELAXED, __HIP_MEMORY_SCOPE_AGENT);
    }
    __device__ __forceinline__ bool next(int i, Unit& u) const {
        const int L = i * G + c, NT = __builtin_amdgcn_readfirstlane(tstart[NE]); if (L >= NT * 4) return false;
        const int T = L >> 2; const int e = tstart[560 + T];
        u.pm = __builtin_amdgcn_readfirstlane(T); u.pn = L & 3; u.e = __builtin_amdgcn_readfirstlane(e); u.rb = __builtin_amdgcn_readfirstlane(T - tstart[e]); return true;
    }
    static constexpr int KU = DM / 2;
    __device__ __forceinline__ const char* a_base(const Unit&) const { return (const char*)X; }
    __device__ __forceinline__ const char* b_base(const Unit& u) const { return (const char*)W1 + ((size_t)u.e * 1024 + (size_t)u.pn * BM) * DM; }
    __device__ __forceinline__ void a_voff(const Unit& u, const int (&R)[2], const int (&C)[2], unsigned (&v)[2][2]) const {
        const int n = cnt[u.e * 64]; const int* tl = tok + (size_t)u.e * TOKCAP;
#pragma unroll
        for (int h = 0; h < 2; ++h)
#pragma unroll
            for (int i = 0; i < 2; ++i) { int row = u.rb * BM + h * HALF + R[i]; row = row < n ? row : 0; const int t = tl[row]; v[h][i] = (unsigned)(t * KU + C[i]) * 2u; }
    }
};
struct SchedG2 {
    static constexpr bool GATHER = false;
    const LAS int* tstart; const bf16* HB; const bf16* W2; int G, c; unsigned* ready; unsigned* tmo; int wave;
    __device__ __forceinline__ bool next(int i, Unit& u) const {
        constexpr int K0 = 3;
        const int NT = __builtin_amdgcn_readfirstlane(tstart[NE]), n1 = 4 * NT, n1max = (n1 + G - 1) / G, R = n1 - G * (n1max - 1), nB = G - R;
        int L;
        if (c >= R) L = (i < K0) ? i * nB + (c - R) : K0 * nB + (i - K0) * G + c;
        else L = K0 * nB + i * G + c;
        if (L >= NT * 8) return false;
        const int T = L >> 3; const int e = tstart[560 + T];
        u.pm = __builtin_amdgcn_readfirstlane(T); u.pn = __builtin_amdgcn_readfirstlane(L & 7); u.e = __builtin_amdgcn_readfirstlane(e); u.rb = __builtin_amdgcn_readfirstlane(T - tstart[e]); return true;
    }
    __device__ __forceinline__ void done(const Unit&) const {}
    __device__ __forceinline__ void a_ready(const Unit& u) const {
        if (wave == 0) {
            unsigned polls = 0;
            while ((unsigned)__builtin_amdgcn_readfirstlane(__hip_atomic_load(ready + 64 * u.pm, __ATOMIC_RELAXED, __HIP_MEMORY_SCOPE_AGENT)) < 32u) {
                if (++polls > (1u << 22)) { if (lane_now() == 0) __hip_atomic_store(tmo, 0x600u | (unsigned)(u.pm & 0xff), __ATOMIC_RELAXED, __HIP_MEMORY_SCOPE_AGENT); break; }
                __builtin_amdgcn_s_sleep(2); }
            __builtin_amdgcn_fence(__ATOMIC_ACQUIRE, "agent");
            asm volatile("s_waitcnt vmcnt(0)" ::: "memory");
        }
        asm volatile("" ::: "memory"); __builtin_amdgcn_s_barrier(); asm volatile("" ::: "memory");
    }
    __device__ __forceinline__ const char* a_base(const Unit& u) const { return (const char*)HB + (size_t)u.pm * BM * DE; }
    __device__ __forceinline__ const char* b_base(const Unit& u) const { return (const char*)W2 + ((size_t)u.e * DM + (size_t)u.pn * BM) * DE; }
    __device__ __forceinline__ void a_voff(const Unit&, const int (&R)[2], const int (&C)[2], unsigned (&v)[2][2]) const {
#pragma unroll
        for (int h = 0; h < 2; ++h)
#pragma unroll
            for (int i = 0; i < 2; ++i) v[h][i] = (unsigned)((h * HALF + R[i]) * DE + C[i]) * 2u;
    }
};
}

struct Params { const float* in[22]; float* out; unsigned char* ws; int ph_lo, ph_hi; };
enum { IN_X = 0, IN_NORM1, IN_WIN, IN_SGUN, IN_SGUW, IN_SGUB, IN_CONVW, IN_CONVB, IN_LNG, IN_LNB, IN_QN, IN_KN, IN_OUTN, IN_WOUT, IN_NORM2, IN_WRG, IN_BRG, IN_WRE, IN_BRE, IN_WG, IN_WU, IN_WD };

struct Frame {
    LAS unsigned char* lds; volatile LAS unsigned* MISC;
    int tid, lane, wave, vcu, G;
    const float* const* in; float* out; unsigned char* ws;
};

__device__ __forceinline__ void tile_desc(const float* const* in, unsigned char* ws, int it, const float*& src, int& ldw, unsigned char*& dst, int& pitch, const float*& ksc, float& wsc, int& fp8) {
    constexpr int T_IN = 32 * 80, T_OUT = 32 * 32, T_E = 32 * 8, T_D = 8 * 32;
    constexpr int T_LAYER = T_IN + T_OUT + NE * (2 * T_E + T_D);
    const int l = it / T_LAYER; int r = it % T_LAYER; ksc = nullptr; wsc = 1.f; fp8 = 0;
    if (r < T_IN) { ldw = DIN;
        if (IP8(l)) { const int kb = r / 160, nb = r % 160; pitch = DM; fp8 = 1; wsc = WIN_SCALE; src = in[IN_WIN] + (size_t)l * DM * DIN + (size_t)(128 * kb) * DIN + 32 * nb; dst = ws + WS_WIN + (size_t)l * DIN * DM * 2 + ((size_t)32 * nb) * DM + 128 * kb; }
        else { const int kb = r / 80, nb = r % 80; pitch = DM * 2; src = in[IN_WIN] + (size_t)l * DM * DIN + (size_t)(64 * kb) * DIN + 64 * nb; dst = ws + WS_WIN + (((size_t)l * DIN + 64 * nb) * DM + 64 * kb) * 2; }
        return; } r -= T_IN;
    if (r < T_OUT) { const int kb = r / 32, nb = r % 32; ldw = DM; src = in[IN_WOUT] + (size_t)l * DM * DM + (size_t)(64 * kb) * DM + 64 * nb;
        if (OP8(l)) { const int kb8 = r / 64, nb8 = r % 64; pitch = DM; fp8 = 1; wsc = WOUT_SCALE; src = in[IN_WOUT] + (size_t)l * DM * DM + (size_t)(128 * kb8) * DM + 32 * nb8; dst = ws + WS_WOUT + (size_t)l * DM * DM * 2 + ((size_t)32 * nb8) * DM + 128 * kb8; } else { pitch = DM * 2; dst = ws + WS_WOUT + (((size_t)l * DM + 64 * nb) * DM + 64 * kb) * 2; }
        return; } r -= T_OUT;
    const int e = r / (2 * T_E + T_D); r %= (2 * T_E + T_D);
    const size_t le = (size_t)l * NE + e; fp8 = 1;
    if (r < 2 * T_E) { const int up = r >= T_E; r -= up * T_E; const int kb = r / 16, nb = r % 16, n0 = 32 * nb; ldw = DE; pitch = DM; wsc = W1_SCALE;
        src = (up ? in[IN_WU] : in[IN_WG]) + le * DM * DE + (size_t)(128 * kb) * DE + n0; dst = ws + WS_W1 + (le * 1024 + (size_t)((n0 / 128) * 256 + up * 128 + (n0 % 128))) * DM + 128 * kb; ksc = in[IN_NORM2] + (size_t)l * DM + 128 * kb; return; }
    r -= 2 * T_E;
    { const int kb = r / 64, nb = r % 64; ldw = DM; pitch = DE; wsc = W2_SCALE; src = in[IN_WD] + le * DE * DM + (size_t)(128 * kb) * DM + 32 * nb; dst = ws + WS_W2 + (le * DM + 32 * nb) * DE + 128 * kb; }
}
#define TR_LOAD(V, src, ldw, fp8) do { if (fp8) { _Pragma("unroll") for (int i = 0; i < 16; ++i) V[i] = __builtin_nontemporal_load((const f32x4*)((src) + (size_t)(8 * i + (lane >> 3)) * (ldw) + 4 * (lane & 7))); } \
    else { _Pragma("unroll") for (int i = 0; i < 16; ++i) V[i] = __builtin_nontemporal_load((const f32x4*)((src) + (size_t)(4 * i + (lane >> 4)) * (ldw) + 4 * (lane & 15))); } } while (0)
#define TR_PROC(V, dst, pitch, ksc, wsc, fp8) do { \
    if (fp8) {        \
        _Pragma("unroll") for (int i = 0; i < 16; ++i) { const int kk = 8 * i + (lane >> 3); f32x4 v = V[i] * ((ksc) ? (ksc)[kk] * (wsc) : (wsc)); \
            LAS float* d = scr + kk * 33 + 4 * (lane & 7); d[0] = v[0]; d[1] = v[1]; d[2] = v[2]; d[3] = v[3]; } \
        LDS_WAIT(); \
        _Pragma("unroll") for (int j = 0; j < 8; ++j) { const int n = (lane >> 4) + 4 * j; const LAS float* sp = scr + (8 * (lane & 15)) * 33 + n; \
            u32x2 o; o.x = pk4_fp8(sp[0], sp[33], sp[2 * 33], sp[3 * 33]); o.y = pk4_fp8(sp[4 * 33], sp[5 * 33], sp[6 * 33], sp[7 * 33]); *(u32x2*)((dst) + (size_t)n * (pitch) + 8 * (lane & 15)) = o; } \
    } else { \
        _Pragma("unroll") for (int i = 0; i < 16; ++i) { const int kk = 4 * i + (lane >> 4); f32x4 v = V[i] * ((ksc) ? (ksc)[kk] * (wsc) : (wsc)); \
            LAS float* d = scr + kk * 65 + 4 * (lane & 15); d[0] = v[0]; d[1] = v[1]; d[2] = v[2]; d[3] = v[3]; } \
        LDS_WAIT(); \
        _Pragma("unroll") for (int j = 0; j < 8; ++j) { const int n = (lane >> 3) + 8 * j; const LAS float* sp = scr + (8 * (lane & 7)) * 65 + n; \
            u32x4 o; o.x = cvt_pk_bf16(sp[0], sp[65]); o.y = cvt_pk_bf16(sp[2 * 65], sp[3 * 65]); o.z = cvt_pk_bf16(sp[4 * 65], sp[5 * 65]); o.w = cvt_pk_bf16(sp[6 * 65], sp[7 * 65]); \
            *(u32x4*)((dst) + (size_t)n * (pitch) + 16 * (lane & 7)) = o; } } \
    LDS_WAIT(); } while (0)
__device__ __forceinline__ void norm_row_bf16(const float* xrow, const float* g, bf16* orow, int lane) {
    f32x4 v[8]; float s = 0.f;
#pragma unroll
    for (int j = 0; j < 8; ++j) { v[j] = *(const f32x4*)(xrow + 4 * lane + 256 * j); s += (v[j][0] * v[j][0] + v[j][1] * v[j][1]) + (v[j][2] * v[j][2] + v[j][3] * v[j][3]); }
    const float rs = __builtin_amdgcn_rsqf(wave_sum(s) * (1.f / DM) + EPS);
#pragma unroll
    for (int j = 0; j < 8; ++j) { const f32x4 gg = *(const f32x4*)(g + 4 * lane + 256 * j);
        u32x2 o; o.x = cvt_pk_bf16(v[j][0] * rs * gg[0], v[j][1] * rs * gg[1]); o.y = cvt_pk_bf16(v[j][2] * rs * gg[2], v[j][3] * rs * gg[3]);
        *(u32x2*)(orow + 4 * lane + 256 * j) = o; }
}
__device__ __forceinline__ void p_prologue(Frame& F) {
    LAS float* scr = (LAS float*)(F.lds + F.wave * 16896);
    const int gw = F.vcu * NWAVES + F.wave, NGW = F.G * NWAVES, lane = F.lane;
    constexpr int T_TOTAL = NLAYER * (32 * 80 + 32 * 32 + NE * (2 * 32 * 8 + 8 * 32));
    {
        f32x4 va[16], vb[16];
        const float* srcA; const float* srcB; unsigned char* dstA; unsigned char* dstB; const float* kA; const float* kB; int ldA, ldB, pA, pB, fA, fB; float wA, wB;
        int it = gw;
        if (it < T_TOTAL) { tile_desc(F.in, F.ws, it, srcA, ldA, dstA, pA, kA, wA, fA); TR_LOAD(va, srcA, ldA, fA); }
        while (it < T_TOTAL) {
            const int itb = it + NGW;
            if (itb < T_TOTAL) { tile_desc(F.in, F.ws, itb, srcB, ldB, dstB, pB, kB, wB, fB); TR_LOAD(vb, srcB, ldB, fB); }
            TR_PROC(va, dstA, pA, kA, wA, fA);
            if (itb >= T_TOTAL) break;
            const int ita = itb + NGW;
            if (ita < T_TOTAL) { tile_desc(F.in, F.ws, ita, srcA, ldA, dstA, pA, kA, wA, fA); TR_LOAD(va, srcA, ldA, fA); }
            TR_PROC(vb, dstB, pB, kB, wB, fB);
            it = ita;
        }
    }
    { bf16* SW = (bf16*)(F.ws + WS_SGUW); const int gt = gw * 64 + F.lane, NGT = NGW * 64;
      for (int idx = gt; idx < NLAYER * 4 * 8 * 4 * 64; idx += NGT) {
          const int ln = idx & 63, pp = (idx >> 6) & 3, itile = (idx >> 8) & 7, h = (idx >> 11) & 3, l = idx >> 13;
          const int i = 16 * itile + (ln & 15), gq = ln >> 4;
          const float* w = F.in[IN_SGUW] + ((size_t)(l * 4 + h) * 128 + i) * 128;
          float v[8];
#pragma unroll
          for (int jj = 0; jj < 8; ++jj) { const int j = 32 * pp + (jj < 4 ? 4 * gq + jj : 16 + 4 * gq + (jj - 4)); v[jj] = (j <= i) ? w[j] : 0.f; }
          u32x4 o; o.x = cvt_pk_bf16(v[0], v[1]); o.y = cvt_pk_bf16(v[2], v[3]); o.z = cvt_pk_bf16(v[4], v[5]); o.w = cvt_pk_bf16(v[6], v[7]);
          *(u32x4*)(SW + (size_t)idx * 8) = o; }
      bf16* WRF = (bf16*)(F.ws + WS_WRT);
      for (int idx = gt; idx < NLAYER * 64 * 3 * 64; idx += NGT) { const int ln = idx & 63, ct = (idx >> 6) % 3, ks = (idx / 192) & 63, l = idx / (192 * 64);
          const int o = 16 * ct + (ln & 15), k0 = 32 * ks + 8 * (ln >> 4);
          float v[8];
#pragma unroll
          for (int j = 0; j < 8; ++j) { const int k = k0 + j; const float wv = o < 32 ? F.in[IN_WRE][((size_t)l * DM + k) * NE + o] : (o < 36 ? F.in[IN_WRG][((size_t)l * DM + k) * 4 + (o - 32)] : 0.f);
              v[j] = wv * F.in[IN_NORM2][(size_t)l * DM + k]; }
          u32x4 hi, lo; hi.x = cvt_pk_bf16(v[0], v[1]); hi.y = cvt_pk_bf16(v[2], v[3]); hi.z = cvt_pk_bf16(v[4], v[5]); hi.w = cvt_pk_bf16(v[6], v[7]);
          lo.x = cvt_pk_bf16(v[0] - bf_lo(hi.x), v[1] - bf_hi(hi.x)); lo.y = cvt_pk_bf16(v[2] - bf_lo(hi.y), v[3] - bf_hi(hi.y));
          lo.z = cvt_pk_bf16(v[4] - bf_lo(hi.z), v[5] - bf_hi(hi.z)); lo.w = cvt_pk_bf16(v[6] - bf_lo(hi.w), v[7] - bf_hi(hi.w));
          bf16* dst = WRF + ((((size_t)l * 64 + ks) * 3 + ct) * 2 * 64 + ln) * 8;
          *(u32x4*)dst = hi; *(u32x4*)(dst + 512) = lo; } }
    bf16* HN = (bf16*)(F.ws + WS_HN);
    for (int m = gw; m < SEQ; m += NGW) norm_row_bf16(F.in[IN_X] + (size_t)m * DM, F.in[IN_NORM1], HN + (size_t)m * DM, F.lane);
}

__device__ __forceinline__ int vimg_off(int row, int c) { return row * 256 + ((((c >> 1) ^ (row & 7)) << 1) | (c & 1)) * 16; }
__device__ __forceinline__ bf16x8 tr_frag(const LAS unsigned char* img, int ra, int rb, int dt, int lane) {
    const int gq = lane >> 4, q = (lane & 15) >> 2, p = lane & 3;
    const int r0 = ra + 4 * gq + q, r1 = rb + 4 * gq + q, c = 2 * dt + (p >> 1);
    const s16x4 a = __builtin_amdgcn_ds_read_tr16_b64_v4i16((LAS s16x4*)(img + vimg_off(r0, c) + 8 * (p & 1)));
    const s16x4 b = __builtin_amdgcn_ds_read_tr16_b64_v4i16((LAS s16x4*)(img + vimg_off(r1, c) + 8 * (p & 1)));
    bf16x8 r; r[0] = a[0]; r[1] = a[1]; r[2] = a[2]; r[3] = a[3]; r[4] = b[0]; r[5] = b[1]; r[6] = b[2]; r[7] = b[3]; return r;
}
__device__ __forceinline__ void sgu_stage8(const bf16* vsrc, int j0, int w, int lane, const f32x4& g0, const f32x4& g1, LAS unsigned char* lds) {
    u32x4 raw[8];
#pragma unroll
    for (int j = 0; j < 8; ++j) raw[j] = *(const u32x4*)(vsrc + (size_t)(w + 8 * (j0 + j)) * DIN);
#pragma unroll
    for (int j = 0; j < 8; ++j) { const int row = w + 8 * (j0 + j);
        float x[8] = {bf_lo(raw[j].x), bf_hi(raw[j].x), bf_lo(raw[j].y), bf_hi(raw[j].y), bf_lo(raw[j].z), bf_hi(raw[j].z), bf_lo(raw[j].w), bf_hi(raw[j].w)};
        float s = 0.f;
#pragma unroll
        for (int e = 0; e < 8; ++e) s += x[e] * x[e];
        const float rs = __builtin_amdgcn_rsqf(wave_sum(s) * (1.f / 512.f) + EPS);
        u32x4 o; o.x = cvt_pk_bf16(x[0] * rs * g0[0], x[1] * rs * g0[1]); o.y = cvt_pk_bf16(x[2] * rs * g0[2], x[3] * rs * g0[3]);
        o.z = cvt_pk_bf16(x[4] * rs * g1[0], x[5] * rs * g1[1]); o.w = cvt_pk_bf16(x[6] * rs * g1[2], x[7] * rs * g1[3]);
        *(LAS u32x4*)(lds + (lane >> 4) * 32768 + vimg_off(row, lane & 15)) = o; }
}
__device__ __forceinline__ void sgu_item(Frame& F, int l, int chunk, int half) {
    const bf16* PROJ = (const bf16*)(F.ws + WS_PROJ); bf16* MIX = (bf16*)(F.ws + WS_MIX);
    const int p0 = chunk * 128, lane = F.lane, w = F.wave;
    LAS float* red = (LAS float*)(F.lds + MISC_OFF + 256);
    const float* gn = F.in[IN_SGUN] + l * 512;
    const f32x4 g0 = *(const f32x4*)(gn + 8 * lane), g1 = *(const f32x4*)(gn + 8 * lane + 4);
    const bf16* vsrc = PROJ + (size_t)p0 * DIN + OFF_V + 8 * lane;
    sgu_stage8(vsrc, 0, w, lane, g0, g1, F.lds);
    if (half) sgu_stage8(vsrc, 8, w, lane, g0, g1, F.lds);
    const int h = w >> 1, ih = w & 1, gq = lane >> 4, fr = lane & 15;
    const LAS unsigned char* img = F.lds + h * 32768;
    const bf16* SW = (const bf16*)(F.ws + WS_SGUW) + (size_t)(l * 4 + h) * 8 * 4 * 64 * 8;
    const float* bs = F.in[IN_SGUB] + (size_t)(l * 4 + h) * 128;
    const float* og = F.in[IN_OUTN] + (size_t)l * DM + h * 128 + 4 * gq;
    const int it0 = ih + 4 * half;
    u32x2 ur[2][8];
#pragma unroll
    for (int ii = 0; ii < 2; ++ii) { const bf16* urow = PROJ + (size_t)(p0 + 16 * (it0 + 2 * ii) + fr) * DIN + OFF_U + h * 128 + 4 * gq;
#pragma unroll
        for (int dt = 0; dt < 8; ++dt) ur[ii][dt] = *(const u32x2*)(urow + 16 * dt); }
    __syncthreads();
    f32x4 z[2][8];
#pragma unroll
    for (int ii = 0; ii < 2; ++ii)
#pragma unroll
        for (int dt = 0; dt < 8; ++dt) z[ii][dt] = (f32x4){0.f, 0.f, 0.f, 0.f};
#pragma unroll 1
    for (int pp = 0; pp <= (it0 + 2) / 2; ++pp) {
        const bf16x8 bw0 = *(const bf16x8*)(SW + ((size_t)(it0 * 4 + pp) * 64 + lane) * 8);
        const bf16x8 bw1 = *(const bf16x8*)(SW + ((size_t)((it0 + 2) * 4 + pp) * 64 + lane) * 8);
        const bool do0 = pp <= it0 / 2;
#pragma unroll
        for (int dt = 0; dt < 8; ++dt) { const bf16x8 a = tr_frag(img, 32 * pp, 32 * pp + 16, dt, lane);
            if (do0) z[0][dt] = __builtin_amdgcn_mfma_f32_16x16x32_bf16(a, bw0, z[0][dt], 0, 0, 0);
            z[1][dt] = __builtin_amdgcn_mfma_f32_16x16x32_bf16(a, bw1, z[1][dt], 0, 0, 0); }
    }
#pragma unroll
    for (int ii = 0; ii < 2; ++ii) { const int i = 16 * (it0 + 2 * ii) + fr; const float bi = bs[i]; float s = 0.f;
#pragma unroll
        for (int dt = 0; dt < 8; ++dt) { const u32x2 u2 = ur[ii][dt];
            f32x4 y; y[0] = bf_lo(u2.x) * (z[ii][dt][0] + bi); y[1] = bf_hi(u2.x) * (z[ii][dt][1] + bi); y[2] = bf_lo(u2.y) * (z[ii][dt][2] + bi); y[3] = bf_hi(u2.y) * (z[ii][dt][3] + bi);
            z[ii][dt] = y; s += (y[0] * y[0] + y[1] * y[1]) + (y[2] * y[2] + y[3] * y[3]); }
        s += __shfl_xor(s, 16); s += __shfl_xor(s, 32);
        if (gq == 0) red[i * 4 + h] = s; }
    __syncthreads();
#pragma unroll
    for (int ii = 0; ii < 2; ++ii) { const int i = 16 * (it0 + 2 * ii) + fr;
        const f32x4 rr = *(const LAS f32x4*)(red + i * 4);
        const float rs = __builtin_amdgcn_rsqf(((rr[0] + rr[1]) + (rr[2] + rr[3])) * (1.f / 512.f) + EPS);
        bf16* orow = MIX + (size_t)(p0 + i) * DM + h * 128 + 4 * gq;
#pragma unroll
        for (int dt = 0; dt < 8; ++dt) { const f32x4 gg = *(const f32x4*)(og + 16 * dt); const f32x4 y = z[ii][dt];
            if (OP8(l)) *(unsigned*)((unsigned char*)MIX + (size_t)(p0 + i) * DM + h * 128 + 4 * gq + 16 * dt) = pk4_fp8(y[0] * rs * gg[0], y[1] * rs * gg[1], y[2] * rs * gg[2], y[3] * rs * gg[3]);
            else { u32x2 o; o.x = cvt_pk_bf16(y[0] * rs * gg[0], y[1] * rs * gg[1]); o.y = cvt_pk_bf16(y[2] * rs * gg[2], y[3] * rs * gg[3]);
            *(u32x2*)(orow + 16 * dt) = o; } } }
    __syncthreads();
}

__device__ __forceinline__ void conv_item(Frame& F, int l, int tile) {
    const bf16* PROJ = (const bf16*)(F.ws + WS_PROJ); bf16* MIX = (bf16*)(F.ws + WS_MIX);
    constexpr int TP = 32, NR = TP + 30;
    const int p0 = tile * TP, c = F.tid, tid = F.tid;
    LAS float* cbuf = (LAS float*)F.lds;
    LAS bf16* zbuf = (LAS bf16*)(F.lds + 65536);
    { u32x4 av[8], gv[8];
#pragma unroll
      for (int i = 0; i < 8; ++i) { const int id = tid + NTHREADS * i, row = id >> 6, ch = (id & 63) * 8; int p = p0 - 30 + row; p = p < 0 ? 0 : p; p = row < NR ? p : 0;
          av[i] = *(const u32x4*)(PROJ + (size_t)p * DIN + OFF_A + ch); gv[i] = *(const u32x4*)(PROJ + (size_t)p * DIN + OFF_G + ch); }
#pragma unroll
      for (int i = 0; i < 8; ++i) { const int id = tid + NTHREADS * i, row = id >> 6, ch = (id & 63) * 8; const bool live = (p0 - 30 + row) >= 0;
          const unsigned au[4] = {av[i].x, av[i].y, av[i].z, av[i].w}, gu[4] = {gv[i].x, gv[i].y, gv[i].z, gv[i].w}; u32x4 o; unsigned ou[4];
#pragma unroll
          for (int e = 0; e < 4; ++e) { const float z0 = bf_lo(au[e]) * sigmoidf_(bf_lo(gu[e])), z1 = bf_hi(au[e]) * sigmoidf_(bf_hi(gu[e])); ou[e] = live ? cvt_pk_bf16(z0, z1) : 0u; }
          o.x = ou[0]; o.y = ou[1]; o.z = ou[2]; o.w = ou[3];
          if (row < NR) *(LAS u32x4*)(zbuf + row * 512 + ch) = o; } }
    float wk[CONV_K];
#pragma unroll
    for (int k = 0; k < CONV_K; ++k) wk[k] = F.in[IN_CONVW][((size_t)l * CONV_K + k) * 512 + c];
    const float cb = F.in[IN_CONVB][l * 512 + c];
    __syncthreads();
#define CONV_Z(r) __builtin_bit_cast(float, (unsigned)zbuf[(r) * 512 + c] << 16)
    float win[30];
#pragma unroll
    for (int r = 0; r < 30; ++r) win[r] = CONV_Z(r);
#pragma unroll
    for (int q = 0; q < TP; ++q) { const float zv = CONV_Z(30 + q); float acc = cb + wk[30] * zv;
#pragma unroll
        for (int k = 0; k < 30; ++k) acc += wk[k] * win[(k + q) % 30];
        win[q % 30] = zv; cbuf[q * 512 + c] = acc; }
#undef CONV_Z
    __syncthreads();
    const float* lg = F.in[IN_LNG] + l * 512 + 8 * F.lane; const float* lb = F.in[IN_LNB] + l * 512 + 8 * F.lane; const float* og = F.in[IN_OUTN] + (size_t)l * DM + 512 + 8 * F.lane;
    const f32x4 lg0 = *(const f32x4*)lg, lg1 = *(const f32x4*)(lg + 4), lb0 = *(const f32x4*)lb, lb1 = *(const f32x4*)(lb + 4), og0 = *(const f32x4*)og, og1 = *(const f32x4*)(og + 4);
    for (int r = F.wave; r < TP; r += NWAVES) {
        const f32x4 a0 = *(const LAS f32x4*)(cbuf + r * 512 + 8 * F.lane), a1 = *(const LAS f32x4*)(cbuf + r * 512 + 8 * F.lane + 4);
        float x[8] = {a0[0], a0[1], a0[2], a0[3], a1[0], a1[1], a1[2], a1[3]};
        float s = 0.f;
#pragma unroll
        for (int e = 0; e < 8; ++e) s += x[e];
        const float mu = wave_sum(s) * (1.f / 512.f); float q2 = 0.f;
#pragma unroll
        for (int e = 0; e < 8; ++e) { x[e] -= mu; q2 += x[e] * x[e]; }
        const float rstd = __builtin_amdgcn_rsqf(wave_sum(q2) * (1.f / 512.f) + EPS);
        const float gam[8] = {lg0[0], lg0[1], lg0[2], lg0[3], lg1[0], lg1[1], lg1[2], lg1[3]}, bet[8] = {lb0[0], lb0[1], lb0[2], lb0[3], lb1[0], lb1[1], lb1[2], lb1[3]};
        float s2 = 0.f;
#pragma unroll
        for (int e = 0; e < 8; ++e) { const float y = x[e] * rstd * gam[e] + bet[e]; x[e] = y * sigmoidf_(y); s2 += x[e] * x[e]; }
        const float rs = __builtin_amdgcn_rsqf(wave_sum(s2) * (1.f / 512.f) + EPS);
        if (OP8(l)) { u32x2 o8; o8.x = pk4_fp8(x[0] * rs * og0[0], x[1] * rs * og0[1], x[2] * rs * og0[2], x[3] * rs * og0[3]); o8.y = pk4_fp8(x[4] * rs * og1[0], x[5] * rs * og1[1], x[6] * rs * og1[2], x[7] * rs * og1[3]);
            *(u32x2*)((unsigned char*)MIX + (size_t)(p0 + r) * DM + 512 + 8 * F.lane) = o8; }
        else {
        u32x4 o; o.x = cvt_pk_bf16(x[0] * rs * og0[0], x[1] * rs * og0[1]); o.y = cvt_pk_bf16(x[2] * rs * og0[2], x[3] * rs * og0[3]);
        o.z = cvt_pk_bf16(x[4] * rs * og1[0], x[5] * rs * og1[1]); o.w = cvt_pk_bf16(x[6] * rs * og1[2], x[7] * rs * og1[3]);
        *(u32x4*)(MIX + (size_t)(p0 + r) * DM + 512 + 8 * F.lane) = o; }
    }
    __syncthreads();
}

__device__ __forceinline__ int kimg_off(int row, int c) { return row * 256 + ((c ^ (row & 15)) << 4); }
__device__ __forceinline__ bf16x8 tr_frag2(const LAS unsigned char* vs, int ta, int tb, int dt, int lane) {
    const int gq = lane >> 4, q = (lane & 15) >> 2, p = lane & 3, c = 2 * dt + (p >> 1), rr = 4 * gq + q;
    const int off = rr * 256 + ((((c >> 1) ^ (rr & 7)) << 1) | (c & 1)) * 16 + 8 * (p & 1);
    const s16x4 a = __builtin_amdgcn_ds_read_tr16_b64_v4i16((LAS s16x4*)(vs + ta + off));
    const s16x4 b = __builtin_amdgcn_ds_read_tr16_b64_v4i16((LAS s16x4*)(vs + tb + off));
    bf16x8 r; r[0] = a[0]; r[1] = a[1]; r[2] = a[2]; r[3] = a[3]; r[4] = b[0]; r[5] = b[1]; r[6] = b[2]; r[7] = b[3]; return r;
}
#define ATT_DECODE(st) const int run_ = (int)blockIdx.x + F.G * ((st) / 5), b_ = (st) % 5 - 1; const int g = run_ >> 8, h = (run_ >> 5) & 7, rr_ = run_ & 31; \
    const int sh = 2 * g, dil = 1 << sh, rps = 32 >> sh; const int r = rr_ / rps, nb = 4 * (rr_ % rps) + b_
#define ATT_LOAD(st) do { if (ATT_EXP == 2) break; ATT_DECODE(st); const int cc = tid & 15; \
    _Pragma("unroll") for (int j = 0; j < 4; ++j) { const int row = (tid >> 4) + 32 * j; int ms = nb * 128 + row; ms = ms < 0 ? 0 : ms; const size_t pos = (size_t)ms * dil + r; \
        kr[j] = *(const u32x4*)(PROJ + pos * DIN + OFF_K + h * HD + 8 * cc); vr[j] = *(const u32x4*)(PROJ + pos * DIN + OFF_VV + h * HD + 8 * cc); } \
    if (b_ >= 0) { const size_t qpos_ = (size_t)(nb * 128 + 16 * w + (lane & 15)) * dil + r; \
        _Pragma("unroll") for (int ks = 0; ks < 4; ++ks) qr[ks] = *(const u32x4*)(PROJ + qpos_ * DIN + OFF_Q + h * HD + 32 * ks + 8 * (lane >> 4)); } } while (0)
__device__ __forceinline__ void att_phase(Frame& F, int l) {
    const bf16* PROJ = (const bf16*)(F.ws + WS_PROJ);
    bf16* ATT = (bf16*)(F.ws + WS_ATT); float* LSE = (float*)(F.ws + WS_LSE);
    const int lane = F.lane, w = F.wave, tid = F.tid, fr = lane & 15, gq = lane >> 4;
    LAS unsigned char* Ks = F.lds; LAS unsigned char* Vs = F.lds + 65536;
    const int nsteps = 5 * ((768 - (int)blockIdx.x + F.G - 1) / F.G);
    u32x4 kr[4], vr[4], qr[4];
    if (ATT_EXP == 2) { for (int j = 0; j < 4; ++j) { kr[j] = (u32x4){0x3f803f80u + (unsigned)tid, 0x3f003f80u, 0x3f803f00u, 0x3e803f80u}; vr[j] = kr[j]; qr[j] = kr[j]; } }
    if (nsteps > 0) ATT_LOAD(0);
    const int cc = tid & 15;
    const float* kgp = F.in[IN_KN] + l * HD + 8 * cc;
    const f32x4 kg0 = *(const f32x4*)kgp, kg1 = *(const f32x4*)(kgp + 4);
    for (int st = 0; st < nsteps; ++st) {
        ATT_DECODE(st);
        const int slot = (b_ + 1) & 1, curoff = slot * 32768, prevoff = 32768 - curoff;
#pragma unroll
        for (int j = 0; j < 4; ++j) { const int row = (tid >> 4) + 32 * j;
            const u32x4 k4 = kr[j];
            float x[8] = {bf_lo(k4.x), bf_hi(k4.x), bf_lo(k4.y), bf_hi(k4.y), bf_lo(k4.z), bf_hi(k4.z), bf_lo(k4.w), bf_hi(k4.w)};
            float sq = 0.f;
#pragma unroll
            for (int e = 0; e < 8; ++e) sq += x[e] * x[e];
            const float rs = __builtin_amdgcn_rsqf(row16_sum(sq) * (1.f / HD) + EPS);
            u32x4 o; o.x = cvt_pk_bf16(x[0] * rs * kg0[0], x[1] * rs * kg0[1]); o.y = cvt_pk_bf16(x[2] * rs * kg0[2], x[3] * rs * kg0[3]);
            o.z = cvt_pk_bf16(x[4] * rs * kg1[0], x[5] * rs * kg1[1]); o.w = cvt_pk_bf16(x[6] * rs * kg1[2], x[7] * rs * kg1[3]);
            *(LAS u32x4*)(Ks + curoff + kimg_off(row, cc)) = o;
            *(LAS u32x4*)(Vs + curoff + vimg_off(row, cc)) = vr[j]; }
        const int iq = 16 * w + fr; const size_t qpos = (size_t)(nb * 128 + iq) * dil + r;
        bf16x8 qf[4];
        if (b_ >= 0) { float x[4][8]; float sq = 0.f;
#pragma unroll
          for (int ks = 0; ks < 4; ++ks) { const u32x4 q4 = qr[ks];
              x[ks][0] = bf_lo(q4.x); x[ks][1] = bf_hi(q4.x); x[ks][2] = bf_lo(q4.y); x[ks][3] = bf_hi(q4.y); x[ks][4] = bf_lo(q4.z); x[ks][5] = bf_hi(q4.z); x[ks][6] = bf_lo(q4.w); x[ks][7] = bf_hi(q4.w);
#pragma unroll
              for (int e = 0; e < 8; ++e) sq += x[ks][e] * x[ks][e]; }
          sq = sum4(sq);
          const float rs = __builtin_amdgcn_rsqf(sq * (1.f / HD) + EPS) * 0.12751743f;
#pragma unroll
          for (int ks = 0; ks < 4; ++ks) { const float* qg = F.in[IN_QN] + l * HD + 32 * ks + 8 * gq; const f32x4 q0 = *(const f32x4*)qg, q1 = *(const f32x4*)(qg + 4);
              u32x4 o; o.x = cvt_pk_bf16(x[ks][0] * rs * q0[0], x[ks][1] * rs * q0[1]); o.y = cvt_pk_bf16(x[ks][2] * rs * q0[2], x[ks][3] * rs * q0[3]);
              o.z = cvt_pk_bf16(x[ks][4] * rs * q1[0], x[ks][5] * rs * q1[1]); o.w = cvt_pk_bf16(x[ks][6] * rs * q1[2], x[ks][7] * rs * q1[3]);
              qf[ks] = __builtin_bit_cast(bf16x8, o); } }
        __syncthreads();
        if (st + 1 < nsteps) ATT_LOAD(st + 1);
        if (b_ >= 0 && ATT_EXP != 1) {
        f32x4 sc[10];
#pragma unroll
        for (int kt = 0; kt < 9; ++kt) { sc[kt] = (f32x4){0.f, 0.f, 0.f, 0.f}; const int T = w + kt; const int kbase = (T < 8 ? prevoff : curoff); const int krow = 16 * (T & 7) + fr;
#pragma unroll
            for (int ks = 0; ks < 4; ++ks) { const bf16x8 kf = *(const LAS bf16x8*)(Ks + kbase + kimg_off(krow, 4 * ks + gq));
                sc[kt] = __builtin_amdgcn_mfma_f32_16x16x32_bf16(kf, qf[ks], sc[kt], 0, 0, 0); } }
#pragma unroll
        for (int e = 0; e < 4; ++e) { sc[0][e] = (4 * gq + e >= fr) ? sc[0][e] : -INFINITY; sc[8][e] = (4 * gq + e <= fr) ? sc[8][e] : -INFINITY; }
        if (nb == 0) {
#pragma unroll
            for (int kt = 0; kt < 8; ++kt) if (w + kt < 8) sc[kt] = (f32x4){-INFINITY, -INFINITY, -INFINITY, -INFINITY}; }
        float mx = -INFINITY;
#pragma unroll
        for (int kt = 0; kt < 9; ++kt) mx = fmaxf(fmaxf(mx, fmaxf(sc[kt][0], sc[kt][1])), fmaxf(sc[kt][2], sc[kt][3]));
        mx = max4(mx);
        float sum = 0.f;
#pragma unroll
        for (int kt = 0; kt < 9; ++kt)
#pragma unroll
            for (int e = 0; e < 4; ++e) { const float p = __builtin_amdgcn_exp2f(sc[kt][e] - mx); sc[kt][e] = p; sum += p; }
        sc[9] = (f32x4){0.f, 0.f, 0.f, 0.f};
        sum = sum4(sum);
        bf16x8 pf[5];
#pragma unroll
        for (int pp = 0; pp < 5; ++pp) { u32x4 o; o.x = cvt_pk_bf16(sc[2 * pp][0], sc[2 * pp][1]); o.y = cvt_pk_bf16(sc[2 * pp][2], sc[2 * pp][3]); o.z = cvt_pk_bf16(sc[2 * pp + 1][0], sc[2 * pp + 1][1]); o.w = cvt_pk_bf16(sc[2 * pp + 1][2], sc[2 * pp + 1][3]);
            pf[pp] = __builtin_bit_cast(bf16x8, o); }
        const float inv = __builtin_amdgcn_rcpf(sum);
        bf16* orow = ATT + ((size_t)g * SEQ + qpos) * 1024 + h * HD + 4 * gq;
        int toff[10];
#pragma unroll
        for (int kt = 0; kt < 10; ++kt) { const int T = (w + kt) < 15 ? (w + kt) : 15; toff[kt] = (T < 8 ? prevoff : curoff) + (T & 7) * 16 * 256; }
#pragma unroll
        for (int dt = 0; dt < 8; ++dt) { f32x4 o = (f32x4){0.f, 0.f, 0.f, 0.f};
#pragma unroll
            for (int pp = 0; pp < 5; ++pp) { const bf16x8 vf = tr_frag2(Vs, toff[2 * pp], toff[2 * pp + 1], dt, lane);
                o = __builtin_amdgcn_mfma_f32_16x16x32_bf16(vf, pf[pp], o, 0, 0, 0); }
            u32x2 ow; ow.x = cvt_pk_bf16(o[0] * inv, o[1] * inv); ow.y = cvt_pk_bf16(o[2] * inv, o[3] * inv);
            *(u32x2*)(orow + 16 * dt) = ow; }
        if (gq == 0) LSE[((size_t)g * SEQ + qpos) * NHEAD + h] = (mx + __builtin_amdgcn_logf(sum)) * 0.6931471805599453f;
        }
        if (b_ >= 0 && ATT_EXP == 1) { bf16* orow = ATT + ((size_t)g * SEQ + qpos) * 1024 + h * HD + 4 * gq;
#pragma unroll
            for (int dt = 0; dt < 8; ++dt) { u32x2 ow; ow.x = __builtin_bit_cast(unsigned, qf[dt & 3][0] | (qf[dt & 3][1] << 16)) & 0x3f803f80u; ow.y = 0u; *(u32x2*)(orow + 16 * dt) = ow; }
            if (gq == 0) LSE[((size_t)g * SEQ + qpos) * NHEAD + h] = 0.f; }
        __syncthreads();
    }
}
#undef ATT_DECODE
#undef ATT_LOAD

__device__ __forceinline__ void att_combine(Frame& F, int l) {
    const bf16* ATT = (const bf16*)(F.ws + WS_ATT); const float* LSE = (const float*)(F.ws + WS_LSE); bf16* MIX = (bf16*)(F.ws + WS_MIX);
    const int gw = F.vcu * NWAVES + F.wave, NGW = F.G * NWAVES, lane = F.lane;
    const float* og = F.in[IN_OUTN] + (size_t)l * DM + 1024 + 16 * lane;
    f32x4 gg[4];
#pragma unroll
    for (int q = 0; q < 4; ++q) gg[q] = *(const f32x4*)(og + 4 * q);
    for (int m = gw; m < SEQ; m += NGW) {
        const int hh = lane >> 3;
        const float l0 = LSE[((size_t)0 * SEQ + m) * NHEAD + hh], l1 = LSE[((size_t)1 * SEQ + m) * NHEAD + hh], l2 = LSE[((size_t)2 * SEQ + m) * NHEAD + hh];
        const float M = fmaxf(l0, fmaxf(l1, l2)); float w0 = fast_exp(l0 - M), w1 = fast_exp(l1 - M), w2 = fast_exp(l2 - M);
        const float iw = __builtin_amdgcn_rcpf(w0 + w1 + w2); w0 *= iw; w1 *= iw; w2 *= iw;
        float y[16]; float s = 0.f;
#pragma unroll
        for (int q = 0; q < 2; ++q) {
            const u32x4 a = *(const u32x4*)(ATT + ((size_t)0 * SEQ + m) * 1024 + 16 * lane + 8 * q), b = *(const u32x4*)(ATT + ((size_t)1 * SEQ + m) * 1024 + 16 * lane + 8 * q), c = *(const u32x4*)(ATT + ((size_t)2 * SEQ + m) * 1024 + 16 * lane + 8 * q);
            const unsigned au[4] = {a.x, a.y, a.z, a.w}, bu[4] = {b.x, b.y, b.z, b.w}, cu[4] = {c.x, c.y, c.z, c.w};
#pragma unroll
            for (int e = 0; e < 4; ++e) { y[8 * q + 2 * e] = w0 * bf_lo(au[e]) + w1 * bf_lo(bu[e]) + w2 * bf_lo(cu[e]); y[8 * q + 2 * e + 1] = w0 * bf_hi(au[e]) + w1 * bf_hi(bu[e]) + w2 * bf_hi(cu[e]); } }
#pragma unroll
        for (int e = 0; e < 16; ++e) s += y[e] * y[e];
        const float rs = __builtin_amdgcn_rsqf(wave_sum(s) * (1.f / 1024.f) + EPS);
        if (OP8(l)) { u32x4 o8;
            o8.x = pk4_fp8(y[0] * rs * gg[0][0], y[1] * rs * gg[0][1], y[2] * rs * gg[0][2], y[3] * rs * gg[0][3]); o8.y = pk4_fp8(y[4] * rs * gg[1][0], y[5] * rs * gg[1][1], y[6] * rs * gg[1][2], y[7] * rs * gg[1][3]);
            o8.z = pk4_fp8(y[8] * rs * gg[2][0], y[9] * rs * gg[2][1], y[10] * rs * gg[2][2], y[11] * rs * gg[2][3]); o8.w = pk4_fp8(y[12] * rs * gg[3][0], y[13] * rs * gg[3][1], y[14] * rs * gg[3][2], y[15] * rs * gg[3][3]);
            *(u32x4*)((unsigned char*)MIX + (size_t)m * DM + 1024 + 16 * lane) = o8; }
        else
#pragma unroll
        for (int q = 0; q < 2; ++q) { u32x4 o;
            o.x = cvt_pk_bf16(y[8 * q + 0] * rs * gg[2 * q][0], y[8 * q + 1] * rs * gg[2 * q][1]); o.y = cvt_pk_bf16(y[8 * q + 2] * rs * gg[2 * q][2], y[8 * q + 3] * rs * gg[2 * q][3]);
            o.z = cvt_pk_bf16(y[8 * q + 4] * rs * gg[2 * q + 1][0], y[8 * q + 5] * rs * gg[2 * q + 1][1]); o.w = cvt_pk_bf16(y[8 * q + 6] * rs * gg[2 * q + 1][2], y[8 * q + 7] * rs * gg[2 * q + 1][3]);
            *(u32x4*)(MIX + (size_t)m * DM + 1024 + 16 * lane + 8 * q) = o; }
    }
}

#define ROUTER_LOAD(S, ks) do { \
    _Pragma("unroll") for (int rt = 0; rt < 4; ++rt) xa##S[rt] = *(const u32x4*)(xrow + (size_t)rt * 16 * DM + 32 * (ks)); \
    _Pragma("unroll") for (int ct = 0; ct < 3; ++ct) { bh##S[ct] = *(const bf16x8*)(wf + (size_t)(ks) * 3072 + (ct * 2) * 512); bl##S[ct] = *(const bf16x8*)(wf + (size_t)(ks) * 3072 + (ct * 2 + 1) * 512); } } while (0)
#define ROUTER_STEP(S, ks) do { \
    _Pragma("unroll") for (int rt = 0; rt < 4; ++rt) { const u32x4 xq = xa##S[rt]; \
        const float x0 = bf_lo(xq.x), x1 = bf_hi(xq.x), x2 = bf_lo(xq.y), x3 = bf_hi(xq.y), x4 = bf_lo(xq.z), x5 = bf_hi(xq.z), x6 = bf_lo(xq.w), x7 = bf_hi(xq.w); \
        ssq[rt] += (x0 * x0 + x1 * x1) + (x2 * x2 + x3 * x3) + (x4 * x4 + x5 * x5) + (x6 * x6 + x7 * x7); \
        { u32x2 x8; x8.x = pk4_fp8(x0, x1, x2, x3); x8.y = pk4_fp8(x4, x5, x6, x7); *(u32x2*)(x8row + (size_t)rt * 16 * DM + 32 * (ks)) = x8; } \
        const bf16x8 xh = __builtin_bit_cast(bf16x8, xq); \
        _Pragma("unroll") for (int ct = 0; ct < 3; ++ct) { \
            acc[rt][ct] = __builtin_amdgcn_mfma_f32_16x16x32_bf16(xh, bh##S[ct], acc[rt][ct], 0, 0, 0); \
            acc[rt][ct] = __builtin_amdgcn_mfma_f32_16x16x32_bf16(xh, bl##S[ct], acc[rt][ct], 0, 0, 0); } } } while (0)
__device__ __forceinline__ void router_phase(Frame& F, int l, int alt = 0) {
    const bf16* H1 = (const bf16*)(F.ws + WS_HN);
    const bf16* WRF = (const bf16*)(F.ws + WS_WRT) + (size_t)l * 64 * 3 * 2 * 64 * 8;
    unsigned* cnt = (unsigned*)(F.ws + WS_CTL) + CW_CNT + 2048 * l + 32768 * alt;
    int* tok = (int*)(F.ws + (alt ? WS_ALT : WS_TOK)); f32x4* tinfo = (f32x4*)(F.ws + (alt ? WS_ALT + 4 * MiB : WS_TINFO)); float* rslot = (float*)(F.ws + (alt ? WS_ALT + 2 * MiB : WS_RSLOT));
    const int lane = F.lane, tid = F.tid, w = F.wave, fr = lane & 15, g = lane >> 4;
    constexpr int PS = 49;
    LAS float* P = (LAS float*)F.lds;
    LAS float* SS = (LAS float*)(F.lds + 8 * 64 * PS * 4);
    for (int task = (int)blockIdx.x; task < SEQ / 64; task += F.G) {
        const bf16* xrow = H1 + (size_t)(task * 64 + fr) * DM + 256 * w + 8 * g;
        unsigned char* x8row = F.ws + WS_X8 + (size_t)(task * 64 + fr) * DM + 256 * w + 8 * g;
        const bf16* wf = WRF + ((size_t)(8 * w) * 3 * 2 * 64 + lane) * 8;
        f32x4 acc[4][3]; float ssq[4] = {0.f, 0.f, 0.f, 0.f};
#pragma unroll
        for (int rt = 0; rt < 4; ++rt)
#pragma unroll
            for (int ct = 0; ct < 3; ++ct) acc[rt][ct] = (f32x4){0.f, 0.f, 0.f, 0.f};
        u32x4 xaA[4], xaB[4]; bf16x8 bhA[3], blA[3], bhB[3], blB[3];
        ROUTER_LOAD(A, 0);
#pragma unroll 1
        for (int it = 0; it < 4; ++it) {
            ROUTER_LOAD(B, 1); __builtin_amdgcn_sched_barrier(0);
            ROUTER_STEP(A, 0); __builtin_amdgcn_sched_barrier(0);
            if (it < 3) ROUTER_LOAD(A, 2);
            __builtin_amdgcn_sched_barrier(0);
            ROUTER_STEP(B, 1); __builtin_amdgcn_sched_barrier(0);
            xrow += 64; x8row += 64; wf += 2 * 3072;
        }
#pragma unroll
        for (int rt = 0; rt < 4; ++rt) { float sq = ssq[rt]; sq += __shfl_xor(sq, 16); sq += __shfl_xor(sq, 32);
            if (g == 0) SS[w * 64 + 16 * rt + fr] = sq;
#pragma unroll
            for (int ct = 0; ct < 3; ++ct)
#pragma unroll
                for (int e = 0; e < 4; ++e) P[(w * 64 + 16 * rt + 4 * g + e) * PS + 16 * ct + fr] = acc[rt][ct][e]; }
        __syncthreads();
        if (tid < 64) {
            const int t = task * 64 + tid;
            float ss = 0.f;
#pragma unroll
            for (int q = 0; q < 8; ++q) ss += SS[q * 64 + tid];
            const float rs = __builtin_amdgcn_rsqf(ss * (1.f / DM) + EPS);
            const LAS float* pr = P + tid * PS;
            float lg[4];
#pragma unroll
            for (int o = 0; o < 4; ++o) { float a = 0.f;
#pragma unroll
                for (int q = 0; q < 8; ++q) a += pr[q * 64 * PS + 32 + o];
                lg[o] = a * rs + F.in[IN_BRG][l * 4 + o]; }
            int gi = 0; float gm = lg[0];
#pragma unroll
            for (int o = 1; o < 4; ++o) if (lg[o] > gm) { gm = lg[o]; gi = o; }
            float den = 0.f;
#pragma unroll
            for (int o = 0; o < 4; ++o) den += __expf(lg[o] - gm);
            const float gate_g = 1.f / den;
            float t1v = -INFINITY, t2v = -INFINITY; int t1i = 0, t2i = 0;
#pragma unroll
            for (int ii = 0; ii < 8; ++ii) { const int o = gi * 8 + ii; float a = 0.f;
#pragma unroll
                for (int q = 0; q < 8; ++q) a += pr[q * 64 * PS + o];
                const float v = a * rs + F.in[IN_BRE][l * NE + o];
                if (v > t1v) { t2v = t1v; t2i = t1i; t1v = v; t1i = ii; }
                else if (v > t2v) { t2v = v; t2i = ii; } }
            const float pp1 = 1.f / (1.f + __expf(t2v - t1v)), pp2 = 1.f - pp1;
            const int e0 = gi * 8 + t1i, e1 = gi * 8 + t2i;
            LAS unsigned* lcnt = (LAS unsigned*)(F.lds + 8 * 64 * PS * 4 + 8 * 64 * 4);
            if (tid < 32) lcnt[tid] = 0u;
            const unsigned r0 = __hip_atomic_fetch_add(lcnt + e0, 1u, __ATOMIC_RELAXED, __HIP_MEMORY_SCOPE_WORKGROUP), r1 = __hip_atomic_fetch_add(lcnt + e1, 1u, __ATOMIC_RELAXED, __HIP_MEMORY_SCOPE_WORKGROUP);
            if (tid < 32) { const unsigned c = lcnt[tid]; lcnt[32 + tid] = c ? atomicAdd(&cnt[tid * CNT_STRIDE], c) : 0u; }
            const unsigned s0 = lcnt[32 + e0] + r0, s1 = lcnt[32 + e1] + r1;
            tok[(size_t)e0 * TOKCAP + s0] = t; tok[(size_t)e1 * TOKCAP + s1] = t;
            rslot[(size_t)e0 * TOKCAP + s0] = rs; rslot[(size_t)e1 * TOKCAP + s1] = rs;
            f32x4 ti; ti[0] = __builtin_bit_cast(float, (int)(e0 * TOKCAP + s0)); ti[1] = __builtin_bit_cast(float, (int)(e1 * TOKCAP + s1)); ti[2] = gate_g * pp1; ti[3] = gate_g * pp2;
            tinfo[t] = ti;
        }
        __syncthreads();
    }
}
__device__ __forceinline__ void moe_table(Frame& F, int l) {
    const unsigned* cnt = (const unsigned*)(F.ws + WS_CTL) + CW_CNT + 2048 * l;
    LAS int* tstart = (LAS int*)(F.lds + MISC_OFF + 64);
    __syncthreads();
    if (F.tid == 0) { int acc = 0; for (int e = 0; e < NE; ++e) { tstart[e] = acc; acc += ((int)cnt[e * CNT_STRIDE] + 255) >> 8; } tstart[NE] = acc; }
    __syncthreads();
    { LAS int* tile_e = (LAS int*)(F.lds + MISC_OFF + 2304);
      if (F.tid < 160) { int e = 0; for (int j = 1; j < NE; ++j) e = (tstart[j] <= F.tid) ? j : e; tile_e[F.tid] = e; } }
    __syncthreads();
}
__device__ __forceinline__ void combine_phase(Frame& F, int l) {
    const LAS int* tstart = (const LAS int*)(F.lds + MISC_OFF + 64);
    const unsigned char* Y = F.ws + WS_Y; const f32x4* tinfo = (const f32x4*)(F.ws + WS_TINFO);
    bf16* H = (bf16*)(F.ws + WS_H); bf16* HN = (bf16*)(F.ws + WS_HN);
    const int gw = F.vcu * NWAVES + F.wave, NGW = F.G * NWAVES, lane = F.lane;
    const float* g1n = F.in[IN_NORM1] + (size_t)DM;
    for (int m = gw; m < SEQ; m += NGW) {
        const f32x4 ti = tinfo[m];
        const float tf0 = ti[0], tf1 = ti[1]; const int s0 = __builtin_bit_cast(int, tf0), s1 = __builtin_bit_cast(int, tf1);
        const int e0 = s0 >> 14, e1 = s1 >> 14;
        const size_t r0 = (size_t)tstart[e0] * 256 + (s0 & (TOKCAP - 1)), r1 = (size_t)tstart[e1] * 256 + (s1 & (TOKCAP - 1));
        const float ga = ti[2] * (1.f / Y_SCALE), gb = ti[3] * (1.f / Y_SCALE);
        f32x4 v[8]; float s = 0.f;
#pragma unroll
        for (int j = 0; j < 8; ++j) { const u32x2 hx = *(const u32x2*)(HN + (size_t)m * DM + 4 * lane + 256 * j);
            const int ya = *(const int*)(Y + r0 * DM + 4 * lane + 256 * j), yb = *(const int*)(Y + r1 * DM + 4 * lane + 256 * j);
            const f32x2 a01 = __builtin_amdgcn_cvt_pk_f32_fp8(ya, false), a23 = __builtin_amdgcn_cvt_pk_f32_fp8(ya, true), b01 = __builtin_amdgcn_cvt_pk_f32_fp8(yb, false), b23 = __builtin_amdgcn_cvt_pk_f32_fp8(yb, true);
            v[j][0] = bf_lo(hx.x) + ga * a01[0] + gb * b01[0]; v[j][1] = bf_hi(hx.x) + ga * a01[1] + gb * b01[1];
            v[j][2] = bf_lo(hx.y) + ga * a23[0] + gb * b23[0]; v[j][3] = bf_hi(hx.y) + ga * a23[1] + gb * b23[1];
            s += (v[j][0] * v[j][0] + v[j][1] * v[j][1]) + (v[j][2] * v[j][2] + v[j][3] * v[j][3]); }
        if (l == 0) {
            const float rs = __builtin_amdgcn_rsqf(wave_sum(s) * (1.f / DM) + EPS);
            bf16* hrow = H + (size_t)m * DM; bf16* orow = HN + (size_t)m * DM;
#pragma unroll
            for (int j = 0; j < 8; ++j) { const f32x4 gg = *(const f32x4*)(g1n + 4 * lane + 256 * j);
                u32x2 hb; hb.x = cvt_pk_bf16(v[j][0], v[j][1]); hb.y = cvt_pk_bf16(v[j][2], v[j][3]); *(u32x2*)(hrow + 4 * lane + 256 * j) = hb;
                if (IP8(1)) *(unsigned*)(F.ws + WS_X8 + (size_t)m * DM + 4 * lane + 256 * j) = pk4_fp8(v[j][0] * rs * gg[0], v[j][1] * rs * gg[1], v[j][2] * rs * gg[2], v[j][3] * rs * gg[3]);
                else { u32x2 o; o.x = cvt_pk_bf16(v[j][0] * rs * gg[0], v[j][1] * rs * gg[1]); o.y = cvt_pk_bf16(v[j][2] * rs * gg[2], v[j][3] * rs * gg[3]);
                *(u32x2*)(orow + 4 * lane + 256 * j) = o; } }
        } else {
            float* orow = F.out + (size_t)m * DM;
#pragma unroll
            for (int j = 0; j < 8; ++j) *(f32x4*)(orow + 4 * lane + 256 * j) = v[j];
        }
    }
}

__device__ __forceinline__ void relaunder(Frame& F) { F.lane = lane_now(); F.tid = F.wave * 64 + F.lane; }
constexpr int N_PHASES = 17;
#ifndef PHASE_MASK
#define PHASE_MASK 0x1ff
#endif
#ifndef MIX_MASK
#define MIX_MASK 7
#endif
#ifndef DUP_PHASE
#define DUP_PHASE 0
#endif
#define DUP(k) for (int _d = 0; _d < ((DUP_PHASE == (k)) ? 2 : 1); ++_d)
#define IN(k) (lo <= (k) && (k) < hi)
#define EN(b) ((PHASE_MASK >> (b)) & 1)
#ifndef PROBE_STAMP
#define PROBE_STAMP (-1)
#endif
#define SEAM(k) do { if (IN(k) && IN((k) + 1)) { xcd_barrier(bar); if (PROBE_STAMP >= 0 && blockIdx.x == 0 && F.tid == 0) { const unsigned long long _t = wall_clock64(); F.MISC[802 + 2 * (k)] = (unsigned)_t; F.MISC[803 + 2 * (k)] = (unsigned)(_t >> 32); } } } while (0)
template <int l>
__device__ __forceinline__ void layer_phases(Frame& F, const XcdBarrier& bar, const int lo, const int hi) {
    constexpr int pb = 1 + 8 * l;
    relaunder(F);
    if (EN(1) && IN(pb)) {
        constexpr int KI = IP8(l) ? DM / 2 : DM;
        pg8::StaticSched S; S.init((const bf16*)(F.ws + (IP8(l) ? WS_X8 : WS_HN)), (const bf16*)(F.ws + WS_WIN) + (size_t)l * DIN * DM, SEQ, DIN, KI, F.G, (int)blockIdx.x);
        pg8::EpiProj E{(bf16*)(F.ws + WS_PROJ), IP8(l) ? 1.f / WIN_SCALE : 1.f};
        DUP(1) pg8::gemm_phase<pg8::EpiProj, pg8::StaticSched, true, IP8(l) != 0>(F.lds, KI, S, E, F.wave);
    }
    SEAM(pb);
    relaunder(F);
    if (EN(2) && IN(pb + 1)) {
        constexpr int N_SGU = 256, N_CONV = 512, N_ATT = 3072;
#define MSTAMP(i) do { if (PROBE_STAMP >= 100 && l == 0 && blockIdx.x == 0 && F.tid == 0) { const unsigned long long _t = wall_clock64(); F.MISC[900 + 2 * (i)] = (unsigned)_t; F.MISC[901 + 2 * (i)] = (unsigned)(_t >> 32); } } while (0)
        MSTAMP(0);
        if (MIX_MASK & 1) DUP(2) att_phase(F, l);
        MSTAMP(1);
        if (MIX_MASK & 2) DUP(3) for (int it = (int)blockIdx.x; it < N_CONV; it += F.G) conv_item(F, l, it);
        MSTAMP(2);
        if (MIX_MASK & 4) DUP(4) for (int it = (int)blockIdx.x; it < N_SGU; it += F.G) sgu_item(F, l, it >> 1, it & 1);
        MSTAMP(3);
#undef MSTAMP
    }
    SEAM(pb + 1);
    if (DUP_PHASE == 12 && IN(pb + 1)) {
        pg8::StaticSched S; S.init((const bf16*)(F.ws + WS_MIX), (const bf16*)(F.ws + WS_WIN) + (size_t)l * DIN * DM, SEQ, DIN, DM, F.G, (int)blockIdx.x);
        pg8::EpiProj E{(bf16*)(F.ws + WS_PROJ), 1.f};
        pg8::gemm_phase<pg8::EpiProj, pg8::StaticSched>(F.lds, DM, S, E, F.wave);
        xcd_barrier(bar);
    }
    relaunder(F);
    if (EN(3) && IN(pb + 2)) DUP(5) att_combine(F, l);
    SEAM(pb + 2);
    relaunder(F);
    if (EN(4) && IN(pb + 3)) {
        constexpr int KO = OP8(l) ? DM / 2 : DM;
        pg8::StaticSched S; S.init((const bf16*)(F.ws + WS_MIX), (const bf16*)(F.ws + WS_WOUT) + (size_t)l * DM * DM, SEQ, DM, KO, F.G, (int)blockIdx.x);
        if constexpr (l == 0) { pg8::EpiResid<false> E{(const void*)F.in[IN_X], (bf16*)(F.ws + WS_HN)}; DUP(6) pg8::gemm_phase<pg8::EpiResid<false>, pg8::StaticSched, true, OP8(l) != 0>(F.lds, KO, S, E, F.wave); }
        else { pg8::EpiResid<true> E{(const void*)(F.ws + WS_H), (bf16*)(F.ws + WS_HN)}; DUP(6) pg8::gemm_phase<pg8::EpiResid<true>, pg8::StaticSched, true, OP8(l) != 0>(F.lds, KO, S, E, F.wave); }
    }
    SEAM(pb + 3);
    relaunder(F);
    if (EN(5) && IN(pb + 4)) { router_phase(F, l); if (DUP_PHASE == 11) router_phase(F, l, 1); }
    if (DUP_PHASE == 13 && IN(pb + 4)) { for (int q = 0; q < 8; ++q) xcd_barrier(bar); }
    SEAM(pb + 4);
    relaunder(F);
    if (EN(6) && IN(pb + 5)) {
        moe_table(F, l);
        unsigned* ready = (unsigned*)(F.ws + WS_CTL) + CW_RDY + 16384 * l;
        {
            pg8::SchedG1 S{(const LAS int*)(F.lds + MISC_OFF + 64), (const int*)((const unsigned*)(F.ws + WS_CTL) + CW_CNT + 2048 * l), (const int*)(F.ws + WS_TOK), (const bf16*)(F.ws + WS_X8),
                           (const bf16*)(F.ws + WS_W1 + (size_t)l * NE * 1024 * DM), F.G, (int)blockIdx.x, ready};
            pg8::EpiSwiGLU E{F.ws + WS_HB, (const float*)(F.ws + WS_RSLOT)};
            DUP(7) pg8::gemm_phase<pg8::EpiSwiGLU, pg8::SchedG1, true, true>(F.lds, DM / 2, S, E, F.wave);
        }
        {
            pg8::SchedG2 S{(const LAS int*)(F.lds + MISC_OFF + 64), (const bf16*)(F.ws + WS_HB), (const bf16*)(F.ws + WS_W2 + (size_t)l * NE * DM * DE), F.G, (int)blockIdx.x, ready, (unsigned*)(F.ws + WS_CTL) + CW_TMO, F.wave};
            pg8::EpiY E{F.ws + WS_Y};
            DUP(8) pg8::gemm_phase<pg8::EpiY, pg8::SchedG2, true, true>(F.lds, DE / 2, S, E, F.wave);
        }
    }
    SEAM(pb + 6);
    relaunder(F);
    if (EN(8) && IN(pb + 7)) { moe_table(F, l); DUP(l == 0 ? 9 : 99) combine_phase(F, l); }
    SEAM(pb + 7);
}
__global__ void __launch_bounds__(NTHREADS, 2) fwd_kernel(Params args) {
    extern __shared__ __attribute__((aligned(16))) unsigned char lds_raw[];
    Frame F;
    F.lds = (LAS unsigned char*)lds_raw; F.MISC = (volatile LAS unsigned*)(F.lds + MISC_OFF);
    F.tid = threadIdx.x; F.lane = F.tid & 63; F.wave = __builtin_amdgcn_readfirstlane(F.tid >> 6);
    F.G = gridDim.x; { const int bx = blockIdx.x; F.vcu = (F.G % 8 == 0) ? (bx % 8) * (F.G / 8) + bx / 8 : bx; }
    F.in = args.in; F.out = args.out; F.ws = args.ws;
    for (int u = F.tid; u < (LDS_BYTES - MISC_OFF) / 4; u += NTHREADS) ((LAS unsigned*)(F.lds + MISC_OFF))[u] = 0u;
    __syncthreads();
    unsigned* ctl = (unsigned*)(args.ws + WS_CTL);
    const int lo = args.ph_lo, hi = args.ph_hi;
    const bool multi = (hi - lo) > 1;
    XcdBarrier bar; bar.bar = ctl + CW_BAR; bar.x = 0; bar.st = nullptr; bar.lead = 0;
    if (multi) bar = xcd_barrier_post(ctl + CW_BAR, F.MISC, F.wave == 0 ? 1u : 0u);
    if (PROBE_STAMP >= 0 && blockIdx.x == 0 && F.tid == 0) { const unsigned long long _t = wall_clock64(); F.MISC[800] = (unsigned)_t; F.MISC[801] = (unsigned)(_t >> 32); }
    if (EN(0) && IN(0)) { DUP(10) p_prologue(F); }
    SEAM(0);
    layer_phases<0>(F, bar, lo, hi);
    layer_phases<1>(F, bar, lo, hi);
    if (PROBE_STAMP >= 0 && blockIdx.x == 0 && F.tid == 0) {
        asm volatile("s_waitcnt vmcnt(0)" ::: "memory");
        constexpr int SB = PROBE_STAMP >= 100 ? 900 + 2 * (PROBE_STAMP - 100) : (PROBE_STAMP == 6 ? 812 : 800 + 2 * PROBE_STAMP);
        constexpr int SB1 = (PROBE_STAMP == 6) ? SB + 4 : SB + 2;
        const unsigned long long t1 = ((unsigned long long)F.MISC[SB1 + 1] << 32) | F.MISC[SB1], t0 = ((unsigned long long)F.MISC[SB + 1] << 32) | F.MISC[SB];
        F.out[0] += (float)(long long)(t1 - t0) * 0.01f;
    }
}
#undef IN
#undef EN
#undef SEAM
#undef DUP

extern "C" void kernel_launch(void* const* d_in, const int* in_sizes, int n_in, void* d_out, int out_size, void* d_ws, size_t ws_size, hipStream_t stream) {
    static int grid = 0;
    if (grid == 0) {
        if (n_in != 22 || out_size != SEQ * DM || ws_size < WS_END) { fprintf(stderr, "kernel_launch: unexpected shapes (n_in %d out %d ws %zu, need %zu)\n", n_in, out_size, ws_size, (size_t)WS_END); grid = -1; return; }
        int dev = 0, cus = 0, per_cu = 0;
        if (hipGetDevice(&dev) != hipSuccess || hipDeviceGetAttribute(&cus, hipDeviceAttributeMultiprocessorCount, dev) != hipSuccess) { grid = -1; return; }
        if (hipFuncSetAttribute((const void*)fwd_kernel, hipFuncAttributeMaxDynamicSharedMemorySize, LDS_BYTES) != hipSuccess) { fprintf(stderr, "kernel_launch: hipFuncSetAttribute failed\n"); grid = -1; return; }
        if (hipOccupancyMaxActiveBlocksPerMultiprocessor(&per_cu, (const void*)fwd_kernel, NTHREADS, LDS_BYTES) != hipSuccess || per_cu < 1) { fprintf(stderr, "kernel_launch: occupancy query says %d\n", per_cu); }
        (void)hipGetLastError();
        grid = cus;
    }
    if (grid < 0) return;
    if (hipMemsetAsync((char*)d_ws + WS_CTL, 0, CTL_ZERO_BYTES, stream) != hipSuccess) return;
    Params p{};
    for (int i = 0; i < 22; ++i) p.in[i] = (const float*)d_in[i];
    p.out = (float*)d_out; p.ws = (unsigned char*)d_ws;
    constexpr int NL = MK_N_LAUNCHES;
    for (int li = 0; li < NL; ++li) {
        p.ph_lo = (NL == 1) ? 0 : li; p.ph_hi = (NL == 1) ? N_PHASES : li + 1;
        hipLaunchKernelGGL(fwd_kernel, dim3(grid), dim3(NTHREADS), LDS_BYTES, stream, p);
        if (hipPeekAtLastError() != hipSuccess) { fprintf(stderr, "kernel_launch: launch %d failed\n", li); break; }
    }
}
```

```cpp
#include <hip/hip_runtime.h>
#include <cstdio>
#include <cstdint>

#ifndef MK_N_LAUNCHES
#define MK_N_LAUNCHES 1
#endif

#ifndef OUTPROJ_FP8
#define OUTPROJ_FP8 2
#endif
#ifndef ATT_EXP
#define ATT_EXP 0
#endif
#define OP8(l) ((OUTPROJ_FP8 >> (l)) & 1)
#ifndef INPROJ_FP8
#define INPROJ_FP8 2
#endif
#define IP8(l) ((INPROJ_FP8 >> (l)) & 1)
#define GAS __attribute__((address_space(1)))
#define LAS __attribute__((address_space(3)))
typedef unsigned short bf16;
typedef short bf16x8 __attribute__((ext_vector_type(8)));
typedef short s16x4 __attribute__((ext_vector_type(4)));
typedef float f32x4 __attribute__((ext_vector_type(4)));
typedef float f32x2 __attribute__((ext_vector_type(2)));
typedef unsigned u32x4 __attribute__((ext_vector_type(4)));
typedef unsigned u32x2 __attribute__((ext_vector_type(2)));

constexpr int SEQ = 16384, DM = 2048, DIN = 5120, NLAYER = 2;
constexpr int HD = 128, NHEAD = 8, CONV_K = 31;
constexpr int NE = 32, DE = 512, TOKCAP = 16384;
constexpr int OFF_U = 0, OFF_V = 512, OFF_A = 1024, OFF_G = 1536, OFF_Q = 2048, OFF_K = 3072, OFF_VV = 4096;
constexpr float EPS = 1e-6f;
constexpr float W1_SCALE = 64.f, W2_SCALE = 32.f, WOUT_SCALE = 64.f, WIN_SCALE = 64.f, Y_SCALE = 16.f;
constexpr int NWAVES = 8, NTHREADS = 512;

constexpr size_t MiB = 1u << 20;
constexpr size_t WS_CTL = 0, CTL_ZERO_BYTES = 1 * MiB;
constexpr size_t WS_WIN = 1 * MiB;
constexpr size_t WS_WOUT = 41 * MiB;
constexpr size_t WS_W1 = 57 * MiB;
constexpr size_t WS_X8 = 185 * MiB;
constexpr size_t WS_W2 = 313 * MiB;
constexpr size_t WS_SGUW = 441 * MiB;
constexpr size_t WS_WRT = 442 * MiB;
constexpr size_t WS_TOK = 443 * MiB;
constexpr size_t WS_TINFO = 445 * MiB;
constexpr size_t WS_HN = 446 * MiB;
constexpr size_t WS_HB = 510 * MiB;
constexpr size_t WS_ATT = WS_HN;
constexpr size_t WS_LSE = WS_HN + 96 * MiB;
constexpr size_t WS_PROJ = 550 * MiB;
constexpr size_t WS_Y = WS_PROJ;
constexpr size_t WS_MIX = 710 * MiB;
constexpr size_t WS_H = 774 * MiB;
constexpr size_t WS_RSLOT = 902 * MiB;
constexpr size_t WS_ALT = 904 * MiB;
constexpr size_t WS_END = 910 * MiB;
constexpr int CW_BAR = 4096;
constexpr int CW_TMO = 0;
constexpr int CW_RDY = 65536;
constexpr int CW_CNT = 16384, CNT_STRIDE = 64;

constexpr int LDS_BYTES = 163840;
constexpr int MISC_OFF = 159744;

__device__ __forceinline__ unsigned cvt_pk_bf16(float lo, float hi) { unsigned r; asm volatile("v_cvt_pk_bf16_f32 %0, %1, %2" : "=v"(r) : "v"(lo), "v"(hi)); return r; }
__device__ __forceinline__ unsigned pk4_fp8(float a, float b, float c, float d) { int p = 0; p = __builtin_amdgcn_cvt_pk_fp8_f32(a, b, p, false); p = __builtin_amdgcn_cvt_pk_fp8_f32(c, d, p, true); return (unsigned)p; }
__device__ __forceinline__ float bf_lo(unsigned u) { return __builtin_bit_cast(float, u << 16); }
__device__ __forceinline__ float bf_hi(unsigned u) { return __builtin_bit_cast(float, u & 0xffff0000u); }
template <int CTRL, int RM> __device__ __forceinline__ float dpp_mov0(float v) { return __builtin_bit_cast(float, __builtin_amdgcn_update_dpp(0, __builtin_bit_cast(int, v), CTRL, RM, 0xf, false)); }
__device__ __forceinline__ float wave_sum(float s) {
    s += dpp_mov0<0xB1, 0xf>(s); s += dpp_mov0<0x4E, 0xf>(s); s += dpp_mov0<0x141, 0xf>(s); s += dpp_mov0<0x140, 0xf>(s);
    s += dpp_mov0<0x142, 0xa>(s); s += dpp_mov0<0x143, 0xc>(s);
    return __builtin_bit_cast(float, __builtin_amdgcn_readlane(__builtin_bit_cast(int, s), 63));
}
__device__ __forceinline__ float row16_sum(float s) {
    s += dpp_mov0<0xB1, 0xf>(s); s += dpp_mov0<0x4E, 0xf>(s); s += dpp_mov0<0x141, 0xf>(s); s += dpp_mov0<0x140, 0xf>(s); return s;
}
__device__ __forceinline__ float sum4(float x) {
    const unsigned xu = __builtin_bit_cast(unsigned, x); const auto r = __builtin_amdgcn_permlane16_swap(xu, xu, false, false); const unsigned r0 = r[0], r1 = r[1];
    const float a = __builtin_bit_cast(float, r0) + __builtin_bit_cast(float, r1);
    const unsigned au = __builtin_bit_cast(unsigned, a); const auto q = __builtin_amdgcn_permlane32_swap(au, au, false, false); const unsigned q0 = q[0], q1 = q[1];
    return __builtin_bit_cast(float, q0) + __builtin_bit_cast(float, q1);
}
__device__ __forceinline__ float max4(float x) {
    const unsigned xu = __builtin_bit_cast(unsigned, x); const auto r = __builtin_amdgcn_permlane16_swap(xu, xu, false, false); const unsigned r0 = r[0], r1 = r[1];
    const float a = fmaxf(__builtin_bit_cast(float, r0), __builtin_bit_cast(float, r1));
    const unsigned au = __builtin_bit_cast(unsigned, a); const auto q = __builtin_amdgcn_permlane32_swap(au, au, false, false); const unsigned q0 = q[0], q1 = q[1];
    return fmaxf(__builtin_bit_cast(float, q0), __builtin_bit_cast(float, q1));
}
__device__ __forceinline__ int lane_now() { int l; asm volatile("v_mbcnt_lo_u32_b32 %0, -1, 0\n\tv_mbcnt_hi_u32_b32 %0, -1, %0" : "=v"(l)); return l; }
#define LDS_WAIT() asm volatile("s_waitcnt lgkmcnt(0)" ::: "memory")
#define VM_WAIT() asm volatile("s_waitcnt vmcnt(0)" ::: "memory")
__device__ __forceinline__ float fast_exp(float x) { return __builtin_amdgcn_exp2f(x * 1.4426950408889634f); }
__device__ __forceinline__ float sigmoidf_(float x) { return __builtin_amdgcn_rcpf(1.0f + fast_exp(-x)); }
__device__ __forceinline__ float gelu_tanh(float x) { const float z = 1.5957691216057308f * (x + 0.044715f * x * x * x); return x * sigmoidf_(z); }

#define XB_TMO      128
#define XB_XCNT(j)  (256  + 64 * (j))
#define XB_XSUB(j)  (1280 + 64 * (j))
#define XB_XGEN(j)  (2304 + 64 * (j))
#define XB_TOP      3328
#define XB_TOPGEN   3392
#define XCD_BAR_WORDS 3456
#define XB_SPIN_CAP (1u << 22)
__device__ __forceinline__ unsigned xb_ld(unsigned* p)              { return __hip_atomic_load(p, __ATOMIC_RELAXED, __HIP_MEMORY_SCOPE_AGENT); }
__device__ __forceinline__ unsigned xb_add(unsigned* p, unsigned v) { return __hip_atomic_fetch_add(p, v, __ATOMIC_RELAXED, __HIP_MEMORY_SCOPE_AGENT); }
__device__ __forceinline__ unsigned xb_xcc_id() { return (unsigned)__builtin_amdgcn_s_getreg((3 << 11) | 20) & 0xFu; }
#define XB_SPIN(cond, bar) do { unsigned _sp = 0; while (cond) { __builtin_amdgcn_s_sleep(1); \
    if ((++_sp & 255u) == 0u) { if (xb_ld(&(bar)[XB_TMO])) break; if (_sp > XB_SPIN_CAP) { atomicAdd(&(bar)[XB_TMO], 1u); break; } } } } while (0)
struct XcdBarrier { unsigned* bar; unsigned x; volatile LAS unsigned* st; unsigned lead; };
__device__ __forceinline__ XcdBarrier xcd_barrier_post(unsigned* bar, volatile LAS unsigned* st, unsigned lead) {
    XcdBarrier b; b.bar = bar; b.x = xb_xcc_id(); b.st = st; b.lead = lead;
    if (lead && lane_now() == 0) (void)xb_add(&bar[XB_XCNT(b.x)], 1u);
    return b;
}
__device__ __forceinline__ void xcd_barrier_complete(unsigned* bar, unsigned x, unsigned& nloc, unsigned& nx) {
    const unsigned G = gridDim.x * gridDim.y * gridDim.z;
    unsigned sum, cnt, mine, sp = 0u;
    for (;;) {
        sum = 0u; cnt = 0u; mine = 0u;
#pragma unroll
        for (unsigned j = 0; j < 16; ++j) { const unsigned c = xb_ld(&bar[XB_XCNT(j)]); sum += c; cnt += (c > 0u) ? 1u : 0u; mine = (j == x) ? c : mine; }
        if (sum == G) break;
        __builtin_amdgcn_s_sleep(1);
        if ((++sp & 255u) == 0u) { if (xb_ld(&bar[XB_TMO])) break; if (sp > XB_SPIN_CAP) { atomicAdd(&bar[XB_TMO], 1u); break; } }
    }
    nloc = mine > 0u ? mine : 1u; nx = cnt > 0u ? cnt : 1u;
}
__device__ __forceinline__ void xcd_barrier(const XcdBarrier& b) {
    asm volatile("s_waitcnt vmcnt(0)" ::: "memory");
    __syncthreads();
    if (b.lead && lane_now() == 0) {
        unsigned* bar = b.bar;
        __builtin_amdgcn_s_waitcnt(0);
        unsigned nloc = b.st[0], nx = b.st[1];
        if (nloc == 0u) { xcd_barrier_complete(bar, b.x, nloc, nx); b.st[0] = nloc; b.st[1] = nx; }
        const unsigned old = xb_add(&bar[XB_XSUB(b.x)], 1u);
        const unsigned gen = old / nloc;
        if (old + 1u == (gen + 1u) * nloc) {
            __builtin_amdgcn_fence(__ATOMIC_RELEASE, "agent");
            asm volatile("s_waitcnt vmcnt(0)" ::: "memory");
            const unsigned og = xb_add(&bar[XB_TOP], 1u);
            const unsigned tg = og / nx;
            if (og + 1u == (tg + 1u) * nx) xb_add(&bar[XB_TOPGEN], 1u);
            else XB_SPIN(xb_ld(&bar[XB_TOPGEN]) == tg, bar);
            __builtin_amdgcn_fence(__ATOMIC_ACQUIRE, "agent");
            xb_add(&bar[XB_XGEN(b.x)], 1u);
            asm volatile("s_waitcnt vmcnt(0)" ::: "memory");
        } else {
            XB_SPIN(xb_ld(&bar[XB_XGEN(b.x)]) == gen, bar);
            __builtin_amdgcn_fence(__ATOMIC_ACQUIRE, "agent");
            asm volatile("s_waitcnt vmcnt(0)" ::: "memory");
        }
    }
    __syncthreads();
}

namespace pg8 {
constexpr int BM = 256, BK = 64, HALF = 128, HTB = HALF * BK * 2, STAGE_BYTES = 8 * HTB, NXCD = 8, WGM = 8;
__device__ __forceinline__ int lds_byte(int r, int c) { const int st = (r >> 4) * 2 + (c >> 5), rr = r & 15, cc = c & 31, ob = rr * 64 + cc * 2; return st * 1024 + (ob ^ (((ob >> 9) & 1) << 5)); }
__device__ __forceinline__ void stage_rc(int b, int& R, int& C) { const int st = b / 1024, sb = b % 1024, swz = sb ^ (((sb >> 9) & 1) << 5); R = (st >> 1) * 16 + swz / 64; C = (st & 1) * 32 + (swz % 64) / 2; }
__device__ __forceinline__ int perm32(int rho) { const int n = rho >> 4, i = rho & 15; return 8 * (i >> 2) + 4 * n + (i & 3); }

struct Unit { int pm, pn, e, rb; };

struct StaticSched {
    static constexpr bool GATHER = false;
    const bf16* A; const bf16* Bt; int K; int nM, nN, nwg, G, c;
    __device__ __forceinline__ void init(const bf16* A_, const bf16* Bt_, int M, int N, int K_, int G_, int c_) { A = A_; Bt = Bt_; K = K_; nM = M / BM; nN = N / BM; nwg = nM * nN; G = G_; c = c_; }
    __device__ __forceinline__ bool next(int i, Unit& u) const {
        const long L = (long)i * G + c; if (L >= nwg) return false;
        int wgid = (int)L; { const int q = nwg / NXCD, r = nwg % NXCD, xcd = wgid % NXCD, off = wgid / NXCD; wgid = (xcd < r ? xcd * (q + 1) : r * (q + 1) + (xcd - r) * q) + off; }
        const int nig = WGM * nN, gid = wgid / nig, fm = gid * WGM, gsz = (nM - fm) < WGM ? (nM - fm) : WGM;
        u.pm = fm + ((wgid % nig) % gsz); u.pn = (wgid % nig) / gsz; u.e = 0; u.rb = 0; return true;
    }
    __device__ __forceinline__ void a_ready(const Unit&) const {}
    __device__ __forceinline__ void done(const Unit&) const {}
    __device__ __forceinline__ const char* a_base(const Unit& u) const { return (const char*)A + (size_t)u.pm * BM * K * 2; }
    __device__ __forceinline__ const char* b_base(const Unit& u) const { return (const char*)Bt + (size_t)u.pn * BM * K * 2; }
    __device__ __forceinline__ void a_voff(const Unit&, const int (&R)[2], const int (&C)[2], unsigned (&v)[2][2]) const {
#pragma unroll
        for (int h = 0; h < 2; ++h)
#pragma unroll
            for (int i = 0; i < 2; ++i) v[h][i] = (unsigned)((h * HALF + R[i]) * K + C[i]) * 2u;
    }
};

typedef int v8i __attribute__((ext_vector_type(8)));
typedef int v4i __attribute__((ext_vector_type(4)));
template <class Epi, class Sched, bool ALIGN_EPI = true, bool FP8 = false>
__device__ __forceinline__ void gemm_phase(LAS unsigned char* lds, const int K, const Sched& S, const Epi& E, const int wave) {
    const int lane = lane_now(), wid = wave, tid = wid * 64 + lane,
              wr = wid >> 2, wc = wid & 3, fr = lane & 15, fq = lane >> 4;
    const int nt = K / BK;
    int Rr[2], Cc[2]; unsigned voffB[2];
#pragma unroll
    for (int i = 0; i < 2; ++i) { stage_rc(tid * 16 + i * 8192, Rr[i], Cc[i]); const int Rb = Epi::PERM ? ((Rr[i] & ~31) + perm32(Rr[i] & 31)) : Rr[i];
        voffB[i] = (unsigned)(Rb * K + Cc[i]) * 2u; }
    const size_t kstep = (size_t)(BK * 2);
    const size_t hstep = (size_t)HALF * K * 2;
    const unsigned ldsw = (unsigned)wid * 1024u;
    const unsigned ldsbase = (unsigned)__builtin_amdgcn_readfirstlane((int)(unsigned)(size_t)lds);
    const int aoff = lds_byte(wr * 64 + fr, fq * 8), boff = lds_byte(wc * 32 + fr, fq * 8);
#define PG8_SA(b, h) (((b) * 2 + (h)) * HTB)
#define PG8_SB(b, h) ((4 + (b) * 2 + (h)) * HTB)
#define PG8_STAGE(bufoff, gbase, voff) do { _Pragma("unroll") for (int _i = 0; _i < 2; ++_i) { unsigned _keep; \
        asm volatile("s_mov_b32 %0, m0\n\ts_mov_b32 m0, %3\n\ts_nop 0\n\tglobal_load_lds_dwordx4 %1, %2\n\ts_mov_b32 m0, %0" : "=&s"(_keep) : "v"((voff)[_i]), "s"((const char*)(gbase)), "s"(ldsbase + (unsigned)(bufoff) + ldsw + (unsigned)(_i * 8192)) : "memory"); } } while (0)
#define PG8_LDA(dst, b, h) do { _Pragma("unroll") for (int m = 0; m < 4; ++m) _Pragma("unroll") for (int k = 0; k < 2; ++k) dst[m][k] = *(const LAS bf16x8*)(lds + PG8_SA(b, h) + aoff + m * 2048 + k * 1024); } while (0)
#define PG8_LDB(dst, b, h) do { _Pragma("unroll") for (int n = 0; n < 2; ++n) _Pragma("unroll") for (int k = 0; k < 2; ++k) dst[n][k] = *(const LAS bf16x8*)(lds + PG8_SB(b, h) + boff + n * 2048 + k * 1024); } while (0)
#define PG8_LDA8(dst, b, h) do { _Pragma("unroll") for (int m = 0; m < 4; ++m) { const v4i lo_ = *(const LAS v4i*)(lds + PG8_SA(b, h) + aoff + m * 2048), hi_ = *(const LAS v4i*)(lds + PG8_SA(b, h) + aoff + m * 2048 + 1024); dst[m] = __builtin_shufflevector(lo_, hi_, 0, 1, 2, 3, 4, 5, 6, 7); } } while (0)
#define PG8_LDB8(dst, b, h) do { _Pragma("unroll") for (int n = 0; n < 2; ++n) { const v4i lo_ = *(const LAS v4i*)(lds + PG8_SB(b, h) + boff + n * 2048), hi_ = *(const LAS v4i*)(lds + PG8_SB(b, h) + boff + n * 2048 + 1024); dst[n] = __builtin_shufflevector(lo_, hi_, 0, 1, 2, 3, 4, 5, 6, 7); } } while (0)
#define PG8_MMA(ai, bj, At, Bt) do { __builtin_amdgcn_s_setprio(1); _Pragma("unroll") for (int m = 0; m < 4; ++m) _Pragma("unroll") for (int n = 0; n < 2; ++n) _Pragma("unroll") for (int k = 0; k < 2; ++k) \
        acc[ai][bj][m][n] = __builtin_amdgcn_mfma_f32_16x16x32_bf16(Bt[n][k], At[m][k], acc[ai][bj][m][n], 0, 0, 0); __builtin_amdgcn_s_setprio(0); } while (0)
#define PG8_MMA8(ai, bj, At, Bt) do { __builtin_amdgcn_s_setprio(1); _Pragma("unroll") for (int m = 0; m < 4; ++m) _Pragma("unroll") for (int n = 0; n < 2; ++n) \
        acc[ai][bj][m][n] = __builtin_amdgcn_mfma_scale_f32_16x16x128_f8f6f4(Bt[n], At[m], acc[ai][bj][m][n], 0, 0, 0, 0, 0, 0); __builtin_amdgcn_s_setprio(0); } while (0)
#define LDA_(b, h) do { if constexpr (FP8) PG8_LDA8(At8, b, h); else PG8_LDA(At, b, h); } while (0)
#define LDB0_(b, h) do { if constexpr (FP8) PG8_LDB8(B08, b, h); else PG8_LDB(B0, b, h); } while (0)
#define LDB1_(b, h) do { if constexpr (FP8) PG8_LDB8(B18, b, h); else PG8_LDB(B1, b, h); } while (0)
#define MMA0_(ai, bj) do { if constexpr (FP8) PG8_MMA8(ai, bj, At8, B08); else PG8_MMA(ai, bj, At, B0); } while (0)
#define MMA1_(ai, bj) do { if constexpr (FP8) PG8_MMA8(ai, bj, At8, B18); else PG8_MMA(ai, bj, At, B1); } while (0)
#define PG8_WAIT_V(n) asm volatile("s_waitcnt vmcnt(" #n ")" ::: "memory")
#define PG8_WAIT_L(n) asm volatile("s_waitcnt lgkmcnt(" #n ")" ::: "memory")
#define PG8_BAR __builtin_amdgcn_s_barrier()
#define PG8_SCHED __builtin_amdgcn_sched_barrier(0)
    Unit cur, nxt; int ui = 0;
    if (!S.next(0, cur)) return;
    f32x4 acc[2][2][4][2];
#pragma unroll
    for (int a = 0; a < 2; ++a)
#pragma unroll
        for (int b = 0; b < 2; ++b)
#pragma unroll
            for (int m = 0; m < 4; ++m)
#pragma unroll
                for (int n = 0; n < 2; ++n) acc[a][b][m][n] = (f32x4){0.f, 0.f, 0.f, 0.f};
    bf16x8 At[4][2], B0[2][2], B1[2][2]; v8i At8[4], B08[2], B18[2];
    const char* cA = S.a_base(cur); const char* cB = S.b_base(cur);
    S.a_ready(cur);
    constexpr bool GATHER = Sched::GATHER;
    unsigned vA[1][2];
    LAS unsigned* goff = (LAS unsigned*)(lds + STAGE_BYTES) + tid;
    int gslot = 0;
    constexpr bool LOFF = GATHER || FP8;
    if constexpr (!GATHER && FP8) { goff[8 * 512] = voffB[0]; goff[9 * 512] = voffB[1]; goff[10 * 512] = (unsigned)(Rr[0] * K + Cc[0]) * 2u; goff[11 * 512] = (unsigned)(Rr[1] * K + Cc[1]) * 2u; }
    if constexpr (GATHER) { unsigned t4[2][2]; S.a_voff(cur, Rr, Cc, t4); goff[0 * 512] = t4[0][0]; goff[1 * 512] = t4[0][1]; goff[2 * 512] = t4[1][0]; goff[3 * 512] = t4[1][1]; goff[8 * 512] = voffB[0]; goff[9 * 512] = voffB[1]; }
    else {
#pragma unroll
        for (int i = 0; i < 2; ++i) vA[0][i] = (unsigned)(Rr[i] * K + Cc[i]) * 2u; }
    const size_t ahstep = GATHER ? 0 : hstep;
#define PG8_STAGE_B(bufoff, kptr) do { if constexpr (LOFF) { unsigned _o[2]; _o[0] = goff[8 * 512]; _o[1] = goff[9 * 512]; PG8_STAGE(bufoff, kptr, _o); } else PG8_STAGE(bufoff, kptr, voffB); } while (0)
#define PG8_STAGE_A(bufoff, kptr, h, nx) do { if constexpr (GATHER) { unsigned _o[2]; const int _s = (gslot ^ (nx)) * 2048 + (h) * 1024; _o[0] = goff[_s]; _o[1] = goff[_s + 512]; PG8_STAGE(bufoff, kptr, _o); } \
        else if constexpr (FP8) { unsigned _o[2]; _o[0] = goff[10 * 512]; _o[1] = goff[11 * 512]; PG8_STAGE(bufoff, (kptr) + (h) * ahstep, _o); } \
        else PG8_STAGE(bufoff, (kptr) + (h) * ahstep, vA[0]); } while (0)
    PG8_STAGE(PG8_SB(0, 0), cB, voffB); PG8_STAGE(PG8_SB(0, 1), cB + hstep, voffB); PG8_STAGE_A(PG8_SA(0, 0), cA, 0, 0); PG8_STAGE_A(PG8_SA(0, 1), cA, 1, 0);
    if (wr == 1) PG8_BAR;
    PG8_WAIT_V(2); PG8_BAR;
    PG8_STAGE(PG8_SB(1, 0), cB + kstep, voffB); PG8_STAGE_A(PG8_SA(1, 0), cA + kstep, 0, 0); PG8_STAGE(PG8_SB(1, 1), cB + hstep + kstep, voffB);
    PG8_WAIT_V(6); PG8_BAR;
    for (;;) {
        const bool has_next = S.next(ui + 1, nxt);
        const char* nA = has_next ? S.a_base(nxt) : cA; const char* nB = has_next ? S.b_base(nxt) : cB;
        if constexpr (GATHER) { if (has_next) { unsigned t4[2][2]; int tl_ = tid; asm volatile("" : "+v"(tl_)); int R2[2], C2[2]; stage_rc(tl_ * 16, R2[0], C2[0]); stage_rc(tl_ * 16 + 8192, R2[1], C2[1]); S.a_voff(nxt, R2, C2, t4); const int o = (gslot ^ 1) * 2048; goff[o] = t4[0][0]; goff[o + 512] = t4[0][1]; goff[o + 1024] = t4[1][0]; goff[o + 1536] = t4[1][1]; } }
#pragma unroll 1
        for (int t = 0; t < nt; t += 2) {
            const bool last = (t == nt - 2);
            const char* a1 = cA + (size_t)(t + 1) * kstep;
            const char* a2 = last ? nA : cA + (size_t)(t + 2) * kstep; const char* b2 = last ? nB : cB + (size_t)(t + 2) * kstep;
            const char* a3 = a2 + kstep; const char* b3 = b2 + kstep;
            if (last && has_next) S.a_ready(nxt);
            const int nx = (last && has_next) ? 1 : 0;
            LDB0_(0, 0); LDB1_(0, 1); PG8_SCHED; LDA_(0, 0); PG8_STAGE_A(PG8_SA(1, 1), a1, 1, 0);
            PG8_WAIT_V(8); PG8_WAIT_L(0); PG8_BAR; MMA0_(0, 0); MMA1_(0, 1); PG8_BAR; PG8_SCHED;
            LDA_(0, 1); PG8_STAGE_B(PG8_SB(0, 0), b2); PG8_STAGE_B(PG8_SB(0, 1), b2 + hstep); PG8_STAGE_A(PG8_SA(0, 0), a2, 0, nx);
            PG8_WAIT_V(8); PG8_WAIT_L(0); PG8_BAR; MMA0_(1, 0); MMA1_(1, 1); PG8_BAR; PG8_SCHED;
            LDB0_(1, 0); LDB1_(1, 1); PG8_SCHED; LDA_(1, 0); PG8_STAGE_A(PG8_SA(0, 1), a2, 1, nx);
            PG8_WAIT_V(8); PG8_WAIT_L(0); PG8_BAR; MMA0_(0, 0); MMA1_(0, 1); PG8_BAR; PG8_SCHED;
            LDA_(1, 1); PG8_STAGE_B(PG8_SB(1, 0), b3); PG8_STAGE_B(PG8_SB(1, 1), b3 + hstep); PG8_STAGE_A(PG8_SA(1, 0), a3, 0, nx);
            PG8_WAIT_V(8); PG8_WAIT_L(0); PG8_BAR; MMA0_(1, 0); MMA1_(1, 1); PG8_BAR; PG8_SCHED;
        }
        if constexpr (ALIGN_EPI) { if (wr == 0) PG8_BAR; }
        { int fr2 = fr, fq2 = fq; asm volatile("" : "+v"(fr2), "+v"(fq2));
          E(acc, cur, wr, wc, fr2, fq2); } S.done(cur);
        if (!has_next) break;
#pragma unroll
        for (int a = 0; a < 2; ++a)
#pragma unroll
            for (int b = 0; b < 2; ++b)
#pragma unroll
                for (int m = 0; m < 4; ++m)
#pragma unroll
                    for (int n = 0; n < 2; ++n) acc[a][b][m][n] = (f32x4){0.f, 0.f, 0.f, 0.f};
        cur = nxt; cA = nA; cB = nB; ++ui;
        if constexpr (GATHER) gslot ^= 1;
        if constexpr (ALIGN_EPI) { if (wr == 1) PG8_BAR; }
    }
    PG8_WAIT_V(0);
    if constexpr (!ALIGN_EPI) { if (wr == 0) PG8_BAR; }
    PG8_BAR;
#undef PG8_SA
#undef PG8_SB
#undef PG8_STAGE
#undef PG8_STAGE_A
#undef PG8_STAGE_B
#undef PG8_LDA
#undef PG8_LDB
#undef PG8_MMA
#undef PG8_MMA8
#undef PG8_LDA8
#undef PG8_LDB8
#undef LDA_
#undef LDB0_
#undef LDB1_
#undef MMA0_
#undef MMA1_
#undef PG8_WAIT_V
#undef PG8_WAIT_L
#undef PG8_BAR
#undef PG8_SCHED
}

struct EpiProj {
    static constexpr bool PERM = true;
    bf16* O; float asc;
    __device__ __forceinline__ void operator()(const f32x4 (&acc)[2][2][4][2], const Unit& u, int wr, int wc, int fr, int fq) const {
        const int row0 = u.pm * BM + wr * 64 + fr, col0 = u.pn * BM + wc * 32 + 8 * fq;
        const bool act = u.pn < 4;
#pragma unroll
        for (int ai = 0; ai < 2; ++ai)
#pragma unroll
            for (int m = 0; m < 4; ++m) { bf16* rowp = O + (size_t)(row0 + ai * HALF + m * 16) * DIN + col0;
#pragma unroll
                for (int bj = 0; bj < 2; ++bj) { f32x4 v0 = acc[ai][bj][m][0] * asc, v1 = acc[ai][bj][m][1] * asc;
                    if (act) {
#pragma unroll
                        for (int j = 0; j < 4; ++j) { v0[j] = gelu_tanh(v0[j]); v1[j] = gelu_tanh(v1[j]); } }
                    u32x4 w; w.x = cvt_pk_bf16(v0[0], v0[1]); w.y = cvt_pk_bf16(v0[2], v0[3]); w.z = cvt_pk_bf16(v1[0], v1[1]); w.w = cvt_pk_bf16(v1[2], v1[3]);
                    *(u32x4*)(rowp + bj * HALF) = w; } }
    }
};
template <bool RES_BF16> struct EpiResid {
    static constexpr bool PERM = true; static constexpr float ASC = OP8(RES_BF16 ? 1 : 0) ? 1.f / WOUT_SCALE : 1.f;
    const void* res; bf16* out;
    __device__ __forceinline__ void operator()(const f32x4 (&acc)[2][2][4][2], const Unit& u, int wr, int wc, int fr, int fq) const {
        const int row0 = u.pm * BM + wr * 64 + fr, col0 = u.pn * BM + wc * 32 + 8 * fq;
#pragma unroll
        for (int ai = 0; ai < 2; ++ai) {
            if constexpr (RES_BF16) {
                u32x4 r[4][2];
#pragma unroll
                for (int m = 0; m < 4; ++m)
#pragma unroll
                    for (int bj = 0; bj < 2; ++bj) r[m][bj] = *(const u32x4*)((const bf16*)res + (size_t)(row0 + ai * HALF + m * 16) * DM + col0 + bj * HALF);
                asm volatile("s_waitcnt vmcnt(0)" ::: "memory");
#pragma unroll
                for (int m = 0; m < 4; ++m)
#pragma unroll
                    for (int bj = 0; bj < 2; ++bj) { f32x4 v0 = acc[ai][bj][m][0] * ASC, v1 = acc[ai][bj][m][1] * ASC; const u32x4 q = r[m][bj];
                        v0[0] += bf_lo(q.x); v0[1] += bf_hi(q.x); v0[2] += bf_lo(q.y); v0[3] += bf_hi(q.y); v1[0] += bf_lo(q.z); v1[1] += bf_hi(q.z); v1[2] += bf_lo(q.w); v1[3] += bf_hi(q.w);
                        u32x4 w; w.x = cvt_pk_bf16(v0[0], v0[1]); w.y = cvt_pk_bf16(v0[2], v0[3]); w.z = cvt_pk_bf16(v1[0], v1[1]); w.w = cvt_pk_bf16(v1[2], v1[3]);
                        *(u32x4*)(out + (size_t)(row0 + ai * HALF + m * 16) * DM + col0 + bj * HALF) = w; }
            } else {
#pragma unroll
                for (int mh = 0; mh < 2; ++mh) {
                    f32x4 r[2][2][2];
#pragma unroll
                    for (int m = 0; m < 2; ++m)
#pragma unroll
                        for (int bj = 0; bj < 2; ++bj) { const float* rp = (const float*)res + (size_t)(row0 + ai * HALF + (2 * mh + m) * 16) * DM + col0 + bj * HALF; r[m][bj][0] = *(const f32x4*)rp; r[m][bj][1] = *(const f32x4*)(rp + 4); }
                    asm volatile("s_waitcnt vmcnt(0)" ::: "memory");
#pragma unroll
                    for (int m = 0; m < 2; ++m)
#pragma unroll
                        for (int bj = 0; bj < 2; ++bj) { const f32x4 v0 = acc[ai][bj][2 * mh + m][0] * ASC + r[m][bj][0], v1 = acc[ai][bj][2 * mh + m][1] * ASC + r[m][bj][1];
                            u32x4 w; w.x = cvt_pk_bf16(v0[0], v0[1]); w.y = cvt_pk_bf16(v0[2], v0[3]); w.z = cvt_pk_bf16(v1[0], v1[1]); w.w = cvt_pk_bf16(v1[2], v1[3]);
                            *(u32x4*)(out + (size_t)(row0 + ai * HALF + (2 * mh + m) * 16) * DM + col0 + bj * HALF) = w; }
                }
            }
        }
    }
};
struct EpiSwiGLU {
    static constexpr bool PERM = true;
    unsigned char* HB; const float* rslot;
    __device__ __forceinline__ void operator()(const f32x4 (&acc)[2][2][4][2], const Unit& u, int wr, int wc, int fr, int fq) const {
        const int row0 = u.pm * BM + wr * 64 + fr, col0 = u.pn * HALF + wc * 32 + 8 * fq;
        const __amdgpu_buffer_rsrc_t rsrc = __builtin_amdgcn_make_buffer_rsrc((void*)HB, 0, 40960 * DE, 0x00020000);
        const float* rsl = rslot + (size_t)u.e * TOKCAP + u.rb * BM + wr * 64 + fr;
#pragma unroll
        for (int ai = 0; ai < 2; ++ai) {
            float rsv[4];
#pragma unroll
            for (int m = 0; m < 4; ++m) rsv[m] = rsl[ai * HALF + m * 16];
            asm volatile("s_waitcnt vmcnt(0)" ::: "memory");
#pragma unroll
            for (int m = 0; m < 4; ++m) { const unsigned boff = (unsigned)((row0 + ai * HALF + m * 16) * DE + col0);
                const float rs = rsv[m] * (1.f / W1_SCALE);
                float h[8];
#pragma unroll
                for (int n = 0; n < 2; ++n)
#pragma unroll
                    for (int j = 0; j < 4; ++j) { const float g = acc[ai][0][m][n][j] * rs, up = acc[ai][1][m][n][j] * rs; h[n * 4 + j] = g * sigmoidf_(g) * up; }
                u32x2 w; w.x = pk4_fp8(h[0], h[1], h[2], h[3]); w.y = pk4_fp8(h[4], h[5], h[6], h[7]);
                __builtin_amdgcn_raw_buffer_store_b64(w, rsrc, boff, 0, 16); } }
    }
};
struct EpiY {
    static constexpr bool PERM = true;
    unsigned char* Y;
    __device__ __forceinline__ void operator()(const f32x4 (&acc)[2][2][4][2], const Unit& u, int wr, int wc, int fr, int fq) const {
        const int row0 = u.pm * BM + wr * 64 + fr, col0 = u.pn * BM + wc * 32 + 8 * fq;
#pragma unroll
        for (int ai = 0; ai < 2; ++ai)
#pragma unroll
            for (int m = 0; m < 4; ++m) { unsigned char* rowp = Y + (size_t)(row0 + ai * HALF + m * 16) * DM + col0;
#pragma unroll
                for (int bj = 0; bj < 2; ++bj) { const f32x4 v0 = acc[ai][bj][m][0] * (Y_SCALE / W2_SCALE), v1 = acc[ai][bj][m][1] * (Y_SCALE / W2_SCALE);
                    u32x2 w; w.x = pk4_fp8(v0[0], v0[1], v0[2], v0[3]); w.y = pk4_fp8(v1[0], v1[1], v1[2], v1[3]);
                    *(u32x2*)(rowp + bj * HALF) = w; } }
    }
};

struct SchedG1 {
    static constexpr bool GATHER = true;
    const LAS int* tstart; const int* cnt; const int* tok; const bf16* X; const bf16* W1; int G, c; unsigned* ready;
    __device__ __forceinline__ void a_ready(const Unit&) const {}
    __device__ __forceinline__ void done(const Unit& u) const {
        asm volatile("s_waitcnt vmcnt(0)" ::: "memory");
        if (lane_now() == 0) __hip_atomic_fetch_add(ready + 64 * u.pm, 1u, __ATOMIC_RELAXED, __HIP_MEMORY_SCOPE_AGENT);
    }
    __device__ __forceinline__ bool next(int i, Unit& u) const {
        const int L = i * G + c, NT = __builtin_amdgcn_readfirstlane(tstart[NE]); if (L >= NT * 4) return false;
        const int T = L >> 2; const int e = tstart[560 + T];
        u.pm = __builtin_amdgcn_readfirstlane(T); u.pn = L & 3; u.e = __builtin_amdgcn_readfirstlane(e); u.rb = __builtin_amdgcn_readfirstlane(T - tstart[e]); return true;
    }
    static constexpr int KU = DM / 2;
    __device__ __forceinline__ const char* a_base(const Unit&) const { return (const char*)X; }
    __device__ __forceinline__ const char* b_base(const Unit& u) const { return (const char*)W1 + ((size_t)u.e * 1024 + (size_t)u.pn * BM) * DM; }
    __device__ __forceinline__ void a_voff(const Unit& u, const int (&R)[2], const int (&C)[2], unsigned (&v)[2][2]) const {
        const int n = cnt[u.e * 64]; const int* tl = tok + (size_t)u.e * TOKCAP;
#pragma unroll
        for (int h = 0; h < 2; ++h)
#pragma unroll
            for (int i = 0; i < 2; ++i) { int row = u.rb * BM + h * HALF + R[i]; row = row < n ? row : 0; const int t = tl[row]; v[h][i] = (unsigned)(t * KU + C[i]) * 2u; }
    }
};
struct SchedG2 {
    static constexpr bool GATHER = false;
    const LAS int* tstart; const bf16* HB; const bf16* W2; int G, c; unsigned* ready; unsigned* tmo; int wave;
    __device__ __forceinline__ bool next(int i, Unit& u) const {
        constexpr int K0 = 3;
        const int NT = __builtin_amdgcn_readfirstlane(tstart[NE]), n1 = 4 * NT, n1max = (n1 + G - 1) / G, R = n1 - G * (n1max - 1), nB = G - R;
        int L;
        if (c >= R) L = (i < K0) ? i * nB + (c - R) : K0 * nB + (i - K0) * G + c;
        else L = K0 * nB + i * G + c;
        if (L >= NT * 8) return false;
        const int T = L >> 3; const int e = tstart[560 + T];
        u.pm = __builtin_amdgcn_readfirstlane(T); u.pn = __builtin_amdgcn_readfirstlane(L & 7); u.e = __builtin_amdgcn_readfirstlane(e); u.rb = __builtin_amdgcn_readfirstlane(T - tstart[e]); return true;
    }
    __device__ __forceinline__ void done(const Unit&) const {}
    __device__ __forceinline__ void a_ready(const Unit& u) const {
        if (wave == 0) {
            unsigned polls = 0;
            while ((unsigned)__builtin_amdgcn_readfirstlane(__hip_atomic_load(ready + 64 * u.pm, __ATOMIC_RELAXED, __HIP_MEMORY_SCOPE_AGENT)) < 32u) {
                if (++polls > (1u << 22)) { if (lane_now() == 0) __hip_atomic_store(tmo, 0x600u | (unsigned)(u.pm & 0xff), __ATOMIC_RELAXED, __HIP_MEMORY_SCOPE_AGENT); break; }
                __builtin_amdgcn_s_sleep(2); }
            __builtin_amdgcn_fence(__ATOMIC_ACQUIRE, "agent");
            asm volatile("s_waitcnt vmcnt(0)" ::: "memory");
        }
        asm volatile("" ::: "memory"); __builtin_amdgcn_s_barrier(); asm volatile("" ::: "memory");
    }
    __device__ __forceinline__ const char* a_base(const Unit& u) const { return (const char*)HB + (size_t)u.pm * BM * DE; }
    __device__ __forceinline__ const char* b_base(const Unit& u) const { return (const char*)W2 + ((size_t)u.e * DM + (size_t)u.pn * BM) * DE; }
    __device__ __forceinline__ void a_voff(const Unit&, const int (&R)[2], const int (&C)[2], unsigned (&v)[2][2]) const {
#pragma unroll
        for (int h = 0; h < 2; ++h)
#pragma unroll
            for (int i = 0; i < 2; ++i) v[h][i] = (unsigned)((h * HALF + R[i]) * DE + C[i]) * 2u;
    }
};
}

struct Params { const float* in[22]; float* out; unsigned char* ws; int ph_lo, ph_hi; };
enum { IN_X = 0, IN_NORM1, IN_WIN, IN_SGUN, IN_SGUW, IN_SGUB, IN_CONVW, IN_CONVB, IN_LNG, IN_LNB, IN_QN, IN_KN, IN_OUTN, IN_WOUT, IN_NORM2, IN_WRG, IN_BRG, IN_WRE, IN_BRE, IN_WG, IN_WU, IN_WD };

struct Frame {
    LAS unsigned char* lds; volatile LAS unsigned* MISC;
    int tid, lane, wave, vcu, G;
    const float* const* in; float* out; unsigned char* ws;
};

__device__ __forceinline__ void tile_desc(const float* const* in, unsigned char* ws, int it, const float*& src, int& ldw, unsigned char*& dst, int& pitch, const float*& ksc, float& wsc, int& fp8) {
    constexpr int T_IN = 32 * 80, T_OUT = 32 * 32, T_E = 32 * 8, T_D = 8 * 32;
    constexpr int T_LAYER = T_IN + T_OUT + NE * (2 * T_E + T_D);
    const int l = it / T_LAYER; int r = it % T_LAYER; ksc = nullptr; wsc = 1.f; fp8 = 0;
    if (r < T_IN) { ldw = DIN;
        if (IP8(l)) { const int kb = r / 160, nb = r % 160; pitch = DM; fp8 = 1; wsc = WIN_SCALE; src = in[IN_WIN] + (size_t)l * DM * DIN + (size_t)(128 * kb) * DIN + 32 * nb; dst = ws + WS_WIN + (size_t)l * DIN * DM * 2 + ((size_t)32 * nb) * DM + 128 * kb; }
        else { const int kb = r / 80, nb = r % 80; pitch = DM * 2; src = in[IN_WIN] + (size_t)l * DM * DIN + (size_t)(64 * kb) * DIN + 64 * nb; dst = ws + WS_WIN + (((size_t)l * DIN + 64 * nb) * DM + 64 * kb) * 2; }
        return; } r -= T_IN;
    if (r < T_OUT) { const int kb = r / 32, nb = r % 32; ldw = DM; src = in[IN_WOUT] + (size_t)l * DM * DM + (size_t)(64 * kb) * DM + 64 * nb;
        if (OP8(l)) { const int kb8 = r / 64, nb8 = r % 64; pitch = DM; fp8 = 1; wsc = WOUT_SCALE; src = in[IN_WOUT] + (size_t)l * DM * DM + (size_t)(128 * kb8) * DM + 32 * nb8; dst = ws + WS_WOUT + (size_t)l * DM * DM * 2 + ((size_t)32 * nb8) * DM + 128 * kb8; } else { pitch = DM * 2; dst = ws + WS_WOUT + (((size_t)l * DM + 64 * nb) * DM + 64 * kb) * 2; }
        return; } r -= T_OUT;
    const int e = r / (2 * T_E + T_D); r %= (2 * T_E + T_D);
    const size_t le = (size_t)l * NE + e; fp8 = 1;
    if (r < 2 * T_E) { const int up = r >= T_E; r -= up * T_E; const int kb = r / 16, nb = r % 16, n0 = 32 * nb; ldw = DE; pitch = DM; wsc = W1_SCALE;
        src = (up ? in[IN_WU] : in[IN_WG]) + le * DM * DE + (size_t)(128 * kb) * DE + n0; dst = ws + WS_W1 + (le * 1024 + (size_t)((n0 / 128) * 256 + up * 128 + (n0 % 128))) * DM + 128 * kb; ksc = in[IN_NORM2] + (size_t)l * DM + 128 * kb; return; }
    r -= 2 * T_E;
    { const int kb = r / 64, nb = r % 64; ldw = DM; pitch = DE; wsc = W2_SCALE; src = in[IN_WD] + le * DE * DM + (size_t)(128 * kb) * DM + 32 * nb; dst = ws + WS_W2 + (le * DM + 32 * nb) * DE + 128 * kb; }
}
#define TR_LOAD(V, src, ldw, fp8) do { if (fp8) { _Pragma("unroll") for (int i = 0; i < 16; ++i) V[i] = __builtin_nontemporal_load((const f32x4*)((src) + (size_t)(8 * i + (lane >> 3)) * (ldw) + 4 * (lane & 7))); } \
    else { _Pragma("unroll") for (int i = 0; i < 16; ++i) V[i] = __builtin_nontemporal_load((const f32x4*)((src) + (size_t)(4 * i + (lane >> 4)) * (ldw) + 4 * (lane & 15))); } } while (0)
#define TR_PROC(V, dst, pitch, ksc, wsc, fp8) do { \
    if (fp8) {        \
        _Pragma("unroll") for (int i = 0; i < 16; ++i) { const int kk = 8 * i + (lane >> 3); f32x4 v = V[i] * ((ksc) ? (ksc)[kk] * (wsc) : (wsc)); \
            LAS float* d = scr + kk * 33 + 4 * (lane & 7); d[0] = v[0]; d[1] = v[1]; d[2] = v[2]; d[3] = v[3]; } \
        LDS_WAIT(); \
        _Pragma("unroll") for (int j = 0; j < 8; ++j) { const int n = (lane >> 4) + 4 * j; const LAS float* sp = scr + (8 * (lane & 15)) * 33 + n; \
            u32x2 o; o.x = pk4_fp8(sp[0], sp[33], sp[2 * 33], sp[3 * 33]); o.y = pk4_fp8(sp[4 * 33], sp[5 * 33], sp[6 * 33], sp[7 * 33]); __builtin_nontemporal_store(o, (u32x2*)((dst) + (size_t)n * (pitch) + 8 * (lane & 15))); }     \
    } else { \
        _Pragma("unroll") for (int i = 0; i < 16; ++i) { const int kk = 4 * i + (lane >> 4); f32x4 v = V[i] * ((ksc) ? (ksc)[kk] * (wsc) : (wsc)); \
            LAS float* d = scr + kk * 65 + 4 * (lane & 15); d[0] = v[0]; d[1] = v[1]; d[2] = v[2]; d[3] = v[3]; } \
        LDS_WAIT(); \
        _Pragma("unroll") for (int j = 0; j < 8; ++j) { const int n = (lane >> 3) + 8 * j; const LAS float* sp = scr + (8 * (lane & 7)) * 65 + n; \
            u32x4 o; o.x = cvt_pk_bf16(sp[0], sp[65]); o.y = cvt_pk_bf16(sp[2 * 65], sp[3 * 65]); o.z = cvt_pk_bf16(sp[4 * 65], sp[5 * 65]); o.w = cvt_pk_bf16(sp[6 * 65], sp[7 * 65]); \
            *(u32x4*)((dst) + (size_t)n * (pitch) + 16 * (lane & 7)) = o; } } \
    LDS_WAIT(); } while (0)
__device__ __forceinline__ void norm_row_bf16(const float* xrow, const float* g, bf16* orow, int lane) {
    f32x4 v[8]; float s = 0.f;
#pragma unroll
    for (int j = 0; j < 8; ++j) { v[j] = *(const f32x4*)(xrow + 4 * lane + 256 * j); s += (v[j][0] * v[j][0] + v[j][1] * v[j][1]) + (v[j][2] * v[j][2] + v[j][3] * v[j][3]); }
    const float rs = __builtin_amdgcn_rsqf(wave_sum(s) * (1.f / DM) + EPS);
#pragma unroll
    for (int j = 0; j < 8; ++j) { const f32x4 gg = *(const f32x4*)(g + 4 * lane + 256 * j);
        u32x2 o; o.x = cvt_pk_bf16(v[j][0] * rs * gg[0], v[j][1] * rs * gg[1]); o.y = cvt_pk_bf16(v[j][2] * rs * gg[2], v[j][3] * rs * gg[3]);
        *(u32x2*)(orow + 4 * lane + 256 * j) = o; }
}
__device__ __forceinline__ void p_prologue(Frame& F) {
    LAS float* scr = (LAS float*)(F.lds + F.wave * 16896);
    const int gw = F.vcu * NWAVES + F.wave, NGW = F.G * NWAVES, lane = F.lane;
    constexpr int T_TOTAL = NLAYER * (32 * 80 + 32 * 32 + NE * (2 * 32 * 8 + 8 * 32));
    {
        f32x4 va[16], vb[16];
        const float* srcA; const float* srcB; unsigned char* dstA; unsigned char* dstB; const float* kA; const float* kB; int ldA, ldB, pA, pB, fA, fB; float wA, wB;
        int it = gw;
        if (it < T_TOTAL) { tile_desc(F.in, F.ws, it, srcA, ldA, dstA, pA, kA, wA, fA); TR_LOAD(va, srcA, ldA, fA); }
        while (it < T_TOTAL) {
            const int itb = it + NGW;
            if (itb < T_TOTAL) { tile_desc(F.in, F.ws, itb, srcB, ldB, dstB, pB, kB, wB, fB); TR_LOAD(vb, srcB, ldB, fB); }
            TR_PROC(va, dstA, pA, kA, wA, fA);
            if (itb >= T_TOTAL) break;
            const int ita = itb + NGW;
            if (ita < T_TOTAL) { tile_desc(F.in, F.ws, ita, srcA, ldA, dstA, pA, kA, wA, fA); TR_LOAD(va, srcA, ldA, fA); }
            TR_PROC(vb, dstB, pB, kB, wB, fB);
            it = ita;
        }
    }
    { bf16* SW = (bf16*)(F.ws + WS_SGUW); const int gt = gw * 64 + F.lane, NGT = NGW * 64;
      for (int idx = gt; idx < NLAYER * 4 * 8 * 4 * 64; idx += NGT) {
          const int ln = idx & 63, pp = (idx >> 6) & 3, itile = (idx >> 8) & 7, h = (idx >> 11) & 3, l = idx >> 13;
          const int i = 16 * itile + (ln & 15), gq = ln >> 4;
          const float* w = F.in[IN_SGUW] + ((size_t)(l * 4 + h) * 128 + i) * 128;
          float v[8];
#pragma unroll
          for (int jj = 0; jj < 8; ++jj) { const int j = 32 * pp + (jj < 4 ? 4 * gq + jj : 16 + 4 * gq + (jj - 4)); v[jj] = (j <= i) ? w[j] : 0.f; }
          u32x4 o; o.x = cvt_pk_bf16(v[0], v[1]); o.y = cvt_pk_bf16(v[2], v[3]); o.z = cvt_pk_bf16(v[4], v[5]); o.w = cvt_pk_bf16(v[6], v[7]);
          *(u32x4*)(SW + (size_t)idx * 8) = o; }
      bf16* WRF = (bf16*)(F.ws + WS_WRT);
      for (int idx = gt; idx < NLAYER * 64 * 3 * 64; idx += NGT) { const int ln = idx & 63, ct = (idx >> 6) % 3, ks = (idx / 192) & 63, l = idx / (192 * 64);
          const int o = 16 * ct + (ln & 15), k0 = 32 * ks + 8 * (ln >> 4);
          float v[8];
#pragma unroll
          for (int j = 0; j < 8; ++j) { const int k = k0 + j; const float wv = o < 32 ? F.in[IN_WRE][((size_t)l * DM + k) * NE + o] : (o < 36 ? F.in[IN_WRG][((size_t)l * DM + k) * 4 + (o - 32)] : 0.f);
              v[j] = wv * F.in[IN_NORM2][(size_t)l * DM + k]; }
          u32x4 hi, lo; hi.x = cvt_pk_bf16(v[0], v[1]); hi.y = cvt_pk_bf16(v[2], v[3]); hi.z = cvt_pk_bf16(v[4], v[5]); hi.w = cvt_pk_bf16(v[6], v[7]);
          lo.x = cvt_pk_bf16(v[0] - bf_lo(hi.x), v[1] - bf_hi(hi.x)); lo.y = cvt_pk_bf16(v[2] - bf_lo(hi.y), v[3] - bf_hi(hi.y));
          lo.z = cvt_pk_bf16(v[4] - bf_lo(hi.z), v[5] - bf_hi(hi.z)); lo.w = cvt_pk_bf16(v[6] - bf_lo(hi.w), v[7] - bf_hi(hi.w));
          bf16* dst = WRF + ((((size_t)l * 64 + ks) * 3 + ct) * 2 * 64 + ln) * 8;
          *(u32x4*)dst = hi; *(u32x4*)(dst + 512) = lo; } }
    bf16* HN = (bf16*)(F.ws + WS_HN);
    for (int m = gw; m < SEQ; m += NGW) norm_row_bf16(F.in[IN_X] + (size_t)m * DM, F.in[IN_NORM1], HN + (size_t)m * DM, F.lane);
}

__device__ __forceinline__ int vimg_off(int row, int c) { return row * 256 + ((((c >> 1) ^ (row & 7)) << 1) | (c & 1)) * 16; }
__device__ __forceinline__ bf16x8 tr_frag(const LAS unsigned char* img, int ra, int rb, int dt, int lane) {
    const int gq = lane >> 4, q = (lane & 15) >> 2, p = lane & 3;
    const int r0 = ra + 4 * gq + q, r1 = rb + 4 * gq + q, c = 2 * dt + (p >> 1);
    const s16x4 a = __builtin_amdgcn_ds_read_tr16_b64_v4i16((LAS s16x4*)(img + vimg_off(r0, c) + 8 * (p & 1)));
    const s16x4 b = __builtin_amdgcn_ds_read_tr16_b64_v4i16((LAS s16x4*)(img + vimg_off(r1, c) + 8 * (p & 1)));
    bf16x8 r; r[0] = a[0]; r[1] = a[1]; r[2] = a[2]; r[3] = a[3]; r[4] = b[0]; r[5] = b[1]; r[6] = b[2]; r[7] = b[3]; return r;
}
__device__ __forceinline__ void sgu_stage8(const bf16* vsrc, int j0, int w, int lane, const f32x4& g0, const f32x4& g1, LAS unsigned char* lds) {
    u32x4 raw[8];
#pragma unroll
    for (int j = 0; j < 8; ++j) raw[j] = *(const u32x4*)(vsrc + (size_t)(w + 8 * (j0 + j)) * DIN);
#pragma unroll
    for (int j = 0; j < 8; ++j) { const int row = w + 8 * (j0 + j);
        float x[8] = {bf_lo(raw[j].x), bf_hi(raw[j].x), bf_lo(raw[j].y), bf_hi(raw[j].y), bf_lo(raw[j].z), bf_hi(raw[j].z), bf_lo(raw[j].w), bf_hi(raw[j].w)};
        float s = 0.f;
#pragma unroll
        for (int e = 0; e < 8; ++e) s += x[e] * x[e];
        const float rs = __builtin_amdgcn_rsqf(wave_sum(s) * (1.f / 512.f) + EPS);
        u32x4 o; o.x = cvt_pk_bf16(x[0] * rs * g0[0], x[1] * rs * g0[1]); o.y = cvt_pk_bf16(x[2] * rs * g0[2], x[3] * rs * g0[3]);
        o.z = cvt_pk_bf16(x[4] * rs * g1[0], x[5] * rs * g1[1]); o.w = cvt_pk_bf16(x[6] * rs * g1[2], x[7] * rs * g1[3]);
        *(LAS u32x4*)(lds + (lane >> 4) * 32768 + vimg_off(row, lane & 15)) = o; }
}
__device__ __forceinline__ void sgu_item(Frame& F, int l, int chunk, int half) {
    const bf16* PROJ = (const bf16*)(F.ws + WS_PROJ); bf16* MIX = (bf16*)(F.ws + WS_MIX);
    const int p0 = chunk * 128, lane = F.lane, w = F.wave;
    LAS float* red = (LAS float*)(F.lds + MISC_OFF + 256);
    const float* gn = F.in[IN_SGUN] + l * 512;
    const f32x4 g0 = *(const f32x4*)(gn + 8 * lane), g1 = *(const f32x4*)(gn + 8 * lane + 4);
    const bf16* vsrc = PROJ + (size_t)p0 * DIN + OFF_V + 8 * lane;
    sgu_stage8(vsrc, 0, w, lane, g0, g1, F.lds);
    if (half) sgu_stage8(vsrc, 8, w, lane, g0, g1, F.lds);
    const int h = w >> 1, ih = w & 1, gq = lane >> 4, fr = lane & 15;
    const LAS unsigned char* img = F.lds + h * 32768;
    const bf16* SW = (const bf16*)(F.ws + WS_SGUW) + (size_t)(l * 4 + h) * 8 * 4 * 64 * 8;
    const float* bs = F.in[IN_SGUB] + (size_t)(l * 4 + h) * 128;
    const float* og = F.in[IN_OUTN] + (size_t)l * DM + h * 128 + 4 * gq;
    const int it0 = ih + 4 * half;
    u32x2 ur[2][8];
#pragma unroll
    for (int ii = 0; ii < 2; ++ii) { const bf16* urow = PROJ + (size_t)(p0 + 16 * (it0 + 2 * ii) + fr) * DIN + OFF_U + h * 128 + 4 * gq;
#pragma unroll
        for (int dt = 0; dt < 8; ++dt) ur[ii][dt] = *(const u32x2*)(urow + 16 * dt); }
    __syncthreads();
    f32x4 z[2][8];
#pragma unroll
    for (int ii = 0; ii < 2; ++ii)
#pragma unroll
        for (int dt = 0; dt < 8; ++dt) z[ii][dt] = (f32x4){0.f, 0.f, 0.f, 0.f};
#pragma unroll 1
    for (int pp = 0; pp <= (it0 + 2) / 2; ++pp) {
        const bf16x8 bw0 = *(const bf16x8*)(SW + ((size_t)(it0 * 4 + pp) * 64 + lane) * 8);
        const bf16x8 bw1 = *(const bf16x8*)(SW + ((size_t)((it0 + 2) * 4 + pp) * 64 + lane) * 8);
        const bool do0 = pp <= it0 / 2;
#pragma unroll
        for (int dt = 0; dt < 8; ++dt) { const bf16x8 a = tr_frag(img, 32 * pp, 32 * pp + 16, dt, lane);
            if (do0) z[0][dt] = __builtin_amdgcn_mfma_f32_16x16x32_bf16(a, bw0, z[0][dt], 0, 0, 0);
            z[1][dt] = __builtin_amdgcn_mfma_f32_16x16x32_bf16(a, bw1, z[1][dt], 0, 0, 0); }
    }
#pragma unroll
    for (int ii = 0; ii < 2; ++ii) { const int i = 16 * (it0 + 2 * ii) + fr; const float bi = bs[i]; float s = 0.f;
#pragma unroll
        for (int dt = 0; dt < 8; ++dt) { const u32x2 u2 = ur[ii][dt];
            f32x4 y; y[0] = bf_lo(u2.x) * (z[ii][dt][0] + bi); y[1] = bf_hi(u2.x) * (z[ii][dt][1] + bi); y[2] = bf_lo(u2.y) * (z[ii][dt][2] + bi); y[3] = bf_hi(u2.y) * (z[ii][dt][3] + bi);
            z[ii][dt] = y; s += (y[0] * y[0] + y[1] * y[1]) + (y[2] * y[2] + y[3] * y[3]); }
        s += __shfl_xor(s, 16); s += __shfl_xor(s, 32);
        if (gq == 0) red[i * 4 + h] = s; }
    __syncthreads();
#pragma unroll
    for (int ii = 0; ii < 2; ++ii) { const int i = 16 * (it0 + 2 * ii) + fr;
        const f32x4 rr = *(const LAS f32x4*)(red + i * 4);
        const float rs = __builtin_amdgcn_rsqf(((rr[0] + rr[1]) + (rr[2] + rr[3])) * (1.f / 512.f) + EPS);
        bf16* orow = MIX + (size_t)(p0 + i) * DM + h * 128 + 4 * gq;
#pragma unroll
        for (int dt = 0; dt < 8; ++dt) { const f32x4 gg = *(const f32x4*)(og + 16 * dt); const f32x4 y = z[ii][dt];
            if (OP8(l)) *(unsigned*)((unsigned char*)MIX + (size_t)(p0 + i) * DM + h * 128 + 4 * gq + 16 * dt) = pk4_fp8(y[0] * rs * gg[0], y[1] * rs * gg[1], y[2] * rs * gg[2], y[3] * rs * gg[3]);
            else { u32x2 o; o.x = cvt_pk_bf16(y[0] * rs * gg[0], y[1] * rs * gg[1]); o.y = cvt_pk_bf16(y[2] * rs * gg[2], y[3] * rs * gg[3]);
            *(u32x2*)(orow + 16 * dt) = o; } } }
    __syncthreads();
}

__device__ __forceinline__ void conv_item(Frame& F, int l, int tile) {
    const bf16* PROJ = (const bf16*)(F.ws + WS_PROJ); bf16* MIX = (bf16*)(F.ws + WS_MIX);
    constexpr int TP = 32, NR = TP + 30;
    const int p0 = tile * TP, c = F.tid, tid = F.tid;
    LAS float* cbuf = (LAS float*)F.lds;
    LAS bf16* zbuf = (LAS bf16*)(F.lds + 65536);
    { u32x4 av[8], gv[8];
#pragma unroll
      for (int i = 0; i < 8; ++i) { const int id = tid + NTHREADS * i, row = id >> 6, ch = (id & 63) * 8; int p = p0 - 30 + row; p = p < 0 ? 0 : p; p = row < NR ? p : 0;
          av[i] = *(const u32x4*)(PROJ + (size_t)p * DIN + OFF_A + ch); gv[i] = *(const u32x4*)(PROJ + (size_t)p * DIN + OFF_G + ch); }
#pragma unroll
      for (int i = 0; i < 8; ++i) { const int id = tid + NTHREADS * i, row = id >> 6, ch = (id & 63) * 8; const bool live = (p0 - 30 + row) >= 0;
          const unsigned au[4] = {av[i].x, av[i].y, av[i].z, av[i].w}, gu[4] = {gv[i].x, gv[i].y, gv[i].z, gv[i].w}; u32x4 o; unsigned ou[4];
#pragma unroll
          for (int e = 0; e < 4; ++e) { const float z0 = bf_lo(au[e]) * sigmoidf_(bf_lo(gu[e])), z1 = bf_hi(au[e]) * sigmoidf_(bf_hi(gu[e])); ou[e] = live ? cvt_pk_bf16(z0, z1) : 0u; }
          o.x = ou[0]; o.y = ou[1]; o.z = ou[2]; o.w = ou[3];
          if (row < NR) *(LAS u32x4*)(zbuf + row * 512 + ch) = o; } }
    float wk[CONV_K];
#pragma unroll
    for (int k = 0; k < CONV_K; ++k) wk[k] = F.in[IN_CONVW][((size_t)l * CONV_K + k) * 512 + c];
    const float cb = F.in[IN_CONVB][l * 512 + c];
    __syncthreads();
#define CONV_Z(r) __builtin_bit_cast(float, (unsigned)zbuf[(r) * 512 + c] << 16)
    float win[30];
#pragma unroll
    for (int r = 0; r < 30; ++r) win[r] = CONV_Z(r);
#pragma unroll
    for (int q = 0; q < TP; ++q) { const float zv = CONV_Z(30 + q); float acc = cb + wk[30] * zv;
#pragma unroll
        for (int k = 0; k < 30; ++k) acc += wk[k] * win[(k + q) % 30];
        win[q % 30] = zv; cbuf[q * 512 + c] = acc; }
#undef CONV_Z
    __syncthreads();
    const float* lg = F.in[IN_LNG] + l * 512 + 8 * F.lane; const float* lb = F.in[IN_LNB] + l * 512 + 8 * F.lane; const float* og = F.in[IN_OUTN] + (size_t)l * DM + 512 + 8 * F.lane;
    const f32x4 lg0 = *(const f32x4*)lg, lg1 = *(const f32x4*)(lg + 4), lb0 = *(const f32x4*)lb, lb1 = *(const f32x4*)(lb + 4), og0 = *(const f32x4*)og, og1 = *(const f32x4*)(og + 4);
    for (int r = F.wave; r < TP; r += NWAVES) {
        const f32x4 a0 = *(const LAS f32x4*)(cbuf + r * 512 + 8 * F.lane), a1 = *(const LAS f32x4*)(cbuf + r * 512 + 8 * F.lane + 4);
        float x[8] = {a0[0], a0[1], a0[2], a0[3], a1[0], a1[1], a1[2], a1[3]};
        float s = 0.f;
#pragma unroll
        for (int e = 0; e < 8; ++e) s += x[e];
        const float mu = wave_sum(s) * (1.f / 512.f); float q2 = 0.f;
#pragma unroll
        for (int e = 0; e < 8; ++e) { x[e] -= mu; q2 += x[e] * x[e]; }
        const float rstd = __builtin_amdgcn_rsqf(wave_sum(q2) * (1.f / 512.f) + EPS);
        const float gam[8] = {lg0[0], lg0[1], lg0[2], lg0[3], lg1[0], lg1[1], lg1[2], lg1[3]}, bet[8] = {lb0[0], lb0[1], lb0[2], lb0[3], lb1[0], lb1[1], lb1[2], lb1[3]};
        float s2 = 0.f;
#pragma unroll
        for (int e = 0; e < 8; ++e) { const float y = x[e] * rstd * gam[e] + bet[e]; x[e] = y * sigmoidf_(y); s2 += x[e] * x[e]; }
        const float rs = __builtin_amdgcn_rsqf(wave_sum(s2) * (1.f / 512.f) + EPS);
        if (OP8(l)) { u32x2 o8; o8.x = pk4_fp8(x[0] * rs * og0[0], x[1] * rs * og0[1], x[2] * rs * og0[2], x[3] * rs * og0[3]); o8.y = pk4_fp8(x[4] * rs * og1[0], x[5] * rs * og1[1], x[6] * rs * og1[2], x[7] * rs * og1[3]);
            *(u32x2*)((unsigned char*)MIX + (size_t)(p0 + r) * DM + 512 + 8 * F.lane) = o8; }
        else {
        u32x4 o; o.x = cvt_pk_bf16(x[0] * rs * og0[0], x[1] * rs * og0[1]); o.y = cvt_pk_bf16(x[2] * rs * og0[2], x[3] * rs * og0[3]);
        o.z = cvt_pk_bf16(x[4] * rs * og1[0], x[5] * rs * og1[1]); o.w = cvt_pk_bf16(x[6] * rs * og1[2], x[7] * rs * og1[3]);
        *(u32x4*)(MIX + (size_t)(p0 + r) * DM + 512 + 8 * F.lane) = o; }
    }
    __syncthreads();
}

__device__ __forceinline__ int kimg_off(int row, int c) { return row * 256 + ((c ^ (row & 15)) << 4); }
__device__ __forceinline__ bf16x8 tr_frag2(const LAS unsigned char* vs, int ta, int tb, int dt, int lane) {
    const int gq = lane >> 4, q = (lane & 15) >> 2, p = lane & 3, c = 2 * dt + (p >> 1), rr = 4 * gq + q;
    const int off = rr * 256 + ((((c >> 1) ^ (rr & 7)) << 1) | (c & 1)) * 16 + 8 * (p & 1);
    const s16x4 a = __builtin_amdgcn_ds_read_tr16_b64_v4i16((LAS s16x4*)(vs + ta + off));
    const s16x4 b = __builtin_amdgcn_ds_read_tr16_b64_v4i16((LAS s16x4*)(vs + tb + off));
    bf16x8 r; r[0] = a[0]; r[1] = a[1]; r[2] = a[2]; r[3] = a[3]; r[4] = b[0]; r[5] = b[1]; r[6] = b[2]; r[7] = b[3]; return r;
}
#define ATT_DECODE(st) const int run_ = (int)blockIdx.x + F.G * ((st) / 5), b_ = (st) % 5 - 1; const int g = run_ >> 8, h = (run_ >> 5) & 7, rr_ = run_ & 31; \
    const int sh = 2 * g, dil = 1 << sh, rps = 32 >> sh; const int r = rr_ / rps, nb = 4 * (rr_ % rps) + b_
#define ATT_LOAD(st) do { if (ATT_EXP == 2) break; ATT_DECODE(st); const int cc = tid & 15; \
    _Pragma("unroll") for (int j = 0; j < 4; ++j) { const int row = (tid >> 4) + 32 * j; int ms = nb * 128 + row; ms = ms < 0 ? 0 : ms; const size_t pos = (size_t)ms * dil + r; \
        kr[j] = *(const u32x4*)(PROJ + pos * DIN + OFF_K + h * HD + 8 * cc); vr[j] = *(const u32x4*)(PROJ + pos * DIN + OFF_VV + h * HD + 8 * cc); } \
    if (b_ >= 0) { const size_t qpos_ = (size_t)(nb * 128 + 16 * w + (lane & 15)) * dil + r; \
        _Pragma("unroll") for (int ks = 0; ks < 4; ++ks) qr[ks] = *(const u32x4*)(PROJ + qpos_ * DIN + OFF_Q + h * HD + 32 * ks + 8 * (lane >> 4)); } } while (0)
__device__ __forceinline__ void att_phase(Frame& F, int l) {
    const bf16* PROJ = (const bf16*)(F.ws + WS_PROJ);
    bf16* ATT = (bf16*)(F.ws + WS_ATT); float* LSE = (float*)(F.ws + WS_LSE);
    const int lane = F.lane, w = F.wave, tid = F.tid, fr = lane & 15, gq = lane >> 4;
    LAS unsigned char* Ks = F.lds; LAS unsigned char* Vs = F.lds + 65536;
    const int nsteps = 5 * ((768 - (int)blockIdx.x + F.G - 1) / F.G);
    u32x4 kr[4], vr[4], qr[4];
    if (ATT_EXP == 2) { for (int j = 0; j < 4; ++j) { kr[j] = (u32x4){0x3f803f80u + (unsigned)tid, 0x3f003f80u, 0x3f803f00u, 0x3e803f80u}; vr[j] = kr[j]; qr[j] = kr[j]; } }
    if (nsteps > 0) ATT_LOAD(0);
    const int cc = tid & 15;
    const float* kgp = F.in[IN_KN] + l * HD + 8 * cc;
    const f32x4 kg0 = *(const f32x4*)kgp, kg1 = *(const f32x4*)(kgp + 4);
    for (int st = 0; st < nsteps; ++st) {
        ATT_DECODE(st);
        const int slot = (b_ + 1) & 1, curoff = slot * 32768, prevoff = 32768 - curoff;
#pragma unroll
        for (int j = 0; j < 4; ++j) { const int row = (tid >> 4) + 32 * j;
            const u32x4 k4 = kr[j];
            float x[8] = {bf_lo(k4.x), bf_hi(k4.x), bf_lo(k4.y), bf_hi(k4.y), bf_lo(k4.z), bf_hi(k4.z), bf_lo(k4.w), bf_hi(k4.w)};
            float sq = 0.f;
#pragma unroll
            for (int e = 0; e < 8; ++e) sq += x[e] * x[e];
            const float rs = __builtin_amdgcn_rsqf(row16_sum(sq) * (1.f / HD) + EPS);
            u32x4 o; o.x = cvt_pk_bf16(x[0] * rs * kg0[0], x[1] * rs * kg0[1]); o.y = cvt_pk_bf16(x[2] * rs * kg0[2], x[3] * rs * kg0[3]);
            o.z = cvt_pk_bf16(x[4] * rs * kg1[0], x[5] * rs * kg1[1]); o.w = cvt_pk_bf16(x[6] * rs * kg1[2], x[7] * rs * kg1[3]);
            *(LAS u32x4*)(Ks + curoff + kimg_off(row, cc)) = o;
            *(LAS u32x4*)(Vs + curoff + vimg_off(row, cc)) = vr[j]; }
        const int iq = 16 * w + fr; const size_t qpos = (size_t)(nb * 128 + iq) * dil + r;
        bf16x8 qf[4];
        if (b_ >= 0) { float x[4][8]; float sq = 0.f;
#pragma unroll
          for (int ks = 0; ks < 4; ++ks) { const u32x4 q4 = qr[ks];
              x[ks][0] = bf_lo(q4.x); x[ks][1] = bf_hi(q4.x); x[ks][2] = bf_lo(q4.y); x[ks][3] = bf_hi(q4.y); x[ks][4] = bf_lo(q4.z); x[ks][5] = bf_hi(q4.z); x[ks][6] = bf_lo(q4.w); x[ks][7] = bf_hi(q4.w);
#pragma unroll
              for (int e = 0; e < 8; ++e) sq += x[ks][e] * x[ks][e]; }
          sq = sum4(sq);
          const float rs = __builtin_amdgcn_rsqf(sq * (1.f / HD) + EPS) * 0.12751743f;
#pragma unroll
          for (int ks = 0; ks < 4; ++ks) { const float* qg = F.in[IN_QN] + l * HD + 32 * ks + 8 * gq; const f32x4 q0 = *(const f32x4*)qg, q1 = *(const f32x4*)(qg + 4);
              u32x4 o; o.x = cvt_pk_bf16(x[ks][0] * rs * q0[0], x[ks][1] * rs * q0[1]); o.y = cvt_pk_bf16(x[ks][2] * rs * q0[2], x[ks][3] * rs * q0[3]);
              o.z = cvt_pk_bf16(x[ks][4] * rs * q1[0], x[ks][5] * rs * q1[1]); o.w = cvt_pk_bf16(x[ks][6] * rs * q1[2], x[ks][7] * rs * q1[3]);
              qf[ks] = __builtin_bit_cast(bf16x8, o); } }
        __syncthreads();
        if (st + 1 < nsteps) ATT_LOAD(st + 1);
        if (b_ >= 0 && ATT_EXP != 1) {
        f32x4 sc[10];
#pragma unroll
        for (int kt = 0; kt < 9; ++kt) { sc[kt] = (f32x4){0.f, 0.f, 0.f, 0.f}; const int T = w + kt; const int kbase = (T < 8 ? prevoff : curoff); const int krow = 16 * (T & 7) + fr;
#pragma unroll
            for (int ks = 0; ks < 4; ++ks) { const bf16x8 kf = *(const LAS bf16x8*)(Ks + kbase + kimg_off(krow, 4 * ks + gq));
                sc[kt] = __builtin_amdgcn_mfma_f32_16x16x32_bf16(kf, qf[ks], sc[kt], 0, 0, 0); } }
#pragma unroll
        for (int e = 0; e < 4; ++e) { sc[0][e] = (4 * gq + e >= fr) ? sc[0][e] : -INFINITY; sc[8][e] = (4 * gq + e <= fr) ? sc[8][e] : -INFINITY; }
        if (nb == 0) {
#pragma unroll
            for (int kt = 0; kt < 8; ++kt) if (w + kt < 8) sc[kt] = (f32x4){-INFINITY, -INFINITY, -INFINITY, -INFINITY}; }
        float mx = -INFINITY;
#pragma unroll
        for (int kt = 0; kt < 9; ++kt) mx = fmaxf(fmaxf(mx, fmaxf(sc[kt][0], sc[kt][1])), fmaxf(sc[kt][2], sc[kt][3]));
        mx = max4(mx);
        float sum = 0.f;
#pragma unroll
        for (int kt = 0; kt < 9; ++kt)
#pragma unroll
            for (int e = 0; e < 4; ++e) { const float p = __builtin_amdgcn_exp2f(sc[kt][e] - mx); sc[kt][e] = p; sum += p; }
        sc[9] = (f32x4){0.f, 0.f, 0.f, 0.f};
        sum = sum4(sum);
        bf16x8 pf[5];
#pragma unroll
        for (int pp = 0; pp < 5; ++pp) { u32x4 o; o.x = cvt_pk_bf16(sc[2 * pp][0], sc[2 * pp][1]); o.y = cvt_pk_bf16(sc[2 * pp][2], sc[2 * pp][3]); o.z = cvt_pk_bf16(sc[2 * pp + 1][0], sc[2 * pp + 1][1]); o.w = cvt_pk_bf16(sc[2 * pp + 1][2], sc[2 * pp + 1][3]);
            pf[pp] = __builtin_bit_cast(bf16x8, o); }
        const float inv = __builtin_amdgcn_rcpf(sum);
        bf16* orow = ATT + ((size_t)g * SEQ + qpos) * 1024 + h * HD + 4 * gq;
        int toff[10];
#pragma unroll
        for (int kt = 0; kt < 10; ++kt) { const int T = (w + kt) < 15 ? (w + kt) : 15; toff[kt] = (T < 8 ? prevoff : curoff) + (T & 7) * 16 * 256; }
#pragma unroll
        for (int dt = 0; dt < 8; ++dt) { f32x4 o = (f32x4){0.f, 0.f, 0.f, 0.f};
#pragma unroll
            for (int pp = 0; pp < 5; ++pp) { const bf16x8 vf = tr_frag2(Vs, toff[2 * pp], toff[2 * pp + 1], dt, lane);
                o = __builtin_amdgcn_mfma_f32_16x16x32_bf16(vf, pf[pp], o, 0, 0, 0); }
            u32x2 ow; ow.x = cvt_pk_bf16(o[0] * inv, o[1] * inv); ow.y = cvt_pk_bf16(o[2] * inv, o[3] * inv);
            *(u32x2*)(orow + 16 * dt) = ow; }
        if (gq == 0) LSE[((size_t)g * SEQ + qpos) * NHEAD + h] = (mx + __builtin_amdgcn_logf(sum)) * 0.6931471805599453f;
        }
        if (b_ >= 0 && ATT_EXP == 1) { bf16* orow = ATT + ((size_t)g * SEQ + qpos) * 1024 + h * HD + 4 * gq;
#pragma unroll
            for (int dt = 0; dt < 8; ++dt) { u32x2 ow; ow.x = __builtin_bit_cast(unsigned, qf[dt & 3][0] | (qf[dt & 3][1] << 16)) & 0x3f803f80u; ow.y = 0u; *(u32x2*)(orow + 16 * dt) = ow; }
            if (gq == 0) LSE[((size_t)g * SEQ + qpos) * NHEAD + h] = 0.f; }
        __syncthreads();
    }
}
#undef ATT_DECODE
#undef ATT_LOAD

__device__ __forceinline__ void att_combine(Frame& F, int l) {
    const bf16* ATT = (const bf16*)(F.ws + WS_ATT); const float* LSE = (const float*)(F.ws + WS_LSE); bf16* MIX = (bf16*)(F.ws + WS_MIX);
    const int gw = F.vcu * NWAVES + F.wave, NGW = F.G * NWAVES, lane = F.lane;
    const float* og = F.in[IN_OUTN] + (size_t)l * DM + 1024 + 16 * lane;
    f32x4 gg[4];
#pragma unroll
    for (int q = 0; q < 4; ++q) gg[q] = *(const f32x4*)(og + 4 * q);
    for (int m = gw; m < SEQ; m += NGW) {
        const int hh = lane >> 3;
        const float l0 = LSE[((size_t)0 * SEQ + m) * NHEAD + hh], l1 = LSE[((size_t)1 * SEQ + m) * NHEAD + hh], l2 = LSE[((size_t)2 * SEQ + m) * NHEAD + hh];
        const float M = fmaxf(l0, fmaxf(l1, l2)); float w0 = fast_exp(l0 - M), w1 = fast_exp(l1 - M), w2 = fast_exp(l2 - M);
        const float iw = __builtin_amdgcn_rcpf(w0 + w1 + w2); w0 *= iw; w1 *= iw; w2 *= iw;
        float y[16]; float s = 0.f;
#pragma unroll
        for (int q = 0; q < 2; ++q) {
            const u32x4 a = *(const u32x4*)(ATT + ((size_t)0 * SEQ + m) * 1024 + 16 * lane + 8 * q), b = *(const u32x4*)(ATT + ((size_t)1 * SEQ + m) * 1024 + 16 * lane + 8 * q), c = *(const u32x4*)(ATT + ((size_t)2 * SEQ + m) * 1024 + 16 * lane + 8 * q);
            const unsigned au[4] = {a.x, a.y, a.z, a.w}, bu[4] = {b.x, b.y, b.z, b.w}, cu[4] = {c.x, c.y, c.z, c.w};
#pragma unroll
            for (int e = 0; e < 4; ++e) { y[8 * q + 2 * e] = w0 * bf_lo(au[e]) + w1 * bf_lo(bu[e]) + w2 * bf_lo(cu[e]); y[8 * q + 2 * e + 1] = w0 * bf_hi(au[e]) + w1 * bf_hi(bu[e]) + w2 * bf_hi(cu[e]); } }
#pragma unroll
        for (int e = 0; e < 16; ++e) s += y[e] * y[e];
        const float rs = __builtin_amdgcn_rsqf(wave_sum(s) * (1.f / 1024.f) + EPS);
        if (OP8(l)) { u32x4 o8;
            o8.x = pk4_fp8(y[0] * rs * gg[0][0], y[1] * rs * gg[0][1], y[2] * rs * gg[0][2], y[3] * rs * gg[0][3]); o8.y = pk4_fp8(y[4] * rs * gg[1][0], y[5] * rs * gg[1][1], y[6] * rs * gg[1][2], y[7] * rs * gg[1][3]);
            o8.z = pk4_fp8(y[8] * rs * gg[2][0], y[9] * rs * gg[2][1], y[10] * rs * gg[2][2], y[11] * rs * gg[2][3]); o8.w = pk4_fp8(y[12] * rs * gg[3][0], y[13] * rs * gg[3][1], y[14] * rs * gg[3][2], y[15] * rs * gg[3][3]);
            *(u32x4*)((unsigned char*)MIX + (size_t)m * DM + 1024 + 16 * lane) = o8; }
        else
#pragma unroll
        for (int q = 0; q < 2; ++q) { u32x4 o;
            o.x = cvt_pk_bf16(y[8 * q + 0] * rs * gg[2 * q][0], y[8 * q + 1] * rs * gg[2 * q][1]); o.y = cvt_pk_bf16(y[8 * q + 2] * rs * gg[2 * q][2], y[8 * q + 3] * rs * gg[2 * q][3]);
            o.z = cvt_pk_bf16(y[8 * q + 4] * rs * gg[2 * q + 1][0], y[8 * q + 5] * rs * gg[2 * q + 1][1]); o.w = cvt_pk_bf16(y[8 * q + 6] * rs * gg[2 * q + 1][2], y[8 * q + 7] * rs * gg[2 * q + 1][3]);
            *(u32x4*)(MIX + (size_t)m * DM + 1024 + 16 * lane + 8 * q) = o; }
    }
}

#define ROUTER_LOAD(S, ks) do { \
    _Pragma("unroll") for (int rt = 0; rt < 4; ++rt) xa##S[rt] = *(const u32x4*)(xrow + (size_t)rt * 16 * DM + 32 * (ks)); \
    _Pragma("unroll") for (int ct = 0; ct < 3; ++ct) { bh##S[ct] = *(const bf16x8*)(wf + (size_t)(ks) * 3072 + (ct * 2) * 512); bl##S[ct] = *(const bf16x8*)(wf + (size_t)(ks) * 3072 + (ct * 2 + 1) * 512); } } while (0)
#define ROUTER_STEP(S, ks) do { \
    _Pragma("unroll") for (int rt = 0; rt < 4; ++rt) { const u32x4 xq = xa##S[rt]; \
        const float x0 = bf_lo(xq.x), x1 = bf_hi(xq.x), x2 = bf_lo(xq.y), x3 = bf_hi(xq.y), x4 = bf_lo(xq.z), x5 = bf_hi(xq.z), x6 = bf_lo(xq.w), x7 = bf_hi(xq.w); \
        ssq[rt] += (x0 * x0 + x1 * x1) + (x2 * x2 + x3 * x3) + (x4 * x4 + x5 * x5) + (x6 * x6 + x7 * x7); \
        { u32x2 x8; x8.x = pk4_fp8(x0, x1, x2, x3); x8.y = pk4_fp8(x4, x5, x6, x7); *(u32x2*)(x8row + (size_t)rt * 16 * DM + 32 * (ks)) = x8; } \
        const bf16x8 xh = __builtin_bit_cast(bf16x8, xq); \
        _Pragma("unroll") for (int ct = 0; ct < 3; ++ct) { \
            acc[rt][ct] = __builtin_amdgcn_mfma_f32_16x16x32_bf16(xh, bh##S[ct], acc[rt][ct], 0, 0, 0); \
            acc[rt][ct] = __builtin_amdgcn_mfma_f32_16x16x32_bf16(xh, bl##S[ct], acc[rt][ct], 0, 0, 0); } } } while (0)
__device__ __forceinline__ void router_phase(Frame& F, int l, int alt = 0) {
    const bf16* H1 = (const bf16*)(F.ws + WS_HN);
    const bf16* WRF = (const bf16*)(F.ws + WS_WRT) + (size_t)l * 64 * 3 * 2 * 64 * 8;
    unsigned* cnt = (unsigned*)(F.ws + WS_CTL) + CW_CNT + 2048 * l + 32768 * alt;
    int* tok = (int*)(F.ws + (alt ? WS_ALT : WS_TOK)); f32x4* tinfo = (f32x4*)(F.ws + (alt ? WS_ALT + 4 * MiB : WS_TINFO)); float* rslot = (float*)(F.ws + (alt ? WS_ALT + 2 * MiB : WS_RSLOT));
    const int lane = F.lane, tid = F.tid, w = F.wave, fr = lane & 15, g = lane >> 4;
    constexpr int PS = 49;
    LAS float* P = (LAS float*)F.lds;
    LAS float* SS = (LAS float*)(F.lds + 8 * 64 * PS * 4);
    for (int task = (int)blockIdx.x; task < SEQ / 64; task += F.G) {
        const bf16* xrow = H1 + (size_t)(task * 64 + fr) * DM + 256 * w + 8 * g;
        unsigned char* x8row = F.ws + WS_X8 + (size_t)(task * 64 + fr) * DM + 256 * w + 8 * g;
        const bf16* wf = WRF + ((size_t)(8 * w) * 3 * 2 * 64 + lane) * 8;
        f32x4 acc[4][3]; float ssq[4] = {0.f, 0.f, 0.f, 0.f};
#pragma unroll
        for (int rt = 0; rt < 4; ++rt)
#pragma unroll
            for (int ct = 0; ct < 3; ++ct) acc[rt][ct] = (f32x4){0.f, 0.f, 0.f, 0.f};
        u32x4 xaA[4], xaB[4]; bf16x8 bhA[3], blA[3], bhB[3], blB[3];
        ROUTER_LOAD(A, 0);
#pragma unroll 1
        for (int it = 0; it < 4; ++it) {
            ROUTER_LOAD(B, 1); __builtin_amdgcn_sched_barrier(0);
            ROUTER_STEP(A, 0); __builtin_amdgcn_sched_barrier(0);
            if (it < 3) ROUTER_LOAD(A, 2);
            __builtin_amdgcn_sched_barrier(0);
            ROUTER_STEP(B, 1); __builtin_amdgcn_sched_barrier(0);
            xrow += 64; x8row += 64; wf += 2 * 3072;
        }
#pragma unroll
        for (int rt = 0; rt < 4; ++rt) { float sq = ssq[rt]; sq += __shfl_xor(sq, 16); sq += __shfl_xor(sq, 32);
            if (g == 0) SS[w * 64 + 16 * rt + fr] = sq;
#pragma unroll
            for (int ct = 0; ct < 3; ++ct)
#pragma unroll
                for (int e = 0; e < 4; ++e) P[(w * 64 + 16 * rt + 4 * g + e) * PS + 16 * ct + fr] = acc[rt][ct][e]; }
        __syncthreads();
        if (tid < 64) {
            const int t = task * 64 + tid;
            float ss = 0.f;
#pragma unroll
            for (int q = 0; q < 8; ++q) ss += SS[q * 64 + tid];
            const float rs = __builtin_amdgcn_rsqf(ss * (1.f / DM) + EPS);
            const LAS float* pr = P + tid * PS;
            float lg[4];
#pragma unroll
            for (int o = 0; o < 4; ++o) { float a = 0.f;
#pragma unroll
                for (int q = 0; q < 8; ++q) a += pr[q * 64 * PS + 32 + o];
                lg[o] = a * rs + F.in[IN_BRG][l * 4 + o]; }
            int gi = 0; float gm = lg[0];
#pragma unroll
            for (int o = 1; o < 4; ++o) if (lg[o] > gm) { gm = lg[o]; gi = o; }
            float den = 0.f;
#pragma unroll
            for (int o = 0; o < 4; ++o) den += __expf(lg[o] - gm);
            const float gate_g = 1.f / den;
            float t1v = -INFINITY, t2v = -INFINITY; int t1i = 0, t2i = 0;
#pragma unroll
            for (int ii = 0; ii < 8; ++ii) { const int o = gi * 8 + ii; float a = 0.f;
#pragma unroll
                for (int q = 0; q < 8; ++q) a += pr[q * 64 * PS + o];
                const float v = a * rs + F.in[IN_BRE][l * NE + o];
                if (v > t1v) { t2v = t1v; t2i = t1i; t1v = v; t1i = ii; }
                else if (v > t2v) { t2v = v; t2i = ii; } }
            const float pp1 = 1.f / (1.f + __expf(t2v - t1v)), pp2 = 1.f - pp1;
            const int e0 = gi * 8 + t1i, e1 = gi * 8 + t2i;
            LAS unsigned* lcnt = (LAS unsigned*)(F.lds + 8 * 64 * PS * 4 + 8 * 64 * 4);
            if (tid < 32) lcnt[tid] = 0u;
            const unsigned r0 = __hip_atomic_fetch_add(lcnt + e0, 1u, __ATOMIC_RELAXED, __HIP_MEMORY_SCOPE_WORKGROUP), r1 = __hip_atomic_fetch_add(lcnt + e1, 1u, __ATOMIC_RELAXED, __HIP_MEMORY_SCOPE_WORKGROUP);
            if (tid < 32) { const unsigned c = lcnt[tid]; lcnt[32 + tid] = c ? atomicAdd(&cnt[tid * CNT_STRIDE], c) : 0u; }
            const unsigned s0 = lcnt[32 + e0] + r0, s1 = lcnt[32 + e1] + r1;
            tok[(size_t)e0 * TOKCAP + s0] = t; tok[(size_t)e1 * TOKCAP + s1] = t;
            rslot[(size_t)e0 * TOKCAP + s0] = rs; rslot[(size_t)e1 * TOKCAP + s1] = rs;
            f32x4 ti; ti[0] = __builtin_bit_cast(float, (int)(e0 * TOKCAP + s0)); ti[1] = __builtin_bit_cast(float, (int)(e1 * TOKCAP + s1)); ti[2] = gate_g * pp1; ti[3] = gate_g * pp2;
            tinfo[t] = ti;
        }
        __syncthreads();
    }
}
__device__ __forceinline__ void moe_table(Frame& F, int l) {
    const unsigned* cnt = (const unsigned*)(F.ws + WS_CTL) + CW_CNT + 2048 * l;
    LAS int* tstart = (LAS int*)(F.lds + MISC_OFF + 64);
    __syncthreads();
    if (F.tid == 0) { int acc = 0; for (int e = 0; e < NE; ++e) { tstart[e] = acc; acc += ((int)cnt[e * CNT_STRIDE] + 255) >> 8; } tstart[NE] = acc; }
    __syncthreads();
    { LAS int* tile_e = (LAS int*)(F.lds + MISC_OFF + 2304);
      if (F.tid < 160) { int e = 0; for (int j = 1; j < NE; ++j) e = (tstart[j] <= F.tid) ? j : e; tile_e[F.tid] = e; } }
    __syncthreads();
}
__device__ __forceinline__ void combine_phase(Frame& F, int l) {
    const LAS int* tstart = (const LAS int*)(F.lds + MISC_OFF + 64);
    const unsigned char* Y = F.ws + WS_Y; const f32x4* tinfo = (const f32x4*)(F.ws + WS_TINFO);
    bf16* H = (bf16*)(F.ws + WS_H); bf16* HN = (bf16*)(F.ws + WS_HN);
    const int gw = F.vcu * NWAVES + F.wave, NGW = F.G * NWAVES, lane = F.lane;
    const float* g1n = F.in[IN_NORM1] + (size_t)DM;
    for (int m = gw; m < SEQ; m += NGW) {
        const f32x4 ti = tinfo[m];
        const float tf0 = ti[0], tf1 = ti[1]; const int s0 = __builtin_bit_cast(int, tf0), s1 = __builtin_bit_cast(int, tf1);
        const int e0 = s0 >> 14, e1 = s1 >> 14;
        const size_t r0 = (size_t)tstart[e0] * 256 + (s0 & (TOKCAP - 1)), r1 = (size_t)tstart[e1] * 256 + (s1 & (TOKCAP - 1));
        const float ga = ti[2] * (1.f / Y_SCALE), gb = ti[3] * (1.f / Y_SCALE);
        f32x4 v[8]; float s = 0.f;
#pragma unroll
        for (int j = 0; j < 8; ++j) { const u32x2 hx = *(const u32x2*)(HN + (size_t)m * DM + 4 * lane + 256 * j);
            const int ya = *(const int*)(Y + r0 * DM + 4 * lane + 256 * j), yb = *(const int*)(Y + r1 * DM + 4 * lane + 256 * j);
            const f32x2 a01 = __builtin_amdgcn_cvt_pk_f32_fp8(ya, false), a23 = __builtin_amdgcn_cvt_pk_f32_fp8(ya, true), b01 = __builtin_amdgcn_cvt_pk_f32_fp8(yb, false), b23 = __builtin_amdgcn_cvt_pk_f32_fp8(yb, true);
            v[j][0] = bf_lo(hx.x) + ga * a01[0] + gb * b01[0]; v[j][1] = bf_hi(hx.x) + ga * a01[1] + gb * b01[1];
            v[j][2] = bf_lo(hx.y) + ga * a23[0] + gb * b23[0]; v[j][3] = bf_hi(hx.y) + ga * a23[1] + gb * b23[1];
            s += (v[j][0] * v[j][0] + v[j][1] * v[j][1]) + (v[j][2] * v[j][2] + v[j][3] * v[j][3]); }
        if (l == 0) {
            const float rs = __builtin_amdgcn_rsqf(wave_sum(s) * (1.f / DM) + EPS);
            bf16* hrow = H + (size_t)m * DM; bf16* orow = HN + (size_t)m * DM;
#pragma unroll
            for (int j = 0; j < 8; ++j) { const f32x4 gg = *(const f32x4*)(g1n + 4 * lane + 256 * j);
                u32x2 hb; hb.x = cvt_pk_bf16(v[j][0], v[j][1]); hb.y = cvt_pk_bf16(v[j][2], v[j][3]); *(u32x2*)(hrow + 4 * lane + 256 * j) = hb;
                if (IP8(1)) *(unsigned*)(F.ws + WS_X8 + (size_t)m * DM + 4 * lane + 256 * j) = pk4_fp8(v[j][0] * rs * gg[0], v[j][1] * rs * gg[1], v[j][2] * rs * gg[2], v[j][3] * rs * gg[3]);
                else { u32x2 o; o.x = cvt_pk_bf16(v[j][0] * rs * gg[0], v[j][1] * rs * gg[1]); o.y = cvt_pk_bf16(v[j][2] * rs * gg[2], v[j][3] * rs * gg[3]);
                *(u32x2*)(orow + 4 * lane + 256 * j) = o; } }
        } else {
            float* orow = F.out + (size_t)m * DM;
#pragma unroll
            for (int j = 0; j < 8; ++j) __builtin_nontemporal_store(v[j], (f32x4*)(orow + 4 * lane + 256 * j));
        }
    }
}

__device__ __forceinline__ void relaunder(Frame& F) { F.lane = lane_now(); F.tid = F.wave * 64 + F.lane; }
constexpr int N_PHASES = 17;
#ifndef PHASE_MASK
#define PHASE_MASK 0x1ff
#endif
#ifndef MIX_MASK
#define MIX_MASK 7
#endif
#ifndef DUP_PHASE
#define DUP_PHASE 0
#endif
#define DUP(k) for (int _d = 0; _d < ((DUP_PHASE == (k)) ? 2 : 1); ++_d)
#define IN(k) (lo <= (k) && (k) < hi)
#define EN(b) ((PHASE_MASK >> (b)) & 1)
#ifndef PROBE_STAMP
#define PROBE_STAMP (-1)
#endif
#define SEAM(k) do { if (IN(k) && IN((k) + 1)) { xcd_barrier(bar); if (PROBE_STAMP >= 0 && blockIdx.x == 0 && F.tid == 0) { const unsigned long long _t = wall_clock64(); F.MISC[802 + 2 * (k)] = (unsigned)_t; F.MISC[803 + 2 * (k)] = (unsigned)(_t >> 32); } } } while (0)
template <int l>
__device__ __forceinline__ void layer_phases(Frame& F, const XcdBarrier& bar, const int lo, const int hi) {
    constexpr int pb = 1 + 8 * l;
    relaunder(F);
    if (EN(1) && IN(pb)) {
        constexpr int KI = IP8(l) ? DM / 2 : DM;
        pg8::StaticSched S; S.init((const bf16*)(F.ws + (IP8(l) ? WS_X8 : WS_HN)), (const bf16*)(F.ws + WS_WIN) + (size_t)l * DIN * DM, SEQ, DIN, KI, F.G, (int)blockIdx.x);
        pg8::EpiProj E{(bf16*)(F.ws + WS_PROJ), IP8(l) ? 1.f / WIN_SCALE : 1.f};
        DUP(1) pg8::gemm_phase<pg8::EpiProj, pg8::StaticSched, true, IP8(l) != 0>(F.lds, KI, S, E, F.wave);
    }
    SEAM(pb);
    relaunder(F);
    if (EN(2) && IN(pb + 1)) {
        constexpr int N_SGU = 256, N_CONV = 512, N_ATT = 3072;
#define MSTAMP(i) do { if (PROBE_STAMP >= 100 && l == 0 && blockIdx.x == 0 && F.tid == 0) { const unsigned long long _t = wall_clock64(); F.MISC[900 + 2 * (i)] = (unsigned)_t; F.MISC[901 + 2 * (i)] = (unsigned)(_t >> 32); } } while (0)
        MSTAMP(0);
        if (MIX_MASK & 1) DUP(2) att_phase(F, l);
        MSTAMP(1);
        if (MIX_MASK & 2) DUP(3) for (int it = (int)blockIdx.x; it < N_CONV; it += F.G) conv_item(F, l, it);
        MSTAMP(2);
        if (MIX_MASK & 4) DUP(4) for (int it = (int)blockIdx.x; it < N_SGU; it += F.G) sgu_item(F, l, it >> 1, it & 1);
        MSTAMP(3);
#undef MSTAMP
    }
    SEAM(pb + 1);
    if (DUP_PHASE == 12 && IN(pb + 1)) {
        pg8::StaticSched S; S.init((const bf16*)(F.ws + WS_MIX), (const bf16*)(F.ws + WS_WIN) + (size_t)l * DIN * DM, SEQ, DIN, DM, F.G, (int)blockIdx.x);
        pg8::EpiProj E{(bf16*)(F.ws + WS_PROJ), 1.f};
        pg8::gemm_phase<pg8::EpiProj, pg8::StaticSched>(F.lds, DM, S, E, F.wave);
        xcd_barrier(bar);
    }
    relaunder(F);
    if (EN(3) && IN(pb + 2)) DUP(5) att_combine(F, l);
    SEAM(pb + 2);
    relaunder(F);
    if (EN(4) && IN(pb + 3)) {
        constexpr int KO = OP8(l) ? DM / 2 : DM;
        pg8::StaticSched S; S.init((const bf16*)(F.ws + WS_MIX), (const bf16*)(F.ws + WS_WOUT) + (size_t)l * DM * DM, SEQ, DM, KO, F.G, (int)blockIdx.x);
        if constexpr (l == 0) { pg8::EpiResid<false> E{(const void*)F.in[IN_X], (bf16*)(F.ws + WS_HN)}; DUP(6) pg8::gemm_phase<pg8::EpiResid<false>, pg8::StaticSched, true, OP8(l) != 0>(F.lds, KO, S, E, F.wave); }
        else { pg8::EpiResid<true> E{(const void*)(F.ws + WS_H), (bf16*)(F.ws + WS_HN)}; DUP(6) pg8::gemm_phase<pg8::EpiResid<true>, pg8::StaticSched, true, OP8(l) != 0>(F.lds, KO, S, E, F.wave); }
    }
    SEAM(pb + 3);
    relaunder(F);
    if (EN(5) && IN(pb + 4)) { router_phase(F, l); if (DUP_PHASE == 11) router_phase(F, l, 1); }
    if (DUP_PHASE == 13 && IN(pb + 4)) { for (int q = 0; q < 8; ++q) xcd_barrier(bar); }
    SEAM(pb + 4);
    relaunder(F);
    if (EN(6) && IN(pb + 5)) {
        moe_table(F, l);
        unsigned* ready = (unsigned*)(F.ws + WS_CTL) + CW_RDY + 16384 * l;
        {
            pg8::SchedG1 S{(const LAS int*)(F.lds + MISC_OFF + 64), (const int*)((const unsigned*)(F.ws + WS_CTL) + CW_CNT + 2048 * l), (const int*)(F.ws + WS_TOK), (const bf16*)(F.ws + WS_X8),
                           (const bf16*)(F.ws + WS_W1 + (size_t)l * NE * 1024 * DM), F.G, (int)blockIdx.x, ready};
            pg8::EpiSwiGLU E{F.ws + WS_HB, (const float*)(F.ws + WS_RSLOT)};
            DUP(7) pg8::gemm_phase<pg8::EpiSwiGLU, pg8::SchedG1, true, true>(F.lds, DM / 2, S, E, F.wave);
        }
        {
            pg8::SchedG2 S{(const LAS int*)(F.lds + MISC_OFF + 64), (const bf16*)(F.ws + WS_HB), (const bf16*)(F.ws + WS_W2 + (size_t)l * NE * DM * DE), F.G, (int)blockIdx.x, ready, (unsigned*)(F.ws + WS_CTL) + CW_TMO, F.wave};
            pg8::EpiY E{F.ws + WS_Y};
            DUP(8) pg8::gemm_phase<pg8::EpiY, pg8::SchedG2, true, true>(F.lds, DE / 2, S, E, F.wave);
        }
    }
    SEAM(pb + 6);
    relaunder(F);
    if (EN(8) && IN(pb + 7)) { moe_table(F, l); DUP(l == 0 ? 9 : 99) combine_phase(F, l); }
    SEAM(pb + 7);
}
__global__ void __launch_bounds__(NTHREADS, 2) fwd_kernel(Params args) {
    extern __shared__ __attribute__((aligned(16))) unsigned char lds_raw[];
    Frame F;
    F.lds = (LAS unsigned char*)lds_raw; F.MISC = (volatile LAS unsigned*)(F.lds + MISC_OFF);
    F.tid = threadIdx.x; F.lane = F.tid & 63; F.wave = __builtin_amdgcn_readfirstlane(F.tid >> 6);
    F.G = gridDim.x; { const int bx = blockIdx.x; F.vcu = (F.G % 8 == 0) ? (bx % 8) * (F.G / 8) + bx / 8 : bx; }
    F.in = args.in; F.out = args.out; F.ws = args.ws;
    for (int u = F.tid; u < (LDS_BYTES - MISC_OFF) / 4; u += NTHREADS) ((LAS unsigned*)(F.lds + MISC_OFF))[u] = 0u;
    __syncthreads();
    unsigned* ctl = (unsigned*)(args.ws + WS_CTL);
    const int lo = args.ph_lo, hi = args.ph_hi;
    const bool multi = (hi - lo) > 1;
    XcdBarrier bar; bar.bar = ctl + CW_BAR; bar.x = 0; bar.st = nullptr; bar.lead = 0;
    if (multi) bar = xcd_barrier_post(ctl + CW_BAR, F.MISC, F.wave == 0 ? 1u : 0u);
    if (PROBE_STAMP >= 0 && blockIdx.x == 0 && F.tid == 0) { const unsigned long long _t = wall_clock64(); F.MISC[800] = (unsigned)_t; F.MISC[801] = (unsigned)(_t >> 32); }
    if (EN(0) && IN(0)) { DUP(10) p_prologue(F); }
    SEAM(0);
    layer_phases<0>(F, bar, lo, hi);
    layer_phases<1>(F, bar, lo, hi);
    if (PROBE_STAMP >= 0 && blockIdx.x == 0 && F.tid == 0) {
        asm volatile("s_waitcnt vmcnt(0)" ::: "memory");
        constexpr int SB = PROBE_STAMP >= 100 ? 900 + 2 * (PROBE_STAMP - 100) : (PROBE_STAMP == 6 ? 812 : 800 + 2 * PROBE_STAMP);
        constexpr int SB1 = (PROBE_STAMP == 6) ? SB + 4 : SB + 2;
        const unsigned long long t1 = ((unsigned long long)F.MISC[SB1 + 1] << 32) | F.MISC[SB1], t0 = ((unsigned long long)F.MISC[SB + 1] << 32) | F.MISC[SB];
        F.out[0] += (float)(long long)(t1 - t0) * 0.01f;
    }
}
#undef IN
#undef EN
#undef SEAM
#undef DUP

extern "C" void kernel_launch(void* const* d_in, const int* in_sizes, int n_in, void* d_out, int out_size, void* d_ws, size_t ws_size, hipStream_t stream) {
    static int grid = 0;
    if (grid == 0) {
        if (n_in != 22 || out_size != SEQ * DM || ws_size < WS_END) { fprintf(stderr, "kernel_launch: unexpected shapes (n_in %d out %d ws %zu, need %zu)\n", n_in, out_size, ws_size, (size_t)WS_END); grid = -1; return; }
        int dev = 0, cus = 0, per_cu = 0;
        if (hipGetDevice(&dev) != hipSuccess || hipDeviceGetAttribute(&cus, hipDeviceAttributeMultiprocessorCount, dev) != hipSuccess) { grid = -1; return; }
        if (hipFuncSetAttribute((const void*)fwd_kernel, hipFuncAttributeMaxDynamicSharedMemorySize, LDS_BYTES) != hipSuccess) { fprintf(stderr, "kernel_launch: hipFuncSetAttribute failed\n"); grid = -1; return; }
        if (hipOccupancyMaxActiveBlocksPerMultiprocessor(&per_cu, (const void*)fwd_kernel, NTHREADS, LDS_BYTES) != hipSuccess || per_cu < 1) { fprintf(stderr, "kernel_launch: occupancy query says %d\n", per_cu); }
        (void)hipGetLastError();
        grid = cus;
    }
    if (grid < 0) return;
    if (hipMemsetAsync((char*)d_ws + WS_CTL, 0, CTL_ZERO_BYTES, stream) != hipSuccess) return;
    Params p{};
    for (int i = 0; i < 22; ++i) p.in[i] = (const float*)d_in[i];
    p.out = (float*)d_out; p.ws = (unsigned char*)d_ws;
    constexpr int NL = MK_N_LAUNCHES;
    for (int li = 0; li < NL; ++li) {
        p.ph_lo = (NL == 1) ? 0 : li; p.ph_hi = (NL == 1) ? N_PHASES : li + 1;
        hipLaunchKernelGGL(fwd_kernel, dim3(grid), dim3(NTHREADS), LDS_BYTES, stream, p);
        if (hipPeekAtLastError() != hipSuccess) { fprintf(stderr, "kernel_launch: launch %d failed\n", li); break; }
    }
}
```

```cpp
#include <hip/hip_runtime.h>
#include <cstdio>
#include <cstdint>

#ifndef MK_N_LAUNCHES
#define MK_N_LAUNCHES 1
#endif

#ifndef OUTPROJ_FP8
#define OUTPROJ_FP8 2
#endif
#ifndef ATT_EXP
#define ATT_EXP 0
#endif
#define OP8(l) ((OUTPROJ_FP8 >> (l)) & 1)
#ifndef INPROJ_FP8
#define INPROJ_FP8 2
#endif
#define IP8(l) ((INPROJ_FP8 >> (l)) & 1)
#define GAS __attribute__((address_space(1)))
#define LAS __attribute__((address_space(3)))
typedef unsigned short bf16;
typedef short bf16x8 __attribute__((ext_vector_type(8)));
typedef short s16x4 __attribute__((ext_vector_type(4)));
typedef float f32x4 __attribute__((ext_vector_type(4)));
typedef float f32x2 __attribute__((ext_vector_type(2)));
typedef unsigned u32x4 __attribute__((ext_vector_type(4)));
typedef unsigned u32x2 __attribute__((ext_vector_type(2)));

constexpr int SEQ = 16384, DM = 2048, DIN = 5120, NLAYER = 2;
constexpr int HD = 128, NHEAD = 8, CONV_K = 31;
constexpr int NE = 32, DE = 512, TOKCAP = 16384;
constexpr int OFF_U = 0, OFF_V = 512, OFF_A = 1024, OFF_G = 1536, OFF_Q = 2048, OFF_K = 3072, OFF_VV = 4096;
constexpr float EPS = 1e-6f;
constexpr float W1_SCALE = 64.f, W2_SCALE = 32.f, WOUT_SCALE = 64.f, WIN_SCALE = 64.f, Y_SCALE = 16.f;
constexpr int NWAVES = 8, NTHREADS = 512;

constexpr size_t MiB = 1u << 20;
constexpr size_t WS_CTL = 0, CTL_ZERO_BYTES = 1 * MiB;
constexpr size_t WS_WIN = 1 * MiB;
constexpr size_t WS_WOUT = 41 * MiB;
constexpr size_t WS_W1 = 57 * MiB;
constexpr size_t WS_X8 = 185 * MiB;
constexpr size_t WS_W2 = 313 * MiB;
constexpr size_t WS_SGUW = 441 * MiB;
constexpr size_t WS_WRT = 442 * MiB;
constexpr size_t WS_TOK = 443 * MiB;
constexpr size_t WS_TINFO = 445 * MiB;
constexpr size_t WS_HN = 446 * MiB;
constexpr size_t WS_HB = 510 * MiB;
constexpr size_t WS_ATT = WS_HN;
constexpr size_t WS_LSE = WS_HN + 96 * MiB;
constexpr size_t WS_PROJ = 550 * MiB;
constexpr size_t WS_Y = WS_PROJ;
constexpr size_t WS_MIX = 710 * MiB;
constexpr size_t WS_H = 774 * MiB;
constexpr size_t WS_RSLOT = 902 * MiB;
constexpr size_t WS_ALT = 904 * MiB;
constexpr size_t WS_END = 910 * MiB;
constexpr int CW_BAR = 4096;
constexpr int CW_TMO = 0;
constexpr int CW_RDY = 65536;
constexpr int CW_CNT = 16384, CNT_STRIDE = 64;

constexpr int LDS_BYTES = 163840;
constexpr int MISC_OFF = 159744;

__device__ __forceinline__ unsigned cvt_pk_bf16(float lo, float hi) { unsigned r; asm volatile("v_cvt_pk_bf16_f32 %0, %1, %2" : "=v"(r) : "v"(lo), "v"(hi)); return r; }
__device__ __forceinline__ unsigned pk4_fp8(float a, float b, float c, float d) { int p = 0; p = __builtin_amdgcn_cvt_pk_fp8_f32(a, b, p, false); p = __builtin_amdgcn_cvt_pk_fp8_f32(c, d, p, true); return (unsigned)p; }
__device__ __forceinline__ float bf_lo(unsigned u) { return __builtin_bit_cast(float, u << 16); }
__device__ __forceinline__ float bf_hi(unsigned u) { return __builtin_bit_cast(float, u & 0xffff0000u); }
template <int CTRL, int RM> __device__ __forceinline__ float dpp_mov0(float v) { return __builtin_bit_cast(float, __builtin_amdgcn_update_dpp(0, __builtin_bit_cast(int, v), CTRL, RM, 0xf, false)); }
__device__ __forceinline__ float wave_sum(float s) {
    s += dpp_mov0<0xB1, 0xf>(s); s += dpp_mov0<0x4E, 0xf>(s); s += dpp_mov0<0x141, 0xf>(s); s += dpp_mov0<0x140, 0xf>(s);
    s += dpp_mov0<0x142, 0xa>(s); s += dpp_mov0<0x143, 0xc>(s);
    return __builtin_bit_cast(float, __builtin_amdgcn_readlane(__builtin_bit_cast(int, s), 63));
}
__device__ __forceinline__ float row16_sum(float s) {
    s += dpp_mov0<0xB1, 0xf>(s); s += dpp_mov0<0x4E, 0xf>(s); s += dpp_mov0<0x141, 0xf>(s); s += dpp_mov0<0x140, 0xf>(s); return s;
}
__device__ __forceinline__ float sum4(float x) {
    const unsigned xu = __builtin_bit_cast(unsigned, x); const auto r = __builtin_amdgcn_permlane16_swap(xu, xu, false, false); const unsigned r0 = r[0], r1 = r[1];
    const float a = __builtin_bit_cast(float, r0) + __builtin_bit_cast(float, r1);
    const unsigned au = __builtin_bit_cast(unsigned, a); const auto q = __builtin_amdgcn_permlane32_swap(au, au, false, false); const unsigned q0 = q[0], q1 = q[1];
    return __builtin_bit_cast(float, q0) + __builtin_bit_cast(float, q1);
}
__device__ __forceinline__ float max4(float x) {
    const unsigned xu = __builtin_bit_cast(unsigned, x); const auto r = __builtin_amdgcn_permlane16_swap(xu, xu, false, false); const unsigned r0 = r[0], r1 = r[1];
    const float a = fmaxf(__builtin_bit_cast(float, r0), __builtin_bit_cast(float, r1));
    const unsigned au = __builtin_bit_cast(unsigned, a); const auto q = __builtin_amdgcn_permlane32_swap(au, au, false, false); const unsigned q0 = q[0], q1 = q[1];
    return fmaxf(__builtin_bit_cast(float, q0), __builtin_bit_cast(float, q1));
}
__device__ __forceinline__ int lane_now() { int l; asm volatile("v_mbcnt_lo_u32_b32 %0, -1, 0\n\tv_mbcnt_hi_u32_b32 %0, -1, %0" : "=v"(l)); return l; }
#define LDS_WAIT() asm volatile("s_waitcnt lgkmcnt(0)" ::: "memory")
#define VM_WAIT() asm volatile("s_waitcnt vmcnt(0)" ::: "memory")
__device__ __forceinline__ float fast_exp(float x) { return __builtin_amdgcn_exp2f(x * 1.4426950408889634f); }
__device__ __forceinline__ float sigmoidf_(float x) { return __builtin_amdgcn_rcpf(1.0f + fast_exp(-x)); }
__device__ __forceinline__ float gelu_tanh(float x) { const float z = 1.5957691216057308f * (x + 0.044715f * x * x * x); return x * sigmoidf_(z); }

#define XB_TMO      128
#define XB_XCNT(j)  (256  + 64 * (j))
#define XB_XSUB(j)  (1280 + 64 * (j))
#define XB_XGEN(j)  (2304 + 64 * (j))
#define XB_TOP      3328
#define XB_TOPGEN   3392
#define XCD_BAR_WORDS 3456
#define XB_SPIN_CAP (1u << 22)
__device__ __forceinline__ unsigned xb_ld(unsigned* p)              { return __hip_atomic_load(p, __ATOMIC_RELAXED, __HIP_MEMORY_SCOPE_AGENT); }
__device__ __forceinline__ unsigned xb_add(unsigned* p, unsigned v) { return __hip_atomic_fetch_add(p, v, __ATOMIC_RELAXED, __HIP_MEMORY_SCOPE_AGENT); }
__device__ __forceinline__ unsigned xb_xcc_id() { return (unsigned)__builtin_amdgcn_s_getreg((3 << 11) | 20) & 0xFu; }
#define XB_SPIN(cond, bar) do { unsigned _sp = 0; while (cond) { __builtin_amdgcn_s_sleep(1); \
    if ((++_sp & 255u) == 0u) { if (xb_ld(&(bar)[XB_TMO])) break; if (_sp > XB_SPIN_CAP) { atomicAdd(&(bar)[XB_TMO], 1u); break; } } } } while (0)
struct XcdBarrier { unsigned* bar; unsigned x; volatile LAS unsigned* st; unsigned lead; };
__device__ __forceinline__ XcdBarrier xcd_barrier_post(unsigned* bar, volatile LAS unsigned* st, unsigned lead) {
    XcdBarrier b; b.bar = bar; b.x = xb_xcc_id(); b.st = st; b.lead = lead;
    if (lead && lane_now() == 0) (void)xb_add(&bar[XB_XCNT(b.x)], 1u);
    return b;
}
__device__ __forceinline__ void xcd_barrier_complete(unsigned* bar, unsigned x, unsigned& nloc, unsigned& nx) {
    const unsigned G = gridDim.x * gridDim.y * gridDim.z;
    unsigned sum, cnt, mine, sp = 0u;
    for (;;) {
        sum = 0u; cnt = 0u; mine = 0u;
#pragma unroll
        for (unsigned j = 0; j < 16; ++j) { const unsigned c = xb_ld(&bar[XB_XCNT(j)]); sum += c; cnt += (c > 0u) ? 1u : 0u; mine = (j == x) ? c : mine; }
        if (sum == G) break;
        __builtin_amdgcn_s_sleep(1);
        if ((++sp & 255u) == 0u) { if (xb_ld(&bar[XB_TMO])) break; if (sp > XB_SPIN_CAP) { atomicAdd(&bar[XB_TMO], 1u); break; } }
    }
    nloc = mine > 0u ? mine : 1u; nx = cnt > 0u ? cnt : 1u;
}
__device__ __forceinline__ void xcd_barrier(const XcdBarrier& b) {
    asm volatile("s_waitcnt vmcnt(0)" ::: "memory");
    __syncthreads();
    if (b.lead && lane_now() == 0) {
        unsigned* bar = b.bar;
        __builtin_amdgcn_s_waitcnt(0);
        unsigned nloc = b.st[0], nx = b.st[1];
        if (nloc == 0u) { xcd_barrier_complete(bar, b.x, nloc, nx); b.st[0] = nloc; b.st[1] = nx; }
        const unsigned old = xb_add(&bar[XB_XSUB(b.x)], 1u);
        const unsigned gen = old / nloc;
        if (old + 1u == (gen + 1u) * nloc) {
            __builtin_amdgcn_fence(__ATOMIC_RELEASE, "agent");
            asm volatile("s_waitcnt vmcnt(0)" ::: "memory");
            const unsigned og = xb_add(&bar[XB_TOP], 1u);
            const unsigned tg = og / nx;
            if (og + 1u == (tg + 1u) * nx) xb_add(&bar[XB_TOPGEN], 1u);
            else XB_SPIN(xb_ld(&bar[XB_TOPGEN]) == tg, bar);
            __builtin_amdgcn_fence(__ATOMIC_ACQUIRE, "agent");
            xb_add(&bar[XB_XGEN(b.x)], 1u);
            asm volatile("s_waitcnt vmcnt(0)" ::: "memory");
        } else {
            XB_SPIN(xb_ld(&bar[XB_XGEN(b.x)]) == gen, bar);
            __builtin_amdgcn_fence(__ATOMIC_ACQUIRE, "agent");
            asm volatile("s_waitcnt vmcnt(0)" ::: "memory");
        }
    }
    __syncthreads();
}

namespace pg8 {
constexpr int BM = 256, BK = 64, HALF = 128, HTB = HALF * BK * 2, STAGE_BYTES = 8 * HTB, NXCD = 8, WGM = 8;
__device__ __forceinline__ int lds_byte(int r, int c) { const int st = (r >> 4) * 2 + (c >> 5), rr = r & 15, cc = c & 31, ob = rr * 64 + cc * 2; return st * 1024 + (ob ^ (((ob >> 9) & 1) << 5)); }
__device__ __forceinline__ void stage_rc(int b, int& R, int& C) { const int st = b / 1024, sb = b % 1024, swz = sb ^ (((sb >> 9) & 1) << 5); R = (st >> 1) * 16 + swz / 64; C = (st & 1) * 32 + (swz % 64) / 2; }
__device__ __forceinline__ int perm32(int rho) { const int n = rho >> 4, i = rho & 15; return 8 * (i >> 2) + 4 * n + (i & 3); }

struct Unit { int pm, pn, e, rb; };

struct StaticSched {
    static constexpr bool GATHER = false;
    const bf16* A; const bf16* Bt; int K; int nM, nN, nwg, G, c;
    __device__ __forceinline__ void init(const bf16* A_, const bf16* Bt_, int M, int N, int K_, int G_, int c_) { A = A_; Bt = Bt_; K = K_; nM = M / BM; nN = N / BM; nwg = nM * nN; G = G_; c = c_; }
    __device__ __forceinline__ bool next(int i, Unit& u) const {
        const long L = (long)i * G + c; if (L >= nwg) return false;
        int wgid = (int)L; { const int q = nwg / NXCD, r = nwg % NXCD, xcd = wgid % NXCD, off = wgid / NXCD; wgid = (xcd < r ? xcd * (q + 1) : r * (q + 1) + (xcd - r) * q) + off; }
        const int nig = WGM * nN, gid = wgid / nig, fm = gid * WGM, gsz = (nM - fm) < WGM ? (nM - fm) : WGM;
        u.pm = fm + ((wgid % nig) % gsz); u.pn = (wgid % nig) / gsz; u.e = 0; u.rb = 0; return true;
    }
    __device__ __forceinline__ void a_ready(const Unit&) const {}
    __device__ __forceinline__ void done(const Unit&) const {}
    __device__ __forceinline__ const char* a_base(const Unit& u) const { return (const char*)A + (size_t)u.pm * BM * K * 2; }
    __device__ __forceinline__ const char* b_base(const Unit& u) const { return (const char*)Bt + (size_t)u.pn * BM * K * 2; }
    __device__ __forceinline__ void a_voff(const Unit&, const int (&R)[2], const int (&C)[2], unsigned (&v)[2][2]) const {
#pragma unroll
        for (int h = 0; h < 2; ++h)
#pragma unroll
            for (int i = 0; i < 2; ++i) v[h][i] = (unsigned)((h * HALF + R[i]) * K + C[i]) * 2u;
    }
};

typedef int v8i __attribute__((ext_vector_type(8)));
typedef int v4i __attribute__((ext_vector_type(4)));
template <class Epi, class Sched, bool ALIGN_EPI = true, bool FP8 = false>
__device__ __forceinline__ void gemm_phase(LAS unsigned char* lds, const int K, const Sched& S, const Epi& E, const int wave) {
    const int lane = lane_now(), wid = wave, tid = wid * 64 + lane,
              wr = wid >> 2, wc = wid & 3, fr = lane & 15, fq = lane >> 4;
    const int nt = K / BK;
    int Rr[2], Cc[2]; unsigned voffB[2];
#pragma unroll
    for (int i = 0; i < 2; ++i) { stage_rc(tid * 16 + i * 8192, Rr[i], Cc[i]); const int Rb = Epi::PERM ? ((Rr[i] & ~31) + perm32(Rr[i] & 31)) : Rr[i];
        voffB[i] = (unsigned)(Rb * K + Cc[i]) * 2u; }
    const size_t kstep = (size_t)(BK * 2);
    const size_t hstep = (size_t)HALF * K * 2;
    const unsigned ldsw = (unsigned)wid * 1024u;
    const unsigned ldsbase = (unsigned)__builtin_amdgcn_readfirstlane((int)(unsigned)(size_t)lds);
    const int aoff = lds_byte(wr * 64 + fr, fq * 8), boff = lds_byte(wc * 32 + fr, fq * 8);
#define PG8_SA(b, h) (((b) * 2 + (h)) * HTB)
#define PG8_SB(b, h) ((4 + (b) * 2 + (h)) * HTB)
#define PG8_STAGE(bufoff, gbase, voff) do { _Pragma("unroll") for (int _i = 0; _i < 2; ++_i) { unsigned _keep; \
        asm volatile("s_mov_b32 %0, m0\n\ts_mov_b32 m0, %3\n\ts_nop 0\n\tglobal_load_lds_dwordx4 %1, %2\n\ts_mov_b32 m0, %0" : "=&s"(_keep) : "v"((voff)[_i]), "s"((const char*)(gbase)), "s"(ldsbase + (unsigned)(bufoff) + ldsw + (unsigned)(_i * 8192)) : "memory"); } } while (0)
#define PG8_LDA(dst, b, h) do { _Pragma("unroll") for (int m = 0; m < 4; ++m) _Pragma("unroll") for (int k = 0; k < 2; ++k) dst[m][k] = *(const LAS bf16x8*)(lds + PG8_SA(b, h) + aoff + m * 2048 + k * 1024); } while (0)
#define PG8_LDB(dst, b, h) do { _Pragma("unroll") for (int n = 0; n < 2; ++n) _Pragma("unroll") for (int k = 0; k < 2; ++k) dst[n][k] = *(const LAS bf16x8*)(lds + PG8_SB(b, h) + boff + n * 2048 + k * 1024); } while (0)
#define PG8_LDA8(dst, b, h) do { _Pragma("unroll") for (int m = 0; m < 4; ++m) { const v4i lo_ = *(const LAS v4i*)(lds + PG8_SA(b, h) + aoff + m * 2048), hi_ = *(const LAS v4i*)(lds + PG8_SA(b, h) + aoff + m * 2048 + 1024); dst[m] = __builtin_shufflevector(lo_, hi_, 0, 1, 2, 3, 4, 5, 6, 7); } } while (0)
#define PG8_LDB8(dst, b, h) do { _Pragma("unroll") for (int n = 0; n < 2; ++n) { const v4i lo_ = *(const LAS v4i*)(lds + PG8_SB(b, h) + boff + n * 2048), hi_ = *(const LAS v4i*)(lds + PG8_SB(b, h) + boff + n * 2048 + 1024); dst[n] = __builtin_shufflevector(lo_, hi_, 0, 1, 2, 3, 4, 5, 6, 7); } } while (0)
#define PG8_MMA(ai, bj, At, Bt) do { __builtin_amdgcn_s_setprio(1); _Pragma("unroll") for (int m = 0; m < 4; ++m) _Pragma("unroll") for (int n = 0; n < 2; ++n) _Pragma("unroll") for (int k = 0; k < 2; ++k) \
        acc[ai][bj][m][n] = __builtin_amdgcn_mfma_f32_16x16x32_bf16(Bt[n][k], At[m][k], acc[ai][bj][m][n], 0, 0, 0); __builtin_amdgcn_s_setprio(0); } while (0)
#define PG8_MMA8(ai, bj, At, Bt) do { __builtin_amdgcn_s_setprio(1); _Pragma("unroll") for (int m = 0; m < 4; ++m) _Pragma("unroll") for (int n = 0; n < 2; ++n) \
        acc[ai][bj][m][n] = __builtin_amdgcn_mfma_scale_f32_16x16x128_f8f6f4(Bt[n], At[m], acc[ai][bj][m][n], 0, 0, 0, 0, 0, 0); __builtin_amdgcn_s_setprio(0); } while (0)
#define LDA_(b, h) do { if constexpr (FP8) PG8_LDA8(At8, b, h); else PG8_LDA(At, b, h); } while (0)
#define LDB0_(b, h) do { if constexpr (FP8) PG8_LDB8(B08, b, h); else PG8_LDB(B0, b, h); } while (0)
#define LDB1_(b, h) do { if constexpr (FP8) PG8_LDB8(B18, b, h); else PG8_LDB(B1, b, h); } while (0)
#define MMA0_(ai, bj) do { if constexpr (FP8) PG8_MMA8(ai, bj, At8, B08); else PG8_MMA(ai, bj, At, B0); } while (0)
#define MMA1_(ai, bj) do { if constexpr (FP8) PG8_MMA8(ai, bj, At8, B18); else PG8_MMA(ai, bj, At, B1); } while (0)
#define PG8_WAIT_V(n) asm volatile("s_waitcnt vmcnt(" #n ")" ::: "memory")
#define PG8_WAIT_L(n) asm volatile("s_waitcnt lgkmcnt(" #n ")" ::: "memory")
#define PG8_BAR __builtin_amdgcn_s_barrier()
#define PG8_SCHED __builtin_amdgcn_sched_barrier(0)
    Unit cur, nxt; int ui = 0;
    if (!S.next(0, cur)) return;
    f32x4 acc[2][2][4][2];
#pragma unroll
    for (int a = 0; a < 2; ++a)
#pragma unroll
        for (int b = 0; b < 2; ++b)
#pragma unroll
            for (int m = 0; m < 4; ++m)
#pragma unroll
                for (int n = 0; n < 2; ++n) acc[a][b][m][n] = (f32x4){0.f, 0.f, 0.f, 0.f};
    bf16x8 At[4][2], B0[2][2], B1[2][2]; v8i At8[4], B08[2], B18[2];
    const char* cA = S.a_base(cur); const char* cB = S.b_base(cur);
    S.a_ready(cur);
    constexpr bool GATHER = Sched::GATHER;
    unsigned vA[1][2];
    LAS unsigned* goff = (LAS unsigned*)(lds + STAGE_BYTES) + tid;
    int gslot = 0;
    constexpr bool LOFF = GATHER || FP8;
    if constexpr (!GATHER && FP8) { goff[8 * 512] = voffB[0]; goff[9 * 512] = voffB[1]; goff[10 * 512] = (unsigned)(Rr[0] * K + Cc[0]) * 2u; goff[11 * 512] = (unsigned)(Rr[1] * K + Cc[1]) * 2u; }
    if constexpr (GATHER) { unsigned t4[2][2]; S.a_voff(cur, Rr, Cc, t4); goff[0 * 512] = t4[0][0]; goff[1 * 512] = t4[0][1]; goff[2 * 512] = t4[1][0]; goff[3 * 512] = t4[1][1]; goff[8 * 512] = voffB[0]; goff[9 * 512] = voffB[1]; }
    else {
#pragma unroll
        for (int i = 0; i < 2; ++i) vA[0][i] = (unsigned)(Rr[i] * K + Cc[i]) * 2u; }
    const size_t ahstep = GATHER ? 0 : hstep;
#define PG8_STAGE_B(bufoff, kptr) do { if constexpr (LOFF) { unsigned _o[2]; _o[0] = goff[8 * 512]; _o[1] = goff[9 * 512]; PG8_STAGE(bufoff, kptr, _o); } else PG8_STAGE(bufoff, kptr, voffB); } while (0)
#define PG8_STAGE_A(bufoff, kptr, h, nx) do { if constexpr (GATHER) { unsigned _o[2]; const int _s = (gslot ^ (nx)) * 2048 + (h) * 1024; _o[0] = goff[_s]; _o[1] = goff[_s + 512]; PG8_STAGE(bufoff, kptr, _o); } \
        else if constexpr (FP8) { unsigned _o[2]; _o[0] = goff[10 * 512]; _o[1] = goff[11 * 512]; PG8_STAGE(bufoff, (kptr) + (h) * ahstep, _o); } \
        else PG8_STAGE(bufoff, (kptr) + (h) * ahstep, vA[0]); } while (0)
    PG8_STAGE(PG8_SB(0, 0), cB, voffB); PG8_STAGE(PG8_SB(0, 1), cB + hstep, voffB); PG8_STAGE_A(PG8_SA(0, 0), cA, 0, 0); PG8_STAGE_A(PG8_SA(0, 1), cA, 1, 0);
    if (wr == 1) PG8_BAR;
    PG8_WAIT_V(2); PG8_BAR;
    PG8_STAGE(PG8_SB(1, 0), cB + kstep, voffB); PG8_STAGE_A(PG8_SA(1, 0), cA + kstep, 0, 0); PG8_STAGE(PG8_SB(1, 1), cB + hstep + kstep, voffB);
    PG8_WAIT_V(6); PG8_BAR;
    for (;;) {
        const bool has_next = S.next(ui + 1, nxt);
        const char* nA = has_next ? S.a_base(nxt) : cA; const char* nB = has_next ? S.b_base(nxt) : cB;
        if constexpr (GATHER) { if (has_next) { unsigned t4[2][2]; int tl_ = tid; asm volatile("" : "+v"(tl_)); int R2[2], C2[2]; stage_rc(tl_ * 16, R2[0], C2[0]); stage_rc(tl_ * 16 + 8192, R2[1], C2[1]); S.a_voff(nxt, R2, C2, t4); const int o = (gslot ^ 1) * 2048; goff[o] = t4[0][0]; goff[o + 512] = t4[0][1]; goff[o + 1024] = t4[1][0]; goff[o + 1536] = t4[1][1]; } }
#pragma unroll 1
        for (int t = 0; t < nt; t += 2) {
            const bool last = (t == nt - 2);
            const char* a1 = cA + (size_t)(t + 1) * kstep;
            const char* a2 = last ? nA : cA + (size_t)(t + 2) * kstep; const char* b2 = last ? nB : cB + (size_t)(t + 2) * kstep;
            const char* a3 = a2 + kstep; const char* b3 = b2 + kstep;
            if (last && has_next) S.a_ready(nxt);
            const int nx = (last && has_next) ? 1 : 0;
            LDB0_(0, 0); LDB1_(0, 1); PG8_SCHED; LDA_(0, 0); PG8_STAGE_A(PG8_SA(1, 1), a1, 1, 0);
            PG8_WAIT_V(8); PG8_WAIT_L(0); PG8_BAR; MMA0_(0, 0); MMA1_(0, 1); PG8_BAR; PG8_SCHED;
            LDA_(0, 1); PG8_STAGE_B(PG8_SB(0, 0), b2); PG8_STAGE_B(PG8_SB(0, 1), b2 + hstep); PG8_STAGE_A(PG8_SA(0, 0), a2, 0, nx);
            PG8_WAIT_V(8); PG8_WAIT_L(0); PG8_BAR; MMA0_(1, 0); MMA1_(1, 1); PG8_BAR; PG8_SCHED;
            LDB0_(1, 0); LDB1_(1, 1); PG8_SCHED; LDA_(1, 0); PG8_STAGE_A(PG8_SA(0, 1), a2, 1, nx);
            PG8_WAIT_V(8); PG8_WAIT_L(0); PG8_BAR; MMA0_(0, 0); MMA1_(0, 1); PG8_BAR; PG8_SCHED;
            LDA_(1, 1); PG8_STAGE_B(PG8_SB(1, 0), b3); PG8_STAGE_B(PG8_SB(1, 1), b3 + hstep); PG8_STAGE_A(PG8_SA(1, 0), a3, 0, nx);
            PG8_WAIT_V(8); PG8_WAIT_L(0); PG8_BAR; MMA0_(1, 0); MMA1_(1, 1); PG8_BAR; PG8_SCHED;
        }
        if constexpr (ALIGN_EPI) { if (wr == 0) PG8_BAR; }
        { int fr2 = fr, fq2 = fq; asm volatile("" : "+v"(fr2), "+v"(fq2));
          E(acc, cur, wr, wc, fr2, fq2); } S.done(cur);
        if (!has_next) break;
#pragma unroll
        for (int a = 0; a < 2; ++a)
#pragma unroll
            for (int b = 0; b < 2; ++b)
#pragma unroll
                for (int m = 0; m < 4; ++m)
#pragma unroll
                    for (int n = 0; n < 2; ++n) acc[a][b][m][n] = (f32x4){0.f, 0.f, 0.f, 0.f};
        cur = nxt; cA = nA; cB = nB; ++ui;
        if constexpr (GATHER) gslot ^= 1;
        if constexpr (ALIGN_EPI) { if (wr == 1) PG8_BAR; }
    }
    PG8_WAIT_V(0);
    if constexpr (!ALIGN_EPI) { if (wr == 0) PG8_BAR; }
    PG8_BAR;
#undef PG8_SA
#undef PG8_SB
#undef PG8_STAGE
#undef PG8_STAGE_A
#undef PG8_STAGE_B
#undef PG8_LDA
#undef PG8_LDB
#undef PG8_MMA
#undef PG8_MMA8
#undef PG8_LDA8
#undef PG8_LDB8
#undef LDA_
#undef LDB0_
#undef LDB1_
#undef MMA0_
#undef MMA1_
#undef PG8_WAIT_V
#undef PG8_WAIT_L
#undef PG8_BAR
#undef PG8_SCHED
}

struct EpiProj {
    static constexpr bool PERM = true;
    bf16* O; float asc;
    __device__ __forceinline__ void operator()(const f32x4 (&acc)[2][2][4][2], const Unit& u, int wr, int wc, int fr, int fq) const {
        const int row0 = u.pm * BM + wr * 64 + fr, col0 = u.pn * BM + wc * 32 + 8 * fq;
        const bool act = u.pn < 4;
#pragma unroll
        for (int ai = 0; ai < 2; ++ai)
#pragma unroll
            for (int m = 0; m < 4; ++m) { bf16* rowp = O + (size_t)(row0 + ai * HALF + m * 16) * DIN + col0;
#pragma unroll
                for (int bj = 0; bj < 2; ++bj) { f32x4 v0 = acc[ai][bj][m][0] * asc, v1 = acc[ai][bj][m][1] * asc;
                    if (act) {
#pragma unroll
                        for (int j = 0; j < 4; ++j) { v0[j] = gelu_tanh(v0[j]); v1[j] = gelu_tanh(v1[j]); } }
                    u32x4 w; w.x = cvt_pk_bf16(v0[0], v0[1]); w.y = cvt_pk_bf16(v0[2], v0[3]); w.z = cvt_pk_bf16(v1[0], v1[1]); w.w = cvt_pk_bf16(v1[2], v1[3]);
                    *(u32x4*)(rowp + bj * HALF) = w; } }
    }
};
template <bool RES_BF16> struct EpiResid {
    static constexpr bool PERM = true; static constexpr float ASC = OP8(RES_BF16 ? 1 : 0) ? 1.f / WOUT_SCALE : 1.f;
    const void* res; bf16* out;
    __device__ __forceinline__ void operator()(const f32x4 (&acc)[2][2][4][2], const Unit& u, int wr, int wc, int fr, int fq) const {
        const int row0 = u.pm * BM + wr * 64 + fr, col0 = u.pn * BM + wc * 32 + 8 * fq;
#pragma unroll
        for (int ai = 0; ai < 2; ++ai) {
            if constexpr (RES_BF16) {
                u32x4 r[4][2];
#pragma unroll
                for (int m = 0; m < 4; ++m)
#pragma unroll
                    for (int bj = 0; bj < 2; ++bj) r[m][bj] = __builtin_nontemporal_load((const u32x4*)((const bf16*)res + (size_t)(row0 + ai * HALF + m * 16) * DM + col0 + bj * HALF));
                asm volatile("s_waitcnt vmcnt(0)" ::: "memory");
#pragma unroll
                for (int m = 0; m < 4; ++m)
#pragma unroll
                    for (int bj = 0; bj < 2; ++bj) { f32x4 v0 = acc[ai][bj][m][0] * ASC, v1 = acc[ai][bj][m][1] * ASC; const u32x4 q = r[m][bj];
                        v0[0] += bf_lo(q.x); v0[1] += bf_hi(q.x); v0[2] += bf_lo(q.y); v0[3] += bf_hi(q.y); v1[0] += bf_lo(q.z); v1[1] += bf_hi(q.z); v1[2] += bf_lo(q.w); v1[3] += bf_hi(q.w);
                        u32x4 w; w.x = cvt_pk_bf16(v0[0], v0[1]); w.y = cvt_pk_bf16(v0[2], v0[3]); w.z = cvt_pk_bf16(v1[0], v1[1]); w.w = cvt_pk_bf16(v1[2], v1[3]);
                        *(u32x4*)(out + (size_t)(row0 + ai * HALF + m * 16) * DM + col0 + bj * HALF) = w; }
            } else {
#pragma unroll
                for (int mh = 0; mh < 2; ++mh) {
                    f32x4 r[2][2][2];
#pragma unroll
                    for (int m = 0; m < 2; ++m)
#pragma unroll
                        for (int bj = 0; bj < 2; ++bj) { const float* rp = (const float*)res + (size_t)(row0 + ai * HALF + (2 * mh + m) * 16) * DM + col0 + bj * HALF; r[m][bj][0] = __builtin_nontemporal_load((const f32x4*)rp); r[m][bj][1] = __builtin_nontemporal_load((const f32x4*)(rp + 4)); }
                    asm volatile("s_waitcnt vmcnt(0)" ::: "memory");
#pragma unroll
                    for (int m = 0; m < 2; ++m)
#pragma unroll
                        for (int bj = 0; bj < 2; ++bj) { const f32x4 v0 = acc[ai][bj][2 * mh + m][0] * ASC + r[m][bj][0], v1 = acc[ai][bj][2 * mh + m][1] * ASC + r[m][bj][1];
                            u32x4 w; w.x = cvt_pk_bf16(v0[0], v0[1]); w.y = cvt_pk_bf16(v0[2], v0[3]); w.z = cvt_pk_bf16(v1[0], v1[1]); w.w = cvt_pk_bf16(v1[2], v1[3]);
                            *(u32x4*)(out + (size_t)(row0 + ai * HALF + (2 * mh + m) * 16) * DM + col0 + bj * HALF) = w; }
                }
            }
        }
    }
};
struct EpiSwiGLU {
    static constexpr bool PERM = true;
    unsigned char* HB; const float* rslot;
    __device__ __forceinline__ void operator()(const f32x4 (&acc)[2][2][4][2], const Unit& u, int wr, int wc, int fr, int fq) const {
        const int row0 = u.pm * BM + wr * 64 + fr, col0 = u.pn * HALF + wc * 32 + 8 * fq;
        const __amdgpu_buffer_rsrc_t rsrc = __builtin_amdgcn_make_buffer_rsrc((void*)HB, 0, 40960 * DE, 0x00020000);
        const float* rsl = rslot + (size_t)u.e * TOKCAP + u.rb * BM + wr * 64 + fr;
#pragma unroll
        for (int ai = 0; ai < 2; ++ai) {
            float rsv[4];
#pragma unroll
            for (int m = 0; m < 4; ++m) rsv[m] = rsl[ai * HALF + m * 16];
            asm volatile("s_waitcnt vmcnt(0)" ::: "memory");
#pragma unroll
            for (int m = 0; m < 4; ++m) { const unsigned boff = (unsigned)((row0 + ai * HALF + m * 16) * DE + col0);
                const float rs = rsv[m] * (1.f / W1_SCALE);
                float h[8];
#pragma unroll
                for (int n = 0; n < 2; ++n)
#pragma unroll
                    for (int j = 0; j < 4; ++j) { const float g = acc[ai][0][m][n][j] * rs, up = acc[ai][1][m][n][j] * rs; h[n * 4 + j] = g * sigmoidf_(g) * up; }
                u32x2 w; w.x = pk4_fp8(h[0], h[1], h[2], h[3]); w.y = pk4_fp8(h[4], h[5], h[6], h[7]);
                __builtin_amdgcn_raw_buffer_store_b64(w, rsrc, boff, 0, 16); } }
    }
};
struct EpiY {
    static constexpr bool PERM = true;
    unsigned char* Y;
    __device__ __forceinline__ void operator()(const f32x4 (&acc)[2][2][4][2], const Unit& u, int wr, int wc, int fr, int fq) const {
        const int row0 = u.pm * BM + wr * 64 + fr, col0 = u.pn * BM + wc * 32 + 8 * fq;
#pragma unroll
        for (int ai = 0; ai < 2; ++ai)
#pragma unroll
            for (int m = 0; m < 4; ++m) { unsigned char* rowp = Y + (size_t)(row0 + ai * HALF + m * 16) * DM + col0;
#pragma unroll
                for (int bj = 0; bj < 2; ++bj) { const f32x4 v0 = acc[ai][bj][m][0] * (Y_SCALE / W2_SCALE), v1 = acc[ai][bj][m][1] * (Y_SCALE / W2_SCALE);
                    u32x2 w; w.x = pk4_fp8(v0[0], v0[1], v0[2], v0[3]); w.y = pk4_fp8(v1[0], v1[1], v1[2], v1[3]);
                    *(u32x2*)(rowp + bj * HALF) = w; } }
    }
};

struct SchedG1 {
    static constexpr bool GATHER = true;
    const LAS int* tstart; const int* cnt; const int* tok; const bf16* X; const bf16* W1; int G, c; unsigned* ready;
    __device__ __forceinline__ void a_ready(const Unit&) const {}
    __device__ __forceinline__ void done(const Unit& u) const {
        asm volatile("s_waitcnt vmcnt(0)" ::: "memory");
        if (lane_now() == 0) __hip_atomic_fetch_add(ready + 64 * u.pm, 1u, __ATOMIC_RELAXED, __HIP_MEMORY_SCOPE_AGENT);
    }
    __device__ __forceinline__ bool next(int i, Unit& u) const {
        const int L = i * G + c, NT = __builtin_amdgcn_readfirstlane(tstart[NE]); if (L >= NT * 4) return false;
        const int T = L >> 2; const int e = tstart[560 + T];
        u.pm = __builtin_amdgcn_readfirstlane(T); u.pn = L & 3; u.e = __builtin_amdgcn_readfirstlane(e); u.rb = __builtin_amdgcn_readfirstlane(T - tstart[e]); return true;
    }
    static constexpr int KU = DM / 2;
    __device__ __forceinline__ const char* a_base(const Unit&) const { return (const char*)X; }
    __device__ __forceinline__ const char* b_base(const Unit& u) const { return (const char*)W1 + ((size_t)u.e * 1024 + (size_t)u.pn * BM) * DM; }
    __device__ __forceinline__ void a_voff(const Unit& u, const int (&R)[2], const int (&C)[2], unsigned (&v)[2][2]) const {
        const int n = cnt[u.e * 64]; const int* tl = tok + (size_t)u.e * TOKCAP;
#pragma unroll
        for (int h = 0; h < 2; ++h)
#pragma unroll
            for (int i = 0; i < 2; ++i) { int row = u.rb * BM + h * HALF + R[i]; row = row < n ? row : 0; const int t = tl[row]; v[h][i] = (unsigned)(t * KU + C[i]) * 2u; }
    }
};
struct SchedG2 {
    static constexpr bool GATHER = false;
    const LAS int* tstart; const bf16* HB; const bf16* W2; int G, c; unsigned* ready; unsigned* tmo; int wave;
    __device__ __forceinline__ bool next(int i, Unit& u) const {
        constexpr int K0 = 3;
        const int NT = __builtin_amdgcn_readfirstlane(tstart[NE]), n1 = 4 * NT, n1max = (n1 + G - 1) / G, R = n1 - G * (n1max - 1), nB = G - R;
        int L;
        if (c >= R) L = (i < K0) ? i * nB + (c - R) : K0 * nB + (i - K0) * G + c;
        else L = K0 * nB + i * G + c;
        if (L >= NT * 8) return false;
        const int T = L >> 3; const int e = tstart[560 + T];
        u.pm = __builtin_amdgcn_readfirstlane(T); u.pn = __builtin_amdgcn_readfirstlane(L & 7); u.e = __builtin_amdgcn_readfirstlane(e); u.rb = __builtin_amdgcn_readfirstlane(T - tstart[e]); return true;
    }
    __device__ __forceinline__ void done(const Unit&) const {}
    __device__ __forceinline__ void a_ready(const Unit& u) const {
        if (wave == 0) {
            unsigned polls = 0;
            while ((unsigned)__builtin_amdgcn_readfirstlane(__hip_atomic_load(ready + 64 * u.pm, __ATOMIC_RELAXED, __HIP_MEMORY_SCOPE_AGENT)) < 32u) {
                if (++polls > (1u << 22)) { if (lane_now() == 0) __hip_atomic_store(tmo, 0x600u | (unsigned)(u.pm & 0xff), __ATOMIC_RELAXED, __HIP_MEMORY_SCOPE_AGENT); break; }
                __builtin_amdgcn_s_sleep(2); }
            __builtin_amdgcn_fence(__ATOMIC_ACQUIRE, "agent");
            asm volatile("s_waitcnt vmcnt(0)" ::: "memory");
        }
        asm volatile("" ::: "memory"); __builtin_amdgcn_s_barrier(); asm volatile("" ::: "memory");
    }
    __device__ __forceinline__ const char* a_base(const Unit& u) const { return (const char*)HB + (size_t)u.pm * BM * DE; }
    __device__ __forceinline__ const char* b_base(const Unit& u) const { return (const char*)W2 + ((size_t)u.e * DM + (size_t)u.pn * BM) * DE; }
    __device__ __forceinline__ void a_voff(const Unit&, const int (&R)[2], const int (&C)[2], unsigned (&v)[2][2]) const {
#pragma unroll
        for (int h = 0; h < 2; ++h)
#pragma unroll
            for (int i = 0; i < 2; ++i) v[h][i] = (unsigned)((h * HALF + R[i]) * DE + C[i]) * 2u;
    }
};
}

struct Params { const float* in[22]; float* out; unsigned char* ws; int ph_lo, ph_hi; };
enum { IN_X = 0, IN_NORM1, IN_WIN, IN_SGUN, IN_SGUW, IN_SGUB, IN_CONVW, IN_CONVB, IN_LNG, IN_LNB, IN_QN, IN_KN, IN_OUTN, IN_WOUT, IN_NORM2, IN_WRG, IN_BRG, IN_WRE, IN_BRE, IN_WG, IN_WU, IN_WD };

struct Frame {
    LAS unsigned char* lds; volatile LAS unsigned* MISC;
    int tid, lane, wave, vcu, G;
    const float* const* in; float* out; unsigned char* ws;
};

__device__ __forceinline__ void tile_desc(const float* const* in, unsigned char* ws, int it, const float*& src, int& ldw, unsigned char*& dst, int& pitch, const float*& ksc, float& wsc, int& fp8) {
    constexpr int T_IN = 32 * 80, T_OUT = 32 * 32, T_E = 32 * 8, T_D = 8 * 32;
    constexpr int T_LAYER = T_IN + T_OUT + NE * (2 * T_E + T_D);
    const int l = it / T_LAYER; int r = it % T_LAYER; ksc = nullptr; wsc = 1.f; fp8 = 0;
    if (r < T_IN) { ldw = DIN;
        if (IP8(l)) { const int kb = r / 160, nb = r % 160; pitch = DM; fp8 = 1; wsc = WIN_SCALE; src = in[IN_WIN] + (size_t)l * DM * DIN + (size_t)(128 * kb) * DIN + 32 * nb; dst = ws + WS_WIN + (size_t)l * DIN * DM * 2 + ((size_t)32 * nb) * DM + 128 * kb; }
        else { const int kb = r / 80, nb = r % 80; pitch = DM * 2; src = in[IN_WIN] + (size_t)l * DM * DIN + (size_t)(64 * kb) * DIN + 64 * nb; dst = ws + WS_WIN + (((size_t)l * DIN + 64 * nb) * DM + 64 * kb) * 2; }
        return; } r -= T_IN;
    if (r < T_OUT) { const int kb = r / 32, nb = r % 32; ldw = DM; src = in[IN_WOUT] + (size_t)l * DM * DM + (size_t)(64 * kb) * DM + 64 * nb;
        if (OP8(l)) { const int kb8 = r / 64, nb8 = r % 64; pitch = DM; fp8 = 1; wsc = WOUT_SCALE; src = in[IN_WOUT] + (size_t)l * DM * DM + (size_t)(128 * kb8) * DM + 32 * nb8; dst = ws + WS_WOUT + (size_t)l * DM * DM * 2 + ((size_t)32 * nb8) * DM + 128 * kb8; } else { pitch = DM * 2; dst = ws + WS_WOUT + (((size_t)l * DM + 64 * nb) * DM + 64 * kb) * 2; }
        return; } r -= T_OUT;
    const int e = r / (2 * T_E + T_D); r %= (2 * T_E + T_D);
    const size_t le = (size_t)l * NE + e; fp8 = 1;
    if (r < 2 * T_E) { const int up = r >= T_E; r -= up * T_E; const int kb = r / 16, nb = r % 16, n0 = 32 * nb; ldw = DE; pitch = DM; wsc = W1_SCALE;
        src = (up ? in[IN_WU] : in[IN_WG]) + le * DM * DE + (size_t)(128 * kb) * DE + n0; dst = ws + WS_W1 + (le * 1024 + (size_t)((n0 / 128) * 256 + up * 128 + (n0 % 128))) * DM + 128 * kb; ksc = in[IN_NORM2] + (size_t)l * DM + 128 * kb; return; }
    r -= 2 * T_E;
    { const int kb = r / 64, nb = r % 64; ldw = DM; pitch = DE; wsc = W2_SCALE; src = in[IN_WD] + le * DE * DM + (size_t)(128 * kb) * DM + 32 * nb; dst = ws + WS_W2 + (le * DM + 32 * nb) * DE + 128 * kb; }
}
#define TR_LOAD(V, src, ldw, fp8) do { if (fp8) { _Pragma("unroll") for (int i = 0; i < 16; ++i) V[i] = __builtin_nontemporal_load((const f32x4*)((src) + (size_t)(8 * i + (lane >> 3)) * (ldw) + 4 * (lane & 7))); } \
    else { _Pragma("unroll") for (int i = 0; i < 16; ++i) V[i] = __builtin_nontemporal_load((const f32x4*)((src) + (size_t)(4 * i + (lane >> 4)) * (ldw) + 4 * (lane & 15))); } } while (0)
#define TR_PROC(V, dst, pitch, ksc, wsc, fp8) do { \
    if (fp8) {        \
        _Pragma("unroll") for (int i = 0; i < 16; ++i) { const int kk = 8 * i + (lane >> 3); f32x4 v = V[i] * ((ksc) ? (ksc)[kk] * (wsc) : (wsc)); \
            LAS float* d = scr + kk * 33 + 4 * (lane & 7); d[0] = v[0]; d[1] = v[1]; d[2] = v[2]; d[3] = v[3]; } \
        LDS_WAIT(); \
        _Pragma("unroll") for (int j = 0; j < 8; ++j) { const int n = (lane >> 4) + 4 * j; const LAS float* sp = scr + (8 * (lane & 15)) * 33 + n; \
            u32x2 o; o.x = pk4_fp8(sp[0], sp[33], sp[2 * 33], sp[3 * 33]); o.y = pk4_fp8(sp[4 * 33], sp[5 * 33], sp[6 * 33], sp[7 * 33]); __builtin_nontemporal_store(o, (u32x2*)((dst) + (size_t)n * (pitch) + 8 * (lane & 15))); }     \
    } else { \
        _Pragma("unroll") for (int i = 0; i < 16; ++i) { const int kk = 4 * i + (lane >> 4); f32x4 v = V[i] * ((ksc) ? (ksc)[kk] * (wsc) : (wsc)); \
            LAS float* d = scr + kk * 65 + 4 * (lane & 15); d[0] = v[0]; d[1] = v[1]; d[2] = v[2]; d[3] = v[3]; } \
        LDS_WAIT(); \
        _Pragma("unroll") for (int j = 0; j < 8; ++j) { const int n = (lane >> 3) + 8 * j; const LAS float* sp = scr + (8 * (lane & 7)) * 65 + n; \
            u32x4 o; o.x = cvt_pk_bf16(sp[0], sp[65]); o.y = cvt_pk_bf16(sp[2 * 65], sp[3 * 65]); o.z = cvt_pk_bf16(sp[4 * 65], sp[5 * 65]); o.w = cvt_pk_bf16(sp[6 * 65], sp[7 * 65]); \
            *(u32x4*)((dst) + (size_t)n * (pitch) + 16 * (lane & 7)) = o; } } \
    LDS_WAIT(); } while (0)
__device__ __forceinline__ void norm_row_bf16(const float* xrow, const float* g, bf16* orow, int lane) {
    f32x4 v[8]; float s = 0.f;
#pragma unroll
    for (int j = 0; j < 8; ++j) { v[j] = __builtin_nontemporal_load((const f32x4*)(xrow + 4 * lane + 256 * j)); s += (v[j][0] * v[j][0] + v[j][1] * v[j][1]) + (v[j][2] * v[j][2] + v[j][3] * v[j][3]); }
    const float rs = __builtin_amdgcn_rsqf(wave_sum(s) * (1.f / DM) + EPS);
#pragma unroll
    for (int j = 0; j < 8; ++j) { const f32x4 gg = *(const f32x4*)(g + 4 * lane + 256 * j);
        u32x2 o; o.x = cvt_pk_bf16(v[j][0] * rs * gg[0], v[j][1] * rs * gg[1]); o.y = cvt_pk_bf16(v[j][2] * rs * gg[2], v[j][3] * rs * gg[3]);
        *(u32x2*)(orow + 4 * lane + 256 * j) = o; }
}
__device__ __forceinline__ void p_prologue(Frame& F) {
    LAS float* scr = (LAS float*)(F.lds + F.wave * 16896);
    const int gw = F.vcu * NWAVES + F.wave, NGW = F.G * NWAVES, lane = F.lane;
    constexpr int T_TOTAL = NLAYER * (32 * 80 + 32 * 32 + NE * (2 * 32 * 8 + 8 * 32));
    {
        f32x4 va[16], vb[16];
        const float* srcA; const float* srcB; unsigned char* dstA; unsigned char* dstB; const float* kA; const float* kB; int ldA, ldB, pA, pB, fA, fB; float wA, wB;
        int it = gw;
        if (it < T_TOTAL) { tile_desc(F.in, F.ws, it, srcA, ldA, dstA, pA, kA, wA, fA); TR_LOAD(va, srcA, ldA, fA); }
        while (it < T_TOTAL) {
            const int itb = it + NGW;
            if (itb < T_TOTAL) { tile_desc(F.in, F.ws, itb, srcB, ldB, dstB, pB, kB, wB, fB); TR_LOAD(vb, srcB, ldB, fB); }
            TR_PROC(va, dstA, pA, kA, wA, fA);
            if (itb >= T_TOTAL) break;
            const int ita = itb + NGW;
            if (ita < T_TOTAL) { tile_desc(F.in, F.ws, ita, srcA, ldA, dstA, pA, kA, wA, fA); TR_LOAD(va, srcA, ldA, fA); }
            TR_PROC(vb, dstB, pB, kB, wB, fB);
            it = ita;
        }
    }
    { bf16* SW = (bf16*)(F.ws + WS_SGUW); const int gt = gw * 64 + F.lane, NGT = NGW * 64;
      for (int idx = gt; idx < NLAYER * 4 * 8 * 4 * 64; idx += NGT) {
          const int ln = idx & 63, pp = (idx >> 6) & 3, itile = (idx >> 8) & 7, h = (idx >> 11) & 3, l = idx >> 13;
          const int i = 16 * itile + (ln & 15), gq = ln >> 4;
          const float* w = F.in[IN_SGUW] + ((size_t)(l * 4 + h) * 128 + i) * 128;
          float v[8];
#pragma unroll
          for (int jj = 0; jj < 8; ++jj) { const int j = 32 * pp + (jj < 4 ? 4 * gq + jj : 16 + 4 * gq + (jj - 4)); v[jj] = (j <= i) ? w[j] : 0.f; }
          u32x4 o; o.x = cvt_pk_bf16(v[0], v[1]); o.y = cvt_pk_bf16(v[2], v[3]); o.z = cvt_pk_bf16(v[4], v[5]); o.w = cvt_pk_bf16(v[6], v[7]);
          *(u32x4*)(SW + (size_t)idx * 8) = o; }
      bf16* WRF = (bf16*)(F.ws + WS_WRT);
      for (int idx = gt; idx < NLAYER * 64 * 3 * 64; idx += NGT) { const int ln = idx & 63, ct = (idx >> 6) % 3, ks = (idx / 192) & 63, l = idx / (192 * 64);
          const int o = 16 * ct + (ln & 15), k0 = 32 * ks + 8 * (ln >> 4);
          float v[8];
#pragma unroll
          for (int j = 0; j < 8; ++j) { const int k = k0 + j; const float wv = o < 32 ? F.in[IN_WRE][((size_t)l * DM + k) * NE + o] : (o < 36 ? F.in[IN_WRG][((size_t)l * DM + k) * 4 + (o - 32)] : 0.f);
              v[j] = wv * F.in[IN_NORM2][(size_t)l * DM + k]; }
          u32x4 hi, lo; hi.x = cvt_pk_bf16(v[0], v[1]); hi.y = cvt_pk_bf16(v[2], v[3]); hi.z = cvt_pk_bf16(v[4], v[5]); hi.w = cvt_pk_bf16(v[6], v[7]);
          lo.x = cvt_pk_bf16(v[0] - bf_lo(hi.x), v[1] - bf_hi(hi.x)); lo.y = cvt_pk_bf16(v[2] - bf_lo(hi.y), v[3] - bf_hi(hi.y));
          lo.z = cvt_pk_bf16(v[4] - bf_lo(hi.z), v[5] - bf_hi(hi.z)); lo.w = cvt_pk_bf16(v[6] - bf_lo(hi.w), v[7] - bf_hi(hi.w));
          bf16* dst = WRF + ((((size_t)l * 64 + ks) * 3 + ct) * 2 * 64 + ln) * 8;
          *(u32x4*)dst = hi; *(u32x4*)(dst + 512) = lo; } }
    bf16* HN = (bf16*)(F.ws + WS_HN);
    for (int m = gw; m < SEQ; m += NGW) norm_row_bf16(F.in[IN_X] + (size_t)m * DM, F.in[IN_NORM1], HN + (size_t)m * DM, F.lane);
}

__device__ __forceinline__ int vimg_off(int row, int c) { return row * 256 + ((((c >> 1) ^ (row & 7)) << 1) | (c & 1)) * 16; }
__device__ __forceinline__ bf16x8 tr_frag(const LAS unsigned char* img, int ra, int rb, int dt, int lane) {
    const int gq = lane >> 4, q = (lane & 15) >> 2, p = lane & 3;
    const int r0 = ra + 4 * gq + q, r1 = rb + 4 * gq + q, c = 2 * dt + (p >> 1);
    const s16x4 a = __builtin_amdgcn_ds_read_tr16_b64_v4i16((LAS s16x4*)(img + vimg_off(r0, c) + 8 * (p & 1)));
    const s16x4 b = __builtin_amdgcn_ds_read_tr16_b64_v4i16((LAS s16x4*)(img + vimg_off(r1, c) + 8 * (p & 1)));
    bf16x8 r; r[0] = a[0]; r[1] = a[1]; r[2] = a[2]; r[3] = a[3]; r[4] = b[0]; r[5] = b[1]; r[6] = b[2]; r[7] = b[3]; return r;
}
__device__ __forceinline__ void sgu_stage8(const bf16* vsrc, int j0, int w, int lane, const f32x4& g0, const f32x4& g1, LAS unsigned char* lds) {
    u32x4 raw[8];
#pragma unroll
    for (int j = 0; j < 8; ++j) raw[j] = *(const u32x4*)(vsrc + (size_t)(w + 8 * (j0 + j)) * DIN);
#pragma unroll
    for (int j = 0; j < 8; ++j) { const int row = w + 8 * (j0 + j);
        float x[8] = {bf_lo(raw[j].x), bf_hi(raw[j].x), bf_lo(raw[j].y), bf_hi(raw[j].y), bf_lo(raw[j].z), bf_hi(raw[j].z), bf_lo(raw[j].w), bf_hi(raw[j].w)};
        float s = 0.f;
#pragma unroll
        for (int e = 0; e < 8; ++e) s += x[e] * x[e];
        const float rs = __builtin_amdgcn_rsqf(wave_sum(s) * (1.f / 512.f) + EPS);
        u32x4 o; o.x = cvt_pk_bf16(x[0] * rs * g0[0], x[1] * rs * g0[1]); o.y = cvt_pk_bf16(x[2] * rs * g0[2], x[3] * rs * g0[3]);
        o.z = cvt_pk_bf16(x[4] * rs * g1[0], x[5] * rs * g1[1]); o.w = cvt_pk_bf16(x[6] * rs * g1[2], x[7] * rs * g1[3]);
        *(LAS u32x4*)(lds + (lane >> 4) * 32768 + vimg_off(row, lane & 15)) = o; }
}
__device__ __forceinline__ void sgu_item(Frame& F, int l, int chunk, int half) {
    const bf16* PROJ = (const bf16*)(F.ws + WS_PROJ); bf16* MIX = (bf16*)(F.ws + WS_MIX);
    const int p0 = chunk * 128, lane = F.lane, w = F.wave;
    LAS float* red = (LAS float*)(F.lds + MISC_OFF + 256);
    const float* gn = F.in[IN_SGUN] + l * 512;
    const f32x4 g0 = *(const f32x4*)(gn + 8 * lane), g1 = *(const f32x4*)(gn + 8 * lane + 4);
    const bf16* vsrc = PROJ + (size_t)p0 * DIN + OFF_V + 8 * lane;
    sgu_stage8(vsrc, 0, w, lane, g0, g1, F.lds);
    if (half) sgu_stage8(vsrc, 8, w, lane, g0, g1, F.lds);
    const int h = w >> 1, ih = w & 1, gq = lane >> 4, fr = lane & 15;
    const LAS unsigned char* img = F.lds + h * 32768;
    const bf16* SW = (const bf16*)(F.ws + WS_SGUW) + (size_t)(l * 4 + h) * 8 * 4 * 64 * 8;
    const float* bs = F.in[IN_SGUB] + (size_t)(l * 4 + h) * 128;
    const float* og = F.in[IN_OUTN] + (size_t)l * DM + h * 128 + 4 * gq;
    const int it0 = ih + 4 * half;
    u32x2 ur[2][8];
#pragma unroll
    for (int ii = 0; ii < 2; ++ii) { const bf16* urow = PROJ + (size_t)(p0 + 16 * (it0 + 2 * ii) + fr) * DIN + OFF_U + h * 128 + 4 * gq;
#pragma unroll
        for (int dt = 0; dt < 8; ++dt) ur[ii][dt] = *(const u32x2*)(urow + 16 * dt); }
    __syncthreads();
    f32x4 z[2][8];
#pragma unroll
    for (int ii = 0; ii < 2; ++ii)
#pragma unroll
        for (int dt = 0; dt < 8; ++dt) z[ii][dt] = (f32x4){0.f, 0.f, 0.f, 0.f};
#pragma unroll 1
    for (int pp = 0; pp <= (it0 + 2) / 2; ++pp) {
        const bf16x8 bw0 = *(const bf16x8*)(SW + ((size_t)(it0 * 4 + pp) * 64 + lane) * 8);
        const bf16x8 bw1 = *(const bf16x8*)(SW + ((size_t)((it0 + 2) * 4 + pp) * 64 + lane) * 8);
        const bool do0 = pp <= it0 / 2;
#pragma unroll
        for (int dt = 0; dt < 8; ++dt) { const bf16x8 a = tr_frag(img, 32 * pp, 32 * pp + 16, dt, lane);
            if (do0) z[0][dt] = __builtin_amdgcn_mfma_f32_16x16x32_bf16(a, bw0, z[0][dt], 0, 0, 0);
            z[1][dt] = __builtin_amdgcn_mfma_f32_16x16x32_bf16(a, bw1, z[1][dt], 0, 0, 0); }
    }
#pragma unroll
    for (int ii = 0; ii < 2; ++ii) { const int i = 16 * (it0 + 2 * ii) + fr; const float bi = bs[i]; float s = 0.f;
#pragma unroll
        for (int dt = 0; dt < 8; ++dt) { const u32x2 u2 = ur[ii][dt];
            f32x4 y; y[0] = bf_lo(u2.x) * (z[ii][dt][0] + bi); y[1] = bf_hi(u2.x) * (z[ii][dt][1] + bi); y[2] = bf_lo(u2.y) * (z[ii][dt][2] + bi); y[3] = bf_hi(u2.y) * (z[ii][dt][3] + bi);
            z[ii][dt] = y; s += (y[0] * y[0] + y[1] * y[1]) + (y[2] * y[2] + y[3] * y[3]); }
        s += __shfl_xor(s, 16); s += __shfl_xor(s, 32);
        if (gq == 0) red[i * 4 + h] = s; }
    __syncthreads();
#pragma unroll
    for (int ii = 0; ii < 2; ++ii) { const int i = 16 * (it0 + 2 * ii) + fr;
        const f32x4 rr = *(const LAS f32x4*)(red + i * 4);
        const float rs = __builtin_amdgcn_rsqf(((rr[0] + rr[1]) + (rr[2] + rr[3])) * (1.f / 512.f) + EPS);
        bf16* orow = MIX + (size_t)(p0 + i) * DM + h * 128 + 4 * gq;
#pragma unroll
        for (int dt = 0; dt < 8; ++dt) { const f32x4 gg = *(const f32x4*)(og + 16 * dt); const f32x4 y = z[ii][dt];
            if (OP8(l)) *(unsigned*)((unsigned char*)MIX + (size_t)(p0 + i) * DM + h * 128 + 4 * gq + 16 * dt) = pk4_fp8(y[0] * rs * gg[0], y[1] * rs * gg[1], y[2] * rs * gg[2], y[3] * rs * gg[3]);
            else { u32x2 o; o.x = cvt_pk_bf16(y[0] * rs * gg[0], y[1] * rs * gg[1]); o.y = cvt_pk_bf16(y[2] * rs * gg[2], y[3] * rs * gg[3]);
            *(u32x2*)(orow + 16 * dt) = o; } } }
    __syncthreads();
}

__device__ __forceinline__ void conv_item(Frame& F, int l, int tile) {
    const bf16* PROJ = (const bf16*)(F.ws + WS_PROJ); bf16* MIX = (bf16*)(F.ws + WS_MIX);
    constexpr int TP = 32, NR = TP + 30;
    const int p0 = tile * TP, c = F.tid, tid = F.tid;
    LAS float* cbuf = (LAS float*)F.lds;
    LAS bf16* zbuf = (LAS bf16*)(F.lds + 65536);
    { u32x4 av[8], gv[8];
#pragma unroll
      for (int i = 0; i < 8; ++i) { const int id = tid + NTHREADS * i, row = id >> 6, ch = (id & 63) * 8; int p = p0 - 30 + row; p = p < 0 ? 0 : p; p = row < NR ? p : 0;
          av[i] = *(const u32x4*)(PROJ + (size_t)p * DIN + OFF_A + ch); gv[i] = *(const u32x4*)(PROJ + (size_t)p * DIN + OFF_G + ch); }
#pragma unroll
      for (int i = 0; i < 8; ++i) { const int id = tid + NTHREADS * i, row = id >> 6, ch = (id & 63) * 8; const bool live = (p0 - 30 + row) >= 0;
          const unsigned au[4] = {av[i].x, av[i].y, av[i].z, av[i].w}, gu[4] = {gv[i].x, gv[i].y, gv[i].z, gv[i].w}; u32x4 o; unsigned ou[4];
#pragma unroll
          for (int e = 0; e < 4; ++e) { const float z0 = bf_lo(au[e]) * sigmoidf_(bf_lo(gu[e])), z1 = bf_hi(au[e]) * sigmoidf_(bf_hi(gu[e])); ou[e] = live ? cvt_pk_bf16(z0, z1) : 0u; }
          o.x = ou[0]; o.y = ou[1]; o.z = ou[2]; o.w = ou[3];
          if (row < NR) *(LAS u32x4*)(zbuf + row * 512 + ch) = o; } }
    float wk[CONV_K];
#pragma unroll
    for (int k = 0; k < CONV_K; ++k) wk[k] = F.in[IN_CONVW][((size_t)l * CONV_K + k) * 512 + c];
    const float cb = F.in[IN_CONVB][l * 512 + c];
    __syncthreads();
#define CONV_Z(r) __builtin_bit_cast(float, (unsigned)zbuf[(r) * 512 + c] << 16)
    float win[30];
#pragma unroll
    for (int r = 0; r < 30; ++r) win[r] = CONV_Z(r);
#pragma unroll
    for (int q = 0; q < TP; ++q) { const float zv = CONV_Z(30 + q); float acc = cb + wk[30] * zv;
#pragma unroll
        for (int k = 0; k < 30; ++k) acc += wk[k] * win[(k + q) % 30];
        win[q % 30] = zv; cbuf[q * 512 + c] = acc; }
#undef CONV_Z
    __syncthreads();
    const float* lg = F.in[IN_LNG] + l * 512 + 8 * F.lane; const float* lb = F.in[IN_LNB] + l * 512 + 8 * F.lane; const float* og = F.in[IN_OUTN] + (size_t)l * DM + 512 + 8 * F.lane;
    const f32x4 lg0 = *(const f32x4*)lg, lg1 = *(const f32x4*)(lg + 4), lb0 = *(const f32x4*)lb, lb1 = *(const f32x4*)(lb + 4), og0 = *(const f32x4*)og, og1 = *(const f32x4*)(og + 4);
    for (int r = F.wave; r < TP; r += NWAVES) {
        const f32x4 a0 = *(const LAS f32x4*)(cbuf + r * 512 + 8 * F.lane), a1 = *(const LAS f32x4*)(cbuf + r * 512 + 8 * F.lane + 4);
        float x[8] = {a0[0], a0[1], a0[2], a0[3], a1[0], a1[1], a1[2], a1[3]};
        float s = 0.f;
#pragma unroll
        for (int e = 0; e < 8; ++e) s += x[e];
        const float mu = wave_sum(s) * (1.f / 512.f); float q2 = 0.f;
#pragma unroll
        for (int e = 0; e < 8; ++e) { x[e] -= mu; q2 += x[e] * x[e]; }
        const float rstd = __builtin_amdgcn_rsqf(wave_sum(q2) * (1.f / 512.f) + EPS);
        const float gam[8] = {lg0[0], lg0[1], lg0[2], lg0[3], lg1[0], lg1[1], lg1[2], lg1[3]}, bet[8] = {lb0[0], lb0[1], lb0[2], lb0[3], lb1[0], lb1[1], lb1[2], lb1[3]};
        float s2 = 0.f;
#pragma unroll
        for (int e = 0; e < 8; ++e) { const float y = x[e] * rstd * gam[e] + bet[e]; x[e] = y * sigmoidf_(y); s2 += x[e] * x[e]; }
        const float rs = __builtin_amdgcn_rsqf(wave_sum(s2) * (1.f / 512.f) + EPS);
        if (OP8(l)) { u32x2 o8; o8.x = pk4_fp8(x[0] * rs * og0[0], x[1] * rs * og0[1], x[2] * rs * og0[2], x[3] * rs * og0[3]); o8.y = pk4_fp8(x[4] * rs * og1[0], x[5] * rs * og1[1], x[6] * rs * og1[2], x[7] * rs * og1[3]);
            *(u32x2*)((unsigned char*)MIX + (size_t)(p0 + r) * DM + 512 + 8 * F.lane) = o8; }
        else {
        u32x4 o; o.x = cvt_pk_bf16(x[0] * rs * og0[0], x[1] * rs * og0[1]); o.y = cvt_pk_bf16(x[2] * rs * og0[2], x[3] * rs * og0[3]);
        o.z = cvt_pk_bf16(x[4] * rs * og1[0], x[5] * rs * og1[1]); o.w = cvt_pk_bf16(x[6] * rs * og1[2], x[7] * rs * og1[3]);
        *(u32x4*)(MIX + (size_t)(p0 + r) * DM + 512 + 8 * F.lane) = o; }
    }
    __syncthreads();
}

__device__ __forceinline__ int kimg_off(int row, int c) { return row * 256 + ((c ^ (row & 15)) << 4); }
__device__ __forceinline__ bf16x8 tr_frag2(const LAS unsigned char* vs, int ta, int tb, int dt, int lane) {
    const int gq = lane >> 4, q = (lane & 15) >> 2, p = lane & 3, c = 2 * dt + (p >> 1), rr = 4 * gq + q;
    const int off = rr * 256 + ((((c >> 1) ^ (rr & 7)) << 1) | (c & 1)) * 16 + 8 * (p & 1);
    const s16x4 a = __builtin_amdgcn_ds_read_tr16_b64_v4i16((LAS s16x4*)(vs + ta + off));
    const s16x4 b = __builtin_amdgcn_ds_read_tr16_b64_v4i16((LAS s16x4*)(vs + tb + off));
    bf16x8 r; r[0] = a[0]; r[1] = a[1]; r[2] = a[2]; r[3] = a[3]; r[4] = b[0]; r[5] = b[1]; r[6] = b[2]; r[7] = b[3]; return r;
}
#define ATT_DECODE(st) const int run_ = (int)blockIdx.x + F.G * ((st) / 5), b_ = (st) % 5 - 1; const int g = run_ >> 8, h = (run_ >> 5) & 7, rr_ = run_ & 31; \
    const int sh = 2 * g, dil = 1 << sh, rps = 32 >> sh; const int r = rr_ / rps, nb = 4 * (rr_ % rps) + b_
#define ATT_LOAD(st) do { if (ATT_EXP == 2) break; ATT_DECODE(st); const int cc = tid & 15; \
    _Pragma("unroll") for (int j = 0; j < 4; ++j) { const int row = (tid >> 4) + 32 * j; int ms = nb * 128 + row; ms = ms < 0 ? 0 : ms; const size_t pos = (size_t)ms * dil + r; \
        kr[j] = *(const u32x4*)(PROJ + pos * DIN + OFF_K + h * HD + 8 * cc); vr[j] = *(const u32x4*)(PROJ + pos * DIN + OFF_VV + h * HD + 8 * cc); } \
    if (b_ >= 0) { const size_t qpos_ = (size_t)(nb * 128 + 16 * w + (lane & 15)) * dil + r; \
        _Pragma("unroll") for (int ks = 0; ks < 4; ++ks) qr[ks] = *(const u32x4*)(PROJ + qpos_ * DIN + OFF_Q + h * HD + 32 * ks + 8 * (lane >> 4)); } } while (0)
__device__ __forceinline__ void att_phase(Frame& F, int l) {
    const bf16* PROJ = (const bf16*)(F.ws + WS_PROJ);
    bf16* ATT = (bf16*)(F.ws + WS_ATT); float* LSE = (float*)(F.ws + WS_LSE);
    const int lane = F.lane, w = F.wave, tid = F.tid, fr = lane & 15, gq = lane >> 4;
    LAS unsigned char* Ks = F.lds; LAS unsigned char* Vs = F.lds + 65536;
    const int nsteps = 5 * ((768 - (int)blockIdx.x + F.G - 1) / F.G);
    u32x4 kr[4], vr[4], qr[4];
    if (ATT_EXP == 2) { for (int j = 0; j < 4; ++j) { kr[j] = (u32x4){0x3f803f80u + (unsigned)tid, 0x3f003f80u, 0x3f803f00u, 0x3e803f80u}; vr[j] = kr[j]; qr[j] = kr[j]; } }
    if (nsteps > 0) ATT_LOAD(0);
    const int cc = tid & 15;
    const float* kgp = F.in[IN_KN] + l * HD + 8 * cc;
    const f32x4 kg0 = *(const f32x4*)kgp, kg1 = *(const f32x4*)(kgp + 4);
    for (int st = 0; st < nsteps; ++st) {
        ATT_DECODE(st);
        const int slot = (b_ + 1) & 1, curoff = slot * 32768, prevoff = 32768 - curoff;
#pragma unroll
        for (int j = 0; j < 4; ++j) { const int row = (tid >> 4) + 32 * j;
            const u32x4 k4 = kr[j];
            float x[8] = {bf_lo(k4.x), bf_hi(k4.x), bf_lo(k4.y), bf_hi(k4.y), bf_lo(k4.z), bf_hi(k4.z), bf_lo(k4.w), bf_hi(k4.w)};
            float sq = 0.f;
#pragma unroll
            for (int e = 0; e < 8; ++e) sq += x[e] * x[e];
            const float rs = __builtin_amdgcn_rsqf(row16_sum(sq) * (1.f / HD) + EPS);
            u32x4 o; o.x = cvt_pk_bf16(x[0] * rs * kg0[0], x[1] * rs * kg0[1]); o.y = cvt_pk_bf16(x[2] * rs * kg0[2], x[3] * rs * kg0[3]);
            o.z = cvt_pk_bf16(x[4] * rs * kg1[0], x[5] * rs * kg1[1]); o.w = cvt_pk_bf16(x[6] * rs * kg1[2], x[7] * rs * kg1[3]);
            *(LAS u32x4*)(Ks + curoff + kimg_off(row, cc)) = o;
            *(LAS u32x4*)(Vs + curoff + vimg_off(row, cc)) = vr[j]; }
        const int iq = 16 * w + fr; const size_t qpos = (size_t)(nb * 128 + iq) * dil + r;
        bf16x8 qf[4];
        if (b_ >= 0) { float x[4][8]; float sq = 0.f;
#pragma unroll
          for (int ks = 0; ks < 4; ++ks) { const u32x4 q4 = qr[ks];
              x[ks][0] = bf_lo(q4.x); x[ks][1] = bf_hi(q4.x); x[ks][2] = bf_lo(q4.y); x[ks][3] = bf_hi(q4.y); x[ks][4] = bf_lo(q4.z); x[ks][5] = bf_hi(q4.z); x[ks][6] = bf_lo(q4.w); x[ks][7] = bf_hi(q4.w);
#pragma unroll
              for (int e = 0; e < 8; ++e) sq += x[ks][e] * x[ks][e]; }
          sq = sum4(sq);
          const float rs = __builtin_amdgcn_rsqf(sq * (1.f / HD) + EPS) * 0.12751743f;
#pragma unroll
          for (int ks = 0; ks < 4; ++ks) { const float* qg = F.in[IN_QN] + l * HD + 32 * ks + 8 * gq; const f32x4 q0 = *(const f32x4*)qg, q1 = *(const f32x4*)(qg + 4);
              u32x4 o; o.x = cvt_pk_bf16(x[ks][0] * rs * q0[0], x[ks][1] * rs * q0[1]); o.y = cvt_pk_bf16(x[ks][2] * rs * q0[2], x[ks][3] * rs * q0[3]);
              o.z = cvt_pk_bf16(x[ks][4] * rs * q1[0], x[ks][5] * rs * q1[1]); o.w = cvt_pk_bf16(x[ks][6] * rs * q1[2], x[ks][7] * rs * q1[3]);
              qf[ks] = __builtin_bit_cast(bf16x8, o); } }
        __syncthreads();
        if (st + 1 < nsteps) ATT_LOAD(st + 1);
        if (b_ >= 0 && ATT_EXP != 1) {
        f32x4 sc[10];
#pragma unroll
        for (int kt = 0; kt < 9; ++kt) { sc[kt] = (f32x4){0.f, 0.f, 0.f, 0.f}; const int T = w + kt; const int kbase = (T < 8 ? prevoff : curoff); const int krow = 16 * (T & 7) + fr;
#pragma unroll
            for (int ks = 0; ks < 4; ++ks) { const bf16x8 kf = *(const LAS bf16x8*)(Ks + kbase + kimg_off(krow, 4 * ks + gq));
                sc[kt] = __builtin_amdgcn_mfma_f32_16x16x32_bf16(kf, qf[ks], sc[kt], 0, 0, 0); } }
#pragma unroll
        for (int e = 0; e < 4; ++e) { sc[0][e] = (4 * gq + e >= fr) ? sc[0][e] : -INFINITY; sc[8][e] = (4 * gq + e <= fr) ? sc[8][e] : -INFINITY; }
        if (nb == 0) {
#pragma unroll
            for (int kt = 0; kt < 8; ++kt) if (w + kt < 8) sc[kt] = (f32x4){-INFINITY, -INFINITY, -INFINITY, -INFINITY}; }
        float mx = -INFINITY;
#pragma unroll
        for (int kt = 0; kt < 9; ++kt) mx = fmaxf(fmaxf(mx, fmaxf(sc[kt][0], sc[kt][1])), fmaxf(sc[kt][2], sc[kt][3]));
        mx = max4(mx);
        float sum = 0.f;
#pragma unroll
        for (int kt = 0; kt < 9; ++kt)
#pragma unroll
            for (int e = 0; e < 4; ++e) { const float p = __builtin_amdgcn_exp2f(sc[kt][e] - mx); sc[kt][e] = p; sum += p; }
        sc[9] = (f32x4){0.f, 0.f, 0.f, 0.f};
        sum = sum4(sum);
        bf16x8 pf[5];
#pragma unroll
        for (int pp = 0; pp < 5; ++pp) { u32x4 o; o.x = cvt_pk_bf16(sc[2 * pp][0], sc[2 * pp][1]); o.y = cvt_pk_bf16(sc[2 * pp][2], sc[2 * pp][3]); o.z = cvt_pk_bf16(sc[2 * pp + 1][0], sc[2 * pp + 1][1]); o.w = cvt_pk_bf16(sc[2 * pp + 1][2], sc[2 * pp + 1][3]);
            pf[pp] = __builtin_bit_cast(bf16x8, o); }
        const float inv = __builtin_amdgcn_rcpf(sum);
        bf16* orow = ATT + ((size_t)g * SEQ + qpos) * 1024 + h * HD + 4 * gq;
        int toff[10];
#pragma unroll
        for (int kt = 0; kt < 10; ++kt) { const int T = (w + kt) < 15 ? (w + kt) : 15; toff[kt] = (T < 8 ? prevoff : curoff) + (T & 7) * 16 * 256; }
#pragma unroll
        for (int dt = 0; dt < 8; ++dt) { f32x4 o = (f32x4){0.f, 0.f, 0.f, 0.f};
#pragma unroll
            for (int pp = 0; pp < 5; ++pp) { const bf16x8 vf = tr_frag2(Vs, toff[2 * pp], toff[2 * pp + 1], dt, lane);
                o = __builtin_amdgcn_mfma_f32_16x16x32_bf16(vf, pf[pp], o, 0, 0, 0); }
            u32x2 ow; ow.x = cvt_pk_bf16(o[0] * inv, o[1] * inv); ow.y = cvt_pk_bf16(o[2] * inv, o[3] * inv);
            *(u32x2*)(orow + 16 * dt) = ow; }
        if (gq == 0) LSE[((size_t)g * SEQ + qpos) * NHEAD + h] = (mx + __builtin_amdgcn_logf(sum)) * 0.6931471805599453f;
        }
        if (b_ >= 0 && ATT_EXP == 1) { bf16* orow = ATT + ((size_t)g * SEQ + qpos) * 1024 + h * HD + 4 * gq;
#pragma unroll
            for (int dt = 0; dt < 8; ++dt) { u32x2 ow; ow.x = __builtin_bit_cast(unsigned, qf[dt & 3][0] | (qf[dt & 3][1] << 16)) & 0x3f803f80u; ow.y = 0u; *(u32x2*)(orow + 16 * dt) = ow; }
            if (gq == 0) LSE[((size_t)g * SEQ + qpos) * NHEAD + h] = 0.f; }
        __syncthreads();
    }
}
#undef ATT_DECODE
#undef ATT_LOAD

__device__ __forceinline__ void att_combine(Frame& F, int l) {
    const bf16* ATT = (const bf16*)(F.ws + WS_ATT); const float* LSE = (const float*)(F.ws + WS_LSE); bf16* MIX = (bf16*)(F.ws + WS_MIX);
    const int gw = F.vcu * NWAVES + F.wave, NGW = F.G * NWAVES, lane = F.lane;
    const float* og = F.in[IN_OUTN] + (size_t)l * DM + 1024 + 16 * lane;
    f32x4 gg[4];
#pragma unroll
    for (int q = 0; q < 4; ++q) gg[q] = *(const f32x4*)(og + 4 * q);
    for (int m = gw; m < SEQ; m += NGW) {
        const int hh = lane >> 3;
        const float l0 = LSE[((size_t)0 * SEQ + m) * NHEAD + hh], l1 = LSE[((size_t)1 * SEQ + m) * NHEAD + hh], l2 = LSE[((size_t)2 * SEQ + m) * NHEAD + hh];
        const float M = fmaxf(l0, fmaxf(l1, l2)); float w0 = fast_exp(l0 - M), w1 = fast_exp(l1 - M), w2 = fast_exp(l2 - M);
        const float iw = __builtin_amdgcn_rcpf(w0 + w1 + w2); w0 *= iw; w1 *= iw; w2 *= iw;
        float y[16]; float s = 0.f;
#pragma unroll
        for (int q = 0; q < 2; ++q) {
            const u32x4 a = __builtin_nontemporal_load((const u32x4*)(ATT + ((size_t)0 * SEQ + m) * 1024 + 16 * lane + 8 * q)), b = __builtin_nontemporal_load((const u32x4*)(ATT + ((size_t)1 * SEQ + m) * 1024 + 16 * lane + 8 * q)), c = __builtin_nontemporal_load((const u32x4*)(ATT + ((size_t)2 * SEQ + m) * 1024 + 16 * lane + 8 * q));
            const unsigned au[4] = {a.x, a.y, a.z, a.w}, bu[4] = {b.x, b.y, b.z, b.w}, cu[4] = {c.x, c.y, c.z, c.w};
#pragma unroll
            for (int e = 0; e < 4; ++e) { y[8 * q + 2 * e] = w0 * bf_lo(au[e]) + w1 * bf_lo(bu[e]) + w2 * bf_lo(cu[e]); y[8 * q + 2 * e + 1] = w0 * bf_hi(au[e]) + w1 * bf_hi(bu[e]) + w2 * bf_hi(cu[e]); } }
#pragma unroll
        for (int e = 0; e < 16; ++e) s += y[e] * y[e];
        const float rs = __builtin_amdgcn_rsqf(wave_sum(s) * (1.f / 1024.f) + EPS);
        if (OP8(l)) { u32x4 o8;
            o8.x = pk4_fp8(y[0] * rs * gg[0][0], y[1] * rs * gg[0][1], y[2] * rs * gg[0][2], y[3] * rs * gg[0][3]); o8.y = pk4_fp8(y[4] * rs * gg[1][0], y[5] * rs * gg[1][1], y[6] * rs * gg[1][2], y[7] * rs * gg[1][3]);
            o8.z = pk4_fp8(y[8] * rs * gg[2][0], y[9] * rs * gg[2][1], y[10] * rs * gg[2][2], y[11] * rs * gg[2][3]); o8.w = pk4_fp8(y[12] * rs * gg[3][0], y[13] * rs * gg[3][1], y[14] * rs * gg[3][2], y[15] * rs * gg[3][3]);
            *(u32x4*)((unsigned char*)MIX + (size_t)m * DM + 1024 + 16 * lane) = o8; }
        else
#pragma unroll
        for (int q = 0; q < 2; ++q) { u32x4 o;
            o.x = cvt_pk_bf16(y[8 * q + 0] * rs * gg[2 * q][0], y[8 * q + 1] * rs * gg[2 * q][1]); o.y = cvt_pk_bf16(y[8 * q + 2] * rs * gg[2 * q][2], y[8 * q + 3] * rs * gg[2 * q][3]);
            o.z = cvt_pk_bf16(y[8 * q + 4] * rs * gg[2 * q + 1][0], y[8 * q + 5] * rs * gg[2 * q + 1][1]); o.w = cvt_pk_bf16(y[8 * q + 6] * rs * gg[2 * q + 1][2], y[8 * q + 7] * rs * gg[2 * q + 1][3]);
            *(u32x4*)(MIX + (size_t)m * DM + 1024 + 16 * lane + 8 * q) = o; }
    }
}

#define ROUTER_LOAD(S, ks) do { \
    _Pragma("unroll") for (int rt = 0; rt < 4; ++rt) xa##S[rt] = *(const u32x4*)(xrow + (size_t)rt * 16 * DM + 32 * (ks)); \
    _Pragma("unroll") for (int ct = 0; ct < 3; ++ct) { bh##S[ct] = *(const bf16x8*)(wf + (size_t)(ks) * 3072 + (ct * 2) * 512); bl##S[ct] = *(const bf16x8*)(wf + (size_t)(ks) * 3072 + (ct * 2 + 1) * 512); } } while (0)
#define ROUTER_STEP(S, ks) do { \
    _Pragma("unroll") for (int rt = 0; rt < 4; ++rt) { const u32x4 xq = xa##S[rt]; \
        const float x0 = bf_lo(xq.x), x1 = bf_hi(xq.x), x2 = bf_lo(xq.y), x3 = bf_hi(xq.y), x4 = bf_lo(xq.z), x5 = bf_hi(xq.z), x6 = bf_lo(xq.w), x7 = bf_hi(xq.w); \
        ssq[rt] += (x0 * x0 + x1 * x1) + (x2 * x2 + x3 * x3) + (x4 * x4 + x5 * x5) + (x6 * x6 + x7 * x7); \
        { u32x2 x8; x8.x = pk4_fp8(x0, x1, x2, x3); x8.y = pk4_fp8(x4, x5, x6, x7); *(u32x2*)(x8row + (size_t)rt * 16 * DM + 32 * (ks)) = x8; } \
        const bf16x8 xh = __builtin_bit_cast(bf16x8, xq); \
        _Pragma("unroll") for (int ct = 0; ct < 3; ++ct) { \
            acc[rt][ct] = __builtin_amdgcn_mfma_f32_16x16x32_bf16(xh, bh##S[ct], acc[rt][ct], 0, 0, 0); \
            acc[rt][ct] = __builtin_amdgcn_mfma_f32_16x16x32_bf16(xh, bl##S[ct], acc[rt][ct], 0, 0, 0); } } } while (0)
__device__ __forceinline__ void router_phase(Frame& F, int l, int alt = 0) {
    const bf16* H1 = (const bf16*)(F.ws + WS_HN);
    const bf16* WRF = (const bf16*)(F.ws + WS_WRT) + (size_t)l * 64 * 3 * 2 * 64 * 8;
    unsigned* cnt = (unsigned*)(F.ws + WS_CTL) + CW_CNT + 2048 * l + 32768 * alt;
    int* tok = (int*)(F.ws + (alt ? WS_ALT : WS_TOK)); f32x4* tinfo = (f32x4*)(F.ws + (alt ? WS_ALT + 4 * MiB : WS_TINFO)); float* rslot = (float*)(F.ws + (alt ? WS_ALT + 2 * MiB : WS_RSLOT));
    const int lane = F.lane, tid = F.tid, w = F.wave, fr = lane & 15, g = lane >> 4;
    constexpr int PS = 49;
    LAS float* P = (LAS float*)F.lds;
    LAS float* SS = (LAS float*)(F.lds + 8 * 64 * PS * 4);
    for (int task = (int)blockIdx.x; task < SEQ / 64; task += F.G) {
        const bf16* xrow = H1 + (size_t)(task * 64 + fr) * DM + 256 * w + 8 * g;
        unsigned char* x8row = F.ws + WS_X8 + (size_t)(task * 64 + fr) * DM + 256 * w + 8 * g;
        const bf16* wf = WRF + ((size_t)(8 * w) * 3 * 2 * 64 + lane) * 8;
        f32x4 acc[4][3]; float ssq[4] = {0.f, 0.f, 0.f, 0.f};
#pragma unroll
        for (int rt = 0; rt < 4; ++rt)
#pragma unroll
            for (int ct = 0; ct < 3; ++ct) acc[rt][ct] = (f32x4){0.f, 0.f, 0.f, 0.f};
        u32x4 xaA[4], xaB[4]; bf16x8 bhA[3], blA[3], bhB[3], blB[3];
        ROUTER_LOAD(A, 0);
#pragma unroll 1
        for (int it = 0; it < 4; ++it) {
            ROUTER_LOAD(B, 1); __builtin_amdgcn_sched_barrier(0);
            ROUTER_STEP(A, 0); __builtin_amdgcn_sched_barrier(0);
            if (it < 3) ROUTER_LOAD(A, 2);
            __builtin_amdgcn_sched_barrier(0);
            ROUTER_STEP(B, 1); __builtin_amdgcn_sched_barrier(0);
            xrow += 64; x8row += 64; wf += 2 * 3072;
        }
#pragma unroll
        for (int rt = 0; rt < 4; ++rt) { float sq = ssq[rt]; sq += __shfl_xor(sq, 16); sq += __shfl_xor(sq, 32);
            if (g == 0) SS[w * 64 + 16 * rt + fr] = sq;
#pragma unroll
            for (int ct = 0; ct < 3; ++ct)
#pragma unroll
                for (int e = 0; e < 4; ++e) P[(w * 64 + 16 * rt + 4 * g + e) * PS + 16 * ct + fr] = acc[rt][ct][e]; }
        __syncthreads();
        if (tid < 64) {
            const int t = task * 64 + tid;
            float ss = 0.f;
#pragma unroll
            for (int q = 0; q < 8; ++q) ss += SS[q * 64 + tid];
            const float rs = __builtin_amdgcn_rsqf(ss * (1.f / DM) + EPS);
            const LAS float* pr = P + tid * PS;
            float lg[4];
#pragma unroll
            for (int o = 0; o < 4; ++o) { float a = 0.f;
#pragma unroll
                for (int q = 0; q < 8; ++q) a += pr[q * 64 * PS + 32 + o];
                lg[o] = a * rs + F.in[IN_BRG][l * 4 + o]; }
            int gi = 0; float gm = lg[0];
#pragma unroll
            for (int o = 1; o < 4; ++o) if (lg[o] > gm) { gm = lg[o]; gi = o; }
            float den = 0.f;
#pragma unroll
            for (int o = 0; o < 4; ++o) den += __expf(lg[o] - gm);
            const float gate_g = 1.f / den;
            float t1v = -INFINITY, t2v = -INFINITY; int t1i = 0, t2i = 0;
#pragma unroll
            for (int ii = 0; ii < 8; ++ii) { const int o = gi * 8 + ii; float a = 0.f;
#pragma unroll
                for (int q = 0; q < 8; ++q) a += pr[q * 64 * PS + o];
                const float v = a * rs + F.in[IN_BRE][l * NE + o];
                if (v > t1v) { t2v = t1v; t2i = t1i; t1v = v; t1i = ii; }
                else if (v > t2v) { t2v = v; t2i = ii; } }
            const float pp1 = 1.f / (1.f + __expf(t2v - t1v)), pp2 = 1.f - pp1;
            const int e0 = gi * 8 + t1i, e1 = gi * 8 + t2i;
            LAS unsigned* lcnt = (LAS unsigned*)(F.lds + 8 * 64 * PS * 4 + 8 * 64 * 4);
            if (tid < 32) lcnt[tid] = 0u;
            const unsigned r0 = __hip_atomic_fetch_add(lcnt + e0, 1u, __ATOMIC_RELAXED, __HIP_MEMORY_SCOPE_WORKGROUP), r1 = __hip_atomic_fetch_add(lcnt + e1, 1u, __ATOMIC_RELAXED, __HIP_MEMORY_SCOPE_WORKGROUP);
            if (tid < 32) { const unsigned c = lcnt[tid]; lcnt[32 + tid] = c ? atomicAdd(&cnt[tid * CNT_STRIDE], c) : 0u; }
            const unsigned s0 = lcnt[32 + e0] + r0, s1 = lcnt[32 + e1] + r1;
            tok[(size_t)e0 * TOKCAP + s0] = t; tok[(size_t)e1 * TOKCAP + s1] = t;
            rslot[(size_t)e0 * TOKCAP + s0] = rs; rslot[(size_t)e1 * TOKCAP + s1] = rs;
            f32x4 ti; ti[0] = __builtin_bit_cast(float, (int)(e0 * TOKCAP + s0)); ti[1] = __builtin_bit_cast(float, (int)(e1 * TOKCAP + s1)); ti[2] = gate_g * pp1; ti[3] = gate_g * pp2;
            tinfo[t] = ti;
        }
        __syncthreads();
    }
}
__device__ __forceinline__ void moe_table(Frame& F, int l) {
    const unsigned* cnt = (const unsigned*)(F.ws + WS_CTL) + CW_CNT + 2048 * l;
    LAS int* tstart = (LAS int*)(F.lds + MISC_OFF + 64);
    __syncthreads();
    if (F.tid == 0) { int acc = 0; for (int e = 0; e < NE; ++e) { tstart[e] = acc; acc += ((int)cnt[e * CNT_STRIDE] + 255) >> 8; } tstart[NE] = acc; }
    __syncthreads();
    { LAS int* tile_e = (LAS int*)(F.lds + MISC_OFF + 2304);
      if (F.tid < 160) { int e = 0; for (int j = 1; j < NE; ++j) e = (tstart[j] <= F.tid) ? j : e; tile_e[F.tid] = e; } }
    __syncthreads();
}
__device__ __forceinline__ void combine_phase(Frame& F, int l) {
    const LAS int* tstart = (const LAS int*)(F.lds + MISC_OFF + 64);
    const unsigned char* Y = F.ws + WS_Y; const f32x4* tinfo = (const f32x4*)(F.ws + WS_TINFO);
    bf16* H = (bf16*)(F.ws + WS_H); bf16* HN = (bf16*)(F.ws + WS_HN);
    const int gw = F.vcu * NWAVES + F.wave, NGW = F.G * NWAVES, lane = F.lane;
    const float* g1n = F.in[IN_NORM1] + (size_t)DM;
    for (int m = gw; m < SEQ; m += NGW) {
        const f32x4 ti = tinfo[m];
        const float tf0 = ti[0], tf1 = ti[1]; const int s0 = __builtin_bit_cast(int, tf0), s1 = __builtin_bit_cast(int, tf1);
        const int e0 = s0 >> 14, e1 = s1 >> 14;
        const size_t r0 = (size_t)tstart[e0] * 256 + (s0 & (TOKCAP - 1)), r1 = (size_t)tstart[e1] * 256 + (s1 & (TOKCAP - 1));
        const float ga = ti[2] * (1.f / Y_SCALE), gb = ti[3] * (1.f / Y_SCALE);
        f32x4 v[8]; float s = 0.f;
#pragma unroll
        for (int j = 0; j < 8; ++j) { const u32x2 hx = __builtin_nontemporal_load((const u32x2*)(HN + (size_t)m * DM + 4 * lane + 256 * j));
            const int ya = __builtin_nontemporal_load((const int*)(Y + r0 * DM + 4 * lane + 256 * j)), yb = __builtin_nontemporal_load((const int*)(Y + r1 * DM + 4 * lane + 256 * j));
            const f32x2 a01 = __builtin_amdgcn_cvt_pk_f32_fp8(ya, false), a23 = __builtin_amdgcn_cvt_pk_f32_fp8(ya, true), b01 = __builtin_amdgcn_cvt_pk_f32_fp8(yb, false), b23 = __builtin_amdgcn_cvt_pk_f32_fp8(yb, true);
            v[j][0] = bf_lo(hx.x) + ga * a01[0] + gb * b01[0]; v[j][1] = bf_hi(hx.x) + ga * a01[1] + gb * b01[1];
            v[j][2] = bf_lo(hx.y) + ga * a23[0] + gb * b23[0]; v[j][3] = bf_hi(hx.y) + ga * a23[1] + gb * b23[1];
            s += (v[j][0] * v[j][0] + v[j][1] * v[j][1]) + (v[j][2] * v[j][2] + v[j][3] * v[j][3]); }
        if (l == 0) {
            const float rs = __builtin_amdgcn_rsqf(wave_sum(s) * (1.f / DM) + EPS);
            bf16* hrow = H + (size_t)m * DM; bf16* orow = HN + (size_t)m * DM;
#pragma unroll
            for (int j = 0; j < 8; ++j) { const f32x4 gg = *(const f32x4*)(g1n + 4 * lane + 256 * j);
                u32x2 hb; hb.x = cvt_pk_bf16(v[j][0], v[j][1]); hb.y = cvt_pk_bf16(v[j][2], v[j][3]); *(u32x2*)(hrow + 4 * lane + 256 * j) = hb;
                if (IP8(1)) *(unsigned*)(F.ws + WS_X8 + (size_t)m * DM + 4 * lane + 256 * j) = pk4_fp8(v[j][0] * rs * gg[0], v[j][1] * rs * gg[1], v[j][2] * rs * gg[2], v[j][3] * rs * gg[3]);
                else { u32x2 o; o.x = cvt_pk_bf16(v[j][0] * rs * gg[0], v[j][1] * rs * gg[1]); o.y = cvt_pk_bf16(v[j][2] * rs * gg[2], v[j][3] * rs * gg[3]);
                *(u32x2*)(orow + 4 * lane + 256 * j) = o; } }
        } else {
            float* orow = F.out + (size_t)m * DM;
#pragma unroll
            for (int j = 0; j < 8; ++j) __builtin_nontemporal_store(v[j], (f32x4*)(orow + 4 * lane + 256 * j));
        }
    }
}

__device__ __forceinline__ void relaunder(Frame& F) { F.lane = lane_now(); F.tid = F.wave * 64 + F.lane; }
constexpr int N_PHASES = 17;
#ifndef PHASE_MASK
#define PHASE_MASK 0x1ff
#endif
#ifndef MIX_MASK
#define MIX_MASK 7
#endif
#ifndef DUP_PHASE
#define DUP_PHASE 0
#endif
#define DUP(k) for (int _d = 0; _d < ((DUP_PHASE == (k)) ? 2 : 1); ++_d)
#define IN(k) (lo <= (k) && (k) < hi)
#define EN(b) ((PHASE_MASK >> (b)) & 1)
#ifndef PROBE_STAMP
#define PROBE_STAMP (-1)
#endif
#define SEAM(k) do { if (IN(k) && IN((k) + 1)) { xcd_barrier(bar); if (PROBE_STAMP >= 0 && blockIdx.x == 0 && F.tid == 0) { const unsigned long long _t = wall_clock64(); F.MISC[802 + 2 * (k)] = (unsigned)_t; F.MISC[803 + 2 * (k)] = (unsigned)(_t >> 32); } } } while (0)
template <int l>
__device__ __forceinline__ void layer_phases(Frame& F, const XcdBarrier& bar, const int lo, const int hi) {
    constexpr int pb = 1 + 8 * l;
    relaunder(F);
    if (EN(1) && IN(pb)) {
        constexpr int KI = IP8(l) ? DM / 2 : DM;
        pg8::StaticSched S; S.init((const bf16*)(F.ws + (IP8(l) ? WS_X8 : WS_HN)), (const bf16*)(F.ws + WS_WIN) + (size_t)l * DIN * DM, SEQ, DIN, KI, F.G, (int)blockIdx.x);
        pg8::EpiProj E{(bf16*)(F.ws + WS_PROJ), IP8(l) ? 1.f / WIN_SCALE : 1.f};
        DUP(1) pg8::gemm_phase<pg8::EpiProj, pg8::StaticSched, true, IP8(l) != 0>(F.lds, KI, S, E, F.wave);
    }
    SEAM(pb);
    relaunder(F);
    if (EN(2) && IN(pb + 1)) {
        constexpr int N_SGU = 256, N_CONV = 512, N_ATT = 3072;
#define MSTAMP(i) do { if (PROBE_STAMP >= 100 && l == 0 && blockIdx.x == 0 && F.tid == 0) { const unsigned long long _t = wall_clock64(); F.MISC[900 + 2 * (i)] = (unsigned)_t; F.MISC[901 + 2 * (i)] = (unsigned)(_t >> 32); } } while (0)
        MSTAMP(0);
        if (MIX_MASK & 1) DUP(2) att_phase(F, l);
        MSTAMP(1);
        if (MIX_MASK & 2) DUP(3) for (int it = (int)blockIdx.x; it < N_CONV; it += F.G) conv_item(F, l, it);
        MSTAMP(2);
        if (MIX_MASK & 4) DUP(4) for (int it = (int)blockIdx.x; it < N_SGU; it += F.G) sgu_item(F, l, it >> 1, it & 1);
        MSTAMP(3);
#undef MSTAMP
    }
    SEAM(pb + 1);
    if (DUP_PHASE == 12 && IN(pb + 1)) {
        pg8::StaticSched S; S.init((const bf16*)(F.ws + WS_MIX), (const bf16*)(F.ws + WS_WIN) + (size_t)l * DIN * DM, SEQ, DIN, DM, F.G, (int)blockIdx.x);
        pg8::EpiProj E{(bf16*)(F.ws + WS_PROJ), 1.f};
        pg8::gemm_phase<pg8::EpiProj, pg8::StaticSched>(F.lds, DM, S, E, F.wave);
        xcd_barrier(bar);
    }
    relaunder(F);
    if (EN(3) && IN(pb + 2)) DUP(5) att_combine(F, l);
    SEAM(pb + 2);
    relaunder(F);
    if (EN(4) && IN(pb + 3)) {
        constexpr int KO = OP8(l) ? DM / 2 : DM;
        pg8::StaticSched S; S.init((const bf16*)(F.ws + WS_MIX), (const bf16*)(F.ws + WS_WOUT) + (size_t)l * DM * DM, SEQ, DM, KO, F.G, (int)blockIdx.x);
        if constexpr (l == 0) { pg8::EpiResid<false> E{(const void*)F.in[IN_X], (bf16*)(F.ws + WS_HN)}; DUP(6) pg8::gemm_phase<pg8::EpiResid<false>, pg8::StaticSched, true, OP8(l) != 0>(F.lds, KO, S, E, F.wave); }
        else { pg8::EpiResid<true> E{(const void*)(F.ws + WS_H), (bf16*)(F.ws + WS_HN)}; DUP(6) pg8::gemm_phase<pg8::EpiResid<true>, pg8::StaticSched, true, OP8(l) != 0>(F.lds, KO, S, E, F.wave); }
    }
    SEAM(pb + 3);
    relaunder(F);
    if (EN(5) && IN(pb + 4)) { router_phase(F, l); if (DUP_PHASE == 11) router_phase(F, l, 1); }
    if (DUP_PHASE == 13 && IN(pb + 4)) { for (int q = 0; q < 8; ++q) xcd_barrier(bar); }
    SEAM(pb + 4);
    relaunder(F);
    if (EN(6) && IN(pb + 5)) {
        moe_table(F, l);
        unsigned* ready = (unsigned*)(F.ws + WS_CTL) + CW_RDY + 16384 * l;
        {
            pg8::SchedG1 S{(const LAS int*)(F.lds + MISC_OFF + 64), (const int*)((const unsigned*)(F.ws + WS_CTL) + CW_CNT + 2048 * l), (const int*)(F.ws + WS_TOK), (const bf16*)(F.ws + WS_X8),
                           (const bf16*)(F.ws + WS_W1 + (size_t)l * NE * 1024 * DM), F.G, (int)blockIdx.x, ready};
            pg8::EpiSwiGLU E{F.ws + WS_HB, (const float*)(F.ws + WS_RSLOT)};
            DUP(7) pg8::gemm_phase<pg8::EpiSwiGLU, pg8::SchedG1, true, true>(F.lds, DM / 2, S, E, F.wave);
        }
        {
            pg8::SchedG2 S{(const LAS int*)(F.lds + MISC_OFF + 64), (const bf16*)(F.ws + WS_HB), (const bf16*)(F.ws + WS_W2 + (size_t)l * NE * DM * DE), F.G, (int)blockIdx.x, ready, (unsigned*)(F.ws + WS_CTL) + CW_TMO, F.wave};
            pg8::EpiY E{F.ws + WS_Y};
            DUP(8) pg8::gemm_phase<pg8::EpiY, pg8::SchedG2, true, true>(F.lds, DE / 2, S, E, F.wave);
        }
    }
    SEAM(pb + 6);
    relaunder(F);
    if (EN(8) && IN(pb + 7)) { moe_table(F, l); DUP(l == 0 ? 9 : 99) combine_phase(F, l); }
    SEAM(pb + 7);
}
__global__ void __launch_bounds__(NTHREADS, 2) fwd_kernel(Params args) {
    extern __shared__ __attribute__((aligned(16))) unsigned char lds_raw[];
    Frame F;
    F.lds = (LAS unsigned char*)lds_raw; F.MISC = (volatile LAS unsigned*)(F.lds + MISC_OFF);
    F.tid = threadIdx.x; F.lane = F.tid & 63; F.wave = __builtin_amdgcn_readfirstlane(F.tid >> 6);
    F.G = gridDim.x; { const int bx = blockIdx.x; F.vcu = (F.G % 8 == 0) ? (bx % 8) * (F.G / 8) + bx / 8 : bx; }
    F.in = args.in; F.out = args.out; F.ws = args.ws;
    for (int u = F.tid; u < (LDS_BYTES - MISC_OFF) / 4; u += NTHREADS) ((LAS unsigned*)(F.lds + MISC_OFF))[u] = 0u;
    __syncthreads();
    unsigned* ctl = (unsigned*)(args.ws + WS_CTL);
    const int lo = args.ph_lo, hi = args.ph_hi;
    const bool multi = (hi - lo) > 1;
    XcdBarrier bar; bar.bar = ctl + CW_BAR; bar.x = 0; bar.st = nullptr; bar.lead = 0;
    if (multi) bar = xcd_barrier_post(ctl + CW_BAR, F.MISC, F.wave == 0 ? 1u : 0u);
    if (PROBE_STAMP >= 0 && blockIdx.x == 0 && F.tid == 0) { const unsigned long long _t = wall_clock64(); F.MISC[800] = (unsigned)_t; F.MISC[801] = (unsigned)(_t >> 32); }
    if (EN(0) && IN(0)) { DUP(10) p_prologue(F); }
    SEAM(0);
    layer_phases<0>(F, bar, lo, hi);
    layer_phases<1>(F, bar, lo, hi);
    if (PROBE_STAMP >= 0 && blockIdx.x == 0 && F.tid == 0) {
        asm volatile("s_waitcnt vmcnt(0)" ::: "memory");
        constexpr int SB = PROBE_STAMP >= 100 ? 900 + 2 * (PROBE_STAMP - 100) : (PROBE_STAMP == 6 ? 812 : 800 + 2 * PROBE_STAMP);
        constexpr int SB1 = (PROBE_STAMP == 6) ? SB + 4 : SB + 2;
        const unsigned long long t1 = ((unsigned long long)F.MISC[SB1 + 1] << 32) | F.MISC[SB1], t0 = ((unsigned long long)F.MISC[SB + 1] << 32) | F.MISC[SB];
        F.out[0] += (float)(long long)(t1 - t0) * 0.01f;
    }
}
#undef IN
#undef EN
#undef SEAM
#undef DUP

extern "C" void kernel_launch(void* const* d_in, const int* in_sizes, int n_in, void* d_out, int out_size, void* d_ws, size_t ws_size, hipStream_t stream) {
    static int grid = 0;
    if (grid == 0) {
        if (n_in != 22 || out_size != SEQ * DM || ws_size < WS_END) { fprintf(stderr, "kernel_launch: unexpected shapes (n_in %d out %d ws %zu, need %zu)\n", n_in, out_size, ws_size, (size_t)WS_END); grid = -1; return; }
        int dev = 0, cus = 0, per_cu = 0;
        if (hipGetDevice(&dev) != hipSuccess || hipDeviceGetAttribute(&cus, hipDeviceAttributeMultiprocessorCount, dev) != hipSuccess) { grid = -1; return; }
        if (hipFuncSetAttribute((const void*)fwd_kernel, hipFuncAttributeMaxDynamicSharedMemorySize, LDS_BYTES) != hipSuccess) { fprintf(stderr, "kernel_launch: hipFuncSetAttribute failed\n"); grid = -1; return; }
        if (hipOccupancyMaxActiveBlocksPerMultiprocessor(&per_cu, (const void*)fwd_kernel, NTHREADS, LDS_BYTES) != hipSuccess || per_cu < 1) { fprintf(stderr, "kernel_launch: occupancy query says %d\n", per_cu); }
        (void)hipGetLastError();
        grid = cus;
    }
    if (grid < 0) return;
    if (hipMemsetAsync((char*)d_ws + WS_CTL, 0, CTL_ZERO_BYTES, stream) != hipSuccess) return;
    Params p{};
    for (int i = 0; i < 22; ++i) p.in[i] = (const float*)d_in[i];
    p.out = (float*)d_out; p.ws = (unsigned char*)d_ws;
    constexpr int NL = MK_N_LAUNCHES;
    for (int li = 0; li < NL; ++li) {
        p.ph_lo = (NL == 1) ? 0 : li; p.ph_hi = (NL == 1) ? N_PHASES : li + 1;
        hipLaunchKernelGGL(fwd_kernel, dim3(grid), dim3(NTHREADS), LDS_BYTES, stream, p);
        if (hipPeekAtLastError() != hipSuccess) { fprintf(stderr, "kernel_launch: launch %d failed\n", li); break; }
    }
}
```

```cpp
#include <hip/hip_runtime.h>
#include <cstdio>
#include <cstdint>

#ifndef MK_N_LAUNCHES
#define MK_N_LAUNCHES 1
#endif

#ifndef OUTPROJ_FP8
#define OUTPROJ_FP8 2
#endif
#ifndef ATT_EXP
#define ATT_EXP 0
#endif
#define OP8(l) ((OUTPROJ_FP8 >> (l)) & 1)
#ifndef INPROJ_FP8
#define INPROJ_FP8 2
#endif
#define IP8(l) ((INPROJ_FP8 >> (l)) & 1)
#define GAS __attribute__((address_space(1)))
#define LAS __attribute__((address_space(3)))
typedef unsigned short bf16;
typedef short bf16x8 __attribute__((ext_vector_type(8)));
typedef short s16x4 __attribute__((ext_vector_type(4)));
typedef float f32x4 __attribute__((ext_vector_type(4)));
typedef float f32x2 __attribute__((ext_vector_type(2)));
typedef unsigned u32x4 __attribute__((ext_vector_type(4)));
typedef unsigned u32x2 __attribute__((ext_vector_type(2)));

constexpr int SEQ = 16384, DM = 2048, DIN = 5120, NLAYER = 2;
constexpr int HD = 128, NHEAD = 8, CONV_K = 31;
constexpr int NE = 32, DE = 512, TOKCAP = 16384;
constexpr int OFF_U = 0, OFF_V = 512, OFF_A = 1024, OFF_G = 1536, OFF_Q = 2048, OFF_K = 3072, OFF_VV = 4096;
constexpr float EPS = 1e-6f;
constexpr float W1_SCALE = 64.f, W2_SCALE = 32.f, WOUT_SCALE = 64.f, WIN_SCALE = 64.f, Y_SCALE = 16.f;
constexpr int NWAVES = 8, NTHREADS = 512;

constexpr size_t MiB = 1u << 20;
constexpr size_t WS_CTL = 0, CTL_ZERO_BYTES = 1 * MiB;
constexpr size_t WS_WIN = 1 * MiB;
constexpr size_t WS_WOUT = 41 * MiB;
constexpr size_t WS_W1 = 57 * MiB;
constexpr size_t WS_X8 = 185 * MiB;
constexpr size_t WS_W2 = 313 * MiB;
constexpr size_t WS_SGUW = 441 * MiB;
constexpr size_t WS_WRT = 442 * MiB;
constexpr size_t WS_TOK = 443 * MiB;
constexpr size_t WS_TINFO = 445 * MiB;
constexpr size_t WS_HN = 446 * MiB;
constexpr size_t WS_HB = 510 * MiB;
constexpr size_t WS_ATT = WS_HN;
constexpr size_t WS_LSE = WS_HN + 96 * MiB;
constexpr size_t WS_PROJ = 550 * MiB;
constexpr size_t WS_Y = WS_PROJ;
constexpr size_t WS_MIX = 710 * MiB;
constexpr size_t WS_H = 774 * MiB;
constexpr size_t WS_RSLOT = 902 * MiB;
constexpr size_t WS_ALT = 904 * MiB;
constexpr size_t WS_END = 910 * MiB;
constexpr int CW_BAR = 4096;
constexpr int CW_TMO = 0;
constexpr int CW_RDY = 65536;
constexpr int CW_CNT = 16384, CNT_STRIDE = 64;

constexpr int LDS_BYTES = 163840;
constexpr int MISC_OFF = 159744;

__device__ __forceinline__ unsigned cvt_pk_bf16(float lo, float hi) { unsigned r; asm volatile("v_cvt_pk_bf16_f32 %0, %1, %2" : "=v"(r) : "v"(lo), "v"(hi)); return r; }
__device__ __forceinline__ unsigned pk4_fp8(float a, float b, float c, float d) { int p = 0; p = __builtin_amdgcn_cvt_pk_fp8_f32(a, b, p, false); p = __builtin_amdgcn_cvt_pk_fp8_f32(c, d, p, true); return (unsigned)p; }
__device__ __forceinline__ float bf_lo(unsigned u) { return __builtin_bit_cast(float, u << 16); }
__device__ __forceinline__ float bf_hi(unsigned u) { return __builtin_bit_cast(float, u & 0xffff0000u); }
template <int CTRL, int RM> __device__ __forceinline__ float dpp_mov0(float v) { return __builtin_bit_cast(float, __builtin_amdgcn_update_dpp(0, __builtin_bit_cast(int, v), CTRL, RM, 0xf, false)); }
__device__ __forceinline__ float wave_sum(float s) {
    s += dpp_mov0<0xB1, 0xf>(s); s += dpp_mov0<0x4E, 0xf>(s); s += dpp_mov0<0x141, 0xf>(s); s += dpp_mov0<0x140, 0xf>(s);
    s += dpp_mov0<0x142, 0xa>(s); s += dpp_mov0<0x143, 0xc>(s);
    return __builtin_bit_cast(float, __builtin_amdgcn_readlane(__builtin_bit_cast(int, s), 63));
}
__device__ __forceinline__ float row16_sum(float s) {
    s += dpp_mov0<0xB1, 0xf>(s); s += dpp_mov0<0x4E, 0xf>(s); s += dpp_mov0<0x141, 0xf>(s); s += dpp_mov0<0x140, 0xf>(s); return s;
}
__device__ __forceinline__ float sum4(float x) {
    const unsigned xu = __builtin_bit_cast(unsigned, x); const auto r = __builtin_amdgcn_permlane16_swap(xu, xu, false, false); const unsigned r0 = r[0], r1 = r[1];
    const float a = __builtin_bit_cast(float, r0) + __builtin_bit_cast(float, r1);
    const unsigned au = __builtin_bit_cast(unsigned, a); const auto q = __builtin_amdgcn_permlane32_swap(au, au, false, false); const unsigned q0 = q[0], q1 = q[1];
    return __builtin_bit_cast(float, q0) + __builtin_bit_cast(float, q1);
}
__device__ __forceinline__ float max4(float x) {
    const unsigned xu = __builtin_bit_cast(unsigned, x); const auto r = __builtin_amdgcn_permlane16_swap(xu, xu, false, false); const unsigned r0 = r[0], r1 = r[1];
    const float a = fmaxf(__builtin_bit_cast(float, r0), __builtin_bit_cast(float, r1));
    const unsigned au = __builtin_bit_cast(unsigned, a); const auto q = __builtin_amdgcn_permlane32_swap(au, au, false, false); const unsigned q0 = q[0], q1 = q[1];
    return fmaxf(__builtin_bit_cast(float, q0), __builtin_bit_cast(float, q1));
}
__device__ __forceinline__ int lane_now() { int l; asm volatile("v_mbcnt_lo_u32_b32 %0, -1, 0\n\tv_mbcnt_hi_u32_b32 %0, -1, %0" : "=v"(l)); return l; }
#define LDS_WAIT() asm volatile("s_waitcnt lgkmcnt(0)" ::: "memory")
#define VM_WAIT() asm volatile("s_waitcnt vmcnt(0)" ::: "memory")
__device__ __forceinline__ float fast_exp(float x) { return __builtin_amdgcn_exp2f(x * 1.4426950408889634f); }
__device__ __forceinline__ float sigmoidf_(float x) { return __builtin_amdgcn_rcpf(1.0f + fast_exp(-x)); }
__device__ __forceinline__ float gelu_tanh(float x) { const float z = 1.5957691216057308f * (x + 0.044715f * x * x * x); return x * sigmoidf_(z); }

#define XB_TMO      128
#define XB_XCNT(j)  (256  + 64 * (j))
#define XB_XSUB(j)  (1280 + 64 * (j))
#define XB_XGEN(j)  (2304 + 64 * (j))
#define XB_TOP      3328
#define XB_TOPGEN   3392
#define XCD_BAR_WORDS 3456
#define XB_SPIN_CAP (1u << 22)
__device__ __forceinline__ unsigned xb_ld(unsigned* p)              { return __hip_atomic_load(p, __ATOMIC_RELAXED, __HIP_MEMORY_SCOPE_AGENT); }
__device__ __forceinline__ unsigned xb_add(unsigned* p, unsigned v) { return __hip_atomic_fetch_add(p, v, __ATOMIC_RELAXED, __HIP_MEMORY_SCOPE_AGENT); }
__device__ __forceinline__ unsigned xb_xcc_id() { return (unsigned)__builtin_amdgcn_s_getreg((3 << 11) | 20) & 0xFu; }
#define XB_SPIN(cond, bar) do { unsigned _sp = 0; while (cond) { __builtin_amdgcn_s_sleep(1); \
    if ((++_sp & 255u) == 0u) { if (xb_ld(&(bar)[XB_TMO])) break; if (_sp > XB_SPIN_CAP) { atomicAdd(&(bar)[XB_TMO], 1u); break; } } } } while (0)
struct XcdBarrier { unsigned* bar; unsigned x; volatile LAS unsigned* st; unsigned lead; };
__device__ __forceinline__ XcdBarrier xcd_barrier_post(unsigned* bar, volatile LAS unsigned* st, unsigned lead) {
    XcdBarrier b; b.bar = bar; b.x = xb_xcc_id(); b.st = st; b.lead = lead;
    if (lead && lane_now() == 0) (void)xb_add(&bar[XB_XCNT(b.x)], 1u);
    return b;
}
__device__ __forceinline__ void xcd_barrier_complete(unsigned* bar, unsigned x, unsigned& nloc, unsigned& nx) {
    const unsigned G = gridDim.x * gridDim.y * gridDim.z;
    unsigned sum, cnt, mine, sp = 0u;
    for (;;) {
        sum = 0u; cnt = 0u; mine = 0u;
#pragma unroll
        for (unsigned j = 0; j < 16; ++j) { const unsigned c = xb_ld(&bar[XB_XCNT(j)]); sum += c; cnt += (c > 0u) ? 1u : 0u; mine = (j == x) ? c : mine; }
        if (sum == G) break;
        __builtin_amdgcn_s_sleep(1);
        if ((++sp & 255u) == 0u) { if (xb_ld(&bar[XB_TMO])) break; if (sp > XB_SPIN_CAP) { atomicAdd(&bar[XB_TMO], 1u); break; } }
    }
    nloc = mine > 0u ? mine : 1u; nx = cnt > 0u ? cnt : 1u;
}
__device__ __forceinline__ void xcd_barrier(const XcdBarrier& b) {
    asm volatile("s_waitcnt vmcnt(0)" ::: "memory");
    __syncthreads();
    if (b.lead && lane_now() == 0) {
        unsigned* bar = b.bar;
        __builtin_amdgcn_s_waitcnt(0);
        unsigned nloc = b.st[0], nx = b.st[1];
        if (nloc == 0u) { xcd_barrier_complete(bar, b.x, nloc, nx); b.st[0] = nloc; b.st[1] = nx; }
        const unsigned old = xb_add(&bar[XB_XSUB(b.x)], 1u);
        const unsigned gen = old / nloc;
        if (old + 1u == (gen + 1u) * nloc) {
            __builtin_amdgcn_fence(__ATOMIC_RELEASE, "agent");
            asm volatile("s_waitcnt vmcnt(0)" ::: "memory");
            const unsigned og = xb_add(&bar[XB_TOP], 1u);
            const unsigned tg = og / nx;
            if (og + 1u == (tg + 1u) * nx) xb_add(&bar[XB_TOPGEN], 1u);
            else XB_SPIN(xb_ld(&bar[XB_TOPGEN]) == tg, bar);
            __builtin_amdgcn_fence(__ATOMIC_ACQUIRE, "agent");
            xb_add(&bar[XB_XGEN(b.x)], 1u);
            asm volatile("s_waitcnt vmcnt(0)" ::: "memory");
        } else {
            XB_SPIN(xb_ld(&bar[XB_XGEN(b.x)]) == gen, bar);
            __builtin_amdgcn_fence(__ATOMIC_ACQUIRE, "agent");
            asm volatile("s_waitcnt vmcnt(0)" ::: "memory");
        }
    }
    __syncthreads();
}

namespace pg8 {
constexpr int BM = 256, BK = 64, HALF = 128, HTB = HALF * BK * 2, STAGE_BYTES = 8 * HTB, NXCD = 8, WGM = 8;
__device__ __forceinline__ int lds_byte(int r, int c) { const int st = (r >> 4) * 2 + (c >> 5), rr = r & 15, cc = c & 31, ob = rr * 64 + cc * 2; return st * 1024 + (ob ^ (((ob >> 9) & 1) << 5)); }
__device__ __forceinline__ void stage_rc(int b, int& R, int& C) { const int st = b / 1024, sb = b % 1024, swz = sb ^ (((sb >> 9) & 1) << 5); R = (st >> 1) * 16 + swz / 64; C = (st & 1) * 32 + (swz % 64) / 2; }
__device__ __forceinline__ int perm32(int rho) { const int n = rho >> 4, i = rho & 15; return 8 * (i >> 2) + 4 * n + (i & 3); }

struct Unit { int pm, pn, e, rb; };

struct StaticSched {
    static constexpr bool GATHER = false;
    const bf16* A; const bf16* Bt; int K; int nM, nN, nwg, G, c; int i0 = 0, i1 = 0x7fffffff;
    __device__ __forceinline__ void init(const bf16* A_, const bf16* Bt_, int M, int N, int K_, int G_, int c_) { A = A_; Bt = Bt_; K = K_; nM = M / BM; nN = N / BM; nwg = nM * nN; G = G_; c = c_; }
    __device__ __forceinline__ bool next(int i, Unit& u) const {
        if (i + i0 >= i1) return false;
        const long L = (long)(i + i0) * G + c; if (L >= nwg) return false;
        int wgid = (int)L; { const int q = nwg / NXCD, r = nwg % NXCD, xcd = wgid % NXCD, off = wgid / NXCD; wgid = (xcd < r ? xcd * (q + 1) : r * (q + 1) + (xcd - r) * q) + off; }
        const int nig = WGM * nN, gid = wgid / nig, fm = gid * WGM, gsz = (nM - fm) < WGM ? (nM - fm) : WGM;
        u.pm = fm + ((wgid % nig) % gsz); u.pn = (wgid % nig) / gsz; u.e = 0; u.rb = 0; return true;
    }
    __device__ __forceinline__ void a_ready(const Unit&) const {}
    __device__ __forceinline__ void done(const Unit&) const {}
    __device__ __forceinline__ const char* a_base(const Unit& u) const { return (const char*)A + (size_t)u.pm * BM * K * 2; }
    __device__ __forceinline__ const char* b_base(const Unit& u) const { return (const char*)Bt + (size_t)u.pn * BM * K * 2; }
    __device__ __forceinline__ void a_voff(const Unit&, const int (&R)[2], const int (&C)[2], unsigned (&v)[2][2]) const {
#pragma unroll
        for (int h = 0; h < 2; ++h)
#pragma unroll
            for (int i = 0; i < 2; ++i) v[h][i] = (unsigned)((h * HALF + R[i]) * K + C[i]) * 2u;
    }
};

typedef int v8i __attribute__((ext_vector_type(8)));
typedef int v4i __attribute__((ext_vector_type(4)));
template <class Epi, class Sched, bool ALIGN_EPI = true, bool FP8 = false>
__device__ __forceinline__ void gemm_phase(LAS unsigned char* lds, const int K, const Sched& S, const Epi& E, const int wave) {
    const int lane = lane_now(), wid = wave, tid = wid * 64 + lane,
              wr = wid >> 2, wc = wid & 3, fr = lane & 15, fq = lane >> 4;
    const int nt = K / BK;
    int Rr[2], Cc[2]; unsigned voffB[2];
#pragma unroll
    for (int i = 0; i < 2; ++i) { stage_rc(tid * 16 + i * 8192, Rr[i], Cc[i]); const int Rb = Epi::PERM ? ((Rr[i] & ~31) + perm32(Rr[i] & 31)) : Rr[i];
        voffB[i] = (unsigned)(Rb * K + Cc[i]) * 2u; }
    const size_t kstep = (size_t)(BK * 2);
    const size_t hstep = (size_t)HALF * K * 2;
    const unsigned ldsw = (unsigned)wid * 1024u;
    const unsigned ldsbase = (unsigned)__builtin_amdgcn_readfirstlane((int)(unsigned)(size_t)lds);
    const int aoff = lds_byte(wr * 64 + fr, fq * 8), boff = lds_byte(wc * 32 + fr, fq * 8);
#define PG8_SA(b, h) (((b) * 2 + (h)) * HTB)
#define PG8_SB(b, h) ((4 + (b) * 2 + (h)) * HTB)
#define PG8_STAGE(bufoff, gbase, voff) do { _Pragma("unroll") for (int _i = 0; _i < 2; ++_i) { unsigned _keep; \
        asm volatile("s_mov_b32 %0, m0\n\ts_mov_b32 m0, %3\n\ts_nop 0\n\tglobal_load_lds_dwordx4 %1, %2\n\ts_mov_b32 m0, %0" : "=&s"(_keep) : "v"((voff)[_i]), "s"((const char*)(gbase)), "s"(ldsbase + (unsigned)(bufoff) + ldsw + (unsigned)(_i * 8192)) : "memory"); } } while (0)
#define PG8_LDA(dst, b, h) do { _Pragma("unroll") for (int m = 0; m < 4; ++m) _Pragma("unroll") for (int k = 0; k < 2; ++k) dst[m][k] = *(const LAS bf16x8*)(lds + PG8_SA(b, h) + aoff + m * 2048 + k * 1024); } while (0)
#define PG8_LDB(dst, b, h) do { _Pragma("unroll") for (int n = 0; n < 2; ++n) _Pragma("unroll") for (int k = 0; k < 2; ++k) dst[n][k] = *(const LAS bf16x8*)(lds + PG8_SB(b, h) + boff + n * 2048 + k * 1024); } while (0)
#define PG8_LDA8(dst, b, h) do { _Pragma("unroll") for (int m = 0; m < 4; ++m) { const v4i lo_ = *(const LAS v4i*)(lds + PG8_SA(b, h) + aoff + m * 2048), hi_ = *(const LAS v4i*)(lds + PG8_SA(b, h) + aoff + m * 2048 + 1024); dst[m] = __builtin_shufflevector(lo_, hi_, 0, 1, 2, 3, 4, 5, 6, 7); } } while (0)
#define PG8_LDB8(dst, b, h) do { _Pragma("unroll") for (int n = 0; n < 2; ++n) { const v4i lo_ = *(const LAS v4i*)(lds + PG8_SB(b, h) + boff + n * 2048), hi_ = *(const LAS v4i*)(lds + PG8_SB(b, h) + boff + n * 2048 + 1024); dst[n] = __builtin_shufflevector(lo_, hi_, 0, 1, 2, 3, 4, 5, 6, 7); } } while (0)
#define PG8_MMA(ai, bj, At, Bt) do { __builtin_amdgcn_s_setprio(1); _Pragma("unroll") for (int m = 0; m < 4; ++m) _Pragma("unroll") for (int n = 0; n < 2; ++n) _Pragma("unroll") for (int k = 0; k < 2; ++k) \
        acc[ai][bj][m][n] = __builtin_amdgcn_mfma_f32_16x16x32_bf16(Bt[n][k], At[m][k], acc[ai][bj][m][n], 0, 0, 0); __builtin_amdgcn_s_setprio(0); } while (0)
#define PG8_MMA8(ai, bj, At, Bt) do { __builtin_amdgcn_s_setprio(1); _Pragma("unroll") for (int m = 0; m < 4; ++m) _Pragma("unroll") for (int n = 0; n < 2; ++n) \
        acc[ai][bj][m][n] = __builtin_amdgcn_mfma_scale_f32_16x16x128_f8f6f4(Bt[n], At[m], acc[ai][bj][m][n], 0, 0, 0, 0, 0, 0); __builtin_amdgcn_s_setprio(0); } while (0)
#define LDA_(b, h) do { if constexpr (FP8) PG8_LDA8(At8, b, h); else PG8_LDA(At, b, h); } while (0)
#define LDB0_(b, h) do { if constexpr (FP8) PG8_LDB8(B08, b, h); else PG8_LDB(B0, b, h); } while (0)
#define LDB1_(b, h) do { if constexpr (FP8) PG8_LDB8(B18, b, h); else PG8_LDB(B1, b, h); } while (0)
#define MMA0_(ai, bj) do { if constexpr (FP8) PG8_MMA8(ai, bj, At8, B08); else PG8_MMA(ai, bj, At, B0); } while (0)
#define MMA1_(ai, bj) do { if constexpr (FP8) PG8_MMA8(ai, bj, At8, B18); else PG8_MMA(ai, bj, At, B1); } while (0)
#define PG8_WAIT_V(n) asm volatile("s_waitcnt vmcnt(" #n ")" ::: "memory")
#define PG8_WAIT_L(n) asm volatile("s_waitcnt lgkmcnt(" #n ")" ::: "memory")
#define PG8_BAR __builtin_amdgcn_s_barrier()
#define PG8_SCHED __builtin_amdgcn_sched_barrier(0)
    Unit cur, nxt; int ui = 0;
    if (!S.next(0, cur)) return;
    f32x4 acc[2][2][4][2];
#pragma unroll
    for (int a = 0; a < 2; ++a)
#pragma unroll
        for (int b = 0; b < 2; ++b)
#pragma unroll
            for (int m = 0; m < 4; ++m)
#pragma unroll
                for (int n = 0; n < 2; ++n) acc[a][b][m][n] = (f32x4){0.f, 0.f, 0.f, 0.f};
    bf16x8 At[4][2], B0[2][2], B1[2][2]; v8i At8[4], B08[2], B18[2];
    const char* cA = S.a_base(cur); const char* cB = S.b_base(cur);
    S.a_ready(cur);
    constexpr bool GATHER = Sched::GATHER;
    unsigned vA[1][2];
    LAS unsigned* goff = (LAS unsigned*)(lds + STAGE_BYTES) + tid;
    int gslot = 0;
    constexpr bool LOFF = GATHER || FP8;
    if constexpr (!GATHER && FP8) { goff[8 * 512] = voffB[0]; goff[9 * 512] = voffB[1]; goff[10 * 512] = (unsigned)(Rr[0] * K + Cc[0]) * 2u; goff[11 * 512] = (unsigned)(Rr[1] * K + Cc[1]) * 2u; }
    if constexpr (GATHER) { unsigned t4[2][2]; S.a_voff(cur, Rr, Cc, t4); goff[0 * 512] = t4[0][0]; goff[1 * 512] = t4[0][1]; goff[2 * 512] = t4[1][0]; goff[3 * 512] = t4[1][1]; goff[8 * 512] = voffB[0]; goff[9 * 512] = voffB[1]; }
    else {
#pragma unroll
        for (int i = 0; i < 2; ++i) vA[0][i] = (unsigned)(Rr[i] * K + Cc[i]) * 2u; }
    const size_t ahstep = GATHER ? 0 : hstep;
#define PG8_STAGE_B(bufoff, kptr) do { if constexpr (LOFF) { unsigned _o[2]; _o[0] = goff[8 * 512]; _o[1] = goff[9 * 512]; PG8_STAGE(bufoff, kptr, _o); } else PG8_STAGE(bufoff, kptr, voffB); } while (0)
#define PG8_STAGE_A(bufoff, kptr, h, nx) do { if constexpr (GATHER) { unsigned _o[2]; const int _s = (gslot ^ (nx)) * 2048 + (h) * 1024; _o[0] = goff[_s]; _o[1] = goff[_s + 512]; PG8_STAGE(bufoff, kptr, _o); } \
        else if constexpr (FP8) { unsigned _o[2]; _o[0] = goff[10 * 512]; _o[1] = goff[11 * 512]; PG8_STAGE(bufoff, (kptr) + (h) * ahstep, _o); } \
        else PG8_STAGE(bufoff, (kptr) + (h) * ahstep, vA[0]); } while (0)
    PG8_STAGE(PG8_SB(0, 0), cB, voffB); PG8_STAGE(PG8_SB(0, 1), cB + hstep, voffB); PG8_STAGE_A(PG8_SA(0, 0), cA, 0, 0); PG8_STAGE_A(PG8_SA(0, 1), cA, 1, 0);
    if (wr == 1) PG8_BAR;
    PG8_WAIT_V(2); PG8_BAR;
    PG8_STAGE(PG8_SB(1, 0), cB + kstep, voffB); PG8_STAGE_A(PG8_SA(1, 0), cA + kstep, 0, 0); PG8_STAGE(PG8_SB(1, 1), cB + hstep + kstep, voffB);
    PG8_WAIT_V(6); PG8_BAR;
    for (;;) {
        const bool has_next = S.next(ui + 1, nxt);
        const char* nA = has_next ? S.a_base(nxt) : cA; const char* nB = has_next ? S.b_base(nxt) : cB;
        if constexpr (GATHER) { if (has_next) { unsigned t4[2][2]; int tl_ = tid; asm volatile("" : "+v"(tl_)); int R2[2], C2[2]; stage_rc(tl_ * 16, R2[0], C2[0]); stage_rc(tl_ * 16 + 8192, R2[1], C2[1]); S.a_voff(nxt, R2, C2, t4); const int o = (gslot ^ 1) * 2048; goff[o] = t4[0][0]; goff[o + 512] = t4[0][1]; goff[o + 1024] = t4[1][0]; goff[o + 1536] = t4[1][1]; } }
#pragma unroll 1
        for (int t = 0; t < nt; t += 2) {
            const bool last = (t == nt - 2);
            const char* a1 = cA + (size_t)(t + 1) * kstep;
            const char* a2 = last ? nA : cA + (size_t)(t + 2) * kstep; const char* b2 = last ? nB : cB + (size_t)(t + 2) * kstep;
            const char* a3 = a2 + kstep; const char* b3 = b2 + kstep;
            if (last && has_next) S.a_ready(nxt);
            const int nx = (last && has_next) ? 1 : 0;
            LDB0_(0, 0); LDB1_(0, 1); PG8_SCHED; LDA_(0, 0); PG8_STAGE_A(PG8_SA(1, 1), a1, 1, 0);
            PG8_WAIT_V(8); PG8_WAIT_L(0); PG8_BAR; MMA0_(0, 0); MMA1_(0, 1); PG8_BAR; PG8_SCHED;
            LDA_(0, 1); PG8_STAGE_B(PG8_SB(0, 0), b2); PG8_STAGE_B(PG8_SB(0, 1), b2 + hstep); PG8_STAGE_A(PG8_SA(0, 0), a2, 0, nx);
            PG8_WAIT_V(8); PG8_WAIT_L(0); PG8_BAR; MMA0_(1, 0); MMA1_(1, 1); PG8_BAR; PG8_SCHED;
            LDB0_(1, 0); LDB1_(1, 1); PG8_SCHED; LDA_(1, 0); PG8_STAGE_A(PG8_SA(0, 1), a2, 1, nx);
            PG8_WAIT_V(8); PG8_WAIT_L(0); PG8_BAR; MMA0_(0, 0); MMA1_(0, 1); PG8_BAR; PG8_SCHED;
            LDA_(1, 1); PG8_STAGE_B(PG8_SB(1, 0), b3); PG8_STAGE_B(PG8_SB(1, 1), b3 + hstep); PG8_STAGE_A(PG8_SA(1, 0), a3, 0, nx);
            PG8_WAIT_V(8); PG8_WAIT_L(0); PG8_BAR; MMA0_(1, 0); MMA1_(1, 1); PG8_BAR; PG8_SCHED;
        }
        if constexpr (ALIGN_EPI) { if (wr == 0) PG8_BAR; }
        { int fr2 = fr, fq2 = fq; asm volatile("" : "+v"(fr2), "+v"(fq2));
          E(acc, cur, wr, wc, fr2, fq2); } S.done(cur);
        if (!has_next) break;
#pragma unroll
        for (int a = 0; a < 2; ++a)
#pragma unroll
            for (int b = 0; b < 2; ++b)
#pragma unroll
                for (int m = 0; m < 4; ++m)
#pragma unroll
                    for (int n = 0; n < 2; ++n) acc[a][b][m][n] = (f32x4){0.f, 0.f, 0.f, 0.f};
        cur = nxt; cA = nA; cB = nB; ++ui;
        if constexpr (GATHER) gslot ^= 1;
        if constexpr (ALIGN_EPI) { if (wr == 1) PG8_BAR; }
    }
    PG8_WAIT_V(0);
    if constexpr (!ALIGN_EPI) { if (wr == 0) PG8_BAR; }
    PG8_BAR;
#undef PG8_SA
#undef PG8_SB
#undef PG8_STAGE
#undef PG8_STAGE_A
#undef PG8_STAGE_B
#undef PG8_LDA
#undef PG8_LDB
#undef PG8_MMA
#undef PG8_MMA8
#undef PG8_LDA8
#undef PG8_LDB8
#undef LDA_
#undef LDB0_
#undef LDB1_
#undef MMA0_
#undef MMA1_
#undef PG8_WAIT_V
#undef PG8_WAIT_L
#undef PG8_BAR
#undef PG8_SCHED
}

struct EpiProj {
    static constexpr bool PERM = true;
    bf16* O; float asc;
    __device__ __forceinline__ void operator()(const f32x4 (&acc)[2][2][4][2], const Unit& u, int wr, int wc, int fr, int fq) const {
        const int row0 = u.pm * BM + wr * 64 + fr, col0 = u.pn * BM + wc * 32 + 8 * fq;
        const bool act = u.pn < 4;
#pragma unroll
        for (int ai = 0; ai < 2; ++ai)
#pragma unroll
            for (int m = 0; m < 4; ++m) { bf16* rowp = O + (size_t)(row0 + ai * HALF + m * 16) * DIN + col0;
#pragma unroll
                for (int bj = 0; bj < 2; ++bj) { f32x4 v0 = acc[ai][bj][m][0] * asc, v1 = acc[ai][bj][m][1] * asc;
                    if (act) {
#pragma unroll
                        for (int j = 0; j < 4; ++j) { v0[j] = gelu_tanh(v0[j]); v1[j] = gelu_tanh(v1[j]); } }
                    u32x4 w; w.x = cvt_pk_bf16(v0[0], v0[1]); w.y = cvt_pk_bf16(v0[2], v0[3]); w.z = cvt_pk_bf16(v1[0], v1[1]); w.w = cvt_pk_bf16(v1[2], v1[3]);
                    *(u32x4*)(rowp + bj * HALF) = w; } }
    }
};
template <bool RES_BF16> struct EpiResid {
    static constexpr bool PERM = true; static constexpr float ASC = OP8(RES_BF16 ? 1 : 0) ? 1.f / WOUT_SCALE : 1.f;
    const void* res; bf16* out;
    __device__ __forceinline__ void operator()(const f32x4 (&acc)[2][2][4][2], const Unit& u, int wr, int wc, int fr, int fq) const {
        const int row0 = u.pm * BM + wr * 64 + fr, col0 = u.pn * BM + wc * 32 + 8 * fq;
#pragma unroll
        for (int ai = 0; ai < 2; ++ai) {
            if constexpr (RES_BF16) {
                u32x4 r[4][2];
#pragma unroll
                for (int m = 0; m < 4; ++m)
#pragma unroll
                    for (int bj = 0; bj < 2; ++bj) r[m][bj] = __builtin_nontemporal_load((const u32x4*)((const bf16*)res + (size_t)(row0 + ai * HALF + m * 16) * DM + col0 + bj * HALF));
                asm volatile("s_waitcnt vmcnt(0)" ::: "memory");
#pragma unroll
                for (int m = 0; m < 4; ++m)
#pragma unroll
                    for (int bj = 0; bj < 2; ++bj) { f32x4 v0 = acc[ai][bj][m][0] * ASC, v1 = acc[ai][bj][m][1] * ASC; const u32x4 q = r[m][bj];
                        v0[0] += bf_lo(q.x); v0[1] += bf_hi(q.x); v0[2] += bf_lo(q.y); v0[3] += bf_hi(q.y); v1[0] += bf_lo(q.z); v1[1] += bf_hi(q.z); v1[2] += bf_lo(q.w); v1[3] += bf_hi(q.w);
                        u32x4 w; w.x = cvt_pk_bf16(v0[0], v0[1]); w.y = cvt_pk_bf16(v0[2], v0[3]); w.z = cvt_pk_bf16(v1[0], v1[1]); w.w = cvt_pk_bf16(v1[2], v1[3]);
                        *(u32x4*)(out + (size_t)(row0 + ai * HALF + m * 16) * DM + col0 + bj * HALF) = w; }
            } else {
#pragma unroll
                for (int mh = 0; mh < 2; ++mh) {
                    f32x4 r[2][2][2];
#pragma unroll
                    for (int m = 0; m < 2; ++m)
#pragma unroll
                        for (int bj = 0; bj < 2; ++bj) { const float* rp = (const float*)res + (size_t)(row0 + ai * HALF + (2 * mh + m) * 16) * DM + col0 + bj * HALF; r[m][bj][0] = __builtin_nontemporal_load((const f32x4*)rp); r[m][bj][1] = __builtin_nontemporal_load((const f32x4*)(rp + 4)); }
                    asm volatile("s_waitcnt vmcnt(0)" ::: "memory");
#pragma unroll
                    for (int m = 0; m < 2; ++m)
#pragma unroll
                        for (int bj = 0; bj < 2; ++bj) { const f32x4 v0 = acc[ai][bj][2 * mh + m][0] * ASC + r[m][bj][0], v1 = acc[ai][bj][2 * mh + m][1] * ASC + r[m][bj][1];
                            u32x4 w; w.x = cvt_pk_bf16(v0[0], v0[1]); w.y = cvt_pk_bf16(v0[2], v0[3]); w.z = cvt_pk_bf16(v1[0], v1[1]); w.w = cvt_pk_bf16(v1[2], v1[3]);
                            *(u32x4*)(out + (size_t)(row0 + ai * HALF + (2 * mh + m) * 16) * DM + col0 + bj * HALF) = w; }
                }
            }
        }
    }
};
struct EpiSwiGLU {
    static constexpr bool PERM = true;
    unsigned char* HB; const float* rslot;
    __device__ __forceinline__ void operator()(const f32x4 (&acc)[2][2][4][2], const Unit& u, int wr, int wc, int fr, int fq) const {
        const int row0 = u.pm * BM + wr * 64 + fr, col0 = u.pn * HALF + wc * 32 + 8 * fq;
        const __amdgpu_buffer_rsrc_t rsrc = __builtin_amdgcn_make_buffer_rsrc((void*)HB, 0, 40960 * DE, 0x00020000);
        const float* rsl = rslot + (size_t)u.e * TOKCAP + u.rb * BM + wr * 64 + fr;
#pragma unroll
        for (int ai = 0; ai < 2; ++ai) {
            float rsv[4];
#pragma unroll
            for (int m = 0; m < 4; ++m) rsv[m] = rsl[ai * HALF + m * 16];
            asm volatile("s_waitcnt vmcnt(0)" ::: "memory");
#pragma unroll
            for (int m = 0; m < 4; ++m) { const unsigned boff = (unsigned)((row0 + ai * HALF + m * 16) * DE + col0);
                const float rs = rsv[m] * (1.f / W1_SCALE);
                float h[8];
#pragma unroll
                for (int n = 0; n < 2; ++n)
#pragma unroll
                    for (int j = 0; j < 4; ++j) { const float g = acc[ai][0][m][n][j] * rs, up = acc[ai][1][m][n][j] * rs; h[n * 4 + j] = g * sigmoidf_(g) * up; }
                u32x2 w; w.x = pk4_fp8(h[0], h[1], h[2], h[3]); w.y = pk4_fp8(h[4], h[5], h[6], h[7]);
                __builtin_amdgcn_raw_buffer_store_b64(w, rsrc, boff, 0, 16); } }
    }
};
struct EpiY {
    static constexpr bool PERM = true;
    unsigned char* Y;
    __device__ __forceinline__ void operator()(const f32x4 (&acc)[2][2][4][2], const Unit& u, int wr, int wc, int fr, int fq) const {
        const int row0 = u.pm * BM + wr * 64 + fr, col0 = u.pn * BM + wc * 32 + 8 * fq;
#pragma unroll
        for (int ai = 0; ai < 2; ++ai)
#pragma unroll
            for (int m = 0; m < 4; ++m) { unsigned char* rowp = Y + (size_t)(row0 + ai * HALF + m * 16) * DM + col0;
#pragma unroll
                for (int bj = 0; bj < 2; ++bj) { const f32x4 v0 = acc[ai][bj][m][0] * (Y_SCALE / W2_SCALE), v1 = acc[ai][bj][m][1] * (Y_SCALE / W2_SCALE);
                    u32x2 w; w.x = pk4_fp8(v0[0], v0[1], v0[2], v0[3]); w.y = pk4_fp8(v1[0], v1[1], v1[2], v1[3]);
                    *(u32x2*)(rowp + bj * HALF) = w; } }
    }
};

struct SchedG1 {
    static constexpr bool GATHER = true;
    const LAS int* tstart; const int* cnt; const int* tok; const bf16* X; const bf16* W1; int G, c; unsigned* ready;
    __device__ __forceinline__ void a_ready(const Unit&) const {}
    __device__ __forceinline__ void done(const Unit& u) const {
        asm volatile("s_waitcnt vmcnt(0)" ::: "memory");
        if (lane_now() == 0) __hip_atomic_fetch_add(ready + 64 * u.pm, 1u, __ATOMIC_RELAXED, __HIP_MEMORY_SCOPE_AGENT);
    }
    __device__ __forceinline__ bool next(int i, Unit& u) const {
        const int L = i * G + c, NT = __builtin_amdgcn_readfirstlane(tstart[NE]); if (L >= NT * 4) return false;
        const int T = L >> 2; const int e = tstart[560 + T];
        u.pm = __builtin_amdgcn_readfirstlane(T); u.pn = L & 3; u.e = __builtin_amdgcn_readfirstlane(e); u.rb = __builtin_amdgcn_readfirstlane(T - tstart[e]); return true;
    }
    static constexpr int KU = DM / 2;
    __device__ __forceinline__ const char* a_base(const Unit&) const { return (const char*)X; }
    __device__ __forceinline__ const char* b_base(const Unit& u) const { return (const char*)W1 + ((size_t)u.e * 1024 + (size_t)u.pn * BM) * DM; }
    __device__ __forceinline__ void a_voff(const Unit& u, const int (&R)[2], const int (&C)[2], unsigned (&v)[2][2]) const {
        const int n = cnt[u.e * 64]; const int* tl = tok + (size_t)u.e * TOKCAP;
#pragma unroll
        for (int h = 0; h < 2; ++h)
#pragma unroll
            for (int i = 0; i < 2; ++i) { int row = u.rb * BM + h * HALF + R[i]; row = row < n ? row : 0; const int t = tl[row]; v[h][i] = (unsigned)(t * KU + C[i]) * 2u; }
    }
};
struct SchedG2 {
    static constexpr bool GATHER = false;
    const LAS int* tstart; const bf16* HB; const bf16* W2; int G, c; unsigned* ready; unsigned* tmo; int wave;
    __device__ __forceinline__ bool next(int i, Unit& u) const {
        constexpr int K0 = 3;
        const int NT = __builtin_amdgcn_readfirstlane(tstart[NE]), n1 = 4 * NT, n1max = (n1 + G - 1) / G, R = n1 - G * (n1max - 1), nB = G - R;
        int L;
        if (c >= R) L = (i < K0) ? i * nB + (c - R) : K0 * nB + (i - K0) * G + c;
        else L = K0 * nB + i * G + c;
        if (L >= NT * 8) return false;
        const int T = L >> 3; const int e = tstart[560 + T];
        u.pm = __builtin_amdgcn_readfirstlane(T); u.pn = __builtin_amdgcn_readfirstlane(L & 7); u.e = __builtin_amdgcn_readfirstlane(e); u.rb = __builtin_amdgcn_readfirstlane(T - tstart[e]); return true;
    }
    __device__ __forceinline__ void done(const Unit&) const {}
    __device__ __forceinline__ void a_ready(const Unit& u) const {
        if (wave == 0) {
            unsigned polls = 0;
            while ((unsigned)__builtin_amdgcn_readfirstlane(__hip_atomic_load(ready + 64 * u.pm, __ATOMIC_RELAXED, __HIP_MEMORY_SCOPE_AGENT)) < 32u) {
                if (++polls > (1u << 22)) { if (lane_now() == 0) __hip_atomic_store(tmo, 0x600u | (unsigned)(u.pm & 0xff), __ATOMIC_RELAXED, __HIP_MEMORY_SCOPE_AGENT); break; }
                __builtin_amdgcn_s_sleep(2); }
            __builtin_amdgcn_fence(__ATOMIC_ACQUIRE, "agent");
            asm volatile("s_waitcnt vmcnt(0)" ::: "memory");
        }
        asm volatile("" ::: "memory"); __builtin_amdgcn_s_barrier(); asm volatile("" ::: "memory");
    }
    __device__ __forceinline__ const char* a_base(const Unit& u) const { return (const char*)HB + (size_t)u.pm * BM * DE; }
    __device__ __forceinline__ const char* b_base(const Unit& u) const { return (const char*)W2 + ((size_t)u.e * DM + (size_t)u.pn * BM) * DE; }
    __device__ __forceinline__ void a_voff(const Unit&, const int (&R)[2], const int (&C)[2], unsigned (&v)[2][2]) const {
#pragma unroll
        for (int h = 0; h < 2; ++h)
#pragma unroll
            for (int i = 0; i < 2; ++i) v[h][i] = (unsigned)((h * HALF + R[i]) * DE + C[i]) * 2u;
    }
};
}

struct Params { const float* in[22]; float* out; unsigned char* ws; int ph_lo, ph_hi; };
enum { IN_X = 0, IN_NORM1, IN_WIN, IN_SGUN, IN_SGUW, IN_SGUB, IN_CONVW, IN_CONVB, IN_LNG, IN_LNB, IN_QN, IN_KN, IN_OUTN, IN_WOUT, IN_NORM2, IN_WRG, IN_BRG, IN_WRE, IN_BRE, IN_WG, IN_WU, IN_WD };

struct Frame {
    LAS unsigned char* lds; volatile LAS unsigned* MISC;
    int tid, lane, wave, vcu, G;
    const float* const* in; float* out; unsigned char* ws;
};

__device__ __forceinline__ void tile_desc(const float* const* in, unsigned char* ws, int it, const float*& src, int& ldw, unsigned char*& dst, int& pitch, const float*& ksc, float& wsc, int& fp8) {
    constexpr int T_IN = 32 * 80, T_OUT = 32 * 32, T_E = 32 * 8, T_D = 8 * 32;
    constexpr int T_LAYER = T_IN + T_OUT + NE * (2 * T_E + T_D);
    const int l = it / T_LAYER; int r = it % T_LAYER; ksc = nullptr; wsc = 1.f; fp8 = 0;
    if (r < T_IN) { ldw = DIN;
        if (IP8(l)) { const int kb = r / 160, nb = r % 160; pitch = DM; fp8 = 1; wsc = WIN_SCALE; src = in[IN_WIN] + (size_t)l * DM * DIN + (size_t)(128 * kb) * DIN + 32 * nb; dst = ws + WS_WIN + (size_t)l * DIN * DM * 2 + ((size_t)32 * nb) * DM + 128 * kb; }
        else { const int kb = r / 80, nb = r % 80; pitch = DM * 2; src = in[IN_WIN] + (size_t)l * DM * DIN + (size_t)(64 * kb) * DIN + 64 * nb; dst = ws + WS_WIN + (((size_t)l * DIN + 64 * nb) * DM + 64 * kb) * 2; }
        return; } r -= T_IN;
    if (r < T_OUT) { const int kb = r / 32, nb = r % 32; ldw = DM; src = in[IN_WOUT] + (size_t)l * DM * DM + (size_t)(64 * kb) * DM + 64 * nb;
        if (OP8(l)) { const int kb8 = r / 64, nb8 = r % 64; pitch = DM; fp8 = 1; wsc = WOUT_SCALE; src = in[IN_WOUT] + (size_t)l * DM * DM + (size_t)(128 * kb8) * DM + 32 * nb8; dst = ws + WS_WOUT + (size_t)l * DM * DM * 2 + ((size_t)32 * nb8) * DM + 128 * kb8; } else { pitch = DM * 2; dst = ws + WS_WOUT + (((size_t)l * DM + 64 * nb) * DM + 64 * kb) * 2; }
        return; } r -= T_OUT;
    const int e = r / (2 * T_E + T_D); r %= (2 * T_E + T_D);
    const size_t le = (size_t)l * NE + e; fp8 = 1;
    if (r < 2 * T_E) { const int up = r >= T_E; r -= up * T_E; const int kb = r / 16, nb = r % 16, n0 = 32 * nb; ldw = DE; pitch = DM; wsc = W1_SCALE;
        src = (up ? in[IN_WU] : in[IN_WG]) + le * DM * DE + (size_t)(128 * kb) * DE + n0; dst = ws + WS_W1 + (le * 1024 + (size_t)((n0 / 128) * 256 + up * 128 + (n0 % 128))) * DM + 128 * kb; ksc = in[IN_NORM2] + (size_t)l * DM + 128 * kb; return; }
    r -= 2 * T_E;
    { const int kb = r / 64, nb = r % 64; ldw = DM; pitch = DE; wsc = W2_SCALE; src = in[IN_WD] + le * DE * DM + (size_t)(128 * kb) * DM + 32 * nb; dst = ws + WS_W2 + (le * DM + 32 * nb) * DE + 128 * kb; }
}
#define TR_LOAD(V, src, ldw, fp8) do { if (fp8) { _Pragma("unroll") for (int i = 0; i < 16; ++i) V[i] = __builtin_nontemporal_load((const f32x4*)((src) + (size_t)(8 * i + (lane >> 3)) * (ldw) + 4 * (lane & 7))); } \
    else { _Pragma("unroll") for (int i = 0; i < 16; ++i) V[i] = __builtin_nontemporal_load((const f32x4*)((src) + (size_t)(4 * i + (lane >> 4)) * (ldw) + 4 * (lane & 15))); } } while (0)
#define TR_PROC(V, dst, pitch, ksc, wsc, fp8) do { \
    if (fp8) {        \
        _Pragma("unroll") for (int i = 0; i < 16; ++i) { const int kk = 8 * i + (lane >> 3); f32x4 v = V[i] * ((ksc) ? (ksc)[kk] * (wsc) : (wsc)); \
            LAS float* d = scr + kk * 33 + 4 * (lane & 7); d[0] = v[0]; d[1] = v[1]; d[2] = v[2]; d[3] = v[3]; } \
        LDS_WAIT(); \
        _Pragma("unroll") for (int j = 0; j < 8; ++j) { const int n = (lane >> 4) + 4 * j; const LAS float* sp = scr + (8 * (lane & 15)) * 33 + n; \
            u32x2 o; o.x = pk4_fp8(sp[0], sp[33], sp[2 * 33], sp[3 * 33]); o.y = pk4_fp8(sp[4 * 33], sp[5 * 33], sp[6 * 33], sp[7 * 33]); __builtin_nontemporal_store(o, (u32x2*)((dst) + (size_t)n * (pitch) + 8 * (lane & 15))); }     \
    } else { \
        _Pragma("unroll") for (int i = 0; i < 16; ++i) { const int kk = 4 * i + (lane >> 4); f32x4 v = V[i] * ((ksc) ? (ksc)[kk] * (wsc) : (wsc)); \
            LAS float* d = scr + kk * 65 + 4 * (lane & 15); d[0] = v[0]; d[1] = v[1]; d[2] = v[2]; d[3] = v[3]; } \
        LDS_WAIT(); \
        _Pragma("unroll") for (int j = 0; j < 8; ++j) { const int n = (lane >> 3) + 8 * j; const LAS float* sp = scr + (8 * (lane & 7)) * 65 + n; \
            u32x4 o; o.x = cvt_pk_bf16(sp[0], sp[65]); o.y = cvt_pk_bf16(sp[2 * 65], sp[3 * 65]); o.z = cvt_pk_bf16(sp[4 * 65], sp[5 * 65]); o.w = cvt_pk_bf16(sp[6 * 65], sp[7 * 65]); \
            *(u32x4*)((dst) + (size_t)n * (pitch) + 16 * (lane & 7)) = o; } } \
    LDS_WAIT(); } while (0)
__device__ __forceinline__ void norm_row_bf16(const float* xrow, const float* g, bf16* orow, int lane) {
    f32x4 v[8]; float s = 0.f;
#pragma unroll
    for (int j = 0; j < 8; ++j) { v[j] = __builtin_nontemporal_load((const f32x4*)(xrow + 4 * lane + 256 * j)); s += (v[j][0] * v[j][0] + v[j][1] * v[j][1]) + (v[j][2] * v[j][2] + v[j][3] * v[j][3]); }
    const float rs = __builtin_amdgcn_rsqf(wave_sum(s) * (1.f / DM) + EPS);
#pragma unroll
    for (int j = 0; j < 8; ++j) { const f32x4 gg = *(const f32x4*)(g + 4 * lane + 256 * j);
        u32x2 o; o.x = cvt_pk_bf16(v[j][0] * rs * gg[0], v[j][1] * rs * gg[1]); o.y = cvt_pk_bf16(v[j][2] * rs * gg[2], v[j][3] * rs * gg[3]);
        *(u32x2*)(orow + 4 * lane + 256 * j) = o; }
}
constexpr int CV_P = 2560, CV_A = 28160 + 3584, CV_B = 2 * 28160;
__device__ __forceinline__ void convert_tiles(Frame& F, const int t_lo, const int T_TOTAL) {
    LAS float* scr = (LAS float*)(F.lds + F.wave * 16896);
    const int gw = F.vcu * NWAVES + F.wave, NGW = F.G * NWAVES, lane = F.lane;
    {
        f32x4 va[16], vb[16];
        const float* srcA; const float* srcB; unsigned char* dstA; unsigned char* dstB; const float* kA; const float* kB; int ldA, ldB, pA, pB, fA, fB; float wA, wB;
        int it = t_lo + gw;
        if (it < T_TOTAL) { tile_desc(F.in, F.ws, it, srcA, ldA, dstA, pA, kA, wA, fA); TR_LOAD(va, srcA, ldA, fA); }
        while (it < T_TOTAL) {
            const int itb = it + NGW;
            if (itb < T_TOTAL) { tile_desc(F.in, F.ws, itb, srcB, ldB, dstB, pB, kB, wB, fB); TR_LOAD(vb, srcB, ldB, fB); }
            TR_PROC(va, dstA, pA, kA, wA, fA);
            if (itb >= T_TOTAL) break;
            const int ita = itb + NGW;
            if (ita < T_TOTAL) { tile_desc(F.in, F.ws, ita, srcA, ldA, dstA, pA, kA, wA, fA); TR_LOAD(va, srcA, ldA, fA); }
            TR_PROC(vb, dstB, pB, kB, wB, fB);
            it = ita;
        }
    }
}
__device__ __forceinline__ void p_prologue(Frame& F) {
    const int gw = F.vcu * NWAVES + F.wave, NGW = F.G * NWAVES;
    convert_tiles(F, 0, CV_P);
    { bf16* SW = (bf16*)(F.ws + WS_SGUW); const int gt = gw * 64 + F.lane, NGT = NGW * 64;
      for (int idx = gt; idx < NLAYER * 4 * 8 * 4 * 64; idx += NGT) {
          const int ln = idx & 63, pp = (idx >> 6) & 3, itile = (idx >> 8) & 7, h = (idx >> 11) & 3, l = idx >> 13;
          const int i = 16 * itile + (ln & 15), gq = ln >> 4;
          const float* w = F.in[IN_SGUW] + ((size_t)(l * 4 + h) * 128 + i) * 128;
          float v[8];
#pragma unroll
          for (int jj = 0; jj < 8; ++jj) { const int j = 32 * pp + (jj < 4 ? 4 * gq + jj : 16 + 4 * gq + (jj - 4)); v[jj] = (j <= i) ? w[j] : 0.f; }
          u32x4 o; o.x = cvt_pk_bf16(v[0], v[1]); o.y = cvt_pk_bf16(v[2], v[3]); o.z = cvt_pk_bf16(v[4], v[5]); o.w = cvt_pk_bf16(v[6], v[7]);
          *(u32x4*)(SW + (size_t)idx * 8) = o; }
      bf16* WRF = (bf16*)(F.ws + WS_WRT);
      for (int idx = gt; idx < NLAYER * 64 * 3 * 64; idx += NGT) { const int ln = idx & 63, ct = (idx >> 6) % 3, ks = (idx / 192) & 63, l = idx / (192 * 64);
          const int o = 16 * ct + (ln & 15), k0 = 32 * ks + 8 * (ln >> 4);
          float v[8];
#pragma unroll
          for (int j = 0; j < 8; ++j) { const int k = k0 + j; const float wv = o < 32 ? F.in[IN_WRE][((size_t)l * DM + k) * NE + o] : (o < 36 ? F.in[IN_WRG][((size_t)l * DM + k) * 4 + (o - 32)] : 0.f);
              v[j] = wv * F.in[IN_NORM2][(size_t)l * DM + k]; }
          u32x4 hi, lo; hi.x = cvt_pk_bf16(v[0], v[1]); hi.y = cvt_pk_bf16(v[2], v[3]); hi.z = cvt_pk_bf16(v[4], v[5]); hi.w = cvt_pk_bf16(v[6], v[7]);
          lo.x = cvt_pk_bf16(v[0] - bf_lo(hi.x), v[1] - bf_hi(hi.x)); lo.y = cvt_pk_bf16(v[2] - bf_lo(hi.y), v[3] - bf_hi(hi.y));
          lo.z = cvt_pk_bf16(v[4] - bf_lo(hi.z), v[5] - bf_hi(hi.z)); lo.w = cvt_pk_bf16(v[6] - bf_lo(hi.w), v[7] - bf_hi(hi.w));
          bf16* dst = WRF + ((((size_t)l * 64 + ks) * 3 + ct) * 2 * 64 + ln) * 8;
          *(u32x4*)dst = hi; *(u32x4*)(dst + 512) = lo; } }
    bf16* HN = (bf16*)(F.ws + WS_HN);
    for (int m = gw; m < SEQ; m += NGW) norm_row_bf16(F.in[IN_X] + (size_t)m * DM, F.in[IN_NORM1], HN + (size_t)m * DM, F.lane);
}

__device__ __forceinline__ int vimg_off(int row, int c) { return row * 256 + ((((c >> 1) ^ (row & 7)) << 1) | (c & 1)) * 16; }
__device__ __forceinline__ bf16x8 tr_frag(const LAS unsigned char* img, int ra, int rb, int dt, int lane) {
    const int gq = lane >> 4, q = (lane & 15) >> 2, p = lane & 3;
    const int r0 = ra + 4 * gq + q, r1 = rb + 4 * gq + q, c = 2 * dt + (p >> 1);
    const s16x4 a = __builtin_amdgcn_ds_read_tr16_b64_v4i16((LAS s16x4*)(img + vimg_off(r0, c) + 8 * (p & 1)));
    const s16x4 b = __builtin_amdgcn_ds_read_tr16_b64_v4i16((LAS s16x4*)(img + vimg_off(r1, c) + 8 * (p & 1)));
    bf16x8 r; r[0] = a[0]; r[1] = a[1]; r[2] = a[2]; r[3] = a[3]; r[4] = b[0]; r[5] = b[1]; r[6] = b[2]; r[7] = b[3]; return r;
}
__device__ __forceinline__ void sgu_stage8(const bf16* vsrc, int j0, int w, int lane, const f32x4& g0, const f32x4& g1, LAS unsigned char* lds) {
    u32x4 raw[8];
#pragma unroll
    for (int j = 0; j < 8; ++j) raw[j] = *(const u32x4*)(vsrc + (size_t)(w + 8 * (j0 + j)) * DIN);
#pragma unroll
    for (int j = 0; j < 8; ++j) { const int row = w + 8 * (j0 + j);
        float x[8] = {bf_lo(raw[j].x), bf_hi(raw[j].x), bf_lo(raw[j].y), bf_hi(raw[j].y), bf_lo(raw[j].z), bf_hi(raw[j].z), bf_lo(raw[j].w), bf_hi(raw[j].w)};
        float s = 0.f;
#pragma unroll
        for (int e = 0; e < 8; ++e) s += x[e] * x[e];
        const float rs = __builtin_amdgcn_rsqf(wave_sum(s) * (1.f / 512.f) + EPS);
        u32x4 o; o.x = cvt_pk_bf16(x[0] * rs * g0[0], x[1] * rs * g0[1]); o.y = cvt_pk_bf16(x[2] * rs * g0[2], x[3] * rs * g0[3]);
        o.z = cvt_pk_bf16(x[4] * rs * g1[0], x[5] * rs * g1[1]); o.w = cvt_pk_bf16(x[6] * rs * g1[2], x[7] * rs * g1[3]);
        *(LAS u32x4*)(lds + (lane >> 4) * 32768 + vimg_off(row, lane & 15)) = o; }
}
__device__ __forceinline__ void sgu_item(Frame& F, int l, int chunk, int half) {
    const bf16* PROJ = (const bf16*)(F.ws + WS_PROJ); bf16* MIX = (bf16*)(F.ws + WS_MIX);
    const int p0 = chunk * 128, lane = F.lane, w = F.wave;
    LAS float* red = (LAS float*)(F.lds + MISC_OFF + 256);
    const float* gn = F.in[IN_SGUN] + l * 512;
    const f32x4 g0 = *(const f32x4*)(gn + 8 * lane), g1 = *(const f32x4*)(gn + 8 * lane + 4);
    const bf16* vsrc = PROJ + (size_t)p0 * DIN + OFF_V + 8 * lane;
    sgu_stage8(vsrc, 0, w, lane, g0, g1, F.lds);
    if (half) sgu_stage8(vsrc, 8, w, lane, g0, g1, F.lds);
    const int h = w >> 1, ih = w & 1, gq = lane >> 4, fr = lane & 15;
    const LAS unsigned char* img = F.lds + h * 32768;
    const bf16* SW = (const bf16*)(F.ws + WS_SGUW) + (size_t)(l * 4 + h) * 8 * 4 * 64 * 8;
    const float* bs = F.in[IN_SGUB] + (size_t)(l * 4 + h) * 128;
    const float* og = F.in[IN_OUTN] + (size_t)l * DM + h * 128 + 4 * gq;
    const int it0 = ih + 4 * half;
    u32x2 ur[2][8];
#pragma unroll
    for (int ii = 0; ii < 2; ++ii) { const bf16* urow = PROJ + (size_t)(p0 + 16 * (it0 + 2 * ii) + fr) * DIN + OFF_U + h * 128 + 4 * gq;
#pragma unroll
        for (int dt = 0; dt < 8; ++dt) ur[ii][dt] = *(const u32x2*)(urow + 16 * dt); }
    __syncthreads();
    f32x4 z[2][8];
#pragma unroll
    for (int ii = 0; ii < 2; ++ii)
#pragma unroll
        for (int dt = 0; dt < 8; ++dt) z[ii][dt] = (f32x4){0.f, 0.f, 0.f, 0.f};
#pragma unroll 1
    for (int pp = 0; pp <= (it0 + 2) / 2; ++pp) {
        const bf16x8 bw0 = *(const bf16x8*)(SW + ((size_t)(it0 * 4 + pp) * 64 + lane) * 8);
        const bf16x8 bw1 = *(const bf16x8*)(SW + ((size_t)((it0 + 2) * 4 + pp) * 64 + lane) * 8);
        const bool do0 = pp <= it0 / 2;
#pragma unroll
        for (int dt = 0; dt < 8; ++dt) { const bf16x8 a = tr_frag(img, 32 * pp, 32 * pp + 16, dt, lane);
            if (do0) z[0][dt] = __builtin_amdgcn_mfma_f32_16x16x32_bf16(a, bw0, z[0][dt], 0, 0, 0);
            z[1][dt] = __builtin_amdgcn_mfma_f32_16x16x32_bf16(a, bw1, z[1][dt], 0, 0, 0); }
    }
#pragma unroll
    for (int ii = 0; ii < 2; ++ii) { const int i = 16 * (it0 + 2 * ii) + fr; const float bi = bs[i]; float s = 0.f;
#pragma unroll
        for (int dt = 0; dt < 8; ++dt) { const u32x2 u2 = ur[ii][dt];
            f32x4 y; y[0] = bf_lo(u2.x) * (z[ii][dt][0] + bi); y[1] = bf_hi(u2.x) * (z[ii][dt][1] + bi); y[2] = bf_lo(u2.y) * (z[ii][dt][2] + bi); y[3] = bf_hi(u2.y) * (z[ii][dt][3] + bi);
            z[ii][dt] = y; s += (y[0] * y[0] + y[1] * y[1]) + (y[2] * y[2] + y[3] * y[3]); }
        s += __shfl_xor(s, 16); s += __shfl_xor(s, 32);
        if (gq == 0) red[i * 4 + h] = s; }
    __syncthreads();
#pragma unroll
    for (int ii = 0; ii < 2; ++ii) { const int i = 16 * (it0 + 2 * ii) + fr;
        const f32x4 rr = *(const LAS f32x4*)(red + i * 4);
        const float rs = __builtin_amdgcn_rsqf(((rr[0] + rr[1]) + (rr[2] + rr[3])) * (1.f / 512.f) + EPS);
        bf16* orow = MIX + (size_t)(p0 + i) * DM + h * 128 + 4 * gq;
#pragma unroll
        for (int dt = 0; dt < 8; ++dt) { const f32x4 gg = *(const f32x4*)(og + 16 * dt); const f32x4 y = z[ii][dt];
            if (OP8(l)) *(unsigned*)((unsigned char*)MIX + (size_t)(p0 + i) * DM + h * 128 + 4 * gq + 16 * dt) = pk4_fp8(y[0] * rs * gg[0], y[1] * rs * gg[1], y[2] * rs * gg[2], y[3] * rs * gg[3]);
            else { u32x2 o; o.x = cvt_pk_bf16(y[0] * rs * gg[0], y[1] * rs * gg[1]); o.y = cvt_pk_bf16(y[2] * rs * gg[2], y[3] * rs * gg[3]);
            *(u32x2*)(orow + 16 * dt) = o; } } }
    __syncthreads();
}

__device__ __forceinline__ void conv_item(Frame& F, int l, int tile) {
    const bf16* PROJ = (const bf16*)(F.ws + WS_PROJ); bf16* MIX = (bf16*)(F.ws + WS_MIX);
    constexpr int TP = 32, NR = TP + 30;
    const int p0 = tile * TP, c = F.tid, tid = F.tid;
    LAS float* cbuf = (LAS float*)F.lds;
    LAS bf16* zbuf = (LAS bf16*)(F.lds + 65536);
    { u32x4 av[8], gv[8];
#pragma unroll
      for (int i = 0; i < 8; ++i) { const int id = tid + NTHREADS * i, row = id >> 6, ch = (id & 63) * 8; int p = p0 - 30 + row; p = p < 0 ? 0 : p; p = row < NR ? p : 0;
          av[i] = *(const u32x4*)(PROJ + (size_t)p * DIN + OFF_A + ch); gv[i] = *(const u32x4*)(PROJ + (size_t)p * DIN + OFF_G + ch); }
#pragma unroll
      for (int i = 0; i < 8; ++i) { const int id = tid + NTHREADS * i, row = id >> 6, ch = (id & 63) * 8; const bool live = (p0 - 30 + row) >= 0;
          const unsigned au[4] = {av[i].x, av[i].y, av[i].z, av[i].w}, gu[4] = {gv[i].x, gv[i].y, gv[i].z, gv[i].w}; u32x4 o; unsigned ou[4];
#pragma unroll
          for (int e = 0; e < 4; ++e) { const float z0 = bf_lo(au[e]) * sigmoidf_(bf_lo(gu[e])), z1 = bf_hi(au[e]) * sigmoidf_(bf_hi(gu[e])); ou[e] = live ? cvt_pk_bf16(z0, z1) : 0u; }
          o.x = ou[0]; o.y = ou[1]; o.z = ou[2]; o.w = ou[3];
          if (row < NR) *(LAS u32x4*)(zbuf + row * 512 + ch) = o; } }
    float wk[CONV_K];
#pragma unroll
    for (int k = 0; k < CONV_K; ++k) wk[k] = F.in[IN_CONVW][((size_t)l * CONV_K + k) * 512 + c];
    const float cb = F.in[IN_CONVB][l * 512 + c];
    __syncthreads();
#define CONV_Z(r) __builtin_bit_cast(float, (unsigned)zbuf[(r) * 512 + c] << 16)
    float win[30];
#pragma unroll
    for (int r = 0; r < 30; ++r) win[r] = CONV_Z(r);
#pragma unroll
    for (int q = 0; q < TP; ++q) { const float zv = CONV_Z(30 + q); float acc = cb + wk[30] * zv;
#pragma unroll
        for (int k = 0; k < 30; ++k) acc += wk[k] * win[(k + q) % 30];
        win[q % 30] = zv; cbuf[q * 512 + c] = acc; }
#undef CONV_Z
    __syncthreads();
    const float* lg = F.in[IN_LNG] + l * 512 + 8 * F.lane; const float* lb = F.in[IN_LNB] + l * 512 + 8 * F.lane; const float* og = F.in[IN_OUTN] + (size_t)l * DM + 512 + 8 * F.lane;
    const f32x4 lg0 = *(const f32x4*)lg, lg1 = *(const f32x4*)(lg + 4), lb0 = *(const f32x4*)lb, lb1 = *(const f32x4*)(lb + 4), og0 = *(const f32x4*)og, og1 = *(const f32x4*)(og + 4);
    for (int r = F.wave; r < TP; r += NWAVES) {
        const f32x4 a0 = *(const LAS f32x4*)(cbuf + r * 512 + 8 * F.lane), a1 = *(const LAS f32x4*)(cbuf + r * 512 + 8 * F.lane + 4);
        float x[8] = {a0[0], a0[1], a0[2], a0[3], a1[0], a1[1], a1[2], a1[3]};
        float s = 0.f;
#pragma unroll
        for (int e = 0; e < 8; ++e) s += x[e];
        const float mu = wave_sum(s) * (1.f / 512.f); float q2 = 0.f;
#pragma unroll
        for (int e = 0; e < 8; ++e) { x[e] -= mu; q2 += x[e] * x[e]; }
        const float rstd = __builtin_amdgcn_rsqf(wave_sum(q2) * (1.f / 512.f) + EPS);
        const float gam[8] = {lg0[0], lg0[1], lg0[2], lg0[3], lg1[0], lg1[1], lg1[2], lg1[3]}, bet[8] = {lb0[0], lb0[1], lb0[2], lb0[3], lb1[0], lb1[1], lb1[2], lb1[3]};
        float s2 = 0.f;
#pragma unroll
        for (int e = 0; e < 8; ++e) { const float y = x[e] * rstd * gam[e] + bet[e]; x[e] = y * sigmoidf_(y); s2 += x[e] * x[e]; }
        const float rs = __builtin_amdgcn_rsqf(wave_sum(s2) * (1.f / 512.f) + EPS);
        if (OP8(l)) { u32x2 o8; o8.x = pk4_fp8(x[0] * rs * og0[0], x[1] * rs * og0[1], x[2] * rs * og0[2], x[3] * rs * og0[3]); o8.y = pk4_fp8(x[4] * rs * og1[0], x[5] * rs * og1[1], x[6] * rs * og1[2], x[7] * rs * og1[3]);
            *(u32x2*)((unsigned char*)MIX + (size_t)(p0 + r) * DM + 512 + 8 * F.lane) = o8; }
        else {
        u32x4 o; o.x = cvt_pk_bf16(x[0] * rs * og0[0], x[1] * rs * og0[1]); o.y = cvt_pk_bf16(x[2] * rs * og0[2], x[3] * rs * og0[3]);
        o.z = cvt_pk_bf16(x[4] * rs * og1[0], x[5] * rs * og1[1]); o.w = cvt_pk_bf16(x[6] * rs * og1[2], x[7] * rs * og1[3]);
        *(u32x4*)(MIX + (size_t)(p0 + r) * DM + 512 + 8 * F.lane) = o; }
    }
    __syncthreads();
}

__device__ __forceinline__ int kimg_off(int row, int c) { return row * 256 + ((c ^ (row & 15)) << 4); }
__device__ __forceinline__ bf16x8 tr_frag2(const LAS unsigned char* vs, int ta, int tb, int dt, int lane) {
    const int gq = lane >> 4, q = (lane & 15) >> 2, p = lane & 3, c = 2 * dt + (p >> 1), rr = 4 * gq + q;
    const int off = rr * 256 + ((((c >> 1) ^ (rr & 7)) << 1) | (c & 1)) * 16 + 8 * (p & 1);
    const s16x4 a = __builtin_amdgcn_ds_read_tr16_b64_v4i16((LAS s16x4*)(vs + ta + off));
    const s16x4 b = __builtin_amdgcn_ds_read_tr16_b64_v4i16((LAS s16x4*)(vs + tb + off));
    bf16x8 r; r[0] = a[0]; r[1] = a[1]; r[2] = a[2]; r[3] = a[3]; r[4] = b[0]; r[5] = b[1]; r[6] = b[2]; r[7] = b[3]; return r;
}
#define ATT_DECODE(st) const int run_ = (int)blockIdx.x + F.G * ((st) / 5), b_ = (st) % 5 - 1; const int g = run_ >> 8, h = (run_ >> 5) & 7, rr_ = run_ & 31; \
    const int sh = 2 * g, dil = 1 << sh, rps = 32 >> sh; const int r = rr_ / rps, nb = 4 * (rr_ % rps) + b_
#define ATT_LOAD(st) do { if (ATT_EXP == 2) break; ATT_DECODE(st); const int cc = tid & 15; \
    _Pragma("unroll") for (int j = 0; j < 4; ++j) { const int row = (tid >> 4) + 32 * j; int ms = nb * 128 + row; ms = ms < 0 ? 0 : ms; const size_t pos = (size_t)ms * dil + r; \
        kr[j] = *(const u32x4*)(PROJ + pos * DIN + OFF_K + h * HD + 8 * cc); vr[j] = *(const u32x4*)(PROJ + pos * DIN + OFF_VV + h * HD + 8 * cc); } \
    if (b_ >= 0) { const size_t qpos_ = (size_t)(nb * 128 + 16 * w + (lane & 15)) * dil + r; \
        _Pragma("unroll") for (int ks = 0; ks < 4; ++ks) qr[ks] = *(const u32x4*)(PROJ + qpos_ * DIN + OFF_Q + h * HD + 32 * ks + 8 * (lane >> 4)); } } while (0)
__device__ __forceinline__ void att_phase(Frame& F, int l) {
    const bf16* PROJ = (const bf16*)(F.ws + WS_PROJ);
    bf16* ATT = (bf16*)(F.ws + WS_ATT); float* LSE = (float*)(F.ws + WS_LSE);
    const int lane = F.lane, w = F.wave, tid = F.tid, fr = lane & 15, gq = lane >> 4;
    LAS unsigned char* Ks = F.lds; LAS unsigned char* Vs = F.lds + 65536;
    const int nsteps = 5 * ((768 - (int)blockIdx.x + F.G - 1) / F.G);
    u32x4 kr[4], vr[4], qr[4];
    if (ATT_EXP == 2) { for (int j = 0; j < 4; ++j) { kr[j] = (u32x4){0x3f803f80u + (unsigned)tid, 0x3f003f80u, 0x3f803f00u, 0x3e803f80u}; vr[j] = kr[j]; qr[j] = kr[j]; } }
    if (nsteps > 0) ATT_LOAD(0);
    const int cc = tid & 15;
    const float* kgp = F.in[IN_KN] + l * HD + 8 * cc;
    const f32x4 kg0 = *(const f32x4*)kgp, kg1 = *(const f32x4*)(kgp + 4);
    for (int st = 0; st < nsteps; ++st) {
        ATT_DECODE(st);
        const int slot = (b_ + 1) & 1, curoff = slot * 32768, prevoff = 32768 - curoff;
#pragma unroll
        for (int j = 0; j < 4; ++j) { const int row = (tid >> 4) + 32 * j;
            const u32x4 k4 = kr[j];
            float x[8] = {bf_lo(k4.x), bf_hi(k4.x), bf_lo(k4.y), bf_hi(k4.y), bf_lo(k4.z), bf_hi(k4.z), bf_lo(k4.w), bf_hi(k4.w)};
            float sq = 0.f;
#pragma unroll
            for (int e = 0; e < 8; ++e) sq += x[e] * x[e];
            const float rs = __builtin_amdgcn_rsqf(row16_sum(sq) * (1.f / HD) + EPS);
            u32x4 o; o.x = cvt_pk_bf16(x[0] * rs * kg0[0], x[1] * rs * kg0[1]); o.y = cvt_pk_bf16(x[2] * rs * kg0[2], x[3] * rs * kg0[3]);
            o.z = cvt_pk_bf16(x[4] * rs * kg1[0], x[5] * rs * kg1[1]); o.w = cvt_pk_bf16(x[6] * rs * kg1[2], x[7] * rs * kg1[3]);
            *(LAS u32x4*)(Ks + curoff + kimg_off(row, cc)) = o;
            *(LAS u32x4*)(Vs + curoff + vimg_off(row, cc)) = vr[j]; }
        const int iq = 16 * w + fr; const size_t qpos = (size_t)(nb * 128 + iq) * dil + r;
        bf16x8 qf[4];
        if (b_ >= 0) { float x[4][8]; float sq = 0.f;
#pragma unroll
          for (int ks = 0; ks < 4; ++ks) { const u32x4 q4 = qr[ks];
              x[ks][0] = bf_lo(q4.x); x[ks][1] = bf_hi(q4.x); x[ks][2] = bf_lo(q4.y); x[ks][3] = bf_hi(q4.y); x[ks][4] = bf_lo(q4.z); x[ks][5] = bf_hi(q4.z); x[ks][6] = bf_lo(q4.w); x[ks][7] = bf_hi(q4.w);
#pragma unroll
              for (int e = 0; e < 8; ++e) sq += x[ks][e] * x[ks][e]; }
          sq = sum4(sq);
          const float rs = __builtin_amdgcn_rsqf(sq * (1.f / HD) + EPS) * 0.12751743f;
#pragma unroll
          for (int ks = 0; ks < 4; ++ks) { const float* qg = F.in[IN_QN] + l * HD + 32 * ks + 8 * gq; const f32x4 q0 = *(const f32x4*)qg, q1 = *(const f32x4*)(qg + 4);
              u32x4 o; o.x = cvt_pk_bf16(x[ks][0] * rs * q0[0], x[ks][1] * rs * q0[1]); o.y = cvt_pk_bf16(x[ks][2] * rs * q0[2], x[ks][3] * rs * q0[3]);
              o.z = cvt_pk_bf16(x[ks][4] * rs * q1[0], x[ks][5] * rs * q1[1]); o.w = cvt_pk_bf16(x[ks][6] * rs * q1[2], x[ks][7] * rs * q1[3]);
              qf[ks] = __builtin_bit_cast(bf16x8, o); } }
        __syncthreads();
        if (st + 1 < nsteps) ATT_LOAD(st + 1);
        if (b_ >= 0 && ATT_EXP != 1) {
        f32x4 sc[10];
#pragma unroll
        for (int kt = 0; kt < 9; ++kt) { sc[kt] = (f32x4){0.f, 0.f, 0.f, 0.f}; const int T = w + kt; const int kbase = (T < 8 ? prevoff : curoff); const int krow = 16 * (T & 7) + fr;
#pragma unroll
            for (int ks = 0; ks < 4; ++ks) { const bf16x8 kf = *(const LAS bf16x8*)(Ks + kbase + kimg_off(krow, 4 * ks + gq));
                sc[kt] = __builtin_amdgcn_mfma_f32_16x16x32_bf16(kf, qf[ks], sc[kt], 0, 0, 0); } }
#pragma unroll
        for (int e = 0; e < 4; ++e) { sc[0][e] = (4 * gq + e >= fr) ? sc[0][e] : -INFINITY; sc[8][e] = (4 * gq + e <= fr) ? sc[8][e] : -INFINITY; }
        if (nb == 0) {
#pragma unroll
            for (int kt = 0; kt < 8; ++kt) if (w + kt < 8) sc[kt] = (f32x4){-INFINITY, -INFINITY, -INFINITY, -INFINITY}; }
        float mx = -INFINITY;
#pragma unroll
        for (int kt = 0; kt < 9; ++kt) mx = fmaxf(fmaxf(mx, fmaxf(sc[kt][0], sc[kt][1])), fmaxf(sc[kt][2], sc[kt][3]));
        mx = max4(mx);
        float sum = 0.f;
#pragma unroll
        for (int kt = 0; kt < 9; ++kt)
#pragma unroll
            for (int e = 0; e < 4; ++e) { const float p = __builtin_amdgcn_exp2f(sc[kt][e] - mx); sc[kt][e] = p; sum += p; }
        sc[9] = (f32x4){0.f, 0.f, 0.f, 0.f};
        sum = sum4(sum);
        bf16x8 pf[5];
#pragma unroll
        for (int pp = 0; pp < 5; ++pp) { u32x4 o; o.x = cvt_pk_bf16(sc[2 * pp][0], sc[2 * pp][1]); o.y = cvt_pk_bf16(sc[2 * pp][2], sc[2 * pp][3]); o.z = cvt_pk_bf16(sc[2 * pp + 1][0], sc[2 * pp + 1][1]); o.w = cvt_pk_bf16(sc[2 * pp + 1][2], sc[2 * pp + 1][3]);
            pf[pp] = __builtin_bit_cast(bf16x8, o); }
        const float inv = __builtin_amdgcn_rcpf(sum);
        bf16* orow = ATT + ((size_t)g * SEQ + qpos) * 1024 + h * HD + 4 * gq;
        int toff[10];
#pragma unroll
        for (int kt = 0; kt < 10; ++kt) { const int T = (w + kt) < 15 ? (w + kt) : 15; toff[kt] = (T < 8 ? prevoff : curoff) + (T & 7) * 16 * 256; }
#pragma unroll
        for (int dt = 0; dt < 8; ++dt) { f32x4 o = (f32x4){0.f, 0.f, 0.f, 0.f};
#pragma unroll
            for (int pp = 0; pp < 5; ++pp) { const bf16x8 vf = tr_frag2(Vs, toff[2 * pp], toff[2 * pp + 1], dt, lane);
                o = __builtin_amdgcn_mfma_f32_16x16x32_bf16(vf, pf[pp], o, 0, 0, 0); }
            u32x2 ow; ow.x = cvt_pk_bf16(o[0] * inv, o[1] * inv); ow.y = cvt_pk_bf16(o[2] * inv, o[3] * inv);
            *(u32x2*)(orow + 16 * dt) = ow; }
        if (gq == 0) LSE[((size_t)g * SEQ + qpos) * NHEAD + h] = (mx + __builtin_amdgcn_logf(sum)) * 0.6931471805599453f;
        }
        if (b_ >= 0 && ATT_EXP == 1) { bf16* orow = ATT + ((size_t)g * SEQ + qpos) * 1024 + h * HD + 4 * gq;
#pragma unroll
            for (int dt = 0; dt < 8; ++dt) { u32x2 ow; ow.x = __builtin_bit_cast(unsigned, qf[dt & 3][0] | (qf[dt & 3][1] << 16)) & 0x3f803f80u; ow.y = 0u; *(u32x2*)(orow + 16 * dt) = ow; }
            if (gq == 0) LSE[((size_t)g * SEQ + qpos) * NHEAD + h] = 0.f; }
        __syncthreads();
    }
}
#undef ATT_DECODE
#undef ATT_LOAD

__device__ __forceinline__ void att_combine(Frame& F, int l) {
    const bf16* ATT = (const bf16*)(F.ws + WS_ATT); const float* LSE = (const float*)(F.ws + WS_LSE); bf16* MIX = (bf16*)(F.ws + WS_MIX);
    const int gw = F.vcu * NWAVES + F.wave, NGW = F.G * NWAVES, lane = F.lane;
    const float* og = F.in[IN_OUTN] + (size_t)l * DM + 1024 + 16 * lane;
    f32x4 gg[4];
#pragma unroll
    for (int q = 0; q < 4; ++q) gg[q] = *(const f32x4*)(og + 4 * q);
    for (int m = gw; m < SEQ; m += NGW) {
        const int hh = lane >> 3;
        const float l0 = LSE[((size_t)0 * SEQ + m) * NHEAD + hh], l1 = LSE[((size_t)1 * SEQ + m) * NHEAD + hh], l2 = LSE[((size_t)2 * SEQ + m) * NHEAD + hh];
        const float M = fmaxf(l0, fmaxf(l1, l2)); float w0 = fast_exp(l0 - M), w1 = fast_exp(l1 - M), w2 = fast_exp(l2 - M);
        const float iw = __builtin_amdgcn_rcpf(w0 + w1 + w2); w0 *= iw; w1 *= iw; w2 *= iw;
        float y[16]; float s = 0.f;
#pragma unroll
        for (int q = 0; q < 2; ++q) {
            const u32x4 a = __builtin_nontemporal_load((const u32x4*)(ATT + ((size_t)0 * SEQ + m) * 1024 + 16 * lane + 8 * q)), b = __builtin_nontemporal_load((const u32x4*)(ATT + ((size_t)1 * SEQ + m) * 1024 + 16 * lane + 8 * q)), c = __builtin_nontemporal_load((const u32x4*)(ATT + ((size_t)2 * SEQ + m) * 1024 + 16 * lane + 8 * q));
            const unsigned au[4] = {a.x, a.y, a.z, a.w}, bu[4] = {b.x, b.y, b.z, b.w}, cu[4] = {c.x, c.y, c.z, c.w};
#pragma unroll
            for (int e = 0; e < 4; ++e) { y[8 * q + 2 * e] = w0 * bf_lo(au[e]) + w1 * bf_lo(bu[e]) + w2 * bf_lo(cu[e]); y[8 * q + 2 * e + 1] = w0 * bf_hi(au[e]) + w1 * bf_hi(bu[e]) + w2 * bf_hi(cu[e]); } }
#pragma unroll
        for (int e = 0; e < 16; ++e) s += y[e] * y[e];
        const float rs = __builtin_amdgcn_rsqf(wave_sum(s) * (1.f / 1024.f) + EPS);
        if (OP8(l)) { u32x4 o8;
            o8.x = pk4_fp8(y[0] * rs * gg[0][0], y[1] * rs * gg[0][1], y[2] * rs * gg[0][2], y[3] * rs * gg[0][3]); o8.y = pk4_fp8(y[4] * rs * gg[1][0], y[5] * rs * gg[1][1], y[6] * rs * gg[1][2], y[7] * rs * gg[1][3]);
            o8.z = pk4_fp8(y[8] * rs * gg[2][0], y[9] * rs * gg[2][1], y[10] * rs * gg[2][2], y[11] * rs * gg[2][3]); o8.w = pk4_fp8(y[12] * rs * gg[3][0], y[13] * rs * gg[3][1], y[14] * rs * gg[3][2], y[15] * rs * gg[3][3]);
            *(u32x4*)((unsigned char*)MIX + (size_t)m * DM + 1024 + 16 * lane) = o8; }
        else
#pragma unroll
        for (int q = 0; q < 2; ++q) { u32x4 o;
            o.x = cvt_pk_bf16(y[8 * q + 0] * rs * gg[2 * q][0], y[8 * q + 1] * rs * gg[2 * q][1]); o.y = cvt_pk_bf16(y[8 * q + 2] * rs * gg[2 * q][2], y[8 * q + 3] * rs * gg[2 * q][3]);
            o.z = cvt_pk_bf16(y[8 * q + 4] * rs * gg[2 * q + 1][0], y[8 * q + 5] * rs * gg[2 * q + 1][1]); o.w = cvt_pk_bf16(y[8 * q + 6] * rs * gg[2 * q + 1][2], y[8 * q + 7] * rs * gg[2 * q + 1][3]);
            *(u32x4*)(MIX + (size_t)m * DM + 1024 + 16 * lane + 8 * q) = o; }
    }
}

#define ROUTER_LOAD(S, ks) do { \
    _Pragma("unroll") for (int rt = 0; rt < 4; ++rt) xa##S[rt] = *(const u32x4*)(xrow + (size_t)rt * 16 * DM + 32 * (ks)); \
    _Pragma("unroll") for (int ct = 0; ct < 3; ++ct) { bh##S[ct] = *(const bf16x8*)(wf + (size_t)(ks) * 3072 + (ct * 2) * 512); bl##S[ct] = *(const bf16x8*)(wf + (size_t)(ks) * 3072 + (ct * 2 + 1) * 512); } } while (0)
#define ROUTER_STEP(S, ks) do { \
    _Pragma("unroll") for (int rt = 0; rt < 4; ++rt) { const u32x4 xq = xa##S[rt]; \
        const float x0 = bf_lo(xq.x), x1 = bf_hi(xq.x), x2 = bf_lo(xq.y), x3 = bf_hi(xq.y), x4 = bf_lo(xq.z), x5 = bf_hi(xq.z), x6 = bf_lo(xq.w), x7 = bf_hi(xq.w); \
        ssq[rt] += (x0 * x0 + x1 * x1) + (x2 * x2 + x3 * x3) + (x4 * x4 + x5 * x5) + (x6 * x6 + x7 * x7); \
        { u32x2 x8; x8.x = pk4_fp8(x0, x1, x2, x3); x8.y = pk4_fp8(x4, x5, x6, x7); *(u32x2*)(x8row + (size_t)rt * 16 * DM + 32 * (ks)) = x8; } \
        const bf16x8 xh = __builtin_bit_cast(bf16x8, xq); \
        _Pragma("unroll") for (int ct = 0; ct < 3; ++ct) { \
            acc[rt][ct] = __builtin_amdgcn_mfma_f32_16x16x32_bf16(xh, bh##S[ct], acc[rt][ct], 0, 0, 0); \
            acc[rt][ct] = __builtin_amdgcn_mfma_f32_16x16x32_bf16(xh, bl##S[ct], acc[rt][ct], 0, 0, 0); } } } while (0)
__device__ __forceinline__ void router_phase(Frame& F, int l, int alt = 0) {
    const bf16* H1 = (const bf16*)(F.ws + WS_HN);
    const bf16* WRF = (const bf16*)(F.ws + WS_WRT) + (size_t)l * 64 * 3 * 2 * 64 * 8;
    unsigned* cnt = (unsigned*)(F.ws + WS_CTL) + CW_CNT + 2048 * l + 32768 * alt;
    int* tok = (int*)(F.ws + (alt ? WS_ALT : WS_TOK)); f32x4* tinfo = (f32x4*)(F.ws + (alt ? WS_ALT + 4 * MiB : WS_TINFO)); float* rslot = (float*)(F.ws + (alt ? WS_ALT + 2 * MiB : WS_RSLOT));
    const int lane = F.lane, tid = F.tid, w = F.wave, fr = lane & 15, g = lane >> 4;
    constexpr int PS = 49;
    LAS float* P = (LAS float*)F.lds;
    LAS float* SS = (LAS float*)(F.lds + 8 * 64 * PS * 4);
    for (int task = (int)blockIdx.x; task < SEQ / 64; task += F.G) {
        const bf16* xrow = H1 + (size_t)(task * 64 + fr) * DM + 256 * w + 8 * g;
        unsigned char* x8row = F.ws + WS_X8 + (size_t)(task * 64 + fr) * DM + 256 * w + 8 * g;
        const bf16* wf = WRF + ((size_t)(8 * w) * 3 * 2 * 64 + lane) * 8;
        f32x4 acc[4][3]; float ssq[4] = {0.f, 0.f, 0.f, 0.f};
#pragma unroll
        for (int rt = 0; rt < 4; ++rt)
#pragma unroll
            for (int ct = 0; ct < 3; ++ct) acc[rt][ct] = (f32x4){0.f, 0.f, 0.f, 0.f};
        u32x4 xaA[4], xaB[4]; bf16x8 bhA[3], blA[3], bhB[3], blB[3];
        ROUTER_LOAD(A, 0);
#pragma unroll 1
        for (int it = 0; it < 4; ++it) {
            ROUTER_LOAD(B, 1); __builtin_amdgcn_sched_barrier(0);
            ROUTER_STEP(A, 0); __builtin_amdgcn_sched_barrier(0);
            if (it < 3) ROUTER_LOAD(A, 2);
            __builtin_amdgcn_sched_barrier(0);
            ROUTER_STEP(B, 1); __builtin_amdgcn_sched_barrier(0);
            xrow += 64; x8row += 64; wf += 2 * 3072;
        }
#pragma unroll
        for (int rt = 0; rt < 4; ++rt) { float sq = ssq[rt]; sq += __shfl_xor(sq, 16); sq += __shfl_xor(sq, 32);
            if (g == 0) SS[w * 64 + 16 * rt + fr] = sq;
#pragma unroll
            for (int ct = 0; ct < 3; ++ct)
#pragma unroll
                for (int e = 0; e < 4; ++e) P[(w * 64 + 16 * rt + 4 * g + e) * PS + 16 * ct + fr] = acc[rt][ct][e]; }
        __syncthreads();
        if (tid < 64) {
            const int t = task * 64 + tid;
            float ss = 0.f;
#pragma unroll
            for (int q = 0; q < 8; ++q) ss += SS[q * 64 + tid];
            const float rs = __builtin_amdgcn_rsqf(ss * (1.f / DM) + EPS);
            const LAS float* pr = P + tid * PS;
            float lg[4];
#pragma unroll
            for (int o = 0; o < 4; ++o) { float a = 0.f;
#pragma unroll
                for (int q = 0; q < 8; ++q) a += pr[q * 64 * PS + 32 + o];
                lg[o] = a * rs + F.in[IN_BRG][l * 4 + o]; }
            int gi = 0; float gm = lg[0];
#pragma unroll
            for (int o = 1; o < 4; ++o) if (lg[o] > gm) { gm = lg[o]; gi = o; }
            float den = 0.f;
#pragma unroll
            for (int o = 0; o < 4; ++o) den += __expf(lg[o] - gm);
            const float gate_g = 1.f / den;
            float t1v = -INFINITY, t2v = -INFINITY; int t1i = 0, t2i = 0;
#pragma unroll
            for (int ii = 0; ii < 8; ++ii) { const int o = gi * 8 + ii; float a = 0.f;
#pragma unroll
                for (int q = 0; q < 8; ++q) a += pr[q * 64 * PS + o];
                const float v = a * rs + F.in[IN_BRE][l * NE + o];
                if (v > t1v) { t2v = t1v; t2i = t1i; t1v = v; t1i = ii; }
                else if (v > t2v) { t2v = v; t2i = ii; } }
            const float pp1 = 1.f / (1.f + __expf(t2v - t1v)), pp2 = 1.f - pp1;
            const int e0 = gi * 8 + t1i, e1 = gi * 8 + t2i;
            LAS unsigned* lcnt = (LAS unsigned*)(F.lds + 8 * 64 * PS * 4 + 8 * 64 * 4);
            if (tid < 32) lcnt[tid] = 0u;
            const unsigned r0 = __hip_atomic_fetch_add(lcnt + e0, 1u, __ATOMIC_RELAXED, __HIP_MEMORY_SCOPE_WORKGROUP), r1 = __hip_atomic_fetch_add(lcnt + e1, 1u, __ATOMIC_RELAXED, __HIP_MEMORY_SCOPE_WORKGROUP);
            if (tid < 32) { const unsigned c = lcnt[tid]; lcnt[32 + tid] = c ? atomicAdd(&cnt[tid * CNT_STRIDE], c) : 0u; }
            const unsigned s0 = lcnt[32 + e0] + r0, s1 = lcnt[32 + e1] + r1;
            tok[(size_t)e0 * TOKCAP + s0] = t; tok[(size_t)e1 * TOKCAP + s1] = t;
            rslot[(size_t)e0 * TOKCAP + s0] = rs; rslot[(size_t)e1 * TOKCAP + s1] = rs;
            f32x4 ti; ti[0] = __builtin_bit_cast(float, (int)(e0 * TOKCAP + s0)); ti[1] = __builtin_bit_cast(float, (int)(e1 * TOKCAP + s1)); ti[2] = gate_g * pp1; ti[3] = gate_g * pp2;
            tinfo[t] = ti;
        }
        __syncthreads();
    }
}
__device__ __forceinline__ void moe_table(Frame& F, int l) {
    const unsigned* cnt = (const unsigned*)(F.ws + WS_CTL) + CW_CNT + 2048 * l;
    LAS int* tstart = (LAS int*)(F.lds + MISC_OFF + 64);
    __syncthreads();
    if (F.tid == 0) { int acc = 0; for (int e = 0; e < NE; ++e) { tstart[e] = acc; acc += ((int)cnt[e * CNT_STRIDE] + 255) >> 8; } tstart[NE] = acc; }
    __syncthreads();
    { LAS int* tile_e = (LAS int*)(F.lds + MISC_OFF + 2304);
      if (F.tid < 160) { int e = 0; for (int j = 1; j < NE; ++j) e = (tstart[j] <= F.tid) ? j : e; tile_e[F.tid] = e; } }
    __syncthreads();
}
__device__ __forceinline__ void combine_phase(Frame& F, int l) {
    const LAS int* tstart = (const LAS int*)(F.lds + MISC_OFF + 64);
    const unsigned char* Y = F.ws + WS_Y; const f32x4* tinfo = (const f32x4*)(F.ws + WS_TINFO);
    bf16* H = (bf16*)(F.ws + WS_H); bf16* HN = (bf16*)(F.ws + WS_HN);
    const int gw = F.vcu * NWAVES + F.wave, NGW = F.G * NWAVES, lane = F.lane;
    const float* g1n = F.in[IN_NORM1] + (size_t)DM;
    for (int m = gw; m < SEQ; m += NGW) {
        const f32x4 ti = tinfo[m];
        const float tf0 = ti[0], tf1 = ti[1]; const int s0 = __builtin_bit_cast(int, tf0), s1 = __builtin_bit_cast(int, tf1);
        const int e0 = s0 >> 14, e1 = s1 >> 14;
        const size_t r0 = (size_t)tstart[e0] * 256 + (s0 & (TOKCAP - 1)), r1 = (size_t)tstart[e1] * 256 + (s1 & (TOKCAP - 1));
        const float ga = ti[2] * (1.f / Y_SCALE), gb = ti[3] * (1.f / Y_SCALE);
        f32x4 v[8]; float s = 0.f;
#pragma unroll
        for (int j = 0; j < 8; ++j) { const u32x2 hx = __builtin_nontemporal_load((const u32x2*)(HN + (size_t)m * DM + 4 * lane + 256 * j));
            const int ya = __builtin_nontemporal_load((const int*)(Y + r0 * DM + 4 * lane + 256 * j)), yb = __builtin_nontemporal_load((const int*)(Y + r1 * DM + 4 * lane + 256 * j));
            const f32x2 a01 = __builtin_amdgcn_cvt_pk_f32_fp8(ya, false), a23 = __builtin_amdgcn_cvt_pk_f32_fp8(ya, true), b01 = __builtin_amdgcn_cvt_pk_f32_fp8(yb, false), b23 = __builtin_amdgcn_cvt_pk_f32_fp8(yb, true);
            v[j][0] = bf_lo(hx.x) + ga * a01[0] + gb * b01[0]; v[j][1] = bf_hi(hx.x) + ga * a01[1] + gb * b01[1];
            v[j][2] = bf_lo(hx.y) + ga * a23[0] + gb * b23[0]; v[j][3] = bf_hi(hx.y) + ga * a23[1] + gb * b23[1];
            s += (v[j][0] * v[j][0] + v[j][1] * v[j][1]) + (v[j][2] * v[j][2] + v[j][3] * v[j][3]); }
        if (l == 0) {
            const float rs = __builtin_amdgcn_rsqf(wave_sum(s) * (1.f / DM) + EPS);
            bf16* hrow = H + (size_t)m * DM; bf16* orow = HN + (size_t)m * DM;
#pragma unroll
            for (int j = 0; j < 8; ++j) { const f32x4 gg = *(const f32x4*)(g1n + 4 * lane + 256 * j);
                u32x2 hb; hb.x = cvt_pk_bf16(v[j][0], v[j][1]); hb.y = cvt_pk_bf16(v[j][2], v[j][3]); *(u32x2*)(hrow + 4 * lane + 256 * j) = hb;
                if (IP8(1)) *(unsigned*)(F.ws + WS_X8 + (size_t)m * DM + 4 * lane + 256 * j) = pk4_fp8(v[j][0] * rs * gg[0], v[j][1] * rs * gg[1], v[j][2] * rs * gg[2], v[j][3] * rs * gg[3]);
                else { u32x2 o; o.x = cvt_pk_bf16(v[j][0] * rs * gg[0], v[j][1] * rs * gg[1]); o.y = cvt_pk_bf16(v[j][2] * rs * gg[2], v[j][3] * rs * gg[3]);
                *(u32x2*)(orow + 4 * lane + 256 * j) = o; } }
        } else {
            float* orow = F.out + (size_t)m * DM;
#pragma unroll
            for (int j = 0; j < 8; ++j) __builtin_nontemporal_store(v[j], (f32x4*)(orow + 4 * lane + 256 * j));
        }
    }
}

__device__ __forceinline__ void relaunder(Frame& F) { F.lane = lane_now(); F.tid = F.wave * 64 + F.lane; }
constexpr int N_PHASES = 17;
#ifndef PHASE_MASK
#define PHASE_MASK 0x1ff
#endif
#ifndef MIX_MASK
#define MIX_MASK 7
#endif
#ifndef DUP_PHASE
#define DUP_PHASE 0
#endif
#define DUP(k) for (int _d = 0; _d < ((DUP_PHASE == (k)) ? 2 : 1); ++_d)
#define IN(k) (lo <= (k) && (k) < hi)
#define EN(b) ((PHASE_MASK >> (b)) & 1)
#ifndef PROBE_STAMP
#define PROBE_STAMP (-1)
#endif
#define SEAM(k) do { if (IN(k) && IN((k) + 1)) { xcd_barrier(bar); if (PROBE_STAMP >= 0 && blockIdx.x == 0 && F.tid == 0) { const unsigned long long _t = wall_clock64(); F.MISC[802 + 2 * (k)] = (unsigned)_t; F.MISC[803 + 2 * (k)] = (unsigned)(_t >> 32); } } } while (0)
template <int l>
__device__ __forceinline__ void layer_phases(Frame& F, const XcdBarrier& bar, const int lo, const int hi) {
    constexpr int pb = 1 + 8 * l;
    relaunder(F);
    if (EN(1) && IN(pb)) {
        constexpr int KI = IP8(l) ? DM / 2 : DM;
#define INPROJ_PART(first) do { pg8::StaticSched S; S.init((const bf16*)(F.ws + (IP8(l) ? WS_X8 : WS_HN)), (const bf16*)(F.ws + WS_WIN) + (size_t)l * DIN * DM, SEQ, DIN, KI, F.G, (int)blockIdx.x); \
            const int slot = (((int)blockIdx.x & 7) * 6) >> 3; if (first) S.i1 = slot; else S.i0 = slot; \
            pg8::EpiProj E{(bf16*)(F.ws + WS_PROJ), IP8(l) ? 1.f / WIN_SCALE : 1.f}; \
            DUP(1) pg8::gemm_phase<pg8::EpiProj, pg8::StaticSched, true, IP8(l) != 0>(F.lds, KI, S, E, F.wave); } while (0)
        INPROJ_PART(true);
        __syncthreads(); relaunder(F); convert_tiles(F, l == 0 ? CV_P : CV_A, l == 0 ? CV_A : CV_B); __syncthreads(); relaunder(F);
        INPROJ_PART(false);
#undef INPROJ_PART
    }
    SEAM(pb);
    relaunder(F);
    if (EN(2) && IN(pb + 1)) {
        constexpr int N_SGU = 256, N_CONV = 512, N_ATT = 3072;
#define MSTAMP(i) do { if (PROBE_STAMP >= 100 && l == 0 && blockIdx.x == 0 && F.tid == 0) { const unsigned long long _t = wall_clock64(); F.MISC[900 + 2 * (i)] = (unsigned)_t; F.MISC[901 + 2 * (i)] = (unsigned)(_t >> 32); } } while (0)
        MSTAMP(0);
        if (MIX_MASK & 1) DUP(2) att_phase(F, l);
        MSTAMP(1);
        if (MIX_MASK & 2) DUP(3) for (int it = (int)blockIdx.x; it < N_CONV; it += F.G) conv_item(F, l, it);
        MSTAMP(2);
        if (MIX_MASK & 4) DUP(4) for (int it = (int)blockIdx.x; it < N_SGU; it += F.G) sgu_item(F, l, it >> 1, it & 1);
        MSTAMP(3);
#undef MSTAMP
    }
    SEAM(pb + 1);
    if (DUP_PHASE == 12 && IN(pb + 1)) {
        pg8::StaticSched S; S.init((const bf16*)(F.ws + WS_MIX), (const bf16*)(F.ws + WS_WIN) + (size_t)l * DIN * DM, SEQ, DIN, DM, F.G, (int)blockIdx.x);
        pg8::EpiProj E{(bf16*)(F.ws + WS_PROJ), 1.f};
        pg8::gemm_phase<pg8::EpiProj, pg8::StaticSched>(F.lds, DM, S, E, F.wave);
        xcd_barrier(bar);
    }
    relaunder(F);
    if (EN(3) && IN(pb + 2)) DUP(5) att_combine(F, l);
    SEAM(pb + 2);
    relaunder(F);
    if (EN(4) && IN(pb + 3)) {
        constexpr int KO = OP8(l) ? DM / 2 : DM;
        pg8::StaticSched S; S.init((const bf16*)(F.ws + WS_MIX), (const bf16*)(F.ws + WS_WOUT) + (size_t)l * DM * DM, SEQ, DM, KO, F.G, (int)blockIdx.x);
        if constexpr (l == 0) { pg8::EpiResid<false> E{(const void*)F.in[IN_X], (bf16*)(F.ws + WS_HN)}; DUP(6) pg8::gemm_phase<pg8::EpiResid<false>, pg8::StaticSched, true, OP8(l) != 0>(F.lds, KO, S, E, F.wave); }
        else { pg8::EpiResid<true> E{(const void*)(F.ws + WS_H), (bf16*)(F.ws + WS_HN)}; DUP(6) pg8::gemm_phase<pg8::EpiResid<true>, pg8::StaticSched, true, OP8(l) != 0>(F.lds, KO, S, E, F.wave); }
    }
    SEAM(pb + 3);
    relaunder(F);
    if (EN(5) && IN(pb + 4)) { router_phase(F, l); if (DUP_PHASE == 11) router_phase(F, l, 1); }
    if (DUP_PHASE == 13 && IN(pb + 4)) { for (int q = 0; q < 8; ++q) xcd_barrier(bar); }
    SEAM(pb + 4);
    relaunder(F);
    if (EN(6) && IN(pb + 5)) {
        moe_table(F, l);
        unsigned* ready = (unsigned*)(F.ws + WS_CTL) + CW_RDY + 16384 * l;
        {
            pg8::SchedG1 S{(const LAS int*)(F.lds + MISC_OFF + 64), (const int*)((const unsigned*)(F.ws + WS_CTL) + CW_CNT + 2048 * l), (const int*)(F.ws + WS_TOK), (const bf16*)(F.ws + WS_X8),
                           (const bf16*)(F.ws + WS_W1 + (size_t)l * NE * 1024 * DM), F.G, (int)blockIdx.x, ready};
            pg8::EpiSwiGLU E{F.ws + WS_HB, (const float*)(F.ws + WS_RSLOT)};
            DUP(7) pg8::gemm_phase<pg8::EpiSwiGLU, pg8::SchedG1, true, true>(F.lds, DM / 2, S, E, F.wave);
        }
        {
            pg8::SchedG2 S{(const LAS int*)(F.lds + MISC_OFF + 64), (const bf16*)(F.ws + WS_HB), (const bf16*)(F.ws + WS_W2 + (size_t)l * NE * DM * DE), F.G, (int)blockIdx.x, ready, (unsigned*)(F.ws + WS_CTL) + CW_TMO, F.wave};
            pg8::EpiY E{F.ws + WS_Y};
            DUP(8) pg8::gemm_phase<pg8::EpiY, pg8::SchedG2, true, true>(F.lds, DE / 2, S, E, F.wave);
        }
    }
    SEAM(pb + 6);
    relaunder(F);
    if (EN(8) && IN(pb + 7)) { moe_table(F, l); DUP(l == 0 ? 9 : 99) combine_phase(F, l); }
    SEAM(pb + 7);
}
__global__ void __launch_bounds__(NTHREADS, 2) fwd_kernel(Params args) {
    extern __shared__ __attribute__((aligned(16))) unsigned char lds_raw[];
    Frame F;
    F.lds = (LAS unsigned char*)lds_raw; F.MISC = (volatile LAS unsigned*)(F.lds + MISC_OFF);
    F.tid = threadIdx.x; F.lane = F.tid & 63; F.wave = __builtin_amdgcn_readfirstlane(F.tid >> 6);
    F.G = gridDim.x; { const int bx = blockIdx.x; F.vcu = (F.G % 8 == 0) ? (bx % 8) * (F.G / 8) + bx / 8 : bx; }
    F.in = args.in; F.out = args.out; F.ws = args.ws;
    for (int u = F.tid; u < (LDS_BYTES - MISC_OFF) / 4; u += NTHREADS) ((LAS unsigned*)(F.lds + MISC_OFF))[u] = 0u;
    __syncthreads();
    unsigned* ctl = (unsigned*)(args.ws + WS_CTL);
    const int lo = args.ph_lo, hi = args.ph_hi;
    const bool multi = (hi - lo) > 1;
    XcdBarrier bar; bar.bar = ctl + CW_BAR; bar.x = 0; bar.st = nullptr; bar.lead = 0;
    if (multi) bar = xcd_barrier_post(ctl + CW_BAR, F.MISC, F.wave == 0 ? 1u : 0u);
    if (PROBE_STAMP >= 0 && blockIdx.x == 0 && F.tid == 0) { const unsigned long long _t = wall_clock64(); F.MISC[800] = (unsigned)_t; F.MISC[801] = (unsigned)(_t >> 32); }
    if (EN(0) && IN(0)) { DUP(10) p_prologue(F); }
    SEAM(0);
    layer_phases<0>(F, bar, lo, hi);
    layer_phases<1>(F, bar, lo, hi);
    if (PROBE_STAMP >= 0 && blockIdx.x == 0 && F.tid == 0) {
        asm volatile("s_waitcnt vmcnt(0)" ::: "memory");
        constexpr int SB = PROBE_STAMP >= 100 ? 900 + 2 * (PROBE_STAMP - 100) : (PROBE_STAMP == 6 ? 812 : 800 + 2 * PROBE_STAMP);
        constexpr int SB1 = (PROBE_STAMP == 6) ? SB + 4 : SB + 2;
        const unsigned long long t1 = ((unsigned long long)F.MISC[SB1 + 1] << 32) | F.MISC[SB1], t0 = ((unsigned long long)F.MISC[SB + 1] << 32) | F.MISC[SB];
        F.out[0] += (float)(long long)(t1 - t0) * 0.01f;
    }
}
#undef IN
#undef EN
#undef SEAM
#undef DUP

extern "C" void kernel_launch(void* const* d_in, const int* in_sizes, int n_in, void* d_out, int out_size, void* d_ws, size_t ws_size, hipStream_t stream) {
    static int grid = 0;
    if (grid == 0) {
        if (n_in != 22 || out_size != SEQ * DM || ws_size < WS_END) { fprintf(stderr, "kernel_launch: unexpected shapes (n_in %d out %d ws %zu, need %zu)\n", n_in, out_size, ws_size, (size_t)WS_END); grid = -1; return; }
        int dev = 0, cus = 0, per_cu = 0;
        if (hipGetDevice(&dev) != hipSuccess || hipDeviceGetAttribute(&cus, hipDeviceAttributeMultiprocessorCount, dev) != hipSuccess) { grid = -1; return; }
        if (hipFuncSetAttribute((const void*)fwd_kernel, hipFuncAttributeMaxDynamicSharedMemorySize, LDS_BYTES) != hipSuccess) { fprintf(stderr, "kernel_launch: hipFuncSetAttribute failed\n"); grid = -1; return; }
        if (hipOccupancyMaxActiveBlocksPerMultiprocessor(&per_cu, (const void*)fwd_kernel, NTHREADS, LDS_BYTES) != hipSuccess || per_cu < 1) { fprintf(stderr, "kernel_launch: occupancy query says %d\n", per_cu); }
        (void)hipGetLastError();
        grid = cus;
    }
    if (grid < 0) return;
    if (hipMemsetAsync((char*)d_ws + WS_CTL, 0, CTL_ZERO_BYTES, stream) != hipSuccess) return;
    Params p{};
    for (int i = 0; i < 22; ++i) p.in[i] = (const float*)d_in[i];
    p.out = (float*)d_out; p.ws = (unsigned char*)d_ws;
    constexpr int NL = MK_N_LAUNCHES;
    for (int li = 0; li < NL; ++li) {
        p.ph_lo = (NL == 1) ? 0 : li; p.ph_hi = (NL == 1) ? N_PHASES : li + 1;
        hipLaunchKernelGGL(fwd_kernel, dim3(grid), dim3(NTHREADS), LDS_BYTES, stream, p);
        if (hipPeekAtLastError() != hipSuccess) { fprintf(stderr, "kernel_launch: launch %d failed\n", li); break; }
    }
}
```

```cpp
#include <hip/hip_runtime.h>
#include <cstdio>
#include <cstdint>

#ifndef MK_N_LAUNCHES
#define MK_N_LAUNCHES 1
#endif

#ifndef OUTPROJ_FP8
#define OUTPROJ_FP8 2
#endif
#ifndef ATT_EXP
#define ATT_EXP 0
#endif
#define OP8(l) ((OUTPROJ_FP8 >> (l)) & 1)
#ifndef INPROJ_FP8
#define INPROJ_FP8 2
#endif
#define IP8(l) ((INPROJ_FP8 >> (l)) & 1)
#define GAS __attribute__((address_space(1)))
#define LAS __attribute__((address_space(3)))
typedef unsigned short bf16;
typedef short bf16x8 __attribute__((ext_vector_type(8)));
typedef short s16x4 __attribute__((ext_vector_type(4)));
typedef float f32x4 __attribute__((ext_vector_type(4)));
typedef float f32x2 __attribute__((ext_vector_type(2)));
typedef unsigned u32x4 __attribute__((ext_vector_type(4)));
typedef unsigned u32x2 __attribute__((ext_vector_type(2)));

constexpr int SEQ = 16384, DM = 2048, DIN = 5120, NLAYER = 2;
constexpr int HD = 128, NHEAD = 8, CONV_K = 31;
constexpr int NE = 32, DE = 512, TOKCAP = 16384;
constexpr int OFF_U = 0, OFF_V = 512, OFF_A = 1024, OFF_G = 1536, OFF_Q = 2048, OFF_K = 3072, OFF_VV = 4096;
constexpr float EPS = 1e-6f;
constexpr float W1_SCALE = 64.f, W2_SCALE = 32.f, WOUT_SCALE = 64.f, WIN_SCALE = 64.f, Y_SCALE = 16.f;
constexpr int NWAVES = 8, NTHREADS = 512;

constexpr size_t MiB = 1u << 20;
constexpr size_t WS_CTL = 0, CTL_ZERO_BYTES = 1 * MiB;
constexpr size_t WS_WIN = 1 * MiB;
constexpr size_t WS_WOUT = 41 * MiB;
constexpr size_t WS_W1 = 57 * MiB;
constexpr size_t WS_X8 = 185 * MiB;
constexpr size_t WS_W2 = 313 * MiB;
constexpr size_t WS_SGUW = 441 * MiB;
constexpr size_t WS_WRT = 442 * MiB;
constexpr size_t WS_TOK = 443 * MiB;
constexpr size_t WS_TINFO = 445 * MiB;
constexpr size_t WS_HN = 446 * MiB;
constexpr size_t WS_HB = 510 * MiB;
constexpr size_t WS_ATT = WS_HN;
constexpr size_t WS_LSE = WS_HN + 96 * MiB;
constexpr size_t WS_PROJ = 550 * MiB;
constexpr size_t WS_Y = WS_PROJ;
constexpr size_t WS_MIX = 710 * MiB;
constexpr size_t WS_H = 774 * MiB;
constexpr size_t WS_RSLOT = 902 * MiB;
constexpr size_t WS_ALT = 904 * MiB;
constexpr size_t WS_END = 910 * MiB;
constexpr int CW_BAR = 4096;
constexpr int CW_TMO = 0;
constexpr int CW_RDY = 65536;
constexpr int CW_CNT = 16384, CNT_STRIDE = 64;

constexpr int LDS_BYTES = 163840;
constexpr int MISC_OFF = 159744;

__device__ __forceinline__ unsigned cvt_pk_bf16(float lo, float hi) { unsigned r; asm volatile("v_cvt_pk_bf16_f32 %0, %1, %2" : "=v"(r) : "v"(lo), "v"(hi)); return r; }
__device__ __forceinline__ unsigned pk4_fp8(float a, float b, float c, float d) { int p = 0; p = __builtin_amdgcn_cvt_pk_fp8_f32(a, b, p, false); p = __builtin_amdgcn_cvt_pk_fp8_f32(c, d, p, true); return (unsigned)p; }
__device__ __forceinline__ float bf_lo(unsigned u) { return __builtin_bit_cast(float, u << 16); }
__device__ __forceinline__ float bf_hi(unsigned u) { return __builtin_bit_cast(float, u & 0xffff0000u); }
template <int CTRL, int RM> __device__ __forceinline__ float dpp_mov0(float v) { return __builtin_bit_cast(float, __builtin_amdgcn_update_dpp(0, __builtin_bit_cast(int, v), CTRL, RM, 0xf, false)); }
__device__ __forceinline__ float wave_sum(float s) {
    s += dpp_mov0<0xB1, 0xf>(s); s += dpp_mov0<0x4E, 0xf>(s); s += dpp_mov0<0x141, 0xf>(s); s += dpp_mov0<0x140, 0xf>(s);
    s += dpp_mov0<0x142, 0xa>(s); s += dpp_mov0<0x143, 0xc>(s);
    return __builtin_bit_cast(float, __builtin_amdgcn_readlane(__builtin_bit_cast(int, s), 63));
}
__device__ __forceinline__ float row16_sum(float s) {
    s += dpp_mov0<0xB1, 0xf>(s); s += dpp_mov0<0x4E, 0xf>(s); s += dpp_mov0<0x141, 0xf>(s); s += dpp_mov0<0x140, 0xf>(s); return s;
}
__device__ __forceinline__ float sum4(float x) {
    const unsigned xu = __builtin_bit_cast(unsigned, x); const auto r = __builtin_amdgcn_permlane16_swap(xu, xu, false, false); const unsigned r0 = r[0], r1 = r[1];
    const float a = __builtin_bit_cast(float, r0) + __builtin_bit_cast(float, r1);
    const unsigned au = __builtin_bit_cast(unsigned, a); const auto q = __builtin_amdgcn_permlane32_swap(au, au, false, false); const unsigned q0 = q[0], q1 = q[1];
    return __builtin_bit_cast(float, q0) + __builtin_bit_cast(float, q1);
}
__device__ __forceinline__ float max4(float x) {
    const unsigned xu = __builtin_bit_cast(unsigned, x); const auto r = __builtin_amdgcn_permlane16_swap(xu, xu, false, false); const unsigned r0 = r[0], r1 = r[1];
    const float a = fmaxf(__builtin_bit_cast(float, r0), __builtin_bit_cast(float, r1));
    const unsigned au = __builtin_bit_cast(unsigned, a); const auto q = __builtin_amdgcn_permlane32_swap(au, au, false, false); const unsigned q0 = q[0], q1 = q[1];
    return fmaxf(__builtin_bit_cast(float, q0), __builtin_bit_cast(float, q1));
}
__device__ __forceinline__ int lane_now() { int l; asm volatile("v_mbcnt_lo_u32_b32 %0, -1, 0\n\tv_mbcnt_hi_u32_b32 %0, -1, %0" : "=v"(l)); return l; }
#define LDS_WAIT() asm volatile("s_waitcnt lgkmcnt(0)" ::: "memory")
#define VM_WAIT() asm volatile("s_waitcnt vmcnt(0)" ::: "memory")
__device__ __forceinline__ float fast_exp(float x) { return __builtin_amdgcn_exp2f(x * 1.4426950408889634f); }
__device__ __forceinline__ float sigmoidf_(float x) { return __builtin_amdgcn_rcpf(1.0f + fast_exp(-x)); }
__device__ __forceinline__ float gelu_tanh(float x) { const float z = 1.5957691216057308f * (x + 0.044715f * x * x * x); return x * sigmoidf_(z); }

#define XB_TMO      128
#define XB_XCNT(j)  (256  + 64 * (j))
#define XB_XSUB(j)  (1280 + 64 * (j))
#define XB_XGEN(j)  (2304 + 64 * (j))
#define XB_TOP      3328
#define XB_TOPGEN   3392
#define XCD_BAR_WORDS 3456
#define XB_SPIN_CAP (1u << 22)
__device__ __forceinline__ unsigned xb_ld(unsigned* p)              { return __hip_atomic_load(p, __ATOMIC_RELAXED, __HIP_MEMORY_SCOPE_AGENT); }
__device__ __forceinline__ unsigned xb_add(unsigned* p, unsigned v) { return __hip_atomic_fetch_add(p, v, __ATOMIC_RELAXED, __HIP_MEMORY_SCOPE_AGENT); }
__device__ __forceinline__ unsigned xb_xcc_id() { return (unsigned)__builtin_amdgcn_s_getreg((3 << 11) | 20) & 0xFu; }
#define XB_SPIN(cond, bar) do { unsigned _sp = 0; while (cond) { __builtin_amdgcn_s_sleep(1); \
    if ((++_sp & 255u) == 0u) { if (xb_ld(&(bar)[XB_TMO])) break; if (_sp > XB_SPIN_CAP) { atomicAdd(&(bar)[XB_TMO], 1u); break; } } } } while (0)
struct XcdBarrier { unsigned* bar; unsigned x; volatile LAS unsigned* st; unsigned lead; };
__device__ __forceinline__ XcdBarrier xcd_barrier_post(unsigned* bar, volatile LAS unsigned* st, unsigned lead) {
    XcdBarrier b; b.bar = bar; b.x = xb_xcc_id(); b.st = st; b.lead = lead;
    if (lead && lane_now() == 0) (void)xb_add(&bar[XB_XCNT(b.x)], 1u);
    return b;
}
__device__ __forceinline__ void xcd_barrier_complete(unsigned* bar, unsigned x, unsigned& nloc, unsigned& nx) {
    const unsigned G = gridDim.x * gridDim.y * gridDim.z;
    unsigned sum, cnt, mine, sp = 0u;
    for (;;) {
        sum = 0u; cnt = 0u; mine = 0u;
#pragma unroll
        for (unsigned j = 0; j < 16; ++j) { const unsigned c = xb_ld(&bar[XB_XCNT(j)]); sum += c; cnt += (c > 0u) ? 1u : 0u; mine = (j == x) ? c : mine; }
        if (sum == G) break;
        __builtin_amdgcn_s_sleep(1);
        if ((++sp & 255u) == 0u) { if (xb_ld(&bar[XB_TMO])) break; if (sp > XB_SPIN_CAP) { atomicAdd(&bar[XB_TMO], 1u); break; } }
    }
    nloc = mine > 0u ? mine : 1u; nx = cnt > 0u ? cnt : 1u;
}
__device__ __forceinline__ void xcd_barrier(const XcdBarrier& b) {
    asm volatile("s_waitcnt vmcnt(0)" ::: "memory");
    __syncthreads();
    if (b.lead && lane_now() == 0) {
        unsigned* bar = b.bar;
        __builtin_amdgcn_s_waitcnt(0);
        unsigned nloc = b.st[0], nx = b.st[1];
        if (nloc == 0u) { xcd_barrier_complete(bar, b.x, nloc, nx); b.st[0] = nloc; b.st[1] = nx; }
        const unsigned old = xb_add(&bar[XB_XSUB(b.x)], 1u);
        const unsigned gen = old / nloc;
        if (old + 1u == (gen + 1u) * nloc) {
            __builtin_amdgcn_fence(__ATOMIC_RELEASE, "agent");
            asm volatile("s_waitcnt vmcnt(0)" ::: "memory");
            const unsigned og = xb_add(&bar[XB_TOP], 1u);
            const unsigned tg = og / nx;
            if (og + 1u == (tg + 1u) * nx) xb_add(&bar[XB_TOPGEN], 1u);
            else XB_SPIN(xb_ld(&bar[XB_TOPGEN]) == tg, bar);
            __builtin_amdgcn_fence(__ATOMIC_ACQUIRE, "agent");
            xb_add(&bar[XB_XGEN(b.x)], 1u);
            asm volatile("s_waitcnt vmcnt(0)" ::: "memory");
        } else {
            XB_SPIN(xb_ld(&bar[XB_XGEN(b.x)]) == gen, bar);
            __builtin_amdgcn_fence(__ATOMIC_ACQUIRE, "agent");
            asm volatile("s_waitcnt vmcnt(0)" ::: "memory");
        }
    }
    __syncthreads();
}

namespace pg8 {
constexpr int BM = 256, BK = 64, HALF = 128, HTB = HALF * BK * 2, STAGE_BYTES = 8 * HTB, NXCD = 8, WGM = 8;
__device__ __forceinline__ int lds_byte(int r, int c) { const int st = (r >> 4) * 2 + (c >> 5), rr = r & 15, cc = c & 31, ob = rr * 64 + cc * 2; return st * 1024 + (ob ^ (((ob >> 9) & 1) << 5)); }
__device__ __forceinline__ void stage_rc(int b, int& R, int& C) { const int st = b / 1024, sb = b % 1024, swz = sb ^ (((sb >> 9) & 1) << 5); R = (st >> 1) * 16 + swz / 64; C = (st & 1) * 32 + (swz % 64) / 2; }
__device__ __forceinline__ int perm32(int rho) { const int n = rho >> 4, i = rho & 15; return 8 * (i >> 2) + 4 * n + (i & 3); }

struct Unit { int pm, pn, e, rb; };

struct StaticSched {
    static constexpr bool GATHER = false;
    const bf16* A; const bf16* Bt; int K; int nM, nN, nwg, G, c; int i0 = 0, i1 = 0x7fffffff;
    __device__ __forceinline__ void init(const bf16* A_, const bf16* Bt_, int M, int N, int K_, int G_, int c_) { A = A_; Bt = Bt_; K = K_; nM = M / BM; nN = N / BM; nwg = nM * nN; G = G_; c = c_; }
    __device__ __forceinline__ bool next(int i, Unit& u) const {
        if (i + i0 >= i1) return false;
        const long L = (long)(i + i0) * G + c; if (L >= nwg) return false;
        int wgid = (int)L; { const int q = nwg / NXCD, r = nwg % NXCD, xcd = wgid % NXCD, off = wgid / NXCD; wgid = (xcd < r ? xcd * (q + 1) : r * (q + 1) + (xcd - r) * q) + off; }
        const int nig = WGM * nN, gid = wgid / nig, fm = gid * WGM, gsz = (nM - fm) < WGM ? (nM - fm) : WGM;
        u.pm = fm + ((wgid % nig) % gsz); u.pn = (wgid % nig) / gsz; u.e = 0; u.rb = 0; return true;
    }
    __device__ __forceinline__ void a_ready(const Unit&) const {}
    __device__ __forceinline__ void done(const Unit&) const {}
    __device__ __forceinline__ const char* a_base(const Unit& u) const { return (const char*)A + (size_t)u.pm * BM * K * 2; }
    __device__ __forceinline__ const char* b_base(const Unit& u) const { return (const char*)Bt + (size_t)u.pn * BM * K * 2; }
    __device__ __forceinline__ void a_voff(const Unit&, const int (&R)[2], const int (&C)[2], unsigned (&v)[2][2]) const {
#pragma unroll
        for (int h = 0; h < 2; ++h)
#pragma unroll
            for (int i = 0; i < 2; ++i) v[h][i] = (unsigned)((h * HALF + R[i]) * K + C[i]) * 2u;
    }
};

typedef int v8i __attribute__((ext_vector_type(8)));
typedef int v4i __attribute__((ext_vector_type(4)));
template <class Epi, class Sched, bool ALIGN_EPI = true, bool FP8 = false>
__device__ __forceinline__ void gemm_phase(LAS unsigned char* lds, const int K, const Sched& S, const Epi& E, const int wave) {
    const int lane = lane_now(), wid = wave, tid = wid * 64 + lane,
              wr = wid >> 2, wc = wid & 3, fr = lane & 15, fq = lane >> 4;
    const int nt = K / BK;
    int Rr[2], Cc[2]; unsigned voffB[2];
#pragma unroll
    for (int i = 0; i < 2; ++i) { stage_rc(tid * 16 + i * 8192, Rr[i], Cc[i]); const int Rb = Epi::PERM ? ((Rr[i] & ~31) + perm32(Rr[i] & 31)) : Rr[i];
        voffB[i] = (unsigned)(Rb * K + Cc[i]) * 2u; }
    const size_t kstep = (size_t)(BK * 2);
    const size_t hstep = (size_t)HALF * K * 2;
    const unsigned ldsw = (unsigned)wid * 1024u;
    const unsigned ldsbase = (unsigned)__builtin_amdgcn_readfirstlane((int)(unsigned)(size_t)lds);
    const int aoff = lds_byte(wr * 64 + fr, fq * 8), boff = lds_byte(wc * 32 + fr, fq * 8);
#define PG8_SA(b, h) (((b) * 2 + (h)) * HTB)
#define PG8_SB(b, h) ((4 + (b) * 2 + (h)) * HTB)
#define PG8_STAGE(bufoff, gbase, voff) do { _Pragma("unroll") for (int _i = 0; _i < 2; ++_i) { unsigned _keep; \
        asm volatile("s_mov_b32 %0, m0\n\ts_mov_b32 m0, %3\n\ts_nop 0\n\tglobal_load_lds_dwordx4 %1, %2\n\ts_mov_b32 m0, %0" : "=&s"(_keep) : "v"((voff)[_i]), "s"((const char*)(gbase)), "s"(ldsbase + (unsigned)(bufoff) + ldsw + (unsigned)(_i * 8192)) : "memory"); } } while (0)
#define PG8_LDA(dst, b, h) do { _Pragma("unroll") for (int m = 0; m < 4; ++m) _Pragma("unroll") for (int k = 0; k < 2; ++k) dst[m][k] = *(const LAS bf16x8*)(lds + PG8_SA(b, h) + aoff + m * 2048 + k * 1024); } while (0)
#define PG8_LDB(dst, b, h) do { _Pragma("unroll") for (int n = 0; n < 2; ++n) _Pragma("unroll") for (int k = 0; k < 2; ++k) dst[n][k] = *(const LAS bf16x8*)(lds + PG8_SB(b, h) + boff + n * 2048 + k * 1024); } while (0)
#define PG8_LDA8(dst, b, h) do { _Pragma("unroll") for (int m = 0; m < 4; ++m) { const v4i lo_ = *(const LAS v4i*)(lds + PG8_SA(b, h) + aoff + m * 2048), hi_ = *(const LAS v4i*)(lds + PG8_SA(b, h) + aoff + m * 2048 + 1024); dst[m] = __builtin_shufflevector(lo_, hi_, 0, 1, 2, 3, 4, 5, 6, 7); } } while (0)
#define PG8_LDB8(dst, b, h) do { _Pragma("unroll") for (int n = 0; n < 2; ++n) { const v4i lo_ = *(const LAS v4i*)(lds + PG8_SB(b, h) + boff + n * 2048), hi_ = *(const LAS v4i*)(lds + PG8_SB(b, h) + boff + n * 2048 + 1024); dst[n] = __builtin_shufflevector(lo_, hi_, 0, 1, 2, 3, 4, 5, 6, 7); } } while (0)
#define PG8_MMA(ai, bj, At, Bt) do { __builtin_amdgcn_s_setprio(1); _Pragma("unroll") for (int m = 0; m < 4; ++m) _Pragma("unroll") for (int n = 0; n < 2; ++n) _Pragma("unroll") for (int k = 0; k < 2; ++k) \
        acc[ai][bj][m][n] = __builtin_amdgcn_mfma_f32_16x16x32_bf16(Bt[n][k], At[m][k], acc[ai][bj][m][n], 0, 0, 0); __builtin_amdgcn_s_setprio(0); } while (0)
#define PG8_MMA8(ai, bj, At, Bt) do { __builtin_amdgcn_s_setprio(1); _Pragma("unroll") for (int m = 0; m < 4; ++m) _Pragma("unroll") for (int n = 0; n < 2; ++n) \
        acc[ai][bj][m][n] = __builtin_amdgcn_mfma_scale_f32_16x16x128_f8f6f4(Bt[n], At[m], acc[ai][bj][m][n], 0, 0, 0, 0, 0, 0); __builtin_amdgcn_s_setprio(0); } while (0)
#define LDA_(b, h) do { if constexpr (FP8) PG8_LDA8(At8, b, h); else PG8_LDA(At, b, h); } while (0)
#define LDB0_(b, h) do { if constexpr (FP8) PG8_LDB8(B08, b, h); else PG8_LDB(B0, b, h); } while (0)
#define LDB1_(b, h) do { if constexpr (FP8) PG8_LDB8(B18, b, h); else PG8_LDB(B1, b, h); } while (0)
#define MMA0_(ai, bj) do { if constexpr (FP8) PG8_MMA8(ai, bj, At8, B08); else PG8_MMA(ai, bj, At, B0); } while (0)
#define MMA1_(ai, bj) do { if constexpr (FP8) PG8_MMA8(ai, bj, At8, B18); else PG8_MMA(ai, bj, At, B1); } while (0)
#define PG8_WAIT_V(n) asm volatile("s_waitcnt vmcnt(" #n ")" ::: "memory")
#define PG8_WAIT_L(n) asm volatile("s_waitcnt lgkmcnt(" #n ")" ::: "memory")
#define PG8_BAR __builtin_amdgcn_s_barrier()
#define PG8_SCHED __builtin_amdgcn_sched_barrier(0)
    Unit cur, nxt; int ui = 0;
    if (!S.next(0, cur)) return;
    f32x4 acc[2][2][4][2];
#pragma unroll
    for (int a = 0; a < 2; ++a)
#pragma unroll
        for (int b = 0; b < 2; ++b)
#pragma unroll
            for (int m = 0; m < 4; ++m)
#pragma unroll
                for (int n = 0; n < 2; ++n) acc[a][b][m][n] = (f32x4){0.f, 0.f, 0.f, 0.f};
    bf16x8 At[4][2], B0[2][2], B1[2][2]; v8i At8[4], B08[2], B18[2];
    const char* cA = S.a_base(cur); const char* cB = S.b_base(cur);
    S.a_ready(cur);
    constexpr bool GATHER = Sched::GATHER;
    unsigned vA[1][2];
    LAS unsigned* goff = (LAS unsigned*)(lds + STAGE_BYTES) + tid;
    int gslot = 0;
    constexpr bool LOFF = GATHER || FP8;
    if constexpr (!GATHER && FP8) { goff[8 * 512] = voffB[0]; goff[9 * 512] = voffB[1]; goff[10 * 512] = (unsigned)(Rr[0] * K + Cc[0]) * 2u; goff[11 * 512] = (unsigned)(Rr[1] * K + Cc[1]) * 2u; }
    if constexpr (GATHER) { unsigned t4[2][2]; S.a_voff(cur, Rr, Cc, t4); goff[0 * 512] = t4[0][0]; goff[1 * 512] = t4[0][1]; goff[2 * 512] = t4[1][0]; goff[3 * 512] = t4[1][1]; goff[8 * 512] = voffB[0]; goff[9 * 512] = voffB[1]; }
    else {
#pragma unroll
        for (int i = 0; i < 2; ++i) vA[0][i] = (unsigned)(Rr[i] * K + Cc[i]) * 2u; }
    const size_t ahstep = GATHER ? 0 : hstep;
#define PG8_STAGE_B(bufoff, kptr) do { if constexpr (LOFF) { unsigned _o[2]; _o[0] = goff[8 * 512]; _o[1] = goff[9 * 512]; PG8_STAGE(bufoff, kptr, _o); } else PG8_STAGE(bufoff, kptr, voffB); } while (0)
#define PG8_STAGE_A(bufoff, kptr, h, nx) do { if constexpr (GATHER) { unsigned _o[2]; const int _s = (gslot ^ (nx)) * 2048 + (h) * 1024; _o[0] = goff[_s]; _o[1] = goff[_s + 512]; PG8_STAGE(bufoff, kptr, _o); } \
        else if constexpr (FP8) { unsigned _o[2]; _o[0] = goff[10 * 512]; _o[1] = goff[11 * 512]; PG8_STAGE(bufoff, (kptr) + (h) * ahstep, _o); } \
        else PG8_STAGE(bufoff, (kptr) + (h) * ahstep, vA[0]); } while (0)
    PG8_STAGE(PG8_SB(0, 0), cB, voffB); PG8_STAGE(PG8_SB(0, 1), cB + hstep, voffB); PG8_STAGE_A(PG8_SA(0, 0), cA, 0, 0); PG8_STAGE_A(PG8_SA(0, 1), cA, 1, 0);
    if (wr == 1) PG8_BAR;
    PG8_WAIT_V(2); PG8_BAR;
    PG8_STAGE(PG8_SB(1, 0), cB + kstep, voffB); PG8_STAGE_A(PG8_SA(1, 0), cA + kstep, 0, 0); PG8_STAGE(PG8_SB(1, 1), cB + hstep + kstep, voffB);
    PG8_WAIT_V(6); PG8_BAR;
    for (;;) {
        const bool has_next = S.next(ui + 1, nxt);
        const char* nA = has_next ? S.a_base(nxt) : cA; const char* nB = has_next ? S.b_base(nxt) : cB;
        if constexpr (GATHER) { if (has_next) { unsigned t4[2][2]; int tl_ = tid; asm volatile("" : "+v"(tl_)); int R2[2], C2[2]; stage_rc(tl_ * 16, R2[0], C2[0]); stage_rc(tl_ * 16 + 8192, R2[1], C2[1]); S.a_voff(nxt, R2, C2, t4); const int o = (gslot ^ 1) * 2048; goff[o] = t4[0][0]; goff[o + 512] = t4[0][1]; goff[o + 1024] = t4[1][0]; goff[o + 1536] = t4[1][1]; } }
#pragma unroll 1
        for (int t = 0; t < nt; t += 2) {
            const bool last = (t == nt - 2);
            const char* a1 = cA + (size_t)(t + 1) * kstep;
            const char* a2 = last ? nA : cA + (size_t)(t + 2) * kstep; const char* b2 = last ? nB : cB + (size_t)(t + 2) * kstep;
            const char* a3 = a2 + kstep; const char* b3 = b2 + kstep;
            if (last && has_next) S.a_ready(nxt);
            const int nx = (last && has_next) ? 1 : 0;
            LDB0_(0, 0); LDB1_(0, 1); PG8_SCHED; LDA_(0, 0); PG8_STAGE_A(PG8_SA(1, 1), a1, 1, 0);
            PG8_WAIT_V(8); PG8_WAIT_L(0); PG8_BAR; MMA0_(0, 0); MMA1_(0, 1); PG8_BAR; PG8_SCHED;
            LDA_(0, 1); PG8_STAGE_B(PG8_SB(0, 0), b2); PG8_STAGE_B(PG8_SB(0, 1), b2 + hstep); PG8_STAGE_A(PG8_SA(0, 0), a2, 0, nx);
            PG8_WAIT_V(8); PG8_WAIT_L(0); PG8_BAR; MMA0_(1, 0); MMA1_(1, 1); PG8_BAR; PG8_SCHED;
            LDB0_(1, 0); LDB1_(1, 1); PG8_SCHED; LDA_(1, 0); PG8_STAGE_A(PG8_SA(0, 1), a2, 1, nx);
            PG8_WAIT_V(8); PG8_WAIT_L(0); PG8_BAR; MMA0_(0, 0); MMA1_(0, 1); PG8_BAR; PG8_SCHED;
            LDA_(1, 1); PG8_STAGE_B(PG8_SB(1, 0), b3); PG8_STAGE_B(PG8_SB(1, 1), b3 + hstep); PG8_STAGE_A(PG8_SA(1, 0), a3, 0, nx);
            PG8_WAIT_V(8); PG8_WAIT_L(0); PG8_BAR; MMA0_(1, 0); MMA1_(1, 1); PG8_BAR; PG8_SCHED;
        }
        if constexpr (ALIGN_EPI) { if (wr == 0) PG8_BAR; }
        { int fr2 = fr, fq2 = fq; asm volatile("" : "+v"(fr2), "+v"(fq2));
          E(acc, cur, wr, wc, fr2, fq2); } S.done(cur);
        if (!has_next) break;
#pragma unroll
        for (int a = 0; a < 2; ++a)
#pragma unroll
            for (int b = 0; b < 2; ++b)
#pragma unroll
                for (int m = 0; m < 4; ++m)
#pragma unroll
                    for (int n = 0; n < 2; ++n) acc[a][b][m][n] = (f32x4){0.f, 0.f, 0.f, 0.f};
        cur = nxt; cA = nA; cB = nB; ++ui;
        if constexpr (GATHER) gslot ^= 1;
        if constexpr (ALIGN_EPI) { if (wr == 1) PG8_BAR; }
    }
    PG8_WAIT_V(0);
    if constexpr (!ALIGN_EPI) { if (wr == 0) PG8_BAR; }
    PG8_BAR;
#undef PG8_SA
#undef PG8_SB
#undef PG8_STAGE
#undef PG8_STAGE_A
#undef PG8_STAGE_B
#undef PG8_LDA
#undef PG8_LDB
#undef PG8_MMA
#undef PG8_MMA8
#undef PG8_LDA8
#undef PG8_LDB8
#undef LDA_
#undef LDB0_
#undef LDB1_
#undef MMA0_
#undef MMA1_
#undef PG8_WAIT_V
#undef PG8_WAIT_L
#undef PG8_BAR
#undef PG8_SCHED
}

struct EpiProj {
    static constexpr bool PERM = true;
    bf16* O; float asc;
    __device__ __forceinline__ void operator()(const f32x4 (&acc)[2][2][4][2], const Unit& u, int wr, int wc, int fr, int fq) const {
        const int row0 = u.pm * BM + wr * 64 + fr, col0 = u.pn * BM + wc * 32 + 8 * fq;
        const bool act = u.pn < 4;
#pragma unroll
        for (int ai = 0; ai < 2; ++ai)
#pragma unroll
            for (int m = 0; m < 4; ++m) { bf16* rowp = O + (size_t)(row0 + ai * HALF + m * 16) * DIN + col0;
#pragma unroll
                for (int bj = 0; bj < 2; ++bj) { f32x4 v0 = acc[ai][bj][m][0] * asc, v1 = acc[ai][bj][m][1] * asc;
                    if (act) {
#pragma unroll
                        for (int j = 0; j < 4; ++j) { v0[j] = gelu_tanh(v0[j]); v1[j] = gelu_tanh(v1[j]); } }
                    u32x4 w; w.x = cvt_pk_bf16(v0[0], v0[1]); w.y = cvt_pk_bf16(v0[2], v0[3]); w.z = cvt_pk_bf16(v1[0], v1[1]); w.w = cvt_pk_bf16(v1[2], v1[3]);
                    *(u32x4*)(rowp + bj * HALF) = w; } }
    }
};
template <bool RES_BF16> struct EpiResid {
    static constexpr bool PERM = true; static constexpr float ASC = OP8(RES_BF16 ? 1 : 0) ? 1.f / WOUT_SCALE : 1.f;
    const void* res; bf16* out;
    __device__ __forceinline__ void operator()(const f32x4 (&acc)[2][2][4][2], const Unit& u, int wr, int wc, int fr, int fq) const {
        const int row0 = u.pm * BM + wr * 64 + fr, col0 = u.pn * BM + wc * 32 + 8 * fq;
#pragma unroll
        for (int ai = 0; ai < 2; ++ai) {
            if constexpr (RES_BF16) {
                u32x4 r[4][2];
#pragma unroll
                for (int m = 0; m < 4; ++m)
#pragma unroll
                    for (int bj = 0; bj < 2; ++bj) r[m][bj] = __builtin_nontemporal_load((const u32x4*)((const bf16*)res + (size_t)(row0 + ai * HALF + m * 16) * DM + col0 + bj * HALF));
                asm volatile("s_waitcnt vmcnt(0)" ::: "memory");
#pragma unroll
                for (int m = 0; m < 4; ++m)
#pragma unroll
                    for (int bj = 0; bj < 2; ++bj) { f32x4 v0 = acc[ai][bj][m][0] * ASC, v1 = acc[ai][bj][m][1] * ASC; const u32x4 q = r[m][bj];
                        v0[0] += bf_lo(q.x); v0[1] += bf_hi(q.x); v0[2] += bf_lo(q.y); v0[3] += bf_hi(q.y); v1[0] += bf_lo(q.z); v1[1] += bf_hi(q.z); v1[2] += bf_lo(q.w); v1[3] += bf_hi(q.w);
                        u32x4 w; w.x = cvt_pk_bf16(v0[0], v0[1]); w.y = cvt_pk_bf16(v0[2], v0[3]); w.z = cvt_pk_bf16(v1[0], v1[1]); w.w = cvt_pk_bf16(v1[2], v1[3]);
                        *(u32x4*)(out + (size_t)(row0 + ai * HALF + m * 16) * DM + col0 + bj * HALF) = w; }
            } else {
#pragma unroll
                for (int mh = 0; mh < 2; ++mh) {
                    f32x4 r[2][2][2];
#pragma unroll
                    for (int m = 0; m < 2; ++m)
#pragma unroll
                        for (int bj = 0; bj < 2; ++bj) { const float* rp = (const float*)res + (size_t)(row0 + ai * HALF + (2 * mh + m) * 16) * DM + col0 + bj * HALF; r[m][bj][0] = __builtin_nontemporal_load((const f32x4*)rp); r[m][bj][1] = __builtin_nontemporal_load((const f32x4*)(rp + 4)); }
                    asm volatile("s_waitcnt vmcnt(0)" ::: "memory");
#pragma unroll
                    for (int m = 0; m < 2; ++m)
#pragma unroll
                        for (int bj = 0; bj < 2; ++bj) { const f32x4 v0 = acc[ai][bj][2 * mh + m][0] * ASC + r[m][bj][0], v1 = acc[ai][bj][2 * mh + m][1] * ASC + r[m][bj][1];
                            u32x4 w; w.x = cvt_pk_bf16(v0[0], v0[1]); w.y = cvt_pk_bf16(v0[2], v0[3]); w.z = cvt_pk_bf16(v1[0], v1[1]); w.w = cvt_pk_bf16(v1[2], v1[3]);
                            *(u32x4*)(out + (size_t)(row0 + ai * HALF + (2 * mh + m) * 16) * DM + col0 + bj * HALF) = w; }
                }
            }
        }
    }
};
struct EpiSwiGLU {
    static constexpr bool PERM = true;
    unsigned char* HB; const float* rslot;
    __device__ __forceinline__ void operator()(const f32x4 (&acc)[2][2][4][2], const Unit& u, int wr, int wc, int fr, int fq) const {
        const int row0 = u.pm * BM + wr * 64 + fr, col0 = u.pn * HALF + wc * 32 + 8 * fq;
        const __amdgpu_buffer_rsrc_t rsrc = __builtin_amdgcn_make_buffer_rsrc((void*)HB, 0, 40960 * DE, 0x00020000);
        const float* rsl = rslot + (size_t)u.e * TOKCAP + u.rb * BM + wr * 64 + fr;
#pragma unroll
        for (int ai = 0; ai < 2; ++ai) {
            float rsv[4];
#pragma unroll
            for (int m = 0; m < 4; ++m) rsv[m] = rsl[ai * HALF + m * 16];
            asm volatile("s_waitcnt vmcnt(0)" ::: "memory");
#pragma unroll
            for (int m = 0; m < 4; ++m) { const unsigned boff = (unsigned)((row0 + ai * HALF + m * 16) * DE + col0);
                const float rs = rsv[m] * (1.f / W1_SCALE);
                float h[8];
#pragma unroll
                for (int n = 0; n < 2; ++n)
#pragma unroll
                    for (int j = 0; j < 4; ++j) { const float g = acc[ai][0][m][n][j] * rs, up = acc[ai][1][m][n][j] * rs; h[n * 4 + j] = g * sigmoidf_(g) * up; }
                u32x2 w; w.x = pk4_fp8(h[0], h[1], h[2], h[3]); w.y = pk4_fp8(h[4], h[5], h[6], h[7]);
                __builtin_amdgcn_raw_buffer_store_b64(w, rsrc, boff, 0, 16); } }
    }
};
struct EpiY {
    static constexpr bool PERM = true;
    unsigned char* Y;
    __device__ __forceinline__ void operator()(const f32x4 (&acc)[2][2][4][2], const Unit& u, int wr, int wc, int fr, int fq) const {
        const int row0 = u.pm * BM + wr * 64 + fr, col0 = u.pn * BM + wc * 32 + 8 * fq;
#pragma unroll
        for (int ai = 0; ai < 2; ++ai)
#pragma unroll
            for (int m = 0; m < 4; ++m) { unsigned char* rowp = Y + (size_t)(row0 + ai * HALF + m * 16) * DM + col0;
#pragma unroll
                for (int bj = 0; bj < 2; ++bj) { const f32x4 v0 = acc[ai][bj][m][0] * (Y_SCALE / W2_SCALE), v1 = acc[ai][bj][m][1] * (Y_SCALE / W2_SCALE);
                    u32x2 w; w.x = pk4_fp8(v0[0], v0[1], v0[2], v0[3]); w.y = pk4_fp8(v1[0], v1[1], v1[2], v1[3]);
                    *(u32x2*)(rowp + bj * HALF) = w; } }
    }
};

struct SchedG1 {
    static constexpr bool GATHER = true;
    const LAS int* tstart; const int* cnt; const int* tok; const bf16* X; const bf16* W1; int G, c; unsigned* ready;
    __device__ __forceinline__ void a_ready(const Unit&) const {}
    __device__ __forceinline__ void done(const Unit& u) const {
        asm volatile("s_waitcnt vmcnt(0)" ::: "memory");
        if (lane_now() == 0) __hip_atomic_fetch_add(ready + 64 * u.pm, 1u, __ATOMIC_RELAXED, __HIP_MEMORY_SCOPE_AGENT);
    }
    __device__ __forceinline__ bool next(int i, Unit& u) const {
        const int L = i * G + c, NT = __builtin_amdgcn_readfirstlane(tstart[NE]); if (L >= NT * 4) return false;
        const int T = L >> 2; const int e = tstart[560 + T];
        u.pm = __builtin_amdgcn_readfirstlane(T); u.pn = L & 3; u.e = __builtin_amdgcn_readfirstlane(e); u.rb = __builtin_amdgcn_readfirstlane(T - tstart[e]); return true;
    }
    static constexpr int KU = DM / 2;
    __device__ __forceinline__ const char* a_base(const Unit&) const { return (const char*)X; }
    __device__ __forceinline__ const char* b_base(const Unit& u) const { return (const char*)W1 + ((size_t)u.e * 1024 + (size_t)u.pn * BM) * DM; }
    __device__ __forceinline__ void a_voff(const Unit& u, const int (&R)[2], const int (&C)[2], unsigned (&v)[2][2]) const {
        const int n = cnt[u.e * 64]; const int* tl = tok + (size_t)u.e * TOKCAP;
#pragma unroll
        for (int h = 0; h < 2; ++h)
#pragma unroll
            for (int i = 0; i < 2; ++i) { int row = u.rb * BM + h * HALF + R[i]; row = row < n ? row : 0; const int t = tl[row]; v[h][i] = (unsigned)(t * KU + C[i]) * 2u; }
    }
};
struct SchedG2 {
    static constexpr bool GATHER = false;
    const LAS int* tstart; const bf16* HB; const bf16* W2; int G, c; unsigned* ready; unsigned* tmo; int wave;
    __device__ __forceinline__ bool next(int i, Unit& u) const {
        constexpr int K0 = 3;
        const int NT = __builtin_amdgcn_readfirstlane(tstart[NE]), n1 = 4 * NT, n1max = (n1 + G - 1) / G, R = n1 - G * (n1max - 1), nB = G - R;
        int L;
        if (c >= R) L = (i < K0) ? i * nB + (c - R) : K0 * nB + (i - K0) * G + c;
        else L = K0 * nB + i * G + c;
        if (L >= NT * 8) return false;
        const int T = L >> 3; const int e = tstart[560 + T];
        u.pm = __builtin_amdgcn_readfirstlane(T); u.pn = __builtin_amdgcn_readfirstlane(L & 7); u.e = __builtin_amdgcn_readfirstlane(e); u.rb = __builtin_amdgcn_readfirstlane(T - tstart[e]); return true;
    }
    __device__ __forceinline__ void done(const Unit&) const {}
    __device__ __forceinline__ void a_ready(const Unit& u) const {
        if (wave == 0) {
            unsigned polls = 0;
            while ((unsigned)__builtin_amdgcn_readfirstlane(__hip_atomic_load(ready + 64 * u.pm, __ATOMIC_RELAXED, __HIP_MEMORY_SCOPE_AGENT)) < 32u) {
                if (++polls > (1u << 22)) { if (lane_now() == 0) __hip_atomic_store(tmo, 0x600u | (unsigned)(u.pm & 0xff), __ATOMIC_RELAXED, __HIP_MEMORY_SCOPE_AGENT); break; }
                __builtin_amdgcn_s_sleep(2); }
            __builtin_amdgcn_fence(__ATOMIC_ACQUIRE, "agent");
            asm volatile("s_waitcnt vmcnt(0)" ::: "memory");
        }
        asm volatile("" ::: "memory"); __builtin_amdgcn_s_barrier(); asm volatile("" ::: "memory");
    }
    __device__ __forceinline__ const char* a_base(const Unit& u) const { return (const char*)HB + (size_t)u.pm * BM * DE; }
    __device__ __forceinline__ const char* b_base(const Unit& u) const { return (const char*)W2 + ((size_t)u.e * DM + (size_t)u.pn * BM) * DE; }
    __device__ __forceinline__ void a_voff(const Unit&, const int (&R)[2], const int (&C)[2], unsigned (&v)[2][2]) const {
#pragma unroll
        for (int h = 0; h < 2; ++h)
#pragma unroll
            for (int i = 0; i < 2; ++i) v[h][i] = (unsigned)((h * HALF + R[i]) * DE + C[i]) * 2u;
    }
};
}

struct Params { const float* in[22]; float* out; unsigned char* ws; int ph_lo, ph_hi; };
enum { IN_X = 0, IN_NORM1, IN_WIN, IN_SGUN, IN_SGUW, IN_SGUB, IN_CONVW, IN_CONVB, IN_LNG, IN_LNB, IN_QN, IN_KN, IN_OUTN, IN_WOUT, IN_NORM2, IN_WRG, IN_BRG, IN_WRE, IN_BRE, IN_WG, IN_WU, IN_WD };

struct Frame {
    LAS unsigned char* lds; volatile LAS unsigned* MISC;
    int tid, lane, wave, vcu, G;
    const float* const* in; float* out; unsigned char* ws;
};

__device__ __forceinline__ void tile_desc(const float* const* in, unsigned char* ws, int it, const float*& src, int& ldw, unsigned char*& dst, int& pitch, const float*& ksc, float& wsc, int& fp8) {
    constexpr int T_IN = 32 * 80, T_OUT = 32 * 32, T_E = 32 * 8, T_D = 8 * 32;
    constexpr int T_LAYER = T_IN + T_OUT + NE * (2 * T_E + T_D);
    const int l = it / T_LAYER; int r = it % T_LAYER; ksc = nullptr; wsc = 1.f; fp8 = 0;
    if (r < T_IN) { ldw = DIN;
        if (IP8(l)) { const int kb = r / 160, nb = r % 160; pitch = DM; fp8 = 1; wsc = WIN_SCALE; src = in[IN_WIN] + (size_t)l * DM * DIN + (size_t)(128 * kb) * DIN + 32 * nb; dst = ws + WS_WIN + (size_t)l * DIN * DM * 2 + ((size_t)32 * nb) * DM + 128 * kb; }
        else { const int kb = r / 80, nb = r % 80; pitch = DM * 2; src = in[IN_WIN] + (size_t)l * DM * DIN + (size_t)(64 * kb) * DIN + 64 * nb; dst = ws + WS_WIN + (((size_t)l * DIN + 64 * nb) * DM + 64 * kb) * 2; }
        return; } r -= T_IN;
    if (r < T_OUT) { const int kb = r / 32, nb = r % 32; ldw = DM; src = in[IN_WOUT] + (size_t)l * DM * DM + (size_t)(64 * kb) * DM + 64 * nb;
        if (OP8(l)) { const int kb8 = r / 64, nb8 = r % 64; pitch = DM; fp8 = 1; wsc = WOUT_SCALE; src = in[IN_WOUT] + (size_t)l * DM * DM + (size_t)(128 * kb8) * DM + 32 * nb8; dst = ws + WS_WOUT + (size_t)l * DM * DM * 2 + ((size_t)32 * nb8) * DM + 128 * kb8; } else { pitch = DM * 2; dst = ws + WS_WOUT + (((size_t)l * DM + 64 * nb) * DM + 64 * kb) * 2; }
        return; } r -= T_OUT;
    const int e = r / (2 * T_E + T_D); r %= (2 * T_E + T_D);
    const size_t le = (size_t)l * NE + e; fp8 = 1;
    if (r < 2 * T_E) { const int up = r >= T_E; r -= up * T_E; const int kb = r / 16, nb = r % 16, n0 = 32 * nb; ldw = DE; pitch = DM; wsc = W1_SCALE;
        src = (up ? in[IN_WU] : in[IN_WG]) + le * DM * DE + (size_t)(128 * kb) * DE + n0; dst = ws + WS_W1 + (le * 1024 + (size_t)((n0 / 128) * 256 + up * 128 + (n0 % 128))) * DM + 128 * kb; ksc = in[IN_NORM2] + (size_t)l * DM + 128 * kb; return; }
    r -= 2 * T_E;
    { const int kb = r / 64, nb = r % 64; ldw = DM; pitch = DE; wsc = W2_SCALE; src = in[IN_WD] + le * DE * DM + (size_t)(128 * kb) * DM + 32 * nb; dst = ws + WS_W2 + (le * DM + 32 * nb) * DE + 128 * kb; }
}
#define TR_LOAD(V, src, ldw, fp8) do { if (fp8) { _Pragma("unroll") for (int i = 0; i < 16; ++i) V[i] = __builtin_nontemporal_load((const f32x4*)((src) + (size_t)(16 * (lane >> 3) + i) * (ldw) + 4 * (lane & 7))); } \
    else { _Pragma("unroll") for (int i = 0; i < 16; ++i) V[i] = __builtin_nontemporal_load((const f32x4*)((src) + (size_t)(4 * i + (lane >> 4)) * (ldw) + 4 * (lane & 15))); } } while (0)
#define TR_PROC(V, dst, pitch, ksc, wsc, fp8) do { \
    if (fp8) {        \
        f32x4 s_[4]; if (ksc) { _Pragma("unroll") for (int q = 0; q < 4; ++q) s_[q] = *(const f32x4*)((ksc) + 16 * (lane >> 3) + 4 * q) * (wsc); } else { _Pragma("unroll") for (int q = 0; q < 4; ++q) s_[q] = (f32x4){(wsc), (wsc), (wsc), (wsc)}; } \
        _Pragma("unroll") for (int c = 0; c < 4; ++c) { u32x4 o; \
            _Pragma("unroll") for (int q = 0; q < 4; ++q) o[q] = pk4_fp8(V[4 * q][c] * s_[q][0], V[4 * q + 1][c] * s_[q][1], V[4 * q + 2][c] * s_[q][2], V[4 * q + 3][c] * s_[q][3]); \
            __builtin_nontemporal_store(o, (u32x4*)((dst) + (size_t)(4 * (lane & 7) + c) * (pitch) + 16 * (lane >> 3))); }     \
    } else { \
        _Pragma("unroll") for (int i = 0; i < 16; ++i) { const int kk = 4 * i + (lane >> 4); f32x4 v = V[i] * ((ksc) ? (ksc)[kk] * (wsc) : (wsc)); \
            LAS float* d = scr + kk * 65 + 4 * (lane & 15); d[0] = v[0]; d[1] = v[1]; d[2] = v[2]; d[3] = v[3]; } \
        LDS_WAIT(); \
        _Pragma("unroll") for (int j = 0; j < 8; ++j) { const int n = (lane >> 3) + 8 * j; const LAS float* sp = scr + (8 * (lane & 7)) * 65 + n; \
            u32x4 o; o.x = cvt_pk_bf16(sp[0], sp[65]); o.y = cvt_pk_bf16(sp[2 * 65], sp[3 * 65]); o.z = cvt_pk_bf16(sp[4 * 65], sp[5 * 65]); o.w = cvt_pk_bf16(sp[6 * 65], sp[7 * 65]); \
            *(u32x4*)((dst) + (size_t)n * (pitch) + 16 * (lane & 7)) = o; } } \
    LDS_WAIT(); } while (0)
__device__ __forceinline__ void norm_row_bf16(const float* xrow, const float* g, bf16* orow, int lane) {
    f32x4 v[8]; float s = 0.f;
#pragma unroll
    for (int j = 0; j < 8; ++j) { v[j] = __builtin_nontemporal_load((const f32x4*)(xrow + 4 * lane + 256 * j)); s += (v[j][0] * v[j][0] + v[j][1] * v[j][1]) + (v[j][2] * v[j][2] + v[j][3] * v[j][3]); }
    const float rs = __builtin_amdgcn_rsqf(wave_sum(s) * (1.f / DM) + EPS);
#pragma unroll
    for (int j = 0; j < 8; ++j) { const f32x4 gg = *(const f32x4*)(g + 4 * lane + 256 * j);
        u32x2 o; o.x = cvt_pk_bf16(v[j][0] * rs * gg[0], v[j][1] * rs * gg[1]); o.y = cvt_pk_bf16(v[j][2] * rs * gg[2], v[j][3] * rs * gg[3]);
        *(u32x2*)(orow + 4 * lane + 256 * j) = o; }
}
constexpr int CV_P = 2560, CV_A = 28160 + 3584, CV_B = 2 * 28160;
__device__ __forceinline__ void convert_tiles(Frame& F, const int t_lo, const int T_TOTAL) {
    LAS float* scr = (LAS float*)(F.lds + F.wave * 16896);
    const int gw = F.vcu * NWAVES + F.wave, NGW = F.G * NWAVES, lane = F.lane;
    {
        f32x4 va[16], vb[16];
        const float* srcA; const float* srcB; unsigned char* dstA; unsigned char* dstB; const float* kA; const float* kB; int ldA, ldB, pA, pB, fA, fB; float wA, wB;
        int it = t_lo + gw;
        if (it < T_TOTAL) { tile_desc(F.in, F.ws, it, srcA, ldA, dstA, pA, kA, wA, fA); TR_LOAD(va, srcA, ldA, fA); }
        while (it < T_TOTAL) {
            const int itb = it + NGW;
            if (itb < T_TOTAL) { tile_desc(F.in, F.ws, itb, srcB, ldB, dstB, pB, kB, wB, fB); TR_LOAD(vb, srcB, ldB, fB); }
            TR_PROC(va, dstA, pA, kA, wA, fA);
            if (itb >= T_TOTAL) break;
            const int ita = itb + NGW;
            if (ita < T_TOTAL) { tile_desc(F.in, F.ws, ita, srcA, ldA, dstA, pA, kA, wA, fA); TR_LOAD(va, srcA, ldA, fA); }
            TR_PROC(vb, dstB, pB, kB, wB, fB);
            it = ita;
        }
    }
}
__device__ __forceinline__ void p_prologue(Frame& F) {
    const int gw = F.vcu * NWAVES + F.wave, NGW = F.G * NWAVES;
    convert_tiles(F, 0, CV_P);
    { bf16* SW = (bf16*)(F.ws + WS_SGUW); const int gt = gw * 64 + F.lane, NGT = NGW * 64;
      for (int idx = gt; idx < NLAYER * 4 * 8 * 4 * 64; idx += NGT) {
          const int ln = idx & 63, pp = (idx >> 6) & 3, itile = (idx >> 8) & 7, h = (idx >> 11) & 3, l = idx >> 13;
          const int i = 16 * itile + (ln & 15), gq = ln >> 4;
          const float* w = F.in[IN_SGUW] + ((size_t)(l * 4 + h) * 128 + i) * 128;
          float v[8];
#pragma unroll
          for (int jj = 0; jj < 8; ++jj) { const int j = 32 * pp + (jj < 4 ? 4 * gq + jj : 16 + 4 * gq + (jj - 4)); v[jj] = (j <= i) ? w[j] : 0.f; }
          u32x4 o; o.x = cvt_pk_bf16(v[0], v[1]); o.y = cvt_pk_bf16(v[2], v[3]); o.z = cvt_pk_bf16(v[4], v[5]); o.w = cvt_pk_bf16(v[6], v[7]);
          *(u32x4*)(SW + (size_t)idx * 8) = o; }
      bf16* WRF = (bf16*)(F.ws + WS_WRT);
      for (int idx = gt; idx < NLAYER * 64 * 3 * 64; idx += NGT) { const int ln = idx & 63, ct = (idx >> 6) % 3, ks = (idx / 192) & 63, l = idx / (192 * 64);
          const int o = 16 * ct + (ln & 15), k0 = 32 * ks + 8 * (ln >> 4);
          float v[8];
#pragma unroll
          for (int j = 0; j < 8; ++j) { const int k = k0 + j; const float wv = o < 32 ? F.in[IN_WRE][((size_t)l * DM + k) * NE + o] : (o < 36 ? F.in[IN_WRG][((size_t)l * DM + k) * 4 + (o - 32)] : 0.f);
              v[j] = wv * F.in[IN_NORM2][(size_t)l * DM + k]; }
          u32x4 hi, lo; hi.x = cvt_pk_bf16(v[0], v[1]); hi.y = cvt_pk_bf16(v[2], v[3]); hi.z = cvt_pk_bf16(v[4], v[5]); hi.w = cvt_pk_bf16(v[6], v[7]);
          lo.x = cvt_pk_bf16(v[0] - bf_lo(hi.x), v[1] - bf_hi(hi.x)); lo.y = cvt_pk_bf16(v[2] - bf_lo(hi.y), v[3] - bf_hi(hi.y));
          lo.z = cvt_pk_bf16(v[4] - bf_lo(hi.z), v[5] - bf_hi(hi.z)); lo.w = cvt_pk_bf16(v[6] - bf_lo(hi.w), v[7] - bf_hi(hi.w));
          bf16* dst = WRF + ((((size_t)l * 64 + ks) * 3 + ct) * 2 * 64 + ln) * 8;
          *(u32x4*)dst = hi; *(u32x4*)(dst + 512) = lo; } }
    bf16* HN = (bf16*)(F.ws + WS_HN);
    for (int m = gw; m < SEQ; m += NGW) norm_row_bf16(F.in[IN_X] + (size_t)m * DM, F.in[IN_NORM1], HN + (size_t)m * DM, F.lane);
}

__device__ __forceinline__ int vimg_off(int row, int c) { return row * 256 + ((((c >> 1) ^ (row & 7)) << 1) | (c & 1)) * 16; }
__device__ __forceinline__ bf16x8 tr_frag(const LAS unsigned char* img, int ra, int rb, int dt, int lane) {
    const int gq = lane >> 4, q = (lane & 15) >> 2, p = lane & 3;
    const int r0 = ra + 4 * gq + q, r1 = rb + 4 * gq + q, c = 2 * dt + (p >> 1);
    const s16x4 a = __builtin_amdgcn_ds_read_tr16_b64_v4i16((LAS s16x4*)(img + vimg_off(r0, c) + 8 * (p & 1)));
    const s16x4 b = __builtin_amdgcn_ds_read_tr16_b64_v4i16((LAS s16x4*)(img + vimg_off(r1, c) + 8 * (p & 1)));
    bf16x8 r; r[0] = a[0]; r[1] = a[1]; r[2] = a[2]; r[3] = a[3]; r[4] = b[0]; r[5] = b[1]; r[6] = b[2]; r[7] = b[3]; return r;
}
__device__ __forceinline__ void sgu_stage8(const bf16* vsrc, int j0, int w, int lane, const f32x4& g0, const f32x4& g1, LAS unsigned char* lds) {
    u32x4 raw[8];
#pragma unroll
    for (int j = 0; j < 8; ++j) raw[j] = *(const u32x4*)(vsrc + (size_t)(w + 8 * (j0 + j)) * DIN);
#pragma unroll
    for (int j = 0; j < 8; ++j) { const int row = w + 8 * (j0 + j);
        float x[8] = {bf_lo(raw[j].x), bf_hi(raw[j].x), bf_lo(raw[j].y), bf_hi(raw[j].y), bf_lo(raw[j].z), bf_hi(raw[j].z), bf_lo(raw[j].w), bf_hi(raw[j].w)};
        float s = 0.f;
#pragma unroll
        for (int e = 0; e < 8; ++e) s += x[e] * x[e];
        const float rs = __builtin_amdgcn_rsqf(wave_sum(s) * (1.f / 512.f) + EPS);
        u32x4 o; o.x = cvt_pk_bf16(x[0] * rs * g0[0], x[1] * rs * g0[1]); o.y = cvt_pk_bf16(x[2] * rs * g0[2], x[3] * rs * g0[3]);
        o.z = cvt_pk_bf16(x[4] * rs * g1[0], x[5] * rs * g1[1]); o.w = cvt_pk_bf16(x[6] * rs * g1[2], x[7] * rs * g1[3]);
        *(LAS u32x4*)(lds + (lane >> 4) * 32768 + vimg_off(row, lane & 15)) = o; }
}
__device__ __forceinline__ void sgu_item(Frame& F, int l, int chunk, int half) {
    const bf16* PROJ = (const bf16*)(F.ws + WS_PROJ); bf16* MIX = (bf16*)(F.ws + WS_MIX);
    const int p0 = chunk * 128, lane = F.lane, w = F.wave;
    LAS float* red = (LAS float*)(F.lds + MISC_OFF + 256);
    const float* gn = F.in[IN_SGUN] + l * 512;
    const f32x4 g0 = *(const f32x4*)(gn + 8 * lane), g1 = *(const f32x4*)(gn + 8 * lane + 4);
    const bf16* vsrc = PROJ + (size_t)p0 * DIN + OFF_V + 8 * lane;
    sgu_stage8(vsrc, 0, w, lane, g0, g1, F.lds);
    if (half) sgu_stage8(vsrc, 8, w, lane, g0, g1, F.lds);
    const int h = w >> 1, ih = w & 1, gq = lane >> 4, fr = lane & 15;
    const LAS unsigned char* img = F.lds + h * 32768;
    const bf16* SW = (const bf16*)(F.ws + WS_SGUW) + (size_t)(l * 4 + h) * 8 * 4 * 64 * 8;
    const float* bs = F.in[IN_SGUB] + (size_t)(l * 4 + h) * 128;
    const float* og = F.in[IN_OUTN] + (size_t)l * DM + h * 128 + 4 * gq;
    const int it0 = ih + 4 * half;
    u32x2 ur[2][8];
#pragma unroll
    for (int ii = 0; ii < 2; ++ii) { const bf16* urow = PROJ + (size_t)(p0 + 16 * (it0 + 2 * ii) + fr) * DIN + OFF_U + h * 128 + 4 * gq;
#pragma unroll
        for (int dt = 0; dt < 8; ++dt) ur[ii][dt] = *(const u32x2*)(urow + 16 * dt); }
    __syncthreads();
    f32x4 z[2][8];
#pragma unroll
    for (int ii = 0; ii < 2; ++ii)
#pragma unroll
        for (int dt = 0; dt < 8; ++dt) z[ii][dt] = (f32x4){0.f, 0.f, 0.f, 0.f};
#pragma unroll 1
    for (int pp = 0; pp <= (it0 + 2) / 2; ++pp) {
        const bf16x8 bw0 = *(const bf16x8*)(SW + ((size_t)(it0 * 4 + pp) * 64 + lane) * 8);
        const bf16x8 bw1 = *(const bf16x8*)(SW + ((size_t)((it0 + 2) * 4 + pp) * 64 + lane) * 8);
        const bool do0 = pp <= it0 / 2;
#pragma unroll
        for (int dt = 0; dt < 8; ++dt) { const bf16x8 a = tr_frag(img, 32 * pp, 32 * pp + 16, dt, lane);
            if (do0) z[0][dt] = __builtin_amdgcn_mfma_f32_16x16x32_bf16(a, bw0, z[0][dt], 0, 0, 0);
            z[1][dt] = __builtin_amdgcn_mfma_f32_16x16x32_bf16(a, bw1, z[1][dt], 0, 0, 0); }
    }
#pragma unroll
    for (int ii = 0; ii < 2; ++ii) { const int i = 16 * (it0 + 2 * ii) + fr; const float bi = bs[i]; float s = 0.f;
#pragma unroll
        for (int dt = 0; dt < 8; ++dt) { const u32x2 u2 = ur[ii][dt];
            f32x4 y; y[0] = bf_lo(u2.x) * (z[ii][dt][0] + bi); y[1] = bf_hi(u2.x) * (z[ii][dt][1] + bi); y[2] = bf_lo(u2.y) * (z[ii][dt][2] + bi); y[3] = bf_hi(u2.y) * (z[ii][dt][3] + bi);
            z[ii][dt] = y; s += (y[0] * y[0] + y[1] * y[1]) + (y[2] * y[2] + y[3] * y[3]); }
        s += __shfl_xor(s, 16); s += __shfl_xor(s, 32);
        if (gq == 0) red[i * 4 + h] = s; }
    __syncthreads();
#pragma unroll
    for (int ii = 0; ii < 2; ++ii) { const int i = 16 * (it0 + 2 * ii) + fr;
        const f32x4 rr = *(const LAS f32x4*)(red + i * 4);
        const float rs = __builtin_amdgcn_rsqf(((rr[0] + rr[1]) + (rr[2] + rr[3])) * (1.f / 512.f) + EPS);
        bf16* orow = MIX + (size_t)(p0 + i) * DM + h * 128 + 4 * gq;
#pragma unroll
        for (int dt = 0; dt < 8; ++dt) { const f32x4 gg = *(const f32x4*)(og + 16 * dt); const f32x4 y = z[ii][dt];
            if (OP8(l)) *(unsigned*)((unsigned char*)MIX + (size_t)(p0 + i) * DM + h * 128 + 4 * gq + 16 * dt) = pk4_fp8(y[0] * rs * gg[0], y[1] * rs * gg[1], y[2] * rs * gg[2], y[3] * rs * gg[3]);
            else { u32x2 o; o.x = cvt_pk_bf16(y[0] * rs * gg[0], y[1] * rs * gg[1]); o.y = cvt_pk_bf16(y[2] * rs * gg[2], y[3] * rs * gg[3]);
            *(u32x2*)(orow + 16 * dt) = o; } } }
    __syncthreads();
}

__device__ __forceinline__ void conv_item(Frame& F, int l, int tile) {
    const bf16* PROJ = (const bf16*)(F.ws + WS_PROJ); bf16* MIX = (bf16*)(F.ws + WS_MIX);
    constexpr int TP = 32, NR = TP + 30;
    const int p0 = tile * TP, c = F.tid, tid = F.tid;
    LAS float* cbuf = (LAS float*)F.lds;
    LAS bf16* zbuf = (LAS bf16*)(F.lds + 65536);
    { u32x4 av[8], gv[8];
#pragma unroll
      for (int i = 0; i < 8; ++i) { const int id = tid + NTHREADS * i, row = id >> 6, ch = (id & 63) * 8; int p = p0 - 30 + row; p = p < 0 ? 0 : p; p = row < NR ? p : 0;
          av[i] = *(const u32x4*)(PROJ + (size_t)p * DIN + OFF_A + ch); gv[i] = *(const u32x4*)(PROJ + (size_t)p * DIN + OFF_G + ch); }
#pragma unroll
      for (int i = 0; i < 8; ++i) { const int id = tid + NTHREADS * i, row = id >> 6, ch = (id & 63) * 8; const bool live = (p0 - 30 + row) >= 0;
          const unsigned au[4] = {av[i].x, av[i].y, av[i].z, av[i].w}, gu[4] = {gv[i].x, gv[i].y, gv[i].z, gv[i].w}; u32x4 o; unsigned ou[4];
#pragma unroll
          for (int e = 0; e < 4; ++e) { const float z0 = bf_lo(au[e]) * sigmoidf_(bf_lo(gu[e])), z1 = bf_hi(au[e]) * sigmoidf_(bf_hi(gu[e])); ou[e] = live ? cvt_pk_bf16(z0, z1) : 0u; }
          o.x = ou[0]; o.y = ou[1]; o.z = ou[2]; o.w = ou[3];
          if (row < NR) *(LAS u32x4*)(zbuf + row * 512 + ch) = o; } }
    float wk[CONV_K];
#pragma unroll
    for (int k = 0; k < CONV_K; ++k) wk[k] = F.in[IN_CONVW][((size_t)l * CONV_K + k) * 512 + c];
    const float cb = F.in[IN_CONVB][l * 512 + c];
    __syncthreads();
#define CONV_Z(r) __builtin_bit_cast(float, (unsigned)zbuf[(r) * 512 + c] << 16)
    float win[30];
#pragma unroll
    for (int r = 0; r < 30; ++r) win[r] = CONV_Z(r);
#pragma unroll
    for (int q = 0; q < TP; ++q) { const float zv = CONV_Z(30 + q); float acc = cb + wk[30] * zv;
#pragma unroll
        for (int k = 0; k < 30; ++k) acc += wk[k] * win[(k + q) % 30];
        win[q % 30] = zv; cbuf[q * 512 + c] = acc; }
#undef CONV_Z
    __syncthreads();
    const float* lg = F.in[IN_LNG] + l * 512 + 8 * F.lane; const float* lb = F.in[IN_LNB] + l * 512 + 8 * F.lane; const float* og = F.in[IN_OUTN] + (size_t)l * DM + 512 + 8 * F.lane;
    const f32x4 lg0 = *(const f32x4*)lg, lg1 = *(const f32x4*)(lg + 4), lb0 = *(const f32x4*)lb, lb1 = *(const f32x4*)(lb + 4), og0 = *(const f32x4*)og, og1 = *(const f32x4*)(og + 4);
    for (int r = F.wave; r < TP; r += NWAVES) {
        const f32x4 a0 = *(const LAS f32x4*)(cbuf + r * 512 + 8 * F.lane), a1 = *(const LAS f32x4*)(cbuf + r * 512 + 8 * F.lane + 4);
        float x[8] = {a0[0], a0[1], a0[2], a0[3], a1[0], a1[1], a1[2], a1[3]};
        float s = 0.f;
#pragma unroll
        for (int e = 0; e < 8; ++e) s += x[e];
        const float mu = wave_sum(s) * (1.f / 512.f); float q2 = 0.f;
#pragma unroll
        for (int e = 0; e < 8; ++e) { x[e] -= mu; q2 += x[e] * x[e]; }
        const float rstd = __builtin_amdgcn_rsqf(wave_sum(q2) * (1.f / 512.f) + EPS);
        const float gam[8] = {lg0[0], lg0[1], lg0[2], lg0[3], lg1[0], lg1[1], lg1[2], lg1[3]}, bet[8] = {lb0[0], lb0[1], lb0[2], lb0[3], lb1[0], lb1[1], lb1[2], lb1[3]};
        float s2 = 0.f;
#pragma unroll
        for (int e = 0; e < 8; ++e) { const float y = x[e] * rstd * gam[e] + bet[e]; x[e] = y * sigmoidf_(y); s2 += x[e] * x[e]; }
        const float rs = __builtin_amdgcn_rsqf(wave_sum(s2) * (1.f / 512.f) + EPS);
        if (OP8(l)) { u32x2 o8; o8.x = pk4_fp8(x[0] * rs * og0[0], x[1] * rs * og0[1], x[2] * rs * og0[2], x[3] * rs * og0[3]); o8.y = pk4_fp8(x[4] * rs * og1[0], x[5] * rs * og1[1], x[6] * rs * og1[2], x[7] * rs * og1[3]);
            *(u32x2*)((unsigned char*)MIX + (size_t)(p0 + r) * DM + 512 + 8 * F.lane) = o8; }
        else {
        u32x4 o; o.x = cvt_pk_bf16(x[0] * rs * og0[0], x[1] * rs * og0[1]); o.y = cvt_pk_bf16(x[2] * rs * og0[2], x[3] * rs * og0[3]);
        o.z = cvt_pk_bf16(x[4] * rs * og1[0], x[5] * rs * og1[1]); o.w = cvt_pk_bf16(x[6] * rs * og1[2], x[7] * rs * og1[3]);
        *(u32x4*)(MIX + (size_t)(p0 + r) * DM + 512 + 8 * F.lane) = o; }
    }
    __syncthreads();
}

__device__ __forceinline__ int kimg_off(int row, int c) { return row * 256 + ((c ^ (row & 15)) << 4); }
__device__ __forceinline__ bf16x8 tr_frag2(const LAS unsigned char* vs, int ta, int tb, int dt, int lane) {
    const int gq = lane >> 4, q = (lane & 15) >> 2, p = lane & 3, c = 2 * dt + (p >> 1), rr = 4 * gq + q;
    const int off = rr * 256 + ((((c >> 1) ^ (rr & 7)) << 1) | (c & 1)) * 16 + 8 * (p & 1);
    const s16x4 a = __builtin_amdgcn_ds_read_tr16_b64_v4i16((LAS s16x4*)(vs + ta + off));
    const s16x4 b = __builtin_amdgcn_ds_read_tr16_b64_v4i16((LAS s16x4*)(vs + tb + off));
    bf16x8 r; r[0] = a[0]; r[1] = a[1]; r[2] = a[2]; r[3] = a[3]; r[4] = b[0]; r[5] = b[1]; r[6] = b[2]; r[7] = b[3]; return r;
}
#define ATT_DECODE(st) const int run_ = (int)blockIdx.x + F.G * ((st) / 5), b_ = (st) % 5 - 1; const int g = run_ >> 8, h = (run_ >> 5) & 7, rr_ = run_ & 31; \
    const int sh = 2 * g, dil = 1 << sh, rps = 32 >> sh; const int r = rr_ / rps, nb = 4 * (rr_ % rps) + b_
#define ATT_LOAD(st) do { if (ATT_EXP == 2) break; ATT_DECODE(st); const int cc = tid & 15; \
    _Pragma("unroll") for (int j = 0; j < 4; ++j) { const int row = (tid >> 4) + 32 * j; int ms = nb * 128 + row; ms = ms < 0 ? 0 : ms; const size_t pos = (size_t)ms * dil + r; \
        kr[j] = *(const u32x4*)(PROJ + pos * DIN + OFF_K + h * HD + 8 * cc); vr[j] = *(const u32x4*)(PROJ + pos * DIN + OFF_VV + h * HD + 8 * cc); } \
    if (b_ >= 0) { const size_t qpos_ = (size_t)(nb * 128 + 16 * w + (lane & 15)) * dil + r; \
        _Pragma("unroll") for (int ks = 0; ks < 4; ++ks) qr[ks] = *(const u32x4*)(PROJ + qpos_ * DIN + OFF_Q + h * HD + 32 * ks + 8 * (lane >> 4)); } } while (0)
__device__ __forceinline__ void att_phase(Frame& F, int l) {
    const bf16* PROJ = (const bf16*)(F.ws + WS_PROJ);
    bf16* ATT = (bf16*)(F.ws + WS_ATT); float* LSE = (float*)(F.ws + WS_LSE);
    const int lane = F.lane, w = F.wave, tid = F.tid, fr = lane & 15, gq = lane >> 4;
    LAS unsigned char* Ks = F.lds; LAS unsigned char* Vs = F.lds + 65536;
    const int nsteps = 5 * ((768 - (int)blockIdx.x + F.G - 1) / F.G);
    u32x4 kr[4], vr[4], qr[4];
    if (ATT_EXP == 2) { for (int j = 0; j < 4; ++j) { kr[j] = (u32x4){0x3f803f80u + (unsigned)tid, 0x3f003f80u, 0x3f803f00u, 0x3e803f80u}; vr[j] = kr[j]; qr[j] = kr[j]; } }
    if (nsteps > 0) ATT_LOAD(0);
    const int cc = tid & 15;
    const float* kgp = F.in[IN_KN] + l * HD + 8 * cc;
    const f32x4 kg0 = *(const f32x4*)kgp, kg1 = *(const f32x4*)(kgp + 4);
    for (int st = 0; st < nsteps; ++st) {
        ATT_DECODE(st);
        const int slot = (b_ + 1) & 1, curoff = slot * 32768, prevoff = 32768 - curoff;
#pragma unroll
        for (int j = 0; j < 4; ++j) { const int row = (tid >> 4) + 32 * j;
            const u32x4 k4 = kr[j];
            float x[8] = {bf_lo(k4.x), bf_hi(k4.x), bf_lo(k4.y), bf_hi(k4.y), bf_lo(k4.z), bf_hi(k4.z), bf_lo(k4.w), bf_hi(k4.w)};
            float sq = 0.f;
#pragma unroll
            for (int e = 0; e < 8; ++e) sq += x[e] * x[e];
            const float rs = __builtin_amdgcn_rsqf(row16_sum(sq) * (1.f / HD) + EPS);
            u32x4 o; o.x = cvt_pk_bf16(x[0] * rs * kg0[0], x[1] * rs * kg0[1]); o.y = cvt_pk_bf16(x[2] * rs * kg0[2], x[3] * rs * kg0[3]);
            o.z = cvt_pk_bf16(x[4] * rs * kg1[0], x[5] * rs * kg1[1]); o.w = cvt_pk_bf16(x[6] * rs * kg1[2], x[7] * rs * kg1[3]);
            *(LAS u32x4*)(Ks + curoff + kimg_off(row, cc)) = o;
            *(LAS u32x4*)(Vs + curoff + vimg_off(row, cc)) = vr[j]; }
        const int iq = 16 * w + fr; const size_t qpos = (size_t)(nb * 128 + iq) * dil + r;
        bf16x8 qf[4];
        if (b_ >= 0) { float x[4][8]; float sq = 0.f;
#pragma unroll
          for (int ks = 0; ks < 4; ++ks) { const u32x4 q4 = qr[ks];
              x[ks][0] = bf_lo(q4.x); x[ks][1] = bf_hi(q4.x); x[ks][2] = bf_lo(q4.y); x[ks][3] = bf_hi(q4.y); x[ks][4] = bf_lo(q4.z); x[ks][5] = bf_hi(q4.z); x[ks][6] = bf_lo(q4.w); x[ks][7] = bf_hi(q4.w);
#pragma unroll
              for (int e = 0; e < 8; ++e) sq += x[ks][e] * x[ks][e]; }
          sq = sum4(sq);
          const float rs = __builtin_amdgcn_rsqf(sq * (1.f / HD) + EPS) * 0.12751743f;
#pragma unroll
          for (int ks = 0; ks < 4; ++ks) { const float* qg = F.in[IN_QN] + l * HD + 32 * ks + 8 * gq; const f32x4 q0 = *(const f32x4*)qg, q1 = *(const f32x4*)(qg + 4);
              u32x4 o; o.x = cvt_pk_bf16(x[ks][0] * rs * q0[0], x[ks][1] * rs * q0[1]); o.y = cvt_pk_bf16(x[ks][2] * rs * q0[2], x[ks][3] * rs * q0[3]);
              o.z = cvt_pk_bf16(x[ks][4] * rs * q1[0], x[ks][5] * rs * q1[1]); o.w = cvt_pk_bf16(x[ks][6] * rs * q1[2], x[ks][7] * rs * q1[3]);
              qf[ks] = __builtin_bit_cast(bf16x8, o); } }
        __syncthreads();
        if (st + 1 < nsteps) ATT_LOAD(st + 1);
        if (b_ >= 0 && ATT_EXP != 1) {
        f32x4 sc[10];
#pragma unroll
        for (int kt = 0; kt < 9; ++kt) { sc[kt] = (f32x4){0.f, 0.f, 0.f, 0.f}; const int T = w + kt; const int kbase = (T < 8 ? prevoff : curoff); const int krow = 16 * (T & 7) + fr;
#pragma unroll
            for (int ks = 0; ks < 4; ++ks) { const bf16x8 kf = *(const LAS bf16x8*)(Ks + kbase + kimg_off(krow, 4 * ks + gq));
                sc[kt] = __builtin_amdgcn_mfma_f32_16x16x32_bf16(kf, qf[ks], sc[kt], 0, 0, 0); } }
#pragma unroll
        for (int e = 0; e < 4; ++e) { sc[0][e] = (4 * gq + e >= fr) ? sc[0][e] : -INFINITY; sc[8][e] = (4 * gq + e <= fr) ? sc[8][e] : -INFINITY; }
        if (nb == 0) {
#pragma unroll
            for (int kt = 0; kt < 8; ++kt) if (w + kt < 8) sc[kt] = (f32x4){-INFINITY, -INFINITY, -INFINITY, -INFINITY}; }
        float mx = -INFINITY;
#pragma unroll
        for (int kt = 0; kt < 9; ++kt) mx = fmaxf(fmaxf(mx, fmaxf(sc[kt][0], sc[kt][1])), fmaxf(sc[kt][2], sc[kt][3]));
        mx = max4(mx);
        float sum = 0.f;
#pragma unroll
        for (int kt = 0; kt < 9; ++kt)
#pragma unroll
            for (int e = 0; e < 4; ++e) { const float p = __builtin_amdgcn_exp2f(sc[kt][e] - mx); sc[kt][e] = p; sum += p; }
        sc[9] = (f32x4){0.f, 0.f, 0.f, 0.f};
        sum = sum4(sum);
        bf16x8 pf[5];
#pragma unroll
        for (int pp = 0; pp < 5; ++pp) { u32x4 o; o.x = cvt_pk_bf16(sc[2 * pp][0], sc[2 * pp][1]); o.y = cvt_pk_bf16(sc[2 * pp][2], sc[2 * pp][3]); o.z = cvt_pk_bf16(sc[2 * pp + 1][0], sc[2 * pp + 1][1]); o.w = cvt_pk_bf16(sc[2 * pp + 1][2], sc[2 * pp + 1][3]);
            pf[pp] = __builtin_bit_cast(bf16x8, o); }
        const float inv = __builtin_amdgcn_rcpf(sum);
        bf16* orow = ATT + ((size_t)g * SEQ + qpos) * 1024 + h * HD + 4 * gq;
        int toff[10];
#pragma unroll
        for (int kt = 0; kt < 10; ++kt) { const int T = (w + kt) < 15 ? (w + kt) : 15; toff[kt] = (T < 8 ? prevoff : curoff) + (T & 7) * 16 * 256; }
#pragma unroll
        for (int dt = 0; dt < 8; ++dt) { f32x4 o = (f32x4){0.f, 0.f, 0.f, 0.f};
#pragma unroll
            for (int pp = 0; pp < 5; ++pp) { const bf16x8 vf = tr_frag2(Vs, toff[2 * pp], toff[2 * pp + 1], dt, lane);
                o = __builtin_amdgcn_mfma_f32_16x16x32_bf16(vf, pf[pp], o, 0, 0, 0); }
            u32x2 ow; ow.x = cvt_pk_bf16(o[0] * inv, o[1] * inv); ow.y = cvt_pk_bf16(o[2] * inv, o[3] * inv);
            *(u32x2*)(orow + 16 * dt) = ow; }
        if (gq == 0) LSE[((size_t)g * SEQ + qpos) * NHEAD + h] = (mx + __builtin_amdgcn_logf(sum)) * 0.6931471805599453f;
        }
        if (b_ >= 0 && ATT_EXP == 1) { bf16* orow = ATT + ((size_t)g * SEQ + qpos) * 1024 + h * HD + 4 * gq;
#pragma unroll
            for (int dt = 0; dt < 8; ++dt) { u32x2 ow; ow.x = __builtin_bit_cast(unsigned, qf[dt & 3][0] | (qf[dt & 3][1] << 16)) & 0x3f803f80u; ow.y = 0u; *(u32x2*)(orow + 16 * dt) = ow; }
            if (gq == 0) LSE[((size_t)g * SEQ + qpos) * NHEAD + h] = 0.f; }
        __syncthreads();
    }
}
#undef ATT_DECODE
#undef ATT_LOAD

__device__ __forceinline__ void att_combine(Frame& F, int l) {
    const bf16* ATT = (const bf16*)(F.ws + WS_ATT); const float* LSE = (const float*)(F.ws + WS_LSE); bf16* MIX = (bf16*)(F.ws + WS_MIX);
    const int gw = F.vcu * NWAVES + F.wave, NGW = F.G * NWAVES, lane = F.lane;
    const float* og = F.in[IN_OUTN] + (size_t)l * DM + 1024 + 16 * lane;
    f32x4 gg[4];
#pragma unroll
    for (int q = 0; q < 4; ++q) gg[q] = *(const f32x4*)(og + 4 * q);
    for (int m = gw; m < SEQ; m += NGW) {
        const int hh = lane >> 3;
        const float l0 = LSE[((size_t)0 * SEQ + m) * NHEAD + hh], l1 = LSE[((size_t)1 * SEQ + m) * NHEAD + hh], l2 = LSE[((size_t)2 * SEQ + m) * NHEAD + hh];
        const float M = fmaxf(l0, fmaxf(l1, l2)); float w0 = fast_exp(l0 - M), w1 = fast_exp(l1 - M), w2 = fast_exp(l2 - M);
        const float iw = __builtin_amdgcn_rcpf(w0 + w1 + w2); w0 *= iw; w1 *= iw; w2 *= iw;
        float y[16]; float s = 0.f;
#pragma unroll
        for (int q = 0; q < 2; ++q) {
            const u32x4 a = __builtin_nontemporal_load((const u32x4*)(ATT + ((size_t)0 * SEQ + m) * 1024 + 16 * lane + 8 * q)), b = __builtin_nontemporal_load((const u32x4*)(ATT + ((size_t)1 * SEQ + m) * 1024 + 16 * lane + 8 * q)), c = __builtin_nontemporal_load((const u32x4*)(ATT + ((size_t)2 * SEQ + m) * 1024 + 16 * lane + 8 * q));
            const unsigned au[4] = {a.x, a.y, a.z, a.w}, bu[4] = {b.x, b.y, b.z, b.w}, cu[4] = {c.x, c.y, c.z, c.w};
#pragma unroll
            for (int e = 0; e < 4; ++e) { y[8 * q + 2 * e] = w0 * bf_lo(au[e]) + w1 * bf_lo(bu[e]) + w2 * bf_lo(cu[e]); y[8 * q + 2 * e + 1] = w0 * bf_hi(au[e]) + w1 * bf_hi(bu[e]) + w2 * bf_hi(cu[e]); } }
#pragma unroll
        for (int e = 0; e < 16; ++e) s += y[e] * y[e];
        const float rs = __builtin_amdgcn_rsqf(wave_sum(s) * (1.f / 1024.f) + EPS);
        if (OP8(l)) { u32x4 o8;
            o8.x = pk4_fp8(y[0] * rs * gg[0][0], y[1] * rs * gg[0][1], y[2] * rs * gg[0][2], y[3] * rs * gg[0][3]); o8.y = pk4_fp8(y[4] * rs * gg[1][0], y[5] * rs * gg[1][1], y[6] * rs * gg[1][2], y[7] * rs * gg[1][3]);
            o8.z = pk4_fp8(y[8] * rs * gg[2][0], y[9] * rs * gg[2][1], y[10] * rs * gg[2][2], y[11] * rs * gg[2][3]); o8.w = pk4_fp8(y[12] * rs * gg[3][0], y[13] * rs * gg[3][1], y[14] * rs * gg[3][2], y[15] * rs * gg[3][3]);
            *(u32x4*)((unsigned char*)MIX + (size_t)m * DM + 1024 + 16 * lane) = o8; }
        else
#pragma unroll
        for (int q = 0; q < 2; ++q) { u32x4 o;
            o.x = cvt_pk_bf16(y[8 * q + 0] * rs * gg[2 * q][0], y[8 * q + 1] * rs * gg[2 * q][1]); o.y = cvt_pk_bf16(y[8 * q + 2] * rs * gg[2 * q][2], y[8 * q + 3] * rs * gg[2 * q][3]);
            o.z = cvt_pk_bf16(y[8 * q + 4] * rs * gg[2 * q + 1][0], y[8 * q + 5] * rs * gg[2 * q + 1][1]); o.w = cvt_pk_bf16(y[8 * q + 6] * rs * gg[2 * q + 1][2], y[8 * q + 7] * rs * gg[2 * q + 1][3]);
            *(u32x4*)(MIX + (size_t)m * DM + 1024 + 16 * lane + 8 * q) = o; }
    }
}

#define ROUTER_LOAD(S, ks) do { \
    _Pragma("unroll") for (int rt = 0; rt < 4; ++rt) xa##S[rt] = *(const u32x4*)(xrow + (size_t)rt * 16 * DM + 32 * (ks)); \
    _Pragma("unroll") for (int ct = 0; ct < 3; ++ct) { bh##S[ct] = *(const bf16x8*)(wf + (size_t)(ks) * 3072 + (ct * 2) * 512); bl##S[ct] = *(const bf16x8*)(wf + (size_t)(ks) * 3072 + (ct * 2 + 1) * 512); } } while (0)
#define ROUTER_STEP(S, ks) do { \
    _Pragma("unroll") for (int rt = 0; rt < 4; ++rt) { const u32x4 xq = xa##S[rt]; \
        const float x0 = bf_lo(xq.x), x1 = bf_hi(xq.x), x2 = bf_lo(xq.y), x3 = bf_hi(xq.y), x4 = bf_lo(xq.z), x5 = bf_hi(xq.z), x6 = bf_lo(xq.w), x7 = bf_hi(xq.w); \
        ssq[rt] += (x0 * x0 + x1 * x1) + (x2 * x2 + x3 * x3) + (x4 * x4 + x5 * x5) + (x6 * x6 + x7 * x7); \
        { u32x2 x8; x8.x = pk4_fp8(x0, x1, x2, x3); x8.y = pk4_fp8(x4, x5, x6, x7); *(u32x2*)(x8row + (size_t)rt * 16 * DM + 32 * (ks)) = x8; } \
        const bf16x8 xh = __builtin_bit_cast(bf16x8, xq); \
        _Pragma("unroll") for (int ct = 0; ct < 3; ++ct) { \
            acc[rt][ct] = __builtin_amdgcn_mfma_f32_16x16x32_bf16(xh, bh##S[ct], acc[rt][ct], 0, 0, 0); \
            acc[rt][ct] = __builtin_amdgcn_mfma_f32_16x16x32_bf16(xh, bl##S[ct], acc[rt][ct], 0, 0, 0); } } } while (0)
__device__ __forceinline__ void router_phase(Frame& F, int l, int alt = 0) {
    const bf16* H1 = (const bf16*)(F.ws + WS_HN);
    const bf16* WRF = (const bf16*)(F.ws + WS_WRT) + (size_t)l * 64 * 3 * 2 * 64 * 8;
    unsigned* cnt = (unsigned*)(F.ws + WS_CTL) + CW_CNT + 2048 * l + 32768 * alt;
    int* tok = (int*)(F.ws + (alt ? WS_ALT : WS_TOK)); f32x4* tinfo = (f32x4*)(F.ws + (alt ? WS_ALT + 4 * MiB : WS_TINFO)); float* rslot = (float*)(F.ws + (alt ? WS_ALT + 2 * MiB : WS_RSLOT));
    const int lane = F.lane, tid = F.tid, w = F.wave, fr = lane & 15, g = lane >> 4;
    constexpr int PS = 49;
    LAS float* P = (LAS float*)F.lds;
    LAS float* SS = (LAS float*)(F.lds + 8 * 64 * PS * 4);
    for (int task = (int)blockIdx.x; task < SEQ / 64; task += F.G) {
        const bf16* xrow = H1 + (size_t)(task * 64 + fr) * DM + 256 * w + 8 * g;
        unsigned char* x8row = F.ws + WS_X8 + (size_t)(task * 64 + fr) * DM + 256 * w + 8 * g;
        const bf16* wf = WRF + ((size_t)(8 * w) * 3 * 2 * 64 + lane) * 8;
        f32x4 acc[4][3]; float ssq[4] = {0.f, 0.f, 0.f, 0.f};
#pragma unroll
        for (int rt = 0; rt < 4; ++rt)
#pragma unroll
            for (int ct = 0; ct < 3; ++ct) acc[rt][ct] = (f32x4){0.f, 0.f, 0.f, 0.f};
        u32x4 xaA[4], xaB[4]; bf16x8 bhA[3], blA[3], bhB[3], blB[3];
        ROUTER_LOAD(A, 0);
#pragma unroll 1
        for (int it = 0; it < 4; ++it) {
            ROUTER_LOAD(B, 1); __builtin_amdgcn_sched_barrier(0);
            ROUTER_STEP(A, 0); __builtin_amdgcn_sched_barrier(0);
            if (it < 3) ROUTER_LOAD(A, 2);
            __builtin_amdgcn_sched_barrier(0);
            ROUTER_STEP(B, 1); __builtin_amdgcn_sched_barrier(0);
            xrow += 64; x8row += 64; wf += 2 * 3072;
        }
#pragma unroll
        for (int rt = 0; rt < 4; ++rt) { float sq = ssq[rt]; sq += __shfl_xor(sq, 16); sq += __shfl_xor(sq, 32);
            if (g == 0) SS[w * 64 + 16 * rt + fr] = sq;
#pragma unroll
            for (int ct = 0; ct < 3; ++ct)
#pragma unroll
                for (int e = 0; e < 4; ++e) P[(w * 64 + 16 * rt + 4 * g + e) * PS + 16 * ct + fr] = acc[rt][ct][e]; }
        __syncthreads();
        if (tid < 64) {
            const int t = task * 64 + tid;
            float ss = 0.f;
#pragma unroll
            for (int q = 0; q < 8; ++q) ss += SS[q * 64 + tid];
            const float rs = __builtin_amdgcn_rsqf(ss * (1.f / DM) + EPS);
            const LAS float* pr = P + tid * PS;
            float lg[4];
#pragma unroll
            for (int o = 0; o < 4; ++o) { float a = 0.f;
#pragma unroll
                for (int q = 0; q < 8; ++q) a += pr[q * 64 * PS + 32 + o];
                lg[o] = a * rs + F.in[IN_BRG][l * 4 + o]; }
            int gi = 0; float gm = lg[0];
#pragma unroll
            for (int o = 1; o < 4; ++o) if (lg[o] > gm) { gm = lg[o]; gi = o; }
            float den = 0.f;
#pragma unroll
            for (int o = 0; o < 4; ++o) den += __expf(lg[o] - gm);
            const float gate_g = 1.f / den;
            float t1v = -INFINITY, t2v = -INFINITY; int t1i = 0, t2i = 0;
#pragma unroll
            for (int ii = 0; ii < 8; ++ii) { const int o = gi * 8 + ii; float a = 0.f;
#pragma unroll
                for (int q = 0; q < 8; ++q) a += pr[q * 64 * PS + o];
                const float v = a * rs + F.in[IN_BRE][l * NE + o];
                if (v > t1v) { t2v = t1v; t2i = t1i; t1v = v; t1i = ii; }
                else if (v > t2v) { t2v = v; t2i = ii; } }
            const float pp1 = 1.f / (1.f + __expf(t2v - t1v)), pp2 = 1.f - pp1;
            const int e0 = gi * 8 + t1i, e1 = gi * 8 + t2i;
            LAS unsigned* lcnt = (LAS unsigned*)(F.lds + 8 * 64 * PS * 4 + 8 * 64 * 4);
            if (tid < 32) lcnt[tid] = 0u;
            const unsigned r0 = __hip_atomic_fetch_add(lcnt + e0, 1u, __ATOMIC_RELAXED, __HIP_MEMORY_SCOPE_WORKGROUP), r1 = __hip_atomic_fetch_add(lcnt + e1, 1u, __ATOMIC_RELAXED, __HIP_MEMORY_SCOPE_WORKGROUP);
            if (tid < 32) { const unsigned c = lcnt[tid]; lcnt[32 + tid] = c ? atomicAdd(&cnt[tid * CNT_STRIDE], c) : 0u; }
            const unsigned s0 = lcnt[32 + e0] + r0, s1 = lcnt[32 + e1] + r1;
            tok[(size_t)e0 * TOKCAP + s0] = t; tok[(size_t)e1 * TOKCAP + s1] = t;
            rslot[(size_t)e0 * TOKCAP + s0] = rs; rslot[(size_t)e1 * TOKCAP + s1] = rs;
            f32x4 ti; ti[0] = __builtin_bit_cast(float, (int)(e0 * TOKCAP + s0)); ti[1] = __builtin_bit_cast(float, (int)(e1 * TOKCAP + s1)); ti[2] = gate_g * pp1; ti[3] = gate_g * pp2;
            tinfo[t] = ti;
        }
        __syncthreads();
    }
}
__device__ __forceinline__ void moe_table(Frame& F, int l) {
    const unsigned* cnt = (const unsigned*)(F.ws + WS_CTL) + CW_CNT + 2048 * l;
    LAS int* tstart = (LAS int*)(F.lds + MISC_OFF + 64);
    __syncthreads();
    if (F.tid == 0) { int acc = 0; for (int e = 0; e < NE; ++e) { tstart[e] = acc; acc += ((int)cnt[e * CNT_STRIDE] + 255) >> 8; } tstart[NE] = acc; }
    __syncthreads();
    { LAS int* tile_e = (LAS int*)(F.lds + MISC_OFF + 2304);
      if (F.tid < 160) { int e = 0; for (int j = 1; j < NE; ++j) e = (tstart[j] <= F.tid) ? j : e; tile_e[F.tid] = e; } }
    __syncthreads();
}
__device__ __forceinline__ void combine_phase(Frame& F, int l) {
    const LAS int* tstart = (const LAS int*)(F.lds + MISC_OFF + 64);
    const unsigned char* Y = F.ws + WS_Y; const f32x4* tinfo = (const f32x4*)(F.ws + WS_TINFO);
    bf16* H = (bf16*)(F.ws + WS_H); bf16* HN = (bf16*)(F.ws + WS_HN);
    const int gw = F.vcu * NWAVES + F.wave, NGW = F.G * NWAVES, lane = F.lane;
    const float* g1n = F.in[IN_NORM1] + (size_t)DM;
    for (int m = gw; m < SEQ; m += NGW) {
        const f32x4 ti = tinfo[m];
        const float tf0 = ti[0], tf1 = ti[1]; const int s0 = __builtin_bit_cast(int, tf0), s1 = __builtin_bit_cast(int, tf1);
        const int e0 = s0 >> 14, e1 = s1 >> 14;
        const size_t r0 = (size_t)tstart[e0] * 256 + (s0 & (TOKCAP - 1)), r1 = (size_t)tstart[e1] * 256 + (s1 & (TOKCAP - 1));
        const float ga = ti[2] * (1.f / Y_SCALE), gb = ti[3] * (1.f / Y_SCALE);
        f32x4 v[8]; float s = 0.f;
#pragma unroll
        for (int j = 0; j < 8; ++j) { const u32x2 hx = __builtin_nontemporal_load((const u32x2*)(HN + (size_t)m * DM + 4 * lane + 256 * j));
            const int ya = __builtin_nontemporal_load((const int*)(Y + r0 * DM + 4 * lane + 256 * j)), yb = __builtin_nontemporal_load((const int*)(Y + r1 * DM + 4 * lane + 256 * j));
            const f32x2 a01 = __builtin_amdgcn_cvt_pk_f32_fp8(ya, false), a23 = __builtin_amdgcn_cvt_pk_f32_fp8(ya, true), b01 = __builtin_amdgcn_cvt_pk_f32_fp8(yb, false), b23 = __builtin_amdgcn_cvt_pk_f32_fp8(yb, true);
            v[j][0] = bf_lo(hx.x) + ga * a01[0] + gb * b01[0]; v[j][1] = bf_hi(hx.x) + ga * a01[1] + gb * b01[1];
            v[j][2] = bf_lo(hx.y) + ga * a23[0] + gb * b23[0]; v[j][3] = bf_hi(hx.y) + ga * a23[1] + gb * b23[1];
            s += (v[j][0] * v[j][0] + v[j][1] * v[j][1]) + (v[j][2] * v[j][2] + v[j][3] * v[j][3]); }
        if (l == 0) {
            const float rs = __builtin_amdgcn_rsqf(wave_sum(s) * (1.f / DM) + EPS);
            bf16* hrow = H + (size_t)m * DM; bf16* orow = HN + (size_t)m * DM;
#pragma unroll
            for (int j = 0; j < 8; ++j) { const f32x4 gg = *(const f32x4*)(g1n + 4 * lane + 256 * j);
                u32x2 hb; hb.x = cvt_pk_bf16(v[j][0], v[j][1]); hb.y = cvt_pk_bf16(v[j][2], v[j][3]); *(u32x2*)(hrow + 4 * lane + 256 * j) = hb;
                if (IP8(1)) *(unsigned*)(F.ws + WS_X8 + (size_t)m * DM + 4 * lane + 256 * j) = pk4_fp8(v[j][0] * rs * gg[0], v[j][1] * rs * gg[1], v[j][2] * rs * gg[2], v[j][3] * rs * gg[3]);
                else { u32x2 o; o.x = cvt_pk_bf16(v[j][0] * rs * gg[0], v[j][1] * rs * gg[1]); o.y = cvt_pk_bf16(v[j][2] * rs * gg[2], v[j][3] * rs * gg[3]);
                *(u32x2*)(orow + 4 * lane + 256 * j) = o; } }
        } else {
            float* orow = F.out + (size_t)m * DM;
#pragma unroll
            for (int j = 0; j < 8; ++j) __builtin_nontemporal_store(v[j], (f32x4*)(orow + 4 * lane + 256 * j));
        }
    }
}

__device__ __forceinline__ void relaunder(Frame& F) { F.lane = lane_now(); F.tid = F.wave * 64 + F.lane; }
constexpr int N_PHASES = 17;
#ifndef PHASE_MASK
#define PHASE_MASK 0x1ff
#endif
#ifndef MIX_MASK
#define MIX_MASK 7
#endif
#ifndef DUP_PHASE
#define DUP_PHASE 0
#endif
#define DUP(k) for (int _d = 0; _d < ((DUP_PHASE == (k)) ? 2 : 1); ++_d)
#define IN(k) (lo <= (k) && (k) < hi)
#define EN(b) ((PHASE_MASK >> (b)) & 1)
#ifndef PROBE_STAMP
#define PROBE_STAMP (-1)
#endif
#define SEAM(k) do { if (IN(k) && IN((k) + 1)) { xcd_barrier(bar); if (PROBE_STAMP >= 0 && blockIdx.x == 0 && F.tid == 0) { const unsigned long long _t = wall_clock64(); F.MISC[802 + 2 * (k)] = (unsigned)_t; F.MISC[803 + 2 * (k)] = (unsigned)(_t >> 32); } } } while (0)
template <int l>
__device__ __forceinline__ void layer_phases(Frame& F, const XcdBarrier& bar, const int lo, const int hi) {
    constexpr int pb = 1 + 8 * l;
    relaunder(F);
    if (EN(1) && IN(pb)) {
        constexpr int KI = IP8(l) ? DM / 2 : DM;
#define INPROJ_PART(first) do { pg8::StaticSched S; S.init((const bf16*)(F.ws + (IP8(l) ? WS_X8 : WS_HN)), (const bf16*)(F.ws + WS_WIN) + (size_t)l * DIN * DM, SEQ, DIN, KI, F.G, (int)blockIdx.x); \
            const int slot = (((int)blockIdx.x & 7) * 6) >> 3; if (first) S.i1 = slot; else S.i0 = slot; \
            pg8::EpiProj E{(bf16*)(F.ws + WS_PROJ), IP8(l) ? 1.f / WIN_SCALE : 1.f}; \
            DUP(1) pg8::gemm_phase<pg8::EpiProj, pg8::StaticSched, true, IP8(l) != 0>(F.lds, KI, S, E, F.wave); } while (0)
        INPROJ_PART(true);
        __syncthreads(); relaunder(F); convert_tiles(F, l == 0 ? CV_P : CV_A, l == 0 ? CV_A : CV_B); __syncthreads(); relaunder(F);
        INPROJ_PART(false);
#undef INPROJ_PART
    }
    SEAM(pb);
    relaunder(F);
    if (EN(2) && IN(pb + 1)) {
        constexpr int N_SGU = 256, N_CONV = 512, N_ATT = 3072;
#define MSTAMP(i) do { if (PROBE_STAMP >= 100 && l == 0 && blockIdx.x == 0 && F.tid == 0) { const unsigned long long _t = wall_clock64(); F.MISC[900 + 2 * (i)] = (unsigned)_t; F.MISC[901 + 2 * (i)] = (unsigned)(_t >> 32); } } while (0)
        MSTAMP(0);
        if (MIX_MASK & 1) DUP(2) att_phase(F, l);
        MSTAMP(1);
        if (MIX_MASK & 2) DUP(3) for (int it = (int)blockIdx.x; it < N_CONV; it += F.G) conv_item(F, l, it);
        MSTAMP(2);
        if (MIX_MASK & 4) DUP(4) for (int it = (int)blockIdx.x; it < N_SGU; it += F.G) sgu_item(F, l, it >> 1, it & 1);
        MSTAMP(3);
#undef MSTAMP
    }
    SEAM(pb + 1);
    if (DUP_PHASE == 12 && IN(pb + 1)) {
        pg8::StaticSched S; S.init((const bf16*)(F.ws + WS_MIX), (const bf16*)(F.ws + WS_WIN) + (size_t)l * DIN * DM, SEQ, DIN, DM, F.G, (int)blockIdx.x);
        pg8::EpiProj E{(bf16*)(F.ws + WS_PROJ), 1.f};
        pg8::gemm_phase<pg8::EpiProj, pg8::StaticSched>(F.lds, DM, S, E, F.wave);
        xcd_barrier(bar);
    }
    relaunder(F);
    if (EN(3) && IN(pb + 2)) DUP(5) att_combine(F, l);
    SEAM(pb + 2);
    relaunder(F);
    if (EN(4) && IN(pb + 3)) {
        constexpr int KO = OP8(l) ? DM / 2 : DM;
        pg8::StaticSched S; S.init((const bf16*)(F.ws + WS_MIX), (const bf16*)(F.ws + WS_WOUT) + (size_t)l * DM * DM, SEQ, DM, KO, F.G, (int)blockIdx.x);
        if constexpr (l == 0) { pg8::EpiResid<false> E{(const void*)F.in[IN_X], (bf16*)(F.ws + WS_HN)}; DUP(6) pg8::gemm_phase<pg8::EpiResid<false>, pg8::StaticSched, true, OP8(l) != 0>(F.lds, KO, S, E, F.wave); }
        else { pg8::EpiResid<true> E{(const void*)(F.ws + WS_H), (bf16*)(F.ws + WS_HN)}; DUP(6) pg8::gemm_phase<pg8::EpiResid<true>, pg8::StaticSched, true, OP8(l) != 0>(F.lds, KO, S, E, F.wave); }
    }
    SEAM(pb + 3);
    relaunder(F);
    if (EN(5) && IN(pb + 4)) { router_phase(F, l); if (DUP_PHASE == 11) router_phase(F, l, 1); }
    if (DUP_PHASE == 13 && IN(pb + 4)) { for (int q = 0; q < 8; ++q) xcd_barrier(bar); }
    SEAM(pb + 4);
    relaunder(F);
    if (EN(6) && IN(pb + 5)) {
        moe_table(F, l);
        unsigned* ready = (unsigned*)(F.ws + WS_CTL) + CW_RDY + 16384 * l;
        {
            pg8::SchedG1 S{(const LAS int*)(F.lds + MISC_OFF + 64), (const int*)((const unsigned*)(F.ws + WS_CTL) + CW_CNT + 2048 * l), (const int*)(F.ws + WS_TOK), (const bf16*)(F.ws + WS_X8),
                           (const bf16*)(F.ws + WS_W1 + (size_t)l * NE * 1024 * DM), F.G, (int)blockIdx.x, ready};
            pg8::EpiSwiGLU E{F.ws + WS_HB, (const float*)(F.ws + WS_RSLOT)};
            DUP(7) pg8::gemm_phase<pg8::EpiSwiGLU, pg8::SchedG1, true, true>(F.lds, DM / 2, S, E, F.wave);
        }
        {
            pg8::SchedG2 S{(const LAS int*)(F.lds + MISC_OFF + 64), (const bf16*)(F.ws + WS_HB), (const bf16*)(F.ws + WS_W2 + (size_t)l * NE * DM * DE), F.G, (int)blockIdx.x, ready, (unsigned*)(F.ws + WS_CTL) + CW_TMO, F.wave};
            pg8::EpiY E{F.ws + WS_Y};
            DUP(8) pg8::gemm_phase<pg8::EpiY, pg8::SchedG2, true, true>(F.lds, DE / 2, S, E, F.wave);
        }
    }
    SEAM(pb + 6);
    relaunder(F);
    if (EN(8) && IN(pb + 7)) { moe_table(F, l); DUP(l == 0 ? 9 : 99) combine_phase(F, l); }
    SEAM(pb + 7);
}
__global__ void __launch_bounds__(NTHREADS, 2) fwd_kernel(Params args) {
    extern __shared__ __attribute__((aligned(16))) unsigned char lds_raw[];
    Frame F;
    F.lds = (LAS unsigned char*)lds_raw; F.MISC = (volatile LAS unsigned*)(F.lds + MISC_OFF);
    F.tid = threadIdx.x; F.lane = F.tid & 63; F.wave = __builtin_amdgcn_readfirstlane(F.tid >> 6);
    F.G = gridDim.x; { const int bx = blockIdx.x; F.vcu = (F.G % 8 == 0) ? (bx % 8) * (F.G / 8) + bx / 8 : bx; }
    F.in = args.in; F.out = args.out; F.ws = args.ws;
    for (int u = F.tid; u < (LDS_BYTES - MISC_OFF) / 4; u += NTHREADS) ((LAS unsigned*)(F.lds + MISC_OFF))[u] = 0u;
    __syncthreads();
    unsigned* ctl = (unsigned*)(args.ws + WS_CTL);
    const int lo = args.ph_lo, hi = args.ph_hi;
    const bool multi = (hi - lo) > 1;
    XcdBarrier bar; bar.bar = ctl + CW_BAR; bar.x = 0; bar.st = nullptr; bar.lead = 0;
    if (multi) bar = xcd_barrier_post(ctl + CW_BAR, F.MISC, F.wave == 0 ? 1u : 0u);
    if (PROBE_STAMP >= 0 && blockIdx.x == 0 && F.tid == 0) { const unsigned long long _t = wall_clock64(); F.MISC[800] = (unsigned)_t; F.MISC[801] = (unsigned)(_t >> 32); }
    if (EN(0) && IN(0)) { DUP(10) p_prologue(F); }
    SEAM(0);
    layer_phases<0>(F, bar, lo, hi);
    layer_phases<1>(F, bar, lo, hi);
    if (PROBE_STAMP >= 0 && blockIdx.x == 0 && F.tid == 0) {
        asm volatile("s_waitcnt vmcnt(0)" ::: "memory");
        constexpr int SB = PROBE_STAMP >= 100 ? 900 + 2 * (PROBE_STAMP - 100) : (PROBE_STAMP == 6 ? 812 : 800 + 2 * PROBE_STAMP);
        constexpr int SB1 = (PROBE_STAMP == 6) ? SB + 4 : SB + 2;
        const unsigned long long t1 = ((unsigned long long)F.MISC[SB1 + 1] << 32) | F.MISC[SB1], t0 = ((unsigned long long)F.MISC[SB + 1] << 32) | F.MISC[SB];
        F.out[0] += (float)(long long)(t1 - t0) * 0.01f;
    }
}
#undef IN
#undef EN
#undef SEAM
#undef DUP

extern "C" void kernel_launch(void* const* d_in, const int* in_sizes, int n_in, void* d_out, int out_size, void* d_ws, size_t ws_size, hipStream_t stream) {
    static int grid = 0;
    if (grid == 0) {
        if (n_in != 22 || out_size != SEQ * DM || ws_size < WS_END) { fprintf(stderr, "kernel_launch: unexpected shapes (n_in %d out %d ws %zu, need %zu)\n", n_in, out_size, ws_size, (size_t)WS_END); grid = -1; return; }
        int dev = 0, cus = 0, per_cu = 0;
        if (hipGetDevice(&dev) != hipSuccess || hipDeviceGetAttribute(&cus, hipDeviceAttributeMultiprocessorCount, dev) != hipSuccess) { grid = -1; return; }
        if (hipFuncSetAttribute((const void*)fwd_kernel, hipFuncAttributeMaxDynamicSharedMemorySize, LDS_BYTES) != hipSuccess) { fprintf(stderr, "kernel_launch: hipFuncSetAttribute failed\n"); grid = -1; return; }
        if (hipOccupancyMaxActiveBlocksPerMultiprocessor(&per_cu, (const void*)fwd_kernel, NTHREADS, LDS_BYTES) != hipSuccess || per_cu < 1) { fprintf(stderr, "kernel_launch: occupancy query says %d\n", per_cu); }
        (void)hipGetLastError();
        grid = cus;
    }
    if (grid < 0) return;
    if (hipMemsetAsync((char*)d_ws + WS_CTL, 0, CTL_ZERO_BYTES, stream) != hipSuccess) return;
    Params p{};
    for (int i = 0; i < 22; ++i) p.in[i] = (const float*)d_in[i];
    p.out = (float*)d_out; p.ws = (unsigned char*)d_ws;
    constexpr int NL = MK_N_LAUNCHES;
    for (int li = 0; li < NL; ++li) {
        p.ph_lo = (NL == 1) ? 0 : li; p.ph_hi = (NL == 1) ? N_PHASES : li + 1;
        hipLaunchKernelGGL(fwd_kernel, dim3(grid), dim3(NTHREADS), LDS_BYTES, stream, p);
        if (hipPeekAtLastError() != hipSuccess) { fprintf(stderr, "kernel_launch: launch %d failed\n", li); break; }
    }
}
```

```cpp
#include <hip/hip_runtime.h>
#include <cstdio>
#include <cstdint>

#ifndef MK_N_LAUNCHES
#define MK_N_LAUNCHES 1
#endif

#ifndef OUTPROJ_FP8
#define OUTPROJ_FP8 2
#endif
#ifndef ATT_EXP
#define ATT_EXP 0
#endif
#define OP8(l) ((OUTPROJ_FP8 >> (l)) & 1)
#ifndef INPROJ_FP8
#define INPROJ_FP8 2
#endif
#define IP8(l) ((INPROJ_FP8 >> (l)) & 1)
#define GAS __attribute__((address_space(1)))
#define LAS __attribute__((address_space(3)))
typedef unsigned short bf16;
typedef short bf16x8 __attribute__((ext_vector_type(8)));
typedef short s16x4 __attribute__((ext_vector_type(4)));
typedef float f32x4 __attribute__((ext_vector_type(4)));
typedef float f32x2 __attribute__((ext_vector_type(2)));
typedef unsigned u32x4 __attribute__((ext_vector_type(4)));
typedef unsigned u32x2 __attribute__((ext_vector_type(2)));

constexpr int SEQ = 16384, DM = 2048, DIN = 5120, NLAYER = 2;
constexpr int HD = 128, NHEAD = 8, CONV_K = 31;
constexpr int NE = 32, DE = 512, TOKCAP = 16384;
constexpr int OFF_U = 0, OFF_V = 512, OFF_A = 1024, OFF_G = 1536, OFF_Q = 2048, OFF_K = 3072, OFF_VV = 4096;
constexpr float EPS = 1e-6f;
constexpr float W1_SCALE = 64.f, W2_SCALE = 32.f, WOUT_SCALE = 64.f, WIN_SCALE = 64.f, Y_SCALE = 16.f;
constexpr int NWAVES = 8, NTHREADS = 512;

constexpr size_t MiB = 1u << 20;
constexpr size_t WS_CTL = 0, CTL_ZERO_BYTES = 1 * MiB;
constexpr size_t WS_WIN = 1 * MiB;
constexpr size_t WS_WOUT = 41 * MiB;
constexpr size_t WS_W1 = 57 * MiB;
constexpr size_t WS_X8 = 185 * MiB;
constexpr size_t WS_W2 = 313 * MiB;
constexpr size_t WS_SGUW = 441 * MiB;
constexpr size_t WS_WRT = 442 * MiB;
constexpr size_t WS_TOK = 443 * MiB;
constexpr size_t WS_TINFO = 445 * MiB;
constexpr size_t WS_HN = 446 * MiB;
constexpr size_t WS_HB = 510 * MiB;
constexpr size_t WS_ATT = WS_HN;
constexpr size_t WS_LSE = WS_HN + 96 * MiB;
constexpr size_t WS_PROJ = 550 * MiB;
constexpr size_t WS_Y = WS_PROJ;
constexpr size_t WS_MIX = 710 * MiB;
constexpr size_t WS_H = 774 * MiB;
constexpr size_t WS_RSLOT = 902 * MiB;
constexpr size_t WS_ALT = 904 * MiB;
constexpr size_t WS_END = 910 * MiB;
constexpr int CW_BAR = 4096;
constexpr int CW_TMO = 0;
constexpr int CW_RDY = 65536;
constexpr int CW_CNT = 16384, CNT_STRIDE = 64;

constexpr int LDS_BYTES = 163840;
constexpr int MISC_OFF = 159744;

__device__ __forceinline__ unsigned cvt_pk_bf16(float lo, float hi) { unsigned r; asm volatile("v_cvt_pk_bf16_f32 %0, %1, %2" : "=v"(r) : "v"(lo), "v"(hi)); return r; }
__device__ __forceinline__ unsigned pk4_fp8(float a, float b, float c, float d) { int p = 0; p = __builtin_amdgcn_cvt_pk_fp8_f32(a, b, p, false); p = __builtin_amdgcn_cvt_pk_fp8_f32(c, d, p, true); return (unsigned)p; }
__device__ __forceinline__ float bf_lo(unsigned u) { return __builtin_bit_cast(float, u << 16); }
__device__ __forceinline__ float bf_hi(unsigned u) { return __builtin_bit_cast(float, u & 0xffff0000u); }
template <int CTRL, int RM> __device__ __forceinline__ float dpp_mov0(float v) { return __builtin_bit_cast(float, __builtin_amdgcn_update_dpp(0, __builtin_bit_cast(int, v), CTRL, RM, 0xf, false)); }
__device__ __forceinline__ float wave_sum(float s) {
    s += dpp_mov0<0xB1, 0xf>(s); s += dpp_mov0<0x4E, 0xf>(s); s += dpp_mov0<0x141, 0xf>(s); s += dpp_mov0<0x140, 0xf>(s);
    s += dpp_mov0<0x142, 0xa>(s); s += dpp_mov0<0x143, 0xc>(s);
    return __builtin_bit_cast(float, __builtin_amdgcn_readlane(__builtin_bit_cast(int, s), 63));
}
__device__ __forceinline__ float row16_sum(float s) {
    s += dpp_mov0<0xB1, 0xf>(s); s += dpp_mov0<0x4E, 0xf>(s); s += dpp_mov0<0x141, 0xf>(s); s += dpp_mov0<0x140, 0xf>(s); return s;
}
__device__ __forceinline__ float sum4(float x) {
    const unsigned xu = __builtin_bit_cast(unsigned, x); const auto r = __builtin_amdgcn_permlane16_swap(xu, xu, false, false); const unsigned r0 = r[0], r1 = r[1];
    const float a = __builtin_bit_cast(float, r0) + __builtin_bit_cast(float, r1);
    const unsigned au = __builtin_bit_cast(unsigned, a); const auto q = __builtin_amdgcn_permlane32_swap(au, au, false, false); const unsigned q0 = q[0], q1 = q[1];
    return __builtin_bit_cast(float, q0) + __builtin_bit_cast(float, q1);
}
__device__ __forceinline__ float max4(float x) {
    const unsigned xu = __builtin_bit_cast(unsigned, x); const auto r = __builtin_amdgcn_permlane16_swap(xu, xu, false, false); const unsigned r0 = r[0], r1 = r[1];
    const float a = fmaxf(__builtin_bit_cast(float, r0), __builtin_bit_cast(float, r1));
    const unsigned au = __builtin_bit_cast(unsigned, a); const auto q = __builtin_amdgcn_permlane32_swap(au, au, false, false); const unsigned q0 = q[0], q1 = q[1];
    return fmaxf(__builtin_bit_cast(float, q0), __builtin_bit_cast(float, q1));
}
__device__ __forceinline__ int lane_now() { int l; asm volatile("v_mbcnt_lo_u32_b32 %0, -1, 0\n\tv_mbcnt_hi_u32_b32 %0, -1, %0" : "=v"(l)); return l; }
#define LDS_WAIT() asm volatile("s_waitcnt lgkmcnt(0)" ::: "memory")
#define VM_WAIT() asm volatile("s_waitcnt vmcnt(0)" ::: "memory")
__device__ __forceinline__ float fast_exp(float x) { return __builtin_amdgcn_exp2f(x * 1.4426950408889634f); }
__device__ __forceinline__ float sigmoidf_(float x) { return __builtin_amdgcn_rcpf(1.0f + fast_exp(-x)); }
__device__ __forceinline__ float gelu_tanh(float x) { const float z = 1.5957691216057308f * (x + 0.044715f * x * x * x); return x * sigmoidf_(z); }

#define XB_TMO      128
#define XB_XCNT(j)  (256  + 64 * (j))
#define XB_XSUB(j)  (1280 + 64 * (j))
#define XB_XGEN(j)  (2304 + 64 * (j))
#define XB_TOP      3328
#define XB_TOPGEN   3392
#define XCD_BAR_WORDS 3456
#define XB_SPIN_CAP (1u << 22)
__device__ __forceinline__ unsigned xb_ld(unsigned* p)              { return __hip_atomic_load(p, __ATOMIC_RELAXED, __HIP_MEMORY_SCOPE_AGENT); }
__device__ __forceinline__ unsigned xb_add(unsigned* p, unsigned v) { return __hip_atomic_fetch_add(p, v, __ATOMIC_RELAXED, __HIP_MEMORY_SCOPE_AGENT); }
__device__ __forceinline__ unsigned xb_xcc_id() { return (unsigned)__builtin_amdgcn_s_getreg((3 << 11) | 20) & 0xFu; }
#define XB_SPIN(cond, bar) do { unsigned _sp = 0; while (cond) { __builtin_amdgcn_s_sleep(1); \
    if ((++_sp & 255u) == 0u) { if (xb_ld(&(bar)[XB_TMO])) break; if (_sp > XB_SPIN_CAP) { atomicAdd(&(bar)[XB_TMO], 1u); break; } } } } while (0)
struct XcdBarrier { unsigned* bar; unsigned x; volatile LAS unsigned* st; unsigned lead; };
__device__ __forceinline__ XcdBarrier xcd_barrier_post(unsigned* bar, volatile LAS unsigned* st, unsigned lead) {
    XcdBarrier b; b.bar = bar; b.x = xb_xcc_id(); b.st = st; b.lead = lead;
    if (lead && lane_now() == 0) (void)xb_add(&bar[XB_XCNT(b.x)], 1u);
    return b;
}
__device__ __forceinline__ void xcd_barrier_complete(unsigned* bar, unsigned x, unsigned& nloc, unsigned& nx) {
    const unsigned G = gridDim.x * gridDim.y * gridDim.z;
    unsigned sum, cnt, mine, sp = 0u;
    for (;;) {
        sum = 0u; cnt = 0u; mine = 0u;
#pragma unroll
        for (unsigned j = 0; j < 16; ++j) { const unsigned c = xb_ld(&bar[XB_XCNT(j)]); sum += c; cnt += (c > 0u) ? 1u : 0u; mine = (j == x) ? c : mine; }
        if (sum == G) break;
        __builtin_amdgcn_s_sleep(1);
        if ((++sp & 255u) == 0u) { if (xb_ld(&bar[XB_TMO])) break; if (sp > XB_SPIN_CAP) { atomicAdd(&bar[XB_TMO], 1u); break; } }
    }
    nloc = mine > 0u ? mine : 1u; nx = cnt > 0u ? cnt : 1u;
}
__device__ __forceinline__ void xcd_barrier(const XcdBarrier& b) {
    asm volatile("s_waitcnt vmcnt(0)" ::: "memory");
    __syncthreads();
    if (b.lead && lane_now() == 0) {
        unsigned* bar = b.bar;
        __builtin_amdgcn_s_waitcnt(0);
        unsigned nloc = b.st[0], nx = b.st[1];
        if (nloc == 0u) { xcd_barrier_complete(bar, b.x, nloc, nx); b.st[0] = nloc; b.st[1] = nx; }
        const unsigned old = xb_add(&bar[XB_XSUB(b.x)], 1u);
        const unsigned gen = old / nloc;
        if (old + 1u == (gen + 1u) * nloc) {
            __builtin_amdgcn_fence(__ATOMIC_RELEASE, "agent");
            asm volatile("s_waitcnt vmcnt(0)" ::: "memory");
            const unsigned og = xb_add(&bar[XB_TOP], 1u);
            const unsigned tg = og / nx;
            if (og + 1u == (tg + 1u) * nx) xb_add(&bar[XB_TOPGEN], 1u);
            else XB_SPIN(xb_ld(&bar[XB_TOPGEN]) == tg, bar);
            __builtin_amdgcn_fence(__ATOMIC_ACQUIRE, "agent");
            xb_add(&bar[XB_XGEN(b.x)], 1u);
            asm volatile("s_waitcnt vmcnt(0)" ::: "memory");
        } else {
            XB_SPIN(xb_ld(&bar[XB_XGEN(b.x)]) == gen, bar);
            __builtin_amdgcn_fence(__ATOMIC_ACQUIRE, "agent");
            asm volatile("s_waitcnt vmcnt(0)" ::: "memory");
        }
    }
    __syncthreads();
}

namespace pg8 {
constexpr int BM = 256, BK = 64, HALF = 128, HTB = HALF * BK * 2, STAGE_BYTES = 8 * HTB, NXCD = 8, WGM = 8;
__device__ __forceinline__ int lds_byte(int r, int c) { const int st = (r >> 4) * 2 + (c >> 5), rr = r & 15, cc = c & 31, ob = rr * 64 + cc * 2; return st * 1024 + (ob ^ (((ob >> 9) & 1) << 5)); }
__device__ __forceinline__ void stage_rc(int b, int& R, int& C) { const int st = b / 1024, sb = b % 1024, swz = sb ^ (((sb >> 9) & 1) << 5); R = (st >> 1) * 16 + swz / 64; C = (st & 1) * 32 + (swz % 64) / 2; }
__device__ __forceinline__ int perm32(int rho) { const int n = rho >> 4, i = rho & 15; return 8 * (i >> 2) + 4 * n + (i & 3); }

struct Unit { int pm, pn, e, rb; };

struct StaticSched {
    static constexpr bool GATHER = false;
    const bf16* A; const bf16* Bt; int K; int nM, nN, nwg, G, c; int i0 = 0, i1 = 0x7fffffff;
    __device__ __forceinline__ void init(const bf16* A_, const bf16* Bt_, int M, int N, int K_, int G_, int c_) { A = A_; Bt = Bt_; K = K_; nM = M / BM; nN = N / BM; nwg = nM * nN; G = G_; c = c_; }
    __device__ __forceinline__ bool next(int i, Unit& u) const {
        if (i + i0 >= i1) return false;
        const long L = (long)(i + i0) * G + c; if (L >= nwg) return false;
        int wgid = (int)L; { const int q = nwg / NXCD, r = nwg % NXCD, xcd = wgid % NXCD, off = wgid / NXCD; wgid = (xcd < r ? xcd * (q + 1) : r * (q + 1) + (xcd - r) * q) + off; }
        const int nig = WGM * nN, gid = wgid / nig, fm = gid * WGM, gsz = (nM - fm) < WGM ? (nM - fm) : WGM;
        u.pm = fm + ((wgid % nig) % gsz); u.pn = (wgid % nig) / gsz; u.e = 0; u.rb = 0; return true;
    }
    __device__ __forceinline__ void a_ready(const Unit&) const {}
    __device__ __forceinline__ void done(const Unit&) const {}
    __device__ __forceinline__ const char* a_base(const Unit& u) const { return (const char*)A + (size_t)u.pm * BM * K * 2; }
    __device__ __forceinline__ const char* b_base(const Unit& u) const { return (const char*)Bt + (size_t)u.pn * BM * K * 2; }
    __device__ __forceinline__ void a_voff(const Unit&, const int (&R)[2], const int (&C)[2], unsigned (&v)[2][2]) const {
#pragma unroll
        for (int h = 0; h < 2; ++h)
#pragma unroll
            for (int i = 0; i < 2; ++i) v[h][i] = (unsigned)((h * HALF + R[i]) * K + C[i]) * 2u;
    }
};

typedef int v8i __attribute__((ext_vector_type(8)));
typedef int v4i __attribute__((ext_vector_type(4)));
template <class Epi, class Sched, bool ALIGN_EPI = true, bool FP8 = false>
__device__ __forceinline__ void gemm_phase(LAS unsigned char* lds, const int K, const Sched& S, const Epi& E, const int wave) {
    const int lane = lane_now(), wid = wave, tid = wid * 64 + lane,
              wr = wid >> 2, wc = wid & 3, fr = lane & 15, fq = lane >> 4;
    const int nt = K / BK;
    int Rr[2], Cc[2]; unsigned voffB[2];
#pragma unroll
    for (int i = 0; i < 2; ++i) { stage_rc(tid * 16 + i * 8192, Rr[i], Cc[i]); const int Rb = Epi::PERM ? ((Rr[i] & ~31) + perm32(Rr[i] & 31)) : Rr[i];
        voffB[i] = (unsigned)(Rb * K + Cc[i]) * 2u; }
    const size_t kstep = (size_t)(BK * 2);
    const size_t hstep = (size_t)HALF * K * 2;
    const unsigned ldsw = (unsigned)wid * 1024u;
    const unsigned ldsbase = (unsigned)__builtin_amdgcn_readfirstlane((int)(unsigned)(size_t)lds);
    const int aoff = lds_byte(wr * 64 + fr, fq * 8), boff = lds_byte(wc * 32 + fr, fq * 8);
#define PG8_SA(b, h) (((b) * 2 + (h)) * HTB)
#define PG8_SB(b, h) ((4 + (b) * 2 + (h)) * HTB)
#define PG8_STAGE(bufoff, gbase, voff) do { _Pragma("unroll") for (int _i = 0; _i < 2; ++_i) { unsigned _keep; \
        asm volatile("s_mov_b32 %0, m0\n\ts_mov_b32 m0, %3\n\ts_nop 0\n\tglobal_load_lds_dwordx4 %1, %2\n\ts_mov_b32 m0, %0" : "=&s"(_keep) : "v"((voff)[_i]), "s"((const char*)(gbase)), "s"(ldsbase + (unsigned)(bufoff) + ldsw + (unsigned)(_i * 8192)) : "memory"); } } while (0)
#define PG8_LDA(dst, b, h) do { _Pragma("unroll") for (int m = 0; m < 4; ++m) _Pragma("unroll") for (int k = 0; k < 2; ++k) dst[m][k] = *(const LAS bf16x8*)(lds + PG8_SA(b, h) + aoff + m * 2048 + k * 1024); } while (0)
#define PG8_LDB(dst, b, h) do { _Pragma("unroll") for (int n = 0; n < 2; ++n) _Pragma("unroll") for (int k = 0; k < 2; ++k) dst[n][k] = *(const LAS bf16x8*)(lds + PG8_SB(b, h) + boff + n * 2048 + k * 1024); } while (0)
#define PG8_LDA8(dst, b, h) do { _Pragma("unroll") for (int m = 0; m < 4; ++m) { const v4i lo_ = *(const LAS v4i*)(lds + PG8_SA(b, h) + aoff + m * 2048), hi_ = *(const LAS v4i*)(lds + PG8_SA(b, h) + aoff + m * 2048 + 1024); dst[m] = __builtin_shufflevector(lo_, hi_, 0, 1, 2, 3, 4, 5, 6, 7); } } while (0)
#define PG8_LDB8(dst, b, h) do { _Pragma("unroll") for (int n = 0; n < 2; ++n) { const v4i lo_ = *(const LAS v4i*)(lds + PG8_SB(b, h) + boff + n * 2048), hi_ = *(const LAS v4i*)(lds + PG8_SB(b, h) + boff + n * 2048 + 1024); dst[n] = __builtin_shufflevector(lo_, hi_, 0, 1, 2, 3, 4, 5, 6, 7); } } while (0)
#define PG8_MMA(ai, bj, At, Bt) do { __builtin_amdgcn_s_setprio(1); _Pragma("unroll") for (int m = 0; m < 4; ++m) _Pragma("unroll") for (int n = 0; n < 2; ++n) _Pragma("unroll") for (int k = 0; k < 2; ++k) \
        acc[ai][bj][m][n] = __builtin_amdgcn_mfma_f32_16x16x32_bf16(Bt[n][k], At[m][k], acc[ai][bj][m][n], 0, 0, 0); __builtin_amdgcn_s_setprio(0); } while (0)
#define PG8_MMA8(ai, bj, At, Bt) do { __builtin_amdgcn_s_setprio(1); _Pragma("unroll") for (int m = 0; m < 4; ++m) _Pragma("unroll") for (int n = 0; n < 2; ++n) \
        acc[ai][bj][m][n] = __builtin_amdgcn_mfma_scale_f32_16x16x128_f8f6f4(Bt[n], At[m], acc[ai][bj][m][n], 0, 0, 0, 0, 0, 0); __builtin_amdgcn_s_setprio(0); } while (0)
#define LDA_(b, h) do { if constexpr (FP8) PG8_LDA8(At8, b, h); else PG8_LDA(At, b, h); } while (0)
#define LDB0_(b, h) do { if constexpr (FP8) PG8_LDB8(B08, b, h); else PG8_LDB(B0, b, h); } while (0)
#define LDB1_(b, h) do { if constexpr (FP8) PG8_LDB8(B18, b, h); else PG8_LDB(B1, b, h); } while (0)
#define MMA0_(ai, bj) do { if constexpr (FP8) PG8_MMA8(ai, bj, At8, B08); else PG8_MMA(ai, bj, At, B0); } while (0)
#define MMA1_(ai, bj) do { if constexpr (FP8) PG8_MMA8(ai, bj, At8, B18); else PG8_MMA(ai, bj, At, B1); } while (0)
#define PG8_WAIT_V(n) asm volatile("s_waitcnt vmcnt(" #n ")" ::: "memory")
#define PG8_WAIT_L(n) asm volatile("s_waitcnt lgkmcnt(" #n ")" ::: "memory")
#define PG8_BAR __builtin_amdgcn_s_barrier()
#define PG8_SCHED __builtin_amdgcn_sched_barrier(0)
    Unit cur, nxt; int ui = 0;
    if (!S.next(0, cur)) return;
    f32x4 acc[2][2][4][2];
#pragma unroll
    for (int a = 0; a < 2; ++a)
#pragma unroll
        for (int b = 0; b < 2; ++b)
#pragma unroll
            for (int m = 0; m < 4; ++m)
#pragma unroll
                for (int n = 0; n < 2; ++n) acc[a][b][m][n] = (f32x4){0.f, 0.f, 0.f, 0.f};
    bf16x8 At[4][2], B0[2][2], B1[2][2]; v8i At8[4], B08[2], B18[2];
    const char* cA = S.a_base(cur); const char* cB = S.b_base(cur);
    S.a_ready(cur);
    constexpr bool GATHER = Sched::GATHER;
    unsigned vA[1][2];
    LAS unsigned* goff = (LAS unsigned*)(lds + STAGE_BYTES) + tid;
    int gslot = 0;
    constexpr bool LOFF = GATHER || FP8;
    if constexpr (!GATHER && FP8) { goff[8 * 512] = voffB[0]; goff[9 * 512] = voffB[1]; goff[10 * 512] = (unsigned)(Rr[0] * K + Cc[0]) * 2u; goff[11 * 512] = (unsigned)(Rr[1] * K + Cc[1]) * 2u; }
    if constexpr (GATHER) { unsigned t4[2][2]; S.a_voff(cur, Rr, Cc, t4); goff[0 * 512] = t4[0][0]; goff[1 * 512] = t4[0][1]; goff[2 * 512] = t4[1][0]; goff[3 * 512] = t4[1][1]; goff[8 * 512] = voffB[0]; goff[9 * 512] = voffB[1]; }
    else {
#pragma unroll
        for (int i = 0; i < 2; ++i) vA[0][i] = (unsigned)(Rr[i] * K + Cc[i]) * 2u; }
    const size_t ahstep = GATHER ? 0 : hstep;
#define PG8_STAGE_B(bufoff, kptr) do { if constexpr (LOFF) { unsigned _o[2]; _o[0] = goff[8 * 512]; _o[1] = goff[9 * 512]; PG8_STAGE(bufoff, kptr, _o); } else PG8_STAGE(bufoff, kptr, voffB); } while (0)
#define PG8_STAGE_A(bufoff, kptr, h, nx) do { if constexpr (GATHER) { unsigned _o[2]; const int _s = (gslot ^ (nx)) * 2048 + (h) * 1024; _o[0] = goff[_s]; _o[1] = goff[_s + 512]; PG8_STAGE(bufoff, kptr, _o); } \
        else if constexpr (FP8) { unsigned _o[2]; _o[0] = goff[10 * 512]; _o[1] = goff[11 * 512]; PG8_STAGE(bufoff, (kptr) + (h) * ahstep, _o); } \
        else PG8_STAGE(bufoff, (kptr) + (h) * ahstep, vA[0]); } while (0)
    PG8_STAGE(PG8_SB(0, 0), cB, voffB); PG8_STAGE(PG8_SB(0, 1), cB + hstep, voffB); PG8_STAGE_A(PG8_SA(0, 0), cA, 0, 0); PG8_STAGE_A(PG8_SA(0, 1), cA, 1, 0);
    if (wr == 1) PG8_BAR;
    PG8_WAIT_V(2); PG8_BAR;
    PG8_STAGE(PG8_SB(1, 0), cB + kstep, voffB); PG8_STAGE_A(PG8_SA(1, 0), cA + kstep, 0, 0); PG8_STAGE(PG8_SB(1, 1), cB + hstep + kstep, voffB);
    PG8_WAIT_V(6); PG8_BAR;
    for (;;) {
        const bool has_next = S.next(ui + 1, nxt);
        const char* nA = has_next ? S.a_base(nxt) : cA; const char* nB = has_next ? S.b_base(nxt) : cB;
        if constexpr (GATHER) { if (has_next) { unsigned t4[2][2]; int tl_ = tid; asm volatile("" : "+v"(tl_)); int R2[2], C2[2]; stage_rc(tl_ * 16, R2[0], C2[0]); stage_rc(tl_ * 16 + 8192, R2[1], C2[1]); S.a_voff(nxt, R2, C2, t4); const int o = (gslot ^ 1) * 2048; goff[o] = t4[0][0]; goff[o + 512] = t4[0][1]; goff[o + 1024] = t4[1][0]; goff[o + 1536] = t4[1][1]; } }
#pragma unroll 1
        for (int t = 0; t < nt; t += 2) {
            const bool last = (t == nt - 2);
            const char* a1 = cA + (size_t)(t + 1) * kstep;
            const char* a2 = last ? nA : cA + (size_t)(t + 2) * kstep; const char* b2 = last ? nB : cB + (size_t)(t + 2) * kstep;
            const char* a3 = a2 + kstep; const char* b3 = b2 + kstep;
            if (last && has_next) S.a_ready(nxt);
            const int nx = (last && has_next) ? 1 : 0;
            LDB0_(0, 0); LDB1_(0, 1); PG8_SCHED; LDA_(0, 0); PG8_STAGE_A(PG8_SA(1, 1), a1, 1, 0);
            PG8_WAIT_V(8); PG8_WAIT_L(0); PG8_BAR; MMA0_(0, 0); MMA1_(0, 1); PG8_BAR; PG8_SCHED;
            LDA_(0, 1); PG8_STAGE_B(PG8_SB(0, 0), b2); PG8_STAGE_B(PG8_SB(0, 1), b2 + hstep); PG8_STAGE_A(PG8_SA(0, 0), a2, 0, nx);
            PG8_WAIT_V(8); PG8_WAIT_L(0); PG8_BAR; MMA0_(1, 0); MMA1_(1, 1); PG8_BAR; PG8_SCHED;
            LDB0_(1, 0); LDB1_(1, 1); PG8_SCHED; LDA_(1, 0); PG8_STAGE_A(PG8_SA(0, 1), a2, 1, nx);
            PG8_WAIT_V(8); PG8_WAIT_L(0); PG8_BAR; MMA0_(0, 0); MMA1_(0, 1); PG8_BAR; PG8_SCHED;
            LDA_(1, 1); PG8_STAGE_B(PG8_SB(1, 0), b3); PG8_STAGE_B(PG8_SB(1, 1), b3 + hstep); PG8_STAGE_A(PG8_SA(1, 0), a3, 0, nx);
            PG8_WAIT_V(8); PG8_WAIT_L(0); PG8_BAR; MMA0_(1, 0); MMA1_(1, 1); PG8_BAR; PG8_SCHED;
        }
        if constexpr (ALIGN_EPI) { if (wr == 0) PG8_BAR; }
        { int fr2 = fr, fq2 = fq; asm volatile("" : "+v"(fr2), "+v"(fq2));
          E(acc, cur, wr, wc, fr2, fq2); } S.done(cur);
        if (!has_next) break;
#pragma unroll
        for (int a = 0; a < 2; ++a)
#pragma unroll
            for (int b = 0; b < 2; ++b)
#pragma unroll
                for (int m = 0; m < 4; ++m)
#pragma unroll
                    for (int n = 0; n < 2; ++n) acc[a][b][m][n] = (f32x4){0.f, 0.f, 0.f, 0.f};
        cur = nxt; cA = nA; cB = nB; ++ui;
        if constexpr (GATHER) gslot ^= 1;
        if constexpr (ALIGN_EPI) { if (wr == 1) PG8_BAR; }
    }
    PG8_WAIT_V(0);
    if constexpr (!ALIGN_EPI) { if (wr == 0) PG8_BAR; }
    PG8_BAR;
#undef PG8_SA
#undef PG8_SB
#undef PG8_STAGE
#undef PG8_STAGE_A
#undef PG8_STAGE_B
#undef PG8_LDA
#undef PG8_LDB
#undef PG8_MMA
#undef PG8_MMA8
#undef PG8_LDA8
#undef PG8_LDB8
#undef LDA_
#undef LDB0_
#undef LDB1_
#undef MMA0_
#undef MMA1_
#undef PG8_WAIT_V
#undef PG8_WAIT_L
#undef PG8_BAR
#undef PG8_SCHED
}

struct EpiProj {
    static constexpr bool PERM = true;
    bf16* O; float asc;
    __device__ __forceinline__ void operator()(const f32x4 (&acc)[2][2][4][2], const Unit& u, int wr, int wc, int fr, int fq) const {
        const int row0 = u.pm * BM + wr * 64 + fr, col0 = u.pn * BM + wc * 32 + 8 * fq;
        const bool act = u.pn < 4;
#pragma unroll
        for (int ai = 0; ai < 2; ++ai)
#pragma unroll
            for (int m = 0; m < 4; ++m) { bf16* rowp = O + (size_t)(row0 + ai * HALF + m * 16) * DIN + col0;
#pragma unroll
                for (int bj = 0; bj < 2; ++bj) { f32x4 v0 = acc[ai][bj][m][0] * asc, v1 = acc[ai][bj][m][1] * asc;
                    if (act) {
#pragma unroll
                        for (int j = 0; j < 4; ++j) { v0[j] = gelu_tanh(v0[j]); v1[j] = gelu_tanh(v1[j]); } }
                    u32x4 w; w.x = cvt_pk_bf16(v0[0], v0[1]); w.y = cvt_pk_bf16(v0[2], v0[3]); w.z = cvt_pk_bf16(v1[0], v1[1]); w.w = cvt_pk_bf16(v1[2], v1[3]);
                    *(u32x4*)(rowp + bj * HALF) = w; } }
    }
};
template <bool RES_BF16> struct EpiResid {
    static constexpr bool PERM = true; static constexpr float ASC = OP8(RES_BF16 ? 1 : 0) ? 1.f / WOUT_SCALE : 1.f;
    const void* res; bf16* out;
    __device__ __forceinline__ void operator()(const f32x4 (&acc)[2][2][4][2], const Unit& u, int wr, int wc, int fr, int fq) const {
        const int row0 = u.pm * BM + wr * 64 + fr, col0 = u.pn * BM + wc * 32 + 8 * fq;
#pragma unroll
        for (int ai = 0; ai < 2; ++ai) {
            if constexpr (RES_BF16) {
                u32x4 r[4][2];
#pragma unroll
                for (int m = 0; m < 4; ++m)
#pragma unroll
                    for (int bj = 0; bj < 2; ++bj) r[m][bj] = __builtin_nontemporal_load((const u32x4*)((const bf16*)res + (size_t)(row0 + ai * HALF + m * 16) * DM + col0 + bj * HALF));
                asm volatile("s_waitcnt vmcnt(0)" ::: "memory");
#pragma unroll
                for (int m = 0; m < 4; ++m)
#pragma unroll
                    for (int bj = 0; bj < 2; ++bj) { f32x4 v0 = acc[ai][bj][m][0] * ASC, v1 = acc[ai][bj][m][1] * ASC; const u32x4 q = r[m][bj];
                        v0[0] += bf_lo(q.x); v0[1] += bf_hi(q.x); v0[2] += bf_lo(q.y); v0[3] += bf_hi(q.y); v1[0] += bf_lo(q.z); v1[1] += bf_hi(q.z); v1[2] += bf_lo(q.w); v1[3] += bf_hi(q.w);
                        u32x4 w; w.x = cvt_pk_bf16(v0[0], v0[1]); w.y = cvt_pk_bf16(v0[2], v0[3]); w.z = cvt_pk_bf16(v1[0], v1[1]); w.w = cvt_pk_bf16(v1[2], v1[3]);
                        *(u32x4*)(out + (size_t)(row0 + ai * HALF + m * 16) * DM + col0 + bj * HALF) = w; }
            } else {
#pragma unroll
                for (int mh = 0; mh < 2; ++mh) {
                    f32x4 r[2][2][2];
#pragma unroll
                    for (int m = 0; m < 2; ++m)
#pragma unroll
                        for (int bj = 0; bj < 2; ++bj) { const float* rp = (const float*)res + (size_t)(row0 + ai * HALF + (2 * mh + m) * 16) * DM + col0 + bj * HALF; r[m][bj][0] = __builtin_nontemporal_load((const f32x4*)rp); r[m][bj][1] = __builtin_nontemporal_load((const f32x4*)(rp + 4)); }
                    asm volatile("s_waitcnt vmcnt(0)" ::: "memory");
#pragma unroll
                    for (int m = 0; m < 2; ++m)
#pragma unroll
                        for (int bj = 0; bj < 2; ++bj) { const f32x4 v0 = acc[ai][bj][2 * mh + m][0] * ASC + r[m][bj][0], v1 = acc[ai][bj][2 * mh + m][1] * ASC + r[m][bj][1];
                            u32x4 w; w.x = cvt_pk_bf16(v0[0], v0[1]); w.y = cvt_pk_bf16(v0[2], v0[3]); w.z = cvt_pk_bf16(v1[0], v1[1]); w.w = cvt_pk_bf16(v1[2], v1[3]);
                            *(u32x4*)(out + (size_t)(row0 + ai * HALF + (2 * mh + m) * 16) * DM + col0 + bj * HALF) = w; }
                }
            }
        }
    }
};
struct EpiSwiGLU {
    static constexpr bool PERM = true;
    unsigned char* HB; const float* rslot;
    __device__ __forceinline__ void operator()(const f32x4 (&acc)[2][2][4][2], const Unit& u, int wr, int wc, int fr, int fq) const {
        const int row0 = u.pm * BM + wr * 64 + fr, col0 = u.pn * HALF + wc * 32 + 8 * fq;
        const __amdgpu_buffer_rsrc_t rsrc = __builtin_amdgcn_make_buffer_rsrc((void*)HB, 0, 40960 * DE, 0x00020000);
        const float* rsl = rslot + (size_t)u.e * TOKCAP + u.rb * BM + wr * 64 + fr;
#pragma unroll
        for (int ai = 0; ai < 2; ++ai) {
            float rsv[4];
#pragma unroll
            for (int m = 0; m < 4; ++m) rsv[m] = rsl[ai * HALF + m * 16];
            asm volatile("s_waitcnt vmcnt(0)" ::: "memory");
#pragma unroll
            for (int m = 0; m < 4; ++m) { const unsigned boff = (unsigned)((row0 + ai * HALF + m * 16) * DE + col0);
                const float rs = rsv[m] * (1.f / W1_SCALE);
                float h[8];
#pragma unroll
                for (int n = 0; n < 2; ++n)
#pragma unroll
                    for (int j = 0; j < 4; ++j) { const float g = acc[ai][0][m][n][j] * rs, up = acc[ai][1][m][n][j] * rs; h[n * 4 + j] = g * sigmoidf_(g) * up; }
                u32x2 w; w.x = pk4_fp8(h[0], h[1], h[2], h[3]); w.y = pk4_fp8(h[4], h[5], h[6], h[7]);
                __builtin_amdgcn_raw_buffer_store_b64(w, rsrc, boff, 0, 16); } }
    }
};
struct EpiY {
    static constexpr bool PERM = true;
    unsigned char* Y;
    __device__ __forceinline__ void operator()(const f32x4 (&acc)[2][2][4][2], const Unit& u, int wr, int wc, int fr, int fq) const {
        const int row0 = u.pm * BM + wr * 64 + fr, col0 = u.pn * BM + wc * 32 + 8 * fq;
#pragma unroll
        for (int ai = 0; ai < 2; ++ai)
#pragma unroll
            for (int m = 0; m < 4; ++m) { unsigned char* rowp = Y + (size_t)(row0 + ai * HALF + m * 16) * DM + col0;
#pragma unroll
                for (int bj = 0; bj < 2; ++bj) { const f32x4 v0 = acc[ai][bj][m][0] * (Y_SCALE / W2_SCALE), v1 = acc[ai][bj][m][1] * (Y_SCALE / W2_SCALE);
                    u32x2 w; w.x = pk4_fp8(v0[0], v0[1], v0[2], v0[3]); w.y = pk4_fp8(v1[0], v1[1], v1[2], v1[3]);
                    *(u32x2*)(rowp + bj * HALF) = w; } }
    }
};

struct SchedG1 {
    static constexpr bool GATHER = true;
    const LAS int* tstart; const int* cnt; const int* tok; const bf16* X; const bf16* W1; int G, c; unsigned* ready;
    __device__ __forceinline__ void a_ready(const Unit&) const {}
    __device__ __forceinline__ void done(const Unit& u) const {
        asm volatile("s_waitcnt vmcnt(0)" ::: "memory");
        if (lane_now() == 0) __hip_atomic_fetch_add(ready + 64 * u.pm, 1u, __ATOMIC_RELAXED, __HIP_MEMORY_SCOPE_AGENT);
    }
    __device__ __forceinline__ bool next(int i, Unit& u) const {
        const int L = i * G + c, NT = __builtin_amdgcn_readfirstlane(tstart[NE]); if (L >= NT * 4) return false;
        const int T = L >> 2; const int e = tstart[560 + T];
        u.pm = __builtin_amdgcn_readfirstlane(T); u.pn = L & 3; u.e = __builtin_amdgcn_readfirstlane(e); u.rb = __builtin_amdgcn_readfirstlane(T - tstart[e]); return true;
    }
    static constexpr int KU = DM / 2;
    __device__ __forceinline__ const char* a_base(const Unit&) const { return (const char*)X; }
    __device__ __forceinline__ const char* b_base(const Unit& u) const { return (const char*)W1 + ((size_t)u.e * 1024 + (size_t)u.pn * BM) * DM; }
    __device__ __forceinline__ void a_voff(const Unit& u, const int (&R)[2], const int (&C)[2], unsigned (&v)[2][2]) const {
        const int n = cnt[u.e * 64]; const int* tl = tok + (size_t)u.e * TOKCAP;
#pragma unroll
        for (int h = 0; h < 2; ++h)
#pragma unroll
            for (int i = 0; i < 2; ++i) { int row = u.rb * BM + h * HALF + R[i]; row = row < n ? row : 0; const int t = tl[row]; v[h][i] = (unsigned)(t * KU + C[i]) * 2u; }
    }
};
struct SchedG2 {
    static constexpr bool GATHER = false;
    const LAS int* tstart; const bf16* HB; const bf16* W2; int G, c; unsigned* ready; unsigned* tmo; int wave;
    __device__ __forceinline__ bool next(int i, Unit& u) const {
        constexpr int K0 = 3;
        const int NT = __builtin_amdgcn_readfirstlane(tstart[NE]), n1 = 4 * NT, n1max = (n1 + G - 1) / G, R = n1 - G * (n1max - 1), nB = G - R;
        int L;
        if (c >= R) L = (i < K0) ? i * nB + (c - R) : K0 * nB + (i - K0) * G + c;
        else L = K0 * nB + i * G + c;
        if (L >= NT * 8) return false;
        const int T = L >> 3; const int e = tstart[560 + T];
        u.pm = __builtin_amdgcn_readfirstlane(T); u.pn = __builtin_amdgcn_readfirstlane(L & 7); u.e = __builtin_amdgcn_readfirstlane(e); u.rb = __builtin_amdgcn_readfirstlane(T - tstart[e]); return true;
    }
    __device__ __forceinline__ void done(const Unit&) const {}
    __device__ __forceinline__ void a_ready(const Unit& u) const {
        if (wave == 0) {
            unsigned polls = 0;
            while ((unsigned)__builtin_amdgcn_readfirstlane(__hip_atomic_load(ready + 64 * u.pm, __ATOMIC_RELAXED, __HIP_MEMORY_SCOPE_AGENT)) < 32u) {
                if (++polls > (1u << 22)) { if (lane_now() == 0) __hip_atomic_store(tmo, 0x600u | (unsigned)(u.pm & 0xff), __ATOMIC_RELAXED, __HIP_MEMORY_SCOPE_AGENT); break; }
                __builtin_amdgcn_s_sleep(2); }
            __builtin_amdgcn_fence(__ATOMIC_ACQUIRE, "agent");
            asm volatile("s_waitcnt vmcnt(0)" ::: "memory");
        }
        asm volatile("" ::: "memory"); __builtin_amdgcn_s_barrier(); asm volatile("" ::: "memory");
    }
    __device__ __forceinline__ const char* a_base(const Unit& u) const { return (const char*)HB + (size_t)u.pm * BM * DE; }
    __device__ __forceinline__ const char* b_base(const Unit& u) const { return (const char*)W2 + ((size_t)u.e * DM + (size_t)u.pn * BM) * DE; }
    __device__ __forceinline__ void a_voff(const Unit&, const int (&R)[2], const int (&C)[2], unsigned (&v)[2][2]) const {
#pragma unroll
        for (int h = 0; h < 2; ++h)
#pragma unroll
            for (int i = 0; i < 2; ++i) v[h][i] = (unsigned)((h * HALF + R[i]) * DE + C[i]) * 2u;
    }
};
}

struct Params { const float* in[22]; float* out; unsigned char* ws; int ph_lo, ph_hi; };
enum { IN_X = 0, IN_NORM1, IN_WIN, IN_SGUN, IN_SGUW, IN_SGUB, IN_CONVW, IN_CONVB, IN_LNG, IN_LNB, IN_QN, IN_KN, IN_OUTN, IN_WOUT, IN_NORM2, IN_WRG, IN_BRG, IN_WRE, IN_BRE, IN_WG, IN_WU, IN_WD };

struct Frame {
    LAS unsigned char* lds; volatile LAS unsigned* MISC;
    int tid, lane, wave, vcu, G;
    const float* const* in; float* out; unsigned char* ws;
};

__device__ __forceinline__ void tile_desc(const float* const* in, unsigned char* ws, int it, const float*& src, int& ldw, unsigned char*& dst, int& pitch, const float*& ksc, float& wsc, int& fp8) {
    constexpr int T_IN = 32 * 80, T_OUT = 32 * 32, T_E = 32 * 8, T_D = 8 * 32;
    constexpr int T_LAYER = T_IN + T_OUT + NE * (2 * T_E + T_D);
    const int l = it / T_LAYER; int r = it % T_LAYER; ksc = nullptr; wsc = 1.f; fp8 = 0;
    if (r < T_IN) { ldw = DIN;
        if (IP8(l)) { const int kb = r / 160, nb = r % 160; pitch = DM; fp8 = 1; wsc = WIN_SCALE; src = in[IN_WIN] + (size_t)l * DM * DIN + (size_t)(128 * kb) * DIN + 32 * nb; dst = ws + WS_WIN + (size_t)l * DIN * DM * 2 + ((size_t)32 * nb) * DM + 128 * kb; }
        else { const int kb = r / 80, nb = r % 80; pitch = DM * 2; src = in[IN_WIN] + (size_t)l * DM * DIN + (size_t)(64 * kb) * DIN + 64 * nb; dst = ws + WS_WIN + (((size_t)l * DIN + 64 * nb) * DM + 64 * kb) * 2; }
        return; } r -= T_IN;
    if (r < T_OUT) { const int kb = r / 32, nb = r % 32; ldw = DM; src = in[IN_WOUT] + (size_t)l * DM * DM + (size_t)(64 * kb) * DM + 64 * nb;
        if (OP8(l)) { const int kb8 = r / 64, nb8 = r % 64; pitch = DM; fp8 = 1; wsc = WOUT_SCALE; src = in[IN_WOUT] + (size_t)l * DM * DM + (size_t)(128 * kb8) * DM + 32 * nb8; dst = ws + WS_WOUT + (size_t)l * DM * DM * 2 + ((size_t)32 * nb8) * DM + 128 * kb8; } else { pitch = DM * 2; dst = ws + WS_WOUT + (((size_t)l * DM + 64 * nb) * DM + 64 * kb) * 2; }
        return; } r -= T_OUT;
    const int e = r / (2 * T_E + T_D); r %= (2 * T_E + T_D);
    const size_t le = (size_t)l * NE + e; fp8 = 1;
    if (r < 2 * T_E) { const int up = r >= T_E; r -= up * T_E; const int kb = r / 16, nb = r % 16, n0 = 32 * nb; ldw = DE; pitch = DM; wsc = W1_SCALE;
        src = (up ? in[IN_WU] : in[IN_WG]) + le * DM * DE + (size_t)(128 * kb) * DE + n0; dst = ws + WS_W1 + (le * 1024 + (size_t)((n0 / 128) * 256 + up * 128 + (n0 % 128))) * DM + 128 * kb; ksc = in[IN_NORM2] + (size_t)l * DM + 128 * kb; return; }
    r -= 2 * T_E;
    { const int kb = r / 64, nb = r % 64; ldw = DM; pitch = DE; wsc = W2_SCALE; src = in[IN_WD] + le * DE * DM + (size_t)(128 * kb) * DM + 32 * nb; dst = ws + WS_W2 + (le * DM + 32 * nb) * DE + 128 * kb; }
}
#define TR_LOAD(V, src, ldw, fp8) do { if (fp8) { _Pragma("unroll") for (int i = 0; i < 16; ++i) V[i] = __builtin_nontemporal_load((const f32x4*)((src) + (size_t)(16 * (lane >> 3) + i) * (ldw) + 4 * (lane & 7))); } \
    else { _Pragma("unroll") for (int i = 0; i < 16; ++i) V[i] = __builtin_nontemporal_load((const f32x4*)((src) + (size_t)(4 * i + (lane >> 4)) * (ldw) + 4 * (lane & 15))); } } while (0)
#define TR_PROC(V, dst, pitch, ksc, wsc, fp8) do { \
    if (fp8) {        \
        f32x4 s_[4]; if (ksc) { _Pragma("unroll") for (int q = 0; q < 4; ++q) s_[q] = *(const f32x4*)((ksc) + 16 * (lane >> 3) + 4 * q) * (wsc); } else { _Pragma("unroll") for (int q = 0; q < 4; ++q) s_[q] = (f32x4){(wsc), (wsc), (wsc), (wsc)}; } \
        _Pragma("unroll") for (int c = 0; c < 4; ++c) { u32x4 o; \
            _Pragma("unroll") for (int q = 0; q < 4; ++q) o[q] = pk4_fp8(V[4 * q][c] * s_[q][0], V[4 * q + 1][c] * s_[q][1], V[4 * q + 2][c] * s_[q][2], V[4 * q + 3][c] * s_[q][3]); \
            __builtin_nontemporal_store(o, (u32x4*)((dst) + (size_t)(4 * (lane & 7) + c) * (pitch) + 16 * (lane >> 3))); }     \
    } else { \
        _Pragma("unroll") for (int i = 0; i < 16; ++i) { const int kk = 4 * i + (lane >> 4); f32x4 v = V[i] * ((ksc) ? (ksc)[kk] * (wsc) : (wsc)); \
            LAS float* d = scr + kk * 65 + 4 * (lane & 15); d[0] = v[0]; d[1] = v[1]; d[2] = v[2]; d[3] = v[3]; } \
        LDS_WAIT(); \
        _Pragma("unroll") for (int j = 0; j < 8; ++j) { const int n = (lane >> 3) + 8 * j; const LAS float* sp = scr + (8 * (lane & 7)) * 65 + n; \
            u32x4 o; o.x = cvt_pk_bf16(sp[0], sp[65]); o.y = cvt_pk_bf16(sp[2 * 65], sp[3 * 65]); o.z = cvt_pk_bf16(sp[4 * 65], sp[5 * 65]); o.w = cvt_pk_bf16(sp[6 * 65], sp[7 * 65]); \
            *(u32x4*)((dst) + (size_t)n * (pitch) + 16 * (lane & 7)) = o; } } \
    LDS_WAIT(); } while (0)
__device__ __forceinline__ void norm_row_bf16(const float* xrow, const float* g, bf16* orow, int lane) {
    f32x4 v[8]; float s = 0.f;
#pragma unroll
    for (int j = 0; j < 8; ++j) { v[j] = __builtin_nontemporal_load((const f32x4*)(xrow + 4 * lane + 256 * j)); s += (v[j][0] * v[j][0] + v[j][1] * v[j][1]) + (v[j][2] * v[j][2] + v[j][3] * v[j][3]); }
    const float rs = __builtin_amdgcn_rsqf(wave_sum(s) * (1.f / DM) + EPS);
#pragma unroll
    for (int j = 0; j < 8; ++j) { const f32x4 gg = *(const f32x4*)(g + 4 * lane + 256 * j);
        u32x2 o; o.x = cvt_pk_bf16(v[j][0] * rs * gg[0], v[j][1] * rs * gg[1]); o.y = cvt_pk_bf16(v[j][2] * rs * gg[2], v[j][3] * rs * gg[3]);
        *(u32x2*)(orow + 4 * lane + 256 * j) = o; }
}
constexpr int CV_P = 2560, CV_A = 28160 + 3584, CV_B = 2 * 28160;
__device__ __forceinline__ void convert_tiles(Frame& F, const int t_lo, const int T_TOTAL) {
    LAS float* scr = (LAS float*)(F.lds + F.wave * 16896);
    const int gw = F.vcu * NWAVES + F.wave, NGW = F.G * NWAVES, lane = F.lane;
    {
        f32x4 va[16], vb[16];
        const float* srcA; const float* srcB; unsigned char* dstA; unsigned char* dstB; const float* kA; const float* kB; int ldA, ldB, pA, pB, fA, fB; float wA, wB;
        int it = t_lo + gw;
        if (it < T_TOTAL) { tile_desc(F.in, F.ws, it, srcA, ldA, dstA, pA, kA, wA, fA); TR_LOAD(va, srcA, ldA, fA); }
        while (it < T_TOTAL) {
            const int itb = it + NGW;
            if (itb < T_TOTAL) { tile_desc(F.in, F.ws, itb, srcB, ldB, dstB, pB, kB, wB, fB); TR_LOAD(vb, srcB, ldB, fB); }
            TR_PROC(va, dstA, pA, kA, wA, fA);
            if (itb >= T_TOTAL) break;
            const int ita = itb + NGW;
            if (ita < T_TOTAL) { tile_desc(F.in, F.ws, ita, srcA, ldA, dstA, pA, kA, wA, fA); TR_LOAD(va, srcA, ldA, fA); }
            TR_PROC(vb, dstB, pB, kB, wB, fB);
            it = ita;
        }
    }
}
__device__ __forceinline__ void p_prologue(Frame& F) {
    const int gw = F.vcu * NWAVES + F.wave, NGW = F.G * NWAVES;
    convert_tiles(F, 0, CV_P);
    { bf16* SW = (bf16*)(F.ws + WS_SGUW); const int gt = gw * 64 + F.lane, NGT = NGW * 64;
      for (int idx = gt; idx < NLAYER * 4 * 8 * 4 * 64; idx += NGT) {
          const int ln = idx & 63, pp = (idx >> 6) & 3, itile = (idx >> 8) & 7, h = (idx >> 11) & 3, l = idx >> 13;
          const int i = 16 * itile + (ln & 15), gq = ln >> 4;
          const float* w = F.in[IN_SGUW] + ((size_t)(l * 4 + h) * 128 + i) * 128;
          float v[8];
#pragma unroll
          for (int jj = 0; jj < 8; ++jj) { const int j = 32 * pp + (jj < 4 ? 4 * gq + jj : 16 + 4 * gq + (jj - 4)); v[jj] = (j <= i) ? w[j] : 0.f; }
          u32x4 o; o.x = cvt_pk_bf16(v[0], v[1]); o.y = cvt_pk_bf16(v[2], v[3]); o.z = cvt_pk_bf16(v[4], v[5]); o.w = cvt_pk_bf16(v[6], v[7]);
          *(u32x4*)(SW + (size_t)idx * 8) = o; }
      bf16* WRF = (bf16*)(F.ws + WS_WRT);
      for (int idx = gt; idx < NLAYER * 64 * 3 * 64; idx += NGT) { const int ln = idx & 63, ct = (idx >> 6) % 3, ks = (idx / 192) & 63, l = idx / (192 * 64);
          const int o = 16 * ct + (ln & 15), k0 = 32 * ks + 8 * (ln >> 4);
          float v[8];
#pragma unroll
          for (int j = 0; j < 8; ++j) { const int k = k0 + j; const float wv = o < 32 ? F.in[IN_WRE][((size_t)l * DM + k) * NE + o] : (o < 36 ? F.in[IN_WRG][((size_t)l * DM + k) * 4 + (o - 32)] : 0.f);
              v[j] = wv * F.in[IN_NORM2][(size_t)l * DM + k]; }
          u32x4 hi, lo; hi.x = cvt_pk_bf16(v[0], v[1]); hi.y = cvt_pk_bf16(v[2], v[3]); hi.z = cvt_pk_bf16(v[4], v[5]); hi.w = cvt_pk_bf16(v[6], v[7]);
          lo.x = cvt_pk_bf16(v[0] - bf_lo(hi.x), v[1] - bf_hi(hi.x)); lo.y = cvt_pk_bf16(v[2] - bf_lo(hi.y), v[3] - bf_hi(hi.y));
          lo.z = cvt_pk_bf16(v[4] - bf_lo(hi.z), v[5] - bf_hi(hi.z)); lo.w = cvt_pk_bf16(v[6] - bf_lo(hi.w), v[7] - bf_hi(hi.w));
          bf16* dst = WRF + ((((size_t)l * 64 + ks) * 3 + ct) * 2 * 64 + ln) * 8;
          *(u32x4*)dst = hi; *(u32x4*)(dst + 512) = lo; } }
    bf16* HN = (bf16*)(F.ws + WS_HN);
    for (int m = gw; m < SEQ; m += NGW) norm_row_bf16(F.in[IN_X] + (size_t)m * DM, F.in[IN_NORM1], HN + (size_t)m * DM, F.lane);
}

__device__ __forceinline__ int vimg_off(int row, int c) { return row * 256 + ((((c >> 1) ^ (row & 7)) << 1) | (c & 1)) * 16; }
__device__ __forceinline__ bf16x8 tr_frag(const LAS unsigned char* img, int ra, int rb, int dt, int lane) {
    const int gq = lane >> 4, q = (lane & 15) >> 2, p = lane & 3;
    const int r0 = ra + 4 * gq + q, r1 = rb + 4 * gq + q, c = 2 * dt + (p >> 1);
    const s16x4 a = __builtin_amdgcn_ds_read_tr16_b64_v4i16((LAS s16x4*)(img + vimg_off(r0, c) + 8 * (p & 1)));
    const s16x4 b = __builtin_amdgcn_ds_read_tr16_b64_v4i16((LAS s16x4*)(img + vimg_off(r1, c) + 8 * (p & 1)));
    bf16x8 r; r[0] = a[0]; r[1] = a[1]; r[2] = a[2]; r[3] = a[3]; r[4] = b[0]; r[5] = b[1]; r[6] = b[2]; r[7] = b[3]; return r;
}
__device__ __forceinline__ void sgu_stage8(const bf16* vsrc, int j0, int w, int lane, const f32x4& g0, const f32x4& g1, LAS unsigned char* lds) {
    u32x4 raw[8];
#pragma unroll
    for (int j = 0; j < 8; ++j) raw[j] = *(const u32x4*)(vsrc + (size_t)(w + 8 * (j0 + j)) * DIN);
#pragma unroll
    for (int j = 0; j < 8; ++j) { const int row = w + 8 * (j0 + j);
        float x[8] = {bf_lo(raw[j].x), bf_hi(raw[j].x), bf_lo(raw[j].y), bf_hi(raw[j].y), bf_lo(raw[j].z), bf_hi(raw[j].z), bf_lo(raw[j].w), bf_hi(raw[j].w)};
        float s = 0.f;
#pragma unroll
        for (int e = 0; e < 8; ++e) s += x[e] * x[e];
        const float rs = __builtin_amdgcn_rsqf(wave_sum(s) * (1.f / 512.f) + EPS);
        u32x4 o; o.x = cvt_pk_bf16(x[0] * rs * g0[0], x[1] * rs * g0[1]); o.y = cvt_pk_bf16(x[2] * rs * g0[2], x[3] * rs * g0[3]);
        o.z = cvt_pk_bf16(x[4] * rs * g1[0], x[5] * rs * g1[1]); o.w = cvt_pk_bf16(x[6] * rs * g1[2], x[7] * rs * g1[3]);
        *(LAS u32x4*)(lds + (lane >> 4) * 32768 + vimg_off(row, lane & 15)) = o; }
}
__device__ __forceinline__ void sgu_item(Frame& F, int l, int chunk, int half) {
    const bf16* PROJ = (const bf16*)(F.ws + WS_PROJ); bf16* MIX = (bf16*)(F.ws + WS_MIX);
    const int p0 = chunk * 128, lane = F.lane, w = F.wave;
    LAS float* red = (LAS float*)(F.lds + MISC_OFF + 256);
    const float* gn = F.in[IN_SGUN] + l * 512;
    const f32x4 g0 = *(const f32x4*)(gn + 8 * lane), g1 = *(const f32x4*)(gn + 8 * lane + 4);
    const bf16* vsrc = PROJ + (size_t)p0 * DIN + OFF_V + 8 * lane;
    sgu_stage8(vsrc, 0, w, lane, g0, g1, F.lds);
    if (half) sgu_stage8(vsrc, 8, w, lane, g0, g1, F.lds);
    const int h = w >> 1, ih = w & 1, gq = lane >> 4, fr = lane & 15;
    const LAS unsigned char* img = F.lds + h * 32768;
    const bf16* SW = (const bf16*)(F.ws + WS_SGUW) + (size_t)(l * 4 + h) * 8 * 4 * 64 * 8;
    const float* bs = F.in[IN_SGUB] + (size_t)(l * 4 + h) * 128;
    const float* og = F.in[IN_OUTN] + (size_t)l * DM + h * 128 + 4 * gq;
    const int it0 = ih + 4 * half;
    u32x2 ur[2][8];
#pragma unroll
    for (int ii = 0; ii < 2; ++ii) { const bf16* urow = PROJ + (size_t)(p0 + 16 * (it0 + 2 * ii) + fr) * DIN + OFF_U + h * 128 + 4 * gq;
#pragma unroll
        for (int dt = 0; dt < 8; ++dt) ur[ii][dt] = *(const u32x2*)(urow + 16 * dt); }
    __syncthreads();
    f32x4 z[2][8];
#pragma unroll
    for (int ii = 0; ii < 2; ++ii)
#pragma unroll
        for (int dt = 0; dt < 8; ++dt) z[ii][dt] = (f32x4){0.f, 0.f, 0.f, 0.f};
#pragma unroll 1
    for (int pp = 0; pp <= (it0 + 2) / 2; ++pp) {
        const bf16x8 bw0 = *(const bf16x8*)(SW + ((size_t)(it0 * 4 + pp) * 64 + lane) * 8);
        const bf16x8 bw1 = *(const bf16x8*)(SW + ((size_t)((it0 + 2) * 4 + pp) * 64 + lane) * 8);
        const bool do0 = pp <= it0 / 2;
#pragma unroll
        for (int dt = 0; dt < 8; ++dt) { const bf16x8 a = tr_frag(img, 32 * pp, 32 * pp + 16, dt, lane);
            if (do0) z[0][dt] = __builtin_amdgcn_mfma_f32_16x16x32_bf16(a, bw0, z[0][dt], 0, 0, 0);
            z[1][dt] = __builtin_amdgcn_mfma_f32_16x16x32_bf16(a, bw1, z[1][dt], 0, 0, 0); }
    }
#pragma unroll
    for (int ii = 0; ii < 2; ++ii) { const int i = 16 * (it0 + 2 * ii) + fr; const float bi = bs[i]; float s = 0.f;
#pragma unroll
        for (int dt = 0; dt < 8; ++dt) { const u32x2 u2 = ur[ii][dt];
            f32x4 y; y[0] = bf_lo(u2.x) * (z[ii][dt][0] + bi); y[1] = bf_hi(u2.x) * (z[ii][dt][1] + bi); y[2] = bf_lo(u2.y) * (z[ii][dt][2] + bi); y[3] = bf_hi(u2.y) * (z[ii][dt][3] + bi);
            z[ii][dt] = y; s += (y[0] * y[0] + y[1] * y[1]) + (y[2] * y[2] + y[3] * y[3]); }
        s += __shfl_xor(s, 16); s += __shfl_xor(s, 32);
        if (gq == 0) red[i * 4 + h] = s; }
    __syncthreads();
#pragma unroll
    for (int ii = 0; ii < 2; ++ii) { const int i = 16 * (it0 + 2 * ii) + fr;
        const f32x4 rr = *(const LAS f32x4*)(red + i * 4);
        const float rs = __builtin_amdgcn_rsqf(((rr[0] + rr[1]) + (rr[2] + rr[3])) * (1.f / 512.f) + EPS);
        bf16* orow = MIX + (size_t)(p0 + i) * DM + h * 128 + 4 * gq;
#pragma unroll
        for (int dt = 0; dt < 8; ++dt) { const f32x4 gg = *(const f32x4*)(og + 16 * dt); const f32x4 y = z[ii][dt];
            if (OP8(l)) *(unsigned*)((unsigned char*)MIX + (size_t)(p0 + i) * DM + h * 128 + 4 * gq + 16 * dt) = pk4_fp8(y[0] * rs * gg[0], y[1] * rs * gg[1], y[2] * rs * gg[2], y[3] * rs * gg[3]);
            else { u32x2 o; o.x = cvt_pk_bf16(y[0] * rs * gg[0], y[1] * rs * gg[1]); o.y = cvt_pk_bf16(y[2] * rs * gg[2], y[3] * rs * gg[3]);
            *(u32x2*)(orow + 16 * dt) = o; } } }
    __syncthreads();
}

__device__ __forceinline__ void conv_item(Frame& F, int l, int tile) {
    const bf16* PROJ = (const bf16*)(F.ws + WS_PROJ); bf16* MIX = (bf16*)(F.ws + WS_MIX);
    constexpr int TP = 32, NR = TP + 30;
    const int p0 = tile * TP, c = F.tid, tid = F.tid;
    LAS float* cbuf = (LAS float*)F.lds;
    LAS bf16* zbuf = (LAS bf16*)(F.lds + 65536);
    { u32x4 av[8], gv[8];
#pragma unroll
      for (int i = 0; i < 8; ++i) { const int id = tid + NTHREADS * i, row = id >> 6, ch = (id & 63) * 8; int p = p0 - 30 + row; p = p < 0 ? 0 : p; p = row < NR ? p : 0;
          av[i] = *(const u32x4*)(PROJ + (size_t)p * DIN + OFF_A + ch); gv[i] = *(const u32x4*)(PROJ + (size_t)p * DIN + OFF_G + ch); }
#pragma unroll
      for (int i = 0; i < 8; ++i) { const int id = tid + NTHREADS * i, row = id >> 6, ch = (id & 63) * 8; const bool live = (p0 - 30 + row) >= 0;
          const unsigned au[4] = {av[i].x, av[i].y, av[i].z, av[i].w}, gu[4] = {gv[i].x, gv[i].y, gv[i].z, gv[i].w}; u32x4 o; unsigned ou[4];
#pragma unroll
          for (int e = 0; e < 4; ++e) { const float z0 = bf_lo(au[e]) * sigmoidf_(bf_lo(gu[e])), z1 = bf_hi(au[e]) * sigmoidf_(bf_hi(gu[e])); ou[e] = live ? cvt_pk_bf16(z0, z1) : 0u; }
          o.x = ou[0]; o.y = ou[1]; o.z = ou[2]; o.w = ou[3];
          if (row < NR) *(LAS u32x4*)(zbuf + row * 512 + ch) = o; } }
    float wk[CONV_K];
#pragma unroll
    for (int k = 0; k < CONV_K; ++k) wk[k] = F.in[IN_CONVW][((size_t)l * CONV_K + k) * 512 + c];
    const float cb = F.in[IN_CONVB][l * 512 + c];
    __syncthreads();
#define CONV_Z(r) __builtin_bit_cast(float, (unsigned)zbuf[(r) * 512 + c] << 16)
    float win[30];
#pragma unroll
    for (int r = 0; r < 30; ++r) win[r] = CONV_Z(r);
#pragma unroll
    for (int q = 0; q < TP; ++q) { const float zv = CONV_Z(30 + q); float acc = cb + wk[30] * zv;
#pragma unroll
        for (int k = 0; k < 30; ++k) acc += wk[k] * win[(k + q) % 30];
        win[q % 30] = zv; cbuf[q * 512 + c] = acc; }
#undef CONV_Z
    __syncthreads();
    const float* lg = F.in[IN_LNG] + l * 512 + 8 * F.lane; const float* lb = F.in[IN_LNB] + l * 512 + 8 * F.lane; const float* og = F.in[IN_OUTN] + (size_t)l * DM + 512 + 8 * F.lane;
    const f32x4 lg0 = *(const f32x4*)lg, lg1 = *(const f32x4*)(lg + 4), lb0 = *(const f32x4*)lb, lb1 = *(const f32x4*)(lb + 4), og0 = *(const f32x4*)og, og1 = *(const f32x4*)(og + 4);
    for (int r = F.wave; r < TP; r += NWAVES) {
        const f32x4 a0 = *(const LAS f32x4*)(cbuf + r * 512 + 8 * F.lane), a1 = *(const LAS f32x4*)(cbuf + r * 512 + 8 * F.lane + 4);
        float x[8] = {a0[0], a0[1], a0[2], a0[3], a1[0], a1[1], a1[2], a1[3]};
        float s = 0.f;
#pragma unroll
        for (int e = 0; e < 8; ++e) s += x[e];
        const float mu = wave_sum(s) * (1.f / 512.f); float q2 = 0.f;
#pragma unroll
        for (int e = 0; e < 8; ++e) { x[e] -= mu; q2 += x[e] * x[e]; }
        const float rstd = __builtin_amdgcn_rsqf(wave_sum(q2) * (1.f / 512.f) + EPS);
        const float gam[8] = {lg0[0], lg0[1], lg0[2], lg0[3], lg1[0], lg1[1], lg1[2], lg1[3]}, bet[8] = {lb0[0], lb0[1], lb0[2], lb0[3], lb1[0], lb1[1], lb1[2], lb1[3]};
        float s2 = 0.f;
#pragma unroll
        for (int e = 0; e < 8; ++e) { const float y = x[e] * rstd * gam[e] + bet[e]; x[e] = y * sigmoidf_(y); s2 += x[e] * x[e]; }
        const float rs = __builtin_amdgcn_rsqf(wave_sum(s2) * (1.f / 512.f) + EPS);
        if (OP8(l)) { u32x2 o8; o8.x = pk4_fp8(x[0] * rs * og0[0], x[1] * rs * og0[1], x[2] * rs * og0[2], x[3] * rs * og0[3]); o8.y = pk4_fp8(x[4] * rs * og1[0], x[5] * rs * og1[1], x[6] * rs * og1[2], x[7] * rs * og1[3]);
            *(u32x2*)((unsigned char*)MIX + (size_t)(p0 + r) * DM + 512 + 8 * F.lane) = o8; }
        else {
        u32x4 o; o.x = cvt_pk_bf16(x[0] * rs * og0[0], x[1] * rs * og0[1]); o.y = cvt_pk_bf16(x[2] * rs * og0[2], x[3] * rs * og0[3]);
        o.z = cvt_pk_bf16(x[4] * rs * og1[0], x[5] * rs * og1[1]); o.w = cvt_pk_bf16(x[6] * rs * og1[2], x[7] * rs * og1[3]);
        *(u32x4*)(MIX + (size_t)(p0 + r) * DM + 512 + 8 * F.lane) = o; }
    }
    __syncthreads();
}

__device__ __forceinline__ int kimg_off(int row, int c) { return row * 256 + ((c ^ (row & 15)) << 4); }
__device__ __forceinline__ bf16x8 tr_frag2(const LAS unsigned char* vs, int ta, int tb, int dt, int lane) {
    const int gq = lane >> 4, q = (lane & 15) >> 2, p = lane & 3, c = 2 * dt + (p >> 1), rr = 4 * gq + q;
    const int off = rr * 256 + ((((c >> 1) ^ (rr & 7)) << 1) | (c & 1)) * 16 + 8 * (p & 1);
    const s16x4 a = __builtin_amdgcn_ds_read_tr16_b64_v4i16((LAS s16x4*)(vs + ta + off));
    const s16x4 b = __builtin_amdgcn_ds_read_tr16_b64_v4i16((LAS s16x4*)(vs + tb + off));
    bf16x8 r; r[0] = a[0]; r[1] = a[1]; r[2] = a[2]; r[3] = a[3]; r[4] = b[0]; r[5] = b[1]; r[6] = b[2]; r[7] = b[3]; return r;
}
#define ATT_DECODE(st) const int run_ = (int)blockIdx.x + F.G * ((st) / 5), b_ = (st) % 5 - 1; const int g = run_ >> 8, h = (run_ >> 5) & 7, rr_ = run_ & 31; \
    const int sh = 2 * g, dil = 1 << sh, rps = 32 >> sh; const int r = rr_ / rps, nb = 4 * (rr_ % rps) + b_
#define ATT_LOAD(st) do { if (ATT_EXP == 2) break; ATT_DECODE(st); const int cc = tid & 15; \
    _Pragma("unroll") for (int j = 0; j < 4; ++j) { const int row = (tid >> 4) + 32 * j; int ms = nb * 128 + row; ms = ms < 0 ? 0 : ms; const size_t pos = (size_t)ms * dil + r; \
        kr[j] = *(const u32x4*)(PROJ + pos * DIN + OFF_K + h * HD + 8 * cc); vr[j] = *(const u32x4*)(PROJ + pos * DIN + OFF_VV + h * HD + 8 * cc); } \
    if (b_ >= 0) { const size_t qpos_ = (size_t)(nb * 128 + 16 * w + (lane & 15)) * dil + r; \
        _Pragma("unroll") for (int ks = 0; ks < 4; ++ks) qr[ks] = *(const u32x4*)(PROJ + qpos_ * DIN + OFF_Q + h * HD + 32 * ks + 8 * (lane >> 4)); } } while (0)
__device__ __forceinline__ void att_phase(Frame& F, int l) {
    const bf16* PROJ = (const bf16*)(F.ws + WS_PROJ);
    bf16* ATT = (bf16*)(F.ws + WS_ATT); float* LSE = (float*)(F.ws + WS_LSE);
    const int lane = F.lane, w = F.wave, tid = F.tid, fr = lane & 15, gq = lane >> 4;
    LAS unsigned char* Ks = F.lds; LAS unsigned char* Vs = F.lds + 65536;
    const int nsteps = 5 * ((768 - (int)blockIdx.x + F.G - 1) / F.G);
    u32x4 kr[4], vr[4], qr[4];
    if (ATT_EXP == 2) { for (int j = 0; j < 4; ++j) { kr[j] = (u32x4){0x3f803f80u + (unsigned)tid, 0x3f003f80u, 0x3f803f00u, 0x3e803f80u}; vr[j] = kr[j]; qr[j] = kr[j]; } }
    if (nsteps > 0) ATT_LOAD(0);
    const int cc = tid & 15;
    const float* kgp = F.in[IN_KN] + l * HD + 8 * cc;
    const f32x4 kg0 = *(const f32x4*)kgp, kg1 = *(const f32x4*)(kgp + 4);
    for (int st = 0; st < nsteps; ++st) {
        ATT_DECODE(st);
        const int slot = (b_ + 1) & 1, curoff = slot * 32768, prevoff = 32768 - curoff;
#pragma unroll
        for (int j = 0; j < 4; ++j) { const int row = (tid >> 4) + 32 * j;
            const u32x4 k4 = kr[j];
            float x[8] = {bf_lo(k4.x), bf_hi(k4.x), bf_lo(k4.y), bf_hi(k4.y), bf_lo(k4.z), bf_hi(k4.z), bf_lo(k4.w), bf_hi(k4.w)};
            float sq = 0.f;
#pragma unroll
            for (int e = 0; e < 8; ++e) sq += x[e] * x[e];
            const float rs = __builtin_amdgcn_rsqf(row16_sum(sq) * (1.f / HD) + EPS);
            u32x4 o; o.x = cvt_pk_bf16(x[0] * rs * kg0[0], x[1] * rs * kg0[1]); o.y = cvt_pk_bf16(x[2] * rs * kg0[2], x[3] * rs * kg0[3]);
            o.z = cvt_pk_bf16(x[4] * rs * kg1[0], x[5] * rs * kg1[1]); o.w = cvt_pk_bf16(x[6] * rs * kg1[2], x[7] * rs * kg1[3]);
            *(LAS u32x4*)(Ks + curoff + kimg_off(row, cc)) = o;
            *(LAS u32x4*)(Vs + curoff + vimg_off(row, cc)) = vr[j]; }
        const int iq = 16 * w + fr; const size_t qpos = (size_t)(nb * 128 + iq) * dil + r;
        bf16x8 qf[4];
        if (b_ >= 0) { float x[4][8]; float sq = 0.f;
#pragma unroll
          for (int ks = 0; ks < 4; ++ks) { const u32x4 q4 = qr[ks];
              x[ks][0] = bf_lo(q4.x); x[ks][1] = bf_hi(q4.x); x[ks][2] = bf_lo(q4.y); x[ks][3] = bf_hi(q4.y); x[ks][4] = bf_lo(q4.z); x[ks][5] = bf_hi(q4.z); x[ks][6] = bf_lo(q4.w); x[ks][7] = bf_hi(q4.w);
#pragma unroll
              for (int e = 0; e < 8; ++e) sq += x[ks][e] * x[ks][e]; }
          sq = sum4(sq);
          const float rs = __builtin_amdgcn_rsqf(sq * (1.f / HD) + EPS) * 0.12751743f;
#pragma unroll
          for (int ks = 0; ks < 4; ++ks) { const float* qg = F.in[IN_QN] + l * HD + 32 * ks + 8 * gq; const f32x4 q0 = *(const f32x4*)qg, q1 = *(const f32x4*)(qg + 4);
              u32x4 o; o.x = cvt_pk_bf16(x[ks][0] * rs * q0[0], x[ks][1] * rs * q0[1]); o.y = cvt_pk_bf16(x[ks][2] * rs * q0[2], x[ks][3] * rs * q0[3]);
              o.z = cvt_pk_bf16(x[ks][4] * rs * q1[0], x[ks][5] * rs * q1[1]); o.w = cvt_pk_bf16(x[ks][6] * rs * q1[2], x[ks][7] * rs * q1[3]);
              qf[ks] = __builtin_bit_cast(bf16x8, o); } }
        __syncthreads();
        if (st + 1 < nsteps) ATT_LOAD(st + 1);
        if (b_ >= 0 && ATT_EXP != 1) {
        f32x4 sc[10];
#pragma unroll
        for (int kt = 0; kt < 9; ++kt) { sc[kt] = (f32x4){0.f, 0.f, 0.f, 0.f}; const int T = w + kt; const int kbase = (T < 8 ? prevoff : curoff); const int krow = 16 * (T & 7) + fr;
#pragma unroll
            for (int ks = 0; ks < 4; ++ks) { const bf16x8 kf = *(const LAS bf16x8*)(Ks + kbase + kimg_off(krow, 4 * ks + gq));
                sc[kt] = __builtin_amdgcn_mfma_f32_16x16x32_bf16(kf, qf[ks], sc[kt], 0, 0, 0); } }
#pragma unroll
        for (int e = 0; e < 4; ++e) { sc[0][e] = (4 * gq + e >= fr) ? sc[0][e] : -INFINITY; sc[8][e] = (4 * gq + e <= fr) ? sc[8][e] : -INFINITY; }
        if (nb == 0) {
#pragma unroll
            for (int kt = 0; kt < 8; ++kt) if (w + kt < 8) sc[kt] = (f32x4){-INFINITY, -INFINITY, -INFINITY, -INFINITY}; }
        float mx = -INFINITY;
#pragma unroll
        for (int kt = 0; kt < 9; ++kt) mx = fmaxf(fmaxf(mx, fmaxf(sc[kt][0], sc[kt][1])), fmaxf(sc[kt][2], sc[kt][3]));
        mx = max4(mx);
        float sum = 0.f;
#pragma unroll
        for (int kt = 0; kt < 9; ++kt)
#pragma unroll
            for (int e = 0; e < 4; ++e) { const float p = __builtin_amdgcn_exp2f(sc[kt][e] - mx); sc[kt][e] = p; sum += p; }
        sc[9] = (f32x4){0.f, 0.f, 0.f, 0.f};
        sum = sum4(sum);
        bf16x8 pf[5];
#pragma unroll
        for (int pp = 0; pp < 5; ++pp) { u32x4 o; o.x = cvt_pk_bf16(sc[2 * pp][0], sc[2 * pp][1]); o.y = cvt_pk_bf16(sc[2 * pp][2], sc[2 * pp][3]); o.z = cvt_pk_bf16(sc[2 * pp + 1][0], sc[2 * pp + 1][1]); o.w = cvt_pk_bf16(sc[2 * pp + 1][2], sc[2 * pp + 1][3]);
            pf[pp] = __builtin_bit_cast(bf16x8, o); }
        const float inv = __builtin_amdgcn_rcpf(sum);
        bf16* orow = ATT + ((size_t)g * SEQ + qpos) * 1024 + h * HD + 4 * gq;
        int toff[10];
#pragma unroll
        for (int kt = 0; kt < 10; ++kt) { const int T = (w + kt) < 15 ? (w + kt) : 15; toff[kt] = (T < 8 ? prevoff : curoff) + (T & 7) * 16 * 256; }
#pragma unroll
        for (int dt = 0; dt < 8; ++dt) { f32x4 o = (f32x4){0.f, 0.f, 0.f, 0.f};
#pragma unroll
            for (int pp = 0; pp < 5; ++pp) { const bf16x8 vf = tr_frag2(Vs, toff[2 * pp], toff[2 * pp + 1], dt, lane);
                o = __builtin_amdgcn_mfma_f32_16x16x32_bf16(vf, pf[pp], o, 0, 0, 0); }
            u32x2 ow; ow.x = cvt_pk_bf16(o[0] * inv, o[1] * inv); ow.y = cvt_pk_bf16(o[2] * inv, o[3] * inv);
            *(u32x2*)(orow + 16 * dt) = ow; }
        if (gq == 0) LSE[((size_t)g * SEQ + qpos) * NHEAD + h] = (mx + __builtin_amdgcn_logf(sum)) * 0.6931471805599453f;
        }
        if (b_ >= 0 && ATT_EXP == 1) { bf16* orow = ATT + ((size_t)g * SEQ + qpos) * 1024 + h * HD + 4 * gq;
#pragma unroll
            for (int dt = 0; dt < 8; ++dt) { u32x2 ow; ow.x = __builtin_bit_cast(unsigned, qf[dt & 3][0] | (qf[dt & 3][1] << 16)) & 0x3f803f80u; ow.y = 0u; *(u32x2*)(orow + 16 * dt) = ow; }
            if (gq == 0) LSE[((size_t)g * SEQ + qpos) * NHEAD + h] = 0.f; }
        __syncthreads();
    }
}
#undef ATT_DECODE
#undef ATT_LOAD

__device__ __forceinline__ void att_combine(Frame& F, int l) {
    const bf16* ATT = (const bf16*)(F.ws + WS_ATT); const float* LSE = (const float*)(F.ws + WS_LSE); bf16* MIX = (bf16*)(F.ws + WS_MIX);
    const int gw = F.vcu * NWAVES + F.wave, NGW = F.G * NWAVES, lane = F.lane;
    const float* og = F.in[IN_OUTN] + (size_t)l * DM + 1024 + 16 * lane;
    f32x4 gg[4];
#pragma unroll
    for (int q = 0; q < 4; ++q) gg[q] = *(const f32x4*)(og + 4 * q);
    for (int m = gw; m < SEQ; m += NGW) {
        const int hh = lane >> 3;
        const float l0 = LSE[((size_t)0 * SEQ + m) * NHEAD + hh], l1 = LSE[((size_t)1 * SEQ + m) * NHEAD + hh], l2 = LSE[((size_t)2 * SEQ + m) * NHEAD + hh];
        const float M = fmaxf(l0, fmaxf(l1, l2)); float w0 = fast_exp(l0 - M), w1 = fast_exp(l1 - M), w2 = fast_exp(l2 - M);
        const float iw = __builtin_amdgcn_rcpf(w0 + w1 + w2); w0 *= iw; w1 *= iw; w2 *= iw;
        float y[16]; float s = 0.f;
#pragma unroll
        for (int q = 0; q < 2; ++q) {
            const u32x4 a = __builtin_nontemporal_load((const u32x4*)(ATT + ((size_t)0 * SEQ + m) * 1024 + 16 * lane + 8 * q)), b = __builtin_nontemporal_load((const u32x4*)(ATT + ((size_t)1 * SEQ + m) * 1024 + 16 * lane + 8 * q)), c = __builtin_nontemporal_load((const u32x4*)(ATT + ((size_t)2 * SEQ + m) * 1024 + 16 * lane + 8 * q));
            const unsigned au[4] = {a.x, a.y, a.z, a.w}, bu[4] = {b.x, b.y, b.z, b.w}, cu[4] = {c.x, c.y, c.z, c.w};
#pragma unroll
            for (int e = 0; e < 4; ++e) { y[8 * q + 2 * e] = w0 * bf_lo(au[e]) + w1 * bf_lo(bu[e]) + w2 * bf_lo(cu[e]); y[8 * q + 2 * e + 1] = w0 * bf_hi(au[e]) + w1 * bf_hi(bu[e]) + w2 * bf_hi(cu[e]); } }
#pragma unroll
        for (int e = 0; e < 16; ++e) s += y[e] * y[e];
        const float rs = __builtin_amdgcn_rsqf(wave_sum(s) * (1.f / 1024.f) + EPS);
        if (OP8(l)) { u32x4 o8;
            o8.x = pk4_fp8(y[0] * rs * gg[0][0], y[1] * rs * gg[0][1], y[2] * rs * gg[0][2], y[3] * rs * gg[0][3]); o8.y = pk4_fp8(y[4] * rs * gg[1][0], y[5] * rs * gg[1][1], y[6] * rs * gg[1][2], y[7] * rs * gg[1][3]);
            o8.z = pk4_fp8(y[8] * rs * gg[2][0], y[9] * rs * gg[2][1], y[10] * rs * gg[2][2], y[11] * rs * gg[2][3]); o8.w = pk4_fp8(y[12] * rs * gg[3][0], y[13] * rs * gg[3][1], y[14] * rs * gg[3][2], y[15] * rs * gg[3][3]);
            *(u32x4*)((unsigned char*)MIX + (size_t)m * DM + 1024 + 16 * lane) = o8; }
        else
#pragma unroll
        for (int q = 0; q < 2; ++q) { u32x4 o;
            o.x = cvt_pk_bf16(y[8 * q + 0] * rs * gg[2 * q][0], y[8 * q + 1] * rs * gg[2 * q][1]); o.y = cvt_pk_bf16(y[8 * q + 2] * rs * gg[2 * q][2], y[8 * q + 3] * rs * gg[2 * q][3]);
            o.z = cvt_pk_bf16(y[8 * q + 4] * rs * gg[2 * q + 1][0], y[8 * q + 5] * rs * gg[2 * q + 1][1]); o.w = cvt_pk_bf16(y[8 * q + 6] * rs * gg[2 * q + 1][2], y[8 * q + 7] * rs * gg[2 * q + 1][3]);
            *(u32x4*)(MIX + (size_t)m * DM + 1024 + 16 * lane + 8 * q) = o; }
    }
}

#define ROUTER_LOAD(S, ks) do { \
    _Pragma("unroll") for (int rt = 0; rt < 4; ++rt) xa##S[rt] = *(const u32x4*)(xrow + (size_t)rt * 16 * DM + 32 * (ks)); \
    _Pragma("unroll") for (int ct = 0; ct < 3; ++ct) { bh##S[ct] = *(const bf16x8*)(wf + (size_t)(ks) * 3072 + (ct * 2) * 512); bl##S[ct] = *(const bf16x8*)(wf + (size_t)(ks) * 3072 + (ct * 2 + 1) * 512); } } while (0)
#define ROUTER_STEP(S, ks) do { \
    _Pragma("unroll") for (int rt = 0; rt < 4; ++rt) { const u32x4 xq = xa##S[rt]; \
        const float x0 = bf_lo(xq.x), x1 = bf_hi(xq.x), x2 = bf_lo(xq.y), x3 = bf_hi(xq.y), x4 = bf_lo(xq.z), x5 = bf_hi(xq.z), x6 = bf_lo(xq.w), x7 = bf_hi(xq.w); \
        ssq[rt] += (x0 * x0 + x1 * x1) + (x2 * x2 + x3 * x3) + (x4 * x4 + x5 * x5) + (x6 * x6 + x7 * x7); \
        { u32x2 x8; x8.x = pk4_fp8(x0, x1, x2, x3); x8.y = pk4_fp8(x4, x5, x6, x7); *(u32x2*)(x8row + (size_t)rt * 16 * DM + 32 * (ks)) = x8; } \
        const bf16x8 xh = __builtin_bit_cast(bf16x8, xq); \
        _Pragma("unroll") for (int ct = 0; ct < 3; ++ct) { \
            acc[rt][ct] = __builtin_amdgcn_mfma_f32_16x16x32_bf16(xh, bh##S[ct], acc[rt][ct], 0, 0, 0); \
            acc[rt][ct] = __builtin_amdgcn_mfma_f32_16x16x32_bf16(xh, bl##S[ct], acc[rt][ct], 0, 0, 0); } } } while (0)
__device__ __forceinline__ void router_phase(Frame& F, int l, int alt = 0) {
    const bf16* H1 = (const bf16*)(F.ws + WS_HN);
    const bf16* WRF = (const bf16*)(F.ws + WS_WRT) + (size_t)l * 64 * 3 * 2 * 64 * 8;
    unsigned* cnt = (unsigned*)(F.ws + WS_CTL) + CW_CNT + 2048 * l + 32768 * alt;
    int* tok = (int*)(F.ws + (alt ? WS_ALT : WS_TOK)); f32x4* tinfo = (f32x4*)(F.ws + (alt ? WS_ALT + 4 * MiB : WS_TINFO)); float* rslot = (float*)(F.ws + (alt ? WS_ALT + 2 * MiB : WS_RSLOT));
    const int lane = F.lane, tid = F.tid, w = F.wave, fr = lane & 15, g = lane >> 4;
    constexpr int PS = 49;
    LAS float* P = (LAS float*)F.lds;
    LAS float* SS = (LAS float*)(F.lds + 8 * 64 * PS * 4);
    for (int task = (int)blockIdx.x; task < SEQ / 64; task += F.G) {
        const bf16* xrow = H1 + (size_t)(task * 64 + fr) * DM + 256 * w + 8 * g;
        unsigned char* x8row = F.ws + WS_X8 + (size_t)(task * 64 + fr) * DM + 256 * w + 8 * g;
        const bf16* wf = WRF + ((size_t)(8 * w) * 3 * 2 * 64 + lane) * 8;
        f32x4 acc[4][3]; float ssq[4] = {0.f, 0.f, 0.f, 0.f};
#pragma unroll
        for (int rt = 0; rt < 4; ++rt)
#pragma unroll
            for (int ct = 0; ct < 3; ++ct) acc[rt][ct] = (f32x4){0.f, 0.f, 0.f, 0.f};
        u32x4 xaA[4], xaB[4]; bf16x8 bhA[3], blA[3], bhB[3], blB[3];
        ROUTER_LOAD(A, 0);
#pragma unroll 1
        for (int it = 0; it < 4; ++it) {
            ROUTER_LOAD(B, 1); __builtin_amdgcn_sched_barrier(0);
            ROUTER_STEP(A, 0); __builtin_amdgcn_sched_barrier(0);
            if (it < 3) ROUTER_LOAD(A, 2);
            __builtin_amdgcn_sched_barrier(0);
            ROUTER_STEP(B, 1); __builtin_amdgcn_sched_barrier(0);
            xrow += 64; x8row += 64; wf += 2 * 3072;
        }
#pragma unroll
        for (int rt = 0; rt < 4; ++rt) { float sq = ssq[rt]; sq += __shfl_xor(sq, 16); sq += __shfl_xor(sq, 32);
            if (g == 0) SS[w * 64 + 16 * rt + fr] = sq;
#pragma unroll
            for (int ct = 0; ct < 3; ++ct)
#pragma unroll
                for (int e = 0; e < 4; ++e) P[(w * 64 + 16 * rt + 4 * g + e) * PS + 16 * ct + fr] = acc[rt][ct][e]; }
        __syncthreads();
        if (tid < 64) {
            const int t = task * 64 + tid;
            float ss = 0.f;
#pragma unroll
            for (int q = 0; q < 8; ++q) ss += SS[q * 64 + tid];
            const float rs = __builtin_amdgcn_rsqf(ss * (1.f / DM) + EPS);
            const LAS float* pr = P + tid * PS;
            float lg[4];
#pragma unroll
            for (int o = 0; o < 4; ++o) { float a = 0.f;
#pragma unroll
                for (int q = 0; q < 8; ++q) a += pr[q * 64 * PS + 32 + o];
                lg[o] = a * rs + F.in[IN_BRG][l * 4 + o]; }
            int gi = 0; float gm = lg[0];
#pragma unroll
            for (int o = 1; o < 4; ++o) if (lg[o] > gm) { gm = lg[o]; gi = o; }
            float den = 0.f;
#pragma unroll
            for (int o = 0; o < 4; ++o) den += __expf(lg[o] - gm);
            const float gate_g = 1.f / den;
            float t1v = -INFINITY, t2v = -INFINITY; int t1i = 0, t2i = 0;
#pragma unroll
            for (int ii = 0; ii < 8; ++ii) { const int o = gi * 8 + ii; float a = 0.f;
#pragma unroll
                for (int q = 0; q < 8; ++q) a += pr[q * 64 * PS + o];
                const float v = a * rs + F.in[IN_BRE][l * NE + o];
                if (v > t1v) { t2v = t1v; t2i = t1i; t1v = v; t1i = ii; }
                else if (v > t2v) { t2v = v; t2i = ii; } }
            const float pp1 = 1.f / (1.f + __expf(t2v - t1v)), pp2 = 1.f - pp1;
            const int e0 = gi * 8 + t1i, e1 = gi * 8 + t2i;
            LAS unsigned* lcnt = (LAS unsigned*)(F.lds + 8 * 64 * PS * 4 + 8 * 64 * 4);
            if (tid < 32) lcnt[tid] = 0u;
            const unsigned r0 = __hip_atomic_fetch_add(lcnt + e0, 1u, __ATOMIC_RELAXED, __HIP_MEMORY_SCOPE_WORKGROUP), r1 = __hip_atomic_fetch_add(lcnt + e1, 1u, __ATOMIC_RELAXED, __HIP_MEMORY_SCOPE_WORKGROUP);
            if (tid < 32) { const unsigned c = lcnt[tid]; lcnt[32 + tid] = c ? atomicAdd(&cnt[tid * CNT_STRIDE], c) : 0u; }
            const unsigned s0 = lcnt[32 + e0] + r0, s1 = lcnt[32 + e1] + r1;
            tok[(size_t)e0 * TOKCAP + s0] = t; tok[(size_t)e1 * TOKCAP + s1] = t;
            rslot[(size_t)e0 * TOKCAP + s0] = rs; rslot[(size_t)e1 * TOKCAP + s1] = rs;
            f32x4 ti; ti[0] = __builtin_bit_cast(float, (int)(e0 * TOKCAP + s0)); ti[1] = __builtin_bit_cast(float, (int)(e1 * TOKCAP + s1)); ti[2] = gate_g * pp1; ti[3] = gate_g * pp2;
            tinfo[t] = ti;
        }
        __syncthreads();
    }
}
__device__ __forceinline__ void moe_table(Frame& F, int l) {
    const unsigned* cnt = (const unsigned*)(F.ws + WS_CTL) + CW_CNT + 2048 * l;
    LAS int* tstart = (LAS int*)(F.lds + MISC_OFF + 64);
    __syncthreads();
    if (F.tid == 0) { int acc = 0; for (int e = 0; e < NE; ++e) { tstart[e] = acc; acc += ((int)cnt[e * CNT_STRIDE] + 255) >> 8; } tstart[NE] = acc; }
    __syncthreads();
    { LAS int* tile_e = (LAS int*)(F.lds + MISC_OFF + 2304);
      if (F.tid < 160) { int e = 0; for (int j = 1; j < NE; ++j) e = (tstart[j] <= F.tid) ? j : e; tile_e[F.tid] = e; } }
    __syncthreads();
}
__device__ __forceinline__ void combine_phase(Frame& F, int l) {
    const LAS int* tstart = (const LAS int*)(F.lds + MISC_OFF + 64);
    const unsigned char* Y = F.ws + WS_Y; const f32x4* tinfo = (const f32x4*)(F.ws + WS_TINFO);
    bf16* H = (bf16*)(F.ws + WS_H); bf16* HN = (bf16*)(F.ws + WS_HN);
    const int gw = F.vcu * NWAVES + F.wave, NGW = F.G * NWAVES, lane = F.lane;
    const float* g1n = F.in[IN_NORM1] + (size_t)DM;
    for (int m = gw; m < SEQ; m += NGW) {
        const f32x4 ti = tinfo[m];
        const float tf0 = ti[0], tf1 = ti[1]; const int s0 = __builtin_bit_cast(int, tf0), s1 = __builtin_bit_cast(int, tf1);
        const int e0 = s0 >> 14, e1 = s1 >> 14;
        const size_t r0 = (size_t)tstart[e0] * 256 + (s0 & (TOKCAP - 1)), r1 = (size_t)tstart[e1] * 256 + (s1 & (TOKCAP - 1));
        const float ga = ti[2] * (1.f / Y_SCALE), gb = ti[3] * (1.f / Y_SCALE);
        f32x4 v[8]; float s = 0.f;
#pragma unroll
        for (int j = 0; j < 8; ++j) { const u32x2 hx = __builtin_nontemporal_load((const u32x2*)(HN + (size_t)m * DM + 4 * lane + 256 * j));
            const int ya = __builtin_nontemporal_load((const int*)(Y + r0 * DM + 4 * lane + 256 * j)), yb = __builtin_nontemporal_load((const int*)(Y + r1 * DM + 4 * lane + 256 * j));
            const f32x2 a01 = __builtin_amdgcn_cvt_pk_f32_fp8(ya, false), a23 = __builtin_amdgcn_cvt_pk_f32_fp8(ya, true), b01 = __builtin_amdgcn_cvt_pk_f32_fp8(yb, false), b23 = __builtin_amdgcn_cvt_pk_f32_fp8(yb, true);
            v[j][0] = bf_lo(hx.x) + ga * a01[0] + gb * b01[0]; v[j][1] = bf_hi(hx.x) + ga * a01[1] + gb * b01[1];
            v[j][2] = bf_lo(hx.y) + ga * a23[0] + gb * b23[0]; v[j][3] = bf_hi(hx.y) + ga * a23[1] + gb * b23[1];
            s += (v[j][0] * v[j][0] + v[j][1] * v[j][1]) + (v[j][2] * v[j][2] + v[j][3] * v[j][3]); }
        if (l == 0) {
            const float rs = __builtin_amdgcn_rsqf(wave_sum(s) * (1.f / DM) + EPS);
            bf16* hrow = H + (size_t)m * DM; bf16* orow = HN + (size_t)m * DM;
#pragma unroll
            for (int j = 0; j < 8; ++j) { const f32x4 gg = *(const f32x4*)(g1n + 4 * lane + 256 * j);
                u32x2 hb; hb.x = cvt_pk_bf16(v[j][0], v[j][1]); hb.y = cvt_pk_bf16(v[j][2], v[j][3]); *(u32x2*)(hrow + 4 * lane + 256 * j) = hb;
                if (IP8(1)) *(unsigned*)(F.ws + WS_X8 + (size_t)m * DM + 4 * lane + 256 * j) = pk4_fp8(v[j][0] * rs * gg[0], v[j][1] * rs * gg[1], v[j][2] * rs * gg[2], v[j][3] * rs * gg[3]);
                else { u32x2 o; o.x = cvt_pk_bf16(v[j][0] * rs * gg[0], v[j][1] * rs * gg[1]); o.y = cvt_pk_bf16(v[j][2] * rs * gg[2], v[j][3] * rs * gg[3]);
                *(u32x2*)(orow + 4 * lane + 256 * j) = o; } }
        } else {
            float* orow = F.out + (size_t)m * DM;
#pragma unroll
            for (int j = 0; j < 8; ++j) __builtin_nontemporal_store(v[j], (f32x4*)(orow + 4 * lane + 256 * j));
        }
    }
}

__device__ __forceinline__ void relaunder(Frame& F) { F.lane = lane_now(); F.tid = F.wave * 64 + F.lane; }
constexpr int N_PHASES = 17;
#ifndef PHASE_MASK
#define PHASE_MASK 0x1ff
#endif
#ifndef MIX_MASK
#define MIX_MASK 7
#endif
#ifndef DUP_PHASE
#define DUP_PHASE 0
#endif
#define DUP(k) for (int _d = 0; _d < ((DUP_PHASE == (k)) ? 2 : 1); ++_d)
#define IN(k) (lo <= (k) && (k) < hi)
#define EN(b) ((PHASE_MASK >> (b)) & 1)
#ifndef PROBE_STAMP
#define PROBE_STAMP (-1)
#endif
#define SEAM(k) do { if (IN(k) && IN((k) + 1)) { xcd_barrier(bar); if (PROBE_STAMP >= 0 && blockIdx.x == 0 && F.tid == 0) { const unsigned long long _t = wall_clock64(); F.MISC[802 + 2 * (k)] = (unsigned)_t; F.MISC[803 + 2 * (k)] = (unsigned)(_t >> 32); } } } while (0)
template <int l>
__device__ __forceinline__ void layer_phases(Frame& F, const XcdBarrier& bar, const int lo, const int hi) {
    constexpr int pb = 1 + 8 * l;
    relaunder(F);
    if (EN(1) && IN(pb)) {
        constexpr int KI = IP8(l) ? DM / 2 : DM;
#define INPROJ_PART(first) do { pg8::StaticSched S; S.init((const bf16*)(F.ws + (IP8(l) ? WS_X8 : WS_HN)), (const bf16*)(F.ws + WS_WIN) + (size_t)l * DIN * DM, SEQ, DIN, KI, F.G, (int)blockIdx.x); \
            const int slot = ((((((int)blockIdx.x >> 6) & 3) << 3) | ((int)blockIdx.x & 7)) * 6) >> 5; if (first) S.i1 = slot; else S.i0 = slot; \
            pg8::EpiProj E{(bf16*)(F.ws + WS_PROJ), IP8(l) ? 1.f / WIN_SCALE : 1.f}; \
            DUP(1) pg8::gemm_phase<pg8::EpiProj, pg8::StaticSched, true, IP8(l) != 0>(F.lds, KI, S, E, F.wave); } while (0)
        INPROJ_PART(true);
        __syncthreads(); relaunder(F); convert_tiles(F, l == 0 ? CV_P : CV_A, l == 0 ? CV_A : CV_B); __syncthreads(); relaunder(F);
        INPROJ_PART(false);
#undef INPROJ_PART
    }
    SEAM(pb);
    relaunder(F);
    if (EN(2) && IN(pb + 1)) {
        constexpr int N_SGU = 256, N_CONV = 512, N_ATT = 3072;
#define MSTAMP(i) do { if (PROBE_STAMP >= 100 && l == 0 && blockIdx.x == 0 && F.tid == 0) { const unsigned long long _t = wall_clock64(); F.MISC[900 + 2 * (i)] = (unsigned)_t; F.MISC[901 + 2 * (i)] = (unsigned)(_t >> 32); } } while (0)
        MSTAMP(0);
        if (MIX_MASK & 1) DUP(2) att_phase(F, l);
        MSTAMP(1);
        if (MIX_MASK & 2) DUP(3) for (int it = (int)blockIdx.x; it < N_CONV; it += F.G) conv_item(F, l, it);
        MSTAMP(2);
        if (MIX_MASK & 4) DUP(4) for (int it = (int)blockIdx.x; it < N_SGU; it += F.G) sgu_item(F, l, it >> 1, it & 1);
        MSTAMP(3);
#undef MSTAMP
    }
    SEAM(pb + 1);
    if (DUP_PHASE == 12 && IN(pb + 1)) {
        pg8::StaticSched S; S.init((const bf16*)(F.ws + WS_MIX), (const bf16*)(F.ws + WS_WIN) + (size_t)l * DIN * DM, SEQ, DIN, DM, F.G, (int)blockIdx.x);
        pg8::EpiProj E{(bf16*)(F.ws + WS_PROJ), 1.f};
        pg8::gemm_phase<pg8::EpiProj, pg8::StaticSched>(F.lds, DM, S, E, F.wave);
        xcd_barrier(bar);
    }
    relaunder(F);
    if (EN(3) && IN(pb + 2)) DUP(5) att_combine(F, l);
    SEAM(pb + 2);
    relaunder(F);
    if (EN(4) && IN(pb + 3)) {
        constexpr int KO = OP8(l) ? DM / 2 : DM;
        pg8::StaticSched S; S.init((const bf16*)(F.ws + WS_MIX), (const bf16*)(F.ws + WS_WOUT) + (size_t)l * DM * DM, SEQ, DM, KO, F.G, (int)blockIdx.x);
        if constexpr (l == 0) { pg8::EpiResid<false> E{(const void*)F.in[IN_X], (bf16*)(F.ws + WS_HN)}; DUP(6) pg8::gemm_phase<pg8::EpiResid<false>, pg8::StaticSched, true, OP8(l) != 0>(F.lds, KO, S, E, F.wave); }
        else { pg8::EpiResid<true> E{(const void*)(F.ws + WS_H), (bf16*)(F.ws + WS_HN)}; DUP(6) pg8::gemm_phase<pg8::EpiResid<true>, pg8::StaticSched, true, OP8(l) != 0>(F.lds, KO, S, E, F.wave); }
    }
    SEAM(pb + 3);
    relaunder(F);
    if (EN(5) && IN(pb + 4)) { router_phase(F, l); if (DUP_PHASE == 11) router_phase(F, l, 1); }
    if (DUP_PHASE == 13 && IN(pb + 4)) { for (int q = 0; q < 8; ++q) xcd_barrier(bar); }
    SEAM(pb + 4);
    relaunder(F);
    if (EN(6) && IN(pb + 5)) {
        moe_table(F, l);
        unsigned* ready = (unsigned*)(F.ws + WS_CTL) + CW_RDY + 16384 * l;
        {
            pg8::SchedG1 S{(const LAS int*)(F.lds + MISC_OFF + 64), (const int*)((const unsigned*)(F.ws + WS_CTL) + CW_CNT + 2048 * l), (const int*)(F.ws + WS_TOK), (const bf16*)(F.ws + WS_X8),
                           (const bf16*)(F.ws + WS_W1 + (size_t)l * NE * 1024 * DM), F.G, (int)blockIdx.x, ready};
            pg8::EpiSwiGLU E{F.ws + WS_HB, (const float*)(F.ws + WS_RSLOT)};
            DUP(7) pg8::gemm_phase<pg8::EpiSwiGLU, pg8::SchedG1, true, true>(F.lds, DM / 2, S, E, F.wave);
        }
        {
            pg8::SchedG2 S{(const LAS int*)(F.lds + MISC_OFF + 64), (const bf16*)(F.ws + WS_HB), (const bf16*)(F.ws + WS_W2 + (size_t)l * NE * DM * DE), F.G, (int)blockIdx.x, ready, (unsigned*)(F.ws + WS_CTL) + CW_TMO, F.wave};
            pg8::EpiY E{F.ws + WS_Y};
            DUP(8) pg8::gemm_phase<pg8::EpiY, pg8::SchedG2, true, true>(F.lds, DE / 2, S, E, F.wave);
        }
    }
    SEAM(pb + 6);
    relaunder(F);
    if (EN(8) && IN(pb + 7)) { moe_table(F, l); DUP(l == 0 ? 9 : 99) combine_phase(F, l); }
    SEAM(pb + 7);
}
__global__ void __launch_bounds__(NTHREADS, 2) fwd_kernel(Params args) {
    extern __shared__ __attribute__((aligned(16))) unsigned char lds_raw[];
    Frame F;
    F.lds = (LAS unsigned char*)lds_raw; F.MISC = (volatile LAS unsigned*)(F.lds + MISC_OFF);
    F.tid = threadIdx.x; F.lane = F.tid & 63; F.wave = __builtin_amdgcn_readfirstlane(F.tid >> 6);
    F.G = gridDim.x; { const int bx = blockIdx.x; F.vcu = (F.G % 8 == 0) ? (bx % 8) * (F.G / 8) + bx / 8 : bx; }
    F.in = args.in; F.out = args.out; F.ws = args.ws;
    for (int u = F.tid; u < (LDS_BYTES - MISC_OFF) / 4; u += NTHREADS) ((LAS unsigned*)(F.lds + MISC_OFF))[u] = 0u;
    __syncthreads();
    unsigned* ctl = (unsigned*)(args.ws + WS_CTL);
    const int lo = args.ph_lo, hi = args.ph_hi;
    const bool multi = (hi - lo) > 1;
    XcdBarrier bar; bar.bar = ctl + CW_BAR; bar.x = 0; bar.st = nullptr; bar.lead = 0;
    if (multi) bar = xcd_barrier_post(ctl + CW_BAR, F.MISC, F.wave == 0 ? 1u : 0u);
    if (PROBE_STAMP >= 0 && blockIdx.x == 0 && F.tid == 0) { const unsigned long long _t = wall_clock64(); F.MISC[800] = (unsigned)_t; F.MISC[801] = (unsigned)(_t >> 32); }
    if (EN(0) && IN(0)) { DUP(10) p_prologue(F); }
    SEAM(0);
    layer_phases<0>(F, bar, lo, hi);
    layer_phases<1>(F, bar, lo, hi);
    if (PROBE_STAMP >= 0 && blockIdx.x == 0 && F.tid == 0) {
        asm volatile("s_waitcnt vmcnt(0)" ::: "memory");
        constexpr int SB = PROBE_STAMP >= 100 ? 900 + 2 * (PROBE_STAMP - 100) : (PROBE_STAMP == 6 ? 812 : 800 + 2 * PROBE_STAMP);
        constexpr int SB1 = (PROBE_STAMP == 6) ? SB + 4 : SB + 2;
        const unsigned long long t1 = ((unsigned long long)F.MISC[SB1 + 1] << 32) | F.MISC[SB1], t0 = ((unsigned long long)F.MISC[SB + 1] << 32) | F.MISC[SB];
        F.out[0] += (float)(long long)(t1 - t0) * 0.01f;
    }
}
#undef IN
#undef EN
#undef SEAM
#undef DUP

extern "C" void kernel_launch(void* const* d_in, const int* in_sizes, int n_in, void* d_out, int out_size, void* d_ws, size_t ws_size, hipStream_t stream) {
    static int grid = 0;
    if (grid == 0) {
        if (n_in != 22 || out_size != SEQ * DM || ws_size < WS_END) { fprintf(stderr, "kernel_launch: unexpected shapes (n_in %d out %d ws %zu, need %zu)\n", n_in, out_size, ws_size, (size_t)WS_END); grid = -1; return; }
        int dev = 0, cus = 0, per_cu = 0;
        if (hipGetDevice(&dev) != hipSuccess || hipDeviceGetAttribute(&cus, hipDeviceAttributeMultiprocessorCount, dev) != hipSuccess) { grid = -1; return; }
        if (hipFuncSetAttribute((const void*)fwd_kernel, hipFuncAttributeMaxDynamicSharedMemorySize, LDS_BYTES) != hipSuccess) { fprintf(stderr, "kernel_launch: hipFuncSetAttribute failed\n"); grid = -1; return; }
        if (hipOccupancyMaxActiveBlocksPerMultiprocessor(&per_cu, (const void*)fwd_kernel, NTHREADS, LDS_BYTES) != hipSuccess || per_cu < 1) { fprintf(stderr, "kernel_launch: occupancy query says %d\n", per_cu); }
        (void)hipGetLastError();
        grid = cus;
    }
    if (grid < 0) return;
    if (hipMemsetAsync((char*)d_ws + WS_CTL, 0, CTL_ZERO_BYTES, stream) != hipSuccess) return;
    Params p{};
    for (int i = 0; i < 22; ++i) p.in[i] = (const float*)d_in[i];
    p.out = (float*)d_out; p.ws = (unsigned char*)d_ws;
    constexpr int NL = MK_N_LAUNCHES;
    for (int li = 0; li < NL; ++li) {
        p.ph_lo = (NL == 1) ? 0 : li; p.ph_hi = (NL == 1) ? N_PHASES : li + 1;
        hipLaunchKernelGGL(fwd_kernel, dim3(grid), dim3(NTHREADS), LDS_BYTES, stream, p);
        if (hipPeekAtLastError() != hipSuccess) { fprintf(stderr, "kernel_launch: launch %d failed\n", li); break; }
    }
}
```

```cpp
#include <hip/hip_runtime.h>
#include <cstdio>
#include <cstdint>

#ifndef MK_N_LAUNCHES
#define MK_N_LAUNCHES 1
#endif

#ifndef OUTPROJ_FP8
#define OUTPROJ_FP8 2
#endif
#ifndef ATT_EXP
#define ATT_EXP 0
#endif
#define OP8(l) ((OUTPROJ_FP8 >> (l)) & 1)
#ifndef INPROJ_FP8
#define INPROJ_FP8 2
#endif
#define IP8(l) ((INPROJ_FP8 >> (l)) & 1)
#define GAS __attribute__((address_space(1)))
#define LAS __attribute__((address_space(3)))
typedef unsigned short bf16;
typedef short bf16x8 __attribute__((ext_vector_type(8)));
typedef short s16x4 __attribute__((ext_vector_type(4)));
typedef float f32x4 __attribute__((ext_vector_type(4)));
typedef float f32x2 __attribute__((ext_vector_type(2)));
typedef unsigned u32x4 __attribute__((ext_vector_type(4)));
typedef unsigned u32x2 __attribute__((ext_vector_type(2)));

constexpr int SEQ = 16384, DM = 2048, DIN = 5120, NLAYER = 2;
constexpr int HD = 128, NHEAD = 8, CONV_K = 31;
constexpr int NE = 32, DE = 512, TOKCAP = 16384;
constexpr int OFF_U = 0, OFF_V = 512, OFF_A = 1024, OFF_G = 1536, OFF_Q = 2048, OFF_K = 3072, OFF_VV = 4096;
constexpr float EPS = 1e-6f;
constexpr float W1_SCALE = 64.f, W2_SCALE = 32.f, WOUT_SCALE = 64.f, WIN_SCALE = 64.f, Y_SCALE = 16.f;
constexpr int NWAVES = 8, NTHREADS = 512;

constexpr size_t MiB = 1u << 20;
constexpr size_t WS_CTL = 0, CTL_ZERO_BYTES = 1 * MiB;
constexpr size_t WS_WIN = 1 * MiB;
constexpr size_t WS_WOUT = 41 * MiB;
constexpr size_t WS_W1 = 57 * MiB;
constexpr size_t WS_X8 = 185 * MiB;
constexpr size_t WS_W2 = 313 * MiB;
constexpr size_t WS_SGUW = 441 * MiB;
constexpr size_t WS_WRT = 442 * MiB;
constexpr size_t WS_TOK = 443 * MiB;
constexpr size_t WS_TINFO = 445 * MiB;
constexpr size_t WS_HN = 446 * MiB;
constexpr size_t WS_HB = 510 * MiB;
constexpr size_t WS_ATT = WS_HN;
constexpr size_t WS_LSE = WS_HN + 96 * MiB;
constexpr size_t WS_PROJ = 550 * MiB;
constexpr size_t WS_Y = WS_PROJ;
constexpr size_t WS_MIX = 710 * MiB;
constexpr size_t WS_H = 774 * MiB;
constexpr size_t WS_RSLOT = 902 * MiB;
constexpr size_t WS_ALT = 904 * MiB;
constexpr size_t WS_END = 910 * MiB;
constexpr int CW_BAR = 4096;
constexpr int CW_TMO = 0;
constexpr int CW_RDY = 65536;
constexpr int CW_CNT = 16384, CNT_STRIDE = 64;

constexpr int LDS_BYTES = 163840;
constexpr int MISC_OFF = 159744;

__device__ __forceinline__ unsigned cvt_pk_bf16(float lo, float hi) { unsigned r; asm volatile("v_cvt_pk_bf16_f32 %0, %1, %2" : "=v"(r) : "v"(lo), "v"(hi)); return r; }
__device__ __forceinline__ unsigned pk4_fp8(float a, float b, float c, float d) { int p = 0; p = __builtin_amdgcn_cvt_pk_fp8_f32(a, b, p, false); p = __builtin_amdgcn_cvt_pk_fp8_f32(c, d, p, true); return (unsigned)p; }
__device__ __forceinline__ float bf_lo(unsigned u) { return __builtin_bit_cast(float, u << 16); }
__device__ __forceinline__ float bf_hi(unsigned u) { return __builtin_bit_cast(float, u & 0xffff0000u); }
template <int CTRL, int RM> __device__ __forceinline__ float dpp_mov0(float v) { return __builtin_bit_cast(float, __builtin_amdgcn_update_dpp(0, __builtin_bit_cast(int, v), CTRL, RM, 0xf, false)); }
__device__ __forceinline__ float wave_sum(float s) {
    s += dpp_mov0<0xB1, 0xf>(s); s += dpp_mov0<0x4E, 0xf>(s); s += dpp_mov0<0x141, 0xf>(s); s += dpp_mov0<0x140, 0xf>(s);
    s += dpp_mov0<0x142, 0xa>(s); s += dpp_mov0<0x143, 0xc>(s);
    return __builtin_bit_cast(float, __builtin_amdgcn_readlane(__builtin_bit_cast(int, s), 63));
}
__device__ __forceinline__ float row16_sum(float s) {
    s += dpp_mov0<0xB1, 0xf>(s); s += dpp_mov0<0x4E, 0xf>(s); s += dpp_mov0<0x141, 0xf>(s); s += dpp_mov0<0x140, 0xf>(s); return s;
}
__device__ __forceinline__ float sum4(float x) {
    const unsigned xu = __builtin_bit_cast(unsigned, x); const auto r = __builtin_amdgcn_permlane16_swap(xu, xu, false, false); const unsigned r0 = r[0], r1 = r[1];
    const float a = __builtin_bit_cast(float, r0) + __builtin_bit_cast(float, r1);
    const unsigned au = __builtin_bit_cast(unsigned, a); const auto q = __builtin_amdgcn_permlane32_swap(au, au, false, false); const unsigned q0 = q[0], q1 = q[1];
    return __builtin_bit_cast(float, q0) + __builtin_bit_cast(float, q1);
}
__device__ __forceinline__ float max4(float x) {
    const unsigned xu = __builtin_bit_cast(unsigned, x); const auto r = __builtin_amdgcn_permlane16_swap(xu, xu, false, false); const unsigned r0 = r[0], r1 = r[1];
    const float a = fmaxf(__builtin_bit_cast(float, r0), __builtin_bit_cast(float, r1));
    const unsigned au = __builtin_bit_cast(unsigned, a); const auto q = __builtin_amdgcn_permlane32_swap(au, au, false, false); const unsigned q0 = q[0], q1 = q[1];
    return fmaxf(__builtin_bit_cast(float, q0), __builtin_bit_cast(float, q1));
}
__device__ __forceinline__ int lane_now() { int l; asm volatile("v_mbcnt_lo_u32_b32 %0, -1, 0\n\tv_mbcnt_hi_u32_b32 %0, -1, %0" : "=v"(l)); return l; }
#define LDS_WAIT() asm volatile("s_waitcnt lgkmcnt(0)" ::: "memory")
#define VM_WAIT() asm volatile("s_waitcnt vmcnt(0)" ::: "memory")
__device__ __forceinline__ float fast_exp(float x) { return __builtin_amdgcn_exp2f(x * 1.4426950408889634f); }
__device__ __forceinline__ float sigmoidf_(float x) { return __builtin_amdgcn_rcpf(1.0f + fast_exp(-x)); }
__device__ __forceinline__ float gelu_tanh(float x) { const float z = 1.5957691216057308f * (x + 0.044715f * x * x * x); return x * sigmoidf_(z); }

#define XB_TMO      128
#define XB_XCNT(j)  (256  + 64 * (j))
#define XB_XSUB(j)  (1280 + 64 * (j))
#define XB_XGEN(j)  (2304 + 64 * (j))
#define XB_TOP      3328
#define XB_TOPGEN   3392
#define XCD_BAR_WORDS 3456
#define XB_SPIN_CAP (1u << 22)
__device__ __forceinline__ unsigned xb_ld(unsigned* p)              { return __hip_atomic_load(p, __ATOMIC_RELAXED, __HIP_MEMORY_SCOPE_AGENT); }
__device__ __forceinline__ unsigned xb_add(unsigned* p, unsigned v) { return __hip_atomic_fetch_add(p, v, __ATOMIC_RELAXED, __HIP_MEMORY_SCOPE_AGENT); }
__device__ __forceinline__ unsigned xb_xcc_id() { return (unsigned)__builtin_amdgcn_s_getreg((3 << 11) | 20) & 0xFu; }
#define XB_SPIN(cond, bar) do { unsigned _sp = 0; while (cond) { __builtin_amdgcn_s_sleep(1); \
    if ((++_sp & 255u) == 0u) { if (xb_ld(&(bar)[XB_TMO])) break; if (_sp > XB_SPIN_CAP) { atomicAdd(&(bar)[XB_TMO], 1u); break; } } } } while (0)
struct XcdBarrier { unsigned* bar; unsigned x; volatile LAS unsigned* st; unsigned lead; };
__device__ __forceinline__ XcdBarrier xcd_barrier_post(unsigned* bar, volatile LAS unsigned* st, unsigned lead) {
    XcdBarrier b; b.bar = bar; b.x = xb_xcc_id(); b.st = st; b.lead = lead;
    if (lead && lane_now() == 0) (void)xb_add(&bar[XB_XCNT(b.x)], 1u);
    return b;
}
__device__ __forceinline__ void xcd_barrier_complete(unsigned* bar, unsigned x, unsigned& nloc, unsigned& nx) {
    const unsigned G = gridDim.x * gridDim.y * gridDim.z;
    unsigned sum, cnt, mine, sp = 0u;
    for (;;) {
        sum = 0u; cnt = 0u; mine = 0u;
#pragma unroll
        for (unsigned j = 0; j < 16; ++j) { const unsigned c = xb_ld(&bar[XB_XCNT(j)]); sum += c; cnt += (c > 0u) ? 1u : 0u; mine = (j == x) ? c : mine; }
        if (sum == G) break;
        __builtin_amdgcn_s_sleep(1);
        if ((++sp & 255u) == 0u) { if (xb_ld(&bar[XB_TMO])) break; if (sp > XB_SPIN_CAP) { atomicAdd(&bar[XB_TMO], 1u); break; } }
    }
    nloc = mine > 0u ? mine : 1u; nx = cnt > 0u ? cnt : 1u;
}
__device__ __forceinline__ void xcd_barrier(const XcdBarrier& b) {
    asm volatile("s_waitcnt vmcnt(0)" ::: "memory");
    __syncthreads();
    if (b.lead && lane_now() == 0) {
        unsigned* bar = b.bar;
        __builtin_amdgcn_s_waitcnt(0);
        unsigned nloc = b.st[0], nx = b.st[1];
        if (nloc == 0u) { xcd_barrier_complete(bar, b.x, nloc, nx); b.st[0] = nloc; b.st[1] = nx; }
        const unsigned old = xb_add(&bar[XB_XSUB(b.x)], 1u);
        const unsigned gen = old / nloc;
        if (old + 1u == (gen + 1u) * nloc) {
            __builtin_amdgcn_fence(__ATOMIC_RELEASE, "agent");
            asm volatile("s_waitcnt vmcnt(0)" ::: "memory");
            const unsigned og = xb_add(&bar[XB_TOP], 1u);
            const unsigned tg = og / nx;
            if (og + 1u == (tg + 1u) * nx) xb_add(&bar[XB_TOPGEN], 1u);
            else XB_SPIN(xb_ld(&bar[XB_TOPGEN]) == tg, bar);
            __builtin_amdgcn_fence(__ATOMIC_ACQUIRE, "agent");
            xb_add(&bar[XB_XGEN(b.x)], 1u);
            asm volatile("s_waitcnt vmcnt(0)" ::: "memory");
        } else {
            XB_SPIN(xb_ld(&bar[XB_XGEN(b.x)]) == gen, bar);
            __builtin_amdgcn_fence(__ATOMIC_ACQUIRE, "agent");
            asm volatile("s_waitcnt vmcnt(0)" ::: "memory");
        }
    }
    __syncthreads();
}

namespace pg8 {
constexpr int BM = 256, BK = 64, HALF = 128, HTB = HALF * BK * 2, STAGE_BYTES = 8 * HTB, NXCD = 8, WGM = 8;
__device__ __forceinline__ int lds_byte(int r, int c) { const int st = (r >> 4) * 2 + (c >> 5), rr = r & 15, cc = c & 31, ob = rr * 64 + cc * 2; return st * 1024 + (ob ^ (((ob >> 9) & 1) << 5)); }
__device__ __forceinline__ void stage_rc(int b, int& R, int& C) { const int st = b / 1024, sb = b % 1024, swz = sb ^ (((sb >> 9) & 1) << 5); R = (st >> 1) * 16 + swz / 64; C = (st & 1) * 32 + (swz % 64) / 2; }
__device__ __forceinline__ int perm32(int rho) { const int n = rho >> 4, i = rho & 15; return 8 * (i >> 2) + 4 * n + (i & 3); }

struct Unit { int pm, pn, e, rb; };

struct StaticSched {
    static constexpr bool GATHER = false;
    const bf16* A; const bf16* Bt; int K; int nM, nN, nwg, G, c; int i0 = 0, i1 = 0x7fffffff;
    __device__ __forceinline__ void init(const bf16* A_, const bf16* Bt_, int M, int N, int K_, int G_, int c_) { A = A_; Bt = Bt_; K = K_; nM = M / BM; nN = N / BM; nwg = nM * nN; G = G_; c = c_; }
    __device__ __forceinline__ bool next(int i, Unit& u) const {
        if (i + i0 >= i1) return false;
        const long L = (long)(i + i0) * G + c; if (L >= nwg) return false;
        int wgid = (int)L; { const int q = nwg / NXCD, r = nwg % NXCD, xcd = wgid % NXCD, off = wgid / NXCD; wgid = (xcd < r ? xcd * (q + 1) : r * (q + 1) + (xcd - r) * q) + off; }
        const int nig = WGM * nN, gid = wgid / nig, fm = gid * WGM, gsz = (nM - fm) < WGM ? (nM - fm) : WGM;
        u.pm = fm + ((wgid % nig) % gsz); u.pn = (wgid % nig) / gsz; u.e = 0; u.rb = 0; return true;
    }
    __device__ __forceinline__ void a_ready(const Unit&) const {}
    __device__ __forceinline__ void done(const Unit&) const {}
    __device__ __forceinline__ const char* a_base(const Unit& u) const { return (const char*)A + (size_t)u.pm * BM * K * 2; }
    __device__ __forceinline__ const char* b_base(const Unit& u) const { return (const char*)Bt + (size_t)u.pn * BM * K * 2; }
    __device__ __forceinline__ void a_voff(const Unit&, const int (&R)[2], const int (&C)[2], unsigned (&v)[2][2]) const {
#pragma unroll
        for (int h = 0; h < 2; ++h)
#pragma unroll
            for (int i = 0; i < 2; ++i) v[h][i] = (unsigned)((h * HALF + R[i]) * K + C[i]) * 2u;
    }
};

typedef int v8i __attribute__((ext_vector_type(8)));
typedef int v4i __attribute__((ext_vector_type(4)));
template <class Epi, class Sched, bool ALIGN_EPI = true, bool FP8 = false>
__device__ __forceinline__ void gemm_phase(LAS unsigned char* lds, const int K, const Sched& S, const Epi& E, const int wave) {
    const int lane = lane_now(), wid = wave, tid = wid * 64 + lane,
              wr = wid >> 2, wc = wid & 3, fr = lane & 15, fq = lane >> 4;
    const int nt = K / BK;
    int Rr[2], Cc[2]; unsigned voffB[2];
#pragma unroll
    for (int i = 0; i < 2; ++i) { stage_rc(tid * 16 + i * 8192, Rr[i], Cc[i]); const int Rb = Epi::PERM ? ((Rr[i] & ~31) + perm32(Rr[i] & 31)) : Rr[i];
        voffB[i] = (unsigned)(Rb * K + Cc[i]) * 2u; }
    const size_t kstep = (size_t)(BK * 2);
    const size_t hstep = (size_t)HALF * K * 2;
    const unsigned ldsw = (unsigned)wid * 1024u;
    const unsigned ldsbase = (unsigned)__builtin_amdgcn_readfirstlane((int)(unsigned)(size_t)lds);
    const int aoff = lds_byte(wr * 64 + fr, fq * 8), boff = lds_byte(wc * 32 + fr, fq * 8);
#define PG8_SA(b, h) (((b) * 2 + (h)) * HTB)
#define PG8_SB(b, h) ((4 + (b) * 2 + (h)) * HTB)
#define PG8_STAGE(bufoff, gbase, voff) do { _Pragma("unroll") for (int _i = 0; _i < 2; ++_i) { unsigned _keep; \
        asm volatile("s_mov_b32 %0, m0\n\ts_mov_b32 m0, %3\n\ts_nop 0\n\tglobal_load_lds_dwordx4 %1, %2\n\ts_mov_b32 m0, %0" : "=&s"(_keep) : "v"((voff)[_i]), "s"((const char*)(gbase)), "s"(ldsbase + (unsigned)(bufoff) + ldsw + (unsigned)(_i * 8192)) : "memory"); } } while (0)
#define PG8_LDA(dst, b, h) do { _Pragma("unroll") for (int m = 0; m < 4; ++m) _Pragma("unroll") for (int k = 0; k < 2; ++k) dst[m][k] = *(const LAS bf16x8*)(lds + PG8_SA(b, h) + aoff + m * 2048 + k * 1024); } while (0)
#define PG8_LDB(dst, b, h) do { _Pragma("unroll") for (int n = 0; n < 2; ++n) _Pragma("unroll") for (int k = 0; k < 2; ++k) dst[n][k] = *(const LAS bf16x8*)(lds + PG8_SB(b, h) + boff + n * 2048 + k * 1024); } while (0)
#define PG8_LDA8(dst, b, h) do { _Pragma("unroll") for (int m = 0; m < 4; ++m) { const v4i lo_ = *(const LAS v4i*)(lds + PG8_SA(b, h) + aoff + m * 2048), hi_ = *(const LAS v4i*)(lds + PG8_SA(b, h) + aoff + m * 2048 + 1024); dst[m] = __builtin_shufflevector(lo_, hi_, 0, 1, 2, 3, 4, 5, 6, 7); } } while (0)
#define PG8_LDB8(dst, b, h) do { _Pragma("unroll") for (int n = 0; n < 2; ++n) { const v4i lo_ = *(const LAS v4i*)(lds + PG8_SB(b, h) + boff + n * 2048), hi_ = *(const LAS v4i*)(lds + PG8_SB(b, h) + boff + n * 2048 + 1024); dst[n] = __builtin_shufflevector(lo_, hi_, 0, 1, 2, 3, 4, 5, 6, 7); } } while (0)
#define PG8_MMA(ai, bj, At, Bt) do { __builtin_amdgcn_s_setprio(1); _Pragma("unroll") for (int m = 0; m < 4; ++m) _Pragma("unroll") for (int n = 0; n < 2; ++n) _Pragma("unroll") for (int k = 0; k < 2; ++k) \
        acc[ai][bj][m][n] = __builtin_amdgcn_mfma_f32_16x16x32_bf16(Bt[n][k], At[m][k], acc[ai][bj][m][n], 0, 0, 0); __builtin_amdgcn_s_setprio(0); } while (0)
#define PG8_MMA8(ai, bj, At, Bt) do { __builtin_amdgcn_s_setprio(1); _Pragma("unroll") for (int m = 0; m < 4; ++m) _Pragma("unroll") for (int n = 0; n < 2; ++n) \
        acc[ai][bj][m][n] = __builtin_amdgcn_mfma_scale_f32_16x16x128_f8f6f4(Bt[n], At[m], acc[ai][bj][m][n], 0, 0, 0, 0, 0, 0); __builtin_amdgcn_s_setprio(0); } while (0)
#define LDA_(b, h) do { if constexpr (FP8) PG8_LDA8(At8, b, h); else PG8_LDA(At, b, h); } while (0)
#define LDB0_(b, h) do { if constexpr (FP8) PG8_LDB8(B08, b, h); else PG8_LDB(B0, b, h); } while (0)
#define LDB1_(b, h) do { if constexpr (FP8) PG8_LDB8(B18, b, h); else PG8_LDB(B1, b, h); } while (0)
#define MMA0_(ai, bj) do { if constexpr (FP8) PG8_MMA8(ai, bj, At8, B08); else PG8_MMA(ai, bj, At, B0); } while (0)
#define MMA1_(ai, bj) do { if constexpr (FP8) PG8_MMA8(ai, bj, At8, B18); else PG8_MMA(ai, bj, At, B1); } while (0)
#define PG8_WAIT_V(n) asm volatile("s_waitcnt vmcnt(" #n ")" ::: "memory")
#define PG8_WAIT_L(n) asm volatile("s_waitcnt lgkmcnt(" #n ")" ::: "memory")
#define PG8_BAR __builtin_amdgcn_s_barrier()
#define PG8_SCHED __builtin_amdgcn_sched_barrier(0)
    Unit cur, nxt; int ui = 0;
    if (!S.next(0, cur)) return;
    f32x4 acc[2][2][4][2];
#pragma unroll
    for (int a = 0; a < 2; ++a)
#pragma unroll
        for (int b = 0; b < 2; ++b)
#pragma unroll
            for (int m = 0; m < 4; ++m)
#pragma unroll
                for (int n = 0; n < 2; ++n) acc[a][b][m][n] = (f32x4){0.f, 0.f, 0.f, 0.f};
    bf16x8 At[4][2], B0[2][2], B1[2][2]; v8i At8[4], B08[2], B18[2];
    const char* cA = S.a_base(cur); const char* cB = S.b_base(cur);
    S.a_ready(cur);
    constexpr bool GATHER = Sched::GATHER;
    unsigned vA[1][2];
    LAS unsigned* goff = (LAS unsigned*)(lds + STAGE_BYTES) + tid;
    int gslot = 0;
    constexpr bool LOFF = GATHER || FP8;
    if constexpr (!GATHER && FP8) { goff[8 * 512] = voffB[0]; goff[9 * 512] = voffB[1]; goff[10 * 512] = (unsigned)(Rr[0] * K + Cc[0]) * 2u; goff[11 * 512] = (unsigned)(Rr[1] * K + Cc[1]) * 2u; }
    if constexpr (GATHER) { unsigned t4[2][2]; S.a_voff(cur, Rr, Cc, t4); goff[0 * 512] = t4[0][0]; goff[1 * 512] = t4[0][1]; goff[2 * 512] = t4[1][0]; goff[3 * 512] = t4[1][1]; goff[8 * 512] = voffB[0]; goff[9 * 512] = voffB[1]; }
    else {
#pragma unroll
        for (int i = 0; i < 2; ++i) vA[0][i] = (unsigned)(Rr[i] * K + Cc[i]) * 2u; }
    const size_t ahstep = GATHER ? 0 : hstep;
#define PG8_STAGE_B(bufoff, kptr) do { if constexpr (LOFF) { unsigned _o[2]; _o[0] = goff[8 * 512]; _o[1] = goff[9 * 512]; PG8_STAGE(bufoff, kptr, _o); } else PG8_STAGE(bufoff, kptr, voffB); } while (0)
#define PG8_STAGE_A(bufoff, kptr, h, nx) do { if constexpr (GATHER) { unsigned _o[2]; const int _s = (gslot ^ (nx)) * 2048 + (h) * 1024; _o[0] = goff[_s]; _o[1] = goff[_s + 512]; PG8_STAGE(bufoff, kptr, _o); } \
        else if constexpr (FP8) { unsigned _o[2]; _o[0] = goff[10 * 512]; _o[1] = goff[11 * 512]; PG8_STAGE(bufoff, (kptr) + (h) * ahstep, _o); } \
        else PG8_STAGE(bufoff, (kptr) + (h) * ahstep, vA[0]); } while (0)
    PG8_STAGE(PG8_SB(0, 0), cB, voffB); PG8_STAGE(PG8_SB(0, 1), cB + hstep, voffB); PG8_STAGE_A(PG8_SA(0, 0), cA, 0, 0); PG8_STAGE_A(PG8_SA(0, 1), cA, 1, 0);
    if (wr == 1) PG8_BAR;
    PG8_WAIT_V(2); PG8_BAR;
    PG8_STAGE(PG8_SB(1, 0), cB + kstep, voffB); PG8_STAGE_A(PG8_SA(1, 0), cA + kstep, 0, 0); PG8_STAGE(PG8_SB(1, 1), cB + hstep + kstep, voffB);
    PG8_WAIT_V(6); PG8_BAR;
    for (;;) {
        const bool has_next = S.next(ui + 1, nxt);
        const char* nA = has_next ? S.a_base(nxt) : cA; const char* nB = has_next ? S.b_base(nxt) : cB;
        if constexpr (GATHER) { if (has_next) { unsigned t4[2][2]; int tl_ = tid; asm volatile("" : "+v"(tl_)); int R2[2], C2[2]; stage_rc(tl_ * 16, R2[0], C2[0]); stage_rc(tl_ * 16 + 8192, R2[1], C2[1]); S.a_voff(nxt, R2, C2, t4); const int o = (gslot ^ 1) * 2048; goff[o] = t4[0][0]; goff[o + 512] = t4[0][1]; goff[o + 1024] = t4[1][0]; goff[o + 1536] = t4[1][1]; } }
#pragma unroll 1
        for (int t = 0; t < nt; t += 2) {
            const bool last = (t == nt - 2);
            const char* a1 = cA + (size_t)(t + 1) * kstep;
            const char* a2 = last ? nA : cA + (size_t)(t + 2) * kstep; const char* b2 = last ? nB : cB + (size_t)(t + 2) * kstep;
            const char* a3 = a2 + kstep; const char* b3 = b2 + kstep;
            if (last && has_next) S.a_ready(nxt);
            const int nx = (last && has_next) ? 1 : 0;
            LDB0_(0, 0); LDB1_(0, 1); PG8_SCHED; LDA_(0, 0); PG8_STAGE_A(PG8_SA(1, 1), a1, 1, 0);
            PG8_WAIT_V(8); PG8_WAIT_L(0); PG8_BAR; MMA0_(0, 0); MMA1_(0, 1); PG8_BAR; PG8_SCHED;
            LDA_(0, 1); PG8_STAGE_B(PG8_SB(0, 0), b2); PG8_STAGE_B(PG8_SB(0, 1), b2 + hstep); PG8_STAGE_A(PG8_SA(0, 0), a2, 0, nx);
            PG8_WAIT_V(8); PG8_WAIT_L(0); PG8_BAR; MMA0_(1, 0); MMA1_(1, 1); PG8_BAR; PG8_SCHED;
            LDB0_(1, 0); LDB1_(1, 1); PG8_SCHED; LDA_(1, 0); PG8_STAGE_A(PG8_SA(0, 1), a2, 1, nx);
            PG8_WAIT_V(8); PG8_WAIT_L(0); PG8_BAR; MMA0_(0, 0); MMA1_(0, 1); PG8_BAR; PG8_SCHED;
            LDA_(1, 1); PG8_STAGE_B(PG8_SB(1, 0), b3); PG8_STAGE_B(PG8_SB(1, 1), b3 + hstep); PG8_STAGE_A(PG8_SA(1, 0), a3, 0, nx);
            PG8_WAIT_V(8); PG8_WAIT_L(0); PG8_BAR; MMA0_(1, 0); MMA1_(1, 1); PG8_BAR; PG8_SCHED;
        }
        if constexpr (ALIGN_EPI) { if (wr == 0) PG8_BAR; }
        { int fr2 = fr, fq2 = fq; asm volatile("" : "+v"(fr2), "+v"(fq2));
          E(acc, cur, wr, wc, fr2, fq2); } S.done(cur);
        if (!has_next) break;
#pragma unroll
        for (int a = 0; a < 2; ++a)
#pragma unroll
            for (int b = 0; b < 2; ++b)
#pragma unroll
                for (int m = 0; m < 4; ++m)
#pragma unroll
                    for (int n = 0; n < 2; ++n) acc[a][b][m][n] = (f32x4){0.f, 0.f, 0.f, 0.f};
        cur = nxt; cA = nA; cB = nB; ++ui;
        if constexpr (GATHER) gslot ^= 1;
        if constexpr (ALIGN_EPI) { if (wr == 1) PG8_BAR; }
    }
    PG8_WAIT_V(0);
    if constexpr (!ALIGN_EPI) { if (wr == 0) PG8_BAR; }
    PG8_BAR;
#undef PG8_SA
#undef PG8_SB
#undef PG8_STAGE
#undef PG8_STAGE_A
#undef PG8_STAGE_B
#undef PG8_LDA
#undef PG8_LDB
#undef PG8_MMA
#undef PG8_MMA8
#undef PG8_LDA8
#undef PG8_LDB8
#undef LDA_
#undef LDB0_
#undef LDB1_
#undef MMA0_
#undef MMA1_
#undef PG8_WAIT_V
#undef PG8_WAIT_L
#undef PG8_BAR
#undef PG8_SCHED
}

struct EpiProj {
    static constexpr bool PERM = true;
    bf16* O; float asc;
    __device__ __forceinline__ void operator()(const f32x4 (&acc)[2][2][4][2], const Unit& u, int wr, int wc, int fr, int fq) const {
        const int row0 = u.pm * BM + wr * 64 + fr, col0 = u.pn * BM + wc * 32 + 8 * fq;
        const bool act = u.pn < 4;
#pragma unroll
        for (int ai = 0; ai < 2; ++ai)
#pragma unroll
            for (int m = 0; m < 4; ++m) { bf16* rowp = O + (size_t)(row0 + ai * HALF + m * 16) * DIN + col0;
#pragma unroll
                for (int bj = 0; bj < 2; ++bj) { f32x4 v0 = acc[ai][bj][m][0] * asc, v1 = acc[ai][bj][m][1] * asc;
                    if (act) {
#pragma unroll
                        for (int j = 0; j < 4; ++j) { v0[j] = gelu_tanh(v0[j]); v1[j] = gelu_tanh(v1[j]); } }
                    u32x4 w; w.x = cvt_pk_bf16(v0[0], v0[1]); w.y = cvt_pk_bf16(v0[2], v0[3]); w.z = cvt_pk_bf16(v1[0], v1[1]); w.w = cvt_pk_bf16(v1[2], v1[3]);
                    *(u32x4*)(rowp + bj * HALF) = w; } }
    }
};
template <bool RES_BF16> struct EpiResid {
    static constexpr bool PERM = true; static constexpr float ASC = OP8(RES_BF16 ? 1 : 0) ? 1.f / WOUT_SCALE : 1.f;
    const void* res; bf16* out;
    __device__ __forceinline__ void operator()(const f32x4 (&acc)[2][2][4][2], const Unit& u, int wr, int wc, int fr, int fq) const {
        const int row0 = u.pm * BM + wr * 64 + fr, col0 = u.pn * BM + wc * 32 + 8 * fq;
#pragma unroll
        for (int ai = 0; ai < 2; ++ai) {
            if constexpr (RES_BF16) {
                u32x4 r[4][2];
#pragma unroll
                for (int m = 0; m < 4; ++m)
#pragma unroll
                    for (int bj = 0; bj < 2; ++bj) r[m][bj] = __builtin_nontemporal_load((const u32x4*)((const bf16*)res + (size_t)(row0 + ai * HALF + m * 16) * DM + col0 + bj * HALF));
                asm volatile("s_waitcnt vmcnt(0)" ::: "memory");
#pragma unroll
                for (int m = 0; m < 4; ++m)
#pragma unroll
                    for (int bj = 0; bj < 2; ++bj) { f32x4 v0 = acc[ai][bj][m][0] * ASC, v1 = acc[ai][bj][m][1] * ASC; const u32x4 q = r[m][bj];
                        v0[0] += bf_lo(q.x); v0[1] += bf_hi(q.x); v0[2] += bf_lo(q.y); v0[3] += bf_hi(q.y); v1[0] += bf_lo(q.z); v1[1] += bf_hi(q.z); v1[2] += bf_lo(q.w); v1[3] += bf_hi(q.w);
                        u32x4 w; w.x = cvt_pk_bf16(v0[0], v0[1]); w.y = cvt_pk_bf16(v0[2], v0[3]); w.z = cvt_pk_bf16(v1[0], v1[1]); w.w = cvt_pk_bf16(v1[2], v1[3]);
                        *(u32x4*)(out + (size_t)(row0 + ai * HALF + m * 16) * DM + col0 + bj * HALF) = w; }
            } else {
#pragma unroll
                for (int mh = 0; mh < 2; ++mh) {
                    f32x4 r[2][2][2];
#pragma unroll
                    for (int m = 0; m < 2; ++m)
#pragma unroll
                        for (int bj = 0; bj < 2; ++bj) { const float* rp = (const float*)res + (size_t)(row0 + ai * HALF + (2 * mh + m) * 16) * DM + col0 + bj * HALF; r[m][bj][0] = __builtin_nontemporal_load((const f32x4*)rp); r[m][bj][1] = __builtin_nontemporal_load((const f32x4*)(rp + 4)); }
                    asm volatile("s_waitcnt vmcnt(0)" ::: "memory");
#pragma unroll
                    for (int m = 0; m < 2; ++m)
#pragma unroll
                        for (int bj = 0; bj < 2; ++bj) { const f32x4 v0 = acc[ai][bj][2 * mh + m][0] * ASC + r[m][bj][0], v1 = acc[ai][bj][2 * mh + m][1] * ASC + r[m][bj][1];
                            u32x4 w; w.x = cvt_pk_bf16(v0[0], v0[1]); w.y = cvt_pk_bf16(v0[2], v0[3]); w.z = cvt_pk_bf16(v1[0], v1[1]); w.w = cvt_pk_bf16(v1[2], v1[3]);
                            *(u32x4*)(out + (size_t)(row0 + ai * HALF + (2 * mh + m) * 16) * DM + col0 + bj * HALF) = w; }
                }
            }
        }
    }
};
struct EpiSwiGLU {
    static constexpr bool PERM = true;
    unsigned char* HB; const float* rslot;
    __device__ __forceinline__ void operator()(const f32x4 (&acc)[2][2][4][2], const Unit& u, int wr, int wc, int fr, int fq) const {
        const int row0 = u.pm * BM + wr * 64 + fr, col0 = u.pn * HALF + wc * 32 + 8 * fq;
        const __amdgpu_buffer_rsrc_t rsrc = __builtin_amdgcn_make_buffer_rsrc((void*)HB, 0, 40960 * DE, 0x00020000);
        const float* rsl = rslot + (size_t)u.e * TOKCAP + u.rb * BM + wr * 64 + fr;
#pragma unroll
        for (int ai = 0; ai < 2; ++ai) {
            float rsv[4];
#pragma unroll
            for (int m = 0; m < 4; ++m) rsv[m] = rsl[ai * HALF + m * 16];
            asm volatile("s_waitcnt vmcnt(0)" ::: "memory");
#pragma unroll
            for (int m = 0; m < 4; ++m) { const unsigned boff = (unsigned)((row0 + ai * HALF + m * 16) * DE + col0);
                const float rs = rsv[m] * (1.f / W1_SCALE);
                float h[8];
#pragma unroll
                for (int n = 0; n < 2; ++n)
#pragma unroll
                    for (int j = 0; j < 4; ++j) { const float g = acc[ai][0][m][n][j] * rs, up = acc[ai][1][m][n][j] * rs; h[n * 4 + j] = g * sigmoidf_(g) * up; }
                u32x2 w; w.x = pk4_fp8(h[0], h[1], h[2], h[3]); w.y = pk4_fp8(h[4], h[5], h[6], h[7]);
                __builtin_amdgcn_raw_buffer_store_b64(w, rsrc, boff, 0, 16); } }
    }
};
struct EpiY {
    static constexpr bool PERM = true;
    unsigned char* Y;
    __device__ __forceinline__ void operator()(const f32x4 (&acc)[2][2][4][2], const Unit& u, int wr, int wc, int fr, int fq) const {
        const int row0 = u.pm * BM + wr * 64 + fr, col0 = u.pn * BM + wc * 32 + 8 * fq;
#pragma unroll
        for (int ai = 0; ai < 2; ++ai)
#pragma unroll
            for (int m = 0; m < 4; ++m) { unsigned char* rowp = Y + (size_t)(row0 + ai * HALF + m * 16) * DM + col0;
#pragma unroll
                for (int bj = 0; bj < 2; ++bj) { const f32x4 v0 = acc[ai][bj][m][0] * (Y_SCALE / W2_SCALE), v1 = acc[ai][bj][m][1] * (Y_SCALE / W2_SCALE);
                    u32x2 w; w.x = pk4_fp8(v0[0], v0[1], v0[2], v0[3]); w.y = pk4_fp8(v1[0], v1[1], v1[2], v1[3]);
                    *(u32x2*)(rowp + bj * HALF) = w; } }
    }
};

struct SchedG1 {
    static constexpr bool GATHER = true;
    const LAS int* tstart; const int* cnt; const int* tok; const bf16* X; const bf16* W1; int G, c; unsigned* ready;
    __device__ __forceinline__ void a_ready(const Unit&) const {}
    __device__ __forceinline__ void done(const Unit& u) const {
        asm volatile("s_waitcnt vmcnt(0)" ::: "memory");
        if (lane_now() == 0) __hip_atomic_fetch_add(ready + 64 * u.pm, 1u, __ATOMIC_RELAXED, __HIP_MEMORY_SCOPE_AGENT);
    }
    __device__ __forceinline__ bool next(int i, Unit& u) const {
        const int L = i * G + c, NT = __builtin_amdgcn_readfirstlane(tstart[NE]); if (L >= NT * 4) return false;
        const int T = L >> 2; const int e = tstart[560 + T];
        u.pm = __builtin_amdgcn_readfirstlane(T); u.pn = L & 3; u.e = __builtin_amdgcn_readfirstlane(e); u.rb = __builtin_amdgcn_readfirstlane(T - tstart[e]); return true;
    }
    static constexpr int KU = DM / 2;
    __device__ __forceinline__ const char* a_base(const Unit&) const { return (const char*)X; }
    __device__ __forceinline__ const char* b_base(const Unit& u) const { return (const char*)W1 + ((size_t)u.e * 1024 + (size_t)u.pn * BM) * DM; }
    __device__ __forceinline__ void a_voff(const Unit& u, const int (&R)[2], const int (&C)[2], unsigned (&v)[2][2]) const {
        const int n = cnt[u.e * 64]; const int* tl = tok + (size_t)u.e * TOKCAP;
#pragma unroll
        for (int h = 0; h < 2; ++h)
#pragma unroll
            for (int i = 0; i < 2; ++i) { int row = u.rb * BM + h * HALF + R[i]; row = row < n ? row : 0; const int t = tl[row]; v[h][i] = (unsigned)(t * KU + C[i]) * 2u; }
    }
};
struct SchedG2 {
    static constexpr bool GATHER = false;
    const LAS int* tstart; const bf16* HB; const bf16* W2; int G, c; unsigned* ready; unsigned* tmo; int wave;
    __device__ __forceinline__ bool next(int i, Unit& u) const {
        constexpr int K0 = 3;
        const int NT = __builtin_amdgcn_readfirstlane(tstart[NE]), n1 = 4 * NT, n1max = (n1 + G - 1) / G, R = n1 - G * (n1max - 1), nB = G - R;
        int L;
        if (c >= R) L = (i < K0) ? i * nB + (c - R) : K0 * nB + (i - K0) * G + c;
        else L = K0 * nB + i * G + c;
        if (L >= NT * 8) return false;
        const int T = L >> 3; const int e = tstart[560 + T];
        u.pm = __builtin_amdgcn_readfirstlane(T); u.pn = __builtin_amdgcn_readfirstlane(L & 7); u.e = __builtin_amdgcn_readfirstlane(e); u.rb = __builtin_amdgcn_readfirstlane(T - tstart[e]); return true;
    }
    __device__ __forceinline__ void done(const Unit&) const {}
    __device__ __forceinline__ void a_ready(const Unit& u) const {
        if (wave == 0) {
            unsigned polls = 0;
            while ((unsigned)__builtin_amdgcn_readfirstlane(__hip_atomic_load(ready + 64 * u.pm, __ATOMIC_RELAXED, __HIP_MEMORY_SCOPE_AGENT)) < 32u) {
                if (++polls > (1u << 22)) { if (lane_now() == 0) __hip_atomic_store(tmo, 0x600u | (unsigned)(u.pm & 0xff), __ATOMIC_RELAXED, __HIP_MEMORY_SCOPE_AGENT); break; }
                __builtin_amdgcn_s_sleep(2); }
            __builtin_amdgcn_fence(__ATOMIC_ACQUIRE, "agent");
            asm volatile("s_waitcnt vmcnt(0)" ::: "memory");
        }
        asm volatile("" ::: "memory"); __builtin_amdgcn_s_barrier(); asm volatile("" ::: "memory");
    }
    __device__ __forceinline__ const char* a_base(const Unit& u) const { return (const char*)HB + (size_t)u.pm * BM * DE; }
    __device__ __forceinline__ const char* b_base(const Unit& u) const { return (const char*)W2 + ((size_t)u.e * DM + (size_t)u.pn * BM) * DE; }
    __device__ __forceinline__ void a_voff(const Unit&, const int (&R)[2], const int (&C)[2], unsigned (&v)[2][2]) const {
#pragma unroll
        for (int h = 0; h < 2; ++h)
#pragma unroll
            for (int i = 0; i < 2; ++i) v[h][i] = (unsigned)((h * HALF + R[i]) * DE + C[i]) * 2u;
    }
};
}

struct Params { const float* in[22]; float* out; unsigned char* ws; int ph_lo, ph_hi; };
enum { IN_X = 0, IN_NORM1, IN_WIN, IN_SGUN, IN_SGUW, IN_SGUB, IN_CONVW, IN_CONVB, IN_LNG, IN_LNB, IN_QN, IN_KN, IN_OUTN, IN_WOUT, IN_NORM2, IN_WRG, IN_BRG, IN_WRE, IN_BRE, IN_WG, IN_WU, IN_WD };

struct Frame {
    LAS unsigned char* lds; volatile LAS unsigned* MISC;
    int tid, lane, wave, vcu, G;
    const float* const* in; float* out; unsigned char* ws;
};

__device__ __forceinline__ void tile_desc(const float* const* in, unsigned char* ws, int it, const float*& src, int& ldw, unsigned char*& dst, int& pitch, const float*& ksc, float& wsc, int& fp8) {
    constexpr int T_IN = 32 * 80, T_OUT = 32 * 32, T_E = 32 * 8, T_D = 8 * 32;
    constexpr int T_LAYER = T_IN + T_OUT + NE * (2 * T_E + T_D);
    const int l = it / T_LAYER; int r = it % T_LAYER; ksc = nullptr; wsc = 1.f; fp8 = 0;
    if (r < T_IN) { ldw = DIN;
        if (IP8(l)) { const int kb = r / 160, nb = r % 160; pitch = DM; fp8 = 1; wsc = WIN_SCALE; src = in[IN_WIN] + (size_t)l * DM * DIN + (size_t)(128 * kb) * DIN + 32 * nb; dst = ws + WS_WIN + (size_t)l * DIN * DM * 2 + ((size_t)32 * nb) * DM + 128 * kb; }
        else { const int kb = r / 80, nb = r % 80; pitch = DM * 2; src = in[IN_WIN] + (size_t)l * DM * DIN + (size_t)(64 * kb) * DIN + 64 * nb; dst = ws + WS_WIN + (((size_t)l * DIN + 64 * nb) * DM + 64 * kb) * 2; }
        return; } r -= T_IN;
    if (r < T_OUT) { const int kb = r / 32, nb = r % 32; ldw = DM; src = in[IN_WOUT] + (size_t)l * DM * DM + (size_t)(64 * kb) * DM + 64 * nb;
        if (OP8(l)) { const int kb8 = r / 64, nb8 = r % 64; pitch = DM; fp8 = 1; wsc = WOUT_SCALE; src = in[IN_WOUT] + (size_t)l * DM * DM + (size_t)(128 * kb8) * DM + 32 * nb8; dst = ws + WS_WOUT + (size_t)l * DM * DM * 2 + ((size_t)32 * nb8) * DM + 128 * kb8; } else { pitch = DM * 2; dst = ws + WS_WOUT + (((size_t)l * DM + 64 * nb) * DM + 64 * kb) * 2; }
        return; } r -= T_OUT;
    const int e = r / (2 * T_E + T_D); r %= (2 * T_E + T_D);
    const size_t le = (size_t)l * NE + e; fp8 = 1;
    if (r < 2 * T_E) { const int up = r >= T_E; r -= up * T_E; const int kb = r / 16, nb = r % 16, n0 = 32 * nb; ldw = DE; pitch = DM; wsc = W1_SCALE;
        src = (up ? in[IN_WU] : in[IN_WG]) + le * DM * DE + (size_t)(128 * kb) * DE + n0; dst = ws + WS_W1 + (le * 1024 + (size_t)((n0 / 128) * 256 + up * 128 + (n0 % 128))) * DM + 128 * kb; ksc = in[IN_NORM2] + (size_t)l * DM + 128 * kb; return; }
    r -= 2 * T_E;
    { const int kb = r / 64, nb = r % 64; ldw = DM; pitch = DE; wsc = W2_SCALE; src = in[IN_WD] + le * DE * DM + (size_t)(128 * kb) * DM + 32 * nb; dst = ws + WS_W2 + (le * DM + 32 * nb) * DE + 128 * kb; }
}
#define TR_LOAD(V, src, ldw, fp8) do { if (fp8) { _Pragma("unroll") for (int i = 0; i < 16; ++i) V[i] = __builtin_nontemporal_load((const f32x4*)((src) + (size_t)(16 * (lane >> 3) + i) * (ldw) + 4 * (lane & 7))); } \
    else { _Pragma("unroll") for (int i = 0; i < 16; ++i) V[i] = __builtin_nontemporal_load((const f32x4*)((src) + (size_t)(4 * i + (lane >> 4)) * (ldw) + 4 * (lane & 15))); } } while (0)
#define TR_PROC(V, dst, pitch, ksc, wsc, fp8) do { \
    if (fp8) {        \
        f32x4 s_[4]; if (ksc) { const LAS float* kp_ = nrm + ((ksc) - nrm_g) + 16 * (lane >> 3);     \
            _Pragma("unroll") for (int q = 0; q < 4; ++q) s_[q] = *(const LAS f32x4*)(kp_ + 4 * q) * (wsc); } else { _Pragma("unroll") for (int q = 0; q < 4; ++q) s_[q] = (f32x4){(wsc), (wsc), (wsc), (wsc)}; } \
        _Pragma("unroll") for (int c = 0; c < 4; ++c) { u32x4 o; \
            _Pragma("unroll") for (int q = 0; q < 4; ++q) o[q] = pk4_fp8(V[4 * q][c] * s_[q][0], V[4 * q + 1][c] * s_[q][1], V[4 * q + 2][c] * s_[q][2], V[4 * q + 3][c] * s_[q][3]); \
            __builtin_nontemporal_store(o, (u32x4*)((dst) + (size_t)(4 * (lane & 7) + c) * (pitch) + 16 * (lane >> 3))); }     \
    } else { \
        _Pragma("unroll") for (int i = 0; i < 16; ++i) { const int kk = 4 * i + (lane >> 4); f32x4 v = V[i] * ((ksc) ? (ksc)[kk] * (wsc) : (wsc)); \
            LAS float* d = scr + kk * 65 + 4 * (lane & 15); d[0] = v[0]; d[1] = v[1]; d[2] = v[2]; d[3] = v[3]; } \
        LDS_WAIT(); \
        _Pragma("unroll") for (int j = 0; j < 8; ++j) { const int n = (lane >> 3) + 8 * j; const LAS float* sp = scr + (8 * (lane & 7)) * 65 + n; \
            u32x4 o; o.x = cvt_pk_bf16(sp[0], sp[65]); o.y = cvt_pk_bf16(sp[2 * 65], sp[3 * 65]); o.z = cvt_pk_bf16(sp[4 * 65], sp[5 * 65]); o.w = cvt_pk_bf16(sp[6 * 65], sp[7 * 65]); \
            *(u32x4*)((dst) + (size_t)n * (pitch) + 16 * (lane & 7)) = o; } } \
    LDS_WAIT(); } while (0)
__device__ __forceinline__ void norm_row_bf16(const float* xrow, const float* g, bf16* orow, int lane) {
    f32x4 v[8]; float s = 0.f;
#pragma unroll
    for (int j = 0; j < 8; ++j) { v[j] = __builtin_nontemporal_load((const f32x4*)(xrow + 4 * lane + 256 * j)); s += (v[j][0] * v[j][0] + v[j][1] * v[j][1]) + (v[j][2] * v[j][2] + v[j][3] * v[j][3]); }
    const float rs = __builtin_amdgcn_rsqf(wave_sum(s) * (1.f / DM) + EPS);
#pragma unroll
    for (int j = 0; j < 8; ++j) { const f32x4 gg = *(const f32x4*)(g + 4 * lane + 256 * j);
        u32x2 o; o.x = cvt_pk_bf16(v[j][0] * rs * gg[0], v[j][1] * rs * gg[1]); o.y = cvt_pk_bf16(v[j][2] * rs * gg[2], v[j][3] * rs * gg[3]);
        *(u32x2*)(orow + 4 * lane + 256 * j) = o; }
}
constexpr int CV_P = 2560, CV_A = 28160 + 3584, CV_B = 2 * 28160;
__device__ __forceinline__ void convert_tiles(Frame& F, const int t_lo, const int T_TOTAL) {
    LAS float* scr = (LAS float*)(F.lds + F.wave * 16896);
    const int gw = F.vcu * NWAVES + F.wave, NGW = F.G * NWAVES, lane = F.lane;
    LAS float* nrm = (LAS float*)(F.lds + 8 * 16896); const float* nrm_g = F.in[IN_NORM2];
    for (int u = F.tid; u < NLAYER * DM; u += NTHREADS) nrm[u] = nrm_g[u];
    __syncthreads();
    {
        f32x4 va[16], vb[16];
        const float* srcA; const float* srcB; unsigned char* dstA; unsigned char* dstB; const float* kA; const float* kB; int ldA, ldB, pA, pB, fA, fB; float wA, wB;
#define CV_TIDX(q) (t_lo + (((((q) >> 1) * F.G + F.vcu) << 4) | (((q) & 1) << 3) | F.wave))
        int q = 0; const int last = T_TOTAL - 1;
        { const int i0 = CV_TIDX(0) < last ? CV_TIDX(0) : last; tile_desc(F.in, F.ws, i0, srcA, ldA, dstA, pA, kA, wA, fA); TR_LOAD(va, srcA, ldA, fA); }
        while (CV_TIDX(q + 1) < T_TOTAL) {
            tile_desc(F.in, F.ws, CV_TIDX(q + 1), srcB, ldB, dstB, pB, kB, wB, fB); TR_LOAD(vb, srcB, ldB, fB);
            TR_PROC(va, dstA, pA, kA, wA, fA);
            { const int i2 = CV_TIDX(q + 2) < last ? CV_TIDX(q + 2) : last; tile_desc(F.in, F.ws, i2, srcA, ldA, dstA, pA, kA, wA, fA); TR_LOAD(va, srcA, ldA, fA); }
            TR_PROC(vb, dstB, pB, kB, wB, fB);
            q += 2;
        }
        if (CV_TIDX(q) < T_TOTAL) TR_PROC(va, dstA, pA, kA, wA, fA);
#undef CV_TIDX
    }
}
__device__ __forceinline__ void p_prologue(Frame& F) {
    const int gw = F.vcu * NWAVES + F.wave, NGW = F.G * NWAVES;
    convert_tiles(F, 0, CV_P);
    { bf16* SW = (bf16*)(F.ws + WS_SGUW); const int gt = gw * 64 + F.lane, NGT = NGW * 64;
      for (int idx = gt; idx < NLAYER * 4 * 8 * 4 * 64; idx += NGT) {
          const int ln = idx & 63, pp = (idx >> 6) & 3, itile = (idx >> 8) & 7, h = (idx >> 11) & 3, l = idx >> 13;
          const int i = 16 * itile + (ln & 15), gq = ln >> 4;
          const float* w = F.in[IN_SGUW] + ((size_t)(l * 4 + h) * 128 + i) * 128;
          float v[8];
#pragma unroll
          for (int jj = 0; jj < 8; ++jj) { const int j = 32 * pp + (jj < 4 ? 4 * gq + jj : 16 + 4 * gq + (jj - 4)); v[jj] = (j <= i) ? w[j] : 0.f; }
          u32x4 o; o.x = cvt_pk_bf16(v[0], v[1]); o.y = cvt_pk_bf16(v[2], v[3]); o.z = cvt_pk_bf16(v[4], v[5]); o.w = cvt_pk_bf16(v[6], v[7]);
          *(u32x4*)(SW + (size_t)idx * 8) = o; }
      bf16* WRF = (bf16*)(F.ws + WS_WRT);
      for (int idx = gt; idx < NLAYER * 64 * 3 * 64; idx += NGT) { const int ln = idx & 63, ct = (idx >> 6) % 3, ks = (idx / 192) & 63, l = idx / (192 * 64);
          const int o = 16 * ct + (ln & 15), k0 = 32 * ks + 8 * (ln >> 4);
          float v[8];
#pragma unroll
          for (int j = 0; j < 8; ++j) { const int k = k0 + j; const float wv = o < 32 ? F.in[IN_WRE][((size_t)l * DM + k) * NE + o] : (o < 36 ? F.in[IN_WRG][((size_t)l * DM + k) * 4 + (o - 32)] : 0.f);
              v[j] = wv * F.in[IN_NORM2][(size_t)l * DM + k]; }
          u32x4 hi, lo; hi.x = cvt_pk_bf16(v[0], v[1]); hi.y = cvt_pk_bf16(v[2], v[3]); hi.z = cvt_pk_bf16(v[4], v[5]); hi.w = cvt_pk_bf16(v[6], v[7]);
          lo.x = cvt_pk_bf16(v[0] - bf_lo(hi.x), v[1] - bf_hi(hi.x)); lo.y = cvt_pk_bf16(v[2] - bf_lo(hi.y), v[3] - bf_hi(hi.y));
          lo.z = cvt_pk_bf16(v[4] - bf_lo(hi.z), v[5] - bf_hi(hi.z)); lo.w = cvt_pk_bf16(v[6] - bf_lo(hi.w), v[7] - bf_hi(hi.w));
          bf16* dst = WRF + ((((size_t)l * 64 + ks) * 3 + ct) * 2 * 64 + ln) * 8;
          *(u32x4*)dst = hi; *(u32x4*)(dst + 512) = lo; } }
    bf16* HN = (bf16*)(F.ws + WS_HN);
    for (int m = gw; m < SEQ; m += NGW) norm_row_bf16(F.in[IN_X] + (size_t)m * DM, F.in[IN_NORM1], HN + (size_t)m * DM, F.lane);
}

__device__ __forceinline__ int vimg_off(int row, int c) { return row * 256 + ((((c >> 1) ^ (row & 7)) << 1) | (c & 1)) * 16; }
__device__ __forceinline__ bf16x8 tr_frag(const LAS unsigned char* img, int ra, int rb, int dt, int lane) {
    const int gq = lane >> 4, q = (lane & 15) >> 2, p = lane & 3;
    const int r0 = ra + 4 * gq + q, r1 = rb + 4 * gq + q, c = 2 * dt + (p >> 1);
    const s16x4 a = __builtin_amdgcn_ds_read_tr16_b64_v4i16((LAS s16x4*)(img + vimg_off(r0, c) + 8 * (p & 1)));
    const s16x4 b = __builtin_amdgcn_ds_read_tr16_b64_v4i16((LAS s16x4*)(img + vimg_off(r1, c) + 8 * (p & 1)));
    bf16x8 r; r[0] = a[0]; r[1] = a[1]; r[2] = a[2]; r[3] = a[3]; r[4] = b[0]; r[5] = b[1]; r[6] = b[2]; r[7] = b[3]; return r;
}
__device__ __forceinline__ void sgu_stage8(const bf16* vsrc, int j0, int w, int lane, const f32x4& g0, const f32x4& g1, LAS unsigned char* lds) {
    u32x4 raw[8];
#pragma unroll
    for (int j = 0; j < 8; ++j) raw[j] = *(const u32x4*)(vsrc + (size_t)(w + 8 * (j0 + j)) * DIN);
#pragma unroll
    for (int j = 0; j < 8; ++j) { const int row = w + 8 * (j0 + j);
        float x[8] = {bf_lo(raw[j].x), bf_hi(raw[j].x), bf_lo(raw[j].y), bf_hi(raw[j].y), bf_lo(raw[j].z), bf_hi(raw[j].z), bf_lo(raw[j].w), bf_hi(raw[j].w)};
        float s = 0.f;
#pragma unroll
        for (int e = 0; e < 8; ++e) s += x[e] * x[e];
        const float rs = __builtin_amdgcn_rsqf(wave_sum(s) * (1.f / 512.f) + EPS);
        u32x4 o; o.x = cvt_pk_bf16(x[0] * rs * g0[0], x[1] * rs * g0[1]); o.y = cvt_pk_bf16(x[2] * rs * g0[2], x[3] * rs * g0[3]);
        o.z = cvt_pk_bf16(x[4] * rs * g1[0], x[5] * rs * g1[1]); o.w = cvt_pk_bf16(x[6] * rs * g1[2], x[7] * rs * g1[3]);
        *(LAS u32x4*)(lds + (lane >> 4) * 32768 + vimg_off(row, lane & 15)) = o; }
}
__device__ __forceinline__ void sgu_item(Frame& F, int l, int chunk, int half) {
    const bf16* PROJ = (const bf16*)(F.ws + WS_PROJ); bf16* MIX = (bf16*)(F.ws + WS_MIX);
    const int p0 = chunk * 128, lane = F.lane, w = F.wave;
    LAS float* red = (LAS float*)(F.lds + MISC_OFF + 256);
    const float* gn = F.in[IN_SGUN] + l * 512;
    const f32x4 g0 = *(const f32x4*)(gn + 8 * lane), g1 = *(const f32x4*)(gn + 8 * lane + 4);
    const bf16* vsrc = PROJ + (size_t)p0 * DIN + OFF_V + 8 * lane;
    sgu_stage8(vsrc, 0, w, lane, g0, g1, F.lds);
    if (half) sgu_stage8(vsrc, 8, w, lane, g0, g1, F.lds);
    const int h = w >> 1, ih = w & 1, gq = lane >> 4, fr = lane & 15;
    const LAS unsigned char* img = F.lds + h * 32768;
    const bf16* SW = (const bf16*)(F.ws + WS_SGUW) + (size_t)(l * 4 + h) * 8 * 4 * 64 * 8;
    const float* bs = F.in[IN_SGUB] + (size_t)(l * 4 + h) * 128;
    const float* og = F.in[IN_OUTN] + (size_t)l * DM + h * 128 + 4 * gq;
    const int it0 = ih + 4 * half;
    u32x2 ur[2][8];
#pragma unroll
    for (int ii = 0; ii < 2; ++ii) { const bf16* urow = PROJ + (size_t)(p0 + 16 * (it0 + 2 * ii) + fr) * DIN + OFF_U + h * 128 + 4 * gq;
#pragma unroll
        for (int dt = 0; dt < 8; ++dt) ur[ii][dt] = *(const u32x2*)(urow + 16 * dt); }
    __syncthreads();
    f32x4 z[2][8];
#pragma unroll
    for (int ii = 0; ii < 2; ++ii)
#pragma unroll
        for (int dt = 0; dt < 8; ++dt) z[ii][dt] = (f32x4){0.f, 0.f, 0.f, 0.f};
#pragma unroll 1
    for (int pp = 0; pp <= (it0 + 2) / 2; ++pp) {
        const bf16x8 bw0 = *(const bf16x8*)(SW + ((size_t)(it0 * 4 + pp) * 64 + lane) * 8);
        const bf16x8 bw1 = *(const bf16x8*)(SW + ((size_t)((it0 + 2) * 4 + pp) * 64 + lane) * 8);
        const bool do0 = pp <= it0 / 2;
#pragma unroll
        for (int dt = 0; dt < 8; ++dt) { const bf16x8 a = tr_frag(img, 32 * pp, 32 * pp + 16, dt, lane);
            if (do0) z[0][dt] = __builtin_amdgcn_mfma_f32_16x16x32_bf16(a, bw0, z[0][dt], 0, 0, 0);
            z[1][dt] = __builtin_amdgcn_mfma_f32_16x16x32_bf16(a, bw1, z[1][dt], 0, 0, 0); }
    }
#pragma unroll
    for (int ii = 0; ii < 2; ++ii) { const int i = 16 * (it0 + 2 * ii) + fr; const float bi = bs[i]; float s = 0.f;
#pragma unroll
        for (int dt = 0; dt < 8; ++dt) { const u32x2 u2 = ur[ii][dt];
            f32x4 y; y[0] = bf_lo(u2.x) * (z[ii][dt][0] + bi); y[1] = bf_hi(u2.x) * (z[ii][dt][1] + bi); y[2] = bf_lo(u2.y) * (z[ii][dt][2] + bi); y[3] = bf_hi(u2.y) * (z[ii][dt][3] + bi);
            z[ii][dt] = y; s += (y[0] * y[0] + y[1] * y[1]) + (y[2] * y[2] + y[3] * y[3]); }
        s += __shfl_xor(s, 16); s += __shfl_xor(s, 32);
        if (gq == 0) red[i * 4 + h] = s; }
    __syncthreads();
#pragma unroll
    for (int ii = 0; ii < 2; ++ii) { const int i = 16 * (it0 + 2 * ii) + fr;
        const f32x4 rr = *(const LAS f32x4*)(red + i * 4);
        const float rs = __builtin_amdgcn_rsqf(((rr[0] + rr[1]) + (rr[2] + rr[3])) * (1.f / 512.f) + EPS);
        bf16* orow = MIX + (size_t)(p0 + i) * DM + h * 128 + 4 * gq;
#pragma unroll
        for (int dt = 0; dt < 8; ++dt) { const f32x4 gg = *(const f32x4*)(og + 16 * dt); const f32x4 y = z[ii][dt];
            if (OP8(l)) *(unsigned*)((unsigned char*)MIX + (size_t)(p0 + i) * DM + h * 128 + 4 * gq + 16 * dt) = pk4_fp8(y[0] * rs * gg[0], y[1] * rs * gg[1], y[2] * rs * gg[2], y[3] * rs * gg[3]);
            else { u32x2 o; o.x = cvt_pk_bf16(y[0] * rs * gg[0], y[1] * rs * gg[1]); o.y = cvt_pk_bf16(y[2] * rs * gg[2], y[3] * rs * gg[3]);
            *(u32x2*)(orow + 16 * dt) = o; } } }
    __syncthreads();
}

__device__ __forceinline__ void conv_item(Frame& F, int l, int tile) {
    const bf16* PROJ = (const bf16*)(F.ws + WS_PROJ); bf16* MIX = (bf16*)(F.ws + WS_MIX);
    constexpr int TP = 32, NR = TP + 30;
    const int p0 = tile * TP, c = F.tid, tid = F.tid;
    LAS float* cbuf = (LAS float*)F.lds;
    LAS bf16* zbuf = (LAS bf16*)(F.lds + 65536);
    { u32x4 av[8], gv[8];
#pragma unroll
      for (int i = 0; i < 8; ++i) { const int id = tid + NTHREADS * i, row = id >> 6, ch = (id & 63) * 8; int p = p0 - 30 + row; p = p < 0 ? 0 : p; p = row < NR ? p : 0;
          av[i] = *(const u32x4*)(PROJ + (size_t)p * DIN + OFF_A + ch); gv[i] = *(const u32x4*)(PROJ + (size_t)p * DIN + OFF_G + ch); }
#pragma unroll
      for (int i = 0; i < 8; ++i) { const int id = tid + NTHREADS * i, row = id >> 6, ch = (id & 63) * 8; const bool live = (p0 - 30 + row) >= 0;
          const unsigned au[4] = {av[i].x, av[i].y, av[i].z, av[i].w}, gu[4] = {gv[i].x, gv[i].y, gv[i].z, gv[i].w}; u32x4 o; unsigned ou[4];
#pragma unroll
          for (int e = 0; e < 4; ++e) { const float z0 = bf_lo(au[e]) * sigmoidf_(bf_lo(gu[e])), z1 = bf_hi(au[e]) * sigmoidf_(bf_hi(gu[e])); ou[e] = live ? cvt_pk_bf16(z0, z1) : 0u; }
          o.x = ou[0]; o.y = ou[1]; o.z = ou[2]; o.w = ou[3];
          if (row < NR) *(LAS u32x4*)(zbuf + row * 512 + ch) = o; } }
    float wk[CONV_K];
#pragma unroll
    for (int k = 0; k < CONV_K; ++k) wk[k] = F.in[IN_CONVW][((size_t)l * CONV_K + k) * 512 + c];
    const float cb = F.in[IN_CONVB][l * 512 + c];
    __syncthreads();
#define CONV_Z(r) __builtin_bit_cast(float, (unsigned)zbuf[(r) * 512 + c] << 16)
    float win[30];
#pragma unroll
    for (int r = 0; r < 30; ++r) win[r] = CONV_Z(r);
#pragma unroll
    for (int q = 0; q < TP; ++q) { const float zv = CONV_Z(30 + q); float acc = cb + wk[30] * zv;
#pragma unroll
        for (int k = 0; k < 30; ++k) acc += wk[k] * win[(k + q) % 30];
        win[q % 30] = zv; cbuf[q * 512 + c] = acc; }
#undef CONV_Z
    __syncthreads();
    const float* lg = F.in[IN_LNG] + l * 512 + 8 * F.lane; const float* lb = F.in[IN_LNB] + l * 512 + 8 * F.lane; const float* og = F.in[IN_OUTN] + (size_t)l * DM + 512 + 8 * F.lane;
    const f32x4 lg0 = *(const f32x4*)lg, lg1 = *(const f32x4*)(lg + 4), lb0 = *(const f32x4*)lb, lb1 = *(const f32x4*)(lb + 4), og0 = *(const f32x4*)og, og1 = *(const f32x4*)(og + 4);
    for (int r = F.wave; r < TP; r += NWAVES) {
        const f32x4 a0 = *(const LAS f32x4*)(cbuf + r * 512 + 8 * F.lane), a1 = *(const LAS f32x4*)(cbuf + r * 512 + 8 * F.lane + 4);
        float x[8] = {a0[0], a0[1], a0[2], a0[3], a1[0], a1[1], a1[2], a1[3]};
        float s = 0.f;
#pragma unroll
        for (int e = 0; e < 8; ++e) s += x[e];
        const float mu = wave_sum(s) * (1.f / 512.f); float q2 = 0.f;
#pragma unroll
        for (int e = 0; e < 8; ++e) { x[e] -= mu; q2 += x[e] * x[e]; }
        const float rstd = __builtin_amdgcn_rsqf(wave_sum(q2) * (1.f / 512.f) + EPS);
        const float gam[8] = {lg0[0], lg0[1], lg0[2], lg0[3], lg1[0], lg1[1], lg1[2], lg1[3]}, bet[8] = {lb0[0], lb0[1], lb0[2], lb0[3], lb1[0], lb1[1], lb1[2], lb1[3]};
        float s2 = 0.f;
#pragma unroll
        for (int e = 0; e < 8; ++e) { const float y = x[e] * rstd * gam[e] + bet[e]; x[e] = y * sigmoidf_(y); s2 += x[e] * x[e]; }
        const float rs = __builtin_amdgcn_rsqf(wave_sum(s2) * (1.f / 512.f) + EPS);
        if (OP8(l)) { u32x2 o8; o8.x = pk4_fp8(x[0] * rs * og0[0], x[1] * rs * og0[1], x[2] * rs * og0[2], x[3] * rs * og0[3]); o8.y = pk4_fp8(x[4] * rs * og1[0], x[5] * rs * og1[1], x[6] * rs * og1[2], x[7] * rs * og1[3]);
            *(u32x2*)((unsigned char*)MIX + (size_t)(p0 + r) * DM + 512 + 8 * F.lane) = o8; }
        else {
        u32x4 o; o.x = cvt_pk_bf16(x[0] * rs * og0[0], x[1] * rs * og0[1]); o.y = cvt_pk_bf16(x[2] * rs * og0[2], x[3] * rs * og0[3]);
        o.z = cvt_pk_bf16(x[4] * rs * og1[0], x[5] * rs * og1[1]); o.w = cvt_pk_bf16(x[6] * rs * og1[2], x[7] * rs * og1[3]);
        *(u32x4*)(MIX + (size_t)(p0 + r) * DM + 512 + 8 * F.lane) = o; }
    }
    __syncthreads();
}

__device__ __forceinline__ int kimg_off(int row, int c) { return row * 256 + ((c ^ (row & 15)) << 4); }
__device__ __forceinline__ bf16x8 tr_frag2(const LAS unsigned char* vs, int ta, int tb, int dt, int lane) {
    const int gq = lane >> 4, q = (lane & 15) >> 2, p = lane & 3, c = 2 * dt + (p >> 1), rr = 4 * gq + q;
    const int off = rr * 256 + ((((c >> 1) ^ (rr & 7)) << 1) | (c & 1)) * 16 + 8 * (p & 1);
    const s16x4 a = __builtin_amdgcn_ds_read_tr16_b64_v4i16((LAS s16x4*)(vs + ta + off));
    const s16x4 b = __builtin_amdgcn_ds_read_tr16_b64_v4i16((LAS s16x4*)(vs + tb + off));
    bf16x8 r; r[0] = a[0]; r[1] = a[1]; r[2] = a[2]; r[3] = a[3]; r[4] = b[0]; r[5] = b[1]; r[6] = b[2]; r[7] = b[3]; return r;
}
#define ATT_DECODE(st) const int run_ = (int)blockIdx.x + F.G * ((st) / 5), b_ = (st) % 5 - 1; const int g = run_ >> 8, h = (run_ >> 5) & 7, rr_ = run_ & 31; \
    const int sh = 2 * g, dil = 1 << sh, rps = 32 >> sh; const int r = rr_ / rps, nb = 4 * (rr_ % rps) + b_
#define ATT_LOAD(st) do { if (ATT_EXP == 2) break; ATT_DECODE(st); const int cc = tid & 15; \
    _Pragma("unroll") for (int j = 0; j < 4; ++j) { const int row = (tid >> 4) + 32 * j; int ms = nb * 128 + row; ms = ms < 0 ? 0 : ms; const size_t pos = (size_t)ms * dil + r; \
        kr[j] = *(const u32x4*)(PROJ + pos * DIN + OFF_K + h * HD + 8 * cc); vr[j] = *(const u32x4*)(PROJ + pos * DIN + OFF_VV + h * HD + 8 * cc); } \
    if (b_ >= 0) { const size_t qpos_ = (size_t)(nb * 128 + 16 * w + (lane & 15)) * dil + r; \
        _Pragma("unroll") for (int ks = 0; ks < 4; ++ks) qr[ks] = *(const u32x4*)(PROJ + qpos_ * DIN + OFF_Q + h * HD + 32 * ks + 8 * (lane >> 4)); } } while (0)
__device__ __forceinline__ void att_phase(Frame& F, int l) {
    const bf16* PROJ = (const bf16*)(F.ws + WS_PROJ);
    bf16* ATT = (bf16*)(F.ws + WS_ATT); float* LSE = (float*)(F.ws + WS_LSE);
    const int lane = F.lane, w = F.wave, tid = F.tid, fr = lane & 15, gq = lane >> 4;
    LAS unsigned char* Ks = F.lds; LAS unsigned char* Vs = F.lds + 65536;
    const int nsteps = 5 * ((768 - (int)blockIdx.x + F.G - 1) / F.G);
    u32x4 kr[4], vr[4], qr[4];
    if (ATT_EXP == 2) { for (int j = 0; j < 4; ++j) { kr[j] = (u32x4){0x3f803f80u + (unsigned)tid, 0x3f003f80u, 0x3f803f00u, 0x3e803f80u}; vr[j] = kr[j]; qr[j] = kr[j]; } }
    if (nsteps > 0) ATT_LOAD(0);
    const int cc = tid & 15;
    const float* kgp = F.in[IN_KN] + l * HD + 8 * cc;
    const f32x4 kg0 = *(const f32x4*)kgp, kg1 = *(const f32x4*)(kgp + 4);
    for (int st = 0; st < nsteps; ++st) {
        ATT_DECODE(st);
        const int slot = (b_ + 1) & 1, curoff = slot * 32768, prevoff = 32768 - curoff;
#pragma unroll
        for (int j = 0; j < 4; ++j) { const int row = (tid >> 4) + 32 * j;
            const u32x4 k4 = kr[j];
            float x[8] = {bf_lo(k4.x), bf_hi(k4.x), bf_lo(k4.y), bf_hi(k4.y), bf_lo(k4.z), bf_hi(k4.z), bf_lo(k4.w), bf_hi(k4.w)};
            float sq = 0.f;
#pragma unroll
            for (int e = 0; e < 8; ++e) sq += x[e] * x[e];
            const float rs = __builtin_amdgcn_rsqf(row16_sum(sq) * (1.f / HD) + EPS);
            u32x4 o; o.x = cvt_pk_bf16(x[0] * rs * kg0[0], x[1] * rs * kg0[1]); o.y = cvt_pk_bf16(x[2] * rs * kg0[2], x[3] * rs * kg0[3]);
            o.z = cvt_pk_bf16(x[4] * rs * kg1[0], x[5] * rs * kg1[1]); o.w = cvt_pk_bf16(x[6] * rs * kg1[2], x[7] * rs * kg1[3]);
            *(LAS u32x4*)(Ks + curoff + kimg_off(row, cc)) = o;
            *(LAS u32x4*)(Vs + curoff + vimg_off(row, cc)) = vr[j]; }
        const int iq = 16 * w + fr; const size_t qpos = (size_t)(nb * 128 + iq) * dil + r;
        bf16x8 qf[4];
        if (b_ >= 0) { float x[4][8]; float sq = 0.f;
#pragma unroll
          for (int ks = 0; ks < 4; ++ks) { const u32x4 q4 = qr[ks];
              x[ks][0] = bf_lo(q4.x); x[ks][1] = bf_hi(q4.x); x[ks][2] = bf_lo(q4.y); x[ks][3] = bf_hi(q4.y); x[ks][4] = bf_lo(q4.z); x[ks][5] = bf_hi(q4.z); x[ks][6] = bf_lo(q4.w); x[ks][7] = bf_hi(q4.w);
#pragma unroll
              for (int e = 0; e < 8; ++e) sq += x[ks][e] * x[ks][e]; }
          sq = sum4(sq);
          const float rs = __builtin_amdgcn_rsqf(sq * (1.f / HD) + EPS) * 0.12751743f;
#pragma unroll
          for (int ks = 0; ks < 4; ++ks) { const float* qg = F.in[IN_QN] + l * HD + 32 * ks + 8 * gq; const f32x4 q0 = *(const f32x4*)qg, q1 = *(const f32x4*)(qg + 4);
              u32x4 o; o.x = cvt_pk_bf16(x[ks][0] * rs * q0[0], x[ks][1] * rs * q0[1]); o.y = cvt_pk_bf16(x[ks][2] * rs * q0[2], x[ks][3] * rs * q0[3]);
              o.z = cvt_pk_bf16(x[ks][4] * rs * q1[0], x[ks][5] * rs * q1[1]); o.w = cvt_pk_bf16(x[ks][6] * rs * q1[2], x[ks][7] * rs * q1[3]);
              qf[ks] = __builtin_bit_cast(bf16x8, o); } }
        __syncthreads();
        if (st + 1 < nsteps) ATT_LOAD(st + 1);
        if (b_ >= 0 && ATT_EXP != 1) {
        f32x4 sc[10];
#pragma unroll
        for (int kt = 0; kt < 9; ++kt) { sc[kt] = (f32x4){0.f, 0.f, 0.f, 0.f}; const int T = w + kt; const int kbase = (T < 8 ? prevoff : curoff); const int krow = 16 * (T & 7) + fr;
#pragma unroll
            for (int ks = 0; ks < 4; ++ks) { const bf16x8 kf = *(const LAS bf16x8*)(Ks + kbase + kimg_off(krow, 4 * ks + gq));
                sc[kt] = __builtin_amdgcn_mfma_f32_16x16x32_bf16(kf, qf[ks], sc[kt], 0, 0, 0); } }
#pragma unroll
        for (int e = 0; e < 4; ++e) { sc[0][e] = (4 * gq + e >= fr) ? sc[0][e] : -INFINITY; sc[8][e] = (4 * gq + e <= fr) ? sc[8][e] : -INFINITY; }
        if (nb == 0) {
#pragma unroll
            for (int kt = 0; kt < 8; ++kt) if (w + kt < 8) sc[kt] = (f32x4){-INFINITY, -INFINITY, -INFINITY, -INFINITY}; }
        float mx = -INFINITY;
#pragma unroll
        for (int kt = 0; kt < 9; ++kt) mx = fmaxf(fmaxf(mx, fmaxf(sc[kt][0], sc[kt][1])), fmaxf(sc[kt][2], sc[kt][3]));
        mx = max4(mx);
        float sum = 0.f;
#pragma unroll
        for (int kt = 0; kt < 9; ++kt)
#pragma unroll
            for (int e = 0; e < 4; ++e) { const float p = __builtin_amdgcn_exp2f(sc[kt][e] - mx); sc[kt][e] = p; sum += p; }
        sc[9] = (f32x4){0.f, 0.f, 0.f, 0.f};
        sum = sum4(sum);
        bf16x8 pf[5];
#pragma unroll
        for (int pp = 0; pp < 5; ++pp) { u32x4 o; o.x = cvt_pk_bf16(sc[2 * pp][0], sc[2 * pp][1]); o.y = cvt_pk_bf16(sc[2 * pp][2], sc[2 * pp][3]); o.z = cvt_pk_bf16(sc[2 * pp + 1][0], sc[2 * pp + 1][1]); o.w = cvt_pk_bf16(sc[2 * pp + 1][2], sc[2 * pp + 1][3]);
            pf[pp] = __builtin_bit_cast(bf16x8, o); }
        const float inv = __builtin_amdgcn_rcpf(sum);
        bf16* orow = ATT + ((size_t)g * SEQ + qpos) * 1024 + h * HD + 4 * gq;
        int toff[10];
#pragma unroll
        for (int kt = 0; kt < 10; ++kt) { const int T = (w + kt) < 15 ? (w + kt) : 15; toff[kt] = (T < 8 ? prevoff : curoff) + (T & 7) * 16 * 256; }
#pragma unroll
        for (int dt = 0; dt < 8; ++dt) { f32x4 o = (f32x4){0.f, 0.f, 0.f, 0.f};
#pragma unroll
            for (int pp = 0; pp < 5; ++pp) { const bf16x8 vf = tr_frag2(Vs, toff[2 * pp], toff[2 * pp + 1], dt, lane);
                o = __builtin_amdgcn_mfma_f32_16x16x32_bf16(vf, pf[pp], o, 0, 0, 0); }
            u32x2 ow; ow.x = cvt_pk_bf16(o[0] * inv, o[1] * inv); ow.y = cvt_pk_bf16(o[2] * inv, o[3] * inv);
            *(u32x2*)(orow + 16 * dt) = ow; }
        if (gq == 0) LSE[((size_t)g * SEQ + qpos) * NHEAD + h] = (mx + __builtin_amdgcn_logf(sum)) * 0.6931471805599453f;
        }
        if (b_ >= 0 && ATT_EXP == 1) { bf16* orow = ATT + ((size_t)g * SEQ + qpos) * 1024 + h * HD + 4 * gq;
#pragma unroll
            for (int dt = 0; dt < 8; ++dt) { u32x2 ow; ow.x = __builtin_bit_cast(unsigned, qf[dt & 3][0] | (qf[dt & 3][1] << 16)) & 0x3f803f80u; ow.y = 0u; *(u32x2*)(orow + 16 * dt) = ow; }
            if (gq == 0) LSE[((size_t)g * SEQ + qpos) * NHEAD + h] = 0.f; }
        __syncthreads();
    }
}
#undef ATT_DECODE
#undef ATT_LOAD

__device__ __forceinline__ void att_combine(Frame& F, int l) {
    const bf16* ATT = (const bf16*)(F.ws + WS_ATT); const float* LSE = (const float*)(F.ws + WS_LSE); bf16* MIX = (bf16*)(F.ws + WS_MIX);
    const int gw = F.vcu * NWAVES + F.wave, NGW = F.G * NWAVES, lane = F.lane;
    const float* og = F.in[IN_OUTN] + (size_t)l * DM + 1024 + 16 * lane;
    f32x4 gg[4];
#pragma unroll
    for (int q = 0; q < 4; ++q) gg[q] = *(const f32x4*)(og + 4 * q);
    for (int m = gw; m < SEQ; m += NGW) {
        const int hh = lane >> 3;
        const float l0 = LSE[((size_t)0 * SEQ + m) * NHEAD + hh], l1 = LSE[((size_t)1 * SEQ + m) * NHEAD + hh], l2 = LSE[((size_t)2 * SEQ + m) * NHEAD + hh];
        const float M = fmaxf(l0, fmaxf(l1, l2)); float w0 = fast_exp(l0 - M), w1 = fast_exp(l1 - M), w2 = fast_exp(l2 - M);
        const float iw = __builtin_amdgcn_rcpf(w0 + w1 + w2); w0 *= iw; w1 *= iw; w2 *= iw;
        float y[16]; float s = 0.f;
#pragma unroll
        for (int q = 0; q < 2; ++q) {
            const u32x4 a = __builtin_nontemporal_load((const u32x4*)(ATT + ((size_t)0 * SEQ + m) * 1024 + 16 * lane + 8 * q)), b = __builtin_nontemporal_load((const u32x4*)(ATT + ((size_t)1 * SEQ + m) * 1024 + 16 * lane + 8 * q)), c = __builtin_nontemporal_load((const u32x4*)(ATT + ((size_t)2 * SEQ + m) * 1024 + 16 * lane + 8 * q));
            const unsigned au[4] = {a.x, a.y, a.z, a.w}, bu[4] = {b.x, b.y, b.z, b.w}, cu[4] = {c.x, c.y, c.z, c.w};
#pragma unroll
            for (int e = 0; e < 4; ++e) { y[8 * q + 2 * e] = w0 * bf_lo(au[e]) + w1 * bf_lo(bu[e]) + w2 * bf_lo(cu[e]); y[8 * q + 2 * e + 1] = w0 * bf_hi(au[e]) + w1 * bf_hi(bu[e]) + w2 * bf_hi(cu[e]); } }
#pragma unroll
        for (int e = 0; e < 16; ++e) s += y[e] * y[e];
        const float rs = __builtin_amdgcn_rsqf(wave_sum(s) * (1.f / 1024.f) + EPS);
        if (OP8(l)) { u32x4 o8;
            o8.x = pk4_fp8(y[0] * rs * gg[0][0], y[1] * rs * gg[0][1], y[2] * rs * gg[0][2], y[3] * rs * gg[0][3]); o8.y = pk4_fp8(y[4] * rs * gg[1][0], y[5] * rs * gg[1][1], y[6] * rs * gg[1][2], y[7] * rs * gg[1][3]);
            o8.z = pk4_fp8(y[8] * rs * gg[2][0], y[9] * rs * gg[2][1], y[10] * rs * gg[2][2], y[11] * rs * gg[2][3]); o8.w = pk4_fp8(y[12] * rs * gg[3][0], y[13] * rs * gg[3][1], y[14] * rs * gg[3][2], y[15] * rs * gg[3][3]);
            *(u32x4*)((unsigned char*)MIX + (size_t)m * DM + 1024 + 16 * lane) = o8; }
        else
#pragma unroll
        for (int q = 0; q < 2; ++q) { u32x4 o;
            o.x = cvt_pk_bf16(y[8 * q + 0] * rs * gg[2 * q][0], y[8 * q + 1] * rs * gg[2 * q][1]); o.y = cvt_pk_bf16(y[8 * q + 2] * rs * gg[2 * q][2], y[8 * q + 3] * rs * gg[2 * q][3]);
            o.z = cvt_pk_bf16(y[8 * q + 4] * rs * gg[2 * q + 1][0], y[8 * q + 5] * rs * gg[2 * q + 1][1]); o.w = cvt_pk_bf16(y[8 * q + 6] * rs * gg[2 * q + 1][2], y[8 * q + 7] * rs * gg[2 * q + 1][3]);
            *(u32x4*)(MIX + (size_t)m * DM + 1024 + 16 * lane + 8 * q) = o; }
    }
}

#define ROUTER_LOAD(S, ks) do { \
    _Pragma("unroll") for (int rt = 0; rt < 4; ++rt) xa##S[rt] = *(const u32x4*)(xrow + (size_t)rt * 16 * DM + 32 * (ks)); \
    _Pragma("unroll") for (int ct = 0; ct < 3; ++ct) { bh##S[ct] = *(const bf16x8*)(wf + (size_t)(ks) * 3072 + (ct * 2) * 512); bl##S[ct] = *(const bf16x8*)(wf + (size_t)(ks) * 3072 + (ct * 2 + 1) * 512); } } while (0)
#define ROUTER_STEP(S, ks) do { \
    _Pragma("unroll") for (int rt = 0; rt < 4; ++rt) { const u32x4 xq = xa##S[rt]; \
        const float x0 = bf_lo(xq.x), x1 = bf_hi(xq.x), x2 = bf_lo(xq.y), x3 = bf_hi(xq.y), x4 = bf_lo(xq.z), x5 = bf_hi(xq.z), x6 = bf_lo(xq.w), x7 = bf_hi(xq.w); \
        ssq[rt] += (x0 * x0 + x1 * x1) + (x2 * x2 + x3 * x3) + (x4 * x4 + x5 * x5) + (x6 * x6 + x7 * x7); \
        { u32x2 x8; x8.x = pk4_fp8(x0, x1, x2, x3); x8.y = pk4_fp8(x4, x5, x6, x7); *(u32x2*)(x8row + (size_t)rt * 16 * DM + 32 * (ks)) = x8; } \
        const bf16x8 xh = __builtin_bit_cast(bf16x8, xq); \
        _Pragma("unroll") for (int ct = 0; ct < 3; ++ct) { \
            acc[rt][ct] = __builtin_amdgcn_mfma_f32_16x16x32_bf16(xh, bh##S[ct], acc[rt][ct], 0, 0, 0); \
            acc[rt][ct] = __builtin_amdgcn_mfma_f32_16x16x32_bf16(xh, bl##S[ct], acc[rt][ct], 0, 0, 0); } } } while (0)
__device__ __forceinline__ void router_phase(Frame& F, int l, int alt = 0) {
    const bf16* H1 = (const bf16*)(F.ws + WS_HN);
    const bf16* WRF = (const bf16*)(F.ws + WS_WRT) + (size_t)l * 64 * 3 * 2 * 64 * 8;
    unsigned* cnt = (unsigned*)(F.ws + WS_CTL) + CW_CNT + 2048 * l + 32768 * alt;
    int* tok = (int*)(F.ws + (alt ? WS_ALT : WS_TOK)); f32x4* tinfo = (f32x4*)(F.ws + (alt ? WS_ALT + 4 * MiB : WS_TINFO)); float* rslot = (float*)(F.ws + (alt ? WS_ALT + 2 * MiB : WS_RSLOT));
    const int lane = F.lane, tid = F.tid, w = F.wave, fr = lane & 15, g = lane >> 4;
    constexpr int PS = 49;
    LAS float* P = (LAS float*)F.lds;
    LAS float* SS = (LAS float*)(F.lds + 8 * 64 * PS * 4);
    for (int task = (int)blockIdx.x; task < SEQ / 64; task += F.G) {
        const bf16* xrow = H1 + (size_t)(task * 64 + fr) * DM + 256 * w + 8 * g;
        unsigned char* x8row = F.ws + WS_X8 + (size_t)(task * 64 + fr) * DM + 256 * w + 8 * g;
        const bf16* wf = WRF + ((size_t)(8 * w) * 3 * 2 * 64 + lane) * 8;
        f32x4 acc[4][3]; float ssq[4] = {0.f, 0.f, 0.f, 0.f};
#pragma unroll
        for (int rt = 0; rt < 4; ++rt)
#pragma unroll
            for (int ct = 0; ct < 3; ++ct) acc[rt][ct] = (f32x4){0.f, 0.f, 0.f, 0.f};
        u32x4 xaA[4], xaB[4]; bf16x8 bhA[3], blA[3], bhB[3], blB[3];
        ROUTER_LOAD(A, 0);
#pragma unroll 1
        for (int it = 0; it < 4; ++it) {
            ROUTER_LOAD(B, 1); __builtin_amdgcn_sched_barrier(0);
            ROUTER_STEP(A, 0); __builtin_amdgcn_sched_barrier(0);
            if (it < 3) ROUTER_LOAD(A, 2);
            __builtin_amdgcn_sched_barrier(0);
            ROUTER_STEP(B, 1); __builtin_amdgcn_sched_barrier(0);
            xrow += 64; x8row += 64; wf += 2 * 3072;
        }
#pragma unroll
        for (int rt = 0; rt < 4; ++rt) { float sq = ssq[rt]; sq += __shfl_xor(sq, 16); sq += __shfl_xor(sq, 32);
            if (g == 0) SS[w * 64 + 16 * rt + fr] = sq;
#pragma unroll
            for (int ct = 0; ct < 3; ++ct)
#pragma unroll
                for (int e = 0; e < 4; ++e) P[(w * 64 + 16 * rt + 4 * g + e) * PS + 16 * ct + fr] = acc[rt][ct][e]; }
        __syncthreads();
        if (tid < 64) {
            const int t = task * 64 + tid;
            float ss = 0.f;
#pragma unroll
            for (int q = 0; q < 8; ++q) ss += SS[q * 64 + tid];
            const float rs = __builtin_amdgcn_rsqf(ss * (1.f / DM) + EPS);
            const LAS float* pr = P + tid * PS;
            float lg[4];
#pragma unroll
            for (int o = 0; o < 4; ++o) { float a = 0.f;
#pragma unroll
                for (int q = 0; q < 8; ++q) a += pr[q * 64 * PS + 32 + o];
                lg[o] = a * rs + F.in[IN_BRG][l * 4 + o]; }
            int gi = 0; float gm = lg[0];
#pragma unroll
            for (int o = 1; o < 4; ++o) if (lg[o] > gm) { gm = lg[o]; gi = o; }
            float den = 0.f;
#pragma unroll
            for (int o = 0; o < 4; ++o) den += __expf(lg[o] - gm);
            const float gate_g = 1.f / den;
            float t1v = -INFINITY, t2v = -INFINITY; int t1i = 0, t2i = 0;
#pragma unroll
            for (int ii = 0; ii < 8; ++ii) { const int o = gi * 8 + ii; float a = 0.f;
#pragma unroll
                for (int q = 0; q < 8; ++q) a += pr[q * 64 * PS + o];
                const float v = a * rs + F.in[IN_BRE][l * NE + o];
                if (v > t1v) { t2v = t1v; t2i = t1i; t1v = v; t1i = ii; }
                else if (v > t2v) { t2v = v; t2i = ii; } }
            const float pp1 = 1.f / (1.f + __expf(t2v - t1v)), pp2 = 1.f - pp1;
            const int e0 = gi * 8 + t1i, e1 = gi * 8 + t2i;
            LAS unsigned* lcnt = (LAS unsigned*)(F.lds + 8 * 64 * PS * 4 + 8 * 64 * 4);
            if (tid < 32) lcnt[tid] = 0u;
            const unsigned r0 = __hip_atomic_fetch_add(lcnt + e0, 1u, __ATOMIC_RELAXED, __HIP_MEMORY_SCOPE_WORKGROUP), r1 = __hip_atomic_fetch_add(lcnt + e1, 1u, __ATOMIC_RELAXED, __HIP_MEMORY_SCOPE_WORKGROUP);
            if (tid < 32) { const unsigned c = lcnt[tid]; lcnt[32 + tid] = c ? atomicAdd(&cnt[tid * CNT_STRIDE], c) : 0u; }
            const unsigned s0 = lcnt[32 + e0] + r0, s1 = lcnt[32 + e1] + r1;
            tok[(size_t)e0 * TOKCAP + s0] = t; tok[(size_t)e1 * TOKCAP + s1] = t;
            rslot[(size_t)e0 * TOKCAP + s0] = rs; rslot[(size_t)e1 * TOKCAP + s1] = rs;
            f32x4 ti; ti[0] = __builtin_bit_cast(float, (int)(e0 * TOKCAP + s0)); ti[1] = __builtin_bit_cast(float, (int)(e1 * TOKCAP + s1)); ti[2] = gate_g * pp1; ti[3] = gate_g * pp2;
            tinfo[t] = ti;
        }
        __syncthreads();
    }
}
__device__ __forceinline__ void moe_table(Frame& F, int l) {
    const unsigned* cnt = (const unsigned*)(F.ws + WS_CTL) + CW_CNT + 2048 * l;
    LAS int* tstart = (LAS int*)(F.lds + MISC_OFF + 64);
    __syncthreads();
    if (F.tid == 0) { int acc = 0; for (int e = 0; e < NE; ++e) { tstart[e] = acc; acc += ((int)cnt[e * CNT_STRIDE] + 255) >> 8; } tstart[NE] = acc; }
    __syncthreads();
    { LAS int* tile_e = (LAS int*)(F.lds + MISC_OFF + 2304);
      if (F.tid < 160) { int e = 0; for (int j = 1; j < NE; ++j) e = (tstart[j] <= F.tid) ? j : e; tile_e[F.tid] = e; } }
    __syncthreads();
}
__device__ __forceinline__ void combine_phase(Frame& F, int l) {
    const LAS int* tstart = (const LAS int*)(F.lds + MISC_OFF + 64);
    const unsigned char* Y = F.ws + WS_Y; const f32x4* tinfo = (const f32x4*)(F.ws + WS_TINFO);
    bf16* H = (bf16*)(F.ws + WS_H); bf16* HN = (bf16*)(F.ws + WS_HN);
    const int gw = F.vcu * NWAVES + F.wave, NGW = F.G * NWAVES, lane = F.lane;
    const float* g1n = F.in[IN_NORM1] + (size_t)DM;
    for (int m = gw; m < SEQ; m += NGW) {
        const f32x4 ti = tinfo[m];
        const float tf0 = ti[0], tf1 = ti[1]; const int s0 = __builtin_bit_cast(int, tf0), s1 = __builtin_bit_cast(int, tf1);
        const int e0 = s0 >> 14, e1 = s1 >> 14;
        const size_t r0 = (size_t)tstart[e0] * 256 + (s0 & (TOKCAP - 1)), r1 = (size_t)tstart[e1] * 256 + (s1 & (TOKCAP - 1));
        const float ga = ti[2] * (1.f / Y_SCALE), gb = ti[3] * (1.f / Y_SCALE);
        f32x4 v[8]; float s = 0.f;
#pragma unroll
        for (int j = 0; j < 8; ++j) { const u32x2 hx = __builtin_nontemporal_load((const u32x2*)(HN + (size_t)m * DM + 4 * lane + 256 * j));
            const int ya = __builtin_nontemporal_load((const int*)(Y + r0 * DM + 4 * lane + 256 * j)), yb = __builtin_nontemporal_load((const int*)(Y + r1 * DM + 4 * lane + 256 * j));
            const f32x2 a01 = __builtin_amdgcn_cvt_pk_f32_fp8(ya, false), a23 = __builtin_amdgcn_cvt_pk_f32_fp8(ya, true), b01 = __builtin_amdgcn_cvt_pk_f32_fp8(yb, false), b23 = __builtin_amdgcn_cvt_pk_f32_fp8(yb, true);
            v[j][0] = bf_lo(hx.x) + ga * a01[0] + gb * b01[0]; v[j][1] = bf_hi(hx.x) + ga * a01[1] + gb * b01[1];
            v[j][2] = bf_lo(hx.y) + ga * a23[0] + gb * b23[0]; v[j][3] = bf_hi(hx.y) + ga * a23[1] + gb * b23[1];
            s += (v[j][0] * v[j][0] + v[j][1] * v[j][1]) + (v[j][2] * v[j][2] + v[j][3] * v[j][3]); }
        if (l == 0) {
            const float rs = __builtin_amdgcn_rsqf(wave_sum(s) * (1.f / DM) + EPS);
            bf16* hrow = H + (size_t)m * DM; bf16* orow = HN + (size_t)m * DM;
#pragma unroll
            for (int j = 0; j < 8; ++j) { const f32x4 gg = *(const f32x4*)(g1n + 4 * lane + 256 * j);
                u32x2 hb; hb.x = cvt_pk_bf16(v[j][0], v[j][1]); hb.y = cvt_pk_bf16(v[j][2], v[j][3]); *(u32x2*)(hrow + 4 * lane + 256 * j) = hb;
                if (IP8(1)) *(unsigned*)(F.ws + WS_X8 + (size_t)m * DM + 4 * lane + 256 * j) = pk4_fp8(v[j][0] * rs * gg[0], v[j][1] * rs * gg[1], v[j][2] * rs * gg[2], v[j][3] * rs * gg[3]);
                else { u32x2 o; o.x = cvt_pk_bf16(v[j][0] * rs * gg[0], v[j][1] * rs * gg[1]); o.y = cvt_pk_bf16(v[j][2] * rs * gg[2], v[j][3] * rs * gg[3]);
                *(u32x2*)(orow + 4 * lane + 256 * j) = o; } }
        } else {
            float* orow = F.out + (size_t)m * DM;
#pragma unroll
            for (int j = 0; j < 8; ++j) __builtin_nontemporal_store(v[j], (f32x4*)(orow + 4 * lane + 256 * j));
        }
    }
}

__device__ __forceinline__ void relaunder(Frame& F) { F.lane = lane_now(); F.tid = F.wave * 64 + F.lane; }
constexpr int N_PHASES = 17;
#ifndef PHASE_MASK
#define PHASE_MASK 0x1ff
#endif
#ifndef MIX_MASK
#define MIX_MASK 7
#endif
#ifndef DUP_PHASE
#define DUP_PHASE 0
#endif
#define DUP(k) for (int _d = 0; _d < ((DUP_PHASE == (k)) ? 2 : 1); ++_d)
#define IN(k) (lo <= (k) && (k) < hi)
#define EN(b) ((PHASE_MASK >> (b)) & 1)
#ifndef PROBE_STAMP
#define PROBE_STAMP (-1)
#endif
#ifndef PROBE_IDLE
#define PROBE_IDLE (-1)
#endif
#define SEAM(k) do { if (IN(k) && IN((k) + 1)) { unsigned long long _ta = 0; if (PROBE_IDLE == (k)) { asm volatile("s_waitcnt vmcnt(0)" ::: "memory"); __syncthreads(); if (F.wave == 0) _ta = wall_clock64(); } xcd_barrier(bar); \
    if (PROBE_IDLE == (k) && F.wave == 0) { const unsigned long long _tb = wall_clock64(); if (lane_now() == 0) xb_add((unsigned*)(F.ws + WS_CTL) + 200000, (unsigned)(_tb - _ta)); } \
 if (PROBE_STAMP >= 0 && blockIdx.x == 0 && F.tid == 0) { const unsigned long long _t = wall_clock64(); F.MISC[802 + 2 * (k)] = (unsigned)_t; F.MISC[803 + 2 * (k)] = (unsigned)(_t >> 32); } } } while (0)
template <int l>
__device__ __forceinline__ void layer_phases(Frame& F, const XcdBarrier& bar, const int lo, const int hi) {
    constexpr int pb = 1 + 8 * l;
    relaunder(F);
    if (EN(1) && IN(pb)) {
        constexpr int KI = IP8(l) ? DM / 2 : DM;
#define INPROJ_PART(first) do { pg8::StaticSched S; S.init((const bf16*)(F.ws + (IP8(l) ? WS_X8 : WS_HN)), (const bf16*)(F.ws + WS_WIN) + (size_t)l * DIN * DM, SEQ, DIN, KI, F.G, (int)blockIdx.x); \
            const int slot = ((((((int)blockIdx.x >> 6) & 3) << 3) | ((int)blockIdx.x & 7)) * 6) >> 5; if (first) S.i1 = slot; else S.i0 = slot; \
            pg8::EpiProj E{(bf16*)(F.ws + WS_PROJ), IP8(l) ? 1.f / WIN_SCALE : 1.f}; \
            DUP(1) pg8::gemm_phase<pg8::EpiProj, pg8::StaticSched, true, IP8(l) != 0>(F.lds, KI, S, E, F.wave); } while (0)
        INPROJ_PART(true);
        __syncthreads(); relaunder(F); convert_tiles(F, l == 0 ? CV_P : CV_A, l == 0 ? CV_A : CV_B); __syncthreads(); relaunder(F);
        INPROJ_PART(false);
#undef INPROJ_PART
    }
    SEAM(pb);
    relaunder(F);
    if (EN(2) && IN(pb + 1)) {
        constexpr int N_SGU = 256, N_CONV = 512, N_ATT = 3072;
#define MSTAMP(i) do { if (PROBE_STAMP >= 100 && l == 0 && blockIdx.x == 0 && F.tid == 0) { const unsigned long long _t = wall_clock64(); F.MISC[900 + 2 * (i)] = (unsigned)_t; F.MISC[901 + 2 * (i)] = (unsigned)(_t >> 32); } } while (0)
        MSTAMP(0);
        if (MIX_MASK & 1) DUP(2) att_phase(F, l);
        MSTAMP(1);
        if (MIX_MASK & 2) DUP(3) for (int it = (int)blockIdx.x; it < N_CONV; it += F.G) conv_item(F, l, it);
        MSTAMP(2);
        if (MIX_MASK & 4) DUP(4) for (int it = (int)blockIdx.x; it < N_SGU; it += F.G) sgu_item(F, l, it >> 1, it & 1);
        MSTAMP(3);
#undef MSTAMP
    }
    SEAM(pb + 1);
    if (DUP_PHASE == 12 && IN(pb + 1)) {
        pg8::StaticSched S; S.init((const bf16*)(F.ws + WS_MIX), (const bf16*)(F.ws + WS_WIN) + (size_t)l * DIN * DM, SEQ, DIN, DM, F.G, (int)blockIdx.x);
        pg8::EpiProj E{(bf16*)(F.ws + WS_PROJ), 1.f};
        pg8::gemm_phase<pg8::EpiProj, pg8::StaticSched>(F.lds, DM, S, E, F.wave);
        xcd_barrier(bar);
    }
    relaunder(F);
    if (EN(3) && IN(pb + 2)) DUP(5) att_combine(F, l);
    SEAM(pb + 2);
    relaunder(F);
    if (EN(4) && IN(pb + 3)) {
        constexpr int KO = OP8(l) ? DM / 2 : DM;
        pg8::StaticSched S; S.init((const bf16*)(F.ws + WS_MIX), (const bf16*)(F.ws + WS_WOUT) + (size_t)l * DM * DM, SEQ, DM, KO, F.G, (int)blockIdx.x);
        if constexpr (l == 0) { pg8::EpiResid<false> E{(const void*)F.in[IN_X], (bf16*)(F.ws + WS_HN)}; DUP(6) pg8::gemm_phase<pg8::EpiResid<false>, pg8::StaticSched, true, OP8(l) != 0>(F.lds, KO, S, E, F.wave); }
        else { pg8::EpiResid<true> E{(const void*)(F.ws + WS_H), (bf16*)(F.ws + WS_HN)}; DUP(6) pg8::gemm_phase<pg8::EpiResid<true>, pg8::StaticSched, true, OP8(l) != 0>(F.lds, KO, S, E, F.wave); }
    }
    SEAM(pb + 3);
    relaunder(F);
    if (EN(5) && IN(pb + 4)) { router_phase(F, l); if (DUP_PHASE == 11) router_phase(F, l, 1); }
    if (DUP_PHASE == 13 && IN(pb + 4)) { for (int q = 0; q < 8; ++q) xcd_barrier(bar); }
    SEAM(pb + 4);
    relaunder(F);
    if (EN(6) && IN(pb + 5)) {
        moe_table(F, l);
        unsigned* ready = (unsigned*)(F.ws + WS_CTL) + CW_RDY + 16384 * l;
        {
            pg8::SchedG1 S{(const LAS int*)(F.lds + MISC_OFF + 64), (const int*)((const unsigned*)(F.ws + WS_CTL) + CW_CNT + 2048 * l), (const int*)(F.ws + WS_TOK), (const bf16*)(F.ws + WS_X8),
                           (const bf16*)(F.ws + WS_W1 + (size_t)l * NE * 1024 * DM), F.G, (int)blockIdx.x, ready};
            pg8::EpiSwiGLU E{F.ws + WS_HB, (const float*)(F.ws + WS_RSLOT)};
            DUP(7) pg8::gemm_phase<pg8::EpiSwiGLU, pg8::SchedG1, true, true>(F.lds, DM / 2, S, E, F.wave);
        }
        {
            pg8::SchedG2 S{(const LAS int*)(F.lds + MISC_OFF + 64), (const bf16*)(F.ws + WS_HB), (const bf16*)(F.ws + WS_W2 + (size_t)l * NE * DM * DE), F.G, (int)blockIdx.x, ready, (unsigned*)(F.ws + WS_CTL) + CW_TMO, F.wave};
            pg8::EpiY E{F.ws + WS_Y};
            DUP(8) pg8::gemm_phase<pg8::EpiY, pg8::SchedG2, true, true>(F.lds, DE / 2, S, E, F.wave);
        }
    }
    SEAM(pb + 6);
    relaunder(F);
    if (EN(8) && IN(pb + 7)) { moe_table(F, l); DUP(l == 0 ? 9 : 99) combine_phase(F, l); }
    SEAM(pb + 7);
}
__global__ void __launch_bounds__(NTHREADS, 2) fwd_kernel(Params args) {
    extern __shared__ __attribute__((aligned(16))) unsigned char lds_raw[];
    Frame F;
    F.lds = (LAS unsigned char*)lds_raw; F.MISC = (volatile LAS unsigned*)(F.lds + MISC_OFF);
    F.tid = threadIdx.x; F.lane = F.tid & 63; F.wave = __builtin_amdgcn_readfirstlane(F.tid >> 6);
    F.G = gridDim.x; { const int bx = blockIdx.x; F.vcu = (F.G % 8 == 0) ? (bx % 8) * (F.G / 8) + bx / 8 : bx; }
    F.in = args.in; F.out = args.out; F.ws = args.ws;
    for (int u = F.tid; u < (LDS_BYTES - MISC_OFF) / 4; u += NTHREADS) ((LAS unsigned*)(F.lds + MISC_OFF))[u] = 0u;
    __syncthreads();
    unsigned* ctl = (unsigned*)(args.ws + WS_CTL);
    const int lo = args.ph_lo, hi = args.ph_hi;
    const bool multi = (hi - lo) > 1;
    XcdBarrier bar; bar.bar = ctl + CW_BAR; bar.x = 0; bar.st = nullptr; bar.lead = 0;
    if (multi) bar = xcd_barrier_post(ctl + CW_BAR, F.MISC, F.wave == 0 ? 1u : 0u);
    if (PROBE_STAMP >= 0 && blockIdx.x == 0 && F.tid == 0) { const unsigned long long _t = wall_clock64(); F.MISC[800] = (unsigned)_t; F.MISC[801] = (unsigned)(_t >> 32); }
    if (EN(0) && IN(0)) { DUP(10) p_prologue(F); }
    SEAM(0);
    layer_phases<0>(F, bar, lo, hi);
    layer_phases<1>(F, bar, lo, hi);
    if (PROBE_IDLE >= 0 && blockIdx.x == 0 && F.wave == 0 && lane_now() == 0) { asm volatile("s_waitcnt vmcnt(0)" ::: "memory"); F.out[0] += (float)xb_ld((unsigned*)(F.ws + WS_CTL) + 200000) * (0.01f / 256.f); }
    if (PROBE_STAMP >= 0 && blockIdx.x == 0 && F.tid == 0) {
        asm volatile("s_waitcnt vmcnt(0)" ::: "memory");
        constexpr int SB = PROBE_STAMP >= 100 ? 900 + 2 * (PROBE_STAMP - 100) : (PROBE_STAMP == 6 ? 812 : 800 + 2 * PROBE_STAMP);
        constexpr int SB1 = (PROBE_STAMP == 6) ? SB + 4 : SB + 2;
        const unsigned long long t1 = ((unsigned long long)F.MISC[SB1 + 1] << 32) | F.MISC[SB1], t0 = ((unsigned long long)F.MISC[SB + 1] << 32) | F.MISC[SB];
        F.out[0] += (float)(long long)(t1 - t0) * 0.01f;
    }
}
#undef IN
#undef EN
#undef SEAM
#undef DUP

extern "C" void kernel_launch(void* const* d_in, const int* in_sizes, int n_in, void* d_out, int out_size, void* d_ws, size_t ws_size, hipStream_t stream) {
    static int grid = 0;
    if (grid == 0) {
        if (n_in != 22 || out_size != SEQ * DM || ws_size < WS_END) { fprintf(stderr, "kernel_launch: unexpected shapes (n_in %d out %d ws %zu, need %zu)\n", n_in, out_size, ws_size, (size_t)WS_END); grid = -1; return; }
        int dev = 0, cus = 0, per_cu = 0;
        if (hipGetDevice(&dev) != hipSuccess || hipDeviceGetAttribute(&cus, hipDeviceAttributeMultiprocessorCount, dev) != hipSuccess) { grid = -1; return; }
        if (hipFuncSetAttribute((const void*)fwd_kernel, hipFuncAttributeMaxDynamicSharedMemorySize, LDS_BYTES) != hipSuccess) { fprintf(stderr, "kernel_launch: hipFuncSetAttribute failed\n"); grid = -1; return; }
        if (hipOccupancyMaxActiveBlocksPerMultiprocessor(&per_cu, (const void*)fwd_kernel, NTHREADS, LDS_BYTES) != hipSuccess || per_cu < 1) { fprintf(stderr, "kernel_launch: occupancy query says %d\n", per_cu); }
        (void)hipGetLastError();
        grid = cus;
    }
    if (grid < 0) return;
    if (hipMemsetAsync((char*)d_ws + WS_CTL, 0, CTL_ZERO_BYTES, stream) != hipSuccess) return;
    Params p{};
    for (int i = 0; i < 22; ++i) p.in[i] = (const float*)d_in[i];
    p.out = (float*)d_out; p.ws = (unsigned char*)d_ws;
    constexpr int NL = MK_N_LAUNCHES;
    for (int li = 0; li < NL; ++li) {
        p.ph_lo = (NL == 1) ? 0 : li; p.ph_hi = (NL == 1) ? N_PHASES : li + 1;
        hipLaunchKernelGGL(fwd_kernel, dim3(grid), dim3(NTHREADS), LDS_BYTES, stream, p);
        if (hipPeekAtLastError() != hipSuccess) { fprintf(stderr, "kernel_launch: launch %d failed\n", li); break; }
    }
}
```

```cpp
#include <hip/hip_runtime.h>
#include <cstdio>
#include <cstdint>

#ifndef MK_N_LAUNCHES
#define MK_N_LAUNCHES 1
#endif

#ifndef OUTPROJ_FP8
#define OUTPROJ_FP8 2
#endif
#ifndef ATT_EXP
#define ATT_EXP 0
#endif
#define OP8(l) ((OUTPROJ_FP8 >> (l)) & 1)
#ifndef INPROJ_FP8
#define INPROJ_FP8 2
#endif
#define IP8(l) ((INPROJ_FP8 >> (l)) & 1)
#define GAS __attribute__((address_space(1)))
#define LAS __attribute__((address_space(3)))
typedef unsigned short bf16;
typedef short bf16x8 __attribute__((ext_vector_type(8)));
typedef short s16x4 __attribute__((ext_vector_type(4)));
typedef float f32x4 __attribute__((ext_vector_type(4)));
typedef float f32x2 __attribute__((ext_vector_type(2)));
typedef unsigned u32x4 __attribute__((ext_vector_type(4)));
typedef unsigned u32x2 __attribute__((ext_vector_type(2)));

constexpr int SEQ = 16384, DM = 2048, DIN = 5120, NLAYER = 2;
constexpr int HD = 128, NHEAD = 8, CONV_K = 31;
constexpr int NE = 32, DE = 512, TOKCAP = 16384;
constexpr int OFF_U = 0, OFF_V = 512, OFF_A = 1024, OFF_G = 1536, OFF_Q = 2048, OFF_K = 3072, OFF_VV = 4096;
constexpr float EPS = 1e-6f;
constexpr float W1_SCALE = 64.f, W2_SCALE = 32.f, WOUT_SCALE = 64.f, WIN_SCALE = 64.f, Y_SCALE = 16.f;
constexpr int NWAVES = 8, NTHREADS = 512;

constexpr size_t MiB = 1u << 20;
constexpr size_t WS_CTL = 0, CTL_ZERO_BYTES = 1 * MiB;
constexpr size_t WS_WIN = 1 * MiB;
constexpr size_t WS_WOUT = 41 * MiB;
constexpr size_t WS_W1 = 57 * MiB;
constexpr size_t WS_X8 = 185 * MiB;
constexpr size_t WS_W2 = 313 * MiB;
constexpr size_t WS_SGUW = 441 * MiB;
constexpr size_t WS_WRT = 442 * MiB;
constexpr size_t WS_TOK = 443 * MiB;
constexpr size_t WS_TINFO = 445 * MiB;
constexpr size_t WS_HN = 446 * MiB;
constexpr size_t WS_HB = 510 * MiB;
constexpr size_t WS_ATT = WS_HN;
constexpr size_t WS_LSE = WS_HN + 96 * MiB;
constexpr size_t WS_PROJ = 550 * MiB;
constexpr size_t WS_Y = WS_PROJ;
constexpr size_t WS_MIX = 710 * MiB;
constexpr size_t WS_H = 774 * MiB;
constexpr size_t WS_RSLOT = 902 * MiB;
constexpr size_t WS_ALT = 904 * MiB;
constexpr size_t WS_END = 910 * MiB;
constexpr int CW_BAR = 4096;
constexpr int CW_TMO = 0;
constexpr int CW_RDY = 65536;
constexpr int CW_CNT = 16384, CNT_STRIDE = 64;

constexpr int LDS_BYTES = 163840;
constexpr int MISC_OFF = 159744;

__device__ __forceinline__ unsigned cvt_pk_bf16(float lo, float hi) { unsigned r; asm volatile("v_cvt_pk_bf16_f32 %0, %1, %2" : "=v"(r) : "v"(lo), "v"(hi)); return r; }
__device__ __forceinline__ unsigned pk4_fp8(float a, float b, float c, float d) { int p = 0; p = __builtin_amdgcn_cvt_pk_fp8_f32(a, b, p, false); p = __builtin_amdgcn_cvt_pk_fp8_f32(c, d, p, true); return (unsigned)p; }
__device__ __forceinline__ float bf_lo(unsigned u) { return __builtin_bit_cast(float, u << 16); }
__device__ __forceinline__ float bf_hi(unsigned u) { return __builtin_bit_cast(float, u & 0xffff0000u); }
template <int CTRL, int RM> __device__ __forceinline__ float dpp_mov0(float v) { return __builtin_bit_cast(float, __builtin_amdgcn_update_dpp(0, __builtin_bit_cast(int, v), CTRL, RM, 0xf, false)); }
__device__ __forceinline__ float wave_sum(float s) {
    s += dpp_mov0<0xB1, 0xf>(s); s += dpp_mov0<0x4E, 0xf>(s); s += dpp_mov0<0x141, 0xf>(s); s += dpp_mov0<0x140, 0xf>(s);
    s += dpp_mov0<0x142, 0xa>(s); s += dpp_mov0<0x143, 0xc>(s);
    return __builtin_bit_cast(float, __builtin_amdgcn_readlane(__builtin_bit_cast(int, s), 63));
}
__device__ __forceinline__ float row16_sum(float s) {
    s += dpp_mov0<0xB1, 0xf>(s); s += dpp_mov0<0x4E, 0xf>(s); s += dpp_mov0<0x141, 0xf>(s); s += dpp_mov0<0x140, 0xf>(s); return s;
}
__device__ __forceinline__ float sum4(float x) {
    const unsigned xu = __builtin_bit_cast(unsigned, x); const auto r = __builtin_amdgcn_permlane16_swap(xu, xu, false, false); const unsigned r0 = r[0], r1 = r[1];
    const float a = __builtin_bit_cast(float, r0) + __builtin_bit_cast(float, r1);
    const unsigned au = __builtin_bit_cast(unsigned, a); const auto q = __builtin_amdgcn_permlane32_swap(au, au, false, false); const unsigned q0 = q[0], q1 = q[1];
    return __builtin_bit_cast(float, q0) + __builtin_bit_cast(float, q1);
}
__device__ __forceinline__ float max4(float x) {
    const unsigned xu = __builtin_bit_cast(unsigned, x); const auto r = __builtin_amdgcn_permlane16_swap(xu, xu, false, false); const unsigned r0 = r[0], r1 = r[1];
    const float a = fmaxf(__builtin_bit_cast(float, r0), __builtin_bit_cast(float, r1));
    const unsigned au = __builtin_bit_cast(unsigned, a); const auto q = __builtin_amdgcn_permlane32_swap(au, au, false, false); const unsigned q0 = q[0], q1 = q[1];
    return fmaxf(__builtin_bit_cast(float, q0), __builtin_bit_cast(float, q1));
}
__device__ __forceinline__ int lane_now() { int l; asm volatile("v_mbcnt_lo_u32_b32 %0, -1, 0\n\tv_mbcnt_hi_u32_b32 %0, -1, %0" : "=v"(l)); return l; }
#define LDS_WAIT() asm volatile("s_waitcnt lgkmcnt(0)" ::: "memory")
#define VM_WAIT() asm volatile("s_waitcnt vmcnt(0)" ::: "memory")
__device__ __forceinline__ float fast_exp(float x) { return __builtin_amdgcn_exp2f(x * 1.4426950408889634f); }
__device__ __forceinline__ float sigmoidf_(float x) { return __builtin_amdgcn_rcpf(1.0f + fast_exp(-x)); }
__device__ __forceinline__ float gelu_tanh(float x) { const float z = 1.5957691216057308f * (x + 0.044715f * x * x * x); return x * sigmoidf_(z); }

#define XB_TMO      128
#define XB_XCNT(j)  (256  + 64 * (j))
#define XB_XSUB(j)  (1280 + 64 * (j))
#define XB_XGEN(j)  (2304 + 64 * (j))
#define XB_TOP      3328
#define XB_TOPGEN   3392
#define XCD_BAR_WORDS 3456
#define XB_SPIN_CAP (1u << 22)
__device__ __forceinline__ unsigned xb_ld(unsigned* p)              { return __hip_atomic_load(p, __ATOMIC_RELAXED, __HIP_MEMORY_SCOPE_AGENT); }
__device__ __forceinline__ unsigned xb_add(unsigned* p, unsigned v) { return __hip_atomic_fetch_add(p, v, __ATOMIC_RELAXED, __HIP_MEMORY_SCOPE_AGENT); }
__device__ __forceinline__ unsigned xb_xcc_id() { return (unsigned)__builtin_amdgcn_s_getreg((3 << 11) | 20) & 0xFu; }
#define XB_SPIN(cond, bar) do { unsigned _sp = 0; while (cond) { __builtin_amdgcn_s_sleep(1); \
    if ((++_sp & 255u) == 0u) { if (xb_ld(&(bar)[XB_TMO])) break; if (_sp > XB_SPIN_CAP) { atomicAdd(&(bar)[XB_TMO], 1u); break; } } } } while (0)
struct XcdBarrier { unsigned* bar; unsigned x; volatile LAS unsigned* st; unsigned lead; };
__device__ __forceinline__ XcdBarrier xcd_barrier_post(unsigned* bar, volatile LAS unsigned* st, unsigned lead) {
    XcdBarrier b; b.bar = bar; b.x = xb_xcc_id(); b.st = st; b.lead = lead;
    if (lead && lane_now() == 0) (void)xb_add(&bar[XB_XCNT(b.x)], 1u);
    return b;
}
__device__ __forceinline__ void xcd_barrier_complete(unsigned* bar, unsigned x, unsigned& nloc, unsigned& nx) {
    const unsigned G = gridDim.x * gridDim.y * gridDim.z;
    unsigned sum, cnt, mine, sp = 0u;
    for (;;) {
        sum = 0u; cnt = 0u; mine = 0u;
#pragma unroll
        for (unsigned j = 0; j < 16; ++j) { const unsigned c = xb_ld(&bar[XB_XCNT(j)]); sum += c; cnt += (c > 0u) ? 1u : 0u; mine = (j == x) ? c : mine; }
        if (sum == G) break;
        __builtin_amdgcn_s_sleep(1);
        if ((++sp & 255u) == 0u) { if (xb_ld(&bar[XB_TMO])) break; if (sp > XB_SPIN_CAP) { atomicAdd(&bar[XB_TMO], 1u); break; } }
    }
    nloc = mine > 0u ? mine : 1u; nx = cnt > 0u ? cnt : 1u;
}
__device__ __forceinline__ void xcd_barrier(const XcdBarrier& b) {
    asm volatile("s_waitcnt vmcnt(0)" ::: "memory");
    __syncthreads();
    if (b.lead && lane_now() == 0) {
        unsigned* bar = b.bar;
        __builtin_amdgcn_s_waitcnt(0);
        unsigned nloc = b.st[0], nx = b.st[1];
        if (nloc == 0u) { xcd_barrier_complete(bar, b.x, nloc, nx); b.st[0] = nloc; b.st[1] = nx; }
        const unsigned old = xb_add(&bar[XB_XSUB(b.x)], 1u);
        const unsigned gen = old / nloc;
        if (old + 1u == (gen + 1u) * nloc) {
            __builtin_amdgcn_fence(__ATOMIC_RELEASE, "agent");
            asm volatile("s_waitcnt vmcnt(0)" ::: "memory");
            const unsigned og = xb_add(&bar[XB_TOP], 1u);
            const unsigned tg = og / nx;
            if (og + 1u == (tg + 1u) * nx) xb_add(&bar[XB_TOPGEN], 1u);
            else XB_SPIN(xb_ld(&bar[XB_TOPGEN]) == tg, bar);
            __builtin_amdgcn_fence(__ATOMIC_ACQUIRE, "agent");
            xb_add(&bar[XB_XGEN(b.x)], 1u);
            asm volatile("s_waitcnt vmcnt(0)" ::: "memory");
        } else {
            XB_SPIN(xb_ld(&bar[XB_XGEN(b.x)]) == gen, bar);
            __builtin_amdgcn_fence(__ATOMIC_ACQUIRE, "agent");
            asm volatile("s_waitcnt vmcnt(0)" ::: "memory");
        }
    }
    __syncthreads();
}

namespace pg8 {
constexpr int BM = 256, BK = 64, HALF = 128, HTB = HALF * BK * 2, STAGE_BYTES = 8 * HTB, NXCD = 8, WGM = 8;
__device__ __forceinline__ int lds_byte(int r, int c) { const int st = (r >> 4) * 2 + (c >> 5), rr = r & 15, cc = c & 31, ob = rr * 64 + cc * 2; return st * 1024 + (ob ^ (((ob >> 9) & 1) << 5)); }
__device__ __forceinline__ void stage_rc(int b, int& R, int& C) { const int st = b / 1024, sb = b % 1024, swz = sb ^ (((sb >> 9) & 1) << 5); R = (st >> 1) * 16 + swz / 64; C = (st & 1) * 32 + (swz % 64) / 2; }
__device__ __forceinline__ int perm32(int rho) { const int n = rho >> 4, i = rho & 15; return 8 * (i >> 2) + 4 * n + (i & 3); }

struct Unit { int pm, pn, e, rb; };

struct StaticSched {
    static constexpr bool GATHER = false;
    const bf16* A; const bf16* Bt; int K; int nM, nN, nwg, G, c; int i0 = 0, i1 = 0x7fffffff;
    __device__ __forceinline__ void init(const bf16* A_, const bf16* Bt_, int M, int N, int K_, int G_, int c_) { A = A_; Bt = Bt_; K = K_; nM = M / BM; nN = N / BM; nwg = nM * nN; G = G_; c = c_; }
    __device__ __forceinline__ bool next(int i, Unit& u) const {
        if (i + i0 >= i1) return false;
        const long L = (long)(i + i0) * G + c; if (L >= nwg) return false;
        int wgid = (int)L; { const int q = nwg / NXCD, r = nwg % NXCD, xcd = wgid % NXCD, off = wgid / NXCD; wgid = (xcd < r ? xcd * (q + 1) : r * (q + 1) + (xcd - r) * q) + off; }
        const int nig = WGM * nN, gid = wgid / nig, fm = gid * WGM, gsz = (nM - fm) < WGM ? (nM - fm) : WGM;
        u.pm = fm + ((wgid % nig) % gsz); u.pn = (wgid % nig) / gsz; u.e = 0; u.rb = 0; return true;
    }
    __device__ __forceinline__ void a_ready(const Unit&) const {}
    __device__ __forceinline__ void done(const Unit&) const {}
    __device__ __forceinline__ const char* a_base(const Unit& u) const { return (const char*)A + (size_t)u.pm * BM * K * 2; }
    __device__ __forceinline__ const char* b_base(const Unit& u) const { return (const char*)Bt + (size_t)u.pn * BM * K * 2; }
    __device__ __forceinline__ void a_voff(const Unit&, const int (&R)[2], const int (&C)[2], unsigned (&v)[2][2]) const {
#pragma unroll
        for (int h = 0; h < 2; ++h)
#pragma unroll
            for (int i = 0; i < 2; ++i) v[h][i] = (unsigned)((h * HALF + R[i]) * K + C[i]) * 2u;
    }
};

typedef int v8i __attribute__((ext_vector_type(8)));
typedef int v4i __attribute__((ext_vector_type(4)));
template <class Epi, class Sched, bool ALIGN_EPI = true, bool FP8 = false>
__device__ __forceinline__ void gemm_phase(LAS unsigned char* lds, const int K, const Sched& S, const Epi& E, const int wave) {
    const int lane = lane_now(), wid = wave, tid = wid * 64 + lane,
              wr = wid >> 2, wc = wid & 3, fr = lane & 15, fq = lane >> 4;
    const int nt = K / BK;
    int Rr[2], Cc[2]; unsigned voffB[2];
#pragma unroll
    for (int i = 0; i < 2; ++i) { stage_rc(tid * 16 + i * 8192, Rr[i], Cc[i]); const int Rb = Epi::PERM ? ((Rr[i] & ~31) + perm32(Rr[i] & 31)) : Rr[i];
        voffB[i] = (unsigned)(Rb * K + Cc[i]) * 2u; }
    const size_t kstep = (size_t)(BK * 2);
    const size_t hstep = (size_t)HALF * K * 2;
    const unsigned ldsw = (unsigned)wid * 1024u;
    const unsigned ldsbase = (unsigned)__builtin_amdgcn_readfirstlane((int)(unsigned)(size_t)lds);
    const int aoff = lds_byte(wr * 64 + fr, fq * 8), boff = lds_byte(wc * 32 + fr, fq * 8);
#define PG8_SA(b, h) (((b) * 2 + (h)) * HTB)
#define PG8_SB(b, h) ((4 + (b) * 2 + (h)) * HTB)
#define PG8_STAGE(bufoff, gbase, voff) do { _Pragma("unroll") for (int _i = 0; _i < 2; ++_i) { unsigned _keep; \
        asm volatile("s_mov_b32 %0, m0\n\ts_mov_b32 m0, %3\n\ts_nop 0\n\tglobal_load_lds_dwordx4 %1, %2\n\ts_mov_b32 m0, %0" : "=&s"(_keep) : "v"((voff)[_i]), "s"((const char*)(gbase)), "s"(ldsbase + (unsigned)(bufoff) + ldsw + (unsigned)(_i * 8192)) : "memory"); } } while (0)
#define PG8_LDA(dst, b, h) do { _Pragma("unroll") for (int m = 0; m < 4; ++m) _Pragma("unroll") for (int k = 0; k < 2; ++k) dst[m][k] = *(const LAS bf16x8*)(lds + PG8_SA(b, h) + aoff + m * 2048 + k * 1024); } while (0)
#define PG8_LDB(dst, b, h) do { _Pragma("unroll") for (int n = 0; n < 2; ++n) _Pragma("unroll") for (int k = 0; k < 2; ++k) dst[n][k] = *(const LAS bf16x8*)(lds + PG8_SB(b, h) + boff + n * 2048 + k * 1024); } while (0)
#define PG8_LDA8(dst, b, h) do { _Pragma("unroll") for (int m = 0; m < 4; ++m) { const v4i lo_ = *(const LAS v4i*)(lds + PG8_SA(b, h) + aoff + m * 2048), hi_ = *(const LAS v4i*)(lds + PG8_SA(b, h) + aoff + m * 2048 + 1024); dst[m] = __builtin_shufflevector(lo_, hi_, 0, 1, 2, 3, 4, 5, 6, 7); } } while (0)
#define PG8_LDB8(dst, b, h) do { _Pragma("unroll") for (int n = 0; n < 2; ++n) { const v4i lo_ = *(const LAS v4i*)(lds + PG8_SB(b, h) + boff + n * 2048), hi_ = *(const LAS v4i*)(lds + PG8_SB(b, h) + boff + n * 2048 + 1024); dst[n] = __builtin_shufflevector(lo_, hi_, 0, 1, 2, 3, 4, 5, 6, 7); } } while (0)
#define PG8_MMA(ai, bj, At, Bt) do { __builtin_amdgcn_s_setprio(1); _Pragma("unroll") for (int m = 0; m < 4; ++m) _Pragma("unroll") for (int n = 0; n < 2; ++n) _Pragma("unroll") for (int k = 0; k < 2; ++k) \
        acc[ai][bj][m][n] = __builtin_amdgcn_mfma_f32_16x16x32_bf16(Bt[n][k], At[m][k], acc[ai][bj][m][n], 0, 0, 0); __builtin_amdgcn_s_setprio(0); } while (0)
#define PG8_MMA8(ai, bj, At, Bt) do { __builtin_amdgcn_s_setprio(1); _Pragma("unroll") for (int m = 0; m < 4; ++m) _Pragma("unroll") for (int n = 0; n < 2; ++n) \
        acc[ai][bj][m][n] = __builtin_amdgcn_mfma_scale_f32_16x16x128_f8f6f4(Bt[n], At[m], acc[ai][bj][m][n], 0, 0, 0, 0, 0, 0); __builtin_amdgcn_s_setprio(0); } while (0)
#define LDA_(b, h) do { if constexpr (FP8) PG8_LDA8(At8, b, h); else PG8_LDA(At, b, h); } while (0)
#define LDB0_(b, h) do { if constexpr (FP8) PG8_LDB8(B08, b, h); else PG8_LDB(B0, b, h); } while (0)
#define LDB1_(b, h) do { if constexpr (FP8) PG8_LDB8(B18, b, h); else PG8_LDB(B1, b, h); } while (0)
#define MMA0_(ai, bj) do { if constexpr (FP8) PG8_MMA8(ai, bj, At8, B08); else PG8_MMA(ai, bj, At, B0); } while (0)
#define MMA1_(ai, bj) do { if constexpr (FP8) PG8_MMA8(ai, bj, At8, B18); else PG8_MMA(ai, bj, At, B1); } while (0)
#define PG8_WAIT_V(n) asm volatile("s_waitcnt vmcnt(" #n ")" ::: "memory")
#define PG8_WAIT_L(n) asm volatile("s_waitcnt lgkmcnt(" #n ")" ::: "memory")
#define PG8_BAR __builtin_amdgcn_s_barrier()
#define PG8_SCHED __builtin_amdgcn_sched_barrier(0)
    Unit cur, nxt; int ui = 0;
    if (!S.next(0, cur)) return;
    f32x4 acc[2][2][4][2];
#pragma unroll
    for (int a = 0; a < 2; ++a)
#pragma unroll
        for (int b = 0; b < 2; ++b)
#pragma unroll
            for (int m = 0; m < 4; ++m)
#pragma unroll
                for (int n = 0; n < 2; ++n) acc[a][b][m][n] = (f32x4){0.f, 0.f, 0.f, 0.f};
    bf16x8 At[4][2], B0[2][2], B1[2][2]; v8i At8[4], B08[2], B18[2];
    const char* cA = S.a_base(cur); const char* cB = S.b_base(cur);
    S.a_ready(cur);
    constexpr bool GATHER = Sched::GATHER;
    unsigned vA[1][2];
    LAS unsigned* goff = (LAS unsigned*)(lds + STAGE_BYTES) + tid;
    int gslot = 0;
    constexpr bool LOFF = GATHER || FP8;
    if constexpr (!GATHER && FP8) { goff[8 * 512] = voffB[0]; goff[9 * 512] = voffB[1]; goff[10 * 512] = (unsigned)(Rr[0] * K + Cc[0]) * 2u; goff[11 * 512] = (unsigned)(Rr[1] * K + Cc[1]) * 2u; }
    if constexpr (GATHER) { unsigned t4[2][2]; S.a_voff(cur, Rr, Cc, t4); goff[0 * 512] = t4[0][0]; goff[1 * 512] = t4[0][1]; goff[2 * 512] = t4[1][0]; goff[3 * 512] = t4[1][1]; goff[8 * 512] = voffB[0]; goff[9 * 512] = voffB[1]; }
    else {
#pragma unroll
        for (int i = 0; i < 2; ++i) vA[0][i] = (unsigned)(Rr[i] * K + Cc[i]) * 2u; }
    const size_t ahstep = GATHER ? 0 : hstep;
#define PG8_STAGE_B(bufoff, kptr) do { if constexpr (LOFF) { unsigned _o[2]; _o[0] = goff[8 * 512]; _o[1] = goff[9 * 512]; PG8_STAGE(bufoff, kptr, _o); } else PG8_STAGE(bufoff, kptr, voffB); } while (0)
#define PG8_STAGE_A(bufoff, kptr, h, nx) do { if constexpr (GATHER) { unsigned _o[2]; const int _s = (gslot ^ (nx)) * 2048 + (h) * 1024; _o[0] = goff[_s]; _o[1] = goff[_s + 512]; PG8_STAGE(bufoff, kptr, _o); } \
        else if constexpr (FP8) { unsigned _o[2]; _o[0] = goff[10 * 512]; _o[1] = goff[11 * 512]; PG8_STAGE(bufoff, (kptr) + (h) * ahstep, _o); } \
        else PG8_STAGE(bufoff, (kptr) + (h) * ahstep, vA[0]); } while (0)
    PG8_STAGE(PG8_SB(0, 0), cB, voffB); PG8_STAGE(PG8_SB(0, 1), cB + hstep, voffB); PG8_STAGE_A(PG8_SA(0, 0), cA, 0, 0); PG8_STAGE_A(PG8_SA(0, 1), cA, 1, 0);
    if (wr == 1) PG8_BAR;
    PG8_WAIT_V(2); PG8_BAR;
    PG8_STAGE(PG8_SB(1, 0), cB + kstep, voffB); PG8_STAGE_A(PG8_SA(1, 0), cA + kstep, 0, 0); PG8_STAGE(PG8_SB(1, 1), cB + hstep + kstep, voffB);
    PG8_WAIT_V(6); PG8_BAR;
    for (;;) {
        const bool has_next = S.next(ui + 1, nxt);
        const char* nA = has_next ? S.a_base(nxt) : cA; const char* nB = has_next ? S.b_base(nxt) : cB;
        if constexpr (GATHER) { if (has_next) { unsigned t4[2][2]; int tl_ = tid; asm volatile("" : "+v"(tl_)); int R2[2], C2[2]; stage_rc(tl_ * 16, R2[0], C2[0]); stage_rc(tl_ * 16 + 8192, R2[1], C2[1]); S.a_voff(nxt, R2, C2, t4); const int o = (gslot ^ 1) * 2048; goff[o] = t4[0][0]; goff[o + 512] = t4[0][1]; goff[o + 1024] = t4[1][0]; goff[o + 1536] = t4[1][1]; } }
#pragma unroll 1
        for (int t = 0; t < nt; t += 2) {
            const bool last = (t == nt - 2);
            const char* a1 = cA + (size_t)(t + 1) * kstep;
            const char* a2 = last ? nA : cA + (size_t)(t + 2) * kstep; const char* b2 = last ? nB : cB + (size_t)(t + 2) * kstep;
            const char* a3 = a2 + kstep; const char* b3 = b2 + kstep;
            if (last && has_next) S.a_ready(nxt);
            const int nx = (last && has_next) ? 1 : 0;
            LDB0_(0, 0); LDB1_(0, 1); PG8_SCHED; LDA_(0, 0); PG8_STAGE_A(PG8_SA(1, 1), a1, 1, 0);
            PG8_WAIT_V(8); PG8_WAIT_L(0); PG8_BAR; MMA0_(0, 0); MMA1_(0, 1); PG8_BAR; PG8_SCHED;
            LDA_(0, 1); PG8_STAGE_B(PG8_SB(0, 0), b2); PG8_STAGE_B(PG8_SB(0, 1), b2 + hstep); PG8_STAGE_A(PG8_SA(0, 0), a2, 0, nx);
            PG8_WAIT_V(8); PG8_WAIT_L(0); PG8_BAR; MMA0_(1, 0); MMA1_(1, 1); PG8_BAR; PG8_SCHED;
            LDB0_(1, 0); LDB1_(1, 1); PG8_SCHED; LDA_(1, 0); PG8_STAGE_A(PG8_SA(0, 1), a2, 1, nx);
            PG8_WAIT_V(8); PG8_WAIT_L(0); PG8_BAR; MMA0_(0, 0); MMA1_(0, 1); PG8_BAR; PG8_SCHED;
            LDA_(1, 1); PG8_STAGE_B(PG8_SB(1, 0), b3); PG8_STAGE_B(PG8_SB(1, 1), b3 + hstep); PG8_STAGE_A(PG8_SA(1, 0), a3, 0, nx);
            PG8_WAIT_V(8); PG8_WAIT_L(0); PG8_BAR; MMA0_(1, 0); MMA1_(1, 1); PG8_BAR; PG8_SCHED;
        }
        if constexpr (ALIGN_EPI) { if (wr == 0) PG8_BAR; }
        { int fr2 = fr, fq2 = fq; asm volatile("" : "+v"(fr2), "+v"(fq2));
          E(acc, cur, wr, wc, fr2, fq2); } S.done(cur);
        if (!has_next) break;
#pragma unroll
        for (int a = 0; a < 2; ++a)
#pragma unroll
            for (int b = 0; b < 2; ++b)
#pragma unroll
                for (int m = 0; m < 4; ++m)
#pragma unroll
                    for (int n = 0; n < 2; ++n) acc[a][b][m][n] = (f32x4){0.f, 0.f, 0.f, 0.f};
        cur = nxt; cA = nA; cB = nB; ++ui;
        if constexpr (GATHER) gslot ^= 1;
        if constexpr (ALIGN_EPI) { if (wr == 1) PG8_BAR; }
    }
    PG8_WAIT_V(0);
    if constexpr (!ALIGN_EPI) { if (wr == 0) PG8_BAR; }
    PG8_BAR;
#undef PG8_SA
#undef PG8_SB
#undef PG8_STAGE
#undef PG8_STAGE_A
#undef PG8_STAGE_B
#undef PG8_LDA
#undef PG8_LDB
#undef PG8_MMA
#undef PG8_MMA8
#undef PG8_LDA8
#undef PG8_LDB8
#undef LDA_
#undef LDB0_
#undef LDB1_
#undef MMA0_
#undef MMA1_
#undef PG8_WAIT_V
#undef PG8_WAIT_L
#undef PG8_BAR
#undef PG8_SCHED
}

struct EpiProj {
    static constexpr bool PERM = true;
    bf16* O; float asc;
    __device__ __forceinline__ void operator()(const f32x4 (&acc)[2][2][4][2], const Unit& u, int wr, int wc, int fr, int fq) const {
        const int row0 = u.pm * BM + wr * 64 + fr, col0 = u.pn * BM + wc * 32 + 8 * fq;
        const bool act = u.pn < 4;
#pragma unroll
        for (int ai = 0; ai < 2; ++ai)
#pragma unroll
            for (int m = 0; m < 4; ++m) { bf16* rowp = O + (size_t)(row0 + ai * HALF + m * 16) * DIN + col0;
#pragma unroll
                for (int bj = 0; bj < 2; ++bj) { f32x4 v0 = acc[ai][bj][m][0] * asc, v1 = acc[ai][bj][m][1] * asc;
                    if (act) {
#pragma unroll
                        for (int j = 0; j < 4; ++j) { v0[j] = gelu_tanh(v0[j]); v1[j] = gelu_tanh(v1[j]); } }
                    u32x4 w; w.x = cvt_pk_bf16(v0[0], v0[1]); w.y = cvt_pk_bf16(v0[2], v0[3]); w.z = cvt_pk_bf16(v1[0], v1[1]); w.w = cvt_pk_bf16(v1[2], v1[3]);
                    *(u32x4*)(rowp + bj * HALF) = w; } }
    }
};
template <bool RES_BF16> struct EpiResid {
    static constexpr bool PERM = true; static constexpr float ASC = OP8(RES_BF16 ? 1 : 0) ? 1.f / WOUT_SCALE : 1.f;
    const void* res; bf16* out;
    __device__ __forceinline__ void operator()(const f32x4 (&acc)[2][2][4][2], const Unit& u, int wr, int wc, int fr, int fq) const {
        const int row0 = u.pm * BM + wr * 64 + fr, col0 = u.pn * BM + wc * 32 + 8 * fq;
#pragma unroll
        for (int ai = 0; ai < 2; ++ai) {
            if constexpr (RES_BF16) {
                u32x4 r[4][2];
#pragma unroll
                for (int m = 0; m < 4; ++m)
#pragma unroll
                    for (int bj = 0; bj < 2; ++bj) r[m][bj] = __builtin_nontemporal_load((const u32x4*)((const bf16*)res + (size_t)(row0 + ai * HALF + m * 16) * DM + col0 + bj * HALF));
                asm volatile("s_waitcnt vmcnt(0)" ::: "memory");
#pragma unroll
                for (int m = 0; m < 4; ++m)
#pragma unroll
                    for (int bj = 0; bj < 2; ++bj) { f32x4 v0 = acc[ai][bj][m][0] * ASC, v1 = acc[ai][bj][m][1] * ASC; const u32x4 q = r[m][bj];
                        v0[0] += bf_lo(q.x); v0[1] += bf_hi(q.x); v0[2] += bf_lo(q.y); v0[3] += bf_hi(q.y); v1[0] += bf_lo(q.z); v1[1] += bf_hi(q.z); v1[2] += bf_lo(q.w); v1[3] += bf_hi(q.w);
                        u32x4 w; w.x = cvt_pk_bf16(v0[0], v0[1]); w.y = cvt_pk_bf16(v0[2], v0[3]); w.z = cvt_pk_bf16(v1[0], v1[1]); w.w = cvt_pk_bf16(v1[2], v1[3]);
                        *(u32x4*)(out + (size_t)(row0 + ai * HALF + m * 16) * DM + col0 + bj * HALF) = w; }
            } else {
#pragma unroll
                for (int mh = 0; mh < 2; ++mh) {
                    f32x4 r[2][2][2];
#pragma unroll
                    for (int m = 0; m < 2; ++m)
#pragma unroll
                        for (int bj = 0; bj < 2; ++bj) { const float* rp = (const float*)res + (size_t)(row0 + ai * HALF + (2 * mh + m) * 16) * DM + col0 + bj * HALF; r[m][bj][0] = __builtin_nontemporal_load((const f32x4*)rp); r[m][bj][1] = __builtin_nontemporal_load((const f32x4*)(rp + 4)); }
                    asm volatile("s_waitcnt vmcnt(0)" ::: "memory");
#pragma unroll
                    for (int m = 0; m < 2; ++m)
#pragma unroll
                        for (int bj = 0; bj < 2; ++bj) { const f32x4 v0 = acc[ai][bj][2 * mh + m][0] * ASC + r[m][bj][0], v1 = acc[ai][bj][2 * mh + m][1] * ASC + r[m][bj][1];
                            u32x4 w; w.x = cvt_pk_bf16(v0[0], v0[1]); w.y = cvt_pk_bf16(v0[2], v0[3]); w.z = cvt_pk_bf16(v1[0], v1[1]); w.w = cvt_pk_bf16(v1[2], v1[3]);
                            *(u32x4*)(out + (size_t)(row0 + ai * HALF + (2 * mh + m) * 16) * DM + col0 + bj * HALF) = w; }
                }
            }
        }
    }
};
struct EpiSwiGLU {
    static constexpr bool PERM = true;
    unsigned char* HB; const float* rslot;
    __device__ __forceinline__ void operator()(const f32x4 (&acc)[2][2][4][2], const Unit& u, int wr, int wc, int fr, int fq) const {
        const int row0 = u.pm * BM + wr * 64 + fr, col0 = u.pn * HALF + wc * 32 + 8 * fq;
        const __amdgpu_buffer_rsrc_t rsrc = __builtin_amdgcn_make_buffer_rsrc((void*)HB, 0, 40960 * DE, 0x00020000);
        const float* rsl = rslot + (size_t)u.e * TOKCAP + u.rb * BM + wr * 64 + fr;
#pragma unroll
        for (int ai = 0; ai < 2; ++ai) {
            float rsv[4];
#pragma unroll
            for (int m = 0; m < 4; ++m) rsv[m] = rsl[ai * HALF + m * 16];
            asm volatile("s_waitcnt vmcnt(0)" ::: "memory");
#pragma unroll
            for (int m = 0; m < 4; ++m) { const unsigned boff = (unsigned)((row0 + ai * HALF + m * 16) * DE + col0);
                const float rs = rsv[m] * (1.f / W1_SCALE);
                float h[8];
#pragma unroll
                for (int n = 0; n < 2; ++n)
#pragma unroll
                    for (int j = 0; j < 4; ++j) { const float g = acc[ai][0][m][n][j] * rs, up = acc[ai][1][m][n][j] * rs; h[n * 4 + j] = g * sigmoidf_(g) * up; }
                u32x2 w; w.x = pk4_fp8(h[0], h[1], h[2], h[3]); w.y = pk4_fp8(h[4], h[5], h[6], h[7]);
                __builtin_amdgcn_raw_buffer_store_b64(w, rsrc, boff, 0, 16); } }
    }
};
struct EpiY {
    static constexpr bool PERM = true;
    unsigned char* Y;
    __device__ __forceinline__ void operator()(const f32x4 (&acc)[2][2][4][2], const Unit& u, int wr, int wc, int fr, int fq) const {
        const int row0 = u.pm * BM + wr * 64 + fr, col0 = u.pn * BM + wc * 32 + 8 * fq;
#pragma unroll
        for (int ai = 0; ai < 2; ++ai)
#pragma unroll
            for (int m = 0; m < 4; ++m) { unsigned char* rowp = Y + (size_t)(row0 + ai * HALF + m * 16) * DM + col0;
#pragma unroll
                for (int bj = 0; bj < 2; ++bj) { const f32x4 v0 = acc[ai][bj][m][0] * (Y_SCALE / W2_SCALE), v1 = acc[ai][bj][m][1] * (Y_SCALE / W2_SCALE);
                    u32x2 w; w.x = pk4_fp8(v0[0], v0[1], v0[2], v0[3]); w.y = pk4_fp8(v1[0], v1[1], v1[2], v1[3]);
                    *(u32x2*)(rowp + bj * HALF) = w; } }
    }
};

struct SchedG1 {
    static constexpr bool GATHER = true;
    const LAS int* tstart; const int* cnt; const int* tok; const bf16* X; const bf16* W1; int G, c; unsigned* ready;
    __device__ __forceinline__ void a_ready(const Unit&) const {}
    __device__ __forceinline__ void done(const Unit& u) const {
        asm volatile("s_waitcnt vmcnt(0)" ::: "memory");
        if (lane_now() == 0) __hip_atomic_fetch_add(ready + 64 * u.pm, 1u, __ATOMIC_RELAXED, __HIP_MEMORY_SCOPE_AGENT);
    }
    __device__ __forceinline__ bool next(int i, Unit& u) const {
        const int L = i * G + c, NT = __builtin_amdgcn_readfirstlane(tstart[NE]); if (L >= NT * 4) return false;
        const int T = L >> 2; const int e = tstart[560 + T];
        u.pm = __builtin_amdgcn_readfirstlane(T); u.pn = L & 3; u.e = __builtin_amdgcn_readfirstlane(e); u.rb = __builtin_amdgcn_readfirstlane(T - tstart[e]); return true;
    }
    static constexpr int KU = DM / 2;
    __device__ __forceinline__ const char* a_base(const Unit&) const { return (const char*)X; }
    __device__ __forceinline__ const char* b_base(const Unit& u) const { return (const char*)W1 + ((size_t)u.e * 1024 + (size_t)u.pn * BM) * DM; }
    __device__ __forceinline__ void a_voff(const Unit& u, const int (&R)[2], const int (&C)[2], unsigned (&v)[2][2]) const {
        const int n = cnt[u.e * 64]; const int* tl = tok + (size_t)u.e * TOKCAP;
#pragma unroll
        for (int h = 0; h < 2; ++h)
#pragma unroll
            for (int i = 0; i < 2; ++i) { int row = u.rb * BM + h * HALF + R[i]; row = row < n ? row : 0; const int t = tl[row]; v[h][i] = (unsigned)(t * KU + C[i]) * 2u; }
    }
};
struct SchedG2 {
    static constexpr bool GATHER = false;
    const LAS int* tstart; const bf16* HB; const bf16* W2; int G, c; unsigned* ready; unsigned* tmo; int wave;
    __device__ __forceinline__ bool next(int i, Unit& u) const {
        constexpr int K0 = 3;
        const int NT = __builtin_amdgcn_readfirstlane(tstart[NE]), n1 = 4 * NT, n1max = (n1 + G - 1) / G, R = n1 - G * (n1max - 1), nB = G - R;
        int L;
        if (c >= R) L = (i < K0) ? i * nB + (c - R) : K0 * nB + (i - K0) * G + c;
        else L = K0 * nB + i * G + c;
        if (L >= NT * 8) return false;
        const int T = L >> 3; const int e = tstart[560 + T];
        u.pm = __builtin_amdgcn_readfirstlane(T); u.pn = __builtin_amdgcn_readfirstlane(L & 7); u.e = __builtin_amdgcn_readfirstlane(e); u.rb = __builtin_amdgcn_readfirstlane(T - tstart[e]); return true;
    }
    __device__ __forceinline__ void done(const Unit&) const {}
    __device__ __forceinline__ void a_ready(const Unit& u) const {
        if (wave == 0) {
            unsigned polls = 0;
            while ((unsigned)__builtin_amdgcn_readfirstlane(__hip_atomic_load(ready + 64 * u.pm, __ATOMIC_RELAXED, __HIP_MEMORY_SCOPE_AGENT)) < 32u) {
                if (++polls > (1u << 22)) { if (lane_now() == 0) __hip_atomic_store(tmo, 0x600u | (unsigned)(u.pm & 0xff), __ATOMIC_RELAXED, __HIP_MEMORY_SCOPE_AGENT); break; }
                __builtin_amdgcn_s_sleep(2); }
            __builtin_amdgcn_fence(__ATOMIC_ACQUIRE, "agent");
            asm volatile("s_waitcnt vmcnt(0)" ::: "memory");
        }
        asm volatile("" ::: "memory"); __builtin_amdgcn_s_barrier(); asm volatile("" ::: "memory");
    }
    __device__ __forceinline__ const char* a_base(const Unit& u) const { return (const char*)HB + (size_t)u.pm * BM * DE; }
    __device__ __forceinline__ const char* b_base(const Unit& u) const { return (const char*)W2 + ((size_t)u.e * DM + (size_t)u.pn * BM) * DE; }
    __device__ __forceinline__ void a_voff(const Unit&, const int (&R)[2], const int (&C)[2], unsigned (&v)[2][2]) const {
#pragma unroll
        for (int h = 0; h < 2; ++h)
#pragma unroll
            for (int i = 0; i < 2; ++i) v[h][i] = (unsigned)((h * HALF + R[i]) * DE + C[i]) * 2u;
    }
};
}

struct Params { const float* in[22]; float* out; unsigned char* ws; int ph_lo, ph_hi; };
enum { IN_X = 0, IN_NORM1, IN_WIN, IN_SGUN, IN_SGUW, IN_SGUB, IN_CONVW, IN_CONVB, IN_LNG, IN_LNB, IN_QN, IN_KN, IN_OUTN, IN_WOUT, IN_NORM2, IN_WRG, IN_BRG, IN_WRE, IN_BRE, IN_WG, IN_WU, IN_WD };

struct Frame {
    LAS unsigned char* lds; volatile LAS unsigned* MISC;
    int tid, lane, wave, vcu, G;
    const float* const* in; float* out; unsigned char* ws;
};

__device__ __forceinline__ void tile_desc(const float* const* in, unsigned char* ws, int it, const float*& src, int& ldw, unsigned char*& dst, int& pitch, const float*& ksc, float& wsc, int& fp8) {
    constexpr int T_IN = 32 * 80, T_OUT = 32 * 32, T_E = 32 * 8, T_D = 8 * 32;
    constexpr int T_LAYER = T_IN + T_OUT + NE * (2 * T_E + T_D);
    const int l = it / T_LAYER; int r = it % T_LAYER; ksc = nullptr; wsc = 1.f; fp8 = 0;
    if (r < T_IN) { ldw = DIN;
        if (IP8(l)) { const int kb = r / 160, nb = r % 160; pitch = DM; fp8 = 1; wsc = WIN_SCALE; src = in[IN_WIN] + (size_t)l * DM * DIN + (size_t)(128 * kb) * DIN + 32 * nb; dst = ws + WS_WIN + (size_t)l * DIN * DM * 2 + ((size_t)32 * nb) * DM + 128 * kb; }
        else { const int kb = r / 80, nb = r % 80; pitch = DM * 2; src = in[IN_WIN] + (size_t)l * DM * DIN + (size_t)(64 * kb) * DIN + 64 * nb; dst = ws + WS_WIN + (((size_t)l * DIN + 64 * nb) * DM + 64 * kb) * 2; }
        return; } r -= T_IN;
    if (r < T_OUT) { const int kb = r / 32, nb = r % 32; ldw = DM; src = in[IN_WOUT] + (size_t)l * DM * DM + (size_t)(64 * kb) * DM + 64 * nb;
        if (OP8(l)) { const int kb8 = r / 64, nb8 = r % 64; pitch = DM; fp8 = 1; wsc = WOUT_SCALE; src = in[IN_WOUT] + (size_t)l * DM * DM + (size_t)(128 * kb8) * DM + 32 * nb8; dst = ws + WS_WOUT + (size_t)l * DM * DM * 2 + ((size_t)32 * nb8) * DM + 128 * kb8; } else { pitch = DM * 2; dst = ws + WS_WOUT + (((size_t)l * DM + 64 * nb) * DM + 64 * kb) * 2; }
        return; } r -= T_OUT;
    const int e = r / (2 * T_E + T_D); r %= (2 * T_E + T_D);
    const size_t le = (size_t)l * NE + e; fp8 = 1;
    if (r < 2 * T_E) { const int up = r >= T_E; r -= up * T_E; const int kb = r / 16, nb = r % 16, n0 = 32 * nb; ldw = DE; pitch = DM; wsc = W1_SCALE;
        src = (up ? in[IN_WU] : in[IN_WG]) + le * DM * DE + (size_t)(128 * kb) * DE + n0; dst = ws + WS_W1 + (le * 1024 + (size_t)((n0 / 128) * 256 + up * 128 + (n0 % 128))) * DM + 128 * kb; ksc = in[IN_NORM2] + (size_t)l * DM + 128 * kb; return; }
    r -= 2 * T_E;
    { const int kb = r / 64, nb = r % 64; ldw = DM; pitch = DE; wsc = W2_SCALE; src = in[IN_WD] + le * DE * DM + (size_t)(128 * kb) * DM + 32 * nb; dst = ws + WS_W2 + (le * DM + 32 * nb) * DE + 128 * kb; }
}
#define TR_LOAD(V, src, ldw, fp8) do { if (fp8) { _Pragma("unroll") for (int i = 0; i < 16; ++i) V[i] = __builtin_nontemporal_load((const f32x4*)((src) + (size_t)(16 * (lane >> 3) + i) * (ldw) + 4 * (lane & 7))); } \
    else { _Pragma("unroll") for (int i = 0; i < 16; ++i) V[i] = __builtin_nontemporal_load((const f32x4*)((src) + (size_t)(4 * i + (lane >> 4)) * (ldw) + 4 * (lane & 15))); } } while (0)
#define TR_PROC(V, dst, pitch, ksc, wsc, fp8) do { \
    if (fp8) {        \
        f32x4 s_[4]; if (ksc) { const LAS float* kp_ = nrm + ((ksc) - nrm_g) + 16 * (lane >> 3);     \
            _Pragma("unroll") for (int q = 0; q < 4; ++q) s_[q] = *(const LAS f32x4*)(kp_ + 4 * q) * (wsc); } else { _Pragma("unroll") for (int q = 0; q < 4; ++q) s_[q] = (f32x4){(wsc), (wsc), (wsc), (wsc)}; } \
        _Pragma("unroll") for (int c = 0; c < 4; ++c) { u32x4 o; \
            _Pragma("unroll") for (int q = 0; q < 4; ++q) o[q] = pk4_fp8(V[4 * q][c] * s_[q][0], V[4 * q + 1][c] * s_[q][1], V[4 * q + 2][c] * s_[q][2], V[4 * q + 3][c] * s_[q][3]); \
            __builtin_nontemporal_store(o, (u32x4*)((dst) + (size_t)(4 * (lane & 7) + c) * (pitch) + 16 * (lane >> 3))); }     \
    } else { \
        _Pragma("unroll") for (int i = 0; i < 16; ++i) { const int kk = 4 * i + (lane >> 4); f32x4 v = V[i] * ((ksc) ? (ksc)[kk] * (wsc) : (wsc)); \
            LAS float* d = scr + kk * 65 + 4 * (lane & 15); d[0] = v[0]; d[1] = v[1]; d[2] = v[2]; d[3] = v[3]; } \
        LDS_WAIT(); \
        _Pragma("unroll") for (int j = 0; j < 8; ++j) { const int n = (lane >> 3) + 8 * j; const LAS float* sp = scr + (8 * (lane & 7)) * 65 + n; \
            u32x4 o; o.x = cvt_pk_bf16(sp[0], sp[65]); o.y = cvt_pk_bf16(sp[2 * 65], sp[3 * 65]); o.z = cvt_pk_bf16(sp[4 * 65], sp[5 * 65]); o.w = cvt_pk_bf16(sp[6 * 65], sp[7 * 65]); \
            *(u32x4*)((dst) + (size_t)n * (pitch) + 16 * (lane & 7)) = o; } } \
    LDS_WAIT(); } while (0)
__device__ __forceinline__ void norm_row_bf16(const float* xrow, const float* g, bf16* orow, int lane) {
    f32x4 v[8]; float s = 0.f;
#pragma unroll
    for (int j = 0; j < 8; ++j) { v[j] = __builtin_nontemporal_load((const f32x4*)(xrow + 4 * lane + 256 * j)); s += (v[j][0] * v[j][0] + v[j][1] * v[j][1]) + (v[j][2] * v[j][2] + v[j][3] * v[j][3]); }
    const float rs = __builtin_amdgcn_rsqf(wave_sum(s) * (1.f / DM) + EPS);
#pragma unroll
    for (int j = 0; j < 8; ++j) { const f32x4 gg = *(const f32x4*)(g + 4 * lane + 256 * j);
        u32x2 o; o.x = cvt_pk_bf16(v[j][0] * rs * gg[0], v[j][1] * rs * gg[1]); o.y = cvt_pk_bf16(v[j][2] * rs * gg[2], v[j][3] * rs * gg[3]);
        *(u32x2*)(orow + 4 * lane + 256 * j) = o; }
}
constexpr int CV_P = 2560, CV_A = 28160 + 3584, CV_B = 2 * 28160;
__device__ __forceinline__ void convert_tiles(Frame& F, const int t_lo, const int T_TOTAL) {
    LAS float* scr = (LAS float*)(F.lds + F.wave * 16896);
    const int gw = F.vcu * NWAVES + F.wave, NGW = F.G * NWAVES, lane = F.lane;
    LAS float* nrm = (LAS float*)(F.lds + 8 * 16896); const float* nrm_g = F.in[IN_NORM2];
    for (int u = F.tid; u < NLAYER * DM; u += NTHREADS) nrm[u] = nrm_g[u];
    __syncthreads();
    {
        f32x4 va[16], vb[16];
        const float* srcA; const float* srcB; unsigned char* dstA; unsigned char* dstB; const float* kA; const float* kB; int ldA, ldB, pA, pB, fA, fB; float wA, wB;
#define CV_TIDX(q) (t_lo + (((((q) >> 1) * F.G + F.vcu) << 4) | (((q) & 1) << 3) | F.wave))
        int q = 0; const int last = T_TOTAL - 1;
        { const int i0 = CV_TIDX(0) < last ? CV_TIDX(0) : last; tile_desc(F.in, F.ws, i0, srcA, ldA, dstA, pA, kA, wA, fA); TR_LOAD(va, srcA, ldA, fA); }
        while (CV_TIDX(q + 1) < T_TOTAL) {
            tile_desc(F.in, F.ws, CV_TIDX(q + 1), srcB, ldB, dstB, pB, kB, wB, fB); TR_LOAD(vb, srcB, ldB, fB);
            TR_PROC(va, dstA, pA, kA, wA, fA);
            { const int i2 = CV_TIDX(q + 2) < last ? CV_TIDX(q + 2) : last; tile_desc(F.in, F.ws, i2, srcA, ldA, dstA, pA, kA, wA, fA); TR_LOAD(va, srcA, ldA, fA); }
            TR_PROC(vb, dstB, pB, kB, wB, fB);
            q += 2;
        }
        if (CV_TIDX(q) < T_TOTAL) TR_PROC(va, dstA, pA, kA, wA, fA);
#undef CV_TIDX
    }
}
__device__ __forceinline__ void p_prologue(Frame& F) {
    const int gw = F.vcu * NWAVES + F.wave, NGW = F.G * NWAVES;
    convert_tiles(F, 0, CV_P);
    { bf16* SW = (bf16*)(F.ws + WS_SGUW); const int gt = gw * 64 + F.lane, NGT = NGW * 64;
      for (int idx = gt; idx < NLAYER * 4 * 8 * 4 * 64; idx += NGT) {
          const int ln = idx & 63, pp = (idx >> 6) & 3, itile = (idx >> 8) & 7, h = (idx >> 11) & 3, l = idx >> 13;
          const int i = 16 * itile + (ln & 15), gq = ln >> 4;
          const float* w = F.in[IN_SGUW] + ((size_t)(l * 4 + h) * 128 + i) * 128;
          float v[8];
#pragma unroll
          for (int jj = 0; jj < 8; ++jj) { const int j = 32 * pp + (jj < 4 ? 4 * gq + jj : 16 + 4 * gq + (jj - 4)); v[jj] = (j <= i) ? w[j] : 0.f; }
          u32x4 o; o.x = cvt_pk_bf16(v[0], v[1]); o.y = cvt_pk_bf16(v[2], v[3]); o.z = cvt_pk_bf16(v[4], v[5]); o.w = cvt_pk_bf16(v[6], v[7]);
          *(u32x4*)(SW + (size_t)idx * 8) = o; }
      bf16* WRF = (bf16*)(F.ws + WS_WRT);
      for (int idx = gt; idx < NLAYER * 64 * 3 * 64; idx += NGT) { const int ln = idx & 63, ct = (idx >> 6) % 3, ks = (idx / 192) & 63, l = idx / (192 * 64);
          const int o = 16 * ct + (ln & 15), k0 = 32 * ks + 8 * (ln >> 4);
          float v[8];
#pragma unroll
          for (int j = 0; j < 8; ++j) { const int k = k0 + j; const float wv = o < 32 ? F.in[IN_WRE][((size_t)l * DM + k) * NE + o] : (o < 36 ? F.in[IN_WRG][((size_t)l * DM + k) * 4 + (o - 32)] : 0.f);
              v[j] = wv * F.in[IN_NORM2][(size_t)l * DM + k]; }
          u32x4 hi, lo; hi.x = cvt_pk_bf16(v[0], v[1]); hi.y = cvt_pk_bf16(v[2], v[3]); hi.z = cvt_pk_bf16(v[4], v[5]); hi.w = cvt_pk_bf16(v[6], v[7]);
          lo.x = cvt_pk_bf16(v[0] - bf_lo(hi.x), v[1] - bf_hi(hi.x)); lo.y = cvt_pk_bf16(v[2] - bf_lo(hi.y), v[3] - bf_hi(hi.y));
          lo.z = cvt_pk_bf16(v[4] - bf_lo(hi.z), v[5] - bf_hi(hi.z)); lo.w = cvt_pk_bf16(v[6] - bf_lo(hi.w), v[7] - bf_hi(hi.w));
          bf16* dst = WRF + ((((size_t)l * 64 + ks) * 3 + ct) * 2 * 64 + ln) * 8;
          *(u32x4*)dst = hi; *(u32x4*)(dst + 512) = lo; } }
    bf16* HN = (bf16*)(F.ws + WS_HN);
    for (int m = gw; m < SEQ; m += NGW) norm_row_bf16(F.in[IN_X] + (size_t)m * DM, F.in[IN_NORM1], HN + (size_t)m * DM, F.lane);
}

__device__ __forceinline__ int vimg_off(int row, int c) { return row * 256 + ((((c >> 1) ^ (row & 7)) << 1) | (c & 1)) * 16; }
__device__ __forceinline__ bf16x8 tr_frag(const LAS unsigned char* img, int ra, int rb, int dt, int lane) {
    const int gq = lane >> 4, q = (lane & 15) >> 2, p = lane & 3;
    const int r0 = ra + 4 * gq + q, r1 = rb + 4 * gq + q, c = 2 * dt + (p >> 1);
    const s16x4 a = __builtin_amdgcn_ds_read_tr16_b64_v4i16((LAS s16x4*)(img + vimg_off(r0, c) + 8 * (p & 1)));
    const s16x4 b = __builtin_amdgcn_ds_read_tr16_b64_v4i16((LAS s16x4*)(img + vimg_off(r1, c) + 8 * (p & 1)));
    bf16x8 r; r[0] = a[0]; r[1] = a[1]; r[2] = a[2]; r[3] = a[3]; r[4] = b[0]; r[5] = b[1]; r[6] = b[2]; r[7] = b[3]; return r;
}
__device__ __forceinline__ void sgu_stage8(const bf16* vsrc, int j0, int w, int lane, const f32x4& g0, const f32x4& g1, LAS unsigned char* lds) {
    u32x4 raw[8];
#pragma unroll
    for (int j = 0; j < 8; ++j) raw[j] = *(const u32x4*)(vsrc + (size_t)(w + 8 * (j0 + j)) * DIN);
#pragma unroll
    for (int j = 0; j < 8; ++j) { const int row = w + 8 * (j0 + j);
        float x[8] = {bf_lo(raw[j].x), bf_hi(raw[j].x), bf_lo(raw[j].y), bf_hi(raw[j].y), bf_lo(raw[j].z), bf_hi(raw[j].z), bf_lo(raw[j].w), bf_hi(raw[j].w)};
        float s = 0.f;
#pragma unroll
        for (int e = 0; e < 8; ++e) s += x[e] * x[e];
        const float rs = __builtin_amdgcn_rsqf(wave_sum(s) * (1.f / 512.f) + EPS);
        u32x4 o; o.x = cvt_pk_bf16(x[0] * rs * g0[0], x[1] * rs * g0[1]); o.y = cvt_pk_bf16(x[2] * rs * g0[2], x[3] * rs * g0[3]);
        o.z = cvt_pk_bf16(x[4] * rs * g1[0], x[5] * rs * g1[1]); o.w = cvt_pk_bf16(x[6] * rs * g1[2], x[7] * rs * g1[3]);
        *(LAS u32x4*)(lds + (lane >> 4) * 32768 + vimg_off(row, lane & 15)) = o; }
}
__device__ __forceinline__ void sgu_item(Frame& F, int l, int chunk, int half) {
    const bf16* PROJ = (const bf16*)(F.ws + WS_PROJ); bf16* MIX = (bf16*)(F.ws + WS_MIX);
    const int p0 = chunk * 128, lane = F.lane, w = F.wave;
    LAS float* red = (LAS float*)(F.lds + MISC_OFF + 256);
    const float* gn = F.in[IN_SGUN] + l * 512;
    const f32x4 g0 = *(const f32x4*)(gn + 8 * lane), g1 = *(const f32x4*)(gn + 8 * lane + 4);
    const bf16* vsrc = PROJ + (size_t)p0 * DIN + OFF_V + 8 * lane;
    sgu_stage8(vsrc, 0, w, lane, g0, g1, F.lds);
    if (half) sgu_stage8(vsrc, 8, w, lane, g0, g1, F.lds);
    const int h = w >> 1, ih = w & 1, gq = lane >> 4, fr = lane & 15;
    const LAS unsigned char* img = F.lds + h * 32768;
    const bf16* SW = (const bf16*)(F.ws + WS_SGUW) + (size_t)(l * 4 + h) * 8 * 4 * 64 * 8;
    const float* bs = F.in[IN_SGUB] + (size_t)(l * 4 + h) * 128;
    const float* og = F.in[IN_OUTN] + (size_t)l * DM + h * 128 + 4 * gq;
    const int it0 = ih + 4 * half;
    u32x2 ur[2][8];
#pragma unroll
    for (int ii = 0; ii < 2; ++ii) { const bf16* urow = PROJ + (size_t)(p0 + 16 * (it0 + 2 * ii) + fr) * DIN + OFF_U + h * 128 + 4 * gq;
#pragma unroll
        for (int dt = 0; dt < 8; ++dt) ur[ii][dt] = *(const u32x2*)(urow + 16 * dt); }
    __syncthreads();
    f32x4 z[2][8];
#pragma unroll
    for (int ii = 0; ii < 2; ++ii)
#pragma unroll
        for (int dt = 0; dt < 8; ++dt) z[ii][dt] = (f32x4){0.f, 0.f, 0.f, 0.f};
#pragma unroll 1
    for (int pp = 0; pp <= (it0 + 2) / 2; ++pp) {
        const bf16x8 bw0 = *(const bf16x8*)(SW + ((size_t)(it0 * 4 + pp) * 64 + lane) * 8);
        const bf16x8 bw1 = *(const bf16x8*)(SW + ((size_t)((it0 + 2) * 4 + pp) * 64 + lane) * 8);
        const bool do0 = pp <= it0 / 2;
#pragma unroll
        for (int dt = 0; dt < 8; ++dt) { const bf16x8 a = tr_frag(img, 32 * pp, 32 * pp + 16, dt, lane);
            if (do0) z[0][dt] = __builtin_amdgcn_mfma_f32_16x16x32_bf16(a, bw0, z[0][dt], 0, 0, 0);
            z[1][dt] = __builtin_amdgcn_mfma_f32_16x16x32_bf16(a, bw1, z[1][dt], 0, 0, 0); }
    }
#pragma unroll
    for (int ii = 0; ii < 2; ++ii) { const int i = 16 * (it0 + 2 * ii) + fr; const float bi = bs[i]; float s = 0.f;
#pragma unroll
        for (int dt = 0; dt < 8; ++dt) { const u32x2 u2 = ur[ii][dt];
            f32x4 y; y[0] = bf_lo(u2.x) * (z[ii][dt][0] + bi); y[1] = bf_hi(u2.x) * (z[ii][dt][1] + bi); y[2] = bf_lo(u2.y) * (z[ii][dt][2] + bi); y[3] = bf_hi(u2.y) * (z[ii][dt][3] + bi);
            z[ii][dt] = y; s += (y[0] * y[0] + y[1] * y[1]) + (y[2] * y[2] + y[3] * y[3]); }
        s += __shfl_xor(s, 16); s += __shfl_xor(s, 32);
        if (gq == 0) red[i * 4 + h] = s; }
    __syncthreads();
#pragma unroll
    for (int ii = 0; ii < 2; ++ii) { const int i = 16 * (it0 + 2 * ii) + fr;
        const f32x4 rr = *(const LAS f32x4*)(red + i * 4);
        const float rs = __builtin_amdgcn_rsqf(((rr[0] + rr[1]) + (rr[2] + rr[3])) * (1.f / 512.f) + EPS);
        bf16* orow = MIX + (size_t)(p0 + i) * DM + h * 128 + 4 * gq;
#pragma unroll
        for (int dt = 0; dt < 8; ++dt) { const f32x4 gg = *(const f32x4*)(og + 16 * dt); const f32x4 y = z[ii][dt];
            if (OP8(l)) *(unsigned*)((unsigned char*)MIX + (size_t)(p0 + i) * DM + h * 128 + 4 * gq + 16 * dt) = pk4_fp8(y[0] * rs * gg[0], y[1] * rs * gg[1], y[2] * rs * gg[2], y[3] * rs * gg[3]);
            else { u32x2 o; o.x = cvt_pk_bf16(y[0] * rs * gg[0], y[1] * rs * gg[1]); o.y = cvt_pk_bf16(y[2] * rs * gg[2], y[3] * rs * gg[3]);
            *(u32x2*)(orow + 16 * dt) = o; } } }
    __syncthreads();
}

__device__ __forceinline__ void conv_item(Frame& F, int l, int tile) {
    const bf16* PROJ = (const bf16*)(F.ws + WS_PROJ); bf16* MIX = (bf16*)(F.ws + WS_MIX);
    constexpr int TP = 32, NR = TP + 30;
    const int p0 = tile * TP, c = F.tid, tid = F.tid;
    LAS float* cbuf = (LAS float*)F.lds;
    LAS bf16* zbuf = (LAS bf16*)(F.lds + 65536);
    { u32x4 av[8], gv[8];
#pragma unroll
      for (int i = 0; i < 8; ++i) { const int id = tid + NTHREADS * i, row = id >> 6, ch = (id & 63) * 8; int p = p0 - 30 + row; p = p < 0 ? 0 : p; p = row < NR ? p : 0;
          av[i] = *(const u32x4*)(PROJ + (size_t)p * DIN + OFF_A + ch); gv[i] = *(const u32x4*)(PROJ + (size_t)p * DIN + OFF_G + ch); }
#pragma unroll
      for (int i = 0; i < 8; ++i) { const int id = tid + NTHREADS * i, row = id >> 6, ch = (id & 63) * 8; const bool live = (p0 - 30 + row) >= 0;
          const unsigned au[4] = {av[i].x, av[i].y, av[i].z, av[i].w}, gu[4] = {gv[i].x, gv[i].y, gv[i].z, gv[i].w}; u32x4 o; unsigned ou[4];
#pragma unroll
          for (int e = 0; e < 4; ++e) { const float z0 = bf_lo(au[e]) * sigmoidf_(bf_lo(gu[e])), z1 = bf_hi(au[e]) * sigmoidf_(bf_hi(gu[e])); ou[e] = live ? cvt_pk_bf16(z0, z1) : 0u; }
          o.x = ou[0]; o.y = ou[1]; o.z = ou[2]; o.w = ou[3];
          if (row < NR) *(LAS u32x4*)(zbuf + row * 512 + ch) = o; } }
    float wk[CONV_K];
#pragma unroll
    for (int k = 0; k < CONV_K; ++k) wk[k] = F.in[IN_CONVW][((size_t)l * CONV_K + k) * 512 + c];
    const float cb = F.in[IN_CONVB][l * 512 + c];
    __syncthreads();
#define CONV_Z(r) __builtin_bit_cast(float, (unsigned)zbuf[(r) * 512 + c] << 16)
    float win[30];
#pragma unroll
    for (int r = 0; r < 30; ++r) win[r] = CONV_Z(r);
#pragma unroll
    for (int q = 0; q < TP; ++q) { const float zv = CONV_Z(30 + q); float acc = cb + wk[30] * zv;
#pragma unroll
        for (int k = 0; k < 30; ++k) acc += wk[k] * win[(k + q) % 30];
        win[q % 30] = zv; cbuf[q * 512 + c] = acc; }
#undef CONV_Z
    __syncthreads();
    const float* lg = F.in[IN_LNG] + l * 512 + 8 * F.lane; const float* lb = F.in[IN_LNB] + l * 512 + 8 * F.lane; const float* og = F.in[IN_OUTN] + (size_t)l * DM + 512 + 8 * F.lane;
    const f32x4 lg0 = *(const f32x4*)lg, lg1 = *(const f32x4*)(lg + 4), lb0 = *(const f32x4*)lb, lb1 = *(const f32x4*)(lb + 4), og0 = *(const f32x4*)og, og1 = *(const f32x4*)(og + 4);
    for (int r = F.wave; r < TP; r += NWAVES) {
        const f32x4 a0 = *(const LAS f32x4*)(cbuf + r * 512 + 8 * F.lane), a1 = *(const LAS f32x4*)(cbuf + r * 512 + 8 * F.lane + 4);
        float x[8] = {a0[0], a0[1], a0[2], a0[3], a1[0], a1[1], a1[2], a1[3]};
        float s = 0.f;
#pragma unroll
        for (int e = 0; e < 8; ++e) s += x[e];
        const float mu = wave_sum(s) * (1.f / 512.f); float q2 = 0.f;
#pragma unroll
        for (int e = 0; e < 8; ++e) { x[e] -= mu; q2 += x[e] * x[e]; }
        const float rstd = __builtin_amdgcn_rsqf(wave_sum(q2) * (1.f / 512.f) + EPS);
        const float gam[8] = {lg0[0], lg0[1], lg0[2], lg0[3], lg1[0], lg1[1], lg1[2], lg1[3]}, bet[8] = {lb0[0], lb0[1], lb0[2], lb0[3], lb1[0], lb1[1], lb1[2], lb1[3]};
        float s2 = 0.f;
#pragma unroll
        for (int e = 0; e < 8; ++e) { const float y = x[e] * rstd * gam[e] + bet[e]; x[e] = y * sigmoidf_(y); s2 += x[e] * x[e]; }
        const float rs = __builtin_amdgcn_rsqf(wave_sum(s2) * (1.f / 512.f) + EPS);
        if (OP8(l)) { u32x2 o8; o8.x = pk4_fp8(x[0] * rs * og0[0], x[1] * rs * og0[1], x[2] * rs * og0[2], x[3] * rs * og0[3]); o8.y = pk4_fp8(x[4] * rs * og1[0], x[5] * rs * og1[1], x[6] * rs * og1[2], x[7] * rs * og1[3]);
            *(u32x2*)((unsigned char*)MIX + (size_t)(p0 + r) * DM + 512 + 8 * F.lane) = o8; }
        else {
        u32x4 o; o.x = cvt_pk_bf16(x[0] * rs * og0[0], x[1] * rs * og0[1]); o.y = cvt_pk_bf16(x[2] * rs * og0[2], x[3] * rs * og0[3]);
        o.z = cvt_pk_bf16(x[4] * rs * og1[0], x[5] * rs * og1[1]); o.w = cvt_pk_bf16(x[6] * rs * og1[2], x[7] * rs * og1[3]);
        *(u32x4*)(MIX + (size_t)(p0 + r) * DM + 512 + 8 * F.lane) = o; }
    }
    __syncthreads();
}

__device__ __forceinline__ int kimg_off(int row, int c) { return row * 256 + ((c ^ (row & 15)) << 4); }
__device__ __forceinline__ bf16x8 tr_frag2(const LAS unsigned char* vs, int ta, int tb, int dt, int lane) {
    const int gq = lane >> 4, q = (lane & 15) >> 2, p = lane & 3, c = 2 * dt + (p >> 1), rr = 4 * gq + q;
    const int off = rr * 256 + ((((c >> 1) ^ (rr & 7)) << 1) | (c & 1)) * 16 + 8 * (p & 1);
    const s16x4 a = __builtin_amdgcn_ds_read_tr16_b64_v4i16((LAS s16x4*)(vs + ta + off));
    const s16x4 b = __builtin_amdgcn_ds_read_tr16_b64_v4i16((LAS s16x4*)(vs + tb + off));
    bf16x8 r; r[0] = a[0]; r[1] = a[1]; r[2] = a[2]; r[3] = a[3]; r[4] = b[0]; r[5] = b[1]; r[6] = b[2]; r[7] = b[3]; return r;
}
#define ATT_DECODE(st) const int B_ = att_b0 + (st) - att_pre; const int b_ = (att_pre && (st) == 0) ? -1 : 0; const int g = B_ >> 10, h = (B_ >> 7) & 7, j_ = B_ & 127; \
    const int sh = 2 * g, dil = 1 << sh; const int r = j_ >> (7 - sh), nb = j_ & ((128 >> sh) - 1)
#define ATT_LOAD(st) do { if (ATT_EXP == 2) break; ATT_DECODE(st); const int cc = tid & 15; \
    _Pragma("unroll") for (int j = 0; j < 4; ++j) { const int row = (tid >> 4) + 32 * j; int ms = nb * 128 + row; ms = ms < 0 ? 0 : ms; const size_t pos = (size_t)ms * dil + r; \
        kr[j] = *(const u32x4*)(PROJ + pos * DIN + OFF_K + h * HD + 8 * cc); vr[j] = *(const u32x4*)(PROJ + pos * DIN + OFF_VV + h * HD + 8 * cc); } \
    if (b_ >= 0) { const size_t qpos_ = (size_t)(nb * 128 + 16 * w + (lane & 15)) * dil + r; \
        _Pragma("unroll") for (int ks = 0; ks < 4; ++ks) qr[ks] = *(const u32x4*)(PROJ + qpos_ * DIN + OFF_Q + h * HD + 32 * ks + 8 * (lane >> 4)); } } while (0)
__device__ __forceinline__ void att_phase(Frame& F, int l) {
    const bf16* PROJ = (const bf16*)(F.ws + WS_PROJ);
    bf16* ATT = (bf16*)(F.ws + WS_ATT); float* LSE = (float*)(F.ws + WS_LSE);
    const int lane = F.lane, w = F.wave, tid = F.tid, fr = lane & 15, gq = lane >> 4;
    LAS unsigned char* Ks = F.lds; LAS unsigned char* Vs = F.lds + 65536;
    const int att_per = (3072 + F.G - 1) / F.G, att_b0 = (int)blockIdx.x * att_per, att_n = (3072 - att_b0) < att_per ? (3072 - att_b0) : att_per;
    const int att_pre = (att_n > 0 && ((att_b0 & 127) & ((128 >> (2 * (att_b0 >> 10))) - 1)) != 0) ? 1 : 0;
    const int nsteps = att_n > 0 ? att_n + att_pre : 0;
    u32x4 kr[4], vr[4], qr[4];
    if (ATT_EXP == 2) { for (int j = 0; j < 4; ++j) { kr[j] = (u32x4){0x3f803f80u + (unsigned)tid, 0x3f003f80u, 0x3f803f00u, 0x3e803f80u}; vr[j] = kr[j]; qr[j] = kr[j]; } }
    if (nsteps > 0) ATT_LOAD(0);
    const int cc = tid & 15;
    const float* kgp = F.in[IN_KN] + l * HD + 8 * cc;
    const f32x4 kg0 = *(const f32x4*)kgp, kg1 = *(const f32x4*)(kgp + 4);
    for (int st = 0; st < nsteps; ++st) {
        ATT_DECODE(st);
        const int slot = st & 1, curoff = slot * 32768, prevoff = 32768 - curoff;
#pragma unroll
        for (int j = 0; j < 4; ++j) { const int row = (tid >> 4) + 32 * j;
            const u32x4 k4 = kr[j];
            float x[8] = {bf_lo(k4.x), bf_hi(k4.x), bf_lo(k4.y), bf_hi(k4.y), bf_lo(k4.z), bf_hi(k4.z), bf_lo(k4.w), bf_hi(k4.w)};
            float sq = 0.f;
#pragma unroll
            for (int e = 0; e < 8; ++e) sq += x[e] * x[e];
            const float rs = __builtin_amdgcn_rsqf(row16_sum(sq) * (1.f / HD) + EPS);
            u32x4 o; o.x = cvt_pk_bf16(x[0] * rs * kg0[0], x[1] * rs * kg0[1]); o.y = cvt_pk_bf16(x[2] * rs * kg0[2], x[3] * rs * kg0[3]);
            o.z = cvt_pk_bf16(x[4] * rs * kg1[0], x[5] * rs * kg1[1]); o.w = cvt_pk_bf16(x[6] * rs * kg1[2], x[7] * rs * kg1[3]);
            *(LAS u32x4*)(Ks + curoff + kimg_off(row, cc)) = o;
            *(LAS u32x4*)(Vs + curoff + vimg_off(row, cc)) = vr[j]; }
        const int iq = 16 * w + fr; const size_t qpos = (size_t)(nb * 128 + iq) * dil + r;
        bf16x8 qf[4];
        if (b_ >= 0) { float x[4][8]; float sq = 0.f;
#pragma unroll
          for (int ks = 0; ks < 4; ++ks) { const u32x4 q4 = qr[ks];
              x[ks][0] = bf_lo(q4.x); x[ks][1] = bf_hi(q4.x); x[ks][2] = bf_lo(q4.y); x[ks][3] = bf_hi(q4.y); x[ks][4] = bf_lo(q4.z); x[ks][5] = bf_hi(q4.z); x[ks][6] = bf_lo(q4.w); x[ks][7] = bf_hi(q4.w);
#pragma unroll
              for (int e = 0; e < 8; ++e) sq += x[ks][e] * x[ks][e]; }
          sq = sum4(sq);
          const float rs = __builtin_amdgcn_rsqf(sq * (1.f / HD) + EPS) * 0.12751743f;
#pragma unroll
          for (int ks = 0; ks < 4; ++ks) { const float* qg = F.in[IN_QN] + l * HD + 32 * ks + 8 * gq; const f32x4 q0 = *(const f32x4*)qg, q1 = *(const f32x4*)(qg + 4);
              u32x4 o; o.x = cvt_pk_bf16(x[ks][0] * rs * q0[0], x[ks][1] * rs * q0[1]); o.y = cvt_pk_bf16(x[ks][2] * rs * q0[2], x[ks][3] * rs * q0[3]);
              o.z = cvt_pk_bf16(x[ks][4] * rs * q1[0], x[ks][5] * rs * q1[1]); o.w = cvt_pk_bf16(x[ks][6] * rs * q1[2], x[ks][7] * rs * q1[3]);
              qf[ks] = __builtin_bit_cast(bf16x8, o); } }
        __syncthreads();
        if (st + 1 < nsteps) ATT_LOAD(st + 1);
        if (b_ >= 0 && ATT_EXP != 1) {
        f32x4 sc[10];
#pragma unroll
        for (int kt = 0; kt < 9; ++kt) { sc[kt] = (f32x4){0.f, 0.f, 0.f, 0.f}; const int T = w + kt; const int kbase = (T < 8 ? prevoff : curoff); const int krow = 16 * (T & 7) + fr;
#pragma unroll
            for (int ks = 0; ks < 4; ++ks) { const bf16x8 kf = *(const LAS bf16x8*)(Ks + kbase + kimg_off(krow, 4 * ks + gq));
                sc[kt] = __builtin_amdgcn_mfma_f32_16x16x32_bf16(kf, qf[ks], sc[kt], 0, 0, 0); } }
#pragma unroll
        for (int e = 0; e < 4; ++e) { sc[0][e] = (4 * gq + e >= fr) ? sc[0][e] : -INFINITY; sc[8][e] = (4 * gq + e <= fr) ? sc[8][e] : -INFINITY; }
        if (nb == 0) {
#pragma unroll
            for (int kt = 0; kt < 8; ++kt) if (w + kt < 8) sc[kt] = (f32x4){-INFINITY, -INFINITY, -INFINITY, -INFINITY}; }
        float mx = -INFINITY;
#pragma unroll
        for (int kt = 0; kt < 9; ++kt) mx = fmaxf(fmaxf(mx, fmaxf(sc[kt][0], sc[kt][1])), fmaxf(sc[kt][2], sc[kt][3]));
        mx = max4(mx);
        float sum = 0.f;
#pragma unroll
        for (int kt = 0; kt < 9; ++kt)
#pragma unroll
            for (int e = 0; e < 4; ++e) { const float p = __builtin_amdgcn_exp2f(sc[kt][e] - mx); sc[kt][e] = p; sum += p; }
        sc[9] = (f32x4){0.f, 0.f, 0.f, 0.f};
        sum = sum4(sum);
        bf16x8 pf[5];
#pragma unroll
        for (int pp = 0; pp < 5; ++pp) { u32x4 o; o.x = cvt_pk_bf16(sc[2 * pp][0], sc[2 * pp][1]); o.y = cvt_pk_bf16(sc[2 * pp][2], sc[2 * pp][3]); o.z = cvt_pk_bf16(sc[2 * pp + 1][0], sc[2 * pp + 1][1]); o.w = cvt_pk_bf16(sc[2 * pp + 1][2], sc[2 * pp + 1][3]);
            pf[pp] = __builtin_bit_cast(bf16x8, o); }
        const float inv = __builtin_amdgcn_rcpf(sum);
        bf16* orow = ATT + ((size_t)g * SEQ + qpos) * 1024 + h * HD + 4 * gq;
        int toff[10];
#pragma unroll
        for (int kt = 0; kt < 10; ++kt) { const int T = (w + kt) < 15 ? (w + kt) : 15; toff[kt] = (T < 8 ? prevoff : curoff) + (T & 7) * 16 * 256; }
#pragma unroll
        for (int dt = 0; dt < 8; ++dt) { f32x4 o = (f32x4){0.f, 0.f, 0.f, 0.f};
#pragma unroll
            for (int pp = 0; pp < 5; ++pp) { const bf16x8 vf = tr_frag2(Vs, toff[2 * pp], toff[2 * pp + 1], dt, lane);
                o = __builtin_amdgcn_mfma_f32_16x16x32_bf16(vf, pf[pp], o, 0, 0, 0); }
            u32x2 ow; ow.x = cvt_pk_bf16(o[0] * inv, o[1] * inv); ow.y = cvt_pk_bf16(o[2] * inv, o[3] * inv);
            *(u32x2*)(orow + 16 * dt) = ow; }
        if (gq == 0) LSE[((size_t)g * SEQ + qpos) * NHEAD + h] = (mx + __builtin_amdgcn_logf(sum)) * 0.6931471805599453f;
        }
        if (b_ >= 0 && ATT_EXP == 1) { bf16* orow = ATT + ((size_t)g * SEQ + qpos) * 1024 + h * HD + 4 * gq;
#pragma unroll
            for (int dt = 0; dt < 8; ++dt) { u32x2 ow; ow.x = __builtin_bit_cast(unsigned, qf[dt & 3][0] | (qf[dt & 3][1] << 16)) & 0x3f803f80u; ow.y = 0u; *(u32x2*)(orow + 16 * dt) = ow; }
            if (gq == 0) LSE[((size_t)g * SEQ + qpos) * NHEAD + h] = 0.f; }
        __syncthreads();
    }
}
#undef ATT_DECODE
#undef ATT_LOAD

__device__ __forceinline__ void att_combine(Frame& F, int l) {
    const bf16* ATT = (const bf16*)(F.ws + WS_ATT); const float* LSE = (const float*)(F.ws + WS_LSE); bf16* MIX = (bf16*)(F.ws + WS_MIX);
    const int gw = F.vcu * NWAVES + F.wave, NGW = F.G * NWAVES, lane = F.lane;
    const float* og = F.in[IN_OUTN] + (size_t)l * DM + 1024 + 16 * lane;
    f32x4 gg[4];
#pragma unroll
    for (int q = 0; q < 4; ++q) gg[q] = *(const f32x4*)(og + 4 * q);
    for (int m = gw; m < SEQ; m += NGW) {
        const int hh = lane >> 3;
        const float l0 = LSE[((size_t)0 * SEQ + m) * NHEAD + hh], l1 = LSE[((size_t)1 * SEQ + m) * NHEAD + hh], l2 = LSE[((size_t)2 * SEQ + m) * NHEAD + hh];
        const float M = fmaxf(l0, fmaxf(l1, l2)); float w0 = fast_exp(l0 - M), w1 = fast_exp(l1 - M), w2 = fast_exp(l2 - M);
        const float iw = __builtin_amdgcn_rcpf(w0 + w1 + w2); w0 *= iw; w1 *= iw; w2 *= iw;
        float y[16]; float s = 0.f;
#pragma unroll
        for (int q = 0; q < 2; ++q) {
            const u32x4 a = __builtin_nontemporal_load((const u32x4*)(ATT + ((size_t)0 * SEQ + m) * 1024 + 16 * lane + 8 * q)), b = __builtin_nontemporal_load((const u32x4*)(ATT + ((size_t)1 * SEQ + m) * 1024 + 16 * lane + 8 * q)), c = __builtin_nontemporal_load((const u32x4*)(ATT + ((size_t)2 * SEQ + m) * 1024 + 16 * lane + 8 * q));
            const unsigned au[4] = {a.x, a.y, a.z, a.w}, bu[4] = {b.x, b.y, b.z, b.w}, cu[4] = {c.x, c.y, c.z, c.w};
#pragma unroll
            for (int e = 0; e < 4; ++e) { y[8 * q + 2 * e] = w0 * bf_lo(au[e]) + w1 * bf_lo(bu[e]) + w2 * bf_lo(cu[e]); y[8 * q + 2 * e + 1] = w0 * bf_hi(au[e]) + w1 * bf_hi(bu[e]) + w2 * bf_hi(cu[e]); } }
#pragma unroll
        for (int e = 0; e < 16; ++e) s += y[e] * y[e];
        const float rs = __builtin_amdgcn_rsqf(wave_sum(s) * (1.f / 1024.f) + EPS);
        if (OP8(l)) { u32x4 o8;
            o8.x = pk4_fp8(y[0] * rs * gg[0][0], y[1] * rs * gg[0][1], y[2] * rs * gg[0][2], y[3] * rs * gg[0][3]); o8.y = pk4_fp8(y[4] * rs * gg[1][0], y[5] * rs * gg[1][1], y[6] * rs * gg[1][2], y[7] * rs * gg[1][3]);
            o8.z = pk4_fp8(y[8] * rs * gg[2][0], y[9] * rs * gg[2][1], y[10] * rs * gg[2][2], y[11] * rs * gg[2][3]); o8.w = pk4_fp8(y[12] * rs * gg[3][0], y[13] * rs * gg[3][1], y[14] * rs * gg[3][2], y[15] * rs * gg[3][3]);
            *(u32x4*)((unsigned char*)MIX + (size_t)m * DM + 1024 + 16 * lane) = o8; }
        else
#pragma unroll
        for (int q = 0; q < 2; ++q) { u32x4 o;
            o.x = cvt_pk_bf16(y[8 * q + 0] * rs * gg[2 * q][0], y[8 * q + 1] * rs * gg[2 * q][1]); o.y = cvt_pk_bf16(y[8 * q + 2] * rs * gg[2 * q][2], y[8 * q + 3] * rs * gg[2 * q][3]);
            o.z = cvt_pk_bf16(y[8 * q + 4] * rs * gg[2 * q + 1][0], y[8 * q + 5] * rs * gg[2 * q + 1][1]); o.w = cvt_pk_bf16(y[8 * q + 6] * rs * gg[2 * q + 1][2], y[8 * q + 7] * rs * gg[2 * q + 1][3]);
            *(u32x4*)(MIX + (size_t)m * DM + 1024 + 16 * lane + 8 * q) = o; }
    }
}

#define ROUTER_LOAD(S, ks) do { \
    _Pragma("unroll") for (int rt = 0; rt < 4; ++rt) xa##S[rt] = *(const u32x4*)(xrow + (size_t)rt * 16 * DM + 32 * (ks)); \
    _Pragma("unroll") for (int ct = 0; ct < 3; ++ct) { bh##S[ct] = *(const bf16x8*)(wf + (size_t)(ks) * 3072 + (ct * 2) * 512); bl##S[ct] = *(const bf16x8*)(wf + (size_t)(ks) * 3072 + (ct * 2 + 1) * 512); } } while (0)
#define ROUTER_STEP(S, ks) do { \
    _Pragma("unroll") for (int rt = 0; rt < 4; ++rt) { const u32x4 xq = xa##S[rt]; \
        const float x0 = bf_lo(xq.x), x1 = bf_hi(xq.x), x2 = bf_lo(xq.y), x3 = bf_hi(xq.y), x4 = bf_lo(xq.z), x5 = bf_hi(xq.z), x6 = bf_lo(xq.w), x7 = bf_hi(xq.w); \
        ssq[rt] += (x0 * x0 + x1 * x1) + (x2 * x2 + x3 * x3) + (x4 * x4 + x5 * x5) + (x6 * x6 + x7 * x7); \
        { u32x2 x8; x8.x = pk4_fp8(x0, x1, x2, x3); x8.y = pk4_fp8(x4, x5, x6, x7); *(u32x2*)(x8row + (size_t)rt * 16 * DM + 32 * (ks)) = x8; } \
        const bf16x8 xh = __builtin_bit_cast(bf16x8, xq); \
        _Pragma("unroll") for (int ct = 0; ct < 3; ++ct) { \
            acc[rt][ct] = __builtin_amdgcn_mfma_f32_16x16x32_bf16(xh, bh##S[ct], acc[rt][ct], 0, 0, 0); \
            acc[rt][ct] = __builtin_amdgcn_mfma_f32_16x16x32_bf16(xh, bl##S[ct], acc[rt][ct], 0, 0, 0); } } } while (0)
__device__ __forceinline__ void router_phase(Frame& F, int l, int alt = 0) {
    const bf16* H1 = (const bf16*)(F.ws + WS_HN);
    const bf16* WRF = (const bf16*)(F.ws + WS_WRT) + (size_t)l * 64 * 3 * 2 * 64 * 8;
    unsigned* cnt = (unsigned*)(F.ws + WS_CTL) + CW_CNT + 2048 * l + 32768 * alt;
    int* tok = (int*)(F.ws + (alt ? WS_ALT : WS_TOK)); f32x4* tinfo = (f32x4*)(F.ws + (alt ? WS_ALT + 4 * MiB : WS_TINFO)); float* rslot = (float*)(F.ws + (alt ? WS_ALT + 2 * MiB : WS_RSLOT));
    const int lane = F.lane, tid = F.tid, w = F.wave, fr = lane & 15, g = lane >> 4;
    constexpr int PS = 49;
    LAS float* P = (LAS float*)F.lds;
    LAS float* SS = (LAS float*)(F.lds + 8 * 64 * PS * 4);
    for (int task = (int)blockIdx.x; task < SEQ / 64; task += F.G) {
        const bf16* xrow = H1 + (size_t)(task * 64 + fr) * DM + 256 * w + 8 * g;
        unsigned char* x8row = F.ws + WS_X8 + (size_t)(task * 64 + fr) * DM + 256 * w + 8 * g;
        const bf16* wf = WRF + ((size_t)(8 * w) * 3 * 2 * 64 + lane) * 8;
        f32x4 acc[4][3]; float ssq[4] = {0.f, 0.f, 0.f, 0.f};
#pragma unroll
        for (int rt = 0; rt < 4; ++rt)
#pragma unroll
            for (int ct = 0; ct < 3; ++ct) acc[rt][ct] = (f32x4){0.f, 0.f, 0.f, 0.f};
        u32x4 xaA[4], xaB[4]; bf16x8 bhA[3], blA[3], bhB[3], blB[3];
        ROUTER_LOAD(A, 0);
#pragma unroll 1
        for (int it = 0; it < 4; ++it) {
            ROUTER_LOAD(B, 1); __builtin_amdgcn_sched_barrier(0);
            ROUTER_STEP(A, 0); __builtin_amdgcn_sched_barrier(0);
            if (it < 3) ROUTER_LOAD(A, 2);
            __builtin_amdgcn_sched_barrier(0);
            ROUTER_STEP(B, 1); __builtin_amdgcn_sched_barrier(0);
            xrow += 64; x8row += 64; wf += 2 * 3072;
        }
#pragma unroll
        for (int rt = 0; rt < 4; ++rt) { float sq = ssq[rt]; sq += __shfl_xor(sq, 16); sq += __shfl_xor(sq, 32);
            if (g == 0) SS[w * 64 + 16 * rt + fr] = sq;
#pragma unroll
            for (int ct = 0; ct < 3; ++ct)
#pragma unroll
                for (int e = 0; e < 4; ++e) P[(w * 64 + 16 * rt + 4 * g + e) * PS + 16 * ct + fr] = acc[rt][ct][e]; }
        __syncthreads();
        if (tid < 64) {
            const int t = task * 64 + tid;
            float ss = 0.f;
#pragma unroll
            for (int q = 0; q < 8; ++q) ss += SS[q * 64 + tid];
            const float rs = __builtin_amdgcn_rsqf(ss * (1.f / DM) + EPS);
            const LAS float* pr = P + tid * PS;
            float lg[4];
#pragma unroll
            for (int o = 0; o < 4; ++o) { float a = 0.f;
#pragma unroll
                for (int q = 0; q < 8; ++q) a += pr[q * 64 * PS + 32 + o];
                lg[o] = a * rs + F.in[IN_BRG][l * 4 + o]; }
            int gi = 0; float gm = lg[0];
#pragma unroll
            for (int o = 1; o < 4; ++o) if (lg[o] > gm) { gm = lg[o]; gi = o; }
            float den = 0.f;
#pragma unroll
            for (int o = 0; o < 4; ++o) den += __expf(lg[o] - gm);
            const float gate_g = 1.f / den;
            float t1v = -INFINITY, t2v = -INFINITY; int t1i = 0, t2i = 0;
#pragma unroll
            for (int ii = 0; ii < 8; ++ii) { const int o = gi * 8 + ii; float a = 0.f;
#pragma unroll
                for (int q = 0; q < 8; ++q) a += pr[q * 64 * PS + o];
                const float v = a * rs + F.in[IN_BRE][l * NE + o];
                if (v > t1v) { t2v = t1v; t2i = t1i; t1v = v; t1i = ii; }
                else if (v > t2v) { t2v = v; t2i = ii; } }
            const float pp1 = 1.f / (1.f + __expf(t2v - t1v)), pp2 = 1.f - pp1;
            const int e0 = gi * 8 + t1i, e1 = gi * 8 + t2i;
            LAS unsigned* lcnt = (LAS unsigned*)(F.lds + 8 * 64 * PS * 4 + 8 * 64 * 4);
            if (tid < 32) lcnt[tid] = 0u;
            const unsigned r0 = __hip_atomic_fetch_add(lcnt + e0, 1u, __ATOMIC_RELAXED, __HIP_MEMORY_SCOPE_WORKGROUP), r1 = __hip_atomic_fetch_add(lcnt + e1, 1u, __ATOMIC_RELAXED, __HIP_MEMORY_SCOPE_WORKGROUP);
            if (tid < 32) { const unsigned c = lcnt[tid]; lcnt[32 + tid] = c ? atomicAdd(&cnt[tid * CNT_STRIDE], c) : 0u; }
            const unsigned s0 = lcnt[32 + e0] + r0, s1 = lcnt[32 + e1] + r1;
            tok[(size_t)e0 * TOKCAP + s0] = t; tok[(size_t)e1 * TOKCAP + s1] = t;
            rslot[(size_t)e0 * TOKCAP + s0] = rs; rslot[(size_t)e1 * TOKCAP + s1] = rs;
            f32x4 ti; ti[0] = __builtin_bit_cast(float, (int)(e0 * TOKCAP + s0)); ti[1] = __builtin_bit_cast(float, (int)(e1 * TOKCAP + s1)); ti[2] = gate_g * pp1; ti[3] = gate_g * pp2;
            tinfo[t] = ti;
        }
        __syncthreads();
    }
}
__device__ __forceinline__ void moe_table(Frame& F, int l) {
    const unsigned* cnt = (const unsigned*)(F.ws + WS_CTL) + CW_CNT + 2048 * l;
    LAS int* tstart = (LAS int*)(F.lds + MISC_OFF + 64);
    __syncthreads();
    if (F.tid == 0) { int acc = 0; for (int e = 0; e < NE; ++e) { tstart[e] = acc; acc += ((int)cnt[e * CNT_STRIDE] + 255) >> 8; } tstart[NE] = acc; }
    __syncthreads();
    { LAS int* tile_e = (LAS int*)(F.lds + MISC_OFF + 2304);
      if (F.tid < 160) { int e = 0; for (int j = 1; j < NE; ++j) e = (tstart[j] <= F.tid) ? j : e; tile_e[F.tid] = e; } }
    __syncthreads();
}
__device__ __forceinline__ void combine_phase(Frame& F, int l) {
    const LAS int* tstart = (const LAS int*)(F.lds + MISC_OFF + 64);
    const unsigned char* Y = F.ws + WS_Y; const f32x4* tinfo = (const f32x4*)(F.ws + WS_TINFO);
    bf16* H = (bf16*)(F.ws + WS_H); bf16* HN = (bf16*)(F.ws + WS_HN);
    const int gw = F.vcu * NWAVES + F.wave, NGW = F.G * NWAVES, lane = F.lane;
    const float* g1n = F.in[IN_NORM1] + (size_t)DM;
    for (int m = gw; m < SEQ; m += NGW) {
        const f32x4 ti = tinfo[m];
        const float tf0 = ti[0], tf1 = ti[1]; const int s0 = __builtin_bit_cast(int, tf0), s1 = __builtin_bit_cast(int, tf1);
        const int e0 = s0 >> 14, e1 = s1 >> 14;
        const size_t r0 = (size_t)tstart[e0] * 256 + (s0 & (TOKCAP - 1)), r1 = (size_t)tstart[e1] * 256 + (s1 & (TOKCAP - 1));
        const float ga = ti[2] * (1.f / Y_SCALE), gb = ti[3] * (1.f / Y_SCALE);
        f32x4 v[8]; float s = 0.f;
#pragma unroll
        for (int j = 0; j < 8; ++j) { const u32x2 hx = __builtin_nontemporal_load((const u32x2*)(HN + (size_t)m * DM + 4 * lane + 256 * j));
            const int ya = __builtin_nontemporal_load((const int*)(Y + r0 * DM + 4 * lane + 256 * j)), yb = __builtin_nontemporal_load((const int*)(Y + r1 * DM + 4 * lane + 256 * j));
            const f32x2 a01 = __builtin_amdgcn_cvt_pk_f32_fp8(ya, false), a23 = __builtin_amdgcn_cvt_pk_f32_fp8(ya, true), b01 = __builtin_amdgcn_cvt_pk_f32_fp8(yb, false), b23 = __builtin_amdgcn_cvt_pk_f32_fp8(yb, true);
            v[j][0] = bf_lo(hx.x) + ga * a01[0] + gb * b01[0]; v[j][1] = bf_hi(hx.x) + ga * a01[1] + gb * b01[1];
            v[j][2] = bf_lo(hx.y) + ga * a23[0] + gb * b23[0]; v[j][3] = bf_hi(hx.y) + ga * a23[1] + gb * b23[1];
            s += (v[j][0] * v[j][0] + v[j][1] * v[j][1]) + (v[j][2] * v[j][2] + v[j][3] * v[j][3]); }
        if (l == 0) {
            const float rs = __builtin_amdgcn_rsqf(wave_sum(s) * (1.f / DM) + EPS);
            bf16* hrow = H + (size_t)m * DM; bf16* orow = HN + (size_t)m * DM;
#pragma unroll
            for (int j = 0; j < 8; ++j) { const f32x4 gg = *(const f32x4*)(g1n + 4 * lane + 256 * j);
                u32x2 hb; hb.x = cvt_pk_bf16(v[j][0], v[j][1]); hb.y = cvt_pk_bf16(v[j][2], v[j][3]); *(u32x2*)(hrow + 4 * lane + 256 * j) = hb;
                if (IP8(1)) *(unsigned*)(F.ws + WS_X8 + (size_t)m * DM + 4 * lane + 256 * j) = pk4_fp8(v[j][0] * rs * gg[0], v[j][1] * rs * gg[1], v[j][2] * rs * gg[2], v[j][3] * rs * gg[3]);
                else { u32x2 o; o.x = cvt_pk_bf16(v[j][0] * rs * gg[0], v[j][1] * rs * gg[1]); o.y = cvt_pk_bf16(v[j][2] * rs * gg[2], v[j][3] * rs * gg[3]);
                *(u32x2*)(orow + 4 * lane + 256 * j) = o; } }
        } else {
            float* orow = F.out + (size_t)m * DM;
#pragma unroll
            for (int j = 0; j < 8; ++j) __builtin_nontemporal_store(v[j], (f32x4*)(orow + 4 * lane + 256 * j));
        }
    }
}

__device__ __forceinline__ void relaunder(Frame& F) { F.lane = lane_now(); F.tid = F.wave * 64 + F.lane; }
constexpr int N_PHASES = 17;
#ifndef PHASE_MASK
#define PHASE_MASK 0x1ff
#endif
#ifndef MIX_MASK
#define MIX_MASK 7
#endif
#ifndef DUP_PHASE
#define DUP_PHASE 0
#endif
#define DUP(k) for (int _d = 0; _d < ((DUP_PHASE == (k)) ? 2 : 1); ++_d)
#define IN(k) (lo <= (k) && (k) < hi)
#define EN(b) ((PHASE_MASK >> (b)) & 1)
#ifndef PROBE_STAMP
#define PROBE_STAMP (-1)
#endif
#ifndef PROBE_IDLE
#define PROBE_IDLE (-1)
#endif
#define SEAM(k) do { if (IN(k) && IN((k) + 1)) { unsigned long long _ta = 0; if (PROBE_IDLE == (k)) { asm volatile("s_waitcnt vmcnt(0)" ::: "memory"); __syncthreads(); if (F.wave == 0) _ta = wall_clock64(); } xcd_barrier(bar); \
    if (PROBE_IDLE == (k) && F.wave == 0) { const unsigned long long _tb = wall_clock64(); if (lane_now() == 0) xb_add((unsigned*)(F.ws + WS_CTL) + 200000, (unsigned)(_tb - _ta)); } \
 if (PROBE_STAMP >= 0 && blockIdx.x == 0 && F.tid == 0) { const unsigned long long _t = wall_clock64(); F.MISC[802 + 2 * (k)] = (unsigned)_t; F.MISC[803 + 2 * (k)] = (unsigned)(_t >> 32); } } } while (0)
template <int l>
__device__ __forceinline__ void layer_phases(Frame& F, const XcdBarrier& bar, const int lo, const int hi) {
    constexpr int pb = 1 + 8 * l;
    relaunder(F);
    if (EN(1) && IN(pb)) {
        constexpr int KI = IP8(l) ? DM / 2 : DM;
#define INPROJ_PART(first) do { pg8::StaticSched S; S.init((const bf16*)(F.ws + (IP8(l) ? WS_X8 : WS_HN)), (const bf16*)(F.ws + WS_WIN) + (size_t)l * DIN * DM, SEQ, DIN, KI, F.G, (int)blockIdx.x); \
            const int slot = ((((((int)blockIdx.x >> 6) & 3) << 3) | ((int)blockIdx.x & 7)) * 6) >> 5; if (first) S.i1 = slot; else S.i0 = slot; \
            pg8::EpiProj E{(bf16*)(F.ws + WS_PROJ), IP8(l) ? 1.f / WIN_SCALE : 1.f}; \
            DUP(1) pg8::gemm_phase<pg8::EpiProj, pg8::StaticSched, true, IP8(l) != 0>(F.lds, KI, S, E, F.wave); } while (0)
        INPROJ_PART(true);
        __syncthreads(); relaunder(F); convert_tiles(F, l == 0 ? CV_P : CV_A, l == 0 ? CV_A : CV_B); __syncthreads(); relaunder(F);
        INPROJ_PART(false);
#undef INPROJ_PART
    }
    SEAM(pb);
    relaunder(F);
    if (EN(2) && IN(pb + 1)) {
        constexpr int N_SGU = 256, N_CONV = 512, N_ATT = 3072;
#define MSTAMP(i) do { if (PROBE_STAMP >= 100 && l == 0 && blockIdx.x == 0 && F.tid == 0) { const unsigned long long _t = wall_clock64(); F.MISC[900 + 2 * (i)] = (unsigned)_t; F.MISC[901 + 2 * (i)] = (unsigned)(_t >> 32); } } while (0)
        MSTAMP(0);
        if (MIX_MASK & 1) DUP(2) att_phase(F, l);
        MSTAMP(1);
        if (MIX_MASK & 2) DUP(3) for (int it = (int)blockIdx.x; it < N_CONV; it += F.G) conv_item(F, l, it);
        MSTAMP(2);
        if (MIX_MASK & 4) DUP(4) for (int it = (int)blockIdx.x; it < N_SGU; it += F.G) sgu_item(F, l, it >> 1, it & 1);
        MSTAMP(3);
#undef MSTAMP
    }
    SEAM(pb + 1);
    if (DUP_PHASE == 12 && IN(pb + 1)) {
        pg8::StaticSched S; S.init((const bf16*)(F.ws + WS_MIX), (const bf16*)(F.ws + WS_WIN) + (size_t)l * DIN * DM, SEQ, DIN, DM, F.G, (int)blockIdx.x);
        pg8::EpiProj E{(bf16*)(F.ws + WS_PROJ), 1.f};
        pg8::gemm_phase<pg8::EpiProj, pg8::StaticSched>(F.lds, DM, S, E, F.wave);
        xcd_barrier(bar);
    }
    relaunder(F);
    if (EN(3) && IN(pb + 2)) DUP(5) att_combine(F, l);
    SEAM(pb + 2);
    relaunder(F);
    if (EN(4) && IN(pb + 3)) {
        constexpr int KO = OP8(l) ? DM / 2 : DM;
        pg8::StaticSched S; S.init((const bf16*)(F.ws + WS_MIX), (const bf16*)(F.ws + WS_WOUT) + (size_t)l * DM * DM, SEQ, DM, KO, F.G, (int)blockIdx.x);
        if constexpr (l == 0) { pg8::EpiResid<false> E{(const void*)F.in[IN_X], (bf16*)(F.ws + WS_HN)}; DUP(6) pg8::gemm_phase<pg8::EpiResid<false>, pg8::StaticSched, true, OP8(l) != 0>(F.lds, KO, S, E, F.wave); }
        else { pg8::EpiResid<true> E{(const void*)(F.ws + WS_H), (bf16*)(F.ws + WS_HN)}; DUP(6) pg8::gemm_phase<pg8::EpiResid<true>, pg8::StaticSched, true, OP8(l) != 0>(F.lds, KO, S, E, F.wave); }
    }
    SEAM(pb + 3);
    relaunder(F);
    if (EN(5) && IN(pb + 4)) { router_phase(F, l); if (DUP_PHASE == 11) router_phase(F, l, 1); }
    if (DUP_PHASE == 13 && IN(pb + 4)) { for (int q = 0; q < 8; ++q) xcd_barrier(bar); }
    SEAM(pb + 4);
    relaunder(F);
    if (EN(6) && IN(pb + 5)) {
        moe_table(F, l);
        unsigned* ready = (unsigned*)(F.ws + WS_CTL) + CW_RDY + 16384 * l;
        {
            pg8::SchedG1 S{(const LAS int*)(F.lds + MISC_OFF + 64), (const int*)((const unsigned*)(F.ws + WS_CTL) + CW_CNT + 2048 * l), (const int*)(F.ws + WS_TOK), (const bf16*)(F.ws + WS_X8),
                           (const bf16*)(F.ws + WS_W1 + (size_t)l * NE * 1024 * DM), F.G, (int)blockIdx.x, ready};
            pg8::EpiSwiGLU E{F.ws + WS_HB, (const float*)(F.ws + WS_RSLOT)};
            DUP(7) pg8::gemm_phase<pg8::EpiSwiGLU, pg8::SchedG1, true, true>(F.lds, DM / 2, S, E, F.wave);
        }
        {
            pg8::SchedG2 S{(const LAS int*)(F.lds + MISC_OFF + 64), (const bf16*)(F.ws + WS_HB), (const bf16*)(F.ws + WS_W2 + (size_t)l * NE * DM * DE), F.G, (int)blockIdx.x, ready, (unsigned*)(F.ws + WS_CTL) + CW_TMO, F.wave};
            pg8::EpiY E{F.ws + WS_Y};
            DUP(8) pg8::gemm_phase<pg8::EpiY, pg8::SchedG2, true, true>(F.lds, DE / 2, S, E, F.wave);
        }
    }
    SEAM(pb + 6);
    relaunder(F);
    if (EN(8) && IN(pb + 7)) { moe_table(F, l); DUP(l == 0 ? 9 : 99) combine_phase(F, l); }
    SEAM(pb + 7);
}
__global__ void __launch_bounds__(NTHREADS, 2) fwd_kernel(Params args) {
    extern __shared__ __attribute__((aligned(16))) unsigned char lds_raw[];
    Frame F;
    F.lds = (LAS unsigned char*)lds_raw; F.MISC = (volatile LAS unsigned*)(F.lds + MISC_OFF);
    F.tid = threadIdx.x; F.lane = F.tid & 63; F.wave = __builtin_amdgcn_readfirstlane(F.tid >> 6);
    F.G = gridDim.x; { const int bx = blockIdx.x; F.vcu = (F.G % 8 == 0) ? (bx % 8) * (F.G / 8) + bx / 8 : bx; }
    F.in = args.in; F.out = args.out; F.ws = args.ws;
    for (int u = F.tid; u < (LDS_BYTES - MISC_OFF) / 4; u += NTHREADS) ((LAS unsigned*)(F.lds + MISC_OFF))[u] = 0u;
    __syncthreads();
    unsigned* ctl = (unsigned*)(args.ws + WS_CTL);
    const int lo = args.ph_lo, hi = args.ph_hi;
    const bool multi = (hi - lo) > 1;
    XcdBarrier bar; bar.bar = ctl + CW_BAR; bar.x = 0; bar.st = nullptr; bar.lead = 0;
    if (multi) bar = xcd_barrier_post(ctl + CW_BAR, F.MISC, F.wave == 0 ? 1u : 0u);
    if (PROBE_STAMP >= 0 && blockIdx.x == 0 && F.tid == 0) { const unsigned long long _t = wall_clock64(); F.MISC[800] = (unsigned)_t; F.MISC[801] = (unsigned)(_t >> 32); }
    if (EN(0) && IN(0)) { DUP(10) p_prologue(F); }
    SEAM(0);
    layer_phases<0>(F, bar, lo, hi);
    layer_phases<1>(F, bar, lo, hi);
    if (PROBE_IDLE >= 0 && blockIdx.x == 0 && F.wave == 0 && lane_now() == 0) { asm volatile("s_waitcnt vmcnt(0)" ::: "memory"); F.out[0] += (float)xb_ld((unsigned*)(F.ws + WS_CTL) + 200000) * (0.01f / 256.f); }
    if (PROBE_STAMP >= 0 && blockIdx.x == 0 && F.tid == 0) {
        asm volatile("s_waitcnt vmcnt(0)" ::: "memory");
        constexpr int SB = PROBE_STAMP >= 100 ? 900 + 2 * (PROBE_STAMP - 100) : (PROBE_STAMP == 6 ? 812 : 800 + 2 * PROBE_STAMP);
        constexpr int SB1 = (PROBE_STAMP == 6) ? SB + 4 : SB + 2;
        const unsigned long long t1 = ((unsigned long long)F.MISC[SB1 + 1] << 32) | F.MISC[SB1], t0 = ((unsigned long long)F.MISC[SB + 1] << 32) | F.MISC[SB];
        F.out[0] += (float)(long long)(t1 - t0) * 0.01f;
    }
}
#undef IN
#undef EN
#undef SEAM
#undef DUP

extern "C" void kernel_launch(void* const* d_in, const int* in_sizes, int n_in, void* d_out, int out_size, void* d_ws, size_t ws_size, hipStream_t stream) {
    static int grid = 0;
    if (grid == 0) {
        if (n_in != 22 || out_size != SEQ * DM || ws_size < WS_END) { fprintf(stderr, "kernel_launch: unexpected shapes (n_in %d out %d ws %zu, need %zu)\n", n_in, out_size, ws_size, (size_t)WS_END); grid = -1; return; }
        int dev = 0, cus = 0, per_cu = 0;
        if (hipGetDevice(&dev) != hipSuccess || hipDeviceGetAttribute(&cus, hipDeviceAttributeMultiprocessorCount, dev) != hipSuccess) { grid = -1; return; }
        if (hipFuncSetAttribute((const void*)fwd_kernel, hipFuncAttributeMaxDynamicSharedMemorySize, LDS_BYTES) != hipSuccess) { fprintf(stderr, "kernel_launch: hipFuncSetAttribute failed\n"); grid = -1; return; }
        if (hipOccupancyMaxActiveBlocksPerMultiprocessor(&per_cu, (const void*)fwd_kernel, NTHREADS, LDS_BYTES) != hipSuccess || per_cu < 1) { fprintf(stderr, "kernel_launch: occupancy query says %d\n", per_cu); }
        (void)hipGetLastError();
        grid = cus;
    }
    if (grid < 0) return;
    if (hipMemsetAsync((char*)d_ws + WS_CTL, 0, CTL_ZERO_BYTES, stream) != hipSuccess) return;
    Params p{};
    for (int i = 0; i < 22; ++i) p.in[i] = (const float*)d_in[i];
    p.out = (float*)d_out; p.ws = (unsigned char*)d_ws;
    constexpr int NL = MK_N_LAUNCHES;
    for (int li = 0; li < NL; ++li) {
        p.ph_lo = (NL == 1) ? 0 : li; p.ph_hi = (NL == 1) ? N_PHASES : li + 1;
        hipLaunchKernelGGL(fwd_kernel, dim3(grid), dim3(NTHREADS), LDS_BYTES, stream, p);
        if (hipPeekAtLastError() != hipSuccess) { fprintf(stderr, "kernel_launch: launch %d failed\n", li); break; }
    }
}
```
